# Optimizing an MI355X kernel written in HIP

```python
import math
import jax, jax.numpy as jnp
from jax import lax
import numpy as np


D_MODEL = 1024
BATCH = 4
SEQ = 4096
DEPTH = 2

N_MIXERS = 2
MLA_HEADS = 8
MLA_Q_LORA = 384
MLA_KV_LORA = 256
MLA_NOPE = 128
MLA_ROPE = 64
MLA_V = 128
MLA_THETA = 10000.0
MLA_IN = MLA_Q_LORA + MLA_KV_LORA + MLA_ROPE
DIFF_HEADS = 8
DIFF_HEAD_DIM = 64
DIFF_V = 2 * DIFF_HEAD_DIM
DIFF_ROT = DIFF_HEAD_DIM // 4
ROPE_THETA = 500000.0
DIFF_IN = 4 * DIFF_HEADS * DIFF_HEAD_DIM + DIFF_HEADS * DIFF_V
N_EXPERTS = 16
EXPERT_FF = 2048
EC_CAPACITY_FACTOR = 2
Q_BLOCK = 128
NORM_EPS = 1e-5
LATENT_EPS = 1e-6
ALPHA = (2 * DEPTH) ** 0.25
BETA = (8 * DEPTH) ** -0.25
N_MLA_LAYERS = (DEPTH + 1) // 2
N_DIFF_LAYERS = DEPTH // 2

kernel_name = 'hybrid_mla_diffattn_ec_moe_encoder'


def layer_norm(x, g, b):
    xf = x.astype(jnp.float32)
    xc = xf - xf.mean(-1, keepdims=True)
    var = (xc * xc).mean(-1, keepdims=True)
    return (xc * lax.rsqrt(var + NORM_EPS)).astype(x.dtype) * g + b


def rms_norm(x, g, eps):
    xf = x.astype(jnp.float32)
    return (xf * lax.rsqrt((xf * xf).mean(-1, keepdims=True) + eps)).astype(x.dtype) * g


def rope_cos_sin(positions, rot_dim, theta):
    inv = theta ** (-jnp.arange(0, rot_dim, 2, dtype=jnp.float32) / rot_dim)
    ang = positions.astype(jnp.float32)[..., None] * inv
    return jnp.cos(ang), jnp.sin(ang)


def apply_rope(x, cos, sin):
    shape = cos.shape[:2] + (1,) * (x.ndim - 3) + cos.shape[-1:]
    c = cos.reshape(shape).astype(x.dtype)
    s = sin.reshape(shape).astype(x.dtype)
    half = x.shape[-1] // 2
    x1, x2 = x[..., :half], x[..., half:]
    return jnp.concatenate([x1 * c - x2 * s, x2 * c + x1 * s], -1)


def mla_mixer(h, cos, sin, w_in, q_norm, kv_norm, w_uq, w_ukv, w_o):
    B, S, _ = h.shape
    H = MLA_HEADS
    cq, ckv, kr = jnp.split(h @ w_in, [MLA_Q_LORA, MLA_Q_LORA + MLA_KV_LORA], -1)
    q = (rms_norm(cq, q_norm, LATENT_EPS) @ w_uq).reshape(B, S, H, MLA_NOPE + MLA_ROPE)
    q = jnp.concatenate([q[..., :MLA_NOPE], apply_rope(q[..., MLA_NOPE:], cos, sin)], -1)
    kv = (rms_norm(ckv, kv_norm, LATENT_EPS) @ w_ukv).reshape(B, S, H, MLA_NOPE + MLA_V)
    k_pe = apply_rope(kr[:, :, None, :], cos, sin)
    k = jnp.concatenate([kv[..., :MLA_NOPE], jnp.broadcast_to(k_pe, (B, S, H, MLA_ROPE))], -1)
    v = kv[..., MLA_NOPE:]
    scale = (MLA_NOPE + MLA_ROPE) ** -0.5
    nb = S // Q_BLOCK
    qb = q.reshape(B, nb, Q_BLOCK, H, MLA_NOPE + MLA_ROPE).transpose(1, 0, 2, 3, 4)

    def block(qi):
        s = jnp.einsum('bqhd,bkhd->bhqk', qi, k).astype(jnp.float32) * scale
        p = jax.nn.softmax(s, -1).astype(v.dtype)
        return jnp.einsum('bhqk,bkhd->bqhd', p, v)

    o = lax.map(block, qb).transpose(1, 0, 2, 3, 4).reshape(B, S, H * MLA_V)
    return o @ w_o


def diff_mixer(h, cos, sin, w_in, lam_vec, subln, w_o, lambda_init):
    B, S, _ = h.shape
    H, d = DIFF_HEADS, DIFF_HEAD_DIM
    qd = H * 2 * d
    q, k, v = jnp.split(h @ w_in, [qd, 2 * qd], -1)
    q = q.reshape(B, S, H, 2, d)
    k = k.reshape(B, S, H, 2, d)
    v = v.reshape(B, S, H, DIFF_V)

    def partial_rope(t):
        return jnp.concatenate([apply_rope(t[..., :DIFF_ROT], cos, sin), t[..., DIFF_ROT:]], -1)

    q, k = partial_rope(q), partial_rope(k)
    lf = lam_vec.astype(jnp.float32)
    lam = jnp.exp(jnp.sum(lf[0] * lf[1])) - jnp.exp(jnp.sum(lf[2] * lf[3])) + lambda_init
    scale = d ** -0.5
    nb = S // Q_BLOCK
    qb = q.reshape(B, nb, Q_BLOCK, H, 2, d).transpose(1, 0, 2, 3, 4, 5)

    def block(qi):
        s = jnp.einsum('bqhcd,bkhcd->bhcqk', qi, k).astype(jnp.float32) * scale
        p = jax.nn.softmax(s, -1)
        a = (p[:, :, 0] - lam * p[:, :, 1]).astype(v.dtype)
        return jnp.einsum('bhqk,bkhe->bqhe', a, v)

    o = lax.map(block, qb).transpose(1, 0, 2, 3, 4)
    o = rms_norm(o, subln, NORM_EPS) * (1.0 - lambda_init)
    return o.reshape(B, S, H * DIFF_V) @ w_o


def ec_moe(h, router_w, w_in, w_out):
    B, S, D = h.shape
    cap = max(1, EC_CAPACITY_FACTOR * S // N_EXPERTS)
    aff = jax.nn.softmax((h @ router_w).astype(jnp.float32), -1)
    gate, idx = lax.top_k(aff.transpose(0, 2, 1), cap)
    xe = jax.vmap(lambda hb, ib: hb[ib])(h, idx)
    gu = jnp.einsum('becd,edf->becf', xe, w_in)
    g, u = jnp.split(gu, 2, -1)
    y = jnp.einsum('becf,efd->becd', jax.nn.silu(g) * u, w_out) * gate[..., None].astype(h.dtype)
    return jax.vmap(
        lambda yb, ib: jnp.zeros((S, D), yb.dtype).at[ib.reshape(-1)].add(yb.reshape(-1, D))
    )(y, idx)


def setup_inputs(seed: int = 0) -> dict:
    key = jax.random.key(seed)
    ks = jax.random.split(key, 24)
    f32 = jnp.float32
    D = D_MODEL

    def nrm(k, shape, scale):
        return jax.random.normal(k, shape, f32) * scale

    x = jax.random.normal(ks[0], (BATCH, SEQ, D), f32)
    c = jax.random.normal(ks[1], (BATCH, D), f32)
    positions = (jnp.arange(SEQ, dtype=jnp.int32)[None, :]
                 + jax.random.randint(ks[2], (BATCH, 1), 0, SEQ, dtype=jnp.int32))
    ada_w = nrm(ks[3], (DEPTH, D, 6 * D), 0.1 * D ** -0.5)
    ada_b = nrm(ks[4], (DEPTH, 6 * D), 0.01)
    ln1_g = 1.0 + nrm(ks[5], (DEPTH, D), 0.02)
    ln1_b = nrm(ks[6], (DEPTH, D), 0.01)
    ln2_g = 1.0 + nrm(ks[7], (DEPTH, D), 0.02)
    ln2_b = nrm(ks[8], (DEPTH, D), 0.01)
    mla_w_in = nrm(ks[9], (N_MLA_LAYERS, D, MLA_IN), D ** -0.5)
    mla_q_norm = 1.0 + nrm(ks[10], (N_MLA_LAYERS, MLA_Q_LORA), 0.02)
    mla_kv_norm = 1.0 + nrm(ks[11], (N_MLA_LAYERS, MLA_KV_LORA), 0.02)
    mla_w_uq = nrm(ks[12], (N_MLA_LAYERS, MLA_Q_LORA, MLA_HEADS * (MLA_NOPE + MLA_ROPE)), MLA_Q_LORA ** -0.5)
    mla_w_ukv = nrm(ks[13], (N_MLA_LAYERS, MLA_KV_LORA, MLA_HEADS * (MLA_NOPE + MLA_V)), MLA_KV_LORA ** -0.5)
    mla_w_o = nrm(ks[14], (N_MLA_LAYERS, MLA_HEADS * MLA_V, D), BETA * (MLA_HEADS * MLA_V) ** -0.5)
    diff_w_in = nrm(ks[15], (N_DIFF_LAYERS, D, DIFF_IN), D ** -0.5)
    diff_lambda = nrm(ks[16], (N_DIFF_LAYERS, 4, DIFF_HEAD_DIM), 0.1)
    diff_subln = 1.0 + nrm(ks[17], (N_DIFF_LAYERS, DIFF_V), 0.02)
    diff_w_o = nrm(ks[18], (N_DIFF_LAYERS, DIFF_HEADS * DIFF_V, D), BETA * (DIFF_HEADS * DIFF_V) ** -0.5)
    router_w = nrm(ks[19], (DEPTH, D, N_EXPERTS), D ** -0.5)
    moe_w_in = nrm(ks[20], (DEPTH, N_EXPERTS, D, 2 * EXPERT_FF), D ** -0.5)
    moe_w_out = nrm(ks[21], (DEPTH, N_EXPERTS, EXPERT_FF, D), BETA * EXPERT_FF ** -0.5)
    return {'x': x, 'c': c, 'positions': positions, 'ada_w': ada_w, 'ada_b': ada_b,
            'ln1_g': ln1_g, 'ln1_b': ln1_b, 'ln2_g': ln2_g, 'ln2_b': ln2_b,
            'mla_w_in': mla_w_in, 'mla_q_norm': mla_q_norm, 'mla_kv_norm': mla_kv_norm,
            'mla_w_uq': mla_w_uq, 'mla_w_ukv': mla_w_ukv, 'mla_w_o': mla_w_o,
            'diff_w_in': diff_w_in, 'diff_lambda': diff_lambda, 'diff_subln': diff_subln,
            'diff_w_o': diff_w_o, 'router_w': router_w, 'moe_w_in': moe_w_in, 'moe_w_out': moe_w_out}


def reference(x, c, positions, ada_w, ada_b, ln1_g, ln1_b, ln2_g, ln2_b,
              mla_w_in, mla_q_norm, mla_kv_norm, mla_w_uq, mla_w_ukv, mla_w_o,
              diff_w_in, diff_lambda, diff_subln, diff_w_o,
              router_w, moe_w_in, moe_w_out):
    cos_m, sin_m = rope_cos_sin(positions, MLA_ROPE, MLA_THETA)
    cos_d, sin_d = rope_cos_sin(positions, DIFF_ROT, ROPE_THETA)
    mods = jnp.einsum('bd,lde->lbe', jax.nn.silu(c), ada_w) + ada_b[:, None, :]
    for i in range(DEPTH):
        sh1, sc1, g1, sh2, sc2, g2 = jnp.split(mods[i][:, None, :], 6, -1)
        h = x * (1.0 + sc1) + sh1
        j = i // N_MIXERS
        if i % N_MIXERS == 0:
            t = mla_mixer(h, cos_m, sin_m, mla_w_in[j], mla_q_norm[j], mla_kv_norm[j],
                          mla_w_uq[j], mla_w_ukv[j], mla_w_o[j])
        else:
            lambda_init = 0.8 - 0.6 * math.exp(-0.3 * i)
            t = diff_mixer(h, cos_d, sin_d, diff_w_in[j], diff_lambda[j], diff_subln[j],
                           diff_w_o[j], lambda_init)
        x = layer_norm(ALPHA * x + (1.0 + g1) * t, ln1_g[i], ln1_b[i])
        h = x * (1.0 + sc2) + sh2
        f = ec_moe(h, router_w[i], moe_w_in[i], moe_w_out[i])
        x = layer_norm(ALPHA * x + (1.0 + g2) * f, ln2_g[i], ln2_b[i])
    return x
```

```cpp
#include <hip/hip_runtime.h>
#include <cstdio>
#include <cstdint>

#ifndef MK_CUTS
#define MK_CUTS 1
#endif

#define LAS __attribute__((address_space(3)))
#define GAS __attribute__((address_space(1)))
typedef _Float16 f16;
typedef _Float16 h8 __attribute__((ext_vector_type(8)));
typedef _Float16 h4 __attribute__((ext_vector_type(4)));
typedef _Float16 h2 __attribute__((ext_vector_type(2)));
typedef short s16x4 __attribute__((ext_vector_type(4)));
typedef float f32x4 __attribute__((ext_vector_type(4)));
typedef float f32x2 __attribute__((ext_vector_type(2)));
typedef float f32x16 __attribute__((ext_vector_type(16)));
typedef unsigned u32x4 __attribute__((ext_vector_type(4)));
typedef unsigned u32x2 __attribute__((ext_vector_type(2)));

constexpr int NB = 4, SEQ = 4096, DM = 1024, T = NB * SEQ;
constexpr int NE = 16, FF = 2048, CAP = 512, EROWS = NB * CAP;
constexpr int MROWS = NE * EROWS;
constexpr float ALPHA = 1.4142135623730951f;
constexpr float LN_EPS = 1e-5f, LAT_EPS = 1e-6f;
constexpr float LAMBDA_INIT = 0.35550906759096926f;
constexpr int NWAVES = 8, NTHREADS = 512;

constexpr size_t MiB = 1u << 20;
constexpr size_t WS_CTL = 0, CTL_ZERO_BYTES = 1 * MiB;
constexpr size_t WS_MODS = 1 * MiB;
constexpr size_t WS_COSM = 2 * MiB, WS_SINM = 4 * MiB;
constexpr size_t WS_COSD = 6 * MiB, WS_SIND = 6 * MiB + 512 * 1024;
constexpr size_t WS_AFF = 7 * MiB;
constexpr size_t WS_GATE = 8 * MiB;
constexpr size_t WS_ROWTOK = 8 * MiB + 512 * 1024;
constexpr size_t WS_INV = 9 * MiB;
constexpr size_t WS_WIN0 = 16 * MiB;
constexpr size_t WS_WUQ = 18 * MiB;
constexpr size_t WS_WUKV = 20 * MiB;
constexpr size_t WS_WO0 = 22 * MiB;
constexpr size_t WS_WIN1 = 24 * MiB;
constexpr size_t WS_WO1 = 30 * MiB;
constexpr size_t WS_MOEIN = 32 * MiB;
constexpr size_t WS_MOEOUT = 288 * MiB;
constexpr size_t WS_HA = 416 * MiB;
constexpr size_t WS_HB = 448 * MiB;
constexpr size_t WS_LAT = 480 * MiB;
constexpr size_t WS_CQN = 528 * MiB;
constexpr size_t WS_CKVN = 540 * MiB;
constexpr size_t WS_Q = 548 * MiB;
constexpr size_t WS_K = 596 * MiB;
constexpr size_t WS_V = 644 * MiB;
constexpr size_t WS_O = 676 * MiB;
constexpr size_t WS_PRE = 708 * MiB;
constexpr size_t WS_X1 = 772 * MiB;
constexpr size_t WS_X2 = 836 * MiB;
constexpr size_t WS_XE = 900 * MiB;
constexpr size_t WS_ACT = 964 * MiB;
constexpr size_t WS_Y = 1092 * MiB;
constexpr size_t WS_QKV1 = 1156 * MiB;
constexpr size_t WS_OD = 1252 * MiB;
constexpr size_t WS_END = 1316 * MiB;
constexpr int CW_BAR = 4096;

constexpr int RING_BYTES = 131072;
constexpr int LDSCTL_OFF = RING_BYTES, MISC_OFF = LDSCTL_OFF + 320;
constexpr int LDS_BYTES = 147456;

#define LDS_WAIT() asm volatile("s_waitcnt lgkmcnt(0)" ::: "memory")
#define VM_WAIT() asm volatile("s_waitcnt vmcnt(0)" ::: "memory")

__device__ __forceinline__ float wave_sum(float v) {
#pragma unroll
    for (int o = 1; o < 64; o <<= 1) v += __shfl_xor(v, o);
    return v;
}

#define XB_TMO      128
#define XB_XCNT(j)  (256  + 64 * (j))
#define XB_XSUB(j)  (1280 + 64 * (j))
#define XB_XGEN(j)  (2304 + 64 * (j))
#define XB_TOP      3328
#define XB_TOPGEN   3392
#define XCD_BAR_WORDS 3456
#define XB_SPIN_CAP (1u << 20)
__device__ __forceinline__ unsigned xb_ld(unsigned* p)              { return __hip_atomic_load(p, __ATOMIC_RELAXED, __HIP_MEMORY_SCOPE_AGENT); }
__device__ __forceinline__ unsigned xb_add(unsigned* p, unsigned v) { return __hip_atomic_fetch_add(p, v, __ATOMIC_RELAXED, __HIP_MEMORY_SCOPE_AGENT); }
__device__ __forceinline__ unsigned xb_xcc_id() { return (unsigned)__builtin_amdgcn_s_getreg((3 << 11) | 20) & 0xFu; }
#define XB_SPIN(cond, bar) do { unsigned _sp = 0; while (cond) { __builtin_amdgcn_s_sleep(1); \
    if ((++_sp & 255u) == 0u) { if (xb_ld(&(bar)[XB_TMO])) break; if (_sp > XB_SPIN_CAP) { atomicAdd(&(bar)[XB_TMO], 1u); break; } } } } while (0)
struct XcdBarrier { unsigned* bar; unsigned x; volatile LAS unsigned* st; };
__device__ __forceinline__ XcdBarrier xcd_barrier_post(unsigned* bar, volatile LAS unsigned* st) {
    XcdBarrier b; b.bar = bar; b.x = xb_xcc_id(); b.st = st;
    if (threadIdx.x == 0) (void)xb_add(&bar[XB_XCNT(b.x)], 1u);
    return b;
}
__device__ __forceinline__ void xcd_barrier_complete(unsigned* bar, unsigned x, unsigned& nloc, unsigned& nx) {
    const unsigned G = gridDim.x * gridDim.y * gridDim.z;
    unsigned sum, cnt, mine, sp = 0u;
    for (;;) {
        sum = 0u; cnt = 0u; mine = 0u;
#pragma unroll
        for (unsigned j = 0; j < 16; ++j) { const unsigned c = xb_ld(&bar[XB_XCNT(j)]); sum += c; cnt += (c > 0u) ? 1u : 0u; mine = (j == x) ? c : mine; }
        if (sum == G) break;
        __builtin_amdgcn_s_sleep(1);
        if ((++sp & 255u) == 0u) { if (xb_ld(&bar[XB_TMO])) break; if (sp > XB_SPIN_CAP) { atomicAdd(&bar[XB_TMO], 1u); break; } }
    }
    nloc = mine > 0u ? mine : 1u; nx = cnt > 0u ? cnt : 1u;
}
__device__ __forceinline__ void xcd_barrier(const XcdBarrier& b) {
    asm volatile("s_waitcnt vmcnt(0)" ::: "memory");
    __syncthreads();
    if (threadIdx.x == 0) {
        unsigned* bar = b.bar;
        __builtin_amdgcn_s_waitcnt(0);
        unsigned nloc = b.st[0], nx = b.st[1];
        if (nloc == 0u) { xcd_barrier_complete(bar, b.x, nloc, nx); b.st[0] = nloc; b.st[1] = nx; }
        const unsigned old = xb_add(&bar[XB_XSUB(b.x)], 1u);
        const unsigned gen = old / nloc;
        if (old + 1u == (gen + 1u) * nloc) {
            __builtin_amdgcn_fence(__ATOMIC_RELEASE, "agent");
            asm volatile("s_waitcnt vmcnt(0)" ::: "memory");
            const unsigned og = xb_add(&bar[XB_TOP], 1u);
            const unsigned tg = og / nx;
            if (og + 1u == (tg + 1u) * nx) xb_add(&bar[XB_TOPGEN], 1u);
            else XB_SPIN(xb_ld(&bar[XB_TOPGEN]) == tg, bar);
            __builtin_amdgcn_fence(__ATOMIC_ACQUIRE, "agent");
            xb_add(&bar[XB_XGEN(b.x)], 1u);
            asm volatile("s_waitcnt vmcnt(0)" ::: "memory");
        } else {
            XB_SPIN(xb_ld(&bar[XB_XGEN(b.x)]) == gen, bar);
            __builtin_amdgcn_fence(__ATOMIC_ACQUIRE, "agent");
            asm volatile("s_waitcnt vmcnt(0)" ::: "memory");
        }
    }
    __syncthreads();
}

namespace pg8 {
constexpr int BM = 256, BK = 64, HALF = 128, HTB = HALF * BK * 2, STAGE_BYTES = 8 * HTB, NXCD = 8, WGM = 8;
__host__ __device__ __forceinline__ int lds_byte(int r, int c) { const int st = (r >> 4) * 2 + (c >> 5), rr = r & 15, cc = c & 31, ob = rr * 64 + cc * 2; return st * 1024 + (ob ^ (((ob >> 9) & 1) << 5)); }
__host__ __device__ __forceinline__ void stage_rc(int b, int& R, int& C) { const int st = b / 1024, sb = b % 1024, swz = sb ^ (((sb >> 9) & 1) << 5); R = (st >> 1) * 16 + swz / 64; C = (st & 1) * 32 + (swz % 64) / 2; }
__host__ __device__ __forceinline__ int perm32(int rho) { const int n = rho >> 4, i = rho & 15; return 8 * (i >> 2) + 4 * n + (i & 3); }
struct Unit { int pm, pn; };
struct Gemm { const f16* A; const f16* Bt; int M, N, K; int grp_tiles; size_t grp_stride; };
struct StaticOrder {
    int nM, nN, nwg, G, c;
    __host__ __device__ void init(int M, int N, int G_, int c_) { nM = M / BM; nN = N / BM; nwg = nM * nN; G = G_; c = c_; }
    __host__ __device__ bool next(int i, Unit& u) const {
        const long L = (long)i * G + c; if (L >= nwg) return false;
        int wgid = (int)L; { const int q = nwg / NXCD, r = nwg % NXCD, xcd = wgid % NXCD, off = wgid / NXCD; wgid = (xcd < r ? xcd * (q + 1) : r * (q + 1) + (xcd - r) * q) + off; }
        const int nig = WGM * nN, gid = wgid / nig, fm = gid * WGM, gsz = (nM - fm) < WGM ? (nM - fm) : WGM;
        u.pm = fm + ((wgid % nig) % gsz); u.pn = (wgid % nig) / gsz; return true;
    }
};
template <class Epi>
__device__ __forceinline__ void gemm_phase(LAS unsigned char* lds, const Gemm g, const StaticOrder& S, const Epi& E) {
    int tid = threadIdx.x; asm volatile("" : "+v"(tid));
    const int wid = __builtin_amdgcn_readfirstlane(tid >> 6), lane = tid & 63, wr = wid >> 2, wc = wid & 3, fr = lane & 15, fq = lane >> 4;
    const int K = g.K, nt = K / BK;
    unsigned voffA[2], voffB[2];
#pragma unroll
    for (int i = 0; i < 2; ++i) { int R, C; stage_rc(tid * 16 + i * 8192, R, C); const int Rb = Epi::PERM ? ((R & ~31) + perm32(R & 31)) : R;
        voffA[i] = (unsigned)(R * K + C) * 2u; voffB[i] = (unsigned)(Rb * K + C) * 2u; }
    const size_t kstep = (size_t)(BK * 2);
    const size_t hstep = (size_t)HALF * K * 2;
    const size_t tstep = 2 * hstep;
    const unsigned ldsw = (unsigned)wid * 1024u;
    const int aoff = lds_byte(wr * 64 + fr, fq * 8), boff = lds_byte(wc * 32 + fr, fq * 8);
#define PG8_SA(b, h) (((b) * 2 + (h)) * HTB)
#define PG8_SB(b, h) ((4 + (b) * 2 + (h)) * HTB)
#define PG8_STAGE(bufoff, gbase, voff) do { _Pragma("unroll") for (int _i = 0; _i < 2; ++_i) \
        __builtin_amdgcn_global_load_lds((const unsigned*)((const char*)(gbase) + (voff)[_i]), (LAS unsigned*)(lds + (bufoff) + ldsw + _i * 8192), 16, 0, 0); } while (0)
#define PG8_LDA(dst, b, h) do { _Pragma("unroll") for (int m = 0; m < 4; ++m) _Pragma("unroll") for (int k = 0; k < 2; ++k) dst[m][k] = *(const LAS h8*)(lds + PG8_SA(b, h) + aoff + m * 2048 + k * 1024); } while (0)
#define PG8_LDB(dst, b, h) do { _Pragma("unroll") for (int n = 0; n < 2; ++n) _Pragma("unroll") for (int k = 0; k < 2; ++k) dst[n][k] = *(const LAS h8*)(lds + PG8_SB(b, h) + boff + n * 2048 + k * 1024); } while (0)
#define PG8_MMA(ai, bj, At, Bt) do { __builtin_amdgcn_s_setprio(1); _Pragma("unroll") for (int m = 0; m < 4; ++m) _Pragma("unroll") for (int n = 0; n < 2; ++n) _Pragma("unroll") for (int k = 0; k < 2; ++k) \
        acc[ai][bj][m][n] = __builtin_amdgcn_mfma_f32_16x16x32_f16(Bt[n][k], At[m][k], acc[ai][bj][m][n], 0, 0, 0); __builtin_amdgcn_s_setprio(0); } while (0)
#define PG8_WAIT_V(n) asm volatile("s_waitcnt vmcnt(" #n ")" ::: "memory")
#define PG8_WAIT_L(n) asm volatile("s_waitcnt lgkmcnt(" #n ")" ::: "memory")
#define PG8_BAR __builtin_amdgcn_s_barrier()
#define PG8_SCHED __builtin_amdgcn_sched_barrier(0)
#define PG8_BBASE(u) ((const char*)g.Bt + ((size_t)((u).pm / g.grp_tiles) * g.grp_stride) * 2 + (size_t)(u).pn * tstep)
    Unit cur, nxt; int ui = 0;
    if (!S.next(0, cur)) return;
    f32x4 acc[2][2][4][2];
#pragma unroll
    for (int a = 0; a < 2; ++a)
#pragma unroll
        for (int b = 0; b < 2; ++b)
#pragma unroll
            for (int m = 0; m < 4; ++m)
#pragma unroll
                for (int n = 0; n < 2; ++n) acc[a][b][m][n] = (f32x4){0.f, 0.f, 0.f, 0.f};
    h8 At[4][2], B0[2][2], B1[2][2];
    const char* cA = (const char*)g.A + (size_t)cur.pm * tstep; const char* cB = PG8_BBASE(cur);
    PG8_STAGE(PG8_SB(0, 0), cB, voffB); PG8_STAGE(PG8_SA(0, 0), cA, voffA); PG8_STAGE(PG8_SB(0, 1), cB + hstep, voffB); PG8_STAGE(PG8_SA(0, 1), cA + hstep, voffA);
    if (wr == 1) PG8_BAR;
    PG8_WAIT_V(4); PG8_BAR;
    PG8_STAGE(PG8_SB(1, 0), cB + kstep, voffB); PG8_STAGE(PG8_SA(1, 0), cA + kstep, voffA); PG8_STAGE(PG8_SB(1, 1), cB + hstep + kstep, voffB);
    PG8_WAIT_V(6); PG8_BAR;
    for (;;) {
        const bool has_next = S.next(ui + 1, nxt);
        const char* nA = has_next ? (const char*)g.A + (size_t)nxt.pm * tstep : cA; const char* nB = has_next ? PG8_BBASE(nxt) : cB;
#pragma unroll 1
        for (int t = 0; t < nt; t += 2) {
            const bool last = (t == nt - 2);
            const char* a1 = cA + (size_t)(t + 1) * kstep;
            const char* a2 = last ? nA : cA + (size_t)(t + 2) * kstep; const char* b2 = last ? nB : cB + (size_t)(t + 2) * kstep;
            const char* a3 = a2 + kstep; const char* b3 = b2 + kstep;
            PG8_LDB(B0, 0, 0); PG8_SCHED; PG8_LDA(At, 0, 0); PG8_STAGE(PG8_SA(1, 1), a1 + hstep, voffA);
            PG8_WAIT_L(8); PG8_BAR; PG8_WAIT_L(0); PG8_MMA(0, 0, At, B0); PG8_BAR; PG8_SCHED;
            PG8_LDB(B1, 0, 1); PG8_STAGE(PG8_SB(0, 0), b2, voffB);
            PG8_BAR; PG8_WAIT_L(0); PG8_MMA(0, 1, At, B1); PG8_BAR;
            PG8_LDA(At, 0, 1); PG8_STAGE(PG8_SA(0, 0), a2, voffA);
            PG8_BAR; PG8_WAIT_L(0); PG8_MMA(1, 0, At, B0); PG8_BAR; PG8_SCHED;
            PG8_STAGE(PG8_SB(0, 1), b2 + hstep, voffB);
            PG8_WAIT_V(6); PG8_BAR; PG8_MMA(1, 1, At, B1); PG8_BAR;
            PG8_LDB(B0, 1, 0); PG8_SCHED; PG8_LDA(At, 1, 0); PG8_STAGE(PG8_SA(0, 1), a2 + hstep, voffA);
            PG8_WAIT_L(8); PG8_BAR; PG8_WAIT_L(0); PG8_MMA(0, 0, At, B0); PG8_BAR; PG8_SCHED;
            PG8_LDB(B1, 1, 1); PG8_STAGE(PG8_SB(1, 0), b3, voffB);
            PG8_BAR; PG8_WAIT_L(0); PG8_MMA(0, 1, At, B1); PG8_BAR;
            PG8_LDA(At, 1, 1); PG8_STAGE(PG8_SA(1, 0), a3, voffA);
            PG8_BAR; PG8_WAIT_L(0); PG8_MMA(1, 0, At, B0); PG8_BAR; PG8_SCHED;
            PG8_STAGE(PG8_SB(1, 1), b3 + hstep, voffB);
            PG8_WAIT_V(6); PG8_BAR; PG8_MMA(1, 1, At, B1); PG8_BAR;
        }
        E(acc, cur, wr, wc, fr, fq);
        if (!has_next) break;
#pragma unroll
        for (int a = 0; a < 2; ++a)
#pragma unroll
            for (int b = 0; b < 2; ++b)
#pragma unroll
                for (int m = 0; m < 4; ++m)
#pragma unroll
                    for (int n = 0; n < 2; ++n) acc[a][b][m][n] = (f32x4){0.f, 0.f, 0.f, 0.f};
        cur = nxt; cA = nA; cB = nB; ++ui;
    }
    PG8_WAIT_V(0);
    if (wr == 0) PG8_BAR;
    PG8_BAR;
#undef PG8_SA
#undef PG8_SB
#undef PG8_STAGE
#undef PG8_LDA
#undef PG8_LDB
#undef PG8_MMA
#undef PG8_WAIT_V
#undef PG8_WAIT_L
#undef PG8_BAR
#undef PG8_SCHED
#undef PG8_BBASE
}
}

#define EPI_ROW(u, ai, m) ((u).pm * 256 + (ai) * 128 + wr * 64 + (m) * 16 + fr)
__device__ __forceinline__ h8 pack8(f32x4 a, f32x4 b) { h8 o; o[0] = (f16)a[0]; o[1] = (f16)a[1]; o[2] = (f16)a[2]; o[3] = (f16)a[3]; o[4] = (f16)b[0]; o[5] = (f16)b[1]; o[6] = (f16)b[2]; o[7] = (f16)b[3]; return o; }
__device__ __forceinline__ void rope4(f32x4& v0, f32x4& v1, const f32x4 cs, const f32x4 sn) {
    const f32x4 a = v0, b = v1;
    v0[0] = a[0] * cs[0] - a[1] * sn[0]; v0[1] = a[1] * cs[0] + a[0] * sn[0];
    v0[2] = a[2] * cs[1] - a[3] * sn[1]; v0[3] = a[3] * cs[1] + a[2] * sn[1];
    v1[0] = b[0] * cs[2] - b[1] * sn[2]; v1[1] = b[1] * cs[2] + b[0] * sn[2];
    v1[2] = b[2] * cs[3] - b[3] * sn[3]; v1[3] = b[3] * cs[3] + b[2] * sn[3];
}
struct EpiLat {
    static constexpr bool PERM = false; float* out;
    __device__ __forceinline__ void operator()(const f32x4 (&acc)[2][2][4][2], const pg8::Unit& u, int wr, int wc, int fr, int fq) const {
#pragma unroll
        for (int ai = 0; ai < 2; ++ai)
#pragma unroll
            for (int m = 0; m < 4; ++m) { float* rowp = out + (size_t)EPI_ROW(u, ai, m) * 768 + u.pn * 256 + wc * 32 + 4 * fq;
#pragma unroll
                for (int bj = 0; bj < 2; ++bj)
#pragma unroll
                    for (int n = 0; n < 2; ++n) *(f32x4*)(rowp + bj * 128 + n * 16) = acc[ai][bj][m][n]; }
    }
};
struct EpiQNope {
    static constexpr bool PERM = true; f16* Q;
    __device__ __forceinline__ void operator()(const f32x4 (&acc)[2][2][4][2], const pg8::Unit& u, int wr, int wc, int fr, int fq) const {
#pragma unroll
        for (int ai = 0; ai < 2; ++ai)
#pragma unroll
            for (int m = 0; m < 4; ++m) { const int t = EPI_ROW(u, ai, m);
#pragma unroll
                for (int bj = 0; bj < 2; ++bj) { const int c8 = u.pn * 256 + bj * 128 + wc * 32 + 8 * fq;
                    *(h8*)(Q + (size_t)t * 1536 + (c8 >> 7) * 192 + (c8 & 127)) = pack8(acc[ai][bj][m][0], acc[ai][bj][m][1]); } }
    }
};
struct EpiQRope {
    static constexpr bool PERM = true; f16* Q; const float* cosm; const float* sinm;
    __device__ __forceinline__ void operator()(const f32x4 (&acc)[2][2][4][2], const pg8::Unit& u, int wr, int wc, int fr, int fq) const {
#pragma unroll
        for (int ai = 0; ai < 2; ++ai)
#pragma unroll
            for (int m = 0; m < 4; ++m) { const int t = EPI_ROW(u, ai, m);
#pragma unroll
                for (int bj = 0; bj < 2; ++bj) { const int cc = u.pn * 256 + bj * 128 + wc * 32 + 8 * fq; const int h = cc >> 6, jj = cc & 63, i0 = jj >> 1;
                    f32x4 v0 = acc[ai][bj][m][0], v1 = acc[ai][bj][m][1];
                    const f32x4 cs = *(const f32x4*)(cosm + (size_t)t * 32 + i0), sn = *(const f32x4*)(sinm + (size_t)t * 32 + i0); rope4(v0, v1, cs, sn);
                    *(h8*)(Q + (size_t)t * 1536 + h * 192 + 128 + jj) = pack8(v0, v1); }
                asm volatile("" ::: "memory"); }
    }
};
struct EpiKV {
    static constexpr bool PERM = true; f16* Kp; f16* Vp;
    __device__ __forceinline__ void operator()(const f32x4 (&acc)[2][2][4][2], const pg8::Unit& u, int wr, int wc, int fr, int fq) const {
#pragma unroll
        for (int ai = 0; ai < 2; ++ai)
#pragma unroll
            for (int m = 0; m < 4; ++m) { const int t = EPI_ROW(u, ai, m);
#pragma unroll
                for (int bj = 0; bj < 2; ++bj) { const int c8 = u.pn * 256 + bj * 128 + wc * 32 + 8 * fq; const int h = c8 >> 8, j = c8 & 255;
                    f16* dst = (j < 128) ? (Kp + (size_t)t * 1536 + h * 192 + j) : (Vp + (size_t)t * 1024 + h * 128 + (j - 128));
                    *(h8*)dst = pack8(acc[ai][bj][m][0], acc[ai][bj][m][1]); }
                asm volatile("" ::: "memory"); }
    }
};
struct EpiPre {
    static constexpr bool PERM = false; const float* xres; const float* gmod; float* pre;
    __device__ __forceinline__ void operator()(const f32x4 (&acc)[2][2][4][2], const pg8::Unit& u, int wr, int wc, int fr, int fq) const {
#pragma unroll
        for (int ai = 0; ai < 2; ++ai)
#pragma unroll
            for (int m = 0; m < 4; ++m) { const int t = EPI_ROW(u, ai, m); const int b = t >> 12;
#pragma unroll
                for (int bj = 0; bj < 2; ++bj)
#pragma unroll
                    for (int n = 0; n < 2; ++n) { const int c = u.pn * 256 + bj * 128 + wc * 32 + n * 16 + 4 * fq;
                        const f32x4 gv = *(const f32x4*)(gmod + b * 6144 + c), xv = *(const f32x4*)(xres + (size_t)t * 1024 + c);
                        *(f32x4*)(pre + (size_t)t * 1024 + c) = xv * ALPHA + (gv + 1.0f) * acc[ai][bj][m][n]; }
                asm volatile("" ::: "memory"); }
    }
};
struct EpiUp {
    static constexpr bool PERM = true; f16* act;
    __device__ __forceinline__ void operator()(const f32x4 (&acc)[2][2][4][2], const pg8::Unit& u, int wr, int wc, int fr, int fq) const {
#pragma unroll
        for (int ai = 0; ai < 2; ++ai)
#pragma unroll
            for (int m = 0; m < 4; ++m) { const int r = EPI_ROW(u, ai, m);
#pragma unroll
                for (int bj = 0; bj < 2; ++bj) { const int c8 = u.pn * 256 + bj * 128 + wc * 32 + 8 * fq;
                    const f32x4 gq = acc[ai][bj][m][0], uq = acc[ai][bj][m][1]; h4 o;
#pragma unroll
                    for (int i = 0; i < 4; ++i) { const float gg = gq[i]; o[i] = (f16)(gg * __builtin_amdgcn_rcpf(1.0f + __expf(-gg)) * uq[i]); }
                    *(h4*)(act + (size_t)r * 2048 + (c8 >> 1)) = o; } }
    }
};
struct EpiDown {
    static constexpr bool PERM = true; f16* y; const float* gate;
    __device__ __forceinline__ void operator()(const f32x4 (&acc)[2][2][4][2], const pg8::Unit& u, int wr, int wc, int fr, int fq) const {
#pragma unroll
        for (int ai = 0; ai < 2; ++ai)
#pragma unroll
            for (int m = 0; m < 4; ++m) { const int r = EPI_ROW(u, ai, m); const float gt = gate[r];
#pragma unroll
                for (int bj = 0; bj < 2; ++bj) { const int c8 = u.pn * 256 + bj * 128 + wc * 32 + 8 * fq;
                    *(h8*)(y + (size_t)r * 1024 + c8) = pack8(acc[ai][bj][m][0] * gt, acc[ai][bj][m][1] * gt); }
                asm volatile("" ::: "memory"); }
    }
};
struct EpiDiffIn {
    static constexpr bool PERM = true; f16* qkv; const float* cosd; const float* sind;
    __device__ __forceinline__ void operator()(const f32x4 (&acc)[2][2][4][2], const pg8::Unit& u, int wr, int wc, int fr, int fq) const {
#pragma unroll
        for (int ai = 0; ai < 2; ++ai)
#pragma unroll
            for (int m = 0; m < 4; ++m) { const int t = EPI_ROW(u, ai, m);
#pragma unroll
                for (int bj = 0; bj < 2; ++bj) { const int c8 = u.pn * 256 + bj * 128 + wc * 32 + 8 * fq;
                    f32x4 v0 = acc[ai][bj][m][0], v1 = acc[ai][bj][m][1];
                    if (c8 < 2048 && (c8 & 63) < 16) { const int i0 = (c8 & 15) >> 1; const f32x4 cs = *(const f32x4*)(cosd + (size_t)t * 8 + i0), sn = *(const f32x4*)(sind + (size_t)t * 8 + i0); rope4(v0, v1, cs, sn); }
                    *(h8*)(qkv + (size_t)t * 3072 + c8) = pack8(v0, v1); }
                asm volatile("" ::: "memory"); }
    }
};

namespace att {
constexpr int QBLK = 32, KVBLK = 64, DV = 128;
constexpr float THR = 8.f;
constexpr size_t SHM_V = KVBLK * DV * 2;
#define SBAR() __builtin_amdgcn_sched_barrier(0)
__device__ __forceinline__ int crow(int r, int hi) { return (r & 3) + 8 * (r >> 2) + 4 * hi; }
__device__ __forceinline__ unsigned cvtpk(float lo, float hi) { unsigned r; asm volatile("v_cvt_pk_f16_f32 %0, %1, %2" : "=v"(r) : "v"(lo), "v"(hi)); return r; }
template <int DQK> struct Cfg {
    static constexpr int ND0 = DQK / 16, KRB = DQK * 2, NKCH = DQK / 64, KCPR = DQK / 8;
    static constexpr size_t SHM_K = (size_t)KVBLK * KRB;
    static constexpr float SCALE = DQK == 192 ? 0.07216878364870322f : 0.125f;
    static constexpr size_t SHM_TOTAL = 2 * SHM_V + 2 * SHM_K + NWAVES * 64 * 4;
};
template <int DQK> __device__ __forceinline__ void partialSM(f32x16& p0, f32x16& p1, float& m_reg, float& mn, float& alpha) {
    constexpr float SCALE = Cfg<DQK>::SCALE, C = SCALE * 1.4426950408889634f;
    float pmax = p0[0];
#pragma unroll
    for (int r = 1; r < 16; ++r) pmax = fmaxf(pmax, p0[r]);
#pragma unroll
    for (int r = 0; r < 16; ++r) pmax = fmaxf(pmax, p1[r]);
    { auto rr = __builtin_amdgcn_permlane32_swap(__float_as_uint(pmax), __float_as_uint(pmax), false, false);
      pmax = fmaxf(__uint_as_float(rr[0]), __uint_as_float(rr[1])); }
    if (__builtin_expect(__all(pmax - m_reg <= THR / SCALE), 1)) { mn = m_reg; alpha = 1.f; }
    else { mn = fmaxf(m_reg, pmax); alpha = __builtin_amdgcn_exp2f((m_reg - mn) * C); m_reg = mn; }
    const float mnC = -mn * C;
#pragma unroll
    for (int r = 0; r < 16; ++r) p0[r] = fmaf(p0[r], C, mnC);
#pragma unroll
    for (int r = 0; r < 16; ++r) p1[r] = fmaf(p1[r], C, mnC);
#pragma unroll
    for (int r = 0; r < 16; ++r) p0[r] = __builtin_amdgcn_exp2f(p0[r]);
}
__device__ __forceinline__ void finishSM(f32x16& p0, f32x16& p1, float alpha, float& l_reg, h8& pa0, h8& pa1, h8& pa2, h8& pa3) {
#pragma unroll
    for (int r = 0; r < 16; ++r) p1[r] = __builtin_amdgcn_exp2f(p1[r]);
    float ps = 0;
#pragma unroll
    for (int r = 0; r < 16; ++r) ps += p0[r];
#pragma unroll
    for (int r = 0; r < 16; ++r) ps += p1[r];
    { auto rr = __builtin_amdgcn_permlane32_swap(__float_as_uint(ps), __float_as_uint(ps), false, false);
      ps = __uint_as_float(rr[0]) + __uint_as_float(rr[1]); }
    l_reg = l_reg * alpha + ps;
#define PK4(P, BASE, OUT) do { unsigned a0 = cvtpk(P[BASE + 0], P[BASE + 1]), a1 = cvtpk(P[BASE + 2], P[BASE + 3]);   \
    unsigned b0 = cvtpk(P[BASE + 4], P[BASE + 5]), b1 = cvtpk(P[BASE + 6], P[BASE + 7]);                              \
    auto r0 = __builtin_amdgcn_permlane32_swap(a0, b0, false, false); auto r1 = __builtin_amdgcn_permlane32_swap(a1, b1, false, false); \
    u32x4 w = {r0[0], r1[0], r0[1], r1[1]}; OUT = *reinterpret_cast<h8*>(&w); } while (0)
    PK4(p0, 0, pa0); PK4(p0, 8, pa1); PK4(p1, 0, pa2); PK4(p1, 8, pa3);
#undef PK4
}
#define KSWZ(row, colB) ((row) * KRB + ((colB) ^ (((row) & 7) << 4)))
template <int DQK> __device__ __forceinline__ void qkt(f32x16& p0, f32x16& p1, const char* Ks, const h8* qr, int r32, int hi) {
    constexpr int KRB = Cfg<DQK>::KRB;
    p0 = f32x16{}; p1 = f32x16{};
#pragma unroll
    for (int d0 = 0; d0 < Cfg<DQK>::ND0; ++d0) { const int cb = (d0 * 16 + hi * 8) * 2;
        const h8 b0 = *reinterpret_cast<const h8*>(Ks + KSWZ(r32, cb));
        const h8 b1 = *reinterpret_cast<const h8*>(Ks + KSWZ(32 + r32, cb));
        p0 = __builtin_amdgcn_mfma_f32_32x32x16_f16(b0, qr[d0], p0, 0, 0, 0);
        p1 = __builtin_amdgcn_mfma_f32_32x32x16_f16(b1, qr[d0], p1, 0, 0, 0); }
}
__device__ __forceinline__ int v_st(int k, int c) { const int kk = (k & ~0xC) | ((k & 4) << 1) | ((k & 8) >> 1); return ((kk >> 3) * 4 + (c >> 5)) * 512 + ((kk & 7) * 32 + (c & 31)) * 2; }
__device__ __forceinline__ int v_rd_base(int lane) { return ((lane & 3) << 3) | (((lane >> 2) & 3) << 6) | (((lane >> 4) & 1) << 5) | (((lane >> 5) & 1) << 8); }
constexpr int v_rd_off(int d0, int ks, int half) { return d0 * 512 + ks * 4096 + half * 2048; }
template <int OFF> __device__ __forceinline__ s16x4 tr_read(int vb) {
    s16x4 r; asm volatile("ds_read_b64_tr_b16 %0, %1 offset:%2" : "=&v"(r) : "v"(vb), "i"(OFF) : "memory"); return r;
}
template <int D0> __device__ __forceinline__ void pv_one(f32x16& od, int vb, h8 pa0, h8 pa1, h8 pa2, h8 pa3) {
    const s16x4 l0 = tr_read<v_rd_off(D0, 0, 0)>(vb), h0 = tr_read<v_rd_off(D0, 0, 1)>(vb), l1 = tr_read<v_rd_off(D0, 1, 0)>(vb), h1 = tr_read<v_rd_off(D0, 1, 1)>(vb);
    const s16x4 l2 = tr_read<v_rd_off(D0, 2, 0)>(vb), h2_ = tr_read<v_rd_off(D0, 2, 1)>(vb), l3 = tr_read<v_rd_off(D0, 3, 0)>(vb), h3 = tr_read<v_rd_off(D0, 3, 1)>(vb);
    asm volatile("s_waitcnt lgkmcnt(0)" ::: "memory"); SBAR();
#define PKV(L, H) __builtin_bit_cast(h8, (__attribute__((ext_vector_type(8))) short){L[0], L[1], L[2], L[3], H[0], H[1], H[2], H[3]})
    od = __builtin_amdgcn_mfma_f32_32x32x16_f16(pa0, PKV(l0, h0), od, 0, 0, 0);
    od = __builtin_amdgcn_mfma_f32_32x32x16_f16(pa1, PKV(l1, h1), od, 0, 0, 0);
    od = __builtin_amdgcn_mfma_f32_32x32x16_f16(pa2, PKV(l2, h2_), od, 0, 0, 0);
    od = __builtin_amdgcn_mfma_f32_32x32x16_f16(pa3, PKV(l3, h3), od, 0, 0, 0);
#undef PKV
}
__device__ __forceinline__ void pv_d0(f32x16* o, int vb, h8 pa0, h8 pa1, h8 pa2, h8 pa3) {
    pv_one<0>(o[0], vb, pa0, pa1, pa2, pa3); pv_one<1>(o[1], vb, pa0, pa1, pa2, pa3); pv_one<2>(o[2], vb, pa0, pa1, pa2, pa3); pv_one<3>(o[3], vb, pa0, pa1, pa2, pa3);
}
template <int DQK, int LDQ, int LDK, int LDV, int LDO, int SDEPTH>
__device__ __forceinline__ void attn_body(const f16* Qb, const f16* Kh, const f16* Vh, f16* Ob, char* lds) {
    using C = Cfg<DQK>;
    constexpr int KRB = C::KRB, ND0 = C::ND0, NKCH = C::NKCH, KCPR = C::KCPR; constexpr size_t SHM_K = C::SHM_K;
    constexpr int seq = SEQ;
    int tid = threadIdx.x; asm volatile("" : "+v"(tid));
    const int wid = tid >> 6, lane = tid & 63, r32 = lane & 31, hi = lane >> 5;
    char* V_lds = lds; char* K_lds = lds + 2 * SHM_V;
    float* wsl = (float*)(lds + 2 * SHM_V + 2 * SHM_K) + wid * 64; float* li_l = wsl; float* al_l = wsl + 32;
    float m_reg = -1e30f, l_reg = 0; f32x16 o[4] = {}; h8 qr[ND0];
    const f16* Qw = Qb + (long)(wid * QBLK + r32) * LDQ + hi * 8;
#pragma unroll
    for (int d0 = 0; d0 < ND0; ++d0) qr[d0] = *reinterpret_cast<const h8*>(Qw + d0 * 16);
    const int sr = tid >> 4, sc = (tid & 15) * 8, vst0 = v_st(sr, sc), vst1 = v_st(32 + sr, sc);
    int krow[NKCH], kcb[NKCH];
#pragma unroll
    for (int i = 0; i < NKCH; ++i) { const int c = tid + i * 512; krow[i] = c / KCPR; kcb[i] = (c % KCPR) * 16; }
    const int vb0 = (int)(uintptr_t)V_lds + v_rd_base(lane);
    struct { h8 vs0, vs1; h8 ks[NKCH]; } sr_[SDEPTH];
#define SLOAD(i, k0) do { sr_[i].vs0 = *reinterpret_cast<const h8*>(&Vh[(long)((k0) + sr) * LDV + sc]); sr_[i].vs1 = *reinterpret_cast<const h8*>(&Vh[(long)((k0) + 32 + sr) * LDV + sc]); \
    _Pragma("unroll") for (int _c = 0; _c < NKCH; ++_c) sr_[i].ks[_c] = *reinterpret_cast<const h8*>((const char*)Kh + (long)((k0) + krow[_c]) * (LDK * 2) + kcb[_c]); } while (0)
#define SWRITE(b, i) do { *(h8*)(V_lds + (b) * SHM_V + vst0) = sr_[i].vs0; *(h8*)(V_lds + (b) * SHM_V + vst1) = sr_[i].vs1; \
    _Pragma("unroll") for (int _c = 0; _c < NKCH; ++_c) *(h8*)(K_lds + (b) * SHM_K + KSWZ(krow[_c], kcb[_c])) = sr_[i].ks[_c]; } while (0)
#define SWAIT() do { if constexpr (SDEPTH == 2) { if constexpr (NKCH == 3) asm volatile("s_waitcnt vmcnt(5)" ::: "memory"); else asm volatile("s_waitcnt vmcnt(3)" ::: "memory"); } \
    else asm volatile("s_waitcnt vmcnt(0)" ::: "memory"); } while (0)
#define RESC(a) do { if (__any((a) < 1.f)) { if (hi == 0) al_l[r32] = (a); asm volatile("s_waitcnt lgkmcnt(0)" ::: "memory"); \
    _Pragma("unroll") for (int d = 0; d < 4; ++d) _Pragma("unroll") for (int r = 0; r < 16; ++r) o[d][r] *= al_l[crow(r, hi)]; } } while (0)
    f32x16 pA0, pA1, pB0, pB1; float mnA, mnB, alA, alB; h8 pa0, pa1, pa2, pa3; constexpr int NT = seq / KVBLK;
    constexpr int SE = 0, SO = SDEPTH - 1;
    SLOAD(SE, 0); asm volatile("s_waitcnt vmcnt(0)" ::: "memory"); SWRITE(0, SE); __syncthreads();
    qkt<DQK>(pA0, pA1, K_lds, qr, r32, hi); partialSM<DQK>(pA0, pA1, m_reg, mnA, alA);
    SLOAD(SO, KVBLK); if constexpr (SDEPTH == 2) { if (2 < NT) SLOAD(SE, 2 * KVBLK); }
    SWAIT(); SWRITE(1, SO); __syncthreads();
    for (int j = 1; j + 1 < NT; j += 2) {
        SBAR(); qkt<DQK>(pB0, pB1, K_lds + SHM_K, qr, r32, hi);
        finishSM(pA0, pA1, alA, l_reg, pa0, pa1, pa2, pa3); SBAR();
        SLOAD(SO, (j + SDEPTH) * KVBLK); SBAR();
        pv_d0(o, vb0, pa0, pa1, pa2, pa3); partialSM<DQK>(pB0, pB1, m_reg, mnB, alB);
        __syncthreads(); SWAIT(); SWRITE(0, SE);
        RESC(alB); __syncthreads();
        SBAR(); qkt<DQK>(pA0, pA1, K_lds, qr, r32, hi);
        finishSM(pB0, pB1, alB, l_reg, pa0, pa1, pa2, pa3); SBAR();
        if (SDEPTH == 1 || j + 3 < NT) SLOAD(SE, (j + 1 + SDEPTH) * KVBLK); SBAR();
        pv_d0(o, vb0 + (int)SHM_V, pa0, pa1, pa2, pa3); partialSM<DQK>(pA0, pA1, m_reg, mnA, alA);
        __syncthreads(); SWAIT(); SWRITE(1, SO);
        RESC(alA); __syncthreads();
    }
    SBAR(); qkt<DQK>(pB0, pB1, K_lds + SHM_K, qr, r32, hi);
    finishSM(pA0, pA1, alA, l_reg, pa0, pa1, pa2, pa3); SBAR();
    pv_d0(o, vb0, pa0, pa1, pa2, pa3); partialSM<DQK>(pB0, pB1, m_reg, mnB, alB);
    __syncthreads(); RESC(alB);
    finishSM(pB0, pB1, alB, l_reg, pa0, pa1, pa2, pa3); SBAR();
    pv_d0(o, vb0 + (int)SHM_V, pa0, pa1, pa2, pa3);
    if (hi == 0) li_l[r32] = l_reg; asm volatile("s_waitcnt lgkmcnt(0)" ::: "memory");
    float rli[16];
#pragma unroll
    for (int r = 0; r < 16; ++r) rli[r] = __builtin_amdgcn_rcpf(li_l[crow(r, hi)]);
    f16* Ow = Ob + (long)(wid * QBLK) * LDO;
#pragma unroll
    for (int r = 0; r < 16; ++r) { const int orow = crow(r, hi);
#pragma unroll
        for (int d0 = 0; d0 < 4; ++d0) Ow[(long)orow * LDO + d0 * 32 + r32] = (f16)(o[d0][r] * rli[r]); }
    asm volatile("s_waitcnt vmcnt(0) lgkmcnt(0)" ::: "memory");
    __syncthreads();
#undef SLOAD
#undef SWRITE
#undef SWAIT
#undef RESC
}

template <int DQK, int LDQ, int LDK, int LDV, int LDO>
__device__ __forceinline__ void attn_body_simple(const f16* Qb, const f16* Kh, const f16* Vh, f16* Ob, char* lds) {
    using C = Cfg<DQK>;
    constexpr int KRB = C::KRB, ND0 = C::ND0, NKCH = C::NKCH, KCPR = C::KCPR; constexpr size_t SHM_K = C::SHM_K;
    int tid = threadIdx.x; asm volatile("" : "+v"(tid));
    const int wid = tid >> 6, lane = tid & 63, r32 = lane & 31, hi = lane >> 5;
    char* V_lds = lds; char* K_lds = lds + 2 * SHM_V;
    float* wsl = (float*)(lds + 2 * SHM_V + 2 * SHM_K) + wid * 64; float* li_l = wsl; float* al_l = wsl + 32;
    float m_reg = -1e30f, l_reg = 0; f32x16 o[4] = {}; h8 qr[ND0];
    const f16* Qw = Qb + (long)(wid * QBLK + r32) * LDQ + hi * 8;
#pragma unroll
    for (int d0 = 0; d0 < ND0; ++d0) qr[d0] = *reinterpret_cast<const h8*>(Qw + d0 * 16);
    const int sr = tid >> 4, sc = (tid & 15) * 8, vst0 = v_st(sr, sc), vst1 = v_st(32 + sr, sc);
    int krow[NKCH], kcb[NKCH];
#pragma unroll
    for (int i = 0; i < NKCH; ++i) { const int c = tid + i * 512; krow[i] = c / KCPR; kcb[i] = (c % KCPR) * 16; }
    const int vb0 = (int)(uintptr_t)V_lds + v_rd_base(lane);
    h8 vs0, vs1, ks[NKCH];
#define SLOAD1(k0) do { vs0 = *reinterpret_cast<const h8*>(&Vh[(long)((k0) + sr) * LDV + sc]); vs1 = *reinterpret_cast<const h8*>(&Vh[(long)((k0) + 32 + sr) * LDV + sc]); \
    _Pragma("unroll") for (int _c = 0; _c < NKCH; ++_c) ks[_c] = *reinterpret_cast<const h8*>((const char*)Kh + (long)((k0) + krow[_c]) * (LDK * 2) + kcb[_c]); } while (0)
#define SWRITE1(b) do { *(h8*)(V_lds + (b) * SHM_V + vst0) = vs0; *(h8*)(V_lds + (b) * SHM_V + vst1) = vs1; \
    _Pragma("unroll") for (int _c = 0; _c < NKCH; ++_c) *(h8*)(K_lds + (b) * SHM_K + KSWZ(krow[_c], kcb[_c])) = ks[_c]; } while (0)
    constexpr int NT = SEQ / KVBLK;
    SLOAD1(0); asm volatile("s_waitcnt vmcnt(0)" ::: "memory"); SWRITE1(0); __syncthreads();
#pragma unroll 1
    for (int j = 0; j < NT; ++j) {
        const int cb = j & 1;
        if (j + 1 < NT) SLOAD1((j + 1) * KVBLK);
        SBAR();
        f32x16 p0, p1; float mn, al; h8 pa0, pa1, pa2, pa3;
        qkt<DQK>(p0, p1, K_lds + cb * SHM_K, qr, r32, hi);
        partialSM<DQK>(p0, p1, m_reg, mn, al);
        if (__any(al < 1.f)) { if (hi == 0) al_l[r32] = al; asm volatile("s_waitcnt lgkmcnt(0)" ::: "memory");
#pragma unroll
            for (int d = 0; d < 4; ++d)
#pragma unroll
                for (int r = 0; r < 16; ++r) o[d][r] *= al_l[crow(r, hi)]; }
        finishSM(p0, p1, al, l_reg, pa0, pa1, pa2, pa3); SBAR();
        pv_d0(o, vb0 + cb * (int)SHM_V, pa0, pa1, pa2, pa3);
        if (j + 1 < NT) { SWRITE1(cb ^ 1); }
        __syncthreads();
    }
    if (hi == 0) li_l[r32] = l_reg; asm volatile("s_waitcnt lgkmcnt(0)" ::: "memory");
    float rli[16];
#pragma unroll
    for (int r = 0; r < 16; ++r) rli[r] = __builtin_amdgcn_rcpf(li_l[crow(r, hi)]);
    f16* Ow = Ob + (long)(wid * QBLK) * LDO;
#pragma unroll
    for (int r = 0; r < 16; ++r) { const int orow = crow(r, hi);
#pragma unroll
        for (int d0 = 0; d0 < 4; ++d0) Ow[(long)orow * LDO + d0 * 32 + r32] = (f16)(o[d0][r] * rli[r]); }
    asm volatile("s_waitcnt vmcnt(0) lgkmcnt(0)" ::: "memory");
    __syncthreads();
#undef SLOAD1
#undef SWRITE1
}
#undef KSWZ
#undef SBAR
}

struct Args { const void* in[22]; float* out; unsigned char* ws; int ph_lo, ph_hi, li, pad; };
typedef const __attribute__((address_space(4))) Args* KArgs;
__device__ __forceinline__ KArgs kargs() { KArgs p = (KArgs)__builtin_amdgcn_kernarg_segment_ptr(); asm volatile("" : "+s"(p)); return p; }
struct Frame {
    LAS unsigned char* lds; char* ldsg;
    int tid, lane, wave, vcu, G;
    unsigned char* ws;
};
extern __shared__ __attribute__((aligned(16))) unsigned char g_lds[];
__device__ __forceinline__ Frame mkframe(KArgs a) {
    Frame F; int t = threadIdx.x; asm volatile("" : "+v"(t));
    F.lds = (LAS unsigned char*)g_lds; F.ldsg = (char*)g_lds;
    F.tid = t; F.lane = t & 63; F.wave = __builtin_amdgcn_readfirstlane(t >> 6);
    int g = gridDim.x, bx = blockIdx.x; asm volatile("" : "+s"(g), "+s"(bx));
    F.G = g; F.vcu = (g % 8 == 0) ? (bx % 8) * (g / 8) + bx / 8 : bx;
    F.ws = a->ws;
    return F;
}

__device__ __forceinline__ void sincos_d(double a, float& s, float& c) {
    const double k = __builtin_rint(a * 0.63661977236758134308);
    double r = __builtin_fma(-k, 1.57079632679489655800e+00, a); r = __builtin_fma(-k, 6.12323399573676603587e-17, r);
    const double r2 = r * r;
    double sp = -7.6471637318198164759e-13;
    sp = __builtin_fma(sp, r2, 1.6059043836821614599e-10);
    sp = __builtin_fma(sp, r2, -2.5052108385441718775e-08);
    sp = __builtin_fma(sp, r2, 2.7557319223985890653e-06);
    sp = __builtin_fma(sp, r2, -1.9841269841269841270e-04);
    sp = __builtin_fma(sp, r2, 8.3333333333333333333e-03);
    sp = __builtin_fma(sp, r2, -1.6666666666666666667e-01);
    const double sr = __builtin_fma(sp * r2, r, r);
    double cp = 4.7794773323873852974e-14;
    cp = __builtin_fma(cp, r2, -1.1470745597729724714e-11);
    cp = __builtin_fma(cp, r2, 2.0876756987868098979e-09);
    cp = __builtin_fma(cp, r2, -2.7557319223985890653e-07);
    cp = __builtin_fma(cp, r2, 2.4801587301587301587e-05);
    cp = __builtin_fma(cp, r2, -1.3888888888888888889e-03);
    cp = __builtin_fma(cp, r2, 4.1666666666666666667e-02);
    cp = __builtin_fma(cp, r2, -0.5);
    const double cr = __builtin_fma(cp, r2, 1.0);
    const int q = (int)((long long)k & 3);
    const double ss = (q & 1) ? cr : sr, cc = (q & 1) ? sr : cr;
    s = (float)((q & 2) ? -ss : ss); c = (float)(((q + 1) & 2) ? -cc : cc);
}
__device__ const double INV_M[32] = {
    1.0, 0.7498942093324559, 0.5623413251903491, 0.4216965034285822, 0.31622776601683794, 0.23713737056616552, 0.1778279410038923, 0.1333521432163324,
    0.1, 0.07498942093324558, 0.05623413251903491, 0.04216965034285822, 0.03162277660168379, 0.023713737056616554, 0.01778279410038923, 0.01333521432163324,
    0.01, 0.007498942093324559, 0.005623413251903491, 0.004216965034285822, 0.0031622776601683794, 0.0023713737056616554, 0.001778279410038923, 0.001333521432163324,
    0.001, 0.0007498942093324559, 0.0005623413251903491, 0.0004216965034285822, 0.00031622776601683794, 0.00023713737056616554, 0.0001778279410038923, 0.0001333521432163324 };
__device__ const double INV_D[8] = { 1.0, 0.19392274474868576, 0.03760603093086393, 0.007292664737217109, 0.001414213562373095, 0.0002742481756762073, 5.318295896944988e-05, 1.031338537721246e-05 };

template <class FN>
__device__ __forceinline__ void tr_item(const float* W, int Nsrc, int K, f16* WT, FN srccol, LAS float* scr, int kb, int nb, int lane) {
    const int k0 = 64 * kb, n0 = 32 * nb;
    const int scol = srccol(n0 + (lane & 31));
#pragma unroll 8
    for (int i = 0; i < 32; ++i) { const int kk = 2 * i + (lane >> 5); scr[kk * 33 + (lane & 31)] = scol >= 0 ? W[(size_t)(k0 + kk) * Nsrc + scol] : 0.f; }
    LDS_WAIT(); asm volatile("" ::: "memory");
    const int c = lane & 7;
#pragma unroll
    for (int j = 0; j < 4; ++j) { const int n = (lane >> 3) + 8 * j; const LAS float* s = scr + (8 * c) * 33 + n;
        h8 o; o[0] = (f16)s[0 * 33]; o[1] = (f16)s[1 * 33]; o[2] = (f16)s[2 * 33]; o[3] = (f16)s[3 * 33]; o[4] = (f16)s[4 * 33]; o[5] = (f16)s[5 * 33]; o[6] = (f16)s[6 * 33]; o[7] = (f16)s[7 * 33];
        *(h8*)(WT + (size_t)(n0 + n) * K + k0 + 8 * c) = o; }
    LDS_WAIT(); asm volatile("" ::: "memory");
}
struct ColId { __device__ __forceinline__ int operator()(int n) const { return n; } };
struct ColPad704 { __device__ __forceinline__ int operator()(int n) const { return n < 704 ? n : -1; } };
struct ColUq { __device__ __forceinline__ int operator()(int n) const { if (n < 1024) return (n >> 7) * 192 + (n & 127); const int cc = n - 1024, h = cc >> 6, jj = cc & 63; return h * 192 + 128 + (jj >> 1) + 32 * (jj & 1); } };
struct ColDiff { __device__ __forceinline__ int operator()(int n) const { if (n >= 2048) return n; const int off = n & 63; if (off >= 16) return n; return (n & ~63) + (off >> 1) + 8 * (off & 1); } };
struct ColMoeIn { __device__ __forceinline__ int operator()(int n) const { const int w = n & 7, f = (n >> 3) * 4 + (w & 3); return (w < 4) ? f : 2048 + f; } };

__device__ __forceinline__ void p0_prologue() {
    const KArgs a = kargs(); const Frame F = mkframe(a);
    const int tid = F.tid, lane = F.lane;
    {
        const float* cin = (const float*)a->in[1]; const float* ada_w = (const float*)a->in[3]; const float* ada_b = (const float*)a->in[4];
        float* mods = (float*)(F.ws + WS_MODS);
        LAS float* sc = (LAS float*)F.lds; LAS float* red = (LAS float*)(F.lds + 16384);
        for (int i = tid; i < 4096; i += NTHREADS) { const float v = cin[i]; sc[i] = v / (1.0f + __expf(-v)); }
        __syncthreads();
        for (int cb = blockIdx.x; cb < 256; cb += F.G) {
            const int f0 = cb * 48, l = f0 / 6144, e0 = f0 % 6144; const int g = tid / 48, cc = tid % 48;
            if (g < 10) { float a0 = 0.f, a1 = 0.f, a2 = 0.f, a3 = 0.f; const float* wp = ada_w + (size_t)l * 1024 * 6144 + e0 + cc;
#pragma unroll 4
                for (int d = g; d < 1024; d += 10) { const float w = wp[(size_t)d * 6144]; a0 += sc[d] * w; a1 += sc[1024 + d] * w; a2 += sc[2048 + d] * w; a3 += sc[3072 + d] * w; }
                LAS float* rp = red + (g * 48 + cc) * 4; rp[0] = a0; rp[1] = a1; rp[2] = a2; rp[3] = a3; }
            __syncthreads();
            if (tid < 192) { const int c2 = tid % 48, b = tid / 48; float s = 0.f;
#pragma unroll
                for (int gg = 0; gg < 10; ++gg) s += red[(gg * 48 + c2) * 4 + b];
                mods[(size_t)(l * 4 + b) * 6144 + e0 + c2] = s + ada_b[l * 6144 + e0 + c2]; }
            __syncthreads();
        }
    }
    {
        const int* pos = (const int*)a->in[2];
        float* cosm = (float*)(F.ws + WS_COSM); float* sinm = (float*)(F.ws + WS_SINM); float* cosd = (float*)(F.ws + WS_COSD); float* sind = (float*)(F.ws + WS_SIND);
        for (int i = blockIdx.x * NTHREADS + tid; i < T * 40; i += F.G * NTHREADS) {
            const int t = i / 40, j = i % 40; const double p = (double)pos[t]; float s, c;
            if (j < 32) { sincos_d(p * INV_M[j], s, c); cosm[(size_t)t * 32 + j] = c; sinm[(size_t)t * 32 + j] = s; }
            else { sincos_d(p * INV_D[j - 32], s, c); cosd[(size_t)t * 8 + (j - 32)] = c; sind[(size_t)t * 8 + (j - 32)] = s; }
        }
    }
    {
        LAS float* scr = (LAS float*)(F.lds + 32768 + F.wave * 8704);
        const int gw = F.vcu * NWAVES + F.wave, NGW = F.G * NWAVES;
        constexpr int I0 = 16 * 24, I1 = 6 * 48, I2 = 4 * 64, I3 = 16 * 32, I4 = 16 * 96, I5 = 16 * 32;
        constexpr int ISM = I0 + I1 + I2 + I3 + I4 + I5;
        constexpr int IMI = 16 * 128, IMO = 32 * 32;
        constexpr int NITEMS = ISM + 32 * IMI + 32 * IMO;
        for (int it = gw; it < NITEMS; it += NGW) {
            int r = it;
            if (r < I0) { tr_item((const float*)a->in[9], 704, 1024, (f16*)(F.ws + WS_WIN0), ColPad704(), scr, r / 24, r % 24, lane); continue; } r -= I0;
            if (r < I1) { tr_item((const float*)a->in[12], 1536, 384, (f16*)(F.ws + WS_WUQ), ColUq(), scr, r / 48, r % 48, lane); continue; } r -= I1;
            if (r < I2) { tr_item((const float*)a->in[13], 2048, 256, (f16*)(F.ws + WS_WUKV), ColId(), scr, r / 64, r % 64, lane); continue; } r -= I2;
            if (r < I3) { tr_item((const float*)a->in[14], 1024, 1024, (f16*)(F.ws + WS_WO0), ColId(), scr, r / 32, r % 32, lane); continue; } r -= I3;
            if (r < I4) { tr_item((const float*)a->in[15], 3072, 1024, (f16*)(F.ws + WS_WIN1), ColDiff(), scr, r / 96, r % 96, lane); continue; } r -= I4;
            if (r < I5) { tr_item((const float*)a->in[18], 1024, 1024, (f16*)(F.ws + WS_WO1), ColId(), scr, r / 32, r % 32, lane); continue; } r -= I5;
            if (r < 32 * IMI) { const int mat = r / IMI, rr = r % IMI;
                tr_item((const float*)a->in[20] + (size_t)mat * 1024 * 4096, 4096, 1024, (f16*)(F.ws + WS_MOEIN) + (size_t)mat * 4096 * 1024, ColMoeIn(), scr, rr / 128, rr % 128, lane); continue; }
            r -= 32 * IMI;
            { const int mat = r / IMO, rr = r % IMO;
                tr_item((const float*)a->in[21] + (size_t)mat * 2048 * 1024, 1024, 2048, (f16*)(F.ws + WS_MOEOUT) + (size_t)mat * 1024 * 2048, ColId(), scr, rr / 32, rr % 32, lane); }
        }
    }
}

__device__ __forceinline__ void mod_rows_p1() {
    const KArgs a = kargs(); const Frame F = mkframe(a);
    const float* x = (const float*)a->in[0]; const float* mods_l = (const float*)(F.ws + WS_MODS); const int sh_off = 0, sc_off = 1024; f16* out = (f16*)(F.ws + WS_HA);
    const int gw = F.vcu * NWAVES + F.wave, NGW = F.G * NWAVES, lane = F.lane;
    for (int m = gw; m < T; m += NGW) { const int b = m >> 12; const float* mb = mods_l + b * 6144;
#pragma unroll
        for (int j = 0; j < 4; ++j) { const int c = 4 * lane + 256 * j;
            const f32x4 v = *(const f32x4*)(x + (size_t)m * DM + c), sh = *(const f32x4*)(mb + sh_off + c), sc = *(const f32x4*)(mb + sc_off + c);
            const f32x4 h = v * (sc + 1.0f) + sh; h4 o; o[0] = (f16)h[0]; o[1] = (f16)h[1]; o[2] = (f16)h[2]; o[3] = (f16)h[3];
            *(h4*)(out + (size_t)m * DM + c) = o; } }
}

__device__ __forceinline__ void latent_prep() {
    const KArgs a = kargs(); const Frame F = mkframe(a);
    const float* lat = (const float*)(F.ws + WS_LAT); const float* qn = (const float*)a->in[10]; const float* kvn = (const float*)a->in[11];
    f16* cqn = (f16*)(F.ws + WS_CQN); f16* ckvn = (f16*)(F.ws + WS_CKVN); f16* Kp = (f16*)(F.ws + WS_K);
    const float* cosm = (const float*)(F.ws + WS_COSM); const float* sinm = (const float*)(F.ws + WS_SINM);
    const int gw = F.vcu * NWAVES + F.wave, NGW = F.G * NWAVES, lane = F.lane;
    for (int m = gw; m < T; m += NGW) { const float* row = lat + (size_t)m * 768;
        const f32x4 q0 = *(const f32x4*)(row + 4 * lane); f32x4 q1 = (f32x4){0.f, 0.f, 0.f, 0.f}; if (lane < 32) q1 = *(const f32x4*)(row + 256 + 4 * lane);
        const f32x4 kv = *(const f32x4*)(row + 384 + 4 * lane);
        float sq = (q0[0] * q0[0] + q0[1] * q0[1]) + (q0[2] * q0[2] + q0[3] * q0[3]) + (q1[0] * q1[0] + q1[1] * q1[1]) + (q1[2] * q1[2] + q1[3] * q1[3]);
        float sk = (kv[0] * kv[0] + kv[1] * kv[1]) + (kv[2] * kv[2] + kv[3] * kv[3]);
        sq = wave_sum(sq); sk = wave_sum(sk);
        const float rq = 1.0f / sqrtf(sq * (1.0f / 384.0f) + LAT_EPS), rk = 1.0f / sqrtf(sk * (1.0f / 256.0f) + LAT_EPS);
        { const f32x4 g = *(const f32x4*)(qn + 4 * lane); h4 o; o[0] = (f16)(q0[0] * rq * g[0]); o[1] = (f16)(q0[1] * rq * g[1]); o[2] = (f16)(q0[2] * rq * g[2]); o[3] = (f16)(q0[3] * rq * g[3]);
          *(h4*)(cqn + (size_t)m * 384 + 4 * lane) = o; }
        if (lane < 32) { const f32x4 g = *(const f32x4*)(qn + 256 + 4 * lane); h4 o; o[0] = (f16)(q1[0] * rq * g[0]); o[1] = (f16)(q1[1] * rq * g[1]); o[2] = (f16)(q1[2] * rq * g[2]); o[3] = (f16)(q1[3] * rq * g[3]);
          *(h4*)(cqn + (size_t)m * 384 + 256 + 4 * lane) = o; }
        { const f32x4 g = *(const f32x4*)(kvn + 4 * lane); h4 o; o[0] = (f16)(kv[0] * rk * g[0]); o[1] = (f16)(kv[1] * rk * g[1]); o[2] = (f16)(kv[2] * rk * g[2]); o[3] = (f16)(kv[3] * rk * g[3]);
          *(h4*)(ckvn + (size_t)m * 256 + 4 * lane) = o; }
        if (lane < 32) { const float x1 = row[640 + lane], x2 = row[672 + lane], cs = cosm[(size_t)m * 32 + lane], sn = sinm[(size_t)m * 32 + lane];
            h2 o; o[0] = (f16)(x1 * cs - x2 * sn); o[1] = (f16)(x2 * cs + x1 * sn);
#pragma unroll
            for (int h = 0; h < 8; ++h) *(h2*)(Kp + (size_t)m * 1536 + h * 192 + 128 + 2 * lane) = o; }
    }
}

__device__ __forceinline__ void ln_router(int l) {
    const KArgs a = kargs(); const Frame F = mkframe(a);
    const float* lng = (const float*)a->in[5] + l * DM; const float* lnb = (const float*)a->in[6] + l * DM; const float* router_w = (const float*)a->in[19] + (size_t)l * DM * NE;
    const float* mods_l = (const float*)(F.ws + WS_MODS) + (size_t)l * 4 * 6144;
    const float* pre = (const float*)(F.ws + WS_PRE); float* x1 = (float*)(F.ws + WS_X1); f16* hB = (f16*)(F.ws + WS_HB); float* aff = (float*)(F.ws + WS_AFF);
    LAS float* rwT = (LAS float*)F.lds;
    for (int i = F.tid; i < 16384; i += NTHREADS) { const int d = i >> 4, e = i & 15; rwT[e * 1024 + d] = router_w[i]; }
    __syncthreads();
    const int gw = F.vcu * NWAVES + F.wave, NGW = F.G * NWAVES, lane = F.lane;
    for (int m = gw; m < T; m += NGW) { const int b = m >> 12, s_ = m & 4095; const float* mb = mods_l + b * 6144;
        f32x4 v[4]; float s = 0.f;
#pragma unroll
        for (int j = 0; j < 4; ++j) { v[j] = *(const f32x4*)(pre + (size_t)m * DM + 4 * lane + 256 * j); s += (v[j][0] + v[j][1]) + (v[j][2] + v[j][3]); }
        const float mean = wave_sum(s) * (1.f / DM); float s2 = 0.f;
#pragma unroll
        for (int j = 0; j < 4; ++j) { v[j] = v[j] - mean; s2 += (v[j][0] * v[j][0] + v[j][1] * v[j][1]) + (v[j][2] * v[j][2] + v[j][3] * v[j][3]); }
        const float rstd = 1.0f / sqrtf(wave_sum(s2) * (1.f / DM) + LN_EPS);
        float lg[16];
#pragma unroll
        for (int e = 0; e < 16; ++e) lg[e] = 0.f;
#pragma unroll
        for (int j = 0; j < 4; ++j) { const int c = 4 * lane + 256 * j;
            const f32x4 g = *(const f32x4*)(lng + c), bb = *(const f32x4*)(lnb + c), sh = *(const f32x4*)(mb + 3072 + c), sc = *(const f32x4*)(mb + 4096 + c);
            const f32x4 xn = v[j] * rstd * g + bb; *(f32x4*)(x1 + (size_t)m * DM + c) = xn;
            const f32x4 h = xn * (sc + 1.0f) + sh; h4 o; o[0] = (f16)h[0]; o[1] = (f16)h[1]; o[2] = (f16)h[2]; o[3] = (f16)h[3]; *(h4*)(hB + (size_t)m * DM + c) = o;
#pragma unroll
            for (int e = 0; e < 16; ++e) { const f32x4 w = *(const LAS f32x4*)(rwT + e * 1024 + c); lg[e] += (h[0] * w[0] + h[1] * w[1]) + (h[2] * w[2] + h[3] * w[3]); }
            asm volatile("" ::: "memory"); }
        float mx = -1e30f;
#pragma unroll
        for (int e = 0; e < 16; ++e) { lg[e] = wave_sum(lg[e]); mx = fmaxf(mx, lg[e]); }
        float den = 0.f;
#pragma unroll
        for (int e = 0; e < 16; ++e) { lg[e] = __expf(lg[e] - mx); den += lg[e]; }
        const float rden = 1.0f / den; float mine = 0.f;
#pragma unroll
        for (int e = 0; e < 16; ++e) mine = (lane == e) ? lg[e] * rden : mine;
        if (lane < 16) aff[(size_t)(b * 16 + lane) * SEQ + s_] = mine;
    }
    __syncthreads();
}

__device__ __forceinline__ int block_excl_scan(int v, LAS int* tmp, int tid, int& total) {
    const int lane = tid & 63, wid = tid >> 6; int x = v;
#pragma unroll
    for (int o = 1; o < 64; o <<= 1) { const int y = __shfl_up(x, o); if (lane >= o) x += y; }
    if (lane == 63) tmp[wid] = x;
    __syncthreads();
    int base = 0, tot = 0;
#pragma unroll
    for (int w = 0; w < 8; ++w) { const int t = tmp[w]; if (w < wid) base += t; tot += t; }
    __syncthreads();
    total = tot; return base + x - v;
}
__device__ __forceinline__ void topk_phase() {
    const KArgs a = kargs(); const Frame F = mkframe(a);
    const float* aff = (const float*)(F.ws + WS_AFF); float* gate = (float*)(F.ws + WS_GATE); int* rowtok = (int*)(F.ws + WS_ROWTOK); int* inv = (int*)(F.ws + WS_INV);
    LAS unsigned* hist = (LAS unsigned*)F.lds; LAS unsigned* selw = hist + 256; LAS int* tmp = (LAS int*)(hist + 272);
    const int tid = F.tid;
    for (int p = blockIdx.x; p < NB * NE; p += F.G) { const int b = p >> 4, e = p & 15;
        const float* ap = aff + (size_t)p * SEQ + 8 * tid; unsigned key[8];
        { const f32x4 a0 = *(const f32x4*)ap, a1 = *(const f32x4*)(ap + 4);
          key[0] = __float_as_uint(a0[0]); key[1] = __float_as_uint(a0[1]); key[2] = __float_as_uint(a0[2]); key[3] = __float_as_uint(a0[3]);
          key[4] = __float_as_uint(a1[0]); key[5] = __float_as_uint(a1[1]); key[6] = __float_as_uint(a1[2]); key[7] = __float_as_uint(a1[3]); }
        unsigned prefix = 0u, kk = CAP;
        for (int pass = 0; pass < 4; ++pass) { const int shift = 24 - 8 * pass;
            if (tid < 256) hist[tid] = 0u;
            __syncthreads();
#pragma unroll
            for (int j = 0; j < 8; ++j) { const bool match = (pass == 0) || ((key[j] >> (shift + 8)) == prefix); if (match) atomicAdd((unsigned*)&hist[(key[j] >> shift) & 255u], 1u); }
            __syncthreads();
            if (tid < 256) { unsigned S = 0u; for (int j = 0; j <= tid; ++j) S += hist[255 - j]; const unsigned Sp = S - hist[255 - tid];
                if (Sp < kk && kk <= S) { selw[0] = 255u - (unsigned)tid; selw[1] = kk - Sp; } }
            __syncthreads();
            prefix = (prefix << 8) | selw[0]; kk = selw[1];
            __syncthreads();
        }
        int ce = 0;
#pragma unroll
        for (int j = 0; j < 8; ++j) ce += (key[j] == prefix) ? 1 : 0;
        int tot; int eqr = block_excl_scan(ce, tmp, tid, tot);
        unsigned selm = 0u; int cs = 0;
#pragma unroll
        for (int j = 0; j < 8; ++j) { bool sel = key[j] > prefix; if (key[j] == prefix) { sel = (unsigned)eqr < kk; ++eqr; } if (sel) { selm |= 1u << j; ++cs; } }
        int slot = block_excl_scan(cs, tmp, tid, tot);
#pragma unroll
        for (int j = 0; j < 8; ++j) { const int s_ = 8 * tid + j; const int tok = b * SEQ + s_; const bool sel = (selm >> j) & 1u;
            if (sel) { const int row = e * EROWS + b * CAP + slot; rowtok[row] = tok; gate[row] = __uint_as_float(key[j]); inv[(size_t)tok * 16 + e] = slot; ++slot; }
            else inv[(size_t)tok * 16 + e] = -1; }
        __syncthreads();
    }
}
__device__ __forceinline__ void gather_rows() {
    const KArgs a = kargs(); const Frame F = mkframe(a);
    const int* rowtok = (const int*)(F.ws + WS_ROWTOK); const f16* hB = (const f16*)(F.ws + WS_HB); f16* xe = (f16*)(F.ws + WS_XE);
    const int gw = F.vcu * NWAVES + F.wave, NGW = F.G * NWAVES, lane = F.lane;
    for (int r = gw; r < MROWS; r += NGW) { const int tok = rowtok[r];
        const h8 a0 = *(const h8*)(hB + (size_t)tok * DM + 8 * lane), a1 = *(const h8*)(hB + (size_t)tok * DM + 512 + 8 * lane);
        *(h8*)(xe + (size_t)r * DM + 8 * lane) = a0; *(h8*)(xe + (size_t)r * DM + 512 + 8 * lane) = a1; }
}
__device__ __forceinline__ void combine_ln(int l) {
    const KArgs a = kargs(); const Frame F = mkframe(a);
    const float* lng = (const float*)a->in[7] + l * DM; const float* lnb = (const float*)a->in[8] + l * DM;
    const float* mods_l = (const float*)(F.ws + WS_MODS) + (size_t)l * 4 * 6144; const float* mods_next = (const float*)(F.ws + WS_MODS) + (size_t)4 * 6144;
    float* xo = (l == 0) ? (float*)(F.ws + WS_X2) : a->out; f16* hA = (l == 0) ? (f16*)(F.ws + WS_HA) : (f16*)nullptr;
    const float* x1 = (const float*)(F.ws + WS_X1); const f16* y = (const f16*)(F.ws + WS_Y); const int* inv = (const int*)(F.ws + WS_INV);
    const int gw = F.vcu * NWAVES + F.wave, NGW = F.G * NWAVES, lane = F.lane;
    for (int m = gw; m < T; m += NGW) { const int b = m >> 12; const float* mb = mods_l + b * 6144;
        const int myinv = inv[(size_t)m * 16 + (lane & 15)];
        f32x4 f[4];
#pragma unroll
        for (int j = 0; j < 4; ++j) f[j] = (f32x4){0.f, 0.f, 0.f, 0.f};
        for (int e = 0; e < 16; ++e) { const int sl = __shfl(myinv, e);
            if (sl >= 0) { const f16* yr = y + (size_t)(e * EROWS + b * CAP + sl) * DM;
#pragma unroll
                for (int j = 0; j < 4; ++j) { const h4 yv = *(const h4*)(yr + 4 * lane + 256 * j); f[j][0] += (float)yv[0]; f[j][1] += (float)yv[1]; f[j][2] += (float)yv[2]; f[j][3] += (float)yv[3]; } } }
        f32x4 v[4]; float s = 0.f;
#pragma unroll
        for (int j = 0; j < 4; ++j) { const int c = 4 * lane + 256 * j; const f32x4 xv = *(const f32x4*)(x1 + (size_t)m * DM + c), g2 = *(const f32x4*)(mb + 5120 + c);
            v[j] = xv * ALPHA + (g2 + 1.0f) * f[j]; s += (v[j][0] + v[j][1]) + (v[j][2] + v[j][3]); }
        const float mean = wave_sum(s) * (1.f / DM); float s2 = 0.f;
#pragma unroll
        for (int j = 0; j < 4; ++j) { v[j] = v[j] - mean; s2 += (v[j][0] * v[j][0] + v[j][1] * v[j][1]) + (v[j][2] * v[j][2] + v[j][3] * v[j][3]); }
        const float rstd = 1.0f / sqrtf(wave_sum(s2) * (1.f / DM) + LN_EPS);
#pragma unroll
        for (int j = 0; j < 4; ++j) { const int c = 4 * lane + 256 * j; const f32x4 g = *(const f32x4*)(lng + c), bb = *(const f32x4*)(lnb + c);
            const f32x4 xn = v[j] * rstd * g + bb; *(f32x4*)(xo + (size_t)m * DM + c) = xn;
            if (hA) { const float* mn = mods_next + b * 6144; const f32x4 sh = *(const f32x4*)(mn + c), sc = *(const f32x4*)(mn + 1024 + c);
                const f32x4 h = xn * (sc + 1.0f) + sh; h4 o; o[0] = (f16)h[0]; o[1] = (f16)h[1]; o[2] = (f16)h[2]; o[3] = (f16)h[3]; *(h4*)(hA + (size_t)m * DM + c) = o; } }
    }
}
__device__ __forceinline__ void diff_combine() {
    const KArgs a = kargs(); const Frame F = mkframe(a);
    const float* lamv = (const float*)a->in[16]; const float* subln = (const float*)a->in[17];
    const f16* od = (const f16*)(F.ws + WS_OD); f16* o16 = (f16*)(F.ws + WS_O);
    const int gw = F.vcu * NWAVES + F.wave, NGW = F.G * NWAVES, lane = F.lane;
    const float l01 = wave_sum(lamv[lane] * lamv[64 + lane]), l23 = wave_sum(lamv[128 + lane] * lamv[192 + lane]);
    const float lam = expf(l01) - expf(l23) + LAMBDA_INIT;
    const int h = lane >> 3, d0 = (lane & 7) * 16;
    float sl[16];
#pragma unroll
    for (int i = 0; i < 16; ++i) sl[i] = subln[d0 + i] * (1.0f - LAMBDA_INIT);
    for (int m = gw; m < T; m += NGW) { const f16* r0 = od + (size_t)m * 2048 + (2 * h) * 128 + d0; const f16* r1 = r0 + 128;
        const h8 a0 = *(const h8*)r0, a1 = *(const h8*)(r0 + 8), b0 = *(const h8*)r1, b1 = *(const h8*)(r1 + 8);
        float o[16]; float ss = 0.f;
#pragma unroll
        for (int i = 0; i < 8; ++i) { o[i] = (float)a0[i] - lam * (float)b0[i]; o[8 + i] = (float)a1[i] - lam * (float)b1[i]; }
#pragma unroll
        for (int i = 0; i < 16; ++i) ss += o[i] * o[i];
        ss += __shfl_xor(ss, 1); ss += __shfl_xor(ss, 2); ss += __shfl_xor(ss, 4);
        const float rs = 1.0f / sqrtf(ss * (1.0f / 128.0f) + LN_EPS);
        h8 w0, w1;
#pragma unroll
        for (int i = 0; i < 8; ++i) { w0[i] = (f16)(o[i] * rs * sl[i]); w1[i] = (f16)(o[8 + i] * rs * sl[8 + i]); }
        *(h8*)(o16 + (size_t)m * DM + h * 128 + d0) = w0; *(h8*)(o16 + (size_t)m * DM + h * 128 + d0 + 8) = w1; }
}

__device__ __forceinline__ void attn_mla() {
    const KArgs a = kargs(); const Frame F = mkframe(a);
    const f16* Q = (const f16*)(F.ws + WS_Q); const f16* K = (const f16*)(F.ws + WS_K); const f16* V = (const f16*)(F.ws + WS_V); f16* O = (f16*)(F.ws + WS_O);
    for (int u = F.vcu; u < NB * 8 * 16; u += F.G) { const int qb = u & 15, bh = u >> 4, h = bh & 7, b = bh >> 3;
        att::attn_body_simple<192, 1536, 1536, 1024, 1024>(Q + (size_t)(b * SEQ + qb * 256) * 1536 + h * 192, K + (size_t)(b * SEQ) * 1536 + h * 192, V + (size_t)(b * SEQ) * 1024 + h * 128,
                                                       O + (size_t)(b * SEQ + qb * 256) * 1024 + h * 128, F.ldsg); }
}
__device__ __forceinline__ void attn_diff() {
    const KArgs a = kargs(); const Frame F = mkframe(a);
    const f16* QKV = (const f16*)(F.ws + WS_QKV1); f16* O = (f16*)(F.ws + WS_OD);
    for (int u = F.vcu; u < NB * 16 * 16; u += F.G) { const int qb = u & 15, bh = u >> 4, hh = bh & 15, b = bh >> 4;
        att::attn_body<64, 3072, 3072, 3072, 2048, 2>(QKV + (size_t)(b * SEQ + qb * 256) * 3072 + hh * 64, QKV + (size_t)(b * SEQ) * 3072 + 1024 + hh * 64, QKV + (size_t)(b * SEQ) * 3072 + 2048 + (hh >> 1) * 128,
                                                      O + (size_t)(b * SEQ + qb * 256) * 2048 + hh * 128, F.ldsg); }
}

__device__ __forceinline__ void ph_gemm_lat() { const KArgs a = kargs(); const Frame F = mkframe(a);
    pg8::Gemm g{(const f16*)(F.ws + WS_HA), (const f16*)(F.ws + WS_WIN0), T, 768, 1024, 1 << 30, 0}; pg8::StaticOrder S; S.init(T, 768, F.G, (int)blockIdx.x);
    EpiLat E{(float*)(F.ws + WS_LAT)}; pg8::gemm_phase<EpiLat>(F.lds, g, S, E); }
__device__ __forceinline__ void ph_gemm_q() { const KArgs a = kargs(); const Frame F = mkframe(a);
    pg8::Gemm g{(const f16*)(F.ws + WS_CQN), (const f16*)(F.ws + WS_WUQ), T, 1024, 384, 1 << 30, 0}; pg8::StaticOrder S; S.init(T, 1024, F.G, (int)blockIdx.x);
    EpiQNope E{(f16*)(F.ws + WS_Q)}; pg8::gemm_phase<EpiQNope>(F.lds, g, S, E); }
__device__ __forceinline__ void ph_gemm_qr() { const KArgs a = kargs(); const Frame F = mkframe(a);
    pg8::Gemm g{(const f16*)(F.ws + WS_CQN), (const f16*)(F.ws + WS_WUQ) + (size_t)1024 * 384, T, 512, 384, 1 << 30, 0}; pg8::StaticOrder S; S.init(T, 512, F.G, (int)blockIdx.x);
    EpiQRope E{(f16*)(F.ws + WS_Q), (const float*)(F.ws + WS_COSM), (const float*)(F.ws + WS_SINM)}; pg8::gemm_phase<EpiQRope>(F.lds, g, S, E); }
__device__ __forceinline__ void ph_gemm_kv() { const KArgs a = kargs(); const Frame F = mkframe(a);
    pg8::Gemm g{(const f16*)(F.ws + WS_CKVN), (const f16*)(F.ws + WS_WUKV), T, 2048, 256, 1 << 30, 0}; pg8::StaticOrder S; S.init(T, 2048, F.G, (int)blockIdx.x);
    EpiKV E{(f16*)(F.ws + WS_K), (f16*)(F.ws + WS_V)}; pg8::gemm_phase<EpiKV>(F.lds, g, S, E); }
__device__ __forceinline__ void ph_gemm_o(int l) { const KArgs a = kargs(); const Frame F = mkframe(a);
    pg8::Gemm g{(const f16*)(F.ws + WS_O), (const f16*)(F.ws + (l == 0 ? WS_WO0 : WS_WO1)), T, 1024, 1024, 1 << 30, 0}; pg8::StaticOrder S; S.init(T, 1024, F.G, (int)blockIdx.x);
    EpiPre E{l == 0 ? (const float*)a->in[0] : (const float*)(F.ws + WS_X2), (const float*)(F.ws + WS_MODS) + (size_t)l * 4 * 6144 + 2048, (float*)(F.ws + WS_PRE)}; pg8::gemm_phase<EpiPre>(F.lds, g, S, E); }
__device__ __forceinline__ void ph_gemm_diffin() { const KArgs a = kargs(); const Frame F = mkframe(a);
    pg8::Gemm g{(const f16*)(F.ws + WS_HA), (const f16*)(F.ws + WS_WIN1), T, 3072, 1024, 1 << 30, 0}; pg8::StaticOrder S; S.init(T, 3072, F.G, (int)blockIdx.x);
    EpiDiffIn E{(f16*)(F.ws + WS_QKV1), (const float*)(F.ws + WS_COSD), (const float*)(F.ws + WS_SIND)}; pg8::gemm_phase<EpiDiffIn>(F.lds, g, S, E); }
__device__ __forceinline__ void ph_gemm_up(int l) { const KArgs a = kargs(); const Frame F = mkframe(a);
    pg8::Gemm g{(const f16*)(F.ws + WS_XE), (const f16*)(F.ws + WS_MOEIN) + (size_t)l * NE * 4096 * 1024, MROWS, 4096, 1024, EROWS / 256, (size_t)4096 * 1024}; pg8::StaticOrder S; S.init(MROWS, 4096, F.G, (int)blockIdx.x);
    EpiUp E{(f16*)(F.ws + WS_ACT)}; pg8::gemm_phase<EpiUp>(F.lds, g, S, E); }
__device__ __forceinline__ void ph_gemm_down(int l) { const KArgs a = kargs(); const Frame F = mkframe(a);
    pg8::Gemm g{(const f16*)(F.ws + WS_ACT), (const f16*)(F.ws + WS_MOEOUT) + (size_t)l * NE * 1024 * 2048, MROWS, 1024, 2048, EROWS / 256, (size_t)1024 * 2048}; pg8::StaticOrder S; S.init(MROWS, 1024, F.G, (int)blockIdx.x);
    EpiDown E{(f16*)(F.ws + WS_Y), (const float*)(F.ws + WS_GATE)}; pg8::gemm_phase<EpiDown>(F.lds, g, S, E); }

constexpr int NPHASES = 24;
__global__ void __launch_bounds__(NTHREADS, 2) mk_fwd(Args args) {
    LAS unsigned char* ldsp = (LAS unsigned char*)g_lds;
    volatile LAS unsigned* MISC = (volatile LAS unsigned*)(ldsp + MISC_OFF);
    for (int u = threadIdx.x; u < (LDS_BYTES - LDSCTL_OFF) / 4; u += NTHREADS) ((LAS unsigned*)(ldsp + LDSCTL_OFF))[u] = 0u;
    __syncthreads();
    XcdBarrier bar = xcd_barrier_post((unsigned*)(args.ws + WS_CTL) + CW_BAR + args.li * XCD_BAR_WORDS, MISC + 8);
    const int lo = args.ph_lo, hi = args.ph_hi;
#ifndef PH_MASK
#define PH_MASK 0xFFFFFFFFu
#endif
#define IN(k) (((PH_MASK >> (k)) & 1u) && lo <= (k) && (k) < hi)
#define SEAM(k) do { if (lo <= (k) && (k) + 1 < hi) xcd_barrier(bar); } while (0)
    if (IN(0)) p0_prologue();      SEAM(0);
    if (IN(1)) mod_rows_p1();      SEAM(1);
    if (IN(2)) ph_gemm_lat();      SEAM(2);
    if (IN(3)) latent_prep();      SEAM(3);
    if (IN(4)) { ph_gemm_q(); ph_gemm_qr(); }
    if (IN(5)) ph_gemm_kv();       SEAM(5);
    if (IN(6)) attn_mla();         SEAM(6);
#pragma unroll 1
    for (int l = 0; l < 2; ++l) {
        const int pb = (l == 0) ? 7 : 17;
        if (l == 1) {
            if (IN(14)) ph_gemm_diffin(); SEAM(14);
            if (IN(15)) attn_diff();      SEAM(15);
            if (IN(16)) diff_combine();   SEAM(16);
        }
        if (IN(pb + 0)) ph_gemm_o(l);     SEAM(pb + 0);
        if (IN(pb + 1)) ln_router(l);     SEAM(pb + 1);
        if (IN(pb + 2)) topk_phase();     SEAM(pb + 2);
        if (IN(pb + 3)) gather_rows();    SEAM(pb + 3);
        if (IN(pb + 4)) ph_gemm_up(l);    SEAM(pb + 4);
        if (IN(pb + 5)) ph_gemm_down(l);  SEAM(pb + 5);
        if (IN(pb + 6)) combine_ln(l);
        if (l == 0) SEAM(pb + 6);
    }
#undef IN
#undef SEAM
}

extern "C" void kernel_launch(void* const* d_in, const int* in_sizes, int n_in, void* d_out, int out_size, void* d_ws, size_t ws_size, hipStream_t stream) {
    static int grid = 0;
    if (grid == 0) {
        if (n_in != 22 || in_sizes[0] != T * DM || out_size != T * DM || ws_size < WS_END) {
            fprintf(stderr, "kernel_launch: shape/workspace mismatch: n_in %d in0 %d out %d ws %zu (need %zu)\n", n_in, n_in > 0 ? in_sizes[0] : -1, out_size, ws_size, (size_t)WS_END); grid = -1; return; }
        int dev = 0, cus = 0, per_cu = 0;
        if (hipGetDevice(&dev) != hipSuccess || hipDeviceGetAttribute(&cus, hipDeviceAttributeMultiprocessorCount, dev) != hipSuccess) { fprintf(stderr, "kernel_launch: device query failed\n"); grid = -1; return; }
        if (hipFuncSetAttribute((const void*)mk_fwd, hipFuncAttributeMaxDynamicSharedMemorySize, LDS_BYTES) != hipSuccess) { fprintf(stderr, "kernel_launch: hipFuncSetAttribute failed\n"); grid = -1; return; }
        if (hipOccupancyMaxActiveBlocksPerMultiprocessor(&per_cu, (const void*)mk_fwd, NTHREADS, LDS_BYTES) != hipSuccess || per_cu < 1)
            fprintf(stderr, "kernel_launch: note: occupancy query reports %d workgroups per CU\n", per_cu);
        (void)hipGetLastError();
        grid = cus;
    }
    if (grid < 0) return;
    if (hipMemsetAsync((char*)d_ws + WS_CTL, 0, CTL_ZERO_BYTES, stream) != hipSuccess) { fprintf(stderr, "kernel_launch: memset failed\n"); return; }
    Args a{};
    for (int i = 0; i < 22; ++i) a.in[i] = d_in[i];
    a.out = (float*)d_out; a.ws = (unsigned char*)d_ws;
#if MK_CUTS == 1
    a.ph_lo = 0; a.ph_hi = NPHASES; a.li = 0;
    hipLaunchKernelGGL(mk_fwd, dim3(grid), dim3(NTHREADS), LDS_BYTES, stream, a);
#else
    for (int p = 0; p < NPHASES; ++p) { a.ph_lo = p; a.ph_hi = p + 1; a.li = 0; hipLaunchKernelGGL(mk_fwd, dim3(grid), dim3(NTHREADS), LDS_BYTES, stream, a); }
#endif
    const hipError_t le = hipPeekAtLastError();
    if (le != hipSuccess) fprintf(stderr, "kernel_launch: launch failed: %s\n", hipGetErrorName(le));
}
```

```cpp
#include <hip/hip_runtime.h>
#include <cstdio>
#include <cstdint>

#ifndef MK_CUTS
#define MK_CUTS 1
#endif
#define REP_MASK 0x0u

#define LAS __attribute__((address_space(3)))
#define GAS __attribute__((address_space(1)))
typedef _Float16 f16;
typedef _Float16 h8 __attribute__((ext_vector_type(8)));
typedef _Float16 h4 __attribute__((ext_vector_type(4)));
typedef _Float16 h2 __attribute__((ext_vector_type(2)));
typedef short s16x4 __attribute__((ext_vector_type(4)));
typedef float f32x4 __attribute__((ext_vector_type(4)));
typedef float f32x2 __attribute__((ext_vector_type(2)));
typedef float f32x16 __attribute__((ext_vector_type(16)));
typedef unsigned u32x4 __attribute__((ext_vector_type(4)));
typedef unsigned u32x2 __attribute__((ext_vector_type(2)));

constexpr int NB = 4, SEQ = 4096, DM = 1024, T = NB * SEQ;
constexpr int NE = 16, FF = 2048, CAP = 512, EROWS = NB * CAP;
constexpr int MROWS = NE * EROWS;
constexpr float ALPHA = 1.4142135623730951f;
constexpr float LN_EPS = 1e-5f, LAT_EPS = 1e-6f;
constexpr float LAMBDA_INIT = 0.35550906759096926f;
constexpr int NWAVES = 8, NTHREADS = 512;

constexpr size_t MiB = 1u << 20;
constexpr size_t WS_CTL = 0, CTL_ZERO_BYTES = 1 * MiB;
constexpr size_t WS_MODS = 1 * MiB;
constexpr size_t WS_COSM = 2 * MiB, WS_SINM = 4 * MiB;
constexpr size_t WS_COSD = 6 * MiB, WS_SIND = 6 * MiB + 512 * 1024;
constexpr size_t WS_AFF = 7 * MiB;
constexpr size_t WS_GATE = 8 * MiB;
constexpr size_t WS_ROWTOK = 8 * MiB + 512 * 1024;
constexpr size_t WS_INV = 9 * MiB;
constexpr size_t WS_WIN0 = 16 * MiB;
constexpr size_t WS_WUQ = 18 * MiB;
constexpr size_t WS_WUKV = 20 * MiB;
constexpr size_t WS_WO0 = 22 * MiB;
constexpr size_t WS_WIN1 = 24 * MiB;
constexpr size_t WS_WO1 = 30 * MiB;
constexpr size_t WS_MOEIN = 32 * MiB;
constexpr size_t WS_MOEOUT = 288 * MiB;
constexpr size_t WS_HA = 416 * MiB;
constexpr size_t WS_HB = 448 * MiB;
constexpr size_t WS_LAT = 480 * MiB;
constexpr size_t WS_CQN = 528 * MiB;
constexpr size_t WS_CKVN = 540 * MiB;
constexpr size_t WS_Q = 548 * MiB;
constexpr size_t WS_K = 596 * MiB;
constexpr size_t WS_V = 644 * MiB;
constexpr size_t WS_O = 676 * MiB;
constexpr size_t WS_PRE = 708 * MiB;
constexpr size_t WS_X1 = 772 * MiB;
constexpr size_t WS_X2 = 836 * MiB;
constexpr size_t WS_XE = 900 * MiB;
constexpr size_t WS_ACT = 964 * MiB;
constexpr size_t WS_Y = 1092 * MiB;
constexpr size_t WS_QKV1 = 1156 * MiB;
constexpr size_t WS_OD = 1252 * MiB;
constexpr size_t WS_END = 1316 * MiB;
constexpr int CW_BAR = 4096;

constexpr int RING_BYTES = 131072;
constexpr int LDSCTL_OFF = RING_BYTES, MISC_OFF = LDSCTL_OFF + 320;
constexpr int LDS_BYTES = 147456;

#define LDS_WAIT() asm volatile("s_waitcnt lgkmcnt(0)" ::: "memory")
#define VM_WAIT() asm volatile("s_waitcnt vmcnt(0)" ::: "memory")

__device__ __forceinline__ float wave_sum(float v) {
#pragma unroll
    for (int o = 1; o < 64; o <<= 1) v += __shfl_xor(v, o);
    return v;
}

#define XB_TMO      128
#define XB_XCNT(j)  (256  + 64 * (j))
#define XB_XSUB(j)  (1280 + 64 * (j))
#define XB_XGEN(j)  (2304 + 64 * (j))
#define XB_TOP      3328
#define XB_TOPGEN   3392
#define XCD_BAR_WORDS 3456
#define XB_SPIN_CAP (1u << 20)
__device__ __forceinline__ unsigned xb_ld(unsigned* p)              { return __hip_atomic_load(p, __ATOMIC_RELAXED, __HIP_MEMORY_SCOPE_AGENT); }
__device__ __forceinline__ unsigned xb_add(unsigned* p, unsigned v) { return __hip_atomic_fetch_add(p, v, __ATOMIC_RELAXED, __HIP_MEMORY_SCOPE_AGENT); }
__device__ __forceinline__ unsigned xb_xcc_id() { return (unsigned)__builtin_amdgcn_s_getreg((3 << 11) | 20) & 0xFu; }
#define XB_SPIN(cond, bar) do { unsigned _sp = 0; while (cond) { __builtin_amdgcn_s_sleep(1); \
    if ((++_sp & 255u) == 0u) { if (xb_ld(&(bar)[XB_TMO])) break; if (_sp > XB_SPIN_CAP) { atomicAdd(&(bar)[XB_TMO], 1u); break; } } } } while (0)
struct XcdBarrier { unsigned* bar; unsigned x; volatile LAS unsigned* st; };
__device__ __forceinline__ XcdBarrier xcd_barrier_post(unsigned* bar, volatile LAS unsigned* st) {
    XcdBarrier b; b.bar = bar; b.x = xb_xcc_id(); b.st = st;
    if (threadIdx.x == 0) (void)xb_add(&bar[XB_XCNT(b.x)], 1u);
    return b;
}
__device__ __forceinline__ void xcd_barrier_complete(unsigned* bar, unsigned x, unsigned& nloc, unsigned& nx) {
    const unsigned G = gridDim.x * gridDim.y * gridDim.z;
    unsigned sum, cnt, mine, sp = 0u;
    for (;;) {
        sum = 0u; cnt = 0u; mine = 0u;
#pragma unroll
        for (unsigned j = 0; j < 16; ++j) { const unsigned c = xb_ld(&bar[XB_XCNT(j)]); sum += c; cnt += (c > 0u) ? 1u : 0u; mine = (j == x) ? c : mine; }
        if (sum == G) break;
        __builtin_amdgcn_s_sleep(1);
        if ((++sp & 255u) == 0u) { if (xb_ld(&bar[XB_TMO])) break; if (sp > XB_SPIN_CAP) { atomicAdd(&bar[XB_TMO], 1u); break; } }
    }
    nloc = mine > 0u ? mine : 1u; nx = cnt > 0u ? cnt : 1u;
}
__device__ __forceinline__ void xcd_barrier(const XcdBarrier& b) {
    asm volatile("s_waitcnt vmcnt(0)" ::: "memory");
    __syncthreads();
    if (threadIdx.x == 0) {
        unsigned* bar = b.bar;
        __builtin_amdgcn_s_waitcnt(0);
        unsigned nloc = b.st[0], nx = b.st[1];
        if (nloc == 0u) { xcd_barrier_complete(bar, b.x, nloc, nx); b.st[0] = nloc; b.st[1] = nx; }
        const unsigned old = xb_add(&bar[XB_XSUB(b.x)], 1u);
        const unsigned gen = old / nloc;
        if (old + 1u == (gen + 1u) * nloc) {
            __builtin_amdgcn_fence(__ATOMIC_RELEASE, "agent");
            asm volatile("s_waitcnt vmcnt(0)" ::: "memory");
            const unsigned og = xb_add(&bar[XB_TOP], 1u);
            const unsigned tg = og / nx;
            if (og + 1u == (tg + 1u) * nx) xb_add(&bar[XB_TOPGEN], 1u);
            else XB_SPIN(xb_ld(&bar[XB_TOPGEN]) == tg, bar);
            __builtin_amdgcn_fence(__ATOMIC_ACQUIRE, "agent");
            xb_add(&bar[XB_XGEN(b.x)], 1u);
            asm volatile("s_waitcnt vmcnt(0)" ::: "memory");
        } else {
            XB_SPIN(xb_ld(&bar[XB_XGEN(b.x)]) == gen, bar);
            __builtin_amdgcn_fence(__ATOMIC_ACQUIRE, "agent");
            asm volatile("s_waitcnt vmcnt(0)" ::: "memory");
        }
    }
    __syncthreads();
}

namespace pg8 {
constexpr int BM = 256, BK = 64, HALF = 128, HTB = HALF * BK * 2, STAGE_BYTES = 8 * HTB, NXCD = 8, WGM = 8;
__host__ __device__ __forceinline__ int lds_byte(int r, int c) { const int st = (r >> 4) * 2 + (c >> 5), rr = r & 15, cc = c & 31, ob = rr * 64 + cc * 2; return st * 1024 + (ob ^ (((ob >> 9) & 1) << 5)); }
__host__ __device__ __forceinline__ void stage_rc(int b, int& R, int& C) { const int st = b / 1024, sb = b % 1024, swz = sb ^ (((sb >> 9) & 1) << 5); R = (st >> 1) * 16 + swz / 64; C = (st & 1) * 32 + (swz % 64) / 2; }
__host__ __device__ __forceinline__ int perm32(int rho) { const int n = rho >> 4, i = rho & 15; return 8 * (i >> 2) + 4 * n + (i & 3); }
struct Unit { int pm, pn; };
struct Gemm { const f16* A; const f16* Bt; int M, N, K; int grp_tiles; size_t grp_stride; };
struct StaticOrder {
    int nM, nN, nwg, G, c;
    __host__ __device__ void init(int M, int N, int G_, int c_) { nM = M / BM; nN = N / BM; nwg = nM * nN; G = G_; c = c_; }
    __host__ __device__ bool next(int i, Unit& u) const {
        const long L = (long)i * G + c; if (L >= nwg) return false;
        int wgid = (int)L; { const int q = nwg / NXCD, r = nwg % NXCD, xcd = wgid % NXCD, off = wgid / NXCD; wgid = (xcd < r ? xcd * (q + 1) : r * (q + 1) + (xcd - r) * q) + off; }
        const int nig = WGM * nN, gid = wgid / nig, fm = gid * WGM, gsz = (nM - fm) < WGM ? (nM - fm) : WGM;
        u.pm = fm + ((wgid % nig) % gsz); u.pn = (wgid % nig) / gsz; return true;
    }
};
template <class Epi, bool ALIGN_EPI = true, bool SP2 = true>
__device__ __forceinline__ void gemm_phase(LAS unsigned char* lds, const Gemm g, const StaticOrder& S, const Epi& E) {
    int tid = threadIdx.x; asm volatile("" : "+v"(tid));
    const int wid = __builtin_amdgcn_readfirstlane(tid >> 6), lane = tid & 63, wr = wid >> 2, wc = wid & 3, fr = lane & 15, fq = lane >> 4;
    const int K = g.K, nt = K / BK;
    unsigned voffA[2], voffB[2];
#pragma unroll
    for (int i = 0; i < 2; ++i) { int R, C; stage_rc(tid * 16 + i * 8192, R, C); const int Rb = Epi::PERM ? ((R & ~31) + perm32(R & 31)) : R;
        voffA[i] = (unsigned)(R * K + C) * 2u; voffB[i] = (unsigned)(Rb * K + C) * 2u; }
    const size_t kstep = (size_t)(BK * 2);
    const size_t hstep = (size_t)HALF * K * 2;
    const size_t tstep = 2 * hstep;
    const unsigned ldsw = (unsigned)wid * 1024u;
    const int aoff = lds_byte(wr * 64 + fr, fq * 8), boff = lds_byte(wc * 32 + fr, fq * 8);
#define PG8_SA(b, h) (((b) * 2 + (h)) * HTB)
#define PG8_SB(b, h) ((4 + (b) * 2 + (h)) * HTB)
#define PG8_STAGE(bufoff, gbase, voff) do { _Pragma("unroll") for (int _i = 0; _i < 2; ++_i) \
        __builtin_amdgcn_global_load_lds((const unsigned*)((const char*)(gbase) + (voff)[_i]), (LAS unsigned*)(lds + (bufoff) + ldsw + _i * 8192), 16, 0, 0); } while (0)
#define PG8_LDA(dst, b, h) do { _Pragma("unroll") for (int m = 0; m < 4; ++m) _Pragma("unroll") for (int k = 0; k < 2; ++k) dst[m][k] = *(const LAS h8*)(lds + PG8_SA(b, h) + aoff + m * 2048 + k * 1024); } while (0)
#define PG8_LDB(dst, b, h) do { _Pragma("unroll") for (int n = 0; n < 2; ++n) _Pragma("unroll") for (int k = 0; k < 2; ++k) dst[n][k] = *(const LAS h8*)(lds + PG8_SB(b, h) + boff + n * 2048 + k * 1024); } while (0)
#define PG8_MMA(ai, bj, At, Bt) do { __builtin_amdgcn_s_setprio(1); _Pragma("unroll") for (int m = 0; m < 4; ++m) _Pragma("unroll") for (int n = 0; n < 2; ++n) _Pragma("unroll") for (int k = 0; k < 2; ++k) \
        acc[ai][bj][m][n] = __builtin_amdgcn_mfma_f32_16x16x32_f16(Bt[n][k], At[m][k], acc[ai][bj][m][n], 0, 0, 0); __builtin_amdgcn_s_setprio(0); } while (0)
#define PG8_WAIT_V(n) asm volatile("s_waitcnt vmcnt(" #n ")" ::: "memory")
#define PG8_WAIT_L(n) asm volatile("s_waitcnt lgkmcnt(" #n ")" ::: "memory")
#define PG8_BAR __builtin_amdgcn_s_barrier()
#define PG8_SCHED __builtin_amdgcn_sched_barrier(0)
#define PG8_BBASE(u) ((const char*)g.Bt + ((size_t)((u).pm / g.grp_tiles) * g.grp_stride) * 2 + (size_t)(u).pn * tstep)
    Unit cur, nxt; int ui = 0;
    if (!S.next(0, cur)) return;
    f32x4 acc[2][2][4][2];
#pragma unroll
    for (int a = 0; a < 2; ++a)
#pragma unroll
        for (int b = 0; b < 2; ++b)
#pragma unroll
            for (int m = 0; m < 4; ++m)
#pragma unroll
                for (int n = 0; n < 2; ++n) acc[a][b][m][n] = (f32x4){0.f, 0.f, 0.f, 0.f};
    h8 At[4][2], B0[2][2], B1[2][2];
    const char* cA = (const char*)g.A + (size_t)cur.pm * tstep; const char* cB = PG8_BBASE(cur);
    if constexpr (SP2) {
        PG8_STAGE(PG8_SB(0, 0), cB, voffB); PG8_STAGE(PG8_SB(0, 1), cB + hstep, voffB); PG8_STAGE(PG8_SA(0, 0), cA, voffA); PG8_STAGE(PG8_SA(0, 1), cA + hstep, voffA);
        if (wr == 1) PG8_BAR;
        PG8_WAIT_V(2); PG8_BAR;
        PG8_STAGE(PG8_SB(1, 0), cB + kstep, voffB); PG8_STAGE(PG8_SA(1, 0), cA + kstep, voffA); PG8_STAGE(PG8_SB(1, 1), cB + hstep + kstep, voffB);
        PG8_WAIT_V(6); PG8_BAR;
    } else {
        PG8_STAGE(PG8_SB(0, 0), cB, voffB); PG8_STAGE(PG8_SA(0, 0), cA, voffA); PG8_STAGE(PG8_SB(0, 1), cB + hstep, voffB); PG8_STAGE(PG8_SA(0, 1), cA + hstep, voffA);
        if (wr == 1) PG8_BAR;
        PG8_WAIT_V(4); PG8_BAR;
        PG8_STAGE(PG8_SB(1, 0), cB + kstep, voffB); PG8_STAGE(PG8_SA(1, 0), cA + kstep, voffA); PG8_STAGE(PG8_SB(1, 1), cB + hstep + kstep, voffB);
        PG8_WAIT_V(6); PG8_BAR;
    }
    for (;;) {
        const bool has_next = S.next(ui + 1, nxt);
        const char* nA = has_next ? (const char*)g.A + (size_t)nxt.pm * tstep : cA; const char* nB = has_next ? PG8_BBASE(nxt) : cB;
#pragma unroll 1
        for (int t = 0; t < nt; t += 2) {
            const bool last = (t == nt - 2);
            const char* a1 = cA + (size_t)(t + 1) * kstep;
            const char* a2 = last ? nA : cA + (size_t)(t + 2) * kstep; const char* b2 = last ? nB : cB + (size_t)(t + 2) * kstep;
            const char* a3 = a2 + kstep; const char* b3 = b2 + kstep;
            if constexpr (SP2) {
            PG8_LDB(B0, 0, 0); PG8_LDB(B1, 0, 1); PG8_SCHED; PG8_LDA(At, 0, 0); PG8_STAGE(PG8_SA(1, 1), a1 + hstep, voffA);
            PG8_WAIT_V(8); PG8_WAIT_L(0); PG8_BAR; PG8_MMA(0, 0, At, B0); PG8_MMA(0, 1, At, B1); PG8_BAR; PG8_SCHED;
            PG8_LDA(At, 0, 1); PG8_STAGE(PG8_SB(0, 0), b2, voffB); PG8_STAGE(PG8_SB(0, 1), b2 + hstep, voffB); PG8_STAGE(PG8_SA(0, 0), a2, voffA);
            PG8_WAIT_V(8); PG8_WAIT_L(0); PG8_BAR; PG8_MMA(1, 0, At, B0); PG8_MMA(1, 1, At, B1); PG8_BAR; PG8_SCHED;
            PG8_LDB(B0, 1, 0); PG8_LDB(B1, 1, 1); PG8_SCHED; PG8_LDA(At, 1, 0); PG8_STAGE(PG8_SA(0, 1), a2 + hstep, voffA);
            PG8_WAIT_V(8); PG8_WAIT_L(0); PG8_BAR; PG8_MMA(0, 0, At, B0); PG8_MMA(0, 1, At, B1); PG8_BAR; PG8_SCHED;
            PG8_LDA(At, 1, 1); PG8_STAGE(PG8_SB(1, 0), b3, voffB); PG8_STAGE(PG8_SB(1, 1), b3 + hstep, voffB); PG8_STAGE(PG8_SA(1, 0), a3, voffA);
            PG8_WAIT_V(8); PG8_WAIT_L(0); PG8_BAR; PG8_MMA(1, 0, At, B0); PG8_MMA(1, 1, At, B1); PG8_BAR; PG8_SCHED;
            } else {
            PG8_LDB(B0, 0, 0); PG8_SCHED; PG8_LDA(At, 0, 0); PG8_STAGE(PG8_SA(1, 1), a1 + hstep, voffA);
            PG8_WAIT_L(8); PG8_BAR; PG8_WAIT_L(0); PG8_MMA(0, 0, At, B0); PG8_BAR; PG8_SCHED;
            PG8_LDB(B1, 0, 1); PG8_STAGE(PG8_SB(0, 0), b2, voffB);
            PG8_BAR; PG8_WAIT_L(0); PG8_MMA(0, 1, At, B1); PG8_BAR;
            PG8_LDA(At, 0, 1); PG8_STAGE(PG8_SA(0, 0), a2, voffA);
            PG8_BAR; PG8_WAIT_L(0); PG8_MMA(1, 0, At, B0); PG8_BAR; PG8_SCHED;
            PG8_STAGE(PG8_SB(0, 1), b2 + hstep, voffB);
            PG8_WAIT_V(6); PG8_BAR; PG8_MMA(1, 1, At, B1); PG8_BAR;
            PG8_LDB(B0, 1, 0); PG8_SCHED; PG8_LDA(At, 1, 0); PG8_STAGE(PG8_SA(0, 1), a2 + hstep, voffA);
            PG8_WAIT_L(8); PG8_BAR; PG8_WAIT_L(0); PG8_MMA(0, 0, At, B0); PG8_BAR; PG8_SCHED;
            PG8_LDB(B1, 1, 1); PG8_STAGE(PG8_SB(1, 0), b3, voffB);
            PG8_BAR; PG8_WAIT_L(0); PG8_MMA(0, 1, At, B1); PG8_BAR;
            PG8_LDA(At, 1, 1); PG8_STAGE(PG8_SA(1, 0), a3, voffA);
            PG8_BAR; PG8_WAIT_L(0); PG8_MMA(1, 0, At, B0); PG8_BAR; PG8_SCHED;
            PG8_STAGE(PG8_SB(1, 1), b3 + hstep, voffB);
            PG8_WAIT_V(6); PG8_BAR; PG8_MMA(1, 1, At, B1); PG8_BAR;
            }
        }
        if constexpr (ALIGN_EPI) { if (wr == 0) PG8_BAR; }
        E(acc, cur, wr, wc, fr, fq);
        if (!has_next) break;
#pragma unroll
        for (int a = 0; a < 2; ++a)
#pragma unroll
            for (int b = 0; b < 2; ++b)
#pragma unroll
                for (int m = 0; m < 4; ++m)
#pragma unroll
                    for (int n = 0; n < 2; ++n) acc[a][b][m][n] = (f32x4){0.f, 0.f, 0.f, 0.f};
        cur = nxt; cA = nA; cB = nB; ++ui;
        if constexpr (ALIGN_EPI) { if (wr == 1) PG8_BAR; }
    }
    PG8_WAIT_V(0);
    if constexpr (!ALIGN_EPI) { if (wr == 0) PG8_BAR; }
    PG8_BAR;
#undef PG8_SA
#undef PG8_SB
#undef PG8_STAGE
#undef PG8_LDA
#undef PG8_LDB
#undef PG8_MMA
#undef PG8_WAIT_V
#undef PG8_WAIT_L
#undef PG8_BAR
#undef PG8_SCHED
#undef PG8_BBASE
}
}

#define EPI_ROW(u, ai, m) ((u).pm * 256 + (ai) * 128 + wr * 64 + (m) * 16 + fr)
__device__ __forceinline__ h8 pack8(f32x4 a, f32x4 b) { h8 o; o[0] = (f16)a[0]; o[1] = (f16)a[1]; o[2] = (f16)a[2]; o[3] = (f16)a[3]; o[4] = (f16)b[0]; o[5] = (f16)b[1]; o[6] = (f16)b[2]; o[7] = (f16)b[3]; return o; }
__device__ __forceinline__ void rope4(f32x4& v0, f32x4& v1, const f32x4 cs, const f32x4 sn) {
    const f32x4 a = v0, b = v1;
    v0[0] = a[0] * cs[0] - a[1] * sn[0]; v0[1] = a[1] * cs[0] + a[0] * sn[0];
    v0[2] = a[2] * cs[1] - a[3] * sn[1]; v0[3] = a[3] * cs[1] + a[2] * sn[1];
    v1[0] = b[0] * cs[2] - b[1] * sn[2]; v1[1] = b[1] * cs[2] + b[0] * sn[2];
    v1[2] = b[2] * cs[3] - b[3] * sn[3]; v1[3] = b[3] * cs[3] + b[2] * sn[3];
}
struct EpiLat {
    static constexpr bool PERM = false; float* out;
    __device__ __forceinline__ void operator()(const f32x4 (&acc)[2][2][4][2], const pg8::Unit& u, int wr, int wc, int fr, int fq) const {
#pragma unroll
        for (int ai = 0; ai < 2; ++ai)
#pragma unroll
            for (int m = 0; m < 4; ++m) { float* rowp = out + (size_t)EPI_ROW(u, ai, m) * 768 + u.pn * 256 + wc * 32 + 4 * fq;
#pragma unroll
                for (int bj = 0; bj < 2; ++bj)
#pragma unroll
                    for (int n = 0; n < 2; ++n) *(f32x4*)(rowp + bj * 128 + n * 16) = acc[ai][bj][m][n]; }
    }
};
struct EpiQNope {
    static constexpr bool PERM = true; f16* Q;
    __device__ __forceinline__ void operator()(const f32x4 (&acc)[2][2][4][2], const pg8::Unit& u, int wr, int wc, int fr, int fq) const {
#pragma unroll
        for (int ai = 0; ai < 2; ++ai)
#pragma unroll
            for (int m = 0; m < 4; ++m) { const int t = EPI_ROW(u, ai, m);
#pragma unroll
                for (int bj = 0; bj < 2; ++bj) { const int c8 = u.pn * 256 + bj * 128 + wc * 32 + 8 * fq;
                    *(h8*)(Q + (size_t)t * 1536 + (c8 >> 7) * 192 + (c8 & 127)) = pack8(acc[ai][bj][m][0], acc[ai][bj][m][1]); } }
    }
};
struct EpiQRope {
    static constexpr bool PERM = true; f16* Q; const float* cosm; const float* sinm;
    __device__ __forceinline__ void operator()(const f32x4 (&acc)[2][2][4][2], const pg8::Unit& u, int wr, int wc, int fr, int fq) const {
#pragma unroll
        for (int ai = 0; ai < 2; ++ai)
#pragma unroll
            for (int m = 0; m < 4; ++m) { const int t = EPI_ROW(u, ai, m);
#pragma unroll
                for (int bj = 0; bj < 2; ++bj) { const int cc = u.pn * 256 + bj * 128 + wc * 32 + 8 * fq; const int h = cc >> 6, jj = cc & 63, i0 = jj >> 1;
                    f32x4 v0 = acc[ai][bj][m][0], v1 = acc[ai][bj][m][1];
                    const f32x4 cs = *(const f32x4*)(cosm + (size_t)t * 32 + i0), sn = *(const f32x4*)(sinm + (size_t)t * 32 + i0); rope4(v0, v1, cs, sn);
                    *(h8*)(Q + (size_t)t * 1536 + h * 192 + 128 + jj) = pack8(v0, v1); }
                asm volatile("" ::: "memory"); }
    }
};
struct EpiKV {
    static constexpr bool PERM = true; f16* Kp; f16* Vp;
    __device__ __forceinline__ void operator()(const f32x4 (&acc)[2][2][4][2], const pg8::Unit& u, int wr, int wc, int fr, int fq) const {
#pragma unroll
        for (int ai = 0; ai < 2; ++ai)
#pragma unroll
            for (int m = 0; m < 4; ++m) { const int t = EPI_ROW(u, ai, m);
#pragma unroll
                for (int bj = 0; bj < 2; ++bj) { const int c8 = u.pn * 256 + bj * 128 + wc * 32 + 8 * fq; const int h = c8 >> 8, j = c8 & 255;
                    f16* dst = (j < 128) ? (Kp + (size_t)t * 1536 + h * 192 + j) : (Vp + (size_t)t * 1024 + h * 128 + (j - 128));
                    *(h8*)dst = pack8(acc[ai][bj][m][0], acc[ai][bj][m][1]); }
                asm volatile("" ::: "memory"); }
    }
};
struct EpiPre {
    static constexpr bool PERM = false; const float* xres; const float* gmod; float* pre;
    __device__ __forceinline__ void operator()(const f32x4 (&acc)[2][2][4][2], const pg8::Unit& u, int wr, int wc, int fr, int fq) const {
#pragma unroll
        for (int ai = 0; ai < 2; ++ai)
#pragma unroll
            for (int m = 0; m < 4; ++m) { const int t = EPI_ROW(u, ai, m); const int b = t >> 12;
#pragma unroll
                for (int bj = 0; bj < 2; ++bj)
#pragma unroll
                    for (int n = 0; n < 2; ++n) { const int c = u.pn * 256 + bj * 128 + wc * 32 + n * 16 + 4 * fq;
                        const f32x4 gv = *(const f32x4*)(gmod + b * 6144 + c), xv = *(const f32x4*)(xres + (size_t)t * 1024 + c);
                        *(f32x4*)(pre + (size_t)t * 1024 + c) = xv * ALPHA + (gv + 1.0f) * acc[ai][bj][m][n]; }
                asm volatile("" ::: "memory"); }
    }
};
struct EpiUp {
    static constexpr bool PERM = true; f16* act;
    __device__ __forceinline__ void operator()(const f32x4 (&acc)[2][2][4][2], const pg8::Unit& u, int wr, int wc, int fr, int fq) const {
#pragma unroll
        for (int ai = 0; ai < 2; ++ai)
#pragma unroll
            for (int m = 0; m < 4; ++m) { const int r = EPI_ROW(u, ai, m);
#pragma unroll
                for (int bj = 0; bj < 2; ++bj) { const int c8 = u.pn * 256 + bj * 128 + wc * 32 + 8 * fq;
                    const f32x4 gq = acc[ai][bj][m][0], uq = acc[ai][bj][m][1]; h4 o;
#pragma unroll
                    for (int i = 0; i < 4; ++i) { const float gg = gq[i]; o[i] = (f16)(gg * __builtin_amdgcn_rcpf(1.0f + __expf(-gg)) * uq[i]); }
                    *(h4*)(act + (size_t)r * 2048 + (c8 >> 1)) = o; } }
    }
};
struct EpiDown {
    static constexpr bool PERM = true; f16* y; const float* gate;
    __device__ __forceinline__ void operator()(const f32x4 (&acc)[2][2][4][2], const pg8::Unit& u, int wr, int wc, int fr, int fq) const {
#pragma unroll
        for (int ai = 0; ai < 2; ++ai)
#pragma unroll
            for (int m = 0; m < 4; ++m) { const int r = EPI_ROW(u, ai, m); const float gt = gate[r];
#pragma unroll
                for (int bj = 0; bj < 2; ++bj) { const int c8 = u.pn * 256 + bj * 128 + wc * 32 + 8 * fq;
                    *(h8*)(y + (size_t)r * 1024 + c8) = pack8(acc[ai][bj][m][0] * gt, acc[ai][bj][m][1] * gt); }
                asm volatile("" ::: "memory"); }
    }
};
struct EpiDiffIn {
    static constexpr bool PERM = true; f16* qkv; const float* cosd; const float* sind;
    __device__ __forceinline__ void operator()(const f32x4 (&acc)[2][2][4][2], const pg8::Unit& u, int wr, int wc, int fr, int fq) const {
#pragma unroll
        for (int ai = 0; ai < 2; ++ai)
#pragma unroll
            for (int m = 0; m < 4; ++m) { const int t = EPI_ROW(u, ai, m);
#pragma unroll
                for (int bj = 0; bj < 2; ++bj) { const int c8 = u.pn * 256 + bj * 128 + wc * 32 + 8 * fq;
                    f32x4 v0 = acc[ai][bj][m][0], v1 = acc[ai][bj][m][1];
                    if (c8 < 2048 && (c8 & 63) < 16) { const int i0 = (c8 & 15) >> 1; const f32x4 cs = *(const f32x4*)(cosd + (size_t)t * 8 + i0), sn = *(const f32x4*)(sind + (size_t)t * 8 + i0); rope4(v0, v1, cs, sn); }
                    *(h8*)(qkv + (size_t)t * 3072 + c8) = pack8(v0, v1); }
                asm volatile("" ::: "memory"); }
    }
};

namespace att {
constexpr int QBLK = 32, KVBLK = 64, DV = 128;
constexpr float THR = 8.f;
constexpr size_t SHM_V = KVBLK * DV * 2;
#define SBAR() __builtin_amdgcn_sched_barrier(0)
__device__ __forceinline__ int crow(int r, int hi) { return (r & 3) + 8 * (r >> 2) + 4 * hi; }
__device__ __forceinline__ unsigned cvtpk(float lo, float hi) { unsigned r; asm volatile("v_cvt_pk_f16_f32 %0, %1, %2" : "=v"(r) : "v"(lo), "v"(hi)); return r; }
template <int DQK> struct Cfg {
    static constexpr int ND0 = DQK / 16, KRB = DQK * 2, NKCH = DQK / 64, KCPR = DQK / 8;
    static constexpr size_t SHM_K = (size_t)KVBLK * KRB;
    static constexpr float SCALE = DQK == 192 ? 0.07216878364870322f : 0.125f;
    static constexpr size_t SHM_TOTAL = 2 * SHM_V + 2 * SHM_K + NWAVES * 64 * 4;
};
template <int DQK> __device__ __forceinline__ void partialSM(f32x16& p0, f32x16& p1, float& m_reg, float& mn, float& alpha) {
    constexpr float SCALE = Cfg<DQK>::SCALE, C = SCALE * 1.4426950408889634f;
    float pmax = p0[0];
#pragma unroll
    for (int r = 1; r < 16; ++r) pmax = fmaxf(pmax, p0[r]);
#pragma unroll
    for (int r = 0; r < 16; ++r) pmax = fmaxf(pmax, p1[r]);
    { auto rr = __builtin_amdgcn_permlane32_swap(__float_as_uint(pmax), __float_as_uint(pmax), false, false);
      pmax = fmaxf(__uint_as_float(rr[0]), __uint_as_float(rr[1])); }
    if (__builtin_expect(__all(pmax - m_reg <= THR / SCALE), 1)) { mn = m_reg; alpha = 1.f; }
    else { mn = fmaxf(m_reg, pmax); alpha = __builtin_amdgcn_exp2f((m_reg - mn) * C); m_reg = mn; }
    const float mnC = -mn * C;
#pragma unroll
    for (int r = 0; r < 16; ++r) p0[r] = fmaf(p0[r], C, mnC);
#pragma unroll
    for (int r = 0; r < 16; ++r) p1[r] = fmaf(p1[r], C, mnC);
#pragma unroll
    for (int r = 0; r < 16; ++r) p0[r] = __builtin_amdgcn_exp2f(p0[r]);
}
__device__ __forceinline__ void finishSM(f32x16& p0, f32x16& p1, float alpha, float& l_reg, h8& pa0, h8& pa1, h8& pa2, h8& pa3) {
#pragma unroll
    for (int r = 0; r < 16; ++r) p1[r] = __builtin_amdgcn_exp2f(p1[r]);
    float ps = 0;
#pragma unroll
    for (int r = 0; r < 16; ++r) ps += p0[r];
#pragma unroll
    for (int r = 0; r < 16; ++r) ps += p1[r];
    { auto rr = __builtin_amdgcn_permlane32_swap(__float_as_uint(ps), __float_as_uint(ps), false, false);
      ps = __uint_as_float(rr[0]) + __uint_as_float(rr[1]); }
    l_reg = l_reg * alpha + ps;
#define PK4(P, BASE, OUT) do { unsigned a0 = cvtpk(P[BASE + 0], P[BASE + 1]), a1 = cvtpk(P[BASE + 2], P[BASE + 3]);   \
    unsigned b0 = cvtpk(P[BASE + 4], P[BASE + 5]), b1 = cvtpk(P[BASE + 6], P[BASE + 7]);                              \
    auto r0 = __builtin_amdgcn_permlane32_swap(a0, b0, false, false); auto r1 = __builtin_amdgcn_permlane32_swap(a1, b1, false, false); \
    u32x4 w = {r0[0], r1[0], r0[1], r1[1]}; OUT = *reinterpret_cast<h8*>(&w); } while (0)
    PK4(p0, 0, pa0); PK4(p0, 8, pa1); PK4(p1, 0, pa2); PK4(p1, 8, pa3);
#undef PK4
}
#define KSWZ(row, colB) ((row) * KRB + ((colB) ^ (((row) & 7) << 4)))
template <int DQK> __device__ __forceinline__ void qkt(f32x16& p0, f32x16& p1, const char* Ks, const h8* qr, int r32, int hi) {
    constexpr int KRB = Cfg<DQK>::KRB;
    p0 = f32x16{}; p1 = f32x16{};
#pragma unroll
    for (int d0 = 0; d0 < Cfg<DQK>::ND0; ++d0) { const int cb = (d0 * 16 + hi * 8) * 2;
        const h8 b0 = *reinterpret_cast<const h8*>(Ks + KSWZ(r32, cb));
        const h8 b1 = *reinterpret_cast<const h8*>(Ks + KSWZ(32 + r32, cb));
        p0 = __builtin_amdgcn_mfma_f32_32x32x16_f16(b0, qr[d0], p0, 0, 0, 0);
        p1 = __builtin_amdgcn_mfma_f32_32x32x16_f16(b1, qr[d0], p1, 0, 0, 0); }
}
__device__ __forceinline__ int v_st(int k, int c) { const int kk = (k & ~0xC) | ((k & 4) << 1) | ((k & 8) >> 1); return ((kk >> 3) * 4 + (c >> 5)) * 512 + ((kk & 7) * 32 + (c & 31)) * 2; }
__device__ __forceinline__ int v_rd_base(int lane) { return ((lane & 3) << 3) | (((lane >> 2) & 3) << 6) | (((lane >> 4) & 1) << 5) | (((lane >> 5) & 1) << 8); }
constexpr int v_rd_off(int d0, int ks, int half) { return d0 * 512 + ks * 4096 + half * 2048; }
template <int OFF> __device__ __forceinline__ s16x4 tr_read(int vb) {
    s16x4 r; asm volatile("ds_read_b64_tr_b16 %0, %1 offset:%2" : "=&v"(r) : "v"(vb), "i"(OFF) : "memory"); return r;
}
template <int D0> __device__ __forceinline__ void pv_one(f32x16& od, int vb, h8 pa0, h8 pa1, h8 pa2, h8 pa3) {
    const s16x4 l0 = tr_read<v_rd_off(D0, 0, 0)>(vb), h0 = tr_read<v_rd_off(D0, 0, 1)>(vb), l1 = tr_read<v_rd_off(D0, 1, 0)>(vb), h1 = tr_read<v_rd_off(D0, 1, 1)>(vb);
    const s16x4 l2 = tr_read<v_rd_off(D0, 2, 0)>(vb), h2_ = tr_read<v_rd_off(D0, 2, 1)>(vb), l3 = tr_read<v_rd_off(D0, 3, 0)>(vb), h3 = tr_read<v_rd_off(D0, 3, 1)>(vb);
    asm volatile("s_waitcnt lgkmcnt(0)" ::: "memory"); SBAR();
#define PKV(L, H) __builtin_bit_cast(h8, (__attribute__((ext_vector_type(8))) short){L[0], L[1], L[2], L[3], H[0], H[1], H[2], H[3]})
    od = __builtin_amdgcn_mfma_f32_32x32x16_f16(pa0, PKV(l0, h0), od, 0, 0, 0);
    od = __builtin_amdgcn_mfma_f32_32x32x16_f16(pa1, PKV(l1, h1), od, 0, 0, 0);
    od = __builtin_amdgcn_mfma_f32_32x32x16_f16(pa2, PKV(l2, h2_), od, 0, 0, 0);
    od = __builtin_amdgcn_mfma_f32_32x32x16_f16(pa3, PKV(l3, h3), od, 0, 0, 0);
#undef PKV
}
__device__ __forceinline__ void pv_d0(f32x16* o, int vb, h8 pa0, h8 pa1, h8 pa2, h8 pa3) {
    pv_one<0>(o[0], vb, pa0, pa1, pa2, pa3); pv_one<1>(o[1], vb, pa0, pa1, pa2, pa3); pv_one<2>(o[2], vb, pa0, pa1, pa2, pa3); pv_one<3>(o[3], vb, pa0, pa1, pa2, pa3);
}
template <int DQK, int LDQ, int LDK, int LDV, int LDO, int SDEPTH>
__device__ __forceinline__ void attn_body(const f16* Qb, const f16* Kh, const f16* Vh, f16* Ob, char* lds) {
    using C = Cfg<DQK>;
    constexpr int KRB = C::KRB, ND0 = C::ND0, NKCH = C::NKCH, KCPR = C::KCPR; constexpr size_t SHM_K = C::SHM_K;
    constexpr int seq = SEQ;
    int tid = threadIdx.x; asm volatile("" : "+v"(tid));
    const int wid = tid >> 6, lane = tid & 63, r32 = lane & 31, hi = lane >> 5;
    char* V_lds = lds; char* K_lds = lds + 2 * SHM_V;
    float* wsl = (float*)(lds + 2 * SHM_V + 2 * SHM_K) + wid * 64; float* li_l = wsl; float* al_l = wsl + 32;
    float m_reg = -1e30f, l_reg = 0; f32x16 o[4] = {}; h8 qr[ND0];
    const f16* Qw = Qb + (long)(wid * QBLK + r32) * LDQ + hi * 8;
#pragma unroll
    for (int d0 = 0; d0 < ND0; ++d0) qr[d0] = *reinterpret_cast<const h8*>(Qw + d0 * 16);
    const int sr = tid >> 4, sc = (tid & 15) * 8, vst0 = v_st(sr, sc), vst1 = v_st(32 + sr, sc);
    int krow[NKCH], kcb[NKCH];
#pragma unroll
    for (int i = 0; i < NKCH; ++i) { const int c = tid + i * 512; krow[i] = c / KCPR; kcb[i] = (c % KCPR) * 16; }
    const int vb0 = (int)(uintptr_t)V_lds + v_rd_base(lane);
    struct { h8 vs0, vs1; h8 ks[NKCH]; } sr_[SDEPTH];
#define SLOAD(i, k0) do { sr_[i].vs0 = *reinterpret_cast<const h8*>(&Vh[(long)((k0) + sr) * LDV + sc]); sr_[i].vs1 = *reinterpret_cast<const h8*>(&Vh[(long)((k0) + 32 + sr) * LDV + sc]); \
    _Pragma("unroll") for (int _c = 0; _c < NKCH; ++_c) sr_[i].ks[_c] = *reinterpret_cast<const h8*>((const char*)Kh + (long)((k0) + krow[_c]) * (LDK * 2) + kcb[_c]); } while (0)
#define SWRITE(b, i) do { *(h8*)(V_lds + (b) * SHM_V + vst0) = sr_[i].vs0; *(h8*)(V_lds + (b) * SHM_V + vst1) = sr_[i].vs1; \
    _Pragma("unroll") for (int _c = 0; _c < NKCH; ++_c) *(h8*)(K_lds + (b) * SHM_K + KSWZ(krow[_c], kcb[_c])) = sr_[i].ks[_c]; } while (0)
#define SWAIT() do { if constexpr (SDEPTH == 2) { if constexpr (NKCH == 3) asm volatile("s_waitcnt vmcnt(5)" ::: "memory"); else asm volatile("s_waitcnt vmcnt(3)" ::: "memory"); } \
    else asm volatile("s_waitcnt vmcnt(0)" ::: "memory"); } while (0)
#define RESC(a) do { if (__any((a) < 1.f)) { if (hi == 0) al_l[r32] = (a); asm volatile("s_waitcnt lgkmcnt(0)" ::: "memory"); \
    _Pragma("unroll") for (int d = 0; d < 4; ++d) _Pragma("unroll") for (int r = 0; r < 16; ++r) o[d][r] *= al_l[crow(r, hi)]; } } while (0)
    f32x16 pA0, pA1, pB0, pB1; float mnA, mnB, alA, alB; h8 pa0, pa1, pa2, pa3; constexpr int NT = seq / KVBLK;
    constexpr int SE = 0, SO = SDEPTH - 1;
    SLOAD(SE, 0); asm volatile("s_waitcnt vmcnt(0)" ::: "memory"); SWRITE(0, SE); __syncthreads();
    qkt<DQK>(pA0, pA1, K_lds, qr, r32, hi); partialSM<DQK>(pA0, pA1, m_reg, mnA, alA);
    SLOAD(SO, KVBLK); if constexpr (SDEPTH == 2) { if (2 < NT) SLOAD(SE, 2 * KVBLK); }
    SWAIT(); SWRITE(1, SO); __syncthreads();
    for (int j = 1; j + 1 < NT; j += 2) {
        SBAR(); qkt<DQK>(pB0, pB1, K_lds + SHM_K, qr, r32, hi);
        finishSM(pA0, pA1, alA, l_reg, pa0, pa1, pa2, pa3); SBAR();
        SLOAD(SO, (j + SDEPTH) * KVBLK); SBAR();
        pv_d0(o, vb0, pa0, pa1, pa2, pa3); partialSM<DQK>(pB0, pB1, m_reg, mnB, alB);
        __syncthreads(); SWAIT(); SWRITE(0, SE);
        RESC(alB); __syncthreads();
        SBAR(); qkt<DQK>(pA0, pA1, K_lds, qr, r32, hi);
        finishSM(pB0, pB1, alB, l_reg, pa0, pa1, pa2, pa3); SBAR();
        if (SDEPTH == 1 || j + 3 < NT) SLOAD(SE, (j + 1 + SDEPTH) * KVBLK); SBAR();
        pv_d0(o, vb0 + (int)SHM_V, pa0, pa1, pa2, pa3); partialSM<DQK>(pA0, pA1, m_reg, mnA, alA);
        __syncthreads(); SWAIT(); SWRITE(1, SO);
        RESC(alA); __syncthreads();
    }
    SBAR(); qkt<DQK>(pB0, pB1, K_lds + SHM_K, qr, r32, hi);
    finishSM(pA0, pA1, alA, l_reg, pa0, pa1, pa2, pa3); SBAR();
    pv_d0(o, vb0, pa0, pa1, pa2, pa3); partialSM<DQK>(pB0, pB1, m_reg, mnB, alB);
    __syncthreads(); RESC(alB);
    finishSM(pB0, pB1, alB, l_reg, pa0, pa1, pa2, pa3); SBAR();
    pv_d0(o, vb0 + (int)SHM_V, pa0, pa1, pa2, pa3);
    if (hi == 0) li_l[r32] = l_reg; asm volatile("s_waitcnt lgkmcnt(0)" ::: "memory");
    float rli[16];
#pragma unroll
    for (int r = 0; r < 16; ++r) rli[r] = __builtin_amdgcn_rcpf(li_l[crow(r, hi)]);
    f16* Ow = Ob + (long)(wid * QBLK) * LDO;
#pragma unroll
    for (int r = 0; r < 16; ++r) { const int orow = crow(r, hi);
#pragma unroll
        for (int d0 = 0; d0 < 4; ++d0) Ow[(long)orow * LDO + d0 * 32 + r32] = (f16)(o[d0][r] * rli[r]); }
    asm volatile("s_waitcnt vmcnt(0) lgkmcnt(0)" ::: "memory");
    __syncthreads();
#undef SLOAD
#undef SWRITE
#undef SWAIT
#undef RESC
}

template <int DQK, int LDQ, int LDK, int LDV, int LDO>
__device__ __forceinline__ void attn_body_simple(const f16* Qb, const f16* Kh, const f16* Vh, f16* Ob, char* lds) {
    using C = Cfg<DQK>;
    constexpr int KRB = C::KRB, ND0 = C::ND0, NKCH = C::NKCH, KCPR = C::KCPR; constexpr size_t SHM_K = C::SHM_K;
    int tid = threadIdx.x; asm volatile("" : "+v"(tid));
    const int wid = tid >> 6, lane = tid & 63, r32 = lane & 31, hi = lane >> 5;
    char* V_lds = lds; char* K_lds = lds + 2 * SHM_V;
    float* wsl = (float*)(lds + 2 * SHM_V + 2 * SHM_K) + wid * 64; float* li_l = wsl; float* al_l = wsl + 32;
    float m_reg = -1e30f, l_reg = 0; f32x16 o[4] = {}; h8 qr[ND0];
    const f16* Qw = Qb + (long)(wid * QBLK + r32) * LDQ + hi * 8;
#pragma unroll
    for (int d0 = 0; d0 < ND0; ++d0) qr[d0] = *reinterpret_cast<const h8*>(Qw + d0 * 16);
    const int sr = tid >> 4, sc = (tid & 15) * 8, vst0 = v_st(sr, sc), vst1 = v_st(32 + sr, sc);
    int krow[NKCH], kcb[NKCH];
#pragma unroll
    for (int i = 0; i < NKCH; ++i) { const int c = tid + i * 512; krow[i] = c / KCPR; kcb[i] = (c % KCPR) * 16; }
    const int vb0 = (int)(uintptr_t)V_lds + v_rd_base(lane);
    h8 vs0, vs1, ks[NKCH];
#define SLOAD1(k0) do { vs0 = *reinterpret_cast<const h8*>(&Vh[(long)((k0) + sr) * LDV + sc]); vs1 = *reinterpret_cast<const h8*>(&Vh[(long)((k0) + 32 + sr) * LDV + sc]); \
    _Pragma("unroll") for (int _c = 0; _c < NKCH; ++_c) ks[_c] = *reinterpret_cast<const h8*>((const char*)Kh + (long)((k0) + krow[_c]) * (LDK * 2) + kcb[_c]); } while (0)
#define SWRITE1(b) do { *(h8*)(V_lds + (b) * SHM_V + vst0) = vs0; *(h8*)(V_lds + (b) * SHM_V + vst1) = vs1; \
    _Pragma("unroll") for (int _c = 0; _c < NKCH; ++_c) *(h8*)(K_lds + (b) * SHM_K + KSWZ(krow[_c], kcb[_c])) = ks[_c]; } while (0)
    constexpr int NT = SEQ / KVBLK;
    SLOAD1(0); asm volatile("s_waitcnt vmcnt(0)" ::: "memory"); SWRITE1(0); __syncthreads();
#pragma unroll 1
    for (int j = 0; j < NT; ++j) {
        const int cb = j & 1;
        if (j + 1 < NT) SLOAD1((j + 1) * KVBLK);
        SBAR();
        f32x16 p0, p1; float mn, al; h8 pa0, pa1, pa2, pa3;
        qkt<DQK>(p0, p1, K_lds + cb * SHM_K, qr, r32, hi);
        partialSM<DQK>(p0, p1, m_reg, mn, al);
        if (__any(al < 1.f)) { if (hi == 0) al_l[r32] = al; asm volatile("s_waitcnt lgkmcnt(0)" ::: "memory");
#pragma unroll
            for (int d = 0; d < 4; ++d)
#pragma unroll
                for (int r = 0; r < 16; ++r) o[d][r] *= al_l[crow(r, hi)]; }
        finishSM(p0, p1, al, l_reg, pa0, pa1, pa2, pa3); SBAR();
        pv_d0(o, vb0 + cb * (int)SHM_V, pa0, pa1, pa2, pa3);
        if (j + 1 < NT) { SWRITE1(cb ^ 1); }
        __syncthreads();
    }
    if (hi == 0) li_l[r32] = l_reg; asm volatile("s_waitcnt lgkmcnt(0)" ::: "memory");
    float rli[16];
#pragma unroll
    for (int r = 0; r < 16; ++r) rli[r] = __builtin_amdgcn_rcpf(li_l[crow(r, hi)]);
    f16* Ow = Ob + (long)(wid * QBLK) * LDO;
#pragma unroll
    for (int r = 0; r < 16; ++r) { const int orow = crow(r, hi);
#pragma unroll
        for (int d0 = 0; d0 < 4; ++d0) Ow[(long)orow * LDO + d0 * 32 + r32] = (f16)(o[d0][r] * rli[r]); }
    asm volatile("s_waitcnt vmcnt(0) lgkmcnt(0)" ::: "memory");
    __syncthreads();
#undef SLOAD1
#undef SWRITE1
}
#undef KSWZ
#undef SBAR
}

struct Args { const void* in[22]; float* out; unsigned char* ws; int ph_lo, ph_hi, li, pad; };
typedef const __attribute__((address_space(4))) Args* KArgs;
__device__ __forceinline__ KArgs kargs() { KArgs p = (KArgs)__builtin_amdgcn_kernarg_segment_ptr(); asm volatile("" : "+s"(p)); return p; }
struct Frame {
    LAS unsigned char* lds; char* ldsg;
    int tid, lane, wave, vcu, G;
    unsigned char* ws;
};
extern __shared__ __attribute__((aligned(16))) unsigned char g_lds[];
__device__ __forceinline__ Frame mkframe(KArgs a) {
    Frame F; int t = threadIdx.x; asm volatile("" : "+v"(t));
    F.lds = (LAS unsigned char*)g_lds; F.ldsg = (char*)g_lds;
    F.tid = t; F.lane = t & 63; F.wave = __builtin_amdgcn_readfirstlane(t >> 6);
    int g = gridDim.x, bx = blockIdx.x; asm volatile("" : "+s"(g), "+s"(bx));
    F.G = g; F.vcu = (g % 8 == 0) ? (bx % 8) * (g / 8) + bx / 8 : bx;
    F.ws = a->ws;
    return F;
}

__device__ __forceinline__ void sincos_d(double a, float& s, float& c) {
    const double k = __builtin_rint(a * 0.63661977236758134308);
    double r = __builtin_fma(-k, 1.57079632679489655800e+00, a); r = __builtin_fma(-k, 6.12323399573676603587e-17, r);
    const double r2 = r * r;
    double sp = -7.6471637318198164759e-13;
    sp = __builtin_fma(sp, r2, 1.6059043836821614599e-10);
    sp = __builtin_fma(sp, r2, -2.5052108385441718775e-08);
    sp = __builtin_fma(sp, r2, 2.7557319223985890653e-06);
    sp = __builtin_fma(sp, r2, -1.9841269841269841270e-04);
    sp = __builtin_fma(sp, r2, 8.3333333333333333333e-03);
    sp = __builtin_fma(sp, r2, -1.6666666666666666667e-01);
    const double sr = __builtin_fma(sp * r2, r, r);
    double cp = 4.7794773323873852974e-14;
    cp = __builtin_fma(cp, r2, -1.1470745597729724714e-11);
    cp = __builtin_fma(cp, r2, 2.0876756987868098979e-09);
    cp = __builtin_fma(cp, r2, -2.7557319223985890653e-07);
    cp = __builtin_fma(cp, r2, 2.4801587301587301587e-05);
    cp = __builtin_fma(cp, r2, -1.3888888888888888889e-03);
    cp = __builtin_fma(cp, r2, 4.1666666666666666667e-02);
    cp = __builtin_fma(cp, r2, -0.5);
    const double cr = __builtin_fma(cp, r2, 1.0);
    const int q = (int)((long long)k & 3);
    const double ss = (q & 1) ? cr : sr, cc = (q & 1) ? sr : cr;
    s = (float)((q & 2) ? -ss : ss); c = (float)(((q + 1) & 2) ? -cc : cc);
}
__device__ const double INV_M[32] = {
    1.0, 0.7498942093324559, 0.5623413251903491, 0.4216965034285822, 0.31622776601683794, 0.23713737056616552, 0.1778279410038923, 0.1333521432163324,
    0.1, 0.07498942093324558, 0.05623413251903491, 0.04216965034285822, 0.03162277660168379, 0.023713737056616554, 0.01778279410038923, 0.01333521432163324,
    0.01, 0.007498942093324559, 0.005623413251903491, 0.004216965034285822, 0.0031622776601683794, 0.0023713737056616554, 0.001778279410038923, 0.001333521432163324,
    0.001, 0.0007498942093324559, 0.0005623413251903491, 0.0004216965034285822, 0.00031622776601683794, 0.00023713737056616554, 0.0001778279410038923, 0.0001333521432163324 };
__device__ const double INV_D[8] = { 1.0, 0.19392274474868576, 0.03760603093086393, 0.007292664737217109, 0.001414213562373095, 0.0002742481756762073, 5.318295896944988e-05, 1.031338537721246e-05 };

template <class FN>
__device__ __forceinline__ void tr_item(const float* W, int Nsrc, int K, f16* WT, FN srccol, LAS float* scr, int kb, int nb, int lane) {
    const int k0 = 64 * kb, n0 = 32 * nb;
    const int scol = srccol(n0 + (lane & 31));
#pragma unroll 8
    for (int i = 0; i < 32; ++i) { const int kk = 2 * i + (lane >> 5); scr[kk * 33 + (lane & 31)] = scol >= 0 ? W[(size_t)(k0 + kk) * Nsrc + scol] : 0.f; }
    LDS_WAIT(); asm volatile("" ::: "memory");
    const int c = lane & 7;
#pragma unroll
    for (int j = 0; j < 4; ++j) { const int n = (lane >> 3) + 8 * j; const LAS float* s = scr + (8 * c) * 33 + n;
        h8 o; o[0] = (f16)s[0 * 33]; o[1] = (f16)s[1 * 33]; o[2] = (f16)s[2 * 33]; o[3] = (f16)s[3 * 33]; o[4] = (f16)s[4 * 33]; o[5] = (f16)s[5 * 33]; o[6] = (f16)s[6 * 33]; o[7] = (f16)s[7 * 33];
        *(h8*)(WT + (size_t)(n0 + n) * K + k0 + 8 * c) = o; }
    LDS_WAIT(); asm volatile("" ::: "memory");
}
struct ColId { __device__ __forceinline__ int operator()(int n) const { return n; } };
struct ColPad704 { __device__ __forceinline__ int operator()(int n) const { return n < 704 ? n : -1; } };
struct ColUq { __device__ __forceinline__ int operator()(int n) const { if (n < 1024) return (n >> 7) * 192 + (n & 127); const int cc = n - 1024, h = cc >> 6, jj = cc & 63; return h * 192 + 128 + (jj >> 1) + 32 * (jj & 1); } };
struct ColDiff { __device__ __forceinline__ int operator()(int n) const { if (n >= 2048) return n; const int off = n & 63; if (off >= 16) return n; return (n & ~63) + (off >> 1) + 8 * (off & 1); } };
struct ColMoeIn { __device__ __forceinline__ int operator()(int n) const { const int w = n & 7, f = (n >> 3) * 4 + (w & 3); return (w < 4) ? f : 2048 + f; } };

__device__ __forceinline__ void p0_prologue() {
    const KArgs a = kargs(); const Frame F = mkframe(a);
    const int tid = F.tid, lane = F.lane;
    {
        const float* cin = (const float*)a->in[1]; const float* ada_w = (const float*)a->in[3]; const float* ada_b = (const float*)a->in[4];
        float* mods = (float*)(F.ws + WS_MODS);
        LAS float* sc = (LAS float*)F.lds; LAS float* red = (LAS float*)(F.lds + 16384);
        for (int i = tid; i < 4096; i += NTHREADS) { const float v = cin[i]; sc[i] = v / (1.0f + __expf(-v)); }
        __syncthreads();
        for (int cb = blockIdx.x; cb < 256; cb += F.G) {
            const int f0 = cb * 48, l = f0 / 6144, e0 = f0 % 6144; const int g = tid / 48, cc = tid % 48;
            if (g < 10) { float a0 = 0.f, a1 = 0.f, a2 = 0.f, a3 = 0.f; const float* wp = ada_w + (size_t)l * 1024 * 6144 + e0 + cc;
#pragma unroll 4
                for (int d = g; d < 1024; d += 10) { const float w = wp[(size_t)d * 6144]; a0 += sc[d] * w; a1 += sc[1024 + d] * w; a2 += sc[2048 + d] * w; a3 += sc[3072 + d] * w; }
                LAS float* rp = red + (g * 48 + cc) * 4; rp[0] = a0; rp[1] = a1; rp[2] = a2; rp[3] = a3; }
            __syncthreads();
            if (tid < 192) { const int c2 = tid % 48, b = tid / 48; float s = 0.f;
#pragma unroll
                for (int gg = 0; gg < 10; ++gg) s += red[(gg * 48 + c2) * 4 + b];
                mods[(size_t)(l * 4 + b) * 6144 + e0 + c2] = s + ada_b[l * 6144 + e0 + c2]; }
            __syncthreads();
        }
    }
    {
        const int* pos = (const int*)a->in[2];
        float* cosm = (float*)(F.ws + WS_COSM); float* sinm = (float*)(F.ws + WS_SINM); float* cosd = (float*)(F.ws + WS_COSD); float* sind = (float*)(F.ws + WS_SIND);
        for (int i = blockIdx.x * NTHREADS + tid; i < T * 40; i += F.G * NTHREADS) {
            const int t = i / 40, j = i % 40; const double p = (double)pos[t]; float s, c;
            if (j < 32) { sincos_d(p * INV_M[j], s, c); cosm[(size_t)t * 32 + j] = c; sinm[(size_t)t * 32 + j] = s; }
            else { sincos_d(p * INV_D[j - 32], s, c); cosd[(size_t)t * 8 + (j - 32)] = c; sind[(size_t)t * 8 + (j - 32)] = s; }
        }
    }
    {
        LAS float* scr = (LAS float*)(F.lds + 32768 + F.wave * 8704);
        const int gw = F.vcu * NWAVES + F.wave, NGW = F.G * NWAVES;
        constexpr int I0 = 16 * 24, I1 = 6 * 48, I2 = 4 * 64, I3 = 16 * 32, I4 = 16 * 96, I5 = 16 * 32;
        constexpr int ISM = I0 + I1 + I2 + I3 + I4 + I5;
        constexpr int IMI = 16 * 128, IMO = 32 * 32;
        constexpr int NITEMS = ISM + 32 * IMI + 32 * IMO;
        for (int it = gw; it < NITEMS; it += NGW) {
            int r = it;
            if (r < I0) { tr_item((const float*)a->in[9], 704, 1024, (f16*)(F.ws + WS_WIN0), ColPad704(), scr, r / 24, r % 24, lane); continue; } r -= I0;
            if (r < I1) { tr_item((const float*)a->in[12], 1536, 384, (f16*)(F.ws + WS_WUQ), ColUq(), scr, r / 48, r % 48, lane); continue; } r -= I1;
            if (r < I2) { tr_item((const float*)a->in[13], 2048, 256, (f16*)(F.ws + WS_WUKV), ColId(), scr, r / 64, r % 64, lane); continue; } r -= I2;
            if (r < I3) { tr_item((const float*)a->in[14], 1024, 1024, (f16*)(F.ws + WS_WO0), ColId(), scr, r / 32, r % 32, lane); continue; } r -= I3;
            if (r < I4) { tr_item((const float*)a->in[15], 3072, 1024, (f16*)(F.ws + WS_WIN1), ColDiff(), scr, r / 96, r % 96, lane); continue; } r -= I4;
            if (r < I5) { tr_item((const float*)a->in[18], 1024, 1024, (f16*)(F.ws + WS_WO1), ColId(), scr, r / 32, r % 32, lane); continue; } r -= I5;
            if (r < 32 * IMI) { const int mat = r / IMI, rr = r % IMI;
                tr_item((const float*)a->in[20] + (size_t)mat * 1024 * 4096, 4096, 1024, (f16*)(F.ws + WS_MOEIN) + (size_t)mat * 4096 * 1024, ColMoeIn(), scr, rr / 128, rr % 128, lane); continue; }
            r -= 32 * IMI;
            { const int mat = r / IMO, rr = r % IMO;
                tr_item((const float*)a->in[21] + (size_t)mat * 2048 * 1024, 1024, 2048, (f16*)(F.ws + WS_MOEOUT) + (size_t)mat * 1024 * 2048, ColId(), scr, rr / 32, rr % 32, lane); }
        }
    }
}

__device__ __forceinline__ void mod_rows_p1() {
    const KArgs a = kargs(); const Frame F = mkframe(a);
    const float* x = (const float*)a->in[0]; const float* mods_l = (const float*)(F.ws + WS_MODS); f16* out = (f16*)(F.ws + WS_HA);
    const int gw = F.vcu * NWAVES + F.wave, NGW = F.G * NWAVES, lane = F.lane;
    for (int m0 = gw; m0 < T; m0 += 2 * NGW) {
        f32x4 v[2][4];
#pragma unroll
        for (int u = 0; u < 2; ++u) { const int m = m0 + u * NGW; if (m < T) {
#pragma unroll
            for (int j = 0; j < 4; ++j) v[u][j] = *(const f32x4*)(x + (size_t)m * DM + 4 * lane + 256 * j); } }
#pragma unroll
        for (int u = 0; u < 2; ++u) { const int m = m0 + u * NGW; if (m < T) { const float* mb = mods_l + (m >> 12) * 6144;
#pragma unroll
            for (int j = 0; j < 4; ++j) { const int c = 4 * lane + 256 * j; const f32x4 sh = *(const f32x4*)(mb + c), sc = *(const f32x4*)(mb + 1024 + c);
                const f32x4 h = v[u][j] * (sc + 1.0f) + sh; h4 o; o[0] = (f16)h[0]; o[1] = (f16)h[1]; o[2] = (f16)h[2]; o[3] = (f16)h[3];
                *(h4*)(out + (size_t)m * DM + c) = o; } } }
    }
}

__device__ __forceinline__ void latent_prep() {
    const KArgs a = kargs(); const Frame F = mkframe(a);
    const float* lat = (const float*)(F.ws + WS_LAT); const float* qn = (const float*)a->in[10]; const float* kvn = (const float*)a->in[11];
    f16* cqn = (f16*)(F.ws + WS_CQN); f16* ckvn = (f16*)(F.ws + WS_CKVN); f16* Kp = (f16*)(F.ws + WS_K);
    const float* cosm = (const float*)(F.ws + WS_COSM); const float* sinm = (const float*)(F.ws + WS_SINM);
    const int gw = F.vcu * NWAVES + F.wave, NGW = F.G * NWAVES, lane = F.lane;
    for (int m = gw; m < T; m += NGW) { const float* row = lat + (size_t)m * 768;
        const f32x4 q0 = *(const f32x4*)(row + 4 * lane); f32x4 q1 = (f32x4){0.f, 0.f, 0.f, 0.f}; if (lane < 32) q1 = *(const f32x4*)(row + 256 + 4 * lane);
        const f32x4 kv = *(const f32x4*)(row + 384 + 4 * lane);
        float sq = (q0[0] * q0[0] + q0[1] * q0[1]) + (q0[2] * q0[2] + q0[3] * q0[3]) + (q1[0] * q1[0] + q1[1] * q1[1]) + (q1[2] * q1[2] + q1[3] * q1[3]);
        float sk = (kv[0] * kv[0] + kv[1] * kv[1]) + (kv[2] * kv[2] + kv[3] * kv[3]);
        sq = wave_sum(sq); sk = wave_sum(sk);
        const float rq = 1.0f / sqrtf(sq * (1.0f / 384.0f) + LAT_EPS), rk = 1.0f / sqrtf(sk * (1.0f / 256.0f) + LAT_EPS);
        { const f32x4 g = *(const f32x4*)(qn + 4 * lane); h4 o; o[0] = (f16)(q0[0] * rq * g[0]); o[1] = (f16)(q0[1] * rq * g[1]); o[2] = (f16)(q0[2] * rq * g[2]); o[3] = (f16)(q0[3] * rq * g[3]);
          *(h4*)(cqn + (size_t)m * 384 + 4 * lane) = o; }
        if (lane < 32) { const f32x4 g = *(const f32x4*)(qn + 256 + 4 * lane); h4 o; o[0] = (f16)(q1[0] * rq * g[0]); o[1] = (f16)(q1[1] * rq * g[1]); o[2] = (f16)(q1[2] * rq * g[2]); o[3] = (f16)(q1[3] * rq * g[3]);
          *(h4*)(cqn + (size_t)m * 384 + 256 + 4 * lane) = o; }
        { const f32x4 g = *(const f32x4*)(kvn + 4 * lane); h4 o; o[0] = (f16)(kv[0] * rk * g[0]); o[1] = (f16)(kv[1] * rk * g[1]); o[2] = (f16)(kv[2] * rk * g[2]); o[3] = (f16)(kv[3] * rk * g[3]);
          *(h4*)(ckvn + (size_t)m * 256 + 4 * lane) = o; }
        if (lane < 32) { const float x1 = row[640 + lane], x2 = row[672 + lane], cs = cosm[(size_t)m * 32 + lane], sn = sinm[(size_t)m * 32 + lane];
            h2 o; o[0] = (f16)(x1 * cs - x2 * sn); o[1] = (f16)(x2 * cs + x1 * sn);
#pragma unroll
            for (int h = 0; h < 8; ++h) *(h2*)(Kp + (size_t)m * 1536 + h * 192 + 128 + 2 * lane) = o; }
    }
}

__device__ __forceinline__ void ln_router(int l) {
    const KArgs a = kargs(); const Frame F = mkframe(a);
    const float* lng = (const float*)a->in[5] + l * DM; const float* lnb = (const float*)a->in[6] + l * DM; const float* router_w = (const float*)a->in[19] + (size_t)l * DM * NE;
    const float* mods_l = (const float*)(F.ws + WS_MODS) + (size_t)l * 4 * 6144;
    const float* pre = (const float*)(F.ws + WS_PRE); float* x1 = (float*)(F.ws + WS_X1); f16* hB = (f16*)(F.ws + WS_HB); float* aff = (float*)(F.ws + WS_AFF);
    LAS float* rwT = (LAS float*)F.lds;
    for (int i = F.tid; i < 16384; i += NTHREADS) { const int d = i >> 4, e = i & 15; rwT[e * 1024 + d] = router_w[i]; }
    __syncthreads();
    const int gw = F.vcu * NWAVES + F.wave, NGW = F.G * NWAVES, lane = F.lane;
    for (int m0 = gw; m0 < T; m0 += 2 * NGW) {
        f32x4 vv[2][4];
#pragma unroll
        for (int u = 0; u < 2; ++u) { const int m = m0 + u * NGW; if (m < T) {
#pragma unroll
            for (int j = 0; j < 4; ++j) vv[u][j] = *(const f32x4*)(pre + (size_t)m * DM + 4 * lane + 256 * j); } }
#pragma unroll
        for (int u = 0; u < 2; ++u) { const int m = m0 + u * NGW; if (m < T) {
        const int b = m >> 12, s_ = m & 4095; const float* mb = mods_l + b * 6144;
        f32x4 v[4]; float s = 0.f;
#pragma unroll
        for (int j = 0; j < 4; ++j) { v[j] = vv[u][j]; s += (v[j][0] + v[j][1]) + (v[j][2] + v[j][3]); }
        const float mean = wave_sum(s) * (1.f / DM); float s2 = 0.f;
#pragma unroll
        for (int j = 0; j < 4; ++j) { v[j] = v[j] - mean; s2 += (v[j][0] * v[j][0] + v[j][1] * v[j][1]) + (v[j][2] * v[j][2] + v[j][3] * v[j][3]); }
        const float rstd = 1.0f / sqrtf(wave_sum(s2) * (1.f / DM) + LN_EPS);
        float lg[16];
#pragma unroll
        for (int e = 0; e < 16; ++e) lg[e] = 0.f;
#pragma unroll
        for (int j = 0; j < 4; ++j) { const int c = 4 * lane + 256 * j;
            const f32x4 g = *(const f32x4*)(lng + c), bb = *(const f32x4*)(lnb + c), sh = *(const f32x4*)(mb + 3072 + c), sc = *(const f32x4*)(mb + 4096 + c);
            const f32x4 xn = v[j] * rstd * g + bb; *(f32x4*)(x1 + (size_t)m * DM + c) = xn;
            const f32x4 h = xn * (sc + 1.0f) + sh; h4 o; o[0] = (f16)h[0]; o[1] = (f16)h[1]; o[2] = (f16)h[2]; o[3] = (f16)h[3]; *(h4*)(hB + (size_t)m * DM + c) = o;
#pragma unroll
            for (int e = 0; e < 16; ++e) { const f32x4 w = *(const LAS f32x4*)(rwT + e * 1024 + c); lg[e] += (h[0] * w[0] + h[1] * w[1]) + (h[2] * w[2] + h[3] * w[3]); }
            asm volatile("" ::: "memory"); }
        float mx = -1e30f;
#pragma unroll
        for (int e = 0; e < 16; ++e) { lg[e] = wave_sum(lg[e]); mx = fmaxf(mx, lg[e]); }
        float den = 0.f;
#pragma unroll
        for (int e = 0; e < 16; ++e) { lg[e] = __expf(lg[e] - mx); den += lg[e]; }
        const float rden = 1.0f / den; float mine = 0.f;
#pragma unroll
        for (int e = 0; e < 16; ++e) mine = (lane == e) ? lg[e] * rden : mine;
        if (lane < 16) aff[(size_t)(b * 16 + lane) * SEQ + s_] = mine;
        } }
    }
    __syncthreads();
}

__device__ __forceinline__ int block_excl_scan(int v, LAS int* tmp, int tid, int& total) {
    const int lane = tid & 63, wid = tid >> 6; int x = v;
#pragma unroll
    for (int o = 1; o < 64; o <<= 1) { const int y = __shfl_up(x, o); if (lane >= o) x += y; }
    if (lane == 63) tmp[wid] = x;
    __syncthreads();
    int base = 0, tot = 0;
#pragma unroll
    for (int w = 0; w < 8; ++w) { const int t = tmp[w]; if (w < wid) base += t; tot += t; }
    __syncthreads();
    total = tot; return base + x - v;
}
__device__ __forceinline__ void topk_phase() {
    const KArgs a = kargs(); const Frame F = mkframe(a);
    const float* aff = (const float*)(F.ws + WS_AFF); float* gate = (float*)(F.ws + WS_GATE); int* rowtok = (int*)(F.ws + WS_ROWTOK); int* inv = (int*)(F.ws + WS_INV);
    LAS unsigned* hist = (LAS unsigned*)F.lds; LAS unsigned* selw = hist + 256; LAS int* tmp = (LAS int*)(hist + 272);
    const int tid = F.tid;
    for (int p = blockIdx.x; p < NB * NE; p += F.G) { const int b = p >> 4, e = p & 15;
        const float* ap = aff + (size_t)p * SEQ + 8 * tid; unsigned key[8];
        { const f32x4 a0 = *(const f32x4*)ap, a1 = *(const f32x4*)(ap + 4);
          key[0] = __float_as_uint(a0[0]); key[1] = __float_as_uint(a0[1]); key[2] = __float_as_uint(a0[2]); key[3] = __float_as_uint(a0[3]);
          key[4] = __float_as_uint(a1[0]); key[5] = __float_as_uint(a1[1]); key[6] = __float_as_uint(a1[2]); key[7] = __float_as_uint(a1[3]); }
        unsigned prefix = 0u, kk = CAP;
        for (int pass = 0; pass < 4; ++pass) { const int shift = 24 - 8 * pass;
            if (tid < 256) hist[tid] = 0u;
            __syncthreads();
#pragma unroll
            for (int j = 0; j < 8; ++j) { const bool match = (pass == 0) || ((key[j] >> (shift + 8)) == prefix); if (match) atomicAdd((unsigned*)&hist[(key[j] >> shift) & 255u], 1u); }
            __syncthreads();
            if (tid < 256) { unsigned S = 0u; for (int j = 0; j <= tid; ++j) S += hist[255 - j]; const unsigned Sp = S - hist[255 - tid];
                if (Sp < kk && kk <= S) { selw[0] = 255u - (unsigned)tid; selw[1] = kk - Sp; } }
            __syncthreads();
            prefix = (prefix << 8) | selw[0]; kk = selw[1];
            __syncthreads();
        }
        int ce = 0;
#pragma unroll
        for (int j = 0; j < 8; ++j) ce += (key[j] == prefix) ? 1 : 0;
        int tot; int eqr = block_excl_scan(ce, tmp, tid, tot);
        unsigned selm = 0u; int cs = 0;
#pragma unroll
        for (int j = 0; j < 8; ++j) { bool sel = key[j] > prefix; if (key[j] == prefix) { sel = (unsigned)eqr < kk; ++eqr; } if (sel) { selm |= 1u << j; ++cs; } }
        int slot = block_excl_scan(cs, tmp, tid, tot);
#pragma unroll
        for (int j = 0; j < 8; ++j) { const int s_ = 8 * tid + j; const int tok = b * SEQ + s_; const bool sel = (selm >> j) & 1u;
            if (sel) { const int row = e * EROWS + b * CAP + slot; rowtok[row] = tok; gate[row] = __uint_as_float(key[j]); inv[(size_t)tok * 16 + e] = slot; ++slot; }
            else inv[(size_t)tok * 16 + e] = -1; }
        __syncthreads();
    }
}
__device__ __forceinline__ void gather_rows() {
    const KArgs a = kargs(); const Frame F = mkframe(a);
    const int* rowtok = (const int*)(F.ws + WS_ROWTOK); const f16* hB = (const f16*)(F.ws + WS_HB); f16* xe = (f16*)(F.ws + WS_XE);
    const int gw = F.vcu * NWAVES + F.wave, NGW = F.G * NWAVES, lane = F.lane;
    for (int r0 = gw; r0 < MROWS; r0 += 4 * NGW) {
        int tok[4]; h8 d0[4], d1[4];
#pragma unroll
        for (int u = 0; u < 4; ++u) { const int r = r0 + u * NGW; tok[u] = (r < MROWS) ? rowtok[r] : 0; }
#pragma unroll
        for (int u = 0; u < 4; ++u) { d0[u] = *(const h8*)(hB + (size_t)tok[u] * DM + 8 * lane); d1[u] = *(const h8*)(hB + (size_t)tok[u] * DM + 512 + 8 * lane); }
#pragma unroll
        for (int u = 0; u < 4; ++u) { const int r = r0 + u * NGW; if (r < MROWS) { *(h8*)(xe + (size_t)r * DM + 8 * lane) = d0[u]; *(h8*)(xe + (size_t)r * DM + 512 + 8 * lane) = d1[u]; } }
    }
}
__device__ __forceinline__ void combine_ln(int l) {
    const KArgs a = kargs(); const Frame F = mkframe(a);
    const float* lng = (const float*)a->in[7] + l * DM; const float* lnb = (const float*)a->in[8] + l * DM;
    const float* mods_l = (const float*)(F.ws + WS_MODS) + (size_t)l * 4 * 6144; const float* mods_next = (const float*)(F.ws + WS_MODS) + (size_t)4 * 6144;
    float* xo = (l == 0) ? (float*)(F.ws + WS_X2) : a->out; f16* hA = (l == 0) ? (f16*)(F.ws + WS_HA) : (f16*)nullptr;
    const float* x1 = (const float*)(F.ws + WS_X1); const f16* y = (const f16*)(F.ws + WS_Y); const int* inv = (const int*)(F.ws + WS_INV);
    const int gw = F.vcu * NWAVES + F.wave, NGW = F.G * NWAVES, lane = F.lane;
    for (int m0 = gw; m0 < T; m0 += 2 * NGW) {
        int myinv[2]; f32x4 xv[2][4];
#pragma unroll
        for (int u = 0; u < 2; ++u) { const int m = (m0 + u * NGW < T) ? m0 + u * NGW : m0; myinv[u] = inv[(size_t)m * 16 + (lane & 15)];
#pragma unroll
            for (int j = 0; j < 4; ++j) xv[u][j] = *(const f32x4*)(x1 + (size_t)m * DM + 4 * lane + 256 * j); }
#pragma unroll
        for (int u = 0; u < 2; ++u) { const int m = m0 + u * NGW; if (m < T) {
        const int b = m >> 12; const float* mb = mods_l + b * 6144;
        f32x4 f[4];
#pragma unroll
        for (int j = 0; j < 4; ++j) f[j] = (f32x4){0.f, 0.f, 0.f, 0.f};
        unsigned mask = (unsigned)(__ballot(myinv[u] >= 0) & 0xFFFFull);
        while (mask) {
            const int e0 = __builtin_ctz(mask); mask &= mask - 1u; const bool two = mask != 0u; const int e1 = two ? __builtin_ctz(mask) : e0; mask &= mask - 1u;
            const int s0 = __shfl(myinv[u], e0), s1 = __shfl(myinv[u], e1);
            const f16* y0 = y + (size_t)(e0 * EROWS + b * CAP + s0) * DM; const f16* y1 = y + (size_t)(e1 * EROWS + b * CAP + s1) * DM;
            h4 a0[4], a1[4];
#pragma unroll
            for (int j = 0; j < 4; ++j) { a0[j] = *(const h4*)(y0 + 4 * lane + 256 * j); a1[j] = *(const h4*)(y1 + 4 * lane + 256 * j); }
            const float w1 = two ? 1.0f : 0.0f;
#pragma unroll
            for (int j = 0; j < 4; ++j) { f[j][0] += (float)a0[j][0]; f[j][1] += (float)a0[j][1]; f[j][2] += (float)a0[j][2]; f[j][3] += (float)a0[j][3]; }
#pragma unroll
            for (int j = 0; j < 4; ++j) { f[j][0] += w1 * (float)a1[j][0]; f[j][1] += w1 * (float)a1[j][1]; f[j][2] += w1 * (float)a1[j][2]; f[j][3] += w1 * (float)a1[j][3]; }
        }
        f32x4 v[4]; float s = 0.f;
#pragma unroll
        for (int j = 0; j < 4; ++j) { const int c = 4 * lane + 256 * j; const f32x4 g2 = *(const f32x4*)(mb + 5120 + c);
            v[j] = xv[u][j] * ALPHA + (g2 + 1.0f) * f[j]; s += (v[j][0] + v[j][1]) + (v[j][2] + v[j][3]); }
        const float mean = wave_sum(s) * (1.f / DM); float s2 = 0.f;
#pragma unroll
        for (int j = 0; j < 4; ++j) { v[j] = v[j] - mean; s2 += (v[j][0] * v[j][0] + v[j][1] * v[j][1]) + (v[j][2] * v[j][2] + v[j][3] * v[j][3]); }
        const float rstd = 1.0f / sqrtf(wave_sum(s2) * (1.f / DM) + LN_EPS);
#pragma unroll
        for (int j = 0; j < 4; ++j) { const int c = 4 * lane + 256 * j; const f32x4 g = *(const f32x4*)(lng + c), bb = *(const f32x4*)(lnb + c);
            const f32x4 xn = v[j] * rstd * g + bb; *(f32x4*)(xo + (size_t)m * DM + c) = xn;
            if (hA) { const float* mn = mods_next + b * 6144; const f32x4 sh = *(const f32x4*)(mn + c), sc = *(const f32x4*)(mn + 1024 + c);
                const f32x4 h = xn * (sc + 1.0f) + sh; h4 o; o[0] = (f16)h[0]; o[1] = (f16)h[1]; o[2] = (f16)h[2]; o[3] = (f16)h[3]; *(h4*)(hA + (size_t)m * DM + c) = o; } }
        } }
    }
}
__device__ __forceinline__ void diff_combine() {
    const KArgs a = kargs(); const Frame F = mkframe(a);
    const float* lamv = (const float*)a->in[16]; const float* subln = (const float*)a->in[17];
    const f16* od = (const f16*)(F.ws + WS_OD); f16* o16 = (f16*)(F.ws + WS_O);
    const int gw = F.vcu * NWAVES + F.wave, NGW = F.G * NWAVES, lane = F.lane;
    const float l01 = wave_sum(lamv[lane] * lamv[64 + lane]), l23 = wave_sum(lamv[128 + lane] * lamv[192 + lane]);
    const float lam = expf(l01) - expf(l23) + LAMBDA_INIT;
    const int h = lane >> 3, d0 = (lane & 7) * 16;
    float sl[16];
#pragma unroll
    for (int i = 0; i < 16; ++i) sl[i] = subln[d0 + i] * (1.0f - LAMBDA_INIT);
    for (int m0 = gw; m0 < T; m0 += 2 * NGW) {
        h8 qa0[2], qa1[2], qb0[2], qb1[2];
#pragma unroll
        for (int u = 0; u < 2; ++u) { const int m = (m0 + u * NGW < T) ? m0 + u * NGW : m0; const f16* r0 = od + (size_t)m * 2048 + (2 * h) * 128 + d0; const f16* r1 = r0 + 128;
            qa0[u] = *(const h8*)r0; qa1[u] = *(const h8*)(r0 + 8); qb0[u] = *(const h8*)r1; qb1[u] = *(const h8*)(r1 + 8); }
#pragma unroll
        for (int u = 0; u < 2; ++u) { const int m = m0 + u * NGW; if (m < T) {
        const h8 a0 = qa0[u], a1 = qa1[u], b0 = qb0[u], b1 = qb1[u];
        float o[16]; float ss = 0.f;
#pragma unroll
        for (int i = 0; i < 8; ++i) { o[i] = (float)a0[i] - lam * (float)b0[i]; o[8 + i] = (float)a1[i] - lam * (float)b1[i]; }
#pragma unroll
        for (int i = 0; i < 16; ++i) ss += o[i] * o[i];
        ss += __shfl_xor(ss, 1); ss += __shfl_xor(ss, 2); ss += __shfl_xor(ss, 4);
        const float rs = 1.0f / sqrtf(ss * (1.0f / 128.0f) + LN_EPS);
        h8 w0, w1;
#pragma unroll
        for (int i = 0; i < 8; ++i) { w0[i] = (f16)(o[i] * rs * sl[i]); w1[i] = (f16)(o[8 + i] * rs * sl[8 + i]); }
        *(h8*)(o16 + (size_t)m * DM + h * 128 + d0) = w0; *(h8*)(o16 + (size_t)m * DM + h * 128 + d0 + 8) = w1; } }
    }
}

__device__ __forceinline__ void attn_mla() {
    const KArgs a = kargs(); const Frame F = mkframe(a);
    const f16* Q = (const f16*)(F.ws + WS_Q); const f16* K = (const f16*)(F.ws + WS_K); const f16* V = (const f16*)(F.ws + WS_V); f16* O = (f16*)(F.ws + WS_O);
    for (int u = F.vcu; u < NB * 8 * 16; u += F.G) { const int qb = u & 15, bh = u >> 4, h = bh & 7, b = bh >> 3;
        att::attn_body_simple<192, 1536, 1536, 1024, 1024>(Q + (size_t)(b * SEQ + qb * 256) * 1536 + h * 192, K + (size_t)(b * SEQ) * 1536 + h * 192, V + (size_t)(b * SEQ) * 1024 + h * 128,
                                                       O + (size_t)(b * SEQ + qb * 256) * 1024 + h * 128, F.ldsg); }
}
__device__ __forceinline__ void attn_diff() {
    const KArgs a = kargs(); const Frame F = mkframe(a);
    const f16* QKV = (const f16*)(F.ws + WS_QKV1); f16* O = (f16*)(F.ws + WS_OD);
    for (int u = F.vcu; u < NB * 16 * 16; u += F.G) { const int qb = u & 15, bh = u >> 4, hh = bh & 15, b = bh >> 4;
        att::attn_body<64, 3072, 3072, 3072, 2048, 2>(QKV + (size_t)(b * SEQ + qb * 256) * 3072 + hh * 64, QKV + (size_t)(b * SEQ) * 3072 + 1024 + hh * 64, QKV + (size_t)(b * SEQ) * 3072 + 2048 + (hh >> 1) * 128,
                                                      O + (size_t)(b * SEQ + qb * 256) * 2048 + hh * 128, F.ldsg); }
}

__device__ __forceinline__ void ph_gemm_lat() { const KArgs a = kargs(); const Frame F = mkframe(a);
    pg8::Gemm g{(const f16*)(F.ws + WS_HA), (const f16*)(F.ws + WS_WIN0), T, 768, 1024, 1 << 30, 0}; pg8::StaticOrder S; S.init(T, 768, F.G, (int)blockIdx.x);
    EpiLat E{(float*)(F.ws + WS_LAT)}; pg8::gemm_phase<EpiLat>(F.lds, g, S, E); }
__device__ __forceinline__ void ph_gemm_q() { const KArgs a = kargs(); const Frame F = mkframe(a);
    pg8::Gemm g{(const f16*)(F.ws + WS_CQN), (const f16*)(F.ws + WS_WUQ), T, 1024, 384, 1 << 30, 0}; pg8::StaticOrder S; S.init(T, 1024, F.G, (int)blockIdx.x);
    EpiQNope E{(f16*)(F.ws + WS_Q)}; pg8::gemm_phase<EpiQNope>(F.lds, g, S, E); }
__device__ __forceinline__ void ph_gemm_qr() { const KArgs a = kargs(); const Frame F = mkframe(a);
    pg8::Gemm g{(const f16*)(F.ws + WS_CQN), (const f16*)(F.ws + WS_WUQ) + (size_t)1024 * 384, T, 512, 384, 1 << 30, 0}; pg8::StaticOrder S; S.init(T, 512, F.G, (int)blockIdx.x);
    EpiQRope E{(f16*)(F.ws + WS_Q), (const float*)(F.ws + WS_COSM), (const float*)(F.ws + WS_SINM)}; pg8::gemm_phase<EpiQRope>(F.lds, g, S, E); }
__device__ __forceinline__ void ph_gemm_kv() { const KArgs a = kargs(); const Frame F = mkframe(a);
    pg8::Gemm g{(const f16*)(F.ws + WS_CKVN), (const f16*)(F.ws + WS_WUKV), T, 2048, 256, 1 << 30, 0}; pg8::StaticOrder S; S.init(T, 2048, F.G, (int)blockIdx.x);
    EpiKV E{(f16*)(F.ws + WS_K), (f16*)(F.ws + WS_V)}; pg8::gemm_phase<EpiKV>(F.lds, g, S, E); }
__device__ __forceinline__ void ph_gemm_o(int l) { const KArgs a = kargs(); const Frame F = mkframe(a);
    pg8::Gemm g{(const f16*)(F.ws + WS_O), (const f16*)(F.ws + (l == 0 ? WS_WO0 : WS_WO1)), T, 1024, 1024, 1 << 30, 0}; pg8::StaticOrder S; S.init(T, 1024, F.G, (int)blockIdx.x);
    EpiPre E{l == 0 ? (const float*)a->in[0] : (const float*)(F.ws + WS_X2), (const float*)(F.ws + WS_MODS) + (size_t)l * 4 * 6144 + 2048, (float*)(F.ws + WS_PRE)}; pg8::gemm_phase<EpiPre>(F.lds, g, S, E); }
__device__ __forceinline__ void ph_gemm_diffin() { const KArgs a = kargs(); const Frame F = mkframe(a);
    pg8::Gemm g{(const f16*)(F.ws + WS_HA), (const f16*)(F.ws + WS_WIN1), T, 3072, 1024, 1 << 30, 0}; pg8::StaticOrder S; S.init(T, 3072, F.G, (int)blockIdx.x);
    EpiDiffIn E{(f16*)(F.ws + WS_QKV1), (const float*)(F.ws + WS_COSD), (const float*)(F.ws + WS_SIND)}; pg8::gemm_phase<EpiDiffIn>(F.lds, g, S, E); }
__device__ __forceinline__ void ph_gemm_up(int l) { const KArgs a = kargs(); const Frame F = mkframe(a);
    pg8::Gemm g{(const f16*)(F.ws + WS_XE), (const f16*)(F.ws + WS_MOEIN) + (size_t)l * NE * 4096 * 1024, MROWS, 4096, 1024, EROWS / 256, (size_t)4096 * 1024}; pg8::StaticOrder S; S.init(MROWS, 4096, F.G, (int)blockIdx.x);
    EpiUp E{(f16*)(F.ws + WS_ACT)}; pg8::gemm_phase<EpiUp>(F.lds, g, S, E); }
__device__ __forceinline__ void ph_gemm_down(int l) { const KArgs a = kargs(); const Frame F = mkframe(a);
    pg8::Gemm g{(const f16*)(F.ws + WS_ACT), (const f16*)(F.ws + WS_MOEOUT) + (size_t)l * NE * 1024 * 2048, MROWS, 1024, 2048, EROWS / 256, (size_t)1024 * 2048}; pg8::StaticOrder S; S.init(MROWS, 1024, F.G, (int)blockIdx.x);
    EpiDown E{(f16*)(F.ws + WS_Y), (const float*)(F.ws + WS_GATE)}; pg8::gemm_phase<EpiDown>(F.lds, g, S, E); }

constexpr int NPHASES = 24;
__global__ void __launch_bounds__(NTHREADS, 2) mk_fwd(Args args) {
    LAS unsigned char* ldsp = (LAS unsigned char*)g_lds;
    volatile LAS unsigned* MISC = (volatile LAS unsigned*)(ldsp + MISC_OFF);
    for (int u = threadIdx.x; u < (LDS_BYTES - LDSCTL_OFF) / 4; u += NTHREADS) ((LAS unsigned*)(ldsp + LDSCTL_OFF))[u] = 0u;
    __syncthreads();
    XcdBarrier bar = xcd_barrier_post((unsigned*)(args.ws + WS_CTL) + CW_BAR + args.li * XCD_BAR_WORDS, MISC + 8);
    const int lo = args.ph_lo, hi = args.ph_hi;
#ifndef PH_MASK
#define PH_MASK 0xFFFFFFFFu
#endif
#define IN(k) (((PH_MASK >> (k)) & 1u) && lo <= (k) && (k) < hi)
#define SEAM(k) do { if (lo <= (k) && (k) + 1 < hi) xcd_barrier(bar); } while (0)
#ifndef REP_MASK
#define REP_MASK 0u
#endif
#define RUN(k, call) do { if (IN(k)) { call; if ((REP_MASK >> (k)) & 1u) { __syncthreads(); call; } } } while (0)
    RUN(0, p0_prologue());      SEAM(0);
    RUN(1, mod_rows_p1());      SEAM(1);
    RUN(2, ph_gemm_lat());      SEAM(2);
    RUN(3, latent_prep());      SEAM(3);
    RUN(4, ph_gemm_q()); RUN(4, ph_gemm_qr());
    RUN(5, ph_gemm_kv());       SEAM(5);
    RUN(6, attn_mla());         SEAM(6);
#pragma unroll 1
    for (int l = 0; l < 2; ++l) {
        const int pb = (l == 0) ? 7 : 17;
        if (l == 1) {
            RUN(14, ph_gemm_diffin()); SEAM(14);
            RUN(15, attn_diff());      SEAM(15);
            RUN(16, diff_combine());   SEAM(16);
        }
        RUN(pb + 0, ph_gemm_o(l));     SEAM(pb + 0);
        RUN(pb + 1, ln_router(l));     SEAM(pb + 1);
        RUN(pb + 2, topk_phase());     SEAM(pb + 2);
        RUN(pb + 3, gather_rows());    SEAM(pb + 3);
        RUN(pb + 4, ph_gemm_up(l));    SEAM(pb + 4);
        RUN(pb + 5, ph_gemm_down(l));  SEAM(pb + 5);
        RUN(pb + 6, combine_ln(l));
        if (l == 0) SEAM(pb + 6);
    }
#undef IN
#undef SEAM
}

extern "C" void kernel_launch(void* const* d_in, const int* in_sizes, int n_in, void* d_out, int out_size, void* d_ws, size_t ws_size, hipStream_t stream) {
    static int grid = 0;
    if (grid == 0) {
        if (n_in != 22 || in_sizes[0] != T * DM || out_size != T * DM || ws_size < WS_END) {
            fprintf(stderr, "kernel_launch: shape/workspace mismatch: n_in %d in0 %d out %d ws %zu (need %zu)\n", n_in, n_in > 0 ? in_sizes[0] : -1, out_size, ws_size, (size_t)WS_END); grid = -1; return; }
        int dev = 0, cus = 0, per_cu = 0;
        if (hipGetDevice(&dev) != hipSuccess || hipDeviceGetAttribute(&cus, hipDeviceAttributeMultiprocessorCount, dev) != hipSuccess) { fprintf(stderr, "kernel_launch: device query failed\n"); grid = -1; return; }
        if (hipFuncSetAttribute((const void*)mk_fwd, hipFuncAttributeMaxDynamicSharedMemorySize, LDS_BYTES) != hipSuccess) { fprintf(stderr, "kernel_launch: hipFuncSetAttribute failed\n"); grid = -1; return; }
        if (hipOccupancyMaxActiveBlocksPerMultiprocessor(&per_cu, (const void*)mk_fwd, NTHREADS, LDS_BYTES) != hipSuccess || per_cu < 1)
            fprintf(stderr, "kernel_launch: note: occupancy query reports %d workgroups per CU\n", per_cu);
        (void)hipGetLastError();
        grid = cus;
    }
    if (grid < 0) return;
    if (hipMemsetAsync((char*)d_ws + WS_CTL, 0, CTL_ZERO_BYTES, stream) != hipSuccess) { fprintf(stderr, "kernel_launch: memset failed\n"); return; }
    Args a{};
    for (int i = 0; i < 22; ++i) a.in[i] = d_in[i];
    a.out = (float*)d_out; a.ws = (unsigned char*)d_ws;
#if MK_CUTS == 1
    a.ph_lo = 0; a.ph_hi = NPHASES; a.li = 0;
    hipLaunchKernelGGL(mk_fwd, dim3(grid), dim3(NTHREADS), LDS_BYTES, stream, a);
#else
    for (int p = 0; p < NPHASES; ++p) { a.ph_lo = p; a.ph_hi = p + 1; a.li = 0; hipLaunchKernelGGL(mk_fwd, dim3(grid), dim3(NTHREADS), LDS_BYTES, stream, a); }
#endif
    const hipError_t le = hipPeekAtLastError();
    if (le != hipSuccess) fprintf(stderr, "kernel_launch: launch failed: %s\n", hipGetErrorName(le));
}
```

```cpp
#include <hip/hip_runtime.h>
#include <cstdio>
#include <cstdint>

#ifndef MK_CUTS
#define MK_CUTS 1
#endif


#define LAS __attribute__((address_space(3)))
#define GAS __attribute__((address_space(1)))
typedef _Float16 f16;
typedef _Float16 h8 __attribute__((ext_vector_type(8)));
typedef _Float16 h4 __attribute__((ext_vector_type(4)));
typedef _Float16 h2 __attribute__((ext_vector_type(2)));
typedef short s16x4 __attribute__((ext_vector_type(4)));
typedef float f32x4 __attribute__((ext_vector_type(4)));
typedef float f32x2 __attribute__((ext_vector_type(2)));
typedef float f32x16 __attribute__((ext_vector_type(16)));
typedef unsigned u32x4 __attribute__((ext_vector_type(4)));
typedef unsigned u32x2 __attribute__((ext_vector_type(2)));

constexpr int NB = 4, SEQ = 4096, DM = 1024, T = NB * SEQ;
constexpr int NE = 16, FF = 2048, CAP = 512, EROWS = NB * CAP;
constexpr int MROWS = NE * EROWS;
constexpr float ALPHA = 1.4142135623730951f;
constexpr float LN_EPS = 1e-5f, LAT_EPS = 1e-6f;
constexpr float LAMBDA_INIT = 0.35550906759096926f;
constexpr int NWAVES = 8, NTHREADS = 512;

constexpr size_t MiB = 1u << 20;
constexpr size_t WS_CTL = 0, CTL_ZERO_BYTES = 1 * MiB;
constexpr size_t WS_MODS = 1 * MiB;
constexpr size_t WS_COSM = 2 * MiB, WS_SINM = 4 * MiB;
constexpr size_t WS_COSD = 6 * MiB, WS_SIND = 6 * MiB + 512 * 1024;
constexpr size_t WS_AFF = 7 * MiB;
constexpr size_t WS_GATE = 8 * MiB;
constexpr size_t WS_ROWTOK = 8 * MiB + 512 * 1024;
constexpr size_t WS_INV = 9 * MiB;
constexpr size_t WS_WIN0 = 16 * MiB;
constexpr size_t WS_WUQ = 18 * MiB;
constexpr size_t WS_WUKV = 20 * MiB;
constexpr size_t WS_WO0 = 22 * MiB;
constexpr size_t WS_WIN1 = 24 * MiB;
constexpr size_t WS_WO1 = 30 * MiB;
constexpr size_t WS_MOEIN = 32 * MiB;
constexpr size_t WS_MOEOUT = 288 * MiB;
constexpr size_t WS_HA = 416 * MiB;
constexpr size_t WS_HB = 448 * MiB;
constexpr size_t WS_LAT = 480 * MiB;
constexpr size_t WS_CQN = 528 * MiB;
constexpr size_t WS_CKVN = 540 * MiB;
constexpr size_t WS_Q = 548 * MiB;
constexpr size_t WS_K = 596 * MiB;
constexpr size_t WS_V = 644 * MiB;
constexpr size_t WS_O = 676 * MiB;
constexpr size_t WS_PRE = 708 * MiB;
constexpr size_t WS_X1 = 772 * MiB;
constexpr size_t WS_X2 = 836 * MiB;
constexpr size_t WS_XE = 900 * MiB;
constexpr size_t WS_ACT = 964 * MiB;
constexpr size_t WS_Y = 1092 * MiB;
constexpr size_t WS_QKV1 = 1156 * MiB;
constexpr size_t WS_OD = 1252 * MiB;
constexpr size_t WS_END = 1316 * MiB;
constexpr int CW_BAR = 4096;

constexpr int RING_BYTES = 131072;
constexpr int LDSCTL_OFF = RING_BYTES, MISC_OFF = LDSCTL_OFF + 320;
constexpr int LDS_BYTES = 147456;

#define LDS_WAIT() asm volatile("s_waitcnt lgkmcnt(0)" ::: "memory")
#define VM_WAIT() asm volatile("s_waitcnt vmcnt(0)" ::: "memory")

__device__ __forceinline__ float wave_sum(float v) {
#pragma unroll
    for (int o = 1; o < 64; o <<= 1) v += __shfl_xor(v, o);
    return v;
}

#define XB_TMO      128
#define XB_XCNT(j)  (256  + 64 * (j))
#define XB_XSUB(j)  (1280 + 64 * (j))
#define XB_XGEN(j)  (2304 + 64 * (j))
#define XB_TOP      3328
#define XB_TOPGEN   3392
#define XCD_BAR_WORDS 3456
#define XB_SPIN_CAP (1u << 20)
__device__ __forceinline__ unsigned xb_ld(unsigned* p)              { return __hip_atomic_load(p, __ATOMIC_RELAXED, __HIP_MEMORY_SCOPE_AGENT); }
__device__ __forceinline__ unsigned xb_add(unsigned* p, unsigned v) { return __hip_atomic_fetch_add(p, v, __ATOMIC_RELAXED, __HIP_MEMORY_SCOPE_AGENT); }
__device__ __forceinline__ unsigned xb_xcc_id() { return (unsigned)__builtin_amdgcn_s_getreg((3 << 11) | 20) & 0xFu; }
#define XB_SPIN(cond, bar) do { unsigned _sp = 0; while (cond) { __builtin_amdgcn_s_sleep(1); \
    if ((++_sp & 255u) == 0u) { if (xb_ld(&(bar)[XB_TMO])) break; if (_sp > XB_SPIN_CAP) { atomicAdd(&(bar)[XB_TMO], 1u); break; } } } } while (0)
struct XcdBarrier { unsigned* bar; unsigned x; volatile LAS unsigned* st; };
__device__ __forceinline__ XcdBarrier xcd_barrier_post(unsigned* bar, volatile LAS unsigned* st) {
    XcdBarrier b; b.bar = bar; b.x = xb_xcc_id(); b.st = st;
    if (threadIdx.x == 0) (void)xb_add(&bar[XB_XCNT(b.x)], 1u);
    return b;
}
__device__ __forceinline__ void xcd_barrier_complete(unsigned* bar, unsigned x, unsigned& nloc, unsigned& nx) {
    const unsigned G = gridDim.x * gridDim.y * gridDim.z;
    unsigned sum, cnt, mine, sp = 0u;
    for (;;) {
        sum = 0u; cnt = 0u; mine = 0u;
#pragma unroll
        for (unsigned j = 0; j < 16; ++j) { const unsigned c = xb_ld(&bar[XB_XCNT(j)]); sum += c; cnt += (c > 0u) ? 1u : 0u; mine = (j == x) ? c : mine; }
        if (sum == G) break;
        __builtin_amdgcn_s_sleep(1);
        if ((++sp & 255u) == 0u) { if (xb_ld(&bar[XB_TMO])) break; if (sp > XB_SPIN_CAP) { atomicAdd(&bar[XB_TMO], 1u); break; } }
    }
    nloc = mine > 0u ? mine : 1u; nx = cnt > 0u ? cnt : 1u;
}
__device__ __forceinline__ void xcd_barrier(const XcdBarrier& b) {
    asm volatile("s_waitcnt vmcnt(0)" ::: "memory");
    __syncthreads();
    if (threadIdx.x == 0) {
        unsigned* bar = b.bar;
        __builtin_amdgcn_s_waitcnt(0);
        unsigned nloc = b.st[0], nx = b.st[1];
        if (nloc == 0u) { xcd_barrier_complete(bar, b.x, nloc, nx); b.st[0] = nloc; b.st[1] = nx; }
        const unsigned old = xb_add(&bar[XB_XSUB(b.x)], 1u);
        const unsigned gen = old / nloc;
        if (old + 1u == (gen + 1u) * nloc) {
            __builtin_amdgcn_fence(__ATOMIC_RELEASE, "agent");
            asm volatile("s_waitcnt vmcnt(0)" ::: "memory");
            const unsigned og = xb_add(&bar[XB_TOP], 1u);
            const unsigned tg = og / nx;
            if (og + 1u == (tg + 1u) * nx) xb_add(&bar[XB_TOPGEN], 1u);
            else XB_SPIN(xb_ld(&bar[XB_TOPGEN]) == tg, bar);
            __builtin_amdgcn_fence(__ATOMIC_ACQUIRE, "agent");
            xb_add(&bar[XB_XGEN(b.x)], 1u);
            asm volatile("s_waitcnt vmcnt(0)" ::: "memory");
        } else {
            XB_SPIN(xb_ld(&bar[XB_XGEN(b.x)]) == gen, bar);
            __builtin_amdgcn_fence(__ATOMIC_ACQUIRE, "agent");
            asm volatile("s_waitcnt vmcnt(0)" ::: "memory");
        }
    }
    __syncthreads();
}

namespace pg8 {
constexpr int BM = 256, BK = 64, HALF = 128, HTB = HALF * BK * 2, STAGE_BYTES = 8 * HTB, NXCD = 8, WGM = 8;
__host__ __device__ __forceinline__ int lds_byte(int r, int c) { const int st = (r >> 4) * 2 + (c >> 5), rr = r & 15, cc = c & 31, ob = rr * 64 + cc * 2; return st * 1024 + (ob ^ (((ob >> 9) & 1) << 5)); }
__host__ __device__ __forceinline__ void stage_rc(int b, int& R, int& C) { const int st = b / 1024, sb = b % 1024, swz = sb ^ (((sb >> 9) & 1) << 5); R = (st >> 1) * 16 + swz / 64; C = (st & 1) * 32 + (swz % 64) / 2; }
__host__ __device__ __forceinline__ int perm32(int rho) { const int n = rho >> 4, i = rho & 15; return 8 * (i >> 2) + 4 * n + (i & 3); }
struct Unit { int pm, pn; };
struct Gemm { const f16* A; const f16* Bt; int M, N, K; int grp_tiles; size_t grp_stride; const int* rowidx; };
struct StaticOrder {
    int nM, nN, nwg, G, c;
    __host__ __device__ void init(int M, int N, int G_, int c_) { nM = M / BM; nN = N / BM; nwg = nM * nN; G = G_; c = c_; }
    __host__ __device__ bool next(int i, Unit& u) const {
        const long L = (long)i * G + c; if (L >= nwg) return false;
        int wgid = (int)L; { const int q = nwg / NXCD, r = nwg % NXCD, xcd = wgid % NXCD, off = wgid / NXCD; wgid = (xcd < r ? xcd * (q + 1) : r * (q + 1) + (xcd - r) * q) + off; }
        const int nig = WGM * nN, gid = wgid / nig, fm = gid * WGM, gsz = (nM - fm) < WGM ? (nM - fm) : WGM;
        u.pm = fm + ((wgid % nig) % gsz); u.pn = (wgid % nig) / gsz; return true;
    }
};
constexpr int GATHER_MAX_UNITS = 15, GATHER_IDX_OFF = RING_BYTES + 1024;
template <class Epi, bool ALIGN_EPI = true, bool SP2 = true, bool GATHER = false>
__device__ __forceinline__ void gemm_phase(LAS unsigned char* lds, const Gemm g, const StaticOrder& S, const Epi& E) {
    int tid = threadIdx.x; asm volatile("" : "+v"(tid));
    const int wid = __builtin_amdgcn_readfirstlane(tid >> 6), lane = tid & 63, wr = wid >> 2, wc = wid & 3, fr = lane & 15, fq = lane >> 4;
    const int K = g.K, nt = K / BK;
    unsigned voffA[2], voffB[2];
#pragma unroll
    for (int i = 0; i < 2; ++i) { int R, C; stage_rc(tid * 16 + i * 8192, R, C); const int Rb = Epi::PERM ? ((R & ~31) + perm32(R & 31)) : R;
        voffA[i] = (unsigned)(R * K + C) * 2u; voffB[i] = (unsigned)(Rb * K + C) * 2u; }
    int gR[2]; unsigned gC[2];
#pragma unroll
    for (int i = 0; i < 2; ++i) { int R, C; stage_rc(tid * 16 + i * 8192, R, C); gR[i] = R; gC[i] = (unsigned)C * 2u; }
    LAS int* idxbuf = (LAS int*)(lds + GATHER_IDX_OFF);
    if constexpr (GATHER) {
        Unit uu;
        for (int q = 0; q < GATHER_MAX_UNITS; ++q) { if (!S.next(q, uu)) break; if (tid < 256) idxbuf[q * 256 + tid] = g.rowidx[uu.pm * 256 + tid]; }
        asm volatile("s_waitcnt vmcnt(0) lgkmcnt(0)" ::: "memory"); __builtin_amdgcn_s_barrier(); asm volatile("" ::: "memory");
    }
    unsigned gaC[2][2], gaN[2][2], ga2[2][2];
#define PG8_GA(dst, q) do { _Pragma("unroll") for (int _h = 0; _h < 2; ++_h) _Pragma("unroll") for (int _i = 0; _i < 2; ++_i) dst[_h][_i] = (unsigned)idxbuf[(q) * 256 + _h * 128 + gR[_i]] * (unsigned)(K * 2) + gC[_i]; } while (0)
    const size_t kstep = (size_t)(BK * 2);
    const size_t hstep = (size_t)HALF * K * 2;
    const size_t tstep = 2 * hstep;
    const unsigned ldsw = (unsigned)wid * 1024u;
    const int aoff = lds_byte(wr * 64 + fr, fq * 8), boff = lds_byte(wc * 32 + fr, fq * 8);
#define PG8_SA(b, h) (((b) * 2 + (h)) * HTB)
#define PG8_SB(b, h) ((4 + (b) * 2 + (h)) * HTB)
#define PG8_STAGE(bufoff, gbase, voff) do { _Pragma("unroll") for (int _i = 0; _i < 2; ++_i) \
        __builtin_amdgcn_global_load_lds((const unsigned*)((const char*)(gbase) + (voff)[_i]), (LAS unsigned*)(lds + (bufoff) + ldsw + _i * 8192), 16, 0, 0); } while (0)
#define PG8_LDA(dst, b, h) do { _Pragma("unroll") for (int m = 0; m < 4; ++m) _Pragma("unroll") for (int k = 0; k < 2; ++k) dst[m][k] = *(const LAS h8*)(lds + PG8_SA(b, h) + aoff + m * 2048 + k * 1024); } while (0)
#define PG8_LDB(dst, b, h) do { _Pragma("unroll") for (int n = 0; n < 2; ++n) _Pragma("unroll") for (int k = 0; k < 2; ++k) dst[n][k] = *(const LAS h8*)(lds + PG8_SB(b, h) + boff + n * 2048 + k * 1024); } while (0)
#define PG8_MMA(ai, bj, At, Bt) do { __builtin_amdgcn_s_setprio(1); _Pragma("unroll") for (int m = 0; m < 4; ++m) _Pragma("unroll") for (int n = 0; n < 2; ++n) _Pragma("unroll") for (int k = 0; k < 2; ++k) \
        acc[ai][bj][m][n] = __builtin_amdgcn_mfma_f32_16x16x32_f16(Bt[n][k], At[m][k], acc[ai][bj][m][n], 0, 0, 0); __builtin_amdgcn_s_setprio(0); } while (0)
#define PG8_WAIT_V(n) asm volatile("s_waitcnt vmcnt(" #n ")" ::: "memory")
#define PG8_WAIT_L(n) asm volatile("s_waitcnt lgkmcnt(" #n ")" ::: "memory")
#define PG8_BAR __builtin_amdgcn_s_barrier()
#define PG8_SCHED __builtin_amdgcn_sched_barrier(0)
#define PG8_STA(bufoff, tileptr, h, gaset, kbyte) do { if constexpr (GATHER) { PG8_STAGE(bufoff, (const char*)g.A + (kbyte), gaset[h]); } else { PG8_STAGE(bufoff, (tileptr) + (h) * hstep, voffA); } } while (0)
#define PG8_BBASE(u) ((const char*)g.Bt + ((size_t)((u).pm / g.grp_tiles) * g.grp_stride) * 2 + (size_t)(u).pn * tstep)
    Unit cur, nxt; int ui = 0;
    if (!S.next(0, cur)) return;
    f32x4 acc[2][2][4][2];
#pragma unroll
    for (int a = 0; a < 2; ++a)
#pragma unroll
        for (int b = 0; b < 2; ++b)
#pragma unroll
            for (int m = 0; m < 4; ++m)
#pragma unroll
                for (int n = 0; n < 2; ++n) acc[a][b][m][n] = (f32x4){0.f, 0.f, 0.f, 0.f};
    h8 At[4][2], B0[2][2], B1[2][2];
    const char* cA = (const char*)g.A + (size_t)cur.pm * tstep; const char* cB = PG8_BBASE(cur);
    if constexpr (GATHER) { PG8_GA(gaC, 0); }
    if constexpr (SP2) {
        PG8_STAGE(PG8_SB(0, 0), cB, voffB); PG8_STAGE(PG8_SB(0, 1), cB + hstep, voffB); PG8_STA(PG8_SA(0, 0), cA, 0, gaC, 0); PG8_STA(PG8_SA(0, 1), cA, 1, gaC, 0);
        if (wr == 1) PG8_BAR;
        PG8_WAIT_V(2); PG8_BAR;
        PG8_STAGE(PG8_SB(1, 0), cB + kstep, voffB); PG8_STA(PG8_SA(1, 0), cA + kstep, 0, gaC, kstep); PG8_STAGE(PG8_SB(1, 1), cB + hstep + kstep, voffB);
        PG8_WAIT_V(6); PG8_BAR;
    } else {
        PG8_STAGE(PG8_SB(0, 0), cB, voffB); PG8_STA(PG8_SA(0, 0), cA, 0, gaC, 0); PG8_STAGE(PG8_SB(0, 1), cB + hstep, voffB); PG8_STA(PG8_SA(0, 1), cA, 1, gaC, 0);
        if (wr == 1) PG8_BAR;
        PG8_WAIT_V(4); PG8_BAR;
        PG8_STAGE(PG8_SB(1, 0), cB + kstep, voffB); PG8_STA(PG8_SA(1, 0), cA + kstep, 0, gaC, kstep); PG8_STAGE(PG8_SB(1, 1), cB + hstep + kstep, voffB);
        PG8_WAIT_V(6); PG8_BAR;
    }
    for (;;) {
        const bool has_next = S.next(ui + 1, nxt);
        const char* nA = has_next ? (const char*)g.A + (size_t)nxt.pm * tstep : cA; const char* nB = has_next ? PG8_BBASE(nxt) : cB;
        if constexpr (GATHER) { const int qn = has_next ? ui + 1 : ui; PG8_GA(gaN, qn); }
#pragma unroll 1
        for (int t = 0; t < nt; t += 2) {
            const bool last = (t == nt - 2);
            const char* a1 = cA + (size_t)(t + 1) * kstep;
            const char* a2 = last ? nA : cA + (size_t)(t + 2) * kstep; const char* b2 = last ? nB : cB + (size_t)(t + 2) * kstep;
            const char* a3 = a2 + kstep; const char* b3 = b2 + kstep;
            const size_t k1 = (size_t)(t + 1) * kstep, k2 = last ? 0 : (size_t)(t + 2) * kstep, k3 = k2 + kstep;
            if constexpr (GATHER) { _Pragma("unroll") for (int _h = 0; _h < 2; ++_h) _Pragma("unroll") for (int _i = 0; _i < 2; ++_i) ga2[_h][_i] = last ? gaN[_h][_i] : gaC[_h][_i]; }
            if constexpr (SP2) {
            PG8_LDB(B0, 0, 0); PG8_LDB(B1, 0, 1); PG8_SCHED; PG8_LDA(At, 0, 0); PG8_STA(PG8_SA(1, 1), a1, 1, gaC, k1);
            PG8_WAIT_V(8); PG8_WAIT_L(0); PG8_BAR; PG8_MMA(0, 0, At, B0); PG8_MMA(0, 1, At, B1); PG8_BAR; PG8_SCHED;
            PG8_LDA(At, 0, 1); PG8_STAGE(PG8_SB(0, 0), b2, voffB); PG8_STAGE(PG8_SB(0, 1), b2 + hstep, voffB); PG8_STA(PG8_SA(0, 0), a2, 0, ga2, k2);
            PG8_WAIT_V(8); PG8_WAIT_L(0); PG8_BAR; PG8_MMA(1, 0, At, B0); PG8_MMA(1, 1, At, B1); PG8_BAR; PG8_SCHED;
            PG8_LDB(B0, 1, 0); PG8_LDB(B1, 1, 1); PG8_SCHED; PG8_LDA(At, 1, 0); PG8_STA(PG8_SA(0, 1), a2, 1, ga2, k2);
            PG8_WAIT_V(8); PG8_WAIT_L(0); PG8_BAR; PG8_MMA(0, 0, At, B0); PG8_MMA(0, 1, At, B1); PG8_BAR; PG8_SCHED;
            PG8_LDA(At, 1, 1); PG8_STAGE(PG8_SB(1, 0), b3, voffB); PG8_STAGE(PG8_SB(1, 1), b3 + hstep, voffB); PG8_STA(PG8_SA(1, 0), a3, 0, ga2, k3);
            PG8_WAIT_V(8); PG8_WAIT_L(0); PG8_BAR; PG8_MMA(1, 0, At, B0); PG8_MMA(1, 1, At, B1); PG8_BAR; PG8_SCHED;
            } else {
            PG8_LDB(B0, 0, 0); PG8_SCHED; PG8_LDA(At, 0, 0); PG8_STA(PG8_SA(1, 1), a1, 1, gaC, k1);
            PG8_WAIT_L(8); PG8_BAR; PG8_WAIT_L(0); PG8_MMA(0, 0, At, B0); PG8_BAR; PG8_SCHED;
            PG8_LDB(B1, 0, 1); PG8_STAGE(PG8_SB(0, 0), b2, voffB);
            PG8_BAR; PG8_WAIT_L(0); PG8_MMA(0, 1, At, B1); PG8_BAR;
            PG8_LDA(At, 0, 1); PG8_STA(PG8_SA(0, 0), a2, 0, ga2, k2);
            PG8_BAR; PG8_WAIT_L(0); PG8_MMA(1, 0, At, B0); PG8_BAR; PG8_SCHED;
            PG8_STAGE(PG8_SB(0, 1), b2 + hstep, voffB);
            PG8_WAIT_V(6); PG8_BAR; PG8_MMA(1, 1, At, B1); PG8_BAR;
            PG8_LDB(B0, 1, 0); PG8_SCHED; PG8_LDA(At, 1, 0); PG8_STA(PG8_SA(0, 1), a2, 1, ga2, k2);
            PG8_WAIT_L(8); PG8_BAR; PG8_WAIT_L(0); PG8_MMA(0, 0, At, B0); PG8_BAR; PG8_SCHED;
            PG8_LDB(B1, 1, 1); PG8_STAGE(PG8_SB(1, 0), b3, voffB);
            PG8_BAR; PG8_WAIT_L(0); PG8_MMA(0, 1, At, B1); PG8_BAR;
            PG8_LDA(At, 1, 1); PG8_STA(PG8_SA(1, 0), a3, 0, ga2, k3);
            PG8_BAR; PG8_WAIT_L(0); PG8_MMA(1, 0, At, B0); PG8_BAR; PG8_SCHED;
            PG8_STAGE(PG8_SB(1, 1), b3 + hstep, voffB);
            PG8_WAIT_V(6); PG8_BAR; PG8_MMA(1, 1, At, B1); PG8_BAR;
            }
        }
        if constexpr (ALIGN_EPI) { if (wr == 0) PG8_BAR; }
        E(acc, cur, wr, wc, fr, fq);
        if (!has_next) break;
#pragma unroll
        for (int a = 0; a < 2; ++a)
#pragma unroll
            for (int b = 0; b < 2; ++b)
#pragma unroll
                for (int m = 0; m < 4; ++m)
#pragma unroll
                    for (int n = 0; n < 2; ++n) acc[a][b][m][n] = (f32x4){0.f, 0.f, 0.f, 0.f};
        cur = nxt; cA = nA; cB = nB; ++ui;
        if constexpr (GATHER) { _Pragma("unroll") for (int _h = 0; _h < 2; ++_h) _Pragma("unroll") for (int _i = 0; _i < 2; ++_i) gaC[_h][_i] = gaN[_h][_i]; }
        if constexpr (ALIGN_EPI) { if (wr == 1) PG8_BAR; }
    }
    PG8_WAIT_V(0);
    if constexpr (!ALIGN_EPI) { if (wr == 0) PG8_BAR; }
    PG8_BAR;
#undef PG8_SA
#undef PG8_SB
#undef PG8_STAGE
#undef PG8_LDA
#undef PG8_LDB
#undef PG8_MMA
#undef PG8_WAIT_V
#undef PG8_WAIT_L
#undef PG8_BAR
#undef PG8_SCHED
#undef PG8_BBASE
#undef PG8_STA
#undef PG8_GA
}
}

#define EPI_ROW(u, ai, m) ((u).pm * 256 + (ai) * 128 + wr * 64 + (m) * 16 + fr)
__device__ __forceinline__ h8 pack8(f32x4 a, f32x4 b) { h8 o; o[0] = (f16)a[0]; o[1] = (f16)a[1]; o[2] = (f16)a[2]; o[3] = (f16)a[3]; o[4] = (f16)b[0]; o[5] = (f16)b[1]; o[6] = (f16)b[2]; o[7] = (f16)b[3]; return o; }
__device__ __forceinline__ void rope4(f32x4& v0, f32x4& v1, const f32x4 cs, const f32x4 sn) {
    const f32x4 a = v0, b = v1;
    v0[0] = a[0] * cs[0] - a[1] * sn[0]; v0[1] = a[1] * cs[0] + a[0] * sn[0];
    v0[2] = a[2] * cs[1] - a[3] * sn[1]; v0[3] = a[3] * cs[1] + a[2] * sn[1];
    v1[0] = b[0] * cs[2] - b[1] * sn[2]; v1[1] = b[1] * cs[2] + b[0] * sn[2];
    v1[2] = b[2] * cs[3] - b[3] * sn[3]; v1[3] = b[3] * cs[3] + b[2] * sn[3];
}
struct EpiLat {
    static constexpr bool PERM = false; float* out;
    __device__ __forceinline__ void operator()(const f32x4 (&acc)[2][2][4][2], const pg8::Unit& u, int wr, int wc, int fr, int fq) const {
#pragma unroll
        for (int ai = 0; ai < 2; ++ai)
#pragma unroll
            for (int m = 0; m < 4; ++m) { float* rowp = out + (size_t)EPI_ROW(u, ai, m) * 768 + u.pn * 256 + wc * 32 + 4 * fq;
#pragma unroll
                for (int bj = 0; bj < 2; ++bj)
#pragma unroll
                    for (int n = 0; n < 2; ++n) *(f32x4*)(rowp + bj * 128 + n * 16) = acc[ai][bj][m][n]; }
    }
};
struct EpiQNope {
    static constexpr bool PERM = true; f16* Q;
    __device__ __forceinline__ void operator()(const f32x4 (&acc)[2][2][4][2], const pg8::Unit& u, int wr, int wc, int fr, int fq) const {
#pragma unroll
        for (int ai = 0; ai < 2; ++ai)
#pragma unroll
            for (int m = 0; m < 4; ++m) { const int t = EPI_ROW(u, ai, m);
#pragma unroll
                for (int bj = 0; bj < 2; ++bj) { const int c8 = u.pn * 256 + bj * 128 + wc * 32 + 8 * fq;
                    *(h8*)(Q + (size_t)t * 1536 + (c8 >> 7) * 192 + (c8 & 127)) = pack8(acc[ai][bj][m][0], acc[ai][bj][m][1]); } }
    }
};
struct EpiQRope {
    static constexpr bool PERM = true; f16* Q; const float* cosm; const float* sinm;
    __device__ __forceinline__ void operator()(const f32x4 (&acc)[2][2][4][2], const pg8::Unit& u, int wr, int wc, int fr, int fq) const {
#pragma unroll
        for (int ai = 0; ai < 2; ++ai)
#pragma unroll
            for (int m = 0; m < 4; ++m) { const int t = EPI_ROW(u, ai, m);
#pragma unroll
                for (int bj = 0; bj < 2; ++bj) { const int cc = u.pn * 256 + bj * 128 + wc * 32 + 8 * fq; const int h = cc >> 6, jj = cc & 63, i0 = jj >> 1;
                    f32x4 v0 = acc[ai][bj][m][0], v1 = acc[ai][bj][m][1];
                    const f32x4 cs = *(const f32x4*)(cosm + (size_t)t * 32 + i0), sn = *(const f32x4*)(sinm + (size_t)t * 32 + i0); rope4(v0, v1, cs, sn);
                    *(h8*)(Q + (size_t)t * 1536 + h * 192 + 128 + jj) = pack8(v0, v1); }
                asm volatile("" ::: "memory"); }
    }
};
struct EpiKV {
    static constexpr bool PERM = true; f16* Kp; f16* Vp;
    __device__ __forceinline__ void operator()(const f32x4 (&acc)[2][2][4][2], const pg8::Unit& u, int wr, int wc, int fr, int fq) const {
#pragma unroll
        for (int ai = 0; ai < 2; ++ai)
#pragma unroll
            for (int m = 0; m < 4; ++m) { const int t = EPI_ROW(u, ai, m);
#pragma unroll
                for (int bj = 0; bj < 2; ++bj) { const int c8 = u.pn * 256 + bj * 128 + wc * 32 + 8 * fq; const int h = c8 >> 8, j = c8 & 255;
                    f16* dst = (j < 128) ? (Kp + (size_t)t * 1536 + h * 192 + j) : (Vp + (size_t)t * 1024 + h * 128 + (j - 128));
                    *(h8*)dst = pack8(acc[ai][bj][m][0], acc[ai][bj][m][1]); }
                asm volatile("" ::: "memory"); }
    }
};
struct EpiPre {
    static constexpr bool PERM = false; const float* xres; const float* gmod; float* pre;
    __device__ __forceinline__ void operator()(const f32x4 (&acc)[2][2][4][2], const pg8::Unit& u, int wr, int wc, int fr, int fq) const {
#pragma unroll
        for (int ai = 0; ai < 2; ++ai)
#pragma unroll
            for (int m = 0; m < 4; ++m) { const int t = EPI_ROW(u, ai, m); const int b = t >> 12;
#pragma unroll
                for (int bj = 0; bj < 2; ++bj)
#pragma unroll
                    for (int n = 0; n < 2; ++n) { const int c = u.pn * 256 + bj * 128 + wc * 32 + n * 16 + 4 * fq;
                        const f32x4 gv = *(const f32x4*)(gmod + b * 6144 + c), xv = *(const f32x4*)(xres + (size_t)t * 1024 + c);
                        *(f32x4*)(pre + (size_t)t * 1024 + c) = xv * ALPHA + (gv + 1.0f) * acc[ai][bj][m][n]; }
                asm volatile("" ::: "memory"); }
    }
};
struct EpiUp {
    static constexpr bool PERM = true; f16* act;
    __device__ __forceinline__ void operator()(const f32x4 (&acc)[2][2][4][2], const pg8::Unit& u, int wr, int wc, int fr, int fq) const {
#pragma unroll
        for (int ai = 0; ai < 2; ++ai)
#pragma unroll
            for (int m = 0; m < 4; ++m) { const int r = EPI_ROW(u, ai, m);
#pragma unroll
                for (int bj = 0; bj < 2; ++bj) { const int c8 = u.pn * 256 + bj * 128 + wc * 32 + 8 * fq;
                    const f32x4 gq = acc[ai][bj][m][0], uq = acc[ai][bj][m][1]; h4 o;
#pragma unroll
                    for (int i = 0; i < 4; ++i) { const float gg = gq[i]; o[i] = (f16)(gg * __builtin_amdgcn_rcpf(1.0f + __expf(-gg)) * uq[i]); }
                    *(h4*)(act + (size_t)r * 2048 + (c8 >> 1)) = o; } }
    }
};
struct EpiDown {
    static constexpr bool PERM = true; f16* y; const float* gate;
    __device__ __forceinline__ void operator()(const f32x4 (&acc)[2][2][4][2], const pg8::Unit& u, int wr, int wc, int fr, int fq) const {
#pragma unroll
        for (int ai = 0; ai < 2; ++ai)
#pragma unroll
            for (int m = 0; m < 4; ++m) { const int r = EPI_ROW(u, ai, m); const float gt = gate[r];
#pragma unroll
                for (int bj = 0; bj < 2; ++bj) { const int c8 = u.pn * 256 + bj * 128 + wc * 32 + 8 * fq;
                    *(h8*)(y + (size_t)r * 1024 + c8) = pack8(acc[ai][bj][m][0] * gt, acc[ai][bj][m][1] * gt); }
                asm volatile("" ::: "memory"); }
    }
};
struct EpiDiffIn {
    static constexpr bool PERM = true; f16* qkv; const float* cosd; const float* sind;
    __device__ __forceinline__ void operator()(const f32x4 (&acc)[2][2][4][2], const pg8::Unit& u, int wr, int wc, int fr, int fq) const {
#pragma unroll
        for (int ai = 0; ai < 2; ++ai)
#pragma unroll
            for (int m = 0; m < 4; ++m) { const int t = EPI_ROW(u, ai, m);
#pragma unroll
                for (int bj = 0; bj < 2; ++bj) { const int c8 = u.pn * 256 + bj * 128 + wc * 32 + 8 * fq;
                    f32x4 v0 = acc[ai][bj][m][0], v1 = acc[ai][bj][m][1];
                    if (c8 < 2048 && (c8 & 63) < 16) { const int i0 = (c8 & 15) >> 1; const f32x4 cs = *(const f32x4*)(cosd + (size_t)t * 8 + i0), sn = *(const f32x4*)(sind + (size_t)t * 8 + i0); rope4(v0, v1, cs, sn); }
                    *(h8*)(qkv + (size_t)t * 3072 + c8) = pack8(v0, v1); }
                asm volatile("" ::: "memory"); }
    }
};

namespace att {
constexpr int QBLK = 32, KVBLK = 64, DV = 128;
constexpr float THR = 8.f;
constexpr size_t SHM_V = KVBLK * DV * 2;
#define SBAR() __builtin_amdgcn_sched_barrier(0)
__device__ __forceinline__ int crow(int r, int hi) { return (r & 3) + 8 * (r >> 2) + 4 * hi; }
__device__ __forceinline__ unsigned cvtpk(float lo, float hi) { unsigned r; asm volatile("v_cvt_pk_f16_f32 %0, %1, %2" : "=v"(r) : "v"(lo), "v"(hi)); return r; }
template <int DQK> struct Cfg {
    static constexpr int ND0 = DQK / 16, KRB = DQK * 2, NKCH = DQK / 64, KCPR = DQK / 8;
    static constexpr size_t SHM_K = (size_t)KVBLK * KRB;
    static constexpr float SCALE = DQK == 192 ? 0.07216878364870322f : 0.125f;
    static constexpr size_t SHM_TOTAL = 2 * SHM_V + 2 * SHM_K + NWAVES * 64 * 4;
};
template <int DQK> __device__ __forceinline__ void partialSM(f32x16& p0, f32x16& p1, float& m_reg, float& mn, float& alpha) {
    constexpr float SCALE = Cfg<DQK>::SCALE, C = SCALE * 1.4426950408889634f;
    float pmax = p0[0];
#pragma unroll
    for (int r = 1; r < 16; ++r) pmax = fmaxf(pmax, p0[r]);
#pragma unroll
    for (int r = 0; r < 16; ++r) pmax = fmaxf(pmax, p1[r]);
    { auto rr = __builtin_amdgcn_permlane32_swap(__float_as_uint(pmax), __float_as_uint(pmax), false, false);
      pmax = fmaxf(__uint_as_float(rr[0]), __uint_as_float(rr[1])); }
    if (__builtin_expect(__all(pmax - m_reg <= THR / SCALE), 1)) { mn = m_reg; alpha = 1.f; }
    else { mn = fmaxf(m_reg, pmax); alpha = __builtin_amdgcn_exp2f((m_reg - mn) * C); m_reg = mn; }
    const float mnC = -mn * C;
#pragma unroll
    for (int r = 0; r < 16; ++r) p0[r] = fmaf(p0[r], C, mnC);
#pragma unroll
    for (int r = 0; r < 16; ++r) p1[r] = fmaf(p1[r], C, mnC);
#pragma unroll
    for (int r = 0; r < 16; ++r) p0[r] = __builtin_amdgcn_exp2f(p0[r]);
}
__device__ __forceinline__ void finishSM(f32x16& p0, f32x16& p1, float alpha, float& l_reg, h8& pa0, h8& pa1, h8& pa2, h8& pa3) {
#pragma unroll
    for (int r = 0; r < 16; ++r) p1[r] = __builtin_amdgcn_exp2f(p1[r]);
    float ps = 0;
#pragma unroll
    for (int r = 0; r < 16; ++r) ps += p0[r];
#pragma unroll
    for (int r = 0; r < 16; ++r) ps += p1[r];
    { auto rr = __builtin_amdgcn_permlane32_swap(__float_as_uint(ps), __float_as_uint(ps), false, false);
      ps = __uint_as_float(rr[0]) + __uint_as_float(rr[1]); }
    l_reg = l_reg * alpha + ps;
#define PK4(P, BASE, OUT) do { unsigned a0 = cvtpk(P[BASE + 0], P[BASE + 1]), a1 = cvtpk(P[BASE + 2], P[BASE + 3]);   \
    unsigned b0 = cvtpk(P[BASE + 4], P[BASE + 5]), b1 = cvtpk(P[BASE + 6], P[BASE + 7]);                              \
    auto r0 = __builtin_amdgcn_permlane32_swap(a0, b0, false, false); auto r1 = __builtin_amdgcn_permlane32_swap(a1, b1, false, false); \
    u32x4 w = {r0[0], r1[0], r0[1], r1[1]}; OUT = *reinterpret_cast<h8*>(&w); } while (0)
    PK4(p0, 0, pa0); PK4(p0, 8, pa1); PK4(p1, 0, pa2); PK4(p1, 8, pa3);
#undef PK4
}
#define KSWZ(row, colB) ((row) * KRB + ((colB) ^ (((row) & 7) << 4)))
template <int DQK> __device__ __forceinline__ void qkt(f32x16& p0, f32x16& p1, const char* Ks, const h8* qr, int r32, int hi) {
    constexpr int KRB = Cfg<DQK>::KRB;
    p0 = f32x16{}; p1 = f32x16{};
#pragma unroll
    for (int d0 = 0; d0 < Cfg<DQK>::ND0; ++d0) { const int cb = (d0 * 16 + hi * 8) * 2;
        const h8 b0 = *reinterpret_cast<const h8*>(Ks + KSWZ(r32, cb));
        const h8 b1 = *reinterpret_cast<const h8*>(Ks + KSWZ(32 + r32, cb));
        p0 = __builtin_amdgcn_mfma_f32_32x32x16_f16(b0, qr[d0], p0, 0, 0, 0);
        p1 = __builtin_amdgcn_mfma_f32_32x32x16_f16(b1, qr[d0], p1, 0, 0, 0); }
}
__device__ __forceinline__ int v_st(int k, int c) { const int kk = (k & ~0xC) | ((k & 4) << 1) | ((k & 8) >> 1); return ((kk >> 3) * 4 + (c >> 5)) * 512 + ((kk & 7) * 32 + (c & 31)) * 2; }
__device__ __forceinline__ int v_rd_base(int lane) { return ((lane & 3) << 3) | (((lane >> 2) & 3) << 6) | (((lane >> 4) & 1) << 5) | (((lane >> 5) & 1) << 8); }
constexpr int v_rd_off(int d0, int ks, int half) { return d0 * 512 + ks * 4096 + half * 2048; }
template <int OFF> __device__ __forceinline__ s16x4 tr_read(int vb) {
    s16x4 r; asm volatile("ds_read_b64_tr_b16 %0, %1 offset:%2" : "=&v"(r) : "v"(vb), "i"(OFF) : "memory"); return r;
}
template <int D0> __device__ __forceinline__ void pv_one(f32x16& od, int vb, h8 pa0, h8 pa1, h8 pa2, h8 pa3) {
    const s16x4 l0 = tr_read<v_rd_off(D0, 0, 0)>(vb), h0 = tr_read<v_rd_off(D0, 0, 1)>(vb), l1 = tr_read<v_rd_off(D0, 1, 0)>(vb), h1 = tr_read<v_rd_off(D0, 1, 1)>(vb);
    const s16x4 l2 = tr_read<v_rd_off(D0, 2, 0)>(vb), h2_ = tr_read<v_rd_off(D0, 2, 1)>(vb), l3 = tr_read<v_rd_off(D0, 3, 0)>(vb), h3 = tr_read<v_rd_off(D0, 3, 1)>(vb);
    asm volatile("s_waitcnt lgkmcnt(0)" ::: "memory"); SBAR();
#define PKV(L, H) __builtin_bit_cast(h8, (__attribute__((ext_vector_type(8))) short){L[0], L[1], L[2], L[3], H[0], H[1], H[2], H[3]})
    od = __builtin_amdgcn_mfma_f32_32x32x16_f16(pa0, PKV(l0, h0), od, 0, 0, 0);
    od = __builtin_amdgcn_mfma_f32_32x32x16_f16(pa1, PKV(l1, h1), od, 0, 0, 0);
    od = __builtin_amdgcn_mfma_f32_32x32x16_f16(pa2, PKV(l2, h2_), od, 0, 0, 0);
    od = __builtin_amdgcn_mfma_f32_32x32x16_f16(pa3, PKV(l3, h3), od, 0, 0, 0);
#undef PKV
}
__device__ __forceinline__ void pv_d0(f32x16* o, int vb, h8 pa0, h8 pa1, h8 pa2, h8 pa3) {
    pv_one<0>(o[0], vb, pa0, pa1, pa2, pa3); pv_one<1>(o[1], vb, pa0, pa1, pa2, pa3); pv_one<2>(o[2], vb, pa0, pa1, pa2, pa3); pv_one<3>(o[3], vb, pa0, pa1, pa2, pa3);
}
template <int DQK, int LDQ, int LDK, int LDV, int LDO, int SDEPTH>
__device__ __forceinline__ void attn_body(const f16* Qb, const f16* Kh, const f16* Vh, f16* Ob, char* lds) {
    using C = Cfg<DQK>;
    constexpr int KRB = C::KRB, ND0 = C::ND0, NKCH = C::NKCH, KCPR = C::KCPR; constexpr size_t SHM_K = C::SHM_K;
    constexpr int seq = SEQ;
    int tid = threadIdx.x; asm volatile("" : "+v"(tid));
    const int wid = tid >> 6, lane = tid & 63, r32 = lane & 31, hi = lane >> 5;
    char* V_lds = lds; char* K_lds = lds + 2 * SHM_V;
    float* wsl = (float*)(lds + 2 * SHM_V + 2 * SHM_K) + wid * 64; float* li_l = wsl; float* al_l = wsl + 32;
    float m_reg = -1e30f, l_reg = 0; f32x16 o[4] = {}; h8 qr[ND0];
    const f16* Qw = Qb + (long)(wid * QBLK + r32) * LDQ + hi * 8;
#pragma unroll
    for (int d0 = 0; d0 < ND0; ++d0) qr[d0] = *reinterpret_cast<const h8*>(Qw + d0 * 16);
    const int sr = tid >> 4, sc = (tid & 15) * 8, vst0 = v_st(sr, sc), vst1 = v_st(32 + sr, sc);
    int krow[NKCH], kcb[NKCH];
#pragma unroll
    for (int i = 0; i < NKCH; ++i) { const int c = tid + i * 512; krow[i] = c / KCPR; kcb[i] = (c % KCPR) * 16; }
    const int vb0 = (int)(uintptr_t)V_lds + v_rd_base(lane);
    struct { h8 vs0, vs1; h8 ks[NKCH]; } sr_[SDEPTH];
#define SLOAD(i, k0) do { sr_[i].vs0 = *reinterpret_cast<const h8*>(&Vh[(long)((k0) + sr) * LDV + sc]); sr_[i].vs1 = *reinterpret_cast<const h8*>(&Vh[(long)((k0) + 32 + sr) * LDV + sc]); \
    _Pragma("unroll") for (int _c = 0; _c < NKCH; ++_c) sr_[i].ks[_c] = *reinterpret_cast<const h8*>((const char*)Kh + (long)((k0) + krow[_c]) * (LDK * 2) + kcb[_c]); } while (0)
#define SWRITE(b, i) do { *(h8*)(V_lds + (b) * SHM_V + vst0) = sr_[i].vs0; *(h8*)(V_lds + (b) * SHM_V + vst1) = sr_[i].vs1; \
    _Pragma("unroll") for (int _c = 0; _c < NKCH; ++_c) *(h8*)(K_lds + (b) * SHM_K + KSWZ(krow[_c], kcb[_c])) = sr_[i].ks[_c]; } while (0)
#define SWAIT() do { if constexpr (SDEPTH == 2) { if constexpr (NKCH == 3) asm volatile("s_waitcnt vmcnt(5)" ::: "memory"); else asm volatile("s_waitcnt vmcnt(3)" ::: "memory"); } \
    else asm volatile("s_waitcnt vmcnt(0)" ::: "memory"); } while (0)
#define RESC(a) do { if (__any((a) < 1.f)) { if (hi == 0) al_l[r32] = (a); asm volatile("s_waitcnt lgkmcnt(0)" ::: "memory"); \
    _Pragma("unroll") for (int d = 0; d < 4; ++d) _Pragma("unroll") for (int r = 0; r < 16; ++r) o[d][r] *= al_l[crow(r, hi)]; } } while (0)
    f32x16 pA0, pA1, pB0, pB1; float mnA, mnB, alA, alB; h8 pa0, pa1, pa2, pa3; constexpr int NT = seq / KVBLK;
    constexpr int SE = 0, SO = SDEPTH - 1;
    SLOAD(SE, 0); asm volatile("s_waitcnt vmcnt(0)" ::: "memory"); SWRITE(0, SE); __syncthreads();
    qkt<DQK>(pA0, pA1, K_lds, qr, r32, hi); partialSM<DQK>(pA0, pA1, m_reg, mnA, alA);
    SLOAD(SO, KVBLK); if constexpr (SDEPTH == 2) { if (2 < NT) SLOAD(SE, 2 * KVBLK); }
    SWAIT(); SWRITE(1, SO); __syncthreads();
    for (int j = 1; j + 1 < NT; j += 2) {
        SBAR(); qkt<DQK>(pB0, pB1, K_lds + SHM_K, qr, r32, hi);
        finishSM(pA0, pA1, alA, l_reg, pa0, pa1, pa2, pa3); SBAR();
        SLOAD(SO, (j + SDEPTH) * KVBLK); SBAR();
        pv_d0(o, vb0, pa0, pa1, pa2, pa3); partialSM<DQK>(pB0, pB1, m_reg, mnB, alB);
        __syncthreads(); SWAIT(); SWRITE(0, SE);
        RESC(alB); __syncthreads();
        SBAR(); qkt<DQK>(pA0, pA1, K_lds, qr, r32, hi);
        finishSM(pB0, pB1, alB, l_reg, pa0, pa1, pa2, pa3); SBAR();
        if (SDEPTH == 1 || j + 3 < NT) SLOAD(SE, (j + 1 + SDEPTH) * KVBLK); SBAR();
        pv_d0(o, vb0 + (int)SHM_V, pa0, pa1, pa2, pa3); partialSM<DQK>(pA0, pA1, m_reg, mnA, alA);
        __syncthreads(); SWAIT(); SWRITE(1, SO);
        RESC(alA); __syncthreads();
    }
    SBAR(); qkt<DQK>(pB0, pB1, K_lds + SHM_K, qr, r32, hi);
    finishSM(pA0, pA1, alA, l_reg, pa0, pa1, pa2, pa3); SBAR();
    pv_d0(o, vb0, pa0, pa1, pa2, pa3); partialSM<DQK>(pB0, pB1, m_reg, mnB, alB);
    __syncthreads(); RESC(alB);
    finishSM(pB0, pB1, alB, l_reg, pa0, pa1, pa2, pa3); SBAR();
    pv_d0(o, vb0 + (int)SHM_V, pa0, pa1, pa2, pa3);
    if (hi == 0) li_l[r32] = l_reg; asm volatile("s_waitcnt lgkmcnt(0)" ::: "memory");
    float rli[16];
#pragma unroll
    for (int r = 0; r < 16; ++r) rli[r] = __builtin_amdgcn_rcpf(li_l[crow(r, hi)]);
    f16* Ow = Ob + (long)(wid * QBLK) * LDO;
#pragma unroll
    for (int r = 0; r < 16; ++r) { const int orow = crow(r, hi);
#pragma unroll
        for (int d0 = 0; d0 < 4; ++d0) Ow[(long)orow * LDO + d0 * 32 + r32] = (f16)(o[d0][r] * rli[r]); }
    asm volatile("s_waitcnt vmcnt(0) lgkmcnt(0)" ::: "memory");
    __syncthreads();
#undef SLOAD
#undef SWRITE
#undef SWAIT
#undef RESC
}

template <int DQK, int LDQ, int LDK, int LDV, int LDO>
__device__ __forceinline__ void attn_body_simple(const f16* Qb, const f16* Kh, const f16* Vh, f16* Ob, char* lds) {
    using C = Cfg<DQK>;
    constexpr int KRB = C::KRB, ND0 = C::ND0, NKCH = C::NKCH, KCPR = C::KCPR; constexpr size_t SHM_K = C::SHM_K;
    int tid = threadIdx.x; asm volatile("" : "+v"(tid));
    const int wid = tid >> 6, lane = tid & 63, r32 = lane & 31, hi = lane >> 5;
    char* V_lds = lds; char* K_lds = lds + 2 * SHM_V;
    float* wsl = (float*)(lds + 2 * SHM_V + 2 * SHM_K) + wid * 64; float* li_l = wsl; float* al_l = wsl + 32;
    float m_reg = -1e30f, l_reg = 0; f32x16 o[4] = {}; h8 qr[ND0];
    const f16* Qw = Qb + (long)(wid * QBLK + r32) * LDQ + hi * 8;
#pragma unroll
    for (int d0 = 0; d0 < ND0; ++d0) qr[d0] = *reinterpret_cast<const h8*>(Qw + d0 * 16);
    const int sr = tid >> 4, sc = (tid & 15) * 8, vst0 = v_st(sr, sc), vst1 = v_st(32 + sr, sc);
    int krow[NKCH], kcb[NKCH];
#pragma unroll
    for (int i = 0; i < NKCH; ++i) { const int c = tid + i * 512; krow[i] = c / KCPR; kcb[i] = (c % KCPR) * 16; }
    const int vb0 = (int)(uintptr_t)V_lds + v_rd_base(lane);
    h8 vs0, vs1, ks[NKCH];
#define SLOAD1(k0) do { vs0 = *reinterpret_cast<const h8*>(&Vh[(long)((k0) + sr) * LDV + sc]); vs1 = *reinterpret_cast<const h8*>(&Vh[(long)((k0) + 32 + sr) * LDV + sc]); \
    _Pragma("unroll") for (int _c = 0; _c < NKCH; ++_c) ks[_c] = *reinterpret_cast<const h8*>((const char*)Kh + (long)((k0) + krow[_c]) * (LDK * 2) + kcb[_c]); } while (0)
#define SWRITE1(b) do { *(h8*)(V_lds + (b) * SHM_V + vst0) = vs0; *(h8*)(V_lds + (b) * SHM_V + vst1) = vs1; \
    _Pragma("unroll") for (int _c = 0; _c < NKCH; ++_c) *(h8*)(K_lds + (b) * SHM_K + KSWZ(krow[_c], kcb[_c])) = ks[_c]; } while (0)
    constexpr int NT = SEQ / KVBLK;
    SLOAD1(0); asm volatile("s_waitcnt vmcnt(0)" ::: "memory"); SWRITE1(0); __syncthreads();
#pragma unroll 1
    for (int j = 0; j < NT; ++j) {
        const int cb = j & 1;
        if (j + 1 < NT) SLOAD1((j + 1) * KVBLK);
        SBAR();
        f32x16 p0, p1; float mn, al; h8 pa0, pa1, pa2, pa3;
        qkt<DQK>(p0, p1, K_lds + cb * SHM_K, qr, r32, hi);
        partialSM<DQK>(p0, p1, m_reg, mn, al);
        if (__any(al < 1.f)) { if (hi == 0) al_l[r32] = al; asm volatile("s_waitcnt lgkmcnt(0)" ::: "memory");
#pragma unroll
            for (int d = 0; d < 4; ++d)
#pragma unroll
                for (int r = 0; r < 16; ++r) o[d][r] *= al_l[crow(r, hi)]; }
        finishSM(p0, p1, al, l_reg, pa0, pa1, pa2, pa3); SBAR();
        pv_d0(o, vb0 + cb * (int)SHM_V, pa0, pa1, pa2, pa3);
        if (j + 1 < NT) { SWRITE1(cb ^ 1); }
        __syncthreads();
    }
    if (hi == 0) li_l[r32] = l_reg; asm volatile("s_waitcnt lgkmcnt(0)" ::: "memory");
    float rli[16];
#pragma unroll
    for (int r = 0; r < 16; ++r) rli[r] = __builtin_amdgcn_rcpf(li_l[crow(r, hi)]);
    f16* Ow = Ob + (long)(wid * QBLK) * LDO;
#pragma unroll
    for (int r = 0; r < 16; ++r) { const int orow = crow(r, hi);
#pragma unroll
        for (int d0 = 0; d0 < 4; ++d0) Ow[(long)orow * LDO + d0 * 32 + r32] = (f16)(o[d0][r] * rli[r]); }
    asm volatile("s_waitcnt vmcnt(0) lgkmcnt(0)" ::: "memory");
    __syncthreads();
#undef SLOAD1
#undef SWRITE1
}
#undef KSWZ
#undef SBAR
}

struct Args { const void* in[22]; float* out; unsigned char* ws; int ph_lo, ph_hi, li, pad; };
typedef const __attribute__((address_space(4))) Args* KArgs;
__device__ __forceinline__ KArgs kargs() { KArgs p = (KArgs)__builtin_amdgcn_kernarg_segment_ptr(); asm volatile("" : "+s"(p)); return p; }
struct Frame {
    LAS unsigned char* lds; char* ldsg;
    int tid, lane, wave, vcu, G;
    unsigned char* ws;
};
extern __shared__ __attribute__((aligned(16))) unsigned char g_lds[];
__device__ __forceinline__ Frame mkframe(KArgs a) {
    Frame F; int t = threadIdx.x; asm volatile("" : "+v"(t));
    F.lds = (LAS unsigned char*)g_lds; F.ldsg = (char*)g_lds;
    F.tid = t; F.lane = t & 63; F.wave = __builtin_amdgcn_readfirstlane(t >> 6);
    int g = gridDim.x, bx = blockIdx.x; asm volatile("" : "+s"(g), "+s"(bx));
    F.G = g; F.vcu = (g % 8 == 0) ? (bx % 8) * (g / 8) + bx / 8 : bx;
    F.ws = a->ws;
    return F;
}

__device__ __forceinline__ void sincos_d(double a, float& s, float& c) {
    const double k = __builtin_rint(a * 0.63661977236758134308);
    double r = __builtin_fma(-k, 1.57079632679489655800e+00, a); r = __builtin_fma(-k, 6.12323399573676603587e-17, r);
    const double r2 = r * r;
    double sp = -7.6471637318198164759e-13;
    sp = __builtin_fma(sp, r2, 1.6059043836821614599e-10);
    sp = __builtin_fma(sp, r2, -2.5052108385441718775e-08);
    sp = __builtin_fma(sp, r2, 2.7557319223985890653e-06);
    sp = __builtin_fma(sp, r2, -1.9841269841269841270e-04);
    sp = __builtin_fma(sp, r2, 8.3333333333333333333e-03);
    sp = __builtin_fma(sp, r2, -1.6666666666666666667e-01);
    const double sr = __builtin_fma(sp * r2, r, r);
    double cp = 4.7794773323873852974e-14;
    cp = __builtin_fma(cp, r2, -1.1470745597729724714e-11);
    cp = __builtin_fma(cp, r2, 2.0876756987868098979e-09);
    cp = __builtin_fma(cp, r2, -2.7557319223985890653e-07);
    cp = __builtin_fma(cp, r2, 2.4801587301587301587e-05);
    cp = __builtin_fma(cp, r2, -1.3888888888888888889e-03);
    cp = __builtin_fma(cp, r2, 4.1666666666666666667e-02);
    cp = __builtin_fma(cp, r2, -0.5);
    const double cr = __builtin_fma(cp, r2, 1.0);
    const int q = (int)((long long)k & 3);
    const double ss = (q & 1) ? cr : sr, cc = (q & 1) ? sr : cr;
    s = (float)((q & 2) ? -ss : ss); c = (float)(((q + 1) & 2) ? -cc : cc);
}
__device__ const double INV_M[32] = {
    1.0, 0.7498942093324559, 0.5623413251903491, 0.4216965034285822, 0.31622776601683794, 0.23713737056616552, 0.1778279410038923, 0.1333521432163324,
    0.1, 0.07498942093324558, 0.05623413251903491, 0.04216965034285822, 0.03162277660168379, 0.023713737056616554, 0.01778279410038923, 0.01333521432163324,
    0.01, 0.007498942093324559, 0.005623413251903491, 0.004216965034285822, 0.0031622776601683794, 0.0023713737056616554, 0.001778279410038923, 0.001333521432163324,
    0.001, 0.0007498942093324559, 0.0005623413251903491, 0.0004216965034285822, 0.00031622776601683794, 0.00023713737056616554, 0.0001778279410038923, 0.0001333521432163324 };
__device__ const double INV_D[8] = { 1.0, 0.19392274474868576, 0.03760603093086393, 0.007292664737217109, 0.001414213562373095, 0.0002742481756762073, 5.318295896944988e-05, 1.031338537721246e-05 };

template <class FD>
__device__ __forceinline__ void tr_item64(const float* W, int Nsrc, int K, f16* WT, FD dstrow, LAS float* scr, int kb, int cb, int lane) {
    const int k0 = 64 * kb, c0 = 64 * cb, r4 = lane >> 4, cq = (lane & 15) * 4;
    f32x4 v[16];
#pragma unroll
    for (int i = 0; i < 16; ++i) v[i] = *(const f32x4*)(W + (size_t)(k0 + 4 * i + r4) * Nsrc + c0 + cq);
#pragma unroll
    for (int i = 0; i < 16; ++i) { const int k = 4 * i + r4, sw = (i >> 1) * 4;
#pragma unroll
        for (int w = 0; w < 4; ++w) scr[k * 64 + ((cq + w) ^ sw)] = v[i][w]; }
    LDS_WAIT(); asm volatile("" ::: "memory");
    const int c = lane & 7;
#pragma unroll
    for (int j = 0; j < 8; ++j) { const int col = (lane >> 3) + 8 * j; const int dr = dstrow(c0 + col); const LAS float* sp = scr + (8 * c) * 64 + (col ^ (c * 4));
        h8 o; o[0] = (f16)sp[0 * 64]; o[1] = (f16)sp[1 * 64]; o[2] = (f16)sp[2 * 64]; o[3] = (f16)sp[3 * 64]; o[4] = (f16)sp[4 * 64]; o[5] = (f16)sp[5 * 64]; o[6] = (f16)sp[6 * 64]; o[7] = (f16)sp[7 * 64];
        *(h8*)(WT + (size_t)dr * K + k0 + 8 * c) = o; }
    LDS_WAIT(); asm volatile("" ::: "memory");
}
struct RowId { __device__ __forceinline__ int operator()(int c) const { return c; } };
struct RowUq { __device__ __forceinline__ int operator()(int c) const { const int h = c / 192, j = c % 192; if (j < 128) return h * 128 + j; const int jj = j - 128; return 1024 + h * 64 + 2 * (jj & 31) + (jj >> 5); } };
struct RowDiff { __device__ __forceinline__ int operator()(int c) const { if (c >= 2048) return c; const int off = c & 63; if (off >= 16) return c; return (c & ~63) + 2 * (off & 7) + (off >> 3); } };
struct RowMoeIn { __device__ __forceinline__ int operator()(int c) const { const int f = c & 2047; return (f >> 2) * 8 + (f & 3) + ((c >> 11) << 2); } };

__device__ __forceinline__ void p0_prologue() {
    const KArgs a = kargs(); const Frame F = mkframe(a);
    const int tid = F.tid, lane = F.lane;
    {
        const float* cin = (const float*)a->in[1]; const float* ada_w = (const float*)a->in[3]; const float* ada_b = (const float*)a->in[4];
        float* mods = (float*)(F.ws + WS_MODS);
        LAS float* sc = (LAS float*)F.lds; LAS float* red = (LAS float*)(F.lds + 16384);
        for (int i = tid; i < 4096; i += NTHREADS) { const float v = cin[i]; sc[i] = v / (1.0f + __expf(-v)); }
        __syncthreads();
        for (int cb = blockIdx.x; cb < 256; cb += F.G) {
            const int f0 = cb * 48, l = f0 / 6144, e0 = f0 % 6144; const int g = tid / 12, cc = tid % 12;
            if (g < 40) { f32x4 a0 = {0.f, 0.f, 0.f, 0.f}, a1 = a0, a2 = a0, a3 = a0; const float* wp = ada_w + (size_t)l * 1024 * 6144 + e0 + 4 * cc;
                f32x4 w[26];
#pragma unroll
                for (int i = 0; i < 26; ++i) { const int d = g + 40 * i; w[i] = (d < 1024) ? *(const f32x4*)(wp + (size_t)d * 6144) : (f32x4){0.f, 0.f, 0.f, 0.f}; }
#pragma unroll
                for (int i = 0; i < 26; ++i) { const int d = (g + 40 * i) & 1023; a0 += w[i] * sc[d]; a1 += w[i] * sc[1024 + d]; a2 += w[i] * sc[2048 + d]; a3 += w[i] * sc[3072 + d]; }
                LAS f32x4* rp = (LAS f32x4*)red + (g * 12 + cc) * 4; rp[0] = a0; rp[1] = a1; rp[2] = a2; rp[3] = a3; }
            __syncthreads();
            if (tid < 192) { const int c2 = tid % 48, b = tid / 48; float s = 0.f;
#pragma unroll 8
                for (int gg = 0; gg < 40; ++gg) s += red[((gg * 12 + (c2 >> 2)) * 4 + b) * 4 + (c2 & 3)];
                mods[(size_t)(l * 4 + b) * 6144 + e0 + c2] = s + ada_b[l * 6144 + e0 + c2]; }
            __syncthreads();
        }
    }
    {
        const int* pos = (const int*)a->in[2];
        float* cosm = (float*)(F.ws + WS_COSM); float* sinm = (float*)(F.ws + WS_SINM); float* cosd = (float*)(F.ws + WS_COSD); float* sind = (float*)(F.ws + WS_SIND);
        for (int i = blockIdx.x * NTHREADS + tid; i < T * 40; i += F.G * NTHREADS) {
            const int t = i / 40, j = i % 40; const double p = (double)pos[t]; float s, c;
            if (j < 32) { sincos_d(p * INV_M[j], s, c); cosm[(size_t)t * 32 + j] = c; sinm[(size_t)t * 32 + j] = s; }
            else { sincos_d(p * INV_D[j - 32], s, c); cosd[(size_t)t * 8 + (j - 32)] = c; sind[(size_t)t * 8 + (j - 32)] = s; }
        }
    }
    {
        LAS float* scr = (LAS float*)(F.lds + F.wave * 16384);
        const int gw = F.vcu * NWAVES + F.wave, NGW = F.G * NWAVES;
        { f16* z = (f16*)(F.ws + WS_WIN0) + (size_t)704 * 1024; for (int i = blockIdx.x * NTHREADS + tid; i < 8192; i += F.G * NTHREADS) *(u32x4*)(z + (size_t)i * 8) = (u32x4){0u, 0u, 0u, 0u}; }
        __syncthreads();
        constexpr int I0 = 16 * 11, I1 = 6 * 24, I2 = 4 * 32, I3 = 16 * 16, I4 = 16 * 48, I5 = 16 * 16;
        constexpr int ISM = I0 + I1 + I2 + I3 + I4 + I5;
        constexpr int IMI = 16 * 64, IMO = 32 * 16;
        constexpr int NITEMS = ISM + 32 * IMI + 32 * IMO;
        for (int it = gw; it < NITEMS; it += NGW) {
            int r = it;
            if (r < I0) { tr_item64((const float*)a->in[9], 704, 1024, (f16*)(F.ws + WS_WIN0), RowId(), scr, r / 11, r % 11, lane); continue; } r -= I0;
            if (r < I1) { tr_item64((const float*)a->in[12], 1536, 384, (f16*)(F.ws + WS_WUQ), RowUq(), scr, r / 24, r % 24, lane); continue; } r -= I1;
            if (r < I2) { tr_item64((const float*)a->in[13], 2048, 256, (f16*)(F.ws + WS_WUKV), RowId(), scr, r / 32, r % 32, lane); continue; } r -= I2;
            if (r < I3) { tr_item64((const float*)a->in[14], 1024, 1024, (f16*)(F.ws + WS_WO0), RowId(), scr, r / 16, r % 16, lane); continue; } r -= I3;
            if (r < I4) { tr_item64((const float*)a->in[15], 3072, 1024, (f16*)(F.ws + WS_WIN1), RowDiff(), scr, r / 48, r % 48, lane); continue; } r -= I4;
            if (r < I5) { tr_item64((const float*)a->in[18], 1024, 1024, (f16*)(F.ws + WS_WO1), RowId(), scr, r / 16, r % 16, lane); continue; } r -= I5;
            if (r < 32 * IMI) { const int mat = r / IMI, rr = r % IMI;
                tr_item64((const float*)a->in[20] + (size_t)mat * 1024 * 4096, 4096, 1024, (f16*)(F.ws + WS_MOEIN) + (size_t)mat * 4096 * 1024, RowMoeIn(), scr, rr / 64, rr % 64, lane); continue; }
            r -= 32 * IMI;
            { const int mat = r / IMO, rr = r % IMO;
                tr_item64((const float*)a->in[21] + (size_t)mat * 2048 * 1024, 1024, 2048, (f16*)(F.ws + WS_MOEOUT) + (size_t)mat * 1024 * 2048, RowId(), scr, rr / 16, rr % 16, lane); }
        }
    }
}

__device__ __forceinline__ void mod_rows_p1() {
    const KArgs a = kargs(); const Frame F = mkframe(a);
    const float* x = (const float*)a->in[0]; const float* mods_l = (const float*)(F.ws + WS_MODS); f16* out = (f16*)(F.ws + WS_HA);
    const int gw = F.vcu * NWAVES + F.wave, NGW = F.G * NWAVES, lane = F.lane;
    for (int m0 = gw; m0 < T; m0 += 2 * NGW) {
        f32x4 v[2][4];
#pragma unroll
        for (int u = 0; u < 2; ++u) { const int m = m0 + u * NGW; if (m < T) {
#pragma unroll
            for (int j = 0; j < 4; ++j) v[u][j] = *(const f32x4*)(x + (size_t)m * DM + 4 * lane + 256 * j); } }
#pragma unroll
        for (int u = 0; u < 2; ++u) { const int m = m0 + u * NGW; if (m < T) { const float* mb = mods_l + (m >> 12) * 6144;
#pragma unroll
            for (int j = 0; j < 4; ++j) { const int c = 4 * lane + 256 * j; const f32x4 sh = *(const f32x4*)(mb + c), sc = *(const f32x4*)(mb + 1024 + c);
                const f32x4 h = v[u][j] * (sc + 1.0f) + sh; h4 o; o[0] = (f16)h[0]; o[1] = (f16)h[1]; o[2] = (f16)h[2]; o[3] = (f16)h[3];
                *(h4*)(out + (size_t)m * DM + c) = o; } } }
    }
}

__device__ __forceinline__ void latent_prep() {
    const KArgs a = kargs(); const Frame F = mkframe(a);
    const float* lat = (const float*)(F.ws + WS_LAT); const float* qn = (const float*)a->in[10]; const float* kvn = (const float*)a->in[11];
    f16* cqn = (f16*)(F.ws + WS_CQN); f16* ckvn = (f16*)(F.ws + WS_CKVN); f16* Kp = (f16*)(F.ws + WS_K);
    const float* cosm = (const float*)(F.ws + WS_COSM); const float* sinm = (const float*)(F.ws + WS_SINM);
    const int gw = F.vcu * NWAVES + F.wave, NGW = F.G * NWAVES, lane = F.lane;
    for (int m = gw; m < T; m += NGW) { const float* row = lat + (size_t)m * 768;
        const f32x4 q0 = *(const f32x4*)(row + 4 * lane); f32x4 q1 = (f32x4){0.f, 0.f, 0.f, 0.f}; if (lane < 32) q1 = *(const f32x4*)(row + 256 + 4 * lane);
        const f32x4 kv = *(const f32x4*)(row + 384 + 4 * lane);
        float sq = (q0[0] * q0[0] + q0[1] * q0[1]) + (q0[2] * q0[2] + q0[3] * q0[3]) + (q1[0] * q1[0] + q1[1] * q1[1]) + (q1[2] * q1[2] + q1[3] * q1[3]);
        float sk = (kv[0] * kv[0] + kv[1] * kv[1]) + (kv[2] * kv[2] + kv[3] * kv[3]);
        sq = wave_sum(sq); sk = wave_sum(sk);
        const float rq = 1.0f / sqrtf(sq * (1.0f / 384.0f) + LAT_EPS), rk = 1.0f / sqrtf(sk * (1.0f / 256.0f) + LAT_EPS);
        { const f32x4 g = *(const f32x4*)(qn + 4 * lane); h4 o; o[0] = (f16)(q0[0] * rq * g[0]); o[1] = (f16)(q0[1] * rq * g[1]); o[2] = (f16)(q0[2] * rq * g[2]); o[3] = (f16)(q0[3] * rq * g[3]);
          *(h4*)(cqn + (size_t)m * 384 + 4 * lane) = o; }
        if (lane < 32) { const f32x4 g = *(const f32x4*)(qn + 256 + 4 * lane); h4 o; o[0] = (f16)(q1[0] * rq * g[0]); o[1] = (f16)(q1[1] * rq * g[1]); o[2] = (f16)(q1[2] * rq * g[2]); o[3] = (f16)(q1[3] * rq * g[3]);
          *(h4*)(cqn + (size_t)m * 384 + 256 + 4 * lane) = o; }
        { const f32x4 g = *(const f32x4*)(kvn + 4 * lane); h4 o; o[0] = (f16)(kv[0] * rk * g[0]); o[1] = (f16)(kv[1] * rk * g[1]); o[2] = (f16)(kv[2] * rk * g[2]); o[3] = (f16)(kv[3] * rk * g[3]);
          *(h4*)(ckvn + (size_t)m * 256 + 4 * lane) = o; }
        if (lane < 32) { const float x1 = row[640 + lane], x2 = row[672 + lane], cs = cosm[(size_t)m * 32 + lane], sn = sinm[(size_t)m * 32 + lane];
            h2 o; o[0] = (f16)(x1 * cs - x2 * sn); o[1] = (f16)(x2 * cs + x1 * sn);
#pragma unroll
            for (int h = 0; h < 8; ++h) *(h2*)(Kp + (size_t)m * 1536 + h * 192 + 128 + 2 * lane) = o; }
    }
}

__device__ __forceinline__ void ln_router(int l) {
    const KArgs a = kargs(); const Frame F = mkframe(a);
    const float* lng = (const float*)a->in[5] + l * DM; const float* lnb = (const float*)a->in[6] + l * DM; const float* router_w = (const float*)a->in[19] + (size_t)l * DM * NE;
    const float* mods_l = (const float*)(F.ws + WS_MODS) + (size_t)l * 4 * 6144;
    const float* pre = (const float*)(F.ws + WS_PRE); float* x1 = (float*)(F.ws + WS_X1); f16* hB = (f16*)(F.ws + WS_HB); float* aff = (float*)(F.ws + WS_AFF);
    LAS float* rwT = (LAS float*)F.lds;
    for (int i = F.tid; i < 16384; i += NTHREADS) { const int d = i >> 4, e = i & 15; rwT[e * 1024 + d] = router_w[i]; }
    __syncthreads();
    const int gw = F.vcu * NWAVES + F.wave, NGW = F.G * NWAVES, lane = F.lane;
    for (int m0 = gw; m0 < T; m0 += 2 * NGW) {
        f32x4 vv[2][4];
#pragma unroll
        for (int u = 0; u < 2; ++u) { const int m = m0 + u * NGW; if (m < T) {
#pragma unroll
            for (int j = 0; j < 4; ++j) vv[u][j] = *(const f32x4*)(pre + (size_t)m * DM + 4 * lane + 256 * j); } }
#pragma unroll
        for (int u = 0; u < 2; ++u) { const int m = m0 + u * NGW; if (m < T) {
        const int b = m >> 12, s_ = m & 4095; const float* mb = mods_l + b * 6144;
        f32x4 v[4]; float s = 0.f;
#pragma unroll
        for (int j = 0; j < 4; ++j) { v[j] = vv[u][j]; s += (v[j][0] + v[j][1]) + (v[j][2] + v[j][3]); }
        const float mean = wave_sum(s) * (1.f / DM); float s2 = 0.f;
#pragma unroll
        for (int j = 0; j < 4; ++j) { v[j] = v[j] - mean; s2 += (v[j][0] * v[j][0] + v[j][1] * v[j][1]) + (v[j][2] * v[j][2] + v[j][3] * v[j][3]); }
        const float rstd = 1.0f / sqrtf(wave_sum(s2) * (1.f / DM) + LN_EPS);
        float lg[16];
#pragma unroll
        for (int e = 0; e < 16; ++e) lg[e] = 0.f;
#pragma unroll
        for (int j = 0; j < 4; ++j) { const int c = 4 * lane + 256 * j;
            const f32x4 g = *(const f32x4*)(lng + c), bb = *(const f32x4*)(lnb + c), sh = *(const f32x4*)(mb + 3072 + c), sc = *(const f32x4*)(mb + 4096 + c);
            const f32x4 xn = v[j] * rstd * g + bb; *(f32x4*)(x1 + (size_t)m * DM + c) = xn;
            const f32x4 h = xn * (sc + 1.0f) + sh; h4 o; o[0] = (f16)h[0]; o[1] = (f16)h[1]; o[2] = (f16)h[2]; o[3] = (f16)h[3]; *(h4*)(hB + (size_t)m * DM + c) = o;
#pragma unroll
            for (int e = 0; e < 16; ++e) { const f32x4 w = *(const LAS f32x4*)(rwT + e * 1024 + c); lg[e] += (h[0] * w[0] + h[1] * w[1]) + (h[2] * w[2] + h[3] * w[3]); }
            asm volatile("" ::: "memory"); }
        float mx = -1e30f;
#pragma unroll
        for (int e = 0; e < 16; ++e) { lg[e] = wave_sum(lg[e]); mx = fmaxf(mx, lg[e]); }
        float den = 0.f;
#pragma unroll
        for (int e = 0; e < 16; ++e) { lg[e] = __expf(lg[e] - mx); den += lg[e]; }
        const float rden = 1.0f / den; float mine = 0.f;
#pragma unroll
        for (int e = 0; e < 16; ++e) mine = (lane == e) ? lg[e] * rden : mine;
        if (lane < 16) aff[(size_t)(b * 16 + lane) * SEQ + s_] = mine;
        } }
    }
    __syncthreads();
}

__device__ __forceinline__ int block_excl_scan(int v, LAS int* tmp, int tid, int& total) {
    const int lane = tid & 63, wid = tid >> 6; int x = v;
#pragma unroll
    for (int o = 1; o < 64; o <<= 1) { const int y = __shfl_up(x, o); if (lane >= o) x += y; }
    if (lane == 63) tmp[wid] = x;
    __syncthreads();
    int base = 0, tot = 0;
#pragma unroll
    for (int w = 0; w < 8; ++w) { const int t = tmp[w]; if (w < wid) base += t; tot += t; }
    __syncthreads();
    total = tot; return base + x - v;
}
__device__ __forceinline__ void topk_phase() {
    const KArgs a = kargs(); const Frame F = mkframe(a);
    const float* aff = (const float*)(F.ws + WS_AFF); float* gate = (float*)(F.ws + WS_GATE); int* rowtok = (int*)(F.ws + WS_ROWTOK); int* inv = (int*)(F.ws + WS_INV);
    LAS unsigned* hist = (LAS unsigned*)F.lds; LAS unsigned* selw = hist + 256; LAS int* tmp = (LAS int*)(hist + 272);
    const int tid = F.tid;
    for (int p = blockIdx.x; p < NB * NE; p += F.G) { const int b = p >> 4, e = p & 15;
        const float* ap = aff + (size_t)p * SEQ + 8 * tid; unsigned key[8];
        { const f32x4 a0 = *(const f32x4*)ap, a1 = *(const f32x4*)(ap + 4);
          key[0] = __float_as_uint(a0[0]); key[1] = __float_as_uint(a0[1]); key[2] = __float_as_uint(a0[2]); key[3] = __float_as_uint(a0[3]);
          key[4] = __float_as_uint(a1[0]); key[5] = __float_as_uint(a1[1]); key[6] = __float_as_uint(a1[2]); key[7] = __float_as_uint(a1[3]); }
        unsigned prefix = 0u, kk = CAP;
        for (int pass = 0; pass < 4; ++pass) { const int shift = 24 - 8 * pass;
            if (tid < 256) hist[tid] = 0u;
            __syncthreads();
#pragma unroll
            for (int j = 0; j < 8; ++j) { const bool match = (pass == 0) || ((key[j] >> (shift + 8)) == prefix); if (match) atomicAdd((unsigned*)&hist[(key[j] >> shift) & 255u], 1u); }
            __syncthreads();
            if (tid < 256) { unsigned S = 0u; for (int j = 0; j <= tid; ++j) S += hist[255 - j]; const unsigned Sp = S - hist[255 - tid];
                if (Sp < kk && kk <= S) { selw[0] = 255u - (unsigned)tid; selw[1] = kk - Sp; } }
            __syncthreads();
            prefix = (prefix << 8) | selw[0]; kk = selw[1];
            __syncthreads();
        }
        int ce = 0;
#pragma unroll
        for (int j = 0; j < 8; ++j) ce += (key[j] == prefix) ? 1 : 0;
        int tot; int eqr = block_excl_scan(ce, tmp, tid, tot);
        unsigned selm = 0u; int cs = 0;
#pragma unroll
        for (int j = 0; j < 8; ++j) { bool sel = key[j] > prefix; if (key[j] == prefix) { sel = (unsigned)eqr < kk; ++eqr; } if (sel) { selm |= 1u << j; ++cs; } }
        int slot = block_excl_scan(cs, tmp, tid, tot);
#pragma unroll
        for (int j = 0; j < 8; ++j) { const int s_ = 8 * tid + j; const int tok = b * SEQ + s_; const bool sel = (selm >> j) & 1u;
            if (sel) { const int row = e * EROWS + b * CAP + slot; rowtok[row] = tok; gate[row] = __uint_as_float(key[j]); inv[(size_t)tok * 16 + e] = slot; ++slot; }
            else inv[(size_t)tok * 16 + e] = -1; }
        __syncthreads();
    }
}
__device__ __forceinline__ void gather_rows() {
    const KArgs a = kargs(); const Frame F = mkframe(a);
    const int* rowtok = (const int*)(F.ws + WS_ROWTOK); const f16* hB = (const f16*)(F.ws + WS_HB); f16* xe = (f16*)(F.ws + WS_XE);
    const int gw = F.vcu * NWAVES + F.wave, NGW = F.G * NWAVES, lane = F.lane;
    for (int r0 = gw; r0 < MROWS; r0 += 4 * NGW) {
        int tok[4]; h8 d0[4], d1[4];
#pragma unroll
        for (int u = 0; u < 4; ++u) { const int r = r0 + u * NGW; tok[u] = (r < MROWS) ? rowtok[r] : 0; }
#pragma unroll
        for (int u = 0; u < 4; ++u) { d0[u] = *(const h8*)(hB + (size_t)tok[u] * DM + 8 * lane); d1[u] = *(const h8*)(hB + (size_t)tok[u] * DM + 512 + 8 * lane); }
#pragma unroll
        for (int u = 0; u < 4; ++u) { const int r = r0 + u * NGW; if (r < MROWS) { *(h8*)(xe + (size_t)r * DM + 8 * lane) = d0[u]; *(h8*)(xe + (size_t)r * DM + 512 + 8 * lane) = d1[u]; } }
    }
}
__device__ __forceinline__ void combine_ln(int l) {
    const KArgs a = kargs(); const Frame F = mkframe(a);
    const float* lng = (const float*)a->in[7] + l * DM; const float* lnb = (const float*)a->in[8] + l * DM;
    const float* mods_l = (const float*)(F.ws + WS_MODS) + (size_t)l * 4 * 6144; const float* mods_next = (const float*)(F.ws + WS_MODS) + (size_t)4 * 6144;
    float* xo = (l == 0) ? (float*)(F.ws + WS_X2) : a->out; f16* hA = (l == 0) ? (f16*)(F.ws + WS_HA) : (f16*)nullptr;
    const float* x1 = (const float*)(F.ws + WS_X1); const f16* y = (const f16*)(F.ws + WS_Y); const int* inv = (const int*)(F.ws + WS_INV);
    const int gw = F.vcu * NWAVES + F.wave, NGW = F.G * NWAVES, lane = F.lane;
    for (int m0 = gw; m0 < T; m0 += 2 * NGW) {
        int myinv[2]; f32x4 xv[2][4];
#pragma unroll
        for (int u = 0; u < 2; ++u) { const int m = (m0 + u * NGW < T) ? m0 + u * NGW : m0; myinv[u] = inv[(size_t)m * 16 + (lane & 15)];
#pragma unroll
            for (int j = 0; j < 4; ++j) xv[u][j] = *(const f32x4*)(x1 + (size_t)m * DM + 4 * lane + 256 * j); }
#pragma unroll
        for (int u = 0; u < 2; ++u) { const int m = m0 + u * NGW; if (m < T) {
        const int b = m >> 12; const float* mb = mods_l + b * 6144;
        f32x4 f[4];
#pragma unroll
        for (int j = 0; j < 4; ++j) f[j] = (f32x4){0.f, 0.f, 0.f, 0.f};
        unsigned mask = (unsigned)(__ballot(myinv[u] >= 0) & 0xFFFFull);
        while (mask) {
            const int e0 = __builtin_ctz(mask); mask &= mask - 1u; const bool two = mask != 0u; const int e1 = two ? __builtin_ctz(mask) : e0; mask &= mask - 1u;
            const int s0 = __shfl(myinv[u], e0), s1 = __shfl(myinv[u], e1);
            const f16* y0 = y + (size_t)(e0 * EROWS + b * CAP + s0) * DM; const f16* y1 = y + (size_t)(e1 * EROWS + b * CAP + s1) * DM;
            h4 a0[4], a1[4];
#pragma unroll
            for (int j = 0; j < 4; ++j) { a0[j] = *(const h4*)(y0 + 4 * lane + 256 * j); a1[j] = *(const h4*)(y1 + 4 * lane + 256 * j); }
            const float w1 = two ? 1.0f : 0.0f;
#pragma unroll
            for (int j = 0; j < 4; ++j) { f[j][0] += (float)a0[j][0]; f[j][1] += (float)a0[j][1]; f[j][2] += (float)a0[j][2]; f[j][3] += (float)a0[j][3]; }
#pragma unroll
            for (int j = 0; j < 4; ++j) { f[j][0] += w1 * (float)a1[j][0]; f[j][1] += w1 * (float)a1[j][1]; f[j][2] += w1 * (float)a1[j][2]; f[j][3] += w1 * (float)a1[j][3]; }
        }
        f32x4 v[4]; float s = 0.f;
#pragma unroll
        for (int j = 0; j < 4; ++j) { const int c = 4 * lane + 256 * j; const f32x4 g2 = *(const f32x4*)(mb + 5120 + c);
            v[j] = xv[u][j] * ALPHA + (g2 + 1.0f) * f[j]; s += (v[j][0] + v[j][1]) + (v[j][2] + v[j][3]); }
        const float mean = wave_sum(s) * (1.f / DM); float s2 = 0.f;
#pragma unroll
        for (int j = 0; j < 4; ++j) { v[j] = v[j] - mean; s2 += (v[j][0] * v[j][0] + v[j][1] * v[j][1]) + (v[j][2] * v[j][2] + v[j][3] * v[j][3]); }
        const float rstd = 1.0f / sqrtf(wave_sum(s2) * (1.f / DM) + LN_EPS);
#pragma unroll
        for (int j = 0; j < 4; ++j) { const int c = 4 * lane + 256 * j; const f32x4 g = *(const f32x4*)(lng + c), bb = *(const f32x4*)(lnb + c);
            const f32x4 xn = v[j] * rstd * g + bb; *(f32x4*)(xo + (size_t)m * DM + c) = xn;
            if (hA) { const float* mn = mods_next + b * 6144; const f32x4 sh = *(const f32x4*)(mn + c), sc = *(const f32x4*)(mn + 1024 + c);
                const f32x4 h = xn * (sc + 1.0f) + sh; h4 o; o[0] = (f16)h[0]; o[1] = (f16)h[1]; o[2] = (f16)h[2]; o[3] = (f16)h[3]; *(h4*)(hA + (size_t)m * DM + c) = o; } }
        } }
    }
}
__device__ __forceinline__ void diff_combine() {
    const KArgs a = kargs(); const Frame F = mkframe(a);
    const float* lamv = (const float*)a->in[16]; const float* subln = (const float*)a->in[17];
    const f16* od = (const f16*)(F.ws + WS_OD); f16* o16 = (f16*)(F.ws + WS_O);
    const int gw = F.vcu * NWAVES + F.wave, NGW = F.G * NWAVES, lane = F.lane;
    const float l01 = wave_sum(lamv[lane] * lamv[64 + lane]), l23 = wave_sum(lamv[128 + lane] * lamv[192 + lane]);
    const float lam = expf(l01) - expf(l23) + LAMBDA_INIT;
    const int h = lane >> 3, d0 = (lane & 7) * 16;
    float sl[16];
#pragma unroll
    for (int i = 0; i < 16; ++i) sl[i] = subln[d0 + i] * (1.0f - LAMBDA_INIT);
    for (int m0 = gw; m0 < T; m0 += 2 * NGW) {
        h8 qa0[2], qa1[2], qb0[2], qb1[2];
#pragma unroll
        for (int u = 0; u < 2; ++u) { const int m = (m0 + u * NGW < T) ? m0 + u * NGW : m0; const f16* r0 = od + (size_t)m * 2048 + (2 * h) * 128 + d0; const f16* r1 = r0 + 128;
            qa0[u] = *(const h8*)r0; qa1[u] = *(const h8*)(r0 + 8); qb0[u] = *(const h8*)r1; qb1[u] = *(const h8*)(r1 + 8); }
#pragma unroll
        for (int u = 0; u < 2; ++u) { const int m = m0 + u * NGW; if (m < T) {
        const h8 a0 = qa0[u], a1 = qa1[u], b0 = qb0[u], b1 = qb1[u];
        float o[16]; float ss = 0.f;
#pragma unroll
        for (int i = 0; i < 8; ++i) { o[i] = (float)a0[i] - lam * (float)b0[i]; o[8 + i] = (float)a1[i] - lam * (float)b1[i]; }
#pragma unroll
        for (int i = 0; i < 16; ++i) ss += o[i] * o[i];
        ss += __shfl_xor(ss, 1); ss += __shfl_xor(ss, 2); ss += __shfl_xor(ss, 4);
        const float rs = 1.0f / sqrtf(ss * (1.0f / 128.0f) + LN_EPS);
        h8 w0, w1;
#pragma unroll
        for (int i = 0; i < 8; ++i) { w0[i] = (f16)(o[i] * rs * sl[i]); w1[i] = (f16)(o[8 + i] * rs * sl[8 + i]); }
        *(h8*)(o16 + (size_t)m * DM + h * 128 + d0) = w0; *(h8*)(o16 + (size_t)m * DM + h * 128 + d0 + 8) = w1; } }
    }
}

__device__ __forceinline__ void attn_mla() {
    const KArgs a = kargs(); const Frame F = mkframe(a);
    const f16* Q = (const f16*)(F.ws + WS_Q); const f16* K = (const f16*)(F.ws + WS_K); const f16* V = (const f16*)(F.ws + WS_V); f16* O = (f16*)(F.ws + WS_O);
    for (int u = F.vcu; u < NB * 8 * 16; u += F.G) { const int qb = u & 15, bh = u >> 4, h = bh & 7, b = bh >> 3;
        att::attn_body_simple<192, 1536, 1536, 1024, 1024>(Q + (size_t)(b * SEQ + qb * 256) * 1536 + h * 192, K + (size_t)(b * SEQ) * 1536 + h * 192, V + (size_t)(b * SEQ) * 1024 + h * 128,
                                                       O + (size_t)(b * SEQ + qb * 256) * 1024 + h * 128, F.ldsg); }
}
__device__ __forceinline__ void attn_diff() {
    const KArgs a = kargs(); const Frame F = mkframe(a);
    const f16* QKV = (const f16*)(F.ws + WS_QKV1); f16* O = (f16*)(F.ws + WS_OD);
    for (int u = F.vcu; u < NB * 16 * 16; u += F.G) { const int qb = u & 15, bh = u >> 4, hh = bh & 15, b = bh >> 4;
        att::attn_body<64, 3072, 3072, 3072, 2048, 2>(QKV + (size_t)(b * SEQ + qb * 256) * 3072 + hh * 64, QKV + (size_t)(b * SEQ) * 3072 + 1024 + hh * 64, QKV + (size_t)(b * SEQ) * 3072 + 2048 + (hh >> 1) * 128,
                                                      O + (size_t)(b * SEQ + qb * 256) * 2048 + hh * 128, F.ldsg); }
}

__device__ __forceinline__ void ph_gemm_lat() { const KArgs a = kargs(); const Frame F = mkframe(a);
    pg8::Gemm g{(const f16*)(F.ws + WS_HA), (const f16*)(F.ws + WS_WIN0), T, 768, 1024, 1 << 30, 0, nullptr}; pg8::StaticOrder S; S.init(T, 768, F.G, (int)blockIdx.x);
    EpiLat E{(float*)(F.ws + WS_LAT)}; pg8::gemm_phase<EpiLat>(F.lds, g, S, E); }
__device__ __forceinline__ void ph_gemm_q() { const KArgs a = kargs(); const Frame F = mkframe(a);
    pg8::Gemm g{(const f16*)(F.ws + WS_CQN), (const f16*)(F.ws + WS_WUQ), T, 1024, 384, 1 << 30, 0, nullptr}; pg8::StaticOrder S; S.init(T, 1024, F.G, (int)blockIdx.x);
    EpiQNope E{(f16*)(F.ws + WS_Q)}; pg8::gemm_phase<EpiQNope>(F.lds, g, S, E); }
__device__ __forceinline__ void ph_gemm_qr() { const KArgs a = kargs(); const Frame F = mkframe(a);
    pg8::Gemm g{(const f16*)(F.ws + WS_CQN), (const f16*)(F.ws + WS_WUQ) + (size_t)1024 * 384, T, 512, 384, 1 << 30, 0, nullptr}; pg8::StaticOrder S; S.init(T, 512, F.G, (int)blockIdx.x);
    EpiQRope E{(f16*)(F.ws + WS_Q), (const float*)(F.ws + WS_COSM), (const float*)(F.ws + WS_SINM)}; pg8::gemm_phase<EpiQRope>(F.lds, g, S, E); }
__device__ __forceinline__ void ph_gemm_kv() { const KArgs a = kargs(); const Frame F = mkframe(a);
    pg8::Gemm g{(const f16*)(F.ws + WS_CKVN), (const f16*)(F.ws + WS_WUKV), T, 2048, 256, 1 << 30, 0, nullptr}; pg8::StaticOrder S; S.init(T, 2048, F.G, (int)blockIdx.x);
    EpiKV E{(f16*)(F.ws + WS_K), (f16*)(F.ws + WS_V)}; pg8::gemm_phase<EpiKV>(F.lds, g, S, E); }
__device__ __forceinline__ void ph_gemm_o(int l) { const KArgs a = kargs(); const Frame F = mkframe(a);
    pg8::Gemm g{(const f16*)(F.ws + WS_O), (const f16*)(F.ws + (l == 0 ? WS_WO0 : WS_WO1)), T, 1024, 1024, 1 << 30, 0, nullptr}; pg8::StaticOrder S; S.init(T, 1024, F.G, (int)blockIdx.x);
    EpiPre E{l == 0 ? (const float*)a->in[0] : (const float*)(F.ws + WS_X2), (const float*)(F.ws + WS_MODS) + (size_t)l * 4 * 6144 + 2048, (float*)(F.ws + WS_PRE)}; pg8::gemm_phase<EpiPre>(F.lds, g, S, E); }
__device__ __forceinline__ void ph_gemm_diffin() { const KArgs a = kargs(); const Frame F = mkframe(a);
    pg8::Gemm g{(const f16*)(F.ws + WS_HA), (const f16*)(F.ws + WS_WIN1), T, 3072, 1024, 1 << 30, 0, nullptr}; pg8::StaticOrder S; S.init(T, 3072, F.G, (int)blockIdx.x);
    EpiDiffIn E{(f16*)(F.ws + WS_QKV1), (const float*)(F.ws + WS_COSD), (const float*)(F.ws + WS_SIND)}; pg8::gemm_phase<EpiDiffIn>(F.lds, g, S, E); }
__device__ __forceinline__ void ph_gemm_up(int l) { const KArgs a = kargs(); const Frame F = mkframe(a);
    pg8::Gemm g{(const f16*)(F.ws + WS_HB), (const f16*)(F.ws + WS_MOEIN) + (size_t)l * NE * 4096 * 1024, MROWS, 4096, 1024, EROWS / 256, (size_t)4096 * 1024, (const int*)(F.ws + WS_ROWTOK)}; pg8::StaticOrder S; S.init(MROWS, 4096, F.G, (int)blockIdx.x);
    EpiUp E{(f16*)(F.ws + WS_ACT)}; pg8::gemm_phase<EpiUp, true, true, true>(F.lds, g, S, E); }
__device__ __forceinline__ void ph_gemm_down(int l) { const KArgs a = kargs(); const Frame F = mkframe(a);
    pg8::Gemm g{(const f16*)(F.ws + WS_ACT), (const f16*)(F.ws + WS_MOEOUT) + (size_t)l * NE * 1024 * 2048, MROWS, 1024, 2048, EROWS / 256, (size_t)1024 * 2048, nullptr}; pg8::StaticOrder S; S.init(MROWS, 1024, F.G, (int)blockIdx.x);
    EpiDown E{(f16*)(F.ws + WS_Y), (const float*)(F.ws + WS_GATE)}; pg8::gemm_phase<EpiDown>(F.lds, g, S, E); }

constexpr int NPHASES = 24;
__global__ void __launch_bounds__(NTHREADS, 2) mk_fwd(Args args) {
    LAS unsigned char* ldsp = (LAS unsigned char*)g_lds;
    volatile LAS unsigned* MISC = (volatile LAS unsigned*)(ldsp + MISC_OFF);
    for (int u = threadIdx.x; u < (LDS_BYTES - LDSCTL_OFF) / 4; u += NTHREADS) ((LAS unsigned*)(ldsp + LDSCTL_OFF))[u] = 0u;
    __syncthreads();
    XcdBarrier bar = xcd_barrier_post((unsigned*)(args.ws + WS_CTL) + CW_BAR + args.li * XCD_BAR_WORDS, MISC + 8);
    const int lo = args.ph_lo, hi = args.ph_hi;
#ifndef PH_MASK
#define PH_MASK 0xFFFFFFFFu
#endif
#define IN(k) (((PH_MASK >> (k)) & 1u) && lo <= (k) && (k) < hi)
#define SEAM(k) do { if (lo <= (k) && (k) + 1 < hi) xcd_barrier(bar); } while (0)
#ifndef REP_MASK
#define REP_MASK 0u
#endif
#define RUN(k, call) do { if (IN(k)) { call; if ((REP_MASK >> (k)) & 1u) { __syncthreads(); call; } } } while (0)
    RUN(0, p0_prologue());      SEAM(0);
    RUN(1, mod_rows_p1());      SEAM(1);
    RUN(2, ph_gemm_lat());      SEAM(2);
    RUN(3, latent_prep());      SEAM(3);
    RUN(4, ph_gemm_q()); RUN(4, ph_gemm_qr());
    RUN(5, ph_gemm_kv());       SEAM(5);
    RUN(6, attn_mla());         SEAM(6);
#pragma unroll 1
    for (int l = 0; l < 2; ++l) {
        const int pb = (l == 0) ? 7 : 17;
        if (l == 1) {
            RUN(14, ph_gemm_diffin()); SEAM(14);
            RUN(15, attn_diff());      SEAM(15);
            RUN(16, diff_combine());   SEAM(16);
        }
        RUN(pb + 0, ph_gemm_o(l));     SEAM(pb + 0);
        RUN(pb + 1, ln_router(l));     SEAM(pb + 1);
        RUN(pb + 2, topk_phase());     SEAM(pb + 2);
        RUN(pb + 4, ph_gemm_up(l));    SEAM(pb + 4);
        RUN(pb + 5, ph_gemm_down(l));  SEAM(pb + 5);
        RUN(pb + 6, combine_ln(l));
        if (l == 0) SEAM(pb + 6);
    }
#undef IN
#undef SEAM
}

extern "C" void kernel_launch(void* const* d_in, const int* in_sizes, int n_in, void* d_out, int out_size, void* d_ws, size_t ws_size, hipStream_t stream) {
    static int grid = 0;
    if (grid == 0) {
        if (n_in != 22 || in_sizes[0] != T * DM || out_size != T * DM || ws_size < WS_END) {
            fprintf(stderr, "kernel_launch: shape/workspace mismatch: n_in %d in0 %d out %d ws %zu (need %zu)\n", n_in, n_in > 0 ? in_sizes[0] : -1, out_size, ws_size, (size_t)WS_END); grid = -1; return; }
        int dev = 0, cus = 0, per_cu = 0;
        if (hipGetDevice(&dev) != hipSuccess || hipDeviceGetAttribute(&cus, hipDeviceAttributeMultiprocessorCount, dev) != hipSuccess) { fprintf(stderr, "kernel_launch: device query failed\n"); grid = -1; return; }
        if (hipFuncSetAttribute((const void*)mk_fwd, hipFuncAttributeMaxDynamicSharedMemorySize, LDS_BYTES) != hipSuccess) { fprintf(stderr, "kernel_launch: hipFuncSetAttribute failed\n"); grid = -1; return; }
        if (hipOccupancyMaxActiveBlocksPerMultiprocessor(&per_cu, (const void*)mk_fwd, NTHREADS, LDS_BYTES) != hipSuccess || per_cu < 1)
            fprintf(stderr, "kernel_launch: note: occupancy query reports %d workgroups per CU\n", per_cu);
        (void)hipGetLastError();
        grid = cus;
    }
    if (grid < 0) return;
    if (hipMemsetAsync((char*)d_ws + WS_CTL, 0, CTL_ZERO_BYTES, stream) != hipSuccess) { fprintf(stderr, "kernel_launch: memset failed\n"); return; }
    Args a{};
    for (int i = 0; i < 22; ++i) a.in[i] = d_in[i];
    a.out = (float*)d_out; a.ws = (unsigned char*)d_ws;
#if MK_CUTS == 1
    a.ph_lo = 0; a.ph_hi = NPHASES; a.li = 0;
    hipLaunchKernelGGL(mk_fwd, dim3(grid), dim3(NTHREADS), LDS_BYTES, stream, a);
#else
    for (int p = 0; p < NPHASES; ++p) { a.ph_lo = p; a.ph_hi = p + 1; a.li = 0; hipLaunchKernelGGL(mk_fwd, dim3(grid), dim3(NTHREADS), LDS_BYTES, stream, a); }
#endif
    const hipError_t le = hipPeekAtLastError();
    if (le != hipSuccess) fprintf(stderr, "kernel_launch: launch failed: %s\n", hipGetErrorName(le));
}
```

```cpp
#include <hip/hip_runtime.h>
#include <cstdio>
#include <cstdint>

#ifndef MK_CUTS
#define MK_CUTS 1
#endif
#define REP_MASK 0x0u

#define LAS __attribute__((address_space(3)))
#define GAS __attribute__((address_space(1)))
typedef _Float16 f16;
typedef _Float16 h8 __attribute__((ext_vector_type(8)));
typedef _Float16 h4 __attribute__((ext_vector_type(4)));
typedef _Float16 h2 __attribute__((ext_vector_type(2)));
typedef short s16x4 __attribute__((ext_vector_type(4)));
typedef float f32x4 __attribute__((ext_vector_type(4)));
typedef float f32x2 __attribute__((ext_vector_type(2)));
typedef float f32x16 __attribute__((ext_vector_type(16)));
typedef unsigned u32x4 __attribute__((ext_vector_type(4)));
typedef unsigned u32x2 __attribute__((ext_vector_type(2)));

constexpr int NB = 4, SEQ = 4096, DM = 1024, T = NB * SEQ;
constexpr int NE = 16, FF = 2048, CAP = 512, EROWS = NB * CAP;
constexpr int MROWS = NE * EROWS;
constexpr float ALPHA = 1.4142135623730951f;
constexpr float LN_EPS = 1e-5f, LAT_EPS = 1e-6f;
constexpr float LAMBDA_INIT = 0.35550906759096926f;
constexpr int NWAVES = 8, NTHREADS = 512;

constexpr size_t MiB = 1u << 20;
constexpr size_t WS_CTL = 0, CTL_ZERO_BYTES = 1 * MiB;
constexpr size_t WS_MODS = 1 * MiB;
constexpr size_t WS_COSM = 2 * MiB, WS_SINM = 4 * MiB;
constexpr size_t WS_COSD = 6 * MiB, WS_SIND = 6 * MiB + 512 * 1024;
constexpr size_t WS_AFF = 7 * MiB;
constexpr size_t WS_GATE = 8 * MiB;
constexpr size_t WS_ROWTOK = 8 * MiB + 512 * 1024;
constexpr size_t WS_INV = 9 * MiB;
constexpr size_t WS_WIN0 = 16 * MiB;
constexpr size_t WS_WUQ = 18 * MiB;
constexpr size_t WS_WUKV = 20 * MiB;
constexpr size_t WS_WO0 = 22 * MiB;
constexpr size_t WS_WIN1 = 24 * MiB;
constexpr size_t WS_WO1 = 30 * MiB;
constexpr size_t WS_MOEIN = 32 * MiB;
constexpr size_t WS_MOEOUT = 288 * MiB;
constexpr size_t WS_HA = 416 * MiB;
constexpr size_t WS_HB = 448 * MiB;
constexpr size_t WS_PQ = 480 * MiB;
constexpr size_t WS_PKV = 481 * MiB;
constexpr size_t WS_CQN = 528 * MiB;
constexpr size_t WS_CKVN = 540 * MiB;
constexpr size_t WS_Q = 548 * MiB;
constexpr size_t WS_K = 596 * MiB;
constexpr size_t WS_V = 644 * MiB;
constexpr size_t WS_O = 676 * MiB;
constexpr size_t WS_PRE = 708 * MiB;
constexpr size_t WS_STAT = 772 * MiB;
constexpr size_t WS_X2 = 836 * MiB;
constexpr size_t WS_XE = 900 * MiB;
constexpr size_t WS_ACT = 964 * MiB;
constexpr size_t WS_Y = 1092 * MiB;
constexpr size_t WS_QKV1 = 1156 * MiB;
constexpr size_t WS_OD = 1252 * MiB;
constexpr size_t WS_END = 1316 * MiB;
constexpr int CW_BAR = 4096;

constexpr int RING_BYTES = 131072;
constexpr int LDSCTL_OFF = RING_BYTES, MISC_OFF = LDSCTL_OFF + 320;
constexpr int LDS_BYTES = 147456;

#define LDS_WAIT() asm volatile("s_waitcnt lgkmcnt(0)" ::: "memory")
#define VM_WAIT() asm volatile("s_waitcnt vmcnt(0)" ::: "memory")

__device__ __forceinline__ float wave_sum(float v) {
#pragma unroll
    for (int o = 1; o < 64; o <<= 1) v += __shfl_xor(v, o);
    return v;
}

#define XB_TMO      128
#define XB_XCNT(j)  (256  + 64 * (j))
#define XB_XSUB(j)  (1280 + 64 * (j))
#define XB_XGEN(j)  (2304 + 64 * (j))
#define XB_TOP      3328
#define XB_TOPGEN   3392
#define XCD_BAR_WORDS 3456
#define XB_SPIN_CAP (1u << 20)
__device__ __forceinline__ unsigned xb_ld(unsigned* p)              { return __hip_atomic_load(p, __ATOMIC_RELAXED, __HIP_MEMORY_SCOPE_AGENT); }
__device__ __forceinline__ unsigned xb_add(unsigned* p, unsigned v) { return __hip_atomic_fetch_add(p, v, __ATOMIC_RELAXED, __HIP_MEMORY_SCOPE_AGENT); }
__device__ __forceinline__ unsigned xb_xcc_id() { return (unsigned)__builtin_amdgcn_s_getreg((3 << 11) | 20) & 0xFu; }
#define XB_SPIN(cond, bar) do { unsigned _sp = 0; while (cond) { __builtin_amdgcn_s_sleep(1); \
    if ((++_sp & 255u) == 0u) { if (xb_ld(&(bar)[XB_TMO])) break; if (_sp > XB_SPIN_CAP) { atomicAdd(&(bar)[XB_TMO], 1u); break; } } } } while (0)
struct XcdBarrier { unsigned* bar; unsigned x; volatile LAS unsigned* st; };
__device__ __forceinline__ XcdBarrier xcd_barrier_post(unsigned* bar, volatile LAS unsigned* st) {
    XcdBarrier b; b.bar = bar; b.x = xb_xcc_id(); b.st = st;
    if (threadIdx.x == 0) (void)xb_add(&bar[XB_XCNT(b.x)], 1u);
    return b;
}
__device__ __forceinline__ void xcd_barrier_complete(unsigned* bar, unsigned x, unsigned& nloc, unsigned& nx) {
    const unsigned G = gridDim.x * gridDim.y * gridDim.z;
    unsigned sum, cnt, mine, sp = 0u;
    for (;;) {
        sum = 0u; cnt = 0u; mine = 0u;
#pragma unroll
        for (unsigned j = 0; j < 16; ++j) { const unsigned c = xb_ld(&bar[XB_XCNT(j)]); sum += c; cnt += (c > 0u) ? 1u : 0u; mine = (j == x) ? c : mine; }
        if (sum == G) break;
        __builtin_amdgcn_s_sleep(1);
        if ((++sp & 255u) == 0u) { if (xb_ld(&bar[XB_TMO])) break; if (sp > XB_SPIN_CAP) { atomicAdd(&bar[XB_TMO], 1u); break; } }
    }
    nloc = mine > 0u ? mine : 1u; nx = cnt > 0u ? cnt : 1u;
}
__device__ __forceinline__ void xcd_barrier(const XcdBarrier& b) {
    asm volatile("s_waitcnt vmcnt(0)" ::: "memory");
    __syncthreads();
    if (threadIdx.x == 0) {
        unsigned* bar = b.bar;
        __builtin_amdgcn_s_waitcnt(0);
        unsigned nloc = b.st[0], nx = b.st[1];
        if (nloc == 0u) { xcd_barrier_complete(bar, b.x, nloc, nx); b.st[0] = nloc; b.st[1] = nx; }
        const unsigned old = xb_add(&bar[XB_XSUB(b.x)], 1u);
        const unsigned gen = old / nloc;
        if (old + 1u == (gen + 1u) * nloc) {
            __builtin_amdgcn_fence(__ATOMIC_RELEASE, "agent");
            asm volatile("s_waitcnt vmcnt(0)" ::: "memory");
            const unsigned og = xb_add(&bar[XB_TOP], 1u);
            const unsigned tg = og / nx;
            if (og + 1u == (tg + 1u) * nx) xb_add(&bar[XB_TOPGEN], 1u);
            else XB_SPIN(xb_ld(&bar[XB_TOPGEN]) == tg, bar);
            __builtin_amdgcn_fence(__ATOMIC_ACQUIRE, "agent");
            xb_add(&bar[XB_XGEN(b.x)], 1u);
            asm volatile("s_waitcnt vmcnt(0)" ::: "memory");
        } else {
            XB_SPIN(xb_ld(&bar[XB_XGEN(b.x)]) == gen, bar);
            __builtin_amdgcn_fence(__ATOMIC_ACQUIRE, "agent");
            asm volatile("s_waitcnt vmcnt(0)" ::: "memory");
        }
    }
    __syncthreads();
}

namespace pg8 {
constexpr int BM = 256, BK = 64, HALF = 128, HTB = HALF * BK * 2, STAGE_BYTES = 8 * HTB, NXCD = 8, WGM = 8;
__host__ __device__ __forceinline__ int lds_byte(int r, int c) { const int st = (r >> 4) * 2 + (c >> 5), rr = r & 15, cc = c & 31, ob = rr * 64 + cc * 2; return st * 1024 + (ob ^ (((ob >> 9) & 1) << 5)); }
__host__ __device__ __forceinline__ void stage_rc(int b, int& R, int& C) { const int st = b / 1024, sb = b % 1024, swz = sb ^ (((sb >> 9) & 1) << 5); R = (st >> 1) * 16 + swz / 64; C = (st & 1) * 32 + (swz % 64) / 2; }
__host__ __device__ __forceinline__ int perm32(int rho) { const int n = rho >> 4, i = rho & 15; return 8 * (i >> 2) + 4 * n + (i & 3); }
struct Unit { int pm, pn; };
struct Gemm { const f16* A; const f16* Bt; int M, N, K; int grp_tiles; size_t grp_stride; const int* rowidx; };
struct StaticOrder {
    int nM, nN, nwg, G, c;
    __host__ __device__ void init(int M, int N, int G_, int c_) { nM = M / BM; nN = N / BM; nwg = nM * nN; G = G_; c = c_; }
    __host__ __device__ bool next(int i, Unit& u) const {
        const long L = (long)i * G + c; if (L >= nwg) return false;
        int wgid = (int)L; { const int q = nwg / NXCD, r = nwg % NXCD, xcd = wgid % NXCD, off = wgid / NXCD; wgid = (xcd < r ? xcd * (q + 1) : r * (q + 1) + (xcd - r) * q) + off; }
        const int nig = WGM * nN, gid = wgid / nig, fm = gid * WGM, gsz = (nM - fm) < WGM ? (nM - fm) : WGM;
        u.pm = fm + ((wgid % nig) % gsz); u.pn = (wgid % nig) / gsz; return true;
    }
};
constexpr int GATHER_MAX_UNITS = 15, GATHER_IDX_OFF = RING_BYTES + 1024;
template <class Epi, bool ALIGN_EPI = true, bool SP2 = true, bool GATHER = false>
__device__ __forceinline__ void gemm_phase(LAS unsigned char* lds, const Gemm g, const StaticOrder& S, const Epi& E) {
    int tid = threadIdx.x; asm volatile("" : "+v"(tid));
    const int wid = __builtin_amdgcn_readfirstlane(tid >> 6), lane = tid & 63, wr = wid >> 2, wc = wid & 3, fr = lane & 15, fq = lane >> 4;
    const int K = g.K, nt = K / BK;
    unsigned voffA[2], voffB[2];
#pragma unroll
    for (int i = 0; i < 2; ++i) { int R, C; stage_rc(tid * 16 + i * 8192, R, C); const int Rb = Epi::PERM ? ((R & ~31) + perm32(R & 31)) : R;
        voffA[i] = (unsigned)(R * K + C) * 2u; voffB[i] = (unsigned)(Rb * K + C) * 2u; }
    int gR[2]; unsigned gC[2];
#pragma unroll
    for (int i = 0; i < 2; ++i) { int R, C; stage_rc(tid * 16 + i * 8192, R, C); gR[i] = R; gC[i] = (unsigned)C * 2u; }
    LAS int* idxbuf = (LAS int*)(lds + GATHER_IDX_OFF);
    if constexpr (GATHER) {
        Unit uu;
        for (int q = 0; q < GATHER_MAX_UNITS; ++q) { if (!S.next(q, uu)) break; if (tid < 256) idxbuf[q * 256 + tid] = g.rowidx[uu.pm * 256 + tid]; }
        asm volatile("s_waitcnt vmcnt(0) lgkmcnt(0)" ::: "memory"); __builtin_amdgcn_s_barrier(); asm volatile("" ::: "memory");
    }
    unsigned gaC[2][2], gaN[2][2], ga2[2][2];
#define PG8_GA(dst, q) do { _Pragma("unroll") for (int _h = 0; _h < 2; ++_h) _Pragma("unroll") for (int _i = 0; _i < 2; ++_i) dst[_h][_i] = (unsigned)idxbuf[(q) * 256 + _h * 128 + gR[_i]] * (unsigned)(K * 2) + gC[_i]; } while (0)
    const size_t kstep = (size_t)(BK * 2);
    const size_t hstep = (size_t)HALF * K * 2;
    const size_t tstep = 2 * hstep;
    const unsigned ldsw = (unsigned)wid * 1024u;
    const int aoff = lds_byte(wr * 64 + fr, fq * 8), boff = lds_byte(wc * 32 + fr, fq * 8);
#define PG8_SA(b, h) (((b) * 2 + (h)) * HTB)
#define PG8_SB(b, h) ((4 + (b) * 2 + (h)) * HTB)
#define PG8_STAGE(bufoff, gbase, voff) do { _Pragma("unroll") for (int _i = 0; _i < 2; ++_i) \
        __builtin_amdgcn_global_load_lds((const unsigned*)((const char*)(gbase) + (voff)[_i]), (LAS unsigned*)(lds + (bufoff) + ldsw + _i * 8192), 16, 0, 0); } while (0)
#define PG8_LDA(dst, b, h) do { _Pragma("unroll") for (int m = 0; m < 4; ++m) _Pragma("unroll") for (int k = 0; k < 2; ++k) dst[m][k] = *(const LAS h8*)(lds + PG8_SA(b, h) + aoff + m * 2048 + k * 1024); } while (0)
#define PG8_LDB(dst, b, h) do { _Pragma("unroll") for (int n = 0; n < 2; ++n) _Pragma("unroll") for (int k = 0; k < 2; ++k) dst[n][k] = *(const LAS h8*)(lds + PG8_SB(b, h) + boff + n * 2048 + k * 1024); } while (0)
#define PG8_MMA(ai, bj, At, Bt) do { __builtin_amdgcn_s_setprio(1); _Pragma("unroll") for (int m = 0; m < 4; ++m) _Pragma("unroll") for (int n = 0; n < 2; ++n) _Pragma("unroll") for (int k = 0; k < 2; ++k) \
        acc[ai][bj][m][n] = __builtin_amdgcn_mfma_f32_16x16x32_f16(Bt[n][k], At[m][k], acc[ai][bj][m][n], 0, 0, 0); __builtin_amdgcn_s_setprio(0); } while (0)
#define PG8_WAIT_V(n) asm volatile("s_waitcnt vmcnt(" #n ")" ::: "memory")
#define PG8_WAIT_L(n) asm volatile("s_waitcnt lgkmcnt(" #n ")" ::: "memory")
#define PG8_BAR __builtin_amdgcn_s_barrier()
#define PG8_SCHED __builtin_amdgcn_sched_barrier(0)
#define PG8_STA(bufoff, tileptr, h, gaset, kbyte) do { if constexpr (GATHER) { PG8_STAGE(bufoff, (const char*)g.A + (kbyte), gaset[h]); } else { PG8_STAGE(bufoff, (tileptr) + (h) * hstep, voffA); } } while (0)
#define PG8_BBASE(u) ((const char*)g.Bt + ((size_t)((u).pm / g.grp_tiles) * g.grp_stride) * 2 + (size_t)(u).pn * tstep)
    Unit cur, nxt; int ui = 0;
    if (!S.next(0, cur)) return;
    f32x4 acc[2][2][4][2];
#pragma unroll
    for (int a = 0; a < 2; ++a)
#pragma unroll
        for (int b = 0; b < 2; ++b)
#pragma unroll
            for (int m = 0; m < 4; ++m)
#pragma unroll
                for (int n = 0; n < 2; ++n) acc[a][b][m][n] = (f32x4){0.f, 0.f, 0.f, 0.f};
    h8 At[4][2], B0[2][2], B1[2][2];
    const char* cA = (const char*)g.A + (size_t)cur.pm * tstep; const char* cB = PG8_BBASE(cur);
    if constexpr (GATHER) { PG8_GA(gaC, 0); }
    if constexpr (SP2) {
        PG8_STAGE(PG8_SB(0, 0), cB, voffB); PG8_STAGE(PG8_SB(0, 1), cB + hstep, voffB); PG8_STA(PG8_SA(0, 0), cA, 0, gaC, 0); PG8_STA(PG8_SA(0, 1), cA, 1, gaC, 0);
        if (wr == 1) PG8_BAR;
        PG8_WAIT_V(2); PG8_BAR;
        PG8_STAGE(PG8_SB(1, 0), cB + kstep, voffB); PG8_STA(PG8_SA(1, 0), cA + kstep, 0, gaC, kstep); PG8_STAGE(PG8_SB(1, 1), cB + hstep + kstep, voffB);
        PG8_WAIT_V(6); PG8_BAR;
    } else {
        PG8_STAGE(PG8_SB(0, 0), cB, voffB); PG8_STA(PG8_SA(0, 0), cA, 0, gaC, 0); PG8_STAGE(PG8_SB(0, 1), cB + hstep, voffB); PG8_STA(PG8_SA(0, 1), cA, 1, gaC, 0);
        if (wr == 1) PG8_BAR;
        PG8_WAIT_V(4); PG8_BAR;
        PG8_STAGE(PG8_SB(1, 0), cB + kstep, voffB); PG8_STA(PG8_SA(1, 0), cA + kstep, 0, gaC, kstep); PG8_STAGE(PG8_SB(1, 1), cB + hstep + kstep, voffB);
        PG8_WAIT_V(6); PG8_BAR;
    }
    for (;;) {
        const bool has_next = S.next(ui + 1, nxt);
        const char* nA = has_next ? (const char*)g.A + (size_t)nxt.pm * tstep : cA; const char* nB = has_next ? PG8_BBASE(nxt) : cB;
        if constexpr (GATHER) { const int qn = has_next ? ui + 1 : ui; PG8_GA(gaN, qn); }
#pragma unroll 1
        for (int t = 0; t < nt; t += 2) {
            const bool last = (t == nt - 2);
            const char* a1 = cA + (size_t)(t + 1) * kstep;
            const char* a2 = last ? nA : cA + (size_t)(t + 2) * kstep; const char* b2 = last ? nB : cB + (size_t)(t + 2) * kstep;
            const char* a3 = a2 + kstep; const char* b3 = b2 + kstep;
            const size_t k1 = (size_t)(t + 1) * kstep, k2 = last ? 0 : (size_t)(t + 2) * kstep, k3 = k2 + kstep;
            if constexpr (GATHER) { _Pragma("unroll") for (int _h = 0; _h < 2; ++_h) _Pragma("unroll") for (int _i = 0; _i < 2; ++_i) ga2[_h][_i] = last ? gaN[_h][_i] : gaC[_h][_i]; }
            if constexpr (SP2) {
            PG8_LDB(B0, 0, 0); PG8_LDB(B1, 0, 1); PG8_SCHED; PG8_LDA(At, 0, 0); PG8_STA(PG8_SA(1, 1), a1, 1, gaC, k1);
            PG8_WAIT_V(8); PG8_WAIT_L(0); PG8_BAR; PG8_MMA(0, 0, At, B0); PG8_MMA(0, 1, At, B1); PG8_BAR; PG8_SCHED;
            PG8_LDA(At, 0, 1); PG8_STAGE(PG8_SB(0, 0), b2, voffB); PG8_STAGE(PG8_SB(0, 1), b2 + hstep, voffB); PG8_STA(PG8_SA(0, 0), a2, 0, ga2, k2);
            PG8_WAIT_V(8); PG8_WAIT_L(0); PG8_BAR; PG8_MMA(1, 0, At, B0); PG8_MMA(1, 1, At, B1); PG8_BAR; PG8_SCHED;
            PG8_LDB(B0, 1, 0); PG8_LDB(B1, 1, 1); PG8_SCHED; PG8_LDA(At, 1, 0); PG8_STA(PG8_SA(0, 1), a2, 1, ga2, k2);
            PG8_WAIT_V(8); PG8_WAIT_L(0); PG8_BAR; PG8_MMA(0, 0, At, B0); PG8_MMA(0, 1, At, B1); PG8_BAR; PG8_SCHED;
            PG8_LDA(At, 1, 1); PG8_STAGE(PG8_SB(1, 0), b3, voffB); PG8_STAGE(PG8_SB(1, 1), b3 + hstep, voffB); PG8_STA(PG8_SA(1, 0), a3, 0, ga2, k3);
            PG8_WAIT_V(8); PG8_WAIT_L(0); PG8_BAR; PG8_MMA(1, 0, At, B0); PG8_MMA(1, 1, At, B1); PG8_BAR; PG8_SCHED;
            } else {
            PG8_LDB(B0, 0, 0); PG8_SCHED; PG8_LDA(At, 0, 0); PG8_STA(PG8_SA(1, 1), a1, 1, gaC, k1);
            PG8_WAIT_L(8); PG8_BAR; PG8_WAIT_L(0); PG8_MMA(0, 0, At, B0); PG8_BAR; PG8_SCHED;
            PG8_LDB(B1, 0, 1); PG8_STAGE(PG8_SB(0, 0), b2, voffB);
            PG8_BAR; PG8_WAIT_L(0); PG8_MMA(0, 1, At, B1); PG8_BAR;
            PG8_LDA(At, 0, 1); PG8_STA(PG8_SA(0, 0), a2, 0, ga2, k2);
            PG8_BAR; PG8_WAIT_L(0); PG8_MMA(1, 0, At, B0); PG8_BAR; PG8_SCHED;
            PG8_STAGE(PG8_SB(0, 1), b2 + hstep, voffB);
            PG8_WAIT_V(6); PG8_BAR; PG8_MMA(1, 1, At, B1); PG8_BAR;
            PG8_LDB(B0, 1, 0); PG8_SCHED; PG8_LDA(At, 1, 0); PG8_STA(PG8_SA(0, 1), a2, 1, ga2, k2);
            PG8_WAIT_L(8); PG8_BAR; PG8_WAIT_L(0); PG8_MMA(0, 0, At, B0); PG8_BAR; PG8_SCHED;
            PG8_LDB(B1, 1, 1); PG8_STAGE(PG8_SB(1, 0), b3, voffB);
            PG8_BAR; PG8_WAIT_L(0); PG8_MMA(0, 1, At, B1); PG8_BAR;
            PG8_LDA(At, 1, 1); PG8_STA(PG8_SA(1, 0), a3, 0, ga2, k3);
            PG8_BAR; PG8_WAIT_L(0); PG8_MMA(1, 0, At, B0); PG8_BAR; PG8_SCHED;
            PG8_STAGE(PG8_SB(1, 1), b3 + hstep, voffB);
            PG8_WAIT_V(6); PG8_BAR; PG8_MMA(1, 1, At, B1); PG8_BAR;
            }
        }
        if constexpr (ALIGN_EPI) { if (wr == 0) PG8_BAR; }
        E(acc, cur, wr, wc, fr, fq);
        if (!has_next) break;
#pragma unroll
        for (int a = 0; a < 2; ++a)
#pragma unroll
            for (int b = 0; b < 2; ++b)
#pragma unroll
                for (int m = 0; m < 4; ++m)
#pragma unroll
                    for (int n = 0; n < 2; ++n) acc[a][b][m][n] = (f32x4){0.f, 0.f, 0.f, 0.f};
        cur = nxt; cA = nA; cB = nB; ++ui;
        if constexpr (GATHER) { _Pragma("unroll") for (int _h = 0; _h < 2; ++_h) _Pragma("unroll") for (int _i = 0; _i < 2; ++_i) gaC[_h][_i] = gaN[_h][_i]; }
        if constexpr (ALIGN_EPI) { if (wr == 1) PG8_BAR; }
    }
    PG8_WAIT_V(0);
    if constexpr (!ALIGN_EPI) { if (wr == 0) PG8_BAR; }
    PG8_BAR;
#undef PG8_SA
#undef PG8_SB
#undef PG8_STAGE
#undef PG8_LDA
#undef PG8_LDB
#undef PG8_MMA
#undef PG8_WAIT_V
#undef PG8_WAIT_L
#undef PG8_BAR
#undef PG8_SCHED
#undef PG8_BBASE
#undef PG8_STA
#undef PG8_GA
}
}

#define EPI_ROW(u, ai, m) ((u).pm * 256 + (ai) * 128 + wr * 64 + (m) * 16 + fr)
__device__ __forceinline__ h8 pack8(f32x4 a, f32x4 b) { h8 o; o[0] = (f16)a[0]; o[1] = (f16)a[1]; o[2] = (f16)a[2]; o[3] = (f16)a[3]; o[4] = (f16)b[0]; o[5] = (f16)b[1]; o[6] = (f16)b[2]; o[7] = (f16)b[3]; return o; }
__device__ __forceinline__ void rope4(f32x4& v0, f32x4& v1, const f32x4 cs, const f32x4 sn) {
    const f32x4 a = v0, b = v1;
    v0[0] = a[0] * cs[0] - a[1] * sn[0]; v0[1] = a[1] * cs[0] + a[0] * sn[0];
    v0[2] = a[2] * cs[1] - a[3] * sn[1]; v0[3] = a[3] * cs[1] + a[2] * sn[1];
    v1[0] = b[0] * cs[2] - b[1] * sn[2]; v1[1] = b[1] * cs[2] + b[0] * sn[2];
    v1[2] = b[2] * cs[3] - b[3] * sn[3]; v1[3] = b[3] * cs[3] + b[2] * sn[3];
}
struct EpiLat {
    static constexpr bool PERM = true; f16* cq; f16* ckv; f16* Kp; float* pq; float* pkv; const float* cosm; const float* sinm;
    __device__ __forceinline__ void operator()(const f32x4 (&acc)[2][2][4][2], const pg8::Unit& u, int wr, int wc, int fr, int fq) const {
#pragma unroll
        for (int ai = 0; ai < 2; ++ai)
#pragma unroll
            for (int m = 0; m < 4; ++m) { const int t = EPI_ROW(u, ai, m); float sq = 0.f, sk = 0.f;
#pragma unroll
                for (int bj = 0; bj < 2; ++bj) { const int c8 = u.pn * 256 + bj * 128 + wc * 32 + 8 * fq; const int ht = u.pn * 2 + bj;
                    f32x4 v0 = acc[ai][bj][m][0], v1 = acc[ai][bj][m][1];
                    const float ss = (v0[0] * v0[0] + v0[1] * v0[1]) + (v0[2] * v0[2] + v0[3] * v0[3]) + (v1[0] * v1[0] + v1[1] * v1[1]) + (v1[2] * v1[2] + v1[3] * v1[3]);
                    if (ht < 3) { sq += ss; *(h8*)(cq + (size_t)t * 384 + c8) = pack8(v0, v1); }
                    else if (ht < 5) { sk += ss; *(h8*)(ckv + (size_t)t * 256 + (c8 - 384)) = pack8(v0, v1); }
                    else if (c8 < 704) { const int jj = c8 - 640, i0 = jj >> 1;
                        const f32x4 cs = *(const f32x4*)(cosm + (size_t)t * 32 + i0), sn = *(const f32x4*)(sinm + (size_t)t * 32 + i0); rope4(v0, v1, cs, sn);
                        const h8 o = pack8(v0, v1);
#pragma unroll
                        for (int h = 0; h < 8; ++h) *(h8*)(Kp + (size_t)t * 1536 + h * 192 + 128 + jj) = o; } }
                sq += __shfl_xor(sq, 16); sq += __shfl_xor(sq, 32); sk += __shfl_xor(sk, 16); sk += __shfl_xor(sk, 32);
                if (fq == 0) { if (u.pn < 2) pq[(size_t)t * 8 + u.pn * 4 + wc] = sq; if (u.pn >= 1) pkv[(size_t)t * 8 + (u.pn - 1) * 4 + wc] = sk; }
                asm volatile("" ::: "memory"); }
    }
};
__device__ __forceinline__ float row_rms_scale(const float* part, int t, float inv_n, float eps) {
    const f32x4 a = *(const f32x4*)(part + (size_t)t * 8), b = *(const f32x4*)(part + (size_t)t * 8 + 4);
    const float s = ((a[0] + a[1]) + (a[2] + a[3])) + ((b[0] + b[1]) + (b[2] + b[3]));
    return 1.0f / sqrtf(s * inv_n + eps);
}
struct EpiQNope {
    static constexpr bool PERM = true; f16* Q; const float* pq;
    __device__ __forceinline__ void operator()(const f32x4 (&acc)[2][2][4][2], const pg8::Unit& u, int wr, int wc, int fr, int fq) const {
#pragma unroll
        for (int ai = 0; ai < 2; ++ai)
#pragma unroll
            for (int m = 0; m < 4; ++m) { const int t = EPI_ROW(u, ai, m); const float rs = row_rms_scale(pq, t, 1.0f / 384.0f, LAT_EPS);
#pragma unroll
                for (int bj = 0; bj < 2; ++bj) { const int c8 = u.pn * 256 + bj * 128 + wc * 32 + 8 * fq;
                    *(h8*)(Q + (size_t)t * 1536 + (c8 >> 7) * 192 + (c8 & 127)) = pack8(acc[ai][bj][m][0] * rs, acc[ai][bj][m][1] * rs); }
                asm volatile("" ::: "memory"); }
    }
};
struct EpiQRope {
    static constexpr bool PERM = true; f16* Q; const float* cosm; const float* sinm; const float* pq;
    __device__ __forceinline__ void operator()(const f32x4 (&acc)[2][2][4][2], const pg8::Unit& u, int wr, int wc, int fr, int fq) const {
#pragma unroll
        for (int ai = 0; ai < 2; ++ai)
#pragma unroll
            for (int m = 0; m < 4; ++m) { const int t = EPI_ROW(u, ai, m); const float rs = row_rms_scale(pq, t, 1.0f / 384.0f, LAT_EPS);
#pragma unroll
                for (int bj = 0; bj < 2; ++bj) { const int cc = u.pn * 256 + bj * 128 + wc * 32 + 8 * fq; const int h = cc >> 6, jj = cc & 63, i0 = jj >> 1;
                    f32x4 v0 = acc[ai][bj][m][0] * rs, v1 = acc[ai][bj][m][1] * rs;
                    const f32x4 cs = *(const f32x4*)(cosm + (size_t)t * 32 + i0), sn = *(const f32x4*)(sinm + (size_t)t * 32 + i0); rope4(v0, v1, cs, sn);
                    *(h8*)(Q + (size_t)t * 1536 + h * 192 + 128 + jj) = pack8(v0, v1); }
                asm volatile("" ::: "memory"); }
    }
};
struct EpiKV {
    static constexpr bool PERM = true; f16* Kp; f16* Vp; const float* pkv;
    __device__ __forceinline__ void operator()(const f32x4 (&acc)[2][2][4][2], const pg8::Unit& u, int wr, int wc, int fr, int fq) const {
#pragma unroll
        for (int ai = 0; ai < 2; ++ai)
#pragma unroll
            for (int m = 0; m < 4; ++m) { const int t = EPI_ROW(u, ai, m); const float rs = row_rms_scale(pkv, t, 1.0f / 256.0f, LAT_EPS);
#pragma unroll
                for (int bj = 0; bj < 2; ++bj) { const int c8 = u.pn * 256 + bj * 128 + wc * 32 + 8 * fq; const int h = c8 >> 8, j = c8 & 255;
                    f16* dst = (j < 128) ? (Kp + (size_t)t * 1536 + h * 192 + j) : (Vp + (size_t)t * 1024 + h * 128 + (j - 128));
                    *(h8*)dst = pack8(acc[ai][bj][m][0] * rs, acc[ai][bj][m][1] * rs); }
                asm volatile("" ::: "memory"); }
    }
};
template <bool XF16> struct EpiPre {
    static constexpr bool PERM = true; const void* xres; const float* gmod; f16* pre;
    __device__ __forceinline__ void operator()(const f32x4 (&acc)[2][2][4][2], const pg8::Unit& u, int wr, int wc, int fr, int fq) const {
#pragma unroll
        for (int ai = 0; ai < 2; ++ai)
#pragma unroll
            for (int m = 0; m < 4; ++m) { const int t = EPI_ROW(u, ai, m); const int b = t >> 12;
#pragma unroll
                for (int bj = 0; bj < 2; ++bj) { const int c8 = u.pn * 256 + bj * 128 + wc * 32 + 8 * fq;
                    const f32x4 g0 = *(const f32x4*)(gmod + b * 6144 + c8), g1 = *(const f32x4*)(gmod + b * 6144 + c8 + 4); f32x4 x0, x1;
                    if constexpr (XF16) { const h8 xv = *(const h8*)((const f16*)xres + (size_t)t * 1024 + c8);
                        x0 = (f32x4){(float)xv[0], (float)xv[1], (float)xv[2], (float)xv[3]}; x1 = (f32x4){(float)xv[4], (float)xv[5], (float)xv[6], (float)xv[7]}; }
                    else { x0 = *(const f32x4*)((const float*)xres + (size_t)t * 1024 + c8); x1 = *(const f32x4*)((const float*)xres + (size_t)t * 1024 + c8 + 4); }
                    *(h8*)(pre + (size_t)t * 1024 + c8) = pack8(x0 * ALPHA + (g0 + 1.0f) * acc[ai][bj][m][0], x1 * ALPHA + (g1 + 1.0f) * acc[ai][bj][m][1]); }
                asm volatile("" ::: "memory"); }
    }
};
struct EpiUp {
    static constexpr bool PERM = true; f16* act;
    __device__ __forceinline__ void operator()(const f32x4 (&acc)[2][2][4][2], const pg8::Unit& u, int wr, int wc, int fr, int fq) const {
#pragma unroll
        for (int ai = 0; ai < 2; ++ai)
#pragma unroll
            for (int m = 0; m < 4; ++m) { const int r = EPI_ROW(u, ai, m);
#pragma unroll
                for (int bj = 0; bj < 2; ++bj) { const int c8 = u.pn * 256 + bj * 128 + wc * 32 + 8 * fq;
                    const f32x4 gq = acc[ai][bj][m][0], uq = acc[ai][bj][m][1]; h4 o;
#pragma unroll
                    for (int i = 0; i < 4; ++i) { const float gg = gq[i]; o[i] = (f16)(gg * __builtin_amdgcn_rcpf(1.0f + __expf(-gg)) * uq[i]); }
                    *(h4*)(act + (size_t)r * 2048 + (c8 >> 1)) = o; } }
    }
};
struct EpiDown {
    static constexpr bool PERM = true; f16* y; const float* gate;
    __device__ __forceinline__ void operator()(const f32x4 (&acc)[2][2][4][2], const pg8::Unit& u, int wr, int wc, int fr, int fq) const {
#pragma unroll
        for (int ai = 0; ai < 2; ++ai)
#pragma unroll
            for (int m = 0; m < 4; ++m) { const int r = EPI_ROW(u, ai, m); const float gt = gate[r];
#pragma unroll
                for (int bj = 0; bj < 2; ++bj) { const int c8 = u.pn * 256 + bj * 128 + wc * 32 + 8 * fq;
                    *(h8*)(y + (size_t)r * 1024 + c8) = pack8(acc[ai][bj][m][0] * gt, acc[ai][bj][m][1] * gt); }
                asm volatile("" ::: "memory"); }
    }
};
struct EpiDiffIn {
    static constexpr bool PERM = true; f16* qkv; const float* cosd; const float* sind;
    __device__ __forceinline__ void operator()(const f32x4 (&acc)[2][2][4][2], const pg8::Unit& u, int wr, int wc, int fr, int fq) const {
#pragma unroll
        for (int ai = 0; ai < 2; ++ai)
#pragma unroll
            for (int m = 0; m < 4; ++m) { const int t = EPI_ROW(u, ai, m);
#pragma unroll
                for (int bj = 0; bj < 2; ++bj) { const int c8 = u.pn * 256 + bj * 128 + wc * 32 + 8 * fq;
                    f32x4 v0 = acc[ai][bj][m][0], v1 = acc[ai][bj][m][1];
                    if (c8 < 2048 && (c8 & 63) < 16) { const int i0 = (c8 & 15) >> 1; const f32x4 cs = *(const f32x4*)(cosd + (size_t)t * 8 + i0), sn = *(const f32x4*)(sind + (size_t)t * 8 + i0); rope4(v0, v1, cs, sn); }
                    *(h8*)(qkv + (size_t)t * 3072 + c8) = pack8(v0, v1); }
                asm volatile("" ::: "memory"); }
    }
};

namespace att {
constexpr int QBLK = 32, KVBLK = 64, DV = 128;
constexpr float THR = 8.f;
constexpr size_t SHM_V = KVBLK * DV * 2;
#define SBAR() __builtin_amdgcn_sched_barrier(0)
__device__ __forceinline__ int crow(int r, int hi) { return (r & 3) + 8 * (r >> 2) + 4 * hi; }
__device__ __forceinline__ unsigned cvtpk(float lo, float hi) { unsigned r; asm volatile("v_cvt_pk_f16_f32 %0, %1, %2" : "=v"(r) : "v"(lo), "v"(hi)); return r; }
template <int DQK> struct Cfg {
    static constexpr int ND0 = DQK / 16, KRB = DQK * 2, NKCH = DQK / 64, KCPR = DQK / 8;
    static constexpr size_t SHM_K = (size_t)KVBLK * KRB;
    static constexpr float SCALE = DQK == 192 ? 0.07216878364870322f : 0.125f;
    static constexpr size_t SHM_TOTAL = 2 * SHM_V + 2 * SHM_K + NWAVES * 64 * 4;
};
template <int DQK> __device__ __forceinline__ void partialSM(f32x16& p0, f32x16& p1, float& m_reg, float& mn, float& alpha) {
    constexpr float SCALE = Cfg<DQK>::SCALE, C = SCALE * 1.4426950408889634f;
    float pmax = p0[0];
#pragma unroll
    for (int r = 1; r < 16; ++r) pmax = fmaxf(pmax, p0[r]);
#pragma unroll
    for (int r = 0; r < 16; ++r) pmax = fmaxf(pmax, p1[r]);
    { auto rr = __builtin_amdgcn_permlane32_swap(__float_as_uint(pmax), __float_as_uint(pmax), false, false);
      pmax = fmaxf(__uint_as_float(rr[0]), __uint_as_float(rr[1])); }
    if (__builtin_expect(__all(pmax - m_reg <= THR / SCALE), 1)) { mn = m_reg; alpha = 1.f; }
    else { mn = fmaxf(m_reg, pmax); alpha = __builtin_amdgcn_exp2f((m_reg - mn) * C); m_reg = mn; }
    const float mnC = -mn * C;
#pragma unroll
    for (int r = 0; r < 16; ++r) p0[r] = fmaf(p0[r], C, mnC);
#pragma unroll
    for (int r = 0; r < 16; ++r) p1[r] = fmaf(p1[r], C, mnC);
#pragma unroll
    for (int r = 0; r < 16; ++r) p0[r] = __builtin_amdgcn_exp2f(p0[r]);
}
__device__ __forceinline__ void finishSM(f32x16& p0, f32x16& p1, float alpha, float& l_reg, h8& pa0, h8& pa1, h8& pa2, h8& pa3) {
#pragma unroll
    for (int r = 0; r < 16; ++r) p1[r] = __builtin_amdgcn_exp2f(p1[r]);
    float ps = 0;
#pragma unroll
    for (int r = 0; r < 16; ++r) ps += p0[r];
#pragma unroll
    for (int r = 0; r < 16; ++r) ps += p1[r];
    { auto rr = __builtin_amdgcn_permlane32_swap(__float_as_uint(ps), __float_as_uint(ps), false, false);
      ps = __uint_as_float(rr[0]) + __uint_as_float(rr[1]); }
    l_reg = l_reg * alpha + ps;
#define PK4(P, BASE, OUT) do { unsigned a0 = cvtpk(P[BASE + 0], P[BASE + 1]), a1 = cvtpk(P[BASE + 2], P[BASE + 3]);   \
    unsigned b0 = cvtpk(P[BASE + 4], P[BASE + 5]), b1 = cvtpk(P[BASE + 6], P[BASE + 7]);                              \
    auto r0 = __builtin_amdgcn_permlane32_swap(a0, b0, false, false); auto r1 = __builtin_amdgcn_permlane32_swap(a1, b1, false, false); \
    u32x4 w = {r0[0], r1[0], r0[1], r1[1]}; OUT = *reinterpret_cast<h8*>(&w); } while (0)
    PK4(p0, 0, pa0); PK4(p0, 8, pa1); PK4(p1, 0, pa2); PK4(p1, 8, pa3);
#undef PK4
}
#define KSWZ(row, colB) ((row) * KRB + ((colB) ^ (((row) & 7) << 4)))
template <int DQK> __device__ __forceinline__ void qkt(f32x16& p0, f32x16& p1, const char* Ks, const h8* qr, int r32, int hi) {
    constexpr int KRB = Cfg<DQK>::KRB;
    p0 = f32x16{}; p1 = f32x16{};
#pragma unroll
    for (int d0 = 0; d0 < Cfg<DQK>::ND0; ++d0) { const int cb = (d0 * 16 + hi * 8) * 2;
        const h8 b0 = *reinterpret_cast<const h8*>(Ks + KSWZ(r32, cb));
        const h8 b1 = *reinterpret_cast<const h8*>(Ks + KSWZ(32 + r32, cb));
        p0 = __builtin_amdgcn_mfma_f32_32x32x16_f16(b0, qr[d0], p0, 0, 0, 0);
        p1 = __builtin_amdgcn_mfma_f32_32x32x16_f16(b1, qr[d0], p1, 0, 0, 0); }
}
__device__ __forceinline__ int v_st(int k, int c) { const int kk = (k & ~0xC) | ((k & 4) << 1) | ((k & 8) >> 1); return ((kk >> 3) * 4 + (c >> 5)) * 512 + ((kk & 7) * 32 + (c & 31)) * 2; }
__device__ __forceinline__ int v_rd_base(int lane) { return ((lane & 3) << 3) | (((lane >> 2) & 3) << 6) | (((lane >> 4) & 1) << 5) | (((lane >> 5) & 1) << 8); }
constexpr int v_rd_off(int d0, int ks, int half) { return d0 * 512 + ks * 4096 + half * 2048; }
template <int OFF> __device__ __forceinline__ s16x4 tr_read(int vb) {
    s16x4 r; asm volatile("ds_read_b64_tr_b16 %0, %1 offset:%2" : "=&v"(r) : "v"(vb), "i"(OFF) : "memory"); return r;
}
template <int D0> __device__ __forceinline__ void pv_one(f32x16& od, int vb, h8 pa0, h8 pa1, h8 pa2, h8 pa3) {
    const s16x4 l0 = tr_read<v_rd_off(D0, 0, 0)>(vb), h0 = tr_read<v_rd_off(D0, 0, 1)>(vb), l1 = tr_read<v_rd_off(D0, 1, 0)>(vb), h1 = tr_read<v_rd_off(D0, 1, 1)>(vb);
    const s16x4 l2 = tr_read<v_rd_off(D0, 2, 0)>(vb), h2_ = tr_read<v_rd_off(D0, 2, 1)>(vb), l3 = tr_read<v_rd_off(D0, 3, 0)>(vb), h3 = tr_read<v_rd_off(D0, 3, 1)>(vb);
    asm volatile("s_waitcnt lgkmcnt(0)" ::: "memory"); SBAR();
#define PKV(L, H) __builtin_bit_cast(h8, (__attribute__((ext_vector_type(8))) short){L[0], L[1], L[2], L[3], H[0], H[1], H[2], H[3]})
    od = __builtin_amdgcn_mfma_f32_32x32x16_f16(pa0, PKV(l0, h0), od, 0, 0, 0);
    od = __builtin_amdgcn_mfma_f32_32x32x16_f16(pa1, PKV(l1, h1), od, 0, 0, 0);
    od = __builtin_amdgcn_mfma_f32_32x32x16_f16(pa2, PKV(l2, h2_), od, 0, 0, 0);
    od = __builtin_amdgcn_mfma_f32_32x32x16_f16(pa3, PKV(l3, h3), od, 0, 0, 0);
#undef PKV
}
__device__ __forceinline__ void pv_d0(f32x16* o, int vb, h8 pa0, h8 pa1, h8 pa2, h8 pa3) {
    pv_one<0>(o[0], vb, pa0, pa1, pa2, pa3); pv_one<1>(o[1], vb, pa0, pa1, pa2, pa3); pv_one<2>(o[2], vb, pa0, pa1, pa2, pa3); pv_one<3>(o[3], vb, pa0, pa1, pa2, pa3);
}
template <int DQK, int LDQ, int LDK, int LDV, int LDO, int SDEPTH>
__device__ __forceinline__ void attn_body(const f16* Qb, const f16* Kh, const f16* Vh, f16* Ob, char* lds, int mode = 0, float lam = 0.f, const float* subln = nullptr) {
    using C = Cfg<DQK>;
    constexpr int KRB = C::KRB, ND0 = C::ND0, NKCH = C::NKCH, KCPR = C::KCPR; constexpr size_t SHM_K = C::SHM_K;
    constexpr int seq = SEQ;
    int tid = threadIdx.x; asm volatile("" : "+v"(tid));
    const int wid = tid >> 6, lane = tid & 63, r32 = lane & 31, hi = lane >> 5;
    char* V_lds = lds; char* K_lds = lds + 2 * SHM_V;
    float* wsl = (float*)(lds + 2 * SHM_V + 2 * SHM_K) + wid * 64; float* li_l = wsl; float* al_l = wsl + 32;
    float m_reg = -1e30f, l_reg = 0; f32x16 o[4] = {}; h8 qr[ND0];
    const f16* Qw = Qb + (long)(wid * QBLK + r32) * LDQ + hi * 8;
#pragma unroll
    for (int d0 = 0; d0 < ND0; ++d0) qr[d0] = *reinterpret_cast<const h8*>(Qw + d0 * 16);
    const int sr = tid >> 4, sc = (tid & 15) * 8, vst0 = v_st(sr, sc), vst1 = v_st(32 + sr, sc);
    int krow[NKCH], kcb[NKCH];
#pragma unroll
    for (int i = 0; i < NKCH; ++i) { const int c = tid + i * 512; krow[i] = c / KCPR; kcb[i] = (c % KCPR) * 16; }
    const int vb0 = (int)(uintptr_t)V_lds + v_rd_base(lane);
    struct { h8 vs0, vs1; h8 ks[NKCH]; } sr_[SDEPTH];
#define SLOAD(i, k0) do { sr_[i].vs0 = *reinterpret_cast<const h8*>(&Vh[(long)((k0) + sr) * LDV + sc]); sr_[i].vs1 = *reinterpret_cast<const h8*>(&Vh[(long)((k0) + 32 + sr) * LDV + sc]); \
    _Pragma("unroll") for (int _c = 0; _c < NKCH; ++_c) sr_[i].ks[_c] = *reinterpret_cast<const h8*>((const char*)Kh + (long)((k0) + krow[_c]) * (LDK * 2) + kcb[_c]); } while (0)
#define SWRITE(b, i) do { *(h8*)(V_lds + (b) * SHM_V + vst0) = sr_[i].vs0; *(h8*)(V_lds + (b) * SHM_V + vst1) = sr_[i].vs1; \
    _Pragma("unroll") for (int _c = 0; _c < NKCH; ++_c) *(h8*)(K_lds + (b) * SHM_K + KSWZ(krow[_c], kcb[_c])) = sr_[i].ks[_c]; } while (0)
#define SWAIT() do { if constexpr (SDEPTH == 2) { if constexpr (NKCH == 3) asm volatile("s_waitcnt vmcnt(5)" ::: "memory"); else asm volatile("s_waitcnt vmcnt(3)" ::: "memory"); } \
    else asm volatile("s_waitcnt vmcnt(0)" ::: "memory"); } while (0)
#define RESC(a) do { if (__any((a) < 1.f)) { if (hi == 0) al_l[r32] = (a); asm volatile("s_waitcnt lgkmcnt(0)" ::: "memory"); \
    _Pragma("unroll") for (int d = 0; d < 4; ++d) _Pragma("unroll") for (int r = 0; r < 16; ++r) o[d][r] *= al_l[crow(r, hi)]; } } while (0)
    f32x16 pA0, pA1, pB0, pB1; float mnA, mnB, alA, alB; h8 pa0, pa1, pa2, pa3; constexpr int NT = seq / KVBLK;
    constexpr int SE = 0, SO = SDEPTH - 1;
    SLOAD(SE, 0); asm volatile("s_waitcnt vmcnt(0)" ::: "memory"); SWRITE(0, SE); __syncthreads();
    qkt<DQK>(pA0, pA1, K_lds, qr, r32, hi); partialSM<DQK>(pA0, pA1, m_reg, mnA, alA);
    SLOAD(SO, KVBLK); if constexpr (SDEPTH == 2) { if (2 < NT) SLOAD(SE, 2 * KVBLK); }
    SWAIT(); SWRITE(1, SO); __syncthreads();
    for (int j = 1; j + 1 < NT; j += 2) {
        SBAR(); qkt<DQK>(pB0, pB1, K_lds + SHM_K, qr, r32, hi);
        finishSM(pA0, pA1, alA, l_reg, pa0, pa1, pa2, pa3); SBAR();
        SLOAD(SO, (j + SDEPTH) * KVBLK); SBAR();
        pv_d0(o, vb0, pa0, pa1, pa2, pa3); partialSM<DQK>(pB0, pB1, m_reg, mnB, alB);
        __syncthreads(); SWAIT(); SWRITE(0, SE);
        RESC(alB); __syncthreads();
        SBAR(); qkt<DQK>(pA0, pA1, K_lds, qr, r32, hi);
        finishSM(pB0, pB1, alB, l_reg, pa0, pa1, pa2, pa3); SBAR();
        if (SDEPTH == 1 || j + 3 < NT) SLOAD(SE, (j + 1 + SDEPTH) * KVBLK); SBAR();
        pv_d0(o, vb0 + (int)SHM_V, pa0, pa1, pa2, pa3); partialSM<DQK>(pA0, pA1, m_reg, mnA, alA);
        __syncthreads(); SWAIT(); SWRITE(1, SO);
        RESC(alA); __syncthreads();
    }
    SBAR(); qkt<DQK>(pB0, pB1, K_lds + SHM_K, qr, r32, hi);
    finishSM(pA0, pA1, alA, l_reg, pa0, pa1, pa2, pa3); SBAR();
    pv_d0(o, vb0, pa0, pa1, pa2, pa3); partialSM<DQK>(pB0, pB1, m_reg, mnB, alB);
    __syncthreads(); RESC(alB);
    finishSM(pB0, pB1, alB, l_reg, pa0, pa1, pa2, pa3); SBAR();
    pv_d0(o, vb0 + (int)SHM_V, pa0, pa1, pa2, pa3);
    if (hi == 0) li_l[r32] = l_reg; asm volatile("s_waitcnt lgkmcnt(0)" ::: "memory");
    float rli[16];
#pragma unroll
    for (int r = 0; r < 16; ++r) rli[r] = __builtin_amdgcn_rcpf(li_l[crow(r, hi)]);
    f16* Ow = Ob + (long)(wid * QBLK) * LDO;
    if (mode == 0) {
#pragma unroll
        for (int r = 0; r < 16; ++r) { const int orow = crow(r, hi);
#pragma unroll
            for (int d0 = 0; d0 < 4; ++d0) Ow[(long)orow * LDO + d0 * 32 + r32] = (f16)(o[d0][r] * rli[r]); }
    } else {
        float sl[4];
#pragma unroll
        for (int d0 = 0; d0 < 4; ++d0) sl[d0] = subln[d0 * 32 + r32] * (1.0f - LAMBDA_INIT);
        f16 t0[4][16];
#pragma unroll
        for (int r = 0; r < 16; ++r) { const int orow = crow(r, hi);
#pragma unroll
            for (int d0 = 0; d0 < 4; ++d0) t0[d0][r] = Ow[(long)orow * LDO + d0 * 32 + r32]; }
        asm volatile("s_waitcnt vmcnt(0)" ::: "memory");
#pragma unroll
        for (int r = 0; r < 16; ++r) { const int orow = crow(r, hi); float ss = 0.f;
#pragma unroll
            for (int d0 = 0; d0 < 4; ++d0) { const float x = (float)t0[d0][r] - lam * (o[d0][r] * rli[r]); o[d0][r] = x; ss += x * x; }
            ss += __shfl_xor(ss, 1); ss += __shfl_xor(ss, 2); ss += __shfl_xor(ss, 4); ss += __shfl_xor(ss, 8); ss += __shfl_xor(ss, 16);
            const float rs = 1.0f / sqrtf(ss * (1.0f / 128.0f) + LN_EPS);
#pragma unroll
            for (int d0 = 0; d0 < 4; ++d0) Ow[(long)orow * LDO + d0 * 32 + r32] = (f16)(o[d0][r] * rs * sl[d0]); }
    }
    asm volatile("s_waitcnt vmcnt(0) lgkmcnt(0)" ::: "memory");
    __syncthreads();
#undef SLOAD
#undef SWRITE
#undef SWAIT
#undef RESC
}

template <int DQK, int LDQ, int LDK, int LDV, int LDO>
__device__ __forceinline__ void attn_body_simple(const f16* Qb, const f16* Kh, const f16* Vh, f16* Ob, char* lds) {
    using C = Cfg<DQK>;
    constexpr int KRB = C::KRB, ND0 = C::ND0, NKCH = C::NKCH, KCPR = C::KCPR; constexpr size_t SHM_K = C::SHM_K;
    int tid = threadIdx.x; asm volatile("" : "+v"(tid));
    const int wid = tid >> 6, lane = tid & 63, r32 = lane & 31, hi = lane >> 5;
    char* V_lds = lds; char* K_lds = lds + 2 * SHM_V;
    float* wsl = (float*)(lds + 2 * SHM_V + 2 * SHM_K) + wid * 64; float* li_l = wsl; float* al_l = wsl + 32;
    float m_reg = -1e30f, l_reg = 0; f32x16 o[4] = {}; h8 qr[ND0];
    const f16* Qw = Qb + (long)(wid * QBLK + r32) * LDQ + hi * 8;
#pragma unroll
    for (int d0 = 0; d0 < ND0; ++d0) qr[d0] = *reinterpret_cast<const h8*>(Qw + d0 * 16);
    const int sr = tid >> 4, sc = (tid & 15) * 8, vst0 = v_st(sr, sc), vst1 = v_st(32 + sr, sc);
    int krow[NKCH], kcb[NKCH];
#pragma unroll
    for (int i = 0; i < NKCH; ++i) { const int c = tid + i * 512; krow[i] = c / KCPR; kcb[i] = (c % KCPR) * 16; }
    const int vb0 = (int)(uintptr_t)V_lds + v_rd_base(lane);
    h8 vs0, vs1, ks[NKCH];
#define SLOAD1(k0) do { vs0 = *reinterpret_cast<const h8*>(&Vh[(long)((k0) + sr) * LDV + sc]); vs1 = *reinterpret_cast<const h8*>(&Vh[(long)((k0) + 32 + sr) * LDV + sc]); \
    _Pragma("unroll") for (int _c = 0; _c < NKCH; ++_c) ks[_c] = *reinterpret_cast<const h8*>((const char*)Kh + (long)((k0) + krow[_c]) * (LDK * 2) + kcb[_c]); } while (0)
#define SWRITE1(b) do { *(h8*)(V_lds + (b) * SHM_V + vst0) = vs0; *(h8*)(V_lds + (b) * SHM_V + vst1) = vs1; \
    _Pragma("unroll") for (int _c = 0; _c < NKCH; ++_c) *(h8*)(K_lds + (b) * SHM_K + KSWZ(krow[_c], kcb[_c])) = ks[_c]; } while (0)
    constexpr int NT = SEQ / KVBLK;
    SLOAD1(0); asm volatile("s_waitcnt vmcnt(0)" ::: "memory"); SWRITE1(0); __syncthreads();
#pragma unroll 1
    for (int j = 0; j < NT; ++j) {
        const int cb = j & 1;
        if (j + 1 < NT) SLOAD1((j + 1) * KVBLK);
        SBAR();
        f32x16 p0, p1; float mn, al; h8 pa0, pa1, pa2, pa3;
        qkt<DQK>(p0, p1, K_lds + cb * SHM_K, qr, r32, hi);
        partialSM<DQK>(p0, p1, m_reg, mn, al);
        if (__any(al < 1.f)) { if (hi == 0) al_l[r32] = al; asm volatile("s_waitcnt lgkmcnt(0)" ::: "memory");
#pragma unroll
            for (int d = 0; d < 4; ++d)
#pragma unroll
                for (int r = 0; r < 16; ++r) o[d][r] *= al_l[crow(r, hi)]; }
        finishSM(p0, p1, al, l_reg, pa0, pa1, pa2, pa3); SBAR();
        pv_d0(o, vb0 + cb * (int)SHM_V, pa0, pa1, pa2, pa3);
        if (j + 1 < NT) { SWRITE1(cb ^ 1); }
        __syncthreads();
    }
    if (hi == 0) li_l[r32] = l_reg; asm volatile("s_waitcnt lgkmcnt(0)" ::: "memory");
    float rli[16];
#pragma unroll
    for (int r = 0; r < 16; ++r) rli[r] = __builtin_amdgcn_rcpf(li_l[crow(r, hi)]);
    f16* Ow = Ob + (long)(wid * QBLK) * LDO;
#pragma unroll
    for (int r = 0; r < 16; ++r) { const int orow = crow(r, hi);
#pragma unroll
        for (int d0 = 0; d0 < 4; ++d0) Ow[(long)orow * LDO + d0 * 32 + r32] = (f16)(o[d0][r] * rli[r]); }
    asm volatile("s_waitcnt vmcnt(0) lgkmcnt(0)" ::: "memory");
    __syncthreads();
#undef SLOAD1
#undef SWRITE1
}
#undef KSWZ
#undef SBAR
}

struct Args { const void* in[22]; float* out; unsigned char* ws; int ph_lo, ph_hi, li, pad; };
typedef const __attribute__((address_space(4))) Args* KArgs;
__device__ __forceinline__ KArgs kargs() { KArgs p = (KArgs)__builtin_amdgcn_kernarg_segment_ptr(); asm volatile("" : "+s"(p)); return p; }
struct Frame {
    LAS unsigned char* lds; char* ldsg;
    int tid, lane, wave, vcu, G;
    unsigned char* ws;
};
extern __shared__ __attribute__((aligned(16))) unsigned char g_lds[];
__device__ __forceinline__ Frame mkframe(KArgs a) {
    Frame F; int t = threadIdx.x; asm volatile("" : "+v"(t));
    F.lds = (LAS unsigned char*)g_lds; F.ldsg = (char*)g_lds;
    F.tid = t; F.lane = t & 63; F.wave = __builtin_amdgcn_readfirstlane(t >> 6);
    int g = gridDim.x, bx = blockIdx.x; asm volatile("" : "+s"(g), "+s"(bx));
    F.G = g; F.vcu = (g % 8 == 0) ? (bx % 8) * (g / 8) + bx / 8 : bx;
    F.ws = a->ws;
    return F;
}

__device__ __forceinline__ void sincos_d(double a, float& s, float& c) {
    const double k = __builtin_rint(a * 0.63661977236758134308);
    double r = __builtin_fma(-k, 1.57079632679489655800e+00, a); r = __builtin_fma(-k, 6.12323399573676603587e-17, r);
    const double r2 = r * r;
    double sp = -7.6471637318198164759e-13;
    sp = __builtin_fma(sp, r2, 1.6059043836821614599e-10);
    sp = __builtin_fma(sp, r2, -2.5052108385441718775e-08);
    sp = __builtin_fma(sp, r2, 2.7557319223985890653e-06);
    sp = __builtin_fma(sp, r2, -1.9841269841269841270e-04);
    sp = __builtin_fma(sp, r2, 8.3333333333333333333e-03);
    sp = __builtin_fma(sp, r2, -1.6666666666666666667e-01);
    const double sr = __builtin_fma(sp * r2, r, r);
    double cp = 4.7794773323873852974e-14;
    cp = __builtin_fma(cp, r2, -1.1470745597729724714e-11);
    cp = __builtin_fma(cp, r2, 2.0876756987868098979e-09);
    cp = __builtin_fma(cp, r2, -2.7557319223985890653e-07);
    cp = __builtin_fma(cp, r2, 2.4801587301587301587e-05);
    cp = __builtin_fma(cp, r2, -1.3888888888888888889e-03);
    cp = __builtin_fma(cp, r2, 4.1666666666666666667e-02);
    cp = __builtin_fma(cp, r2, -0.5);
    const double cr = __builtin_fma(cp, r2, 1.0);
    const int q = (int)((long long)k & 3);
    const double ss = (q & 1) ? cr : sr, cc = (q & 1) ? sr : cr;
    s = (float)((q & 2) ? -ss : ss); c = (float)(((q + 1) & 2) ? -cc : cc);
}
__device__ const double INV_M[32] = {
    1.0, 0.7498942093324559, 0.5623413251903491, 0.4216965034285822, 0.31622776601683794, 0.23713737056616552, 0.1778279410038923, 0.1333521432163324,
    0.1, 0.07498942093324558, 0.05623413251903491, 0.04216965034285822, 0.03162277660168379, 0.023713737056616554, 0.01778279410038923, 0.01333521432163324,
    0.01, 0.007498942093324559, 0.005623413251903491, 0.004216965034285822, 0.0031622776601683794, 0.0023713737056616554, 0.001778279410038923, 0.001333521432163324,
    0.001, 0.0007498942093324559, 0.0005623413251903491, 0.0004216965034285822, 0.00031622776601683794, 0.00023713737056616554, 0.0001778279410038923, 0.0001333521432163324 };
__device__ const double INV_D[8] = { 1.0, 0.19392274474868576, 0.03760603093086393, 0.007292664737217109, 0.001414213562373095, 0.0002742481756762073, 5.318295896944988e-05, 1.031338537721246e-05 };

template <class FD>
__device__ __forceinline__ void tr_item64(const float* W, int Nsrc, int K, f16* WT, FD dstrow, LAS float* scr, int kb, int cb, int lane, const float* kscale = nullptr) {
    const int k0 = 64 * kb, c0 = 64 * cb, r4 = lane >> 4, cq = (lane & 15) * 4;
    f32x4 v[16];
#pragma unroll
    for (int i = 0; i < 16; ++i) v[i] = *(const f32x4*)(W + (size_t)(k0 + 4 * i + r4) * Nsrc + c0 + cq);
    if (kscale) {
#pragma unroll
        for (int i = 0; i < 16; ++i) v[i] = v[i] * kscale[k0 + 4 * i + r4]; }
#pragma unroll
    for (int i = 0; i < 16; ++i) { const int k = 4 * i + r4, sw = (i >> 1) * 4;
#pragma unroll
        for (int w = 0; w < 4; ++w) scr[k * 64 + ((cq + w) ^ sw)] = v[i][w]; }
    LDS_WAIT(); asm volatile("" ::: "memory");
    const int c = lane & 7;
#pragma unroll
    for (int j = 0; j < 8; ++j) { const int col = (lane >> 3) + 8 * j; const int dr = dstrow(c0 + col); const LAS float* sp = scr + (8 * c) * 64 + (col ^ (c * 4));
        h8 o; o[0] = (f16)sp[0 * 64]; o[1] = (f16)sp[1 * 64]; o[2] = (f16)sp[2 * 64]; o[3] = (f16)sp[3 * 64]; o[4] = (f16)sp[4 * 64]; o[5] = (f16)sp[5 * 64]; o[6] = (f16)sp[6 * 64]; o[7] = (f16)sp[7 * 64];
        *(h8*)(WT + (size_t)dr * K + k0 + 8 * c) = o; }
    LDS_WAIT(); asm volatile("" ::: "memory");
}
struct RowId { __device__ __forceinline__ int operator()(int c) const { return c; } };
struct RowWin0 { __device__ __forceinline__ int operator()(int c) const { if (c < 640) return c; const int jj = c - 640; return 640 + 2 * (jj & 31) + (jj >> 5); } };
struct RowUq { __device__ __forceinline__ int operator()(int c) const { const int h = c / 192, j = c % 192; if (j < 128) return h * 128 + j; const int jj = j - 128; return 1024 + h * 64 + 2 * (jj & 31) + (jj >> 5); } };
struct RowDiff { __device__ __forceinline__ int operator()(int c) const { if (c >= 2048) return c; const int off = c & 63; if (off >= 16) return c; return (c & ~63) + 2 * (off & 7) + (off >> 3); } };
struct RowMoeIn { __device__ __forceinline__ int operator()(int c) const { const int f = c & 2047; return (f >> 2) * 8 + (f & 3) + ((c >> 11) << 2); } };

__device__ __forceinline__ void p0_prologue() {
    const KArgs a = kargs(); const Frame F = mkframe(a);
    const int tid = F.tid, lane = F.lane;
    {
        const float* cin = (const float*)a->in[1]; const float* ada_w = (const float*)a->in[3]; const float* ada_b = (const float*)a->in[4];
        float* mods = (float*)(F.ws + WS_MODS);
        LAS float* sc = (LAS float*)F.lds; LAS float* red = (LAS float*)(F.lds + 16384);
        for (int i = tid; i < 4096; i += NTHREADS) { const float v = cin[i]; sc[i] = v / (1.0f + __expf(-v)); }
        __syncthreads();
        for (int cb = blockIdx.x; cb < 256; cb += F.G) {
            const int f0 = cb * 48, l = f0 / 6144, e0 = f0 % 6144; const int g = tid / 12, cc = tid % 12;
            if (g < 40) { f32x4 a0 = {0.f, 0.f, 0.f, 0.f}, a1 = a0, a2 = a0, a3 = a0; const float* wp = ada_w + (size_t)l * 1024 * 6144 + e0 + 4 * cc;
                f32x4 w[26];
#pragma unroll
                for (int i = 0; i < 26; ++i) { const int d = g + 40 * i; w[i] = (d < 1024) ? *(const f32x4*)(wp + (size_t)d * 6144) : (f32x4){0.f, 0.f, 0.f, 0.f}; }
#pragma unroll
                for (int i = 0; i < 26; ++i) { const int d = (g + 40 * i) & 1023; a0 += w[i] * sc[d]; a1 += w[i] * sc[1024 + d]; a2 += w[i] * sc[2048 + d]; a3 += w[i] * sc[3072 + d]; }
                LAS f32x4* rp = (LAS f32x4*)red + (g * 12 + cc) * 4; rp[0] = a0; rp[1] = a1; rp[2] = a2; rp[3] = a3; }
            __syncthreads();
            if (tid < 192) { const int c2 = tid % 48, b = tid / 48; float s = 0.f;
#pragma unroll 8
                for (int gg = 0; gg < 40; ++gg) s += red[((gg * 12 + (c2 >> 2)) * 4 + b) * 4 + (c2 & 3)];
                mods[(size_t)(l * 4 + b) * 6144 + e0 + c2] = s + ada_b[l * 6144 + e0 + c2]; }
            __syncthreads();
        }
    }
    {
        const int* pos = (const int*)a->in[2];
        float* cosm = (float*)(F.ws + WS_COSM); float* sinm = (float*)(F.ws + WS_SINM); float* cosd = (float*)(F.ws + WS_COSD); float* sind = (float*)(F.ws + WS_SIND);
        for (int i = blockIdx.x * NTHREADS + tid; i < T * 40; i += F.G * NTHREADS) {
            const int t = i / 40, j = i % 40; const double p = (double)pos[t]; float s, c;
            if (j < 32) { sincos_d(p * INV_M[j], s, c); cosm[(size_t)t * 32 + j] = c; sinm[(size_t)t * 32 + j] = s; }
            else { sincos_d(p * INV_D[j - 32], s, c); cosd[(size_t)t * 8 + (j - 32)] = c; sind[(size_t)t * 8 + (j - 32)] = s; }
        }
    }
    {
        LAS float* scr = (LAS float*)(F.lds + F.wave * 16384);
        const int gw = F.vcu * NWAVES + F.wave, NGW = F.G * NWAVES;
        { f16* z = (f16*)(F.ws + WS_WIN0) + (size_t)704 * 1024; for (int i = blockIdx.x * NTHREADS + tid; i < 8192; i += F.G * NTHREADS) *(u32x4*)(z + (size_t)i * 8) = (u32x4){0u, 0u, 0u, 0u}; }
        __syncthreads();
        constexpr int I0 = 16 * 11, I1 = 6 * 24, I2 = 4 * 32, I3 = 16 * 16, I4 = 16 * 48, I5 = 16 * 16;
        constexpr int ISM = I0 + I1 + I2 + I3 + I4 + I5;
        constexpr int IMI = 16 * 64, IMO = 32 * 16;
        constexpr int NITEMS = ISM + 32 * IMI + 32 * IMO;
        for (int it = gw; it < NITEMS; it += NGW) {
            int r = it;
            if (r < I0) { tr_item64((const float*)a->in[9], 704, 1024, (f16*)(F.ws + WS_WIN0), RowWin0(), scr, r / 11, r % 11, lane); continue; } r -= I0;
            if (r < I1) { tr_item64((const float*)a->in[12], 1536, 384, (f16*)(F.ws + WS_WUQ), RowUq(), scr, r / 24, r % 24, lane, (const float*)a->in[10]); continue; } r -= I1;
            if (r < I2) { tr_item64((const float*)a->in[13], 2048, 256, (f16*)(F.ws + WS_WUKV), RowId(), scr, r / 32, r % 32, lane, (const float*)a->in[11]); continue; } r -= I2;
            if (r < I3) { tr_item64((const float*)a->in[14], 1024, 1024, (f16*)(F.ws + WS_WO0), RowId(), scr, r / 16, r % 16, lane); continue; } r -= I3;
            if (r < I4) { tr_item64((const float*)a->in[15], 3072, 1024, (f16*)(F.ws + WS_WIN1), RowDiff(), scr, r / 48, r % 48, lane); continue; } r -= I4;
            if (r < I5) { tr_item64((const float*)a->in[18], 1024, 1024, (f16*)(F.ws + WS_WO1), RowId(), scr, r / 16, r % 16, lane); continue; } r -= I5;
            if (r < 32 * IMI) { const int mat = r / IMI, rr = r % IMI;
                tr_item64((const float*)a->in[20] + (size_t)mat * 1024 * 4096, 4096, 1024, (f16*)(F.ws + WS_MOEIN) + (size_t)mat * 4096 * 1024, RowMoeIn(), scr, rr / 64, rr % 64, lane); continue; }
            r -= 32 * IMI;
            { const int mat = r / IMO, rr = r % IMO;
                tr_item64((const float*)a->in[21] + (size_t)mat * 2048 * 1024, 1024, 2048, (f16*)(F.ws + WS_MOEOUT) + (size_t)mat * 1024 * 2048, RowId(), scr, rr / 16, rr % 16, lane); }
        }
    }
}

__device__ __forceinline__ void mod_rows_p1() {
    const KArgs a = kargs(); const Frame F = mkframe(a);
    const float* x = (const float*)a->in[0]; const float* mods_l = (const float*)(F.ws + WS_MODS); f16* out = (f16*)(F.ws + WS_HA);
    const int gw = F.vcu * NWAVES + F.wave, NGW = F.G * NWAVES, lane = F.lane;
    for (int m0 = gw; m0 < T; m0 += 2 * NGW) {
        f32x4 v[2][4];
#pragma unroll
        for (int u = 0; u < 2; ++u) { const int m = m0 + u * NGW; if (m < T) {
#pragma unroll
            for (int j = 0; j < 4; ++j) v[u][j] = *(const f32x4*)(x + (size_t)m * DM + 4 * lane + 256 * j); } }
#pragma unroll
        for (int u = 0; u < 2; ++u) { const int m = m0 + u * NGW; if (m < T) { const float* mb = mods_l + (m >> 12) * 6144;
#pragma unroll
            for (int j = 0; j < 4; ++j) { const int c = 4 * lane + 256 * j; const f32x4 sh = *(const f32x4*)(mb + c), sc = *(const f32x4*)(mb + 1024 + c);
                const f32x4 h = v[u][j] * (sc + 1.0f) + sh; h4 o; o[0] = (f16)h[0]; o[1] = (f16)h[1]; o[2] = (f16)h[2]; o[3] = (f16)h[3];
                *(h4*)(out + (size_t)m * DM + c) = o; } } }
    }
}

#define RCOL(lane, j) ((((j) >> 1) << 9) + 8 * (lane) + 4 * ((j) & 1))
__device__ __forceinline__ void h8_to_f4(const h8 v, f32x4& a, f32x4& b) { a = (f32x4){(float)v[0], (float)v[1], (float)v[2], (float)v[3]}; b = (f32x4){(float)v[4], (float)v[5], (float)v[6], (float)v[7]}; }
__device__ __forceinline__ void ln_router(int l) {
    const KArgs a = kargs(); const Frame F = mkframe(a);
    const float* lng = (const float*)a->in[5] + l * DM; const float* lnb = (const float*)a->in[6] + l * DM; const float* router_w = (const float*)a->in[19] + (size_t)l * DM * NE;
    const float* mods_l = (const float*)(F.ws + WS_MODS) + (size_t)l * 4 * 6144;
    const f16* pre = (const f16*)(F.ws + WS_PRE); float* stat = (float*)(F.ws + WS_STAT); f16* hB = (f16*)(F.ws + WS_HB); float* aff = (float*)(F.ws + WS_AFF);
    LAS float* rwT = (LAS float*)F.lds;
    for (int i = F.tid; i < 16384; i += NTHREADS) { const int d = i >> 4, e = i & 15; const int seg = d >> 9, w = d & 511; rwT[e * 1024 + seg * 512 + ((w >> 2) & 1) * 256 + (w >> 3) * 4 + (w & 3)] = router_w[i]; }
    __syncthreads();
    const int gw = F.vcu * NWAVES + F.wave, NGW = F.G * NWAVES, lane = F.lane;
    for (int m0 = gw; m0 < T; m0 += 2 * NGW) {
        h8 pv[2][2];
#pragma unroll
        for (int u = 0; u < 2; ++u) { const int m = (m0 + u * NGW < T) ? m0 + u * NGW : m0; pv[u][0] = *(const h8*)(pre + (size_t)m * DM + 8 * lane); pv[u][1] = *(const h8*)(pre + (size_t)m * DM + 512 + 8 * lane); }
#pragma unroll
        for (int u = 0; u < 2; ++u) { const int m = m0 + u * NGW; if (m < T) {
        const int b = m >> 12, s_ = m & 4095; const float* mb = mods_l + b * 6144;
        f32x4 v[4]; h8_to_f4(pv[u][0], v[0], v[1]); h8_to_f4(pv[u][1], v[2], v[3]); float s = 0.f;
#pragma unroll
        for (int j = 0; j < 4; ++j) s += (v[j][0] + v[j][1]) + (v[j][2] + v[j][3]);
        const float mean = wave_sum(s) * (1.f / DM); float s2 = 0.f;
#pragma unroll
        for (int j = 0; j < 4; ++j) { v[j] = v[j] - mean; s2 += (v[j][0] * v[j][0] + v[j][1] * v[j][1]) + (v[j][2] * v[j][2] + v[j][3] * v[j][3]); }
        const float rstd = 1.0f / sqrtf(wave_sum(s2) * (1.f / DM) + LN_EPS);
        if (lane == 0) { f32x2 st = {mean, rstd}; *(f32x2*)(stat + (size_t)m * 2) = st; }
        float lg[16];
#pragma unroll
        for (int e = 0; e < 16; ++e) lg[e] = 0.f;
        f32x4 hh[4];
#pragma unroll
        for (int j = 0; j < 4; ++j) { const int c = RCOL(lane, j);
            const f32x4 g = *(const f32x4*)(lng + c), bb = *(const f32x4*)(lnb + c), sh = *(const f32x4*)(mb + 3072 + c), sc = *(const f32x4*)(mb + 4096 + c);
            const f32x4 xn = v[j] * rstd * g + bb; const f32x4 h = xn * (sc + 1.0f) + sh; hh[j] = h;
#pragma unroll
            for (int e = 0; e < 16; ++e) { const f32x4 w = *(const LAS f32x4*)(rwT + e * 1024 + (j >> 1) * 512 + (j & 1) * 256 + lane * 4); lg[e] += (h[0] * w[0] + h[1] * w[1]) + (h[2] * w[2] + h[3] * w[3]); }
            asm volatile("" ::: "memory"); }
        *(h8*)(hB + (size_t)m * DM + 8 * lane) = pack8(hh[0], hh[1]); *(h8*)(hB + (size_t)m * DM + 512 + 8 * lane) = pack8(hh[2], hh[3]);
        float mx = -1e30f;
#pragma unroll
        for (int e = 0; e < 16; ++e) { lg[e] = wave_sum(lg[e]); mx = fmaxf(mx, lg[e]); }
        float den = 0.f;
#pragma unroll
        for (int e = 0; e < 16; ++e) { lg[e] = __expf(lg[e] - mx); den += lg[e]; }
        const float rden = 1.0f / den; float mine = 0.f;
#pragma unroll
        for (int e = 0; e < 16; ++e) mine = (lane == e) ? lg[e] * rden : mine;
        if (lane < 16) aff[(size_t)(b * 16 + lane) * SEQ + s_] = mine;
        } }
    }
    __syncthreads();
}

__device__ __forceinline__ int block_excl_scan(int v, LAS int* tmp, int tid, int& total) {
    const int lane = tid & 63, wid = tid >> 6; int x = v;
#pragma unroll
    for (int o = 1; o < 64; o <<= 1) { const int y = __shfl_up(x, o); if (lane >= o) x += y; }
    if (lane == 63) tmp[wid] = x;
    __syncthreads();
    int base = 0, tot = 0;
#pragma unroll
    for (int w = 0; w < 8; ++w) { const int t = tmp[w]; if (w < wid) base += t; tot += t; }
    __syncthreads();
    total = tot; return base + x - v;
}
__device__ __forceinline__ void topk_phase() {
    const KArgs a = kargs(); const Frame F = mkframe(a);
    const float* aff = (const float*)(F.ws + WS_AFF); float* gate = (float*)(F.ws + WS_GATE); int* rowtok = (int*)(F.ws + WS_ROWTOK); int* inv = (int*)(F.ws + WS_INV);
    LAS unsigned* hist = (LAS unsigned*)F.lds; LAS unsigned* selw = hist + 256; LAS int* tmp = (LAS int*)(hist + 272);
    const int tid = F.tid;
    for (int p = blockIdx.x; p < NB * NE; p += F.G) { const int b = p >> 4, e = p & 15;
        const float* ap = aff + (size_t)p * SEQ + 8 * tid; unsigned key[8];
        { const f32x4 a0 = *(const f32x4*)ap, a1 = *(const f32x4*)(ap + 4);
          key[0] = __float_as_uint(a0[0]); key[1] = __float_as_uint(a0[1]); key[2] = __float_as_uint(a0[2]); key[3] = __float_as_uint(a0[3]);
          key[4] = __float_as_uint(a1[0]); key[5] = __float_as_uint(a1[1]); key[6] = __float_as_uint(a1[2]); key[7] = __float_as_uint(a1[3]); }
        unsigned prefix = 0u, kk = CAP;
        for (int pass = 0; pass < 4; ++pass) { const int shift = 24 - 8 * pass;
            if (tid < 256) hist[tid] = 0u;
            __syncthreads();
#pragma unroll
            for (int j = 0; j < 8; ++j) { const bool match = (pass == 0) || ((key[j] >> (shift + 8)) == prefix); if (match) atomicAdd((unsigned*)&hist[(key[j] >> shift) & 255u], 1u); }
            __syncthreads();
            if (tid < 256) { unsigned S = 0u; for (int j = 0; j <= tid; ++j) S += hist[255 - j]; const unsigned Sp = S - hist[255 - tid];
                if (Sp < kk && kk <= S) { selw[0] = 255u - (unsigned)tid; selw[1] = kk - Sp; } }
            __syncthreads();
            prefix = (prefix << 8) | selw[0]; kk = selw[1];
            __syncthreads();
        }
        int ce = 0;
#pragma unroll
        for (int j = 0; j < 8; ++j) ce += (key[j] == prefix) ? 1 : 0;
        int tot; int eqr = block_excl_scan(ce, tmp, tid, tot);
        unsigned selm = 0u; int cs = 0;
#pragma unroll
        for (int j = 0; j < 8; ++j) { bool sel = key[j] > prefix; if (key[j] == prefix) { sel = (unsigned)eqr < kk; ++eqr; } if (sel) { selm |= 1u << j; ++cs; } }
        int slot = block_excl_scan(cs, tmp, tid, tot);
#pragma unroll
        for (int j = 0; j < 8; ++j) { const int s_ = 8 * tid + j; const int tok = b * SEQ + s_; const bool sel = (selm >> j) & 1u;
            if (sel) { const int row = e * EROWS + b * CAP + slot; rowtok[row] = tok; gate[row] = __uint_as_float(key[j]); inv[(size_t)tok * 16 + e] = slot; ++slot; }
            else inv[(size_t)tok * 16 + e] = -1; }
        __syncthreads();
    }
}
__device__ __forceinline__ void gather_rows() {
    const KArgs a = kargs(); const Frame F = mkframe(a);
    const int* rowtok = (const int*)(F.ws + WS_ROWTOK); const f16* hB = (const f16*)(F.ws + WS_HB); f16* xe = (f16*)(F.ws + WS_XE);
    const int gw = F.vcu * NWAVES + F.wave, NGW = F.G * NWAVES, lane = F.lane;
    for (int r0 = gw; r0 < MROWS; r0 += 4 * NGW) {
        int tok[4]; h8 d0[4], d1[4];
#pragma unroll
        for (int u = 0; u < 4; ++u) { const int r = r0 + u * NGW; tok[u] = (r < MROWS) ? rowtok[r] : 0; }
#pragma unroll
        for (int u = 0; u < 4; ++u) { d0[u] = *(const h8*)(hB + (size_t)tok[u] * DM + 8 * lane); d1[u] = *(const h8*)(hB + (size_t)tok[u] * DM + 512 + 8 * lane); }
#pragma unroll
        for (int u = 0; u < 4; ++u) { const int r = r0 + u * NGW; if (r < MROWS) { *(h8*)(xe + (size_t)r * DM + 8 * lane) = d0[u]; *(h8*)(xe + (size_t)r * DM + 512 + 8 * lane) = d1[u]; } }
    }
}
__device__ __forceinline__ void combine_ln(int l) {
    const KArgs a = kargs(); const Frame F = mkframe(a);
    const float* lng1 = (const float*)a->in[5] + l * DM; const float* lnb1 = (const float*)a->in[6] + l * DM;
    const float* lng = (const float*)a->in[7] + l * DM; const float* lnb = (const float*)a->in[8] + l * DM;
    const float* mods_l = (const float*)(F.ws + WS_MODS) + (size_t)l * 4 * 6144; const float* mods_next = (const float*)(F.ws + WS_MODS) + (size_t)4 * 6144;
    float* xo32 = a->out; f16* x2 = (f16*)(F.ws + WS_X2); f16* hA = (f16*)(F.ws + WS_HA);
    const f16* pre = (const f16*)(F.ws + WS_PRE); const float* stat = (const float*)(F.ws + WS_STAT); const f16* y = (const f16*)(F.ws + WS_Y); const int* inv = (const int*)(F.ws + WS_INV);
    const int gw = F.vcu * NWAVES + F.wave, NGW = F.G * NWAVES, lane = F.lane;
    for (int m0 = gw; m0 < T; m0 += 2 * NGW) {
        int myinv[2]; h8 pv[2][2]; f32x2 st[2];
#pragma unroll
        for (int u = 0; u < 2; ++u) { const int m = (m0 + u * NGW < T) ? m0 + u * NGW : m0; myinv[u] = inv[(size_t)m * 16 + (lane & 15)]; st[u] = *(const f32x2*)(stat + (size_t)m * 2);
            pv[u][0] = *(const h8*)(pre + (size_t)m * DM + 8 * lane); pv[u][1] = *(const h8*)(pre + (size_t)m * DM + 512 + 8 * lane); }
#pragma unroll
        for (int u = 0; u < 2; ++u) { const int m = m0 + u * NGW; if (m < T) {
        const int b = m >> 12; const float* mb = mods_l + b * 6144;
        f32x4 f[4];
#pragma unroll
        for (int j = 0; j < 4; ++j) f[j] = (f32x4){0.f, 0.f, 0.f, 0.f};
        unsigned mask = (unsigned)(__ballot(myinv[u] >= 0) & 0xFFFFull);
        while (mask) {
            const int e0 = __builtin_ctz(mask); mask &= mask - 1u; const bool two = mask != 0u; const int e1 = two ? __builtin_ctz(mask) : e0; mask &= mask - 1u;
            const int s0 = __shfl(myinv[u], e0), s1 = __shfl(myinv[u], e1);
            const f16* y0 = y + (size_t)(e0 * EROWS + b * CAP + s0) * DM; const f16* y1 = y + (size_t)(e1 * EROWS + b * CAP + s1) * DM;
            const h8 a00 = *(const h8*)(y0 + 8 * lane), a01 = *(const h8*)(y0 + 512 + 8 * lane), a10 = *(const h8*)(y1 + 8 * lane), a11 = *(const h8*)(y1 + 512 + 8 * lane);
            const float w1 = two ? 1.0f : 0.0f; f32x4 t0, t1;
            h8_to_f4(a00, t0, t1); f[0] += t0; f[1] += t1; h8_to_f4(a01, t0, t1); f[2] += t0; f[3] += t1;
            h8_to_f4(a10, t0, t1); f[0] += t0 * w1; f[1] += t1 * w1; h8_to_f4(a11, t0, t1); f[2] += t0 * w1; f[3] += t1 * w1;
        }
        f32x4 v[4]; h8_to_f4(pv[u][0], v[0], v[1]); h8_to_f4(pv[u][1], v[2], v[3]); float s = 0.f;
#pragma unroll
        for (int j = 0; j < 4; ++j) { const int c = RCOL(lane, j); const f32x4 g1 = *(const f32x4*)(lng1 + c), b1 = *(const f32x4*)(lnb1 + c), g2 = *(const f32x4*)(mb + 5120 + c);
            const f32x4 x1 = (v[j] - st[u][0]) * st[u][1] * g1 + b1;
            v[j] = x1 * ALPHA + (g2 + 1.0f) * f[j]; s += (v[j][0] + v[j][1]) + (v[j][2] + v[j][3]); }
        const float mean = wave_sum(s) * (1.f / DM); float s2 = 0.f;
#pragma unroll
        for (int j = 0; j < 4; ++j) { v[j] = v[j] - mean; s2 += (v[j][0] * v[j][0] + v[j][1] * v[j][1]) + (v[j][2] * v[j][2] + v[j][3] * v[j][3]); }
        const float rstd = 1.0f / sqrtf(wave_sum(s2) * (1.f / DM) + LN_EPS);
        f32x4 xn[4];
#pragma unroll
        for (int j = 0; j < 4; ++j) { const int c = RCOL(lane, j); const f32x4 g = *(const f32x4*)(lng + c), bb = *(const f32x4*)(lnb + c); xn[j] = v[j] * rstd * g + bb; }
        if (l == 0) {
            *(h8*)(x2 + (size_t)m * DM + 8 * lane) = pack8(xn[0], xn[1]); *(h8*)(x2 + (size_t)m * DM + 512 + 8 * lane) = pack8(xn[2], xn[3]);
            const float* mn = mods_next + b * 6144; f32x4 hv[4];
#pragma unroll
            for (int j = 0; j < 4; ++j) { const int c = RCOL(lane, j); const f32x4 sh = *(const f32x4*)(mn + c), sc = *(const f32x4*)(mn + 1024 + c); hv[j] = xn[j] * (sc + 1.0f) + sh; }
            *(h8*)(hA + (size_t)m * DM + 8 * lane) = pack8(hv[0], hv[1]); *(h8*)(hA + (size_t)m * DM + 512 + 8 * lane) = pack8(hv[2], hv[3]);
        } else {
#pragma unroll
            for (int j = 0; j < 4; ++j) *(f32x4*)(xo32 + (size_t)m * DM + RCOL(lane, j)) = xn[j];
        }
        } }
    }
}

__device__ __forceinline__ void attn_mla() {
    const KArgs a = kargs(); const Frame F = mkframe(a);
    const f16* Q = (const f16*)(F.ws + WS_Q); const f16* K = (const f16*)(F.ws + WS_K); const f16* V = (const f16*)(F.ws + WS_V); f16* O = (f16*)(F.ws + WS_O);
    for (int u = F.vcu; u < NB * 8 * 16; u += F.G) { const int qb = u & 15, bh = u >> 4, h = bh & 7, b = bh >> 3;
        att::attn_body_simple<192, 1536, 1536, 1024, 1024>(Q + (size_t)(b * SEQ + qb * 256) * 1536 + h * 192, K + (size_t)(b * SEQ) * 1536 + h * 192, V + (size_t)(b * SEQ) * 1024 + h * 128,
                                                       O + (size_t)(b * SEQ + qb * 256) * 1024 + h * 128, F.ldsg); }
}
__device__ __forceinline__ void attn_diff() {
    const KArgs a = kargs(); const Frame F = mkframe(a);
    const f16* QKV = (const f16*)(F.ws + WS_QKV1); f16* O = (f16*)(F.ws + WS_O);
    const float* lamv = (const float*)a->in[16]; const float* subln = (const float*)a->in[17];
    const float l01 = wave_sum(lamv[F.lane] * lamv[64 + F.lane]), l23 = wave_sum(lamv[128 + F.lane] * lamv[192 + F.lane]);
    const float lam = expf(l01) - expf(l23) + LAMBDA_INIT;
    for (int u = F.vcu; u < NB * 8 * 16; u += F.G) { const int qb = u & 15, bh = u >> 4, h = bh & 7, b = bh >> 3;
        f16* Ob = O + (size_t)(b * SEQ + qb * 256) * 1024 + h * 128; const f16* Vh = QKV + (size_t)(b * SEQ) * 3072 + 2048 + h * 128;
#pragma unroll 1
        for (int c = 0; c < 2; ++c) { const int hh = 2 * h + c;
            att::attn_body<64, 3072, 3072, 3072, 1024, 2>(QKV + (size_t)(b * SEQ + qb * 256) * 3072 + hh * 64, QKV + (size_t)(b * SEQ) * 3072 + 1024 + hh * 64, Vh, Ob, F.ldsg, c, lam, subln); } }
}

__device__ __forceinline__ void ph_gemm_lat() { const KArgs a = kargs(); const Frame F = mkframe(a);
    pg8::Gemm g{(const f16*)(F.ws + WS_HA), (const f16*)(F.ws + WS_WIN0), T, 768, 1024, 1 << 30, 0, nullptr}; pg8::StaticOrder S; S.init(T, 768, F.G, (int)blockIdx.x);
    EpiLat E{(f16*)(F.ws + WS_CQN), (f16*)(F.ws + WS_CKVN), (f16*)(F.ws + WS_K), (float*)(F.ws + WS_PQ), (float*)(F.ws + WS_PKV), (const float*)(F.ws + WS_COSM), (const float*)(F.ws + WS_SINM)}; pg8::gemm_phase<EpiLat>(F.lds, g, S, E); }
__device__ __forceinline__ void ph_gemm_q() { const KArgs a = kargs(); const Frame F = mkframe(a);
    pg8::Gemm g{(const f16*)(F.ws + WS_CQN), (const f16*)(F.ws + WS_WUQ), T, 1024, 384, 1 << 30, 0, nullptr}; pg8::StaticOrder S; S.init(T, 1024, F.G, (int)blockIdx.x);
    EpiQNope E{(f16*)(F.ws + WS_Q), (const float*)(F.ws + WS_PQ)}; pg8::gemm_phase<EpiQNope>(F.lds, g, S, E); }
__device__ __forceinline__ void ph_gemm_qr() { const KArgs a = kargs(); const Frame F = mkframe(a);
    pg8::Gemm g{(const f16*)(F.ws + WS_CQN), (const f16*)(F.ws + WS_WUQ) + (size_t)1024 * 384, T, 512, 384, 1 << 30, 0, nullptr}; pg8::StaticOrder S; S.init(T, 512, F.G, (int)blockIdx.x);
    EpiQRope E{(f16*)(F.ws + WS_Q), (const float*)(F.ws + WS_COSM), (const float*)(F.ws + WS_SINM), (const float*)(F.ws + WS_PQ)}; pg8::gemm_phase<EpiQRope>(F.lds, g, S, E); }
__device__ __forceinline__ void ph_gemm_kv() { const KArgs a = kargs(); const Frame F = mkframe(a);
    pg8::Gemm g{(const f16*)(F.ws + WS_CKVN), (const f16*)(F.ws + WS_WUKV), T, 2048, 256, 1 << 30, 0, nullptr}; pg8::StaticOrder S; S.init(T, 2048, F.G, (int)blockIdx.x);
    EpiKV E{(f16*)(F.ws + WS_K), (f16*)(F.ws + WS_V), (const float*)(F.ws + WS_PKV)}; pg8::gemm_phase<EpiKV>(F.lds, g, S, E); }
__device__ __forceinline__ void ph_gemm_o(int l) { const KArgs a = kargs(); const Frame F = mkframe(a);
    pg8::Gemm g{(const f16*)(F.ws + WS_O), (const f16*)(F.ws + (l == 0 ? WS_WO0 : WS_WO1)), T, 1024, 1024, 1 << 30, 0, nullptr}; pg8::StaticOrder S; S.init(T, 1024, F.G, (int)blockIdx.x);
    const float* gm = (const float*)(F.ws + WS_MODS) + (size_t)l * 4 * 6144 + 2048;
    if (l == 0) { EpiPre<false> E{a->in[0], gm, (f16*)(F.ws + WS_PRE)}; pg8::gemm_phase<EpiPre<false>>(F.lds, g, S, E); }
    else { EpiPre<true> E{(const void*)(F.ws + WS_X2), gm, (f16*)(F.ws + WS_PRE)}; pg8::gemm_phase<EpiPre<true>>(F.lds, g, S, E); } }
__device__ __forceinline__ void ph_gemm_diffin() { const KArgs a = kargs(); const Frame F = mkframe(a);
    pg8::Gemm g{(const f16*)(F.ws + WS_HA), (const f16*)(F.ws + WS_WIN1), T, 3072, 1024, 1 << 30, 0, nullptr}; pg8::StaticOrder S; S.init(T, 3072, F.G, (int)blockIdx.x);
    EpiDiffIn E{(f16*)(F.ws + WS_QKV1), (const float*)(F.ws + WS_COSD), (const float*)(F.ws + WS_SIND)}; pg8::gemm_phase<EpiDiffIn>(F.lds, g, S, E); }
__device__ __forceinline__ void ph_gemm_up(int l) { const KArgs a = kargs(); const Frame F = mkframe(a);
    pg8::Gemm g{(const f16*)(F.ws + WS_HB), (const f16*)(F.ws + WS_MOEIN) + (size_t)l * NE * 4096 * 1024, MROWS, 4096, 1024, EROWS / 256, (size_t)4096 * 1024, (const int*)(F.ws + WS_ROWTOK)}; pg8::StaticOrder S; S.init(MROWS, 4096, F.G, (int)blockIdx.x);
    EpiUp E{(f16*)(F.ws + WS_ACT)}; pg8::gemm_phase<EpiUp, true, true, true>(F.lds, g, S, E); }
__device__ __forceinline__ void ph_gemm_down(int l) { const KArgs a = kargs(); const Frame F = mkframe(a);
    pg8::Gemm g{(const f16*)(F.ws + WS_ACT), (const f16*)(F.ws + WS_MOEOUT) + (size_t)l * NE * 1024 * 2048, MROWS, 1024, 2048, EROWS / 256, (size_t)1024 * 2048, nullptr}; pg8::StaticOrder S; S.init(MROWS, 1024, F.G, (int)blockIdx.x);
    EpiDown E{(f16*)(F.ws + WS_Y), (const float*)(F.ws + WS_GATE)}; pg8::gemm_phase<EpiDown>(F.lds, g, S, E); }

constexpr int NPHASES = 24;
__global__ void __launch_bounds__(NTHREADS, 2) mk_fwd(Args args) {
    LAS unsigned char* ldsp = (LAS unsigned char*)g_lds;
    volatile LAS unsigned* MISC = (volatile LAS unsigned*)(ldsp + MISC_OFF);
    for (int u = threadIdx.x; u < (LDS_BYTES - LDSCTL_OFF) / 4; u += NTHREADS) ((LAS unsigned*)(ldsp + LDSCTL_OFF))[u] = 0u;
    __syncthreads();
    XcdBarrier bar = xcd_barrier_post((unsigned*)(args.ws + WS_CTL) + CW_BAR + args.li * XCD_BAR_WORDS, MISC + 8);
    const int lo = args.ph_lo, hi = args.ph_hi;
#ifndef PH_MASK
#define PH_MASK 0xFFFFFFFFu
#endif
#define IN(k) (((PH_MASK >> (k)) & 1u) && lo <= (k) && (k) < hi)
#define SEAM(k) do { if (lo <= (k) && (k) + 1 < hi) xcd_barrier(bar); } while (0)
#ifndef REP_MASK
#define REP_MASK 0u
#endif
#define RUN(k, call) do { if (IN(k)) { call; if ((REP_MASK >> (k)) & 1u) { __syncthreads(); call; } } } while (0)
    RUN(0, p0_prologue());      SEAM(0);
    RUN(1, mod_rows_p1());      SEAM(1);
    RUN(2, ph_gemm_lat());      SEAM(2);
    RUN(4, ph_gemm_q()); RUN(4, ph_gemm_qr());
    RUN(5, ph_gemm_kv());       SEAM(5);
    RUN(6, attn_mla());         SEAM(6);
#pragma unroll 1
    for (int l = 0; l < 2; ++l) {
        const int pb = (l == 0) ? 7 : 17;
        if (l == 1) {
            RUN(14, ph_gemm_diffin()); SEAM(14);
            RUN(15, attn_diff());      SEAM(15);
        }
        RUN(pb + 0, ph_gemm_o(l));     SEAM(pb + 0);
        RUN(pb + 1, ln_router(l));     SEAM(pb + 1);
        RUN(pb + 2, topk_phase());     SEAM(pb + 2);
        RUN(pb + 4, ph_gemm_up(l));    SEAM(pb + 4);
        RUN(pb + 5, ph_gemm_down(l));  SEAM(pb + 5);
        RUN(pb + 6, combine_ln(l));
        if (l == 0) SEAM(pb + 6);
    }
#undef IN
#undef SEAM
}

extern "C" void kernel_launch(void* const* d_in, const int* in_sizes, int n_in, void* d_out, int out_size, void* d_ws, size_t ws_size, hipStream_t stream) {
    static int grid = 0;
    if (grid == 0) {
        if (n_in != 22 || in_sizes[0] != T * DM || out_size != T * DM || ws_size < WS_END) {
            fprintf(stderr, "kernel_launch: shape/workspace mismatch: n_in %d in0 %d out %d ws %zu (need %zu)\n", n_in, n_in > 0 ? in_sizes[0] : -1, out_size, ws_size, (size_t)WS_END); grid = -1; return; }
        int dev = 0, cus = 0, per_cu = 0;
        if (hipGetDevice(&dev) != hipSuccess || hipDeviceGetAttribute(&cus, hipDeviceAttributeMultiprocessorCount, dev) != hipSuccess) { fprintf(stderr, "kernel_launch: device query failed\n"); grid = -1; return; }
        if (hipFuncSetAttribute((const void*)mk_fwd, hipFuncAttributeMaxDynamicSharedMemorySize, LDS_BYTES) != hipSuccess) { fprintf(stderr, "kernel_launch: hipFuncSetAttribute failed\n"); grid = -1; return; }
        if (hipOccupancyMaxActiveBlocksPerMultiprocessor(&per_cu, (const void*)mk_fwd, NTHREADS, LDS_BYTES) != hipSuccess || per_cu < 1)
            fprintf(stderr, "kernel_launch: note: occupancy query reports %d workgroups per CU\n", per_cu);
        (void)hipGetLastError();
        grid = cus;
    }
    if (grid < 0) return;
    if (hipMemsetAsync((char*)d_ws + WS_CTL, 0, CTL_ZERO_BYTES, stream) != hipSuccess) { fprintf(stderr, "kernel_launch: memset failed\n"); return; }
    Args a{};
    for (int i = 0; i < 22; ++i) a.in[i] = d_in[i];
    a.out = (float*)d_out; a.ws = (unsigned char*)d_ws;
#if MK_CUTS == 1
    a.ph_lo = 0; a.ph_hi = NPHASES; a.li = 0;
    hipLaunchKernelGGL(mk_fwd, dim3(grid), dim3(NTHREADS), LDS_BYTES, stream, a);
#else
    for (int p = 0; p < NPHASES; ++p) { a.ph_lo = p; a.ph_hi = p + 1; a.li = 0; hipLaunchKernelGGL(mk_fwd, dim3(grid), dim3(NTHREADS), LDS_BYTES, stream, a); }
#endif
    const hipError_t le = hipPeekAtLastError();
    if (le != hipSuccess) fprintf(stderr, "kernel_launch: launch failed: %s\n", hipGetErrorName(le));
}
```

```cpp
#include <hip/hip_runtime.h>
#include <cstdio>
#include <cstdint>

#ifndef MK_CUTS
#define MK_CUTS 1
#endif


#define LAS __attribute__((address_space(3)))
#define GAS __attribute__((address_space(1)))
typedef _Float16 f16;
typedef _Float16 h8 __attribute__((ext_vector_type(8)));
typedef _Float16 h4 __attribute__((ext_vector_type(4)));
typedef _Float16 h2 __attribute__((ext_vector_type(2)));
typedef short s16x4 __attribute__((ext_vector_type(4)));
typedef float f32x4 __attribute__((ext_vector_type(4)));
typedef float f32x2 __attribute__((ext_vector_type(2)));
typedef float f32x16 __attribute__((ext_vector_type(16)));
typedef unsigned u32x4 __attribute__((ext_vector_type(4)));
typedef unsigned u32x2 __attribute__((ext_vector_type(2)));

constexpr int NB = 4, SEQ = 4096, DM = 1024, T = NB * SEQ;
constexpr int NE = 16, FF = 2048, CAP = 512, EROWS = NB * CAP;
constexpr int MROWS = NE * EROWS;
constexpr float ALPHA = 1.4142135623730951f;
constexpr float LN_EPS = 1e-5f, LAT_EPS = 1e-6f;
constexpr float LAMBDA_INIT = 0.35550906759096926f;
constexpr int NWAVES = 8, NTHREADS = 512;

constexpr size_t MiB = 1u << 20;
constexpr size_t WS_CTL = 0, CTL_ZERO_BYTES = 1 * MiB;
constexpr size_t WS_MODS = 1 * MiB;
constexpr size_t WS_COSM = 2 * MiB, WS_SINM = 4 * MiB;
constexpr size_t WS_COSD = 6 * MiB, WS_SIND = 6 * MiB + 512 * 1024;
constexpr size_t WS_AFF = 7 * MiB;
constexpr size_t WS_GATE = 8 * MiB;
constexpr size_t WS_ROWTOK = 8 * MiB + 512 * 1024;
constexpr size_t WS_INV = 9 * MiB;
constexpr size_t WS_WIN0 = 16 * MiB;
constexpr size_t WS_WUQ = 18 * MiB;
constexpr size_t WS_WUKV = 20 * MiB;
constexpr size_t WS_WO0 = 22 * MiB;
constexpr size_t WS_WIN1 = 24 * MiB;
constexpr size_t WS_WO1 = 30 * MiB;
constexpr size_t WS_MOEIN = 32 * MiB;
constexpr size_t WS_MOEOUT = 288 * MiB;
constexpr size_t WS_HA = 416 * MiB;
constexpr size_t WS_HB = 448 * MiB;
constexpr size_t WS_PQ = 480 * MiB;
constexpr size_t WS_PKV = 481 * MiB;
constexpr size_t WS_CQN = 528 * MiB;
constexpr size_t WS_CKVN = 540 * MiB;
constexpr size_t WS_Q = 548 * MiB;
constexpr size_t WS_K = 596 * MiB;
constexpr size_t WS_V = 644 * MiB;
constexpr size_t WS_O = 676 * MiB;
constexpr size_t WS_PRE = 708 * MiB;
constexpr size_t WS_STAT = 772 * MiB;
constexpr size_t WS_X2 = 836 * MiB;
constexpr size_t WS_XE = 900 * MiB;
constexpr size_t WS_ACT = 964 * MiB;
constexpr size_t WS_Y = 1092 * MiB;
constexpr size_t WS_QKV1 = 1156 * MiB;
constexpr size_t WS_OD = 1252 * MiB;
constexpr size_t WS_END = 1316 * MiB;
constexpr int CW_BAR = 4096;

constexpr int RING_BYTES = 131072;
constexpr int LDSCTL_OFF = RING_BYTES, MISC_OFF = LDSCTL_OFF + 320;
constexpr int LDS_BYTES = 147456;

#define LDS_WAIT() asm volatile("s_waitcnt lgkmcnt(0)" ::: "memory")
#define VM_WAIT() asm volatile("s_waitcnt vmcnt(0)" ::: "memory")

__device__ __forceinline__ float wave_sum(float v) {
#pragma unroll
    for (int o = 1; o < 64; o <<= 1) v += __shfl_xor(v, o);
    return v;
}

#define XB_TMO      128
#define XB_XCNT(j)  (256  + 64 * (j))
#define XB_XSUB(j)  (1280 + 64 * (j))
#define XB_XGEN(j)  (2304 + 64 * (j))
#define XB_TOP      3328
#define XB_TOPGEN   3392
#define XCD_BAR_WORDS 3456
#define XB_SPIN_CAP (1u << 20)
__device__ __forceinline__ unsigned xb_ld(unsigned* p)              { return __hip_atomic_load(p, __ATOMIC_RELAXED, __HIP_MEMORY_SCOPE_AGENT); }
__device__ __forceinline__ unsigned xb_add(unsigned* p, unsigned v) { return __hip_atomic_fetch_add(p, v, __ATOMIC_RELAXED, __HIP_MEMORY_SCOPE_AGENT); }
__device__ __forceinline__ unsigned xb_xcc_id() { return (unsigned)__builtin_amdgcn_s_getreg((3 << 11) | 20) & 0xFu; }
#define XB_SPIN(cond, bar) do { unsigned _sp = 0; while (cond) { __builtin_amdgcn_s_sleep(1); \
    if ((++_sp & 255u) == 0u) { if (xb_ld(&(bar)[XB_TMO])) break; if (_sp > XB_SPIN_CAP) { atomicAdd(&(bar)[XB_TMO], 1u); break; } } } } while (0)
struct XcdBarrier { unsigned* bar; unsigned x; volatile LAS unsigned* st; };
__device__ __forceinline__ XcdBarrier xcd_barrier_post(unsigned* bar, volatile LAS unsigned* st) {
    XcdBarrier b; b.bar = bar; b.x = xb_xcc_id(); b.st = st;
    if (threadIdx.x == 0) (void)xb_add(&bar[XB_XCNT(b.x)], 1u);
    return b;
}
__device__ __forceinline__ void xcd_barrier_complete(unsigned* bar, unsigned x, unsigned& nloc, unsigned& nx) {
    const unsigned G = gridDim.x * gridDim.y * gridDim.z;
    unsigned sum, cnt, mine, sp = 0u;
    for (;;) {
        sum = 0u; cnt = 0u; mine = 0u;
#pragma unroll
        for (unsigned j = 0; j < 16; ++j) { const unsigned c = xb_ld(&bar[XB_XCNT(j)]); sum += c; cnt += (c > 0u) ? 1u : 0u; mine = (j == x) ? c : mine; }
        if (sum == G) break;
        __builtin_amdgcn_s_sleep(1);
        if ((++sp & 255u) == 0u) { if (xb_ld(&bar[XB_TMO])) break; if (sp > XB_SPIN_CAP) { atomicAdd(&bar[XB_TMO], 1u); break; } }
    }
    nloc = mine > 0u ? mine : 1u; nx = cnt > 0u ? cnt : 1u;
}
__device__ __forceinline__ void xcd_barrier(const XcdBarrier& b) {
    asm volatile("s_waitcnt vmcnt(0)" ::: "memory");
    __syncthreads();
    if (threadIdx.x == 0) {
        unsigned* bar = b.bar;
        __builtin_amdgcn_s_waitcnt(0);
        unsigned nloc = b.st[0], nx = b.st[1];
        if (nloc == 0u) { xcd_barrier_complete(bar, b.x, nloc, nx); b.st[0] = nloc; b.st[1] = nx; }
        const unsigned old = xb_add(&bar[XB_XSUB(b.x)], 1u);
        const unsigned gen = old / nloc;
        if (old + 1u == (gen + 1u) * nloc) {
            __builtin_amdgcn_fence(__ATOMIC_RELEASE, "agent");
            asm volatile("s_waitcnt vmcnt(0)" ::: "memory");
            const unsigned og = xb_add(&bar[XB_TOP], 1u);
            const unsigned tg = og / nx;
            if (og + 1u == (tg + 1u) * nx) xb_add(&bar[XB_TOPGEN], 1u);
            else XB_SPIN(xb_ld(&bar[XB_TOPGEN]) == tg, bar);
            __builtin_amdgcn_fence(__ATOMIC_ACQUIRE, "agent");
            xb_add(&bar[XB_XGEN(b.x)], 1u);
            asm volatile("s_waitcnt vmcnt(0)" ::: "memory");
        } else {
            XB_SPIN(xb_ld(&bar[XB_XGEN(b.x)]) == gen, bar);
            __builtin_amdgcn_fence(__ATOMIC_ACQUIRE, "agent");
            asm volatile("s_waitcnt vmcnt(0)" ::: "memory");
        }
    }
    __syncthreads();
}

namespace pg8 {
constexpr int BM = 256, BK = 64, HALF = 128, HTB = HALF * BK * 2, STAGE_BYTES = 8 * HTB, NXCD = 8, WGM = 8;
__host__ __device__ __forceinline__ int lds_byte(int r, int c) { const int st = (r >> 4) * 2 + (c >> 5), rr = r & 15, cc = c & 31, ob = rr * 64 + cc * 2; return st * 1024 + (ob ^ (((ob >> 9) & 1) << 5)); }
__host__ __device__ __forceinline__ void stage_rc(int b, int& R, int& C) { const int st = b / 1024, sb = b % 1024, swz = sb ^ (((sb >> 9) & 1) << 5); R = (st >> 1) * 16 + swz / 64; C = (st & 1) * 32 + (swz % 64) / 2; }
__host__ __device__ __forceinline__ int perm32(int rho) { const int n = rho >> 4, i = rho & 15; return 8 * (i >> 2) + 4 * n + (i & 3); }
struct Unit { int pm, pn; };
struct Gemm { const f16* A; const f16* Bt; int M, N, K; int grp_tiles; size_t grp_stride; const int* rowidx; };
struct StaticOrder {
    int nM, nN, nwg, G, c;
    __host__ __device__ void init(int M, int N, int G_, int c_) { nM = M / BM; nN = N / BM; nwg = nM * nN; G = G_; c = c_; }
    __host__ __device__ bool next(int i, Unit& u) const {
        const long L = (long)i * G + c; if (L >= nwg) return false;
        int wgid = (int)L; { const int q = nwg / NXCD, r = nwg % NXCD, xcd = wgid % NXCD, off = wgid / NXCD; wgid = (xcd < r ? xcd * (q + 1) : r * (q + 1) + (xcd - r) * q) + off; }
        const int nig = WGM * nN, gid = wgid / nig, fm = gid * WGM, gsz = (nM - fm) < WGM ? (nM - fm) : WGM;
        u.pm = fm + ((wgid % nig) % gsz); u.pn = (wgid % nig) / gsz; return true;
    }
};
constexpr int GATHER_MAX_UNITS = 15, GATHER_IDX_OFF = RING_BYTES + 1024;
template <class Epi, bool ALIGN_EPI = true, bool SP2 = true, bool GATHER = false>
__device__ __forceinline__ void gemm_phase(LAS unsigned char* lds, const Gemm g, const StaticOrder& S, const Epi& E) {
    int tid = threadIdx.x; asm volatile("" : "+v"(tid));
    const int wid = __builtin_amdgcn_readfirstlane(tid >> 6), lane = tid & 63, wr = wid >> 2, wc = wid & 3, fr = lane & 15, fq = lane >> 4;
    const int K = g.K, nt = K / BK;
    unsigned voffA[2], voffB[2];
#pragma unroll
    for (int i = 0; i < 2; ++i) { int R, C; stage_rc(tid * 16 + i * 8192, R, C); const int Rb = Epi::PERM ? ((R & ~31) + perm32(R & 31)) : R;
        voffA[i] = (unsigned)(R * K + C) * 2u; voffB[i] = (unsigned)(Rb * K + C) * 2u; }
    int gR[2]; unsigned gC[2];
#pragma unroll
    for (int i = 0; i < 2; ++i) { int R, C; stage_rc(tid * 16 + i * 8192, R, C); gR[i] = R; gC[i] = (unsigned)C * 2u; }
    LAS int* idxbuf = (LAS int*)(lds + GATHER_IDX_OFF);
    if constexpr (GATHER) {
        Unit uu;
        for (int q = 0; q < GATHER_MAX_UNITS; ++q) { if (!S.next(q, uu)) break; if (tid < 256) idxbuf[q * 256 + tid] = g.rowidx[uu.pm * 256 + tid]; }
        asm volatile("s_waitcnt vmcnt(0) lgkmcnt(0)" ::: "memory"); __builtin_amdgcn_s_barrier(); asm volatile("" ::: "memory");
    }
    unsigned gaC[2][2], gaN[2][2], ga2[2][2];
#define PG8_GA(dst, q) do { _Pragma("unroll") for (int _h = 0; _h < 2; ++_h) _Pragma("unroll") for (int _i = 0; _i < 2; ++_i) dst[_h][_i] = (unsigned)idxbuf[(q) * 256 + _h * 128 + gR[_i]] * (unsigned)(K * 2) + gC[_i]; } while (0)
    const size_t kstep = (size_t)(BK * 2);
    const size_t hstep = (size_t)HALF * K * 2;
    const size_t tstep = 2 * hstep;
    const unsigned ldsw = (unsigned)wid * 1024u;
    const int aoff = lds_byte(wr * 64 + fr, fq * 8), boff = lds_byte(wc * 32 + fr, fq * 8);
#define PG8_SA(b, h) (((b) * 2 + (h)) * HTB)
#define PG8_SB(b, h) ((4 + (b) * 2 + (h)) * HTB)
#define PG8_STAGE(bufoff, gbase, voff) do { _Pragma("unroll") for (int _i = 0; _i < 2; ++_i) \
        __builtin_amdgcn_global_load_lds((const unsigned*)((const char*)(gbase) + (voff)[_i]), (LAS unsigned*)(lds + (bufoff) + ldsw + _i * 8192), 16, 0, 0); } while (0)
#define PG8_LDA(dst, b, h) do { _Pragma("unroll") for (int m = 0; m < 4; ++m) _Pragma("unroll") for (int k = 0; k < 2; ++k) dst[m][k] = *(const LAS h8*)(lds + PG8_SA(b, h) + aoff + m * 2048 + k * 1024); } while (0)
#define PG8_LDB(dst, b, h) do { _Pragma("unroll") for (int n = 0; n < 2; ++n) _Pragma("unroll") for (int k = 0; k < 2; ++k) dst[n][k] = *(const LAS h8*)(lds + PG8_SB(b, h) + boff + n * 2048 + k * 1024); } while (0)
#define PG8_MMA(ai, bj, At, Bt) do { __builtin_amdgcn_s_setprio(1); _Pragma("unroll") for (int m = 0; m < 4; ++m) _Pragma("unroll") for (int n = 0; n < 2; ++n) _Pragma("unroll") for (int k = 0; k < 2; ++k) \
        acc[ai][bj][m][n] = __builtin_amdgcn_mfma_f32_16x16x32_f16(Bt[n][k], At[m][k], acc[ai][bj][m][n], 0, 0, 0); __builtin_amdgcn_s_setprio(0); } while (0)
#define PG8_WAIT_V(n) asm volatile("s_waitcnt vmcnt(" #n ")" ::: "memory")
#define PG8_WAIT_L(n) asm volatile("s_waitcnt lgkmcnt(" #n ")" ::: "memory")
#define PG8_BAR __builtin_amdgcn_s_barrier()
#define PG8_SCHED __builtin_amdgcn_sched_barrier(0)
#define PG8_STA(bufoff, tileptr, h, gaset, kbyte) do { if constexpr (GATHER) { PG8_STAGE(bufoff, (const char*)g.A + (kbyte), gaset[h]); } else { PG8_STAGE(bufoff, (tileptr) + (h) * hstep, voffA); } } while (0)
#define PG8_BBASE(u) ((const char*)g.Bt + ((size_t)((u).pm / g.grp_tiles) * g.grp_stride) * 2 + (size_t)(u).pn * tstep)
    Unit cur, nxt; int ui = 0;
    if (!S.next(0, cur)) return;
    f32x4 acc[2][2][4][2];
#pragma unroll
    for (int a = 0; a < 2; ++a)
#pragma unroll
        for (int b = 0; b < 2; ++b)
#pragma unroll
            for (int m = 0; m < 4; ++m)
#pragma unroll
                for (int n = 0; n < 2; ++n) acc[a][b][m][n] = (f32x4){0.f, 0.f, 0.f, 0.f};
    h8 At[4][2], B0[2][2], B1[2][2];
    const char* cA = (const char*)g.A + (size_t)cur.pm * tstep; const char* cB = PG8_BBASE(cur);
    if constexpr (GATHER) { PG8_GA(gaC, 0); }
    if constexpr (SP2) {
        PG8_STAGE(PG8_SB(0, 0), cB, voffB); PG8_STAGE(PG8_SB(0, 1), cB + hstep, voffB); PG8_STA(PG8_SA(0, 0), cA, 0, gaC, 0); PG8_STA(PG8_SA(0, 1), cA, 1, gaC, 0);
        if (wr == 1) PG8_BAR;
        PG8_WAIT_V(2); PG8_BAR;
        PG8_STAGE(PG8_SB(1, 0), cB + kstep, voffB); PG8_STA(PG8_SA(1, 0), cA + kstep, 0, gaC, kstep); PG8_STAGE(PG8_SB(1, 1), cB + hstep + kstep, voffB);
        PG8_WAIT_V(6); PG8_BAR;
    } else {
        PG8_STAGE(PG8_SB(0, 0), cB, voffB); PG8_STA(PG8_SA(0, 0), cA, 0, gaC, 0); PG8_STAGE(PG8_SB(0, 1), cB + hstep, voffB); PG8_STA(PG8_SA(0, 1), cA, 1, gaC, 0);
        if (wr == 1) PG8_BAR;
        PG8_WAIT_V(4); PG8_BAR;
        PG8_STAGE(PG8_SB(1, 0), cB + kstep, voffB); PG8_STA(PG8_SA(1, 0), cA + kstep, 0, gaC, kstep); PG8_STAGE(PG8_SB(1, 1), cB + hstep + kstep, voffB);
        PG8_WAIT_V(6); PG8_BAR;
    }
    for (;;) {
        const bool has_next = S.next(ui + 1, nxt);
        const char* nA = has_next ? (const char*)g.A + (size_t)nxt.pm * tstep : cA; const char* nB = has_next ? PG8_BBASE(nxt) : cB;
        if constexpr (GATHER) { const int qn = has_next ? ui + 1 : ui; PG8_GA(gaN, qn); }
#pragma unroll 1
        for (int t = 0; t < nt; t += 2) {
            const bool last = (t == nt - 2);
            const char* a1 = cA + (size_t)(t + 1) * kstep;
            const char* a2 = last ? nA : cA + (size_t)(t + 2) * kstep; const char* b2 = last ? nB : cB + (size_t)(t + 2) * kstep;
            const char* a3 = a2 + kstep; const char* b3 = b2 + kstep;
            const size_t k1 = (size_t)(t + 1) * kstep, k2 = last ? 0 : (size_t)(t + 2) * kstep, k3 = k2 + kstep;
            if constexpr (GATHER) { _Pragma("unroll") for (int _h = 0; _h < 2; ++_h) _Pragma("unroll") for (int _i = 0; _i < 2; ++_i) ga2[_h][_i] = last ? gaN[_h][_i] : gaC[_h][_i]; }
            if constexpr (SP2) {
            PG8_LDB(B0, 0, 0); PG8_LDB(B1, 0, 1); PG8_SCHED; PG8_LDA(At, 0, 0); PG8_STA(PG8_SA(1, 1), a1, 1, gaC, k1);
            PG8_WAIT_V(8); PG8_WAIT_L(0); PG8_BAR; PG8_MMA(0, 0, At, B0); PG8_MMA(0, 1, At, B1); PG8_BAR; PG8_SCHED;
            PG8_LDA(At, 0, 1); PG8_STAGE(PG8_SB(0, 0), b2, voffB); PG8_STAGE(PG8_SB(0, 1), b2 + hstep, voffB); PG8_STA(PG8_SA(0, 0), a2, 0, ga2, k2);
            PG8_WAIT_V(8); PG8_WAIT_L(0); PG8_BAR; PG8_MMA(1, 0, At, B0); PG8_MMA(1, 1, At, B1); PG8_BAR; PG8_SCHED;
            PG8_LDB(B0, 1, 0); PG8_LDB(B1, 1, 1); PG8_SCHED; PG8_LDA(At, 1, 0); PG8_STA(PG8_SA(0, 1), a2, 1, ga2, k2);
            PG8_WAIT_V(8); PG8_WAIT_L(0); PG8_BAR; PG8_MMA(0, 0, At, B0); PG8_MMA(0, 1, At, B1); PG8_BAR; PG8_SCHED;
            PG8_LDA(At, 1, 1); PG8_STAGE(PG8_SB(1, 0), b3, voffB); PG8_STAGE(PG8_SB(1, 1), b3 + hstep, voffB); PG8_STA(PG8_SA(1, 0), a3, 0, ga2, k3);
            PG8_WAIT_V(8); PG8_WAIT_L(0); PG8_BAR; PG8_MMA(1, 0, At, B0); PG8_MMA(1, 1, At, B1); PG8_BAR; PG8_SCHED;
            } else {
            PG8_LDB(B0, 0, 0); PG8_SCHED; PG8_LDA(At, 0, 0); PG8_STA(PG8_SA(1, 1), a1, 1, gaC, k1);
            PG8_WAIT_L(8); PG8_BAR; PG8_WAIT_L(0); PG8_MMA(0, 0, At, B0); PG8_BAR; PG8_SCHED;
            PG8_LDB(B1, 0, 1); PG8_STAGE(PG8_SB(0, 0), b2, voffB);
            PG8_BAR; PG8_WAIT_L(0); PG8_MMA(0, 1, At, B1); PG8_BAR;
            PG8_LDA(At, 0, 1); PG8_STA(PG8_SA(0, 0), a2, 0, ga2, k2);
            PG8_BAR; PG8_WAIT_L(0); PG8_MMA(1, 0, At, B0); PG8_BAR; PG8_SCHED;
            PG8_STAGE(PG8_SB(0, 1), b2 + hstep, voffB);
            PG8_WAIT_V(6); PG8_BAR; PG8_MMA(1, 1, At, B1); PG8_BAR;
            PG8_LDB(B0, 1, 0); PG8_SCHED; PG8_LDA(At, 1, 0); PG8_STA(PG8_SA(0, 1), a2, 1, ga2, k2);
            PG8_WAIT_L(8); PG8_BAR; PG8_WAIT_L(0); PG8_MMA(0, 0, At, B0); PG8_BAR; PG8_SCHED;
            PG8_LDB(B1, 1, 1); PG8_STAGE(PG8_SB(1, 0), b3, voffB);
            PG8_BAR; PG8_WAIT_L(0); PG8_MMA(0, 1, At, B1); PG8_BAR;
            PG8_LDA(At, 1, 1); PG8_STA(PG8_SA(1, 0), a3, 0, ga2, k3);
            PG8_BAR; PG8_WAIT_L(0); PG8_MMA(1, 0, At, B0); PG8_BAR; PG8_SCHED;
            PG8_STAGE(PG8_SB(1, 1), b3 + hstep, voffB);
            PG8_WAIT_V(6); PG8_BAR; PG8_MMA(1, 1, At, B1); PG8_BAR;
            }
        }
        if constexpr (ALIGN_EPI) { if (wr == 0) PG8_BAR; }
        E(acc, cur, wr, wc, fr, fq);
        if (!has_next) break;
#pragma unroll
        for (int a = 0; a < 2; ++a)
#pragma unroll
            for (int b = 0; b < 2; ++b)
#pragma unroll
                for (int m = 0; m < 4; ++m)
#pragma unroll
                    for (int n = 0; n < 2; ++n) acc[a][b][m][n] = (f32x4){0.f, 0.f, 0.f, 0.f};
        cur = nxt; cA = nA; cB = nB; ++ui;
        if constexpr (GATHER) { _Pragma("unroll") for (int _h = 0; _h < 2; ++_h) _Pragma("unroll") for (int _i = 0; _i < 2; ++_i) gaC[_h][_i] = gaN[_h][_i]; }
        if constexpr (ALIGN_EPI) { if (wr == 1) PG8_BAR; }
    }
    PG8_WAIT_V(0);
    if constexpr (!ALIGN_EPI) { if (wr == 0) PG8_BAR; }
    PG8_BAR;
#undef PG8_SA
#undef PG8_SB
#undef PG8_STAGE
#undef PG8_LDA
#undef PG8_LDB
#undef PG8_MMA
#undef PG8_WAIT_V
#undef PG8_WAIT_L
#undef PG8_BAR
#undef PG8_SCHED
#undef PG8_BBASE
#undef PG8_STA
#undef PG8_GA
}
}

#define EPI_ROW(u, ai, m) ((u).pm * 256 + (ai) * 128 + wr * 64 + (m) * 16 + fr)
__device__ __forceinline__ h8 pack8(f32x4 a, f32x4 b) { h8 o; o[0] = (f16)a[0]; o[1] = (f16)a[1]; o[2] = (f16)a[2]; o[3] = (f16)a[3]; o[4] = (f16)b[0]; o[5] = (f16)b[1]; o[6] = (f16)b[2]; o[7] = (f16)b[3]; return o; }
__device__ __forceinline__ void rope4(f32x4& v0, f32x4& v1, const f32x4 cs, const f32x4 sn) {
    const f32x4 a = v0, b = v1;
    v0[0] = a[0] * cs[0] - a[1] * sn[0]; v0[1] = a[1] * cs[0] + a[0] * sn[0];
    v0[2] = a[2] * cs[1] - a[3] * sn[1]; v0[3] = a[3] * cs[1] + a[2] * sn[1];
    v1[0] = b[0] * cs[2] - b[1] * sn[2]; v1[1] = b[1] * cs[2] + b[0] * sn[2];
    v1[2] = b[2] * cs[3] - b[3] * sn[3]; v1[3] = b[3] * cs[3] + b[2] * sn[3];
}
struct EpiLat {
    static constexpr bool PERM = true; f16* cq; f16* ckv; f16* Kp; float* pq; float* pkv; const float* cosm; const float* sinm;
    __device__ __forceinline__ void operator()(const f32x4 (&acc)[2][2][4][2], const pg8::Unit& u, int wr, int wc, int fr, int fq) const {
#pragma unroll
        for (int ai = 0; ai < 2; ++ai)
#pragma unroll
            for (int m = 0; m < 4; ++m) { const int t = EPI_ROW(u, ai, m); float sq = 0.f, sk = 0.f;
#pragma unroll
                for (int bj = 0; bj < 2; ++bj) { const int c8 = u.pn * 256 + bj * 128 + wc * 32 + 8 * fq; const int ht = u.pn * 2 + bj;
                    f32x4 v0 = acc[ai][bj][m][0], v1 = acc[ai][bj][m][1];
                    const float ss = (v0[0] * v0[0] + v0[1] * v0[1]) + (v0[2] * v0[2] + v0[3] * v0[3]) + (v1[0] * v1[0] + v1[1] * v1[1]) + (v1[2] * v1[2] + v1[3] * v1[3]);
                    if (ht < 3) { sq += ss; *(h8*)(cq + (size_t)t * 384 + c8) = pack8(v0, v1); }
                    else if (ht < 5) { sk += ss; *(h8*)(ckv + (size_t)t * 256 + (c8 - 384)) = pack8(v0, v1); }
                    else if (c8 < 704) { const int jj = c8 - 640, i0 = jj >> 1;
                        const f32x4 cs = *(const f32x4*)(cosm + (size_t)t * 32 + i0), sn = *(const f32x4*)(sinm + (size_t)t * 32 + i0); rope4(v0, v1, cs, sn);
                        const h8 o = pack8(v0, v1);
#pragma unroll
                        for (int h = 0; h < 8; ++h) *(h8*)(Kp + (size_t)t * 1536 + h * 192 + 128 + jj) = o; } }
                sq += __shfl_xor(sq, 16); sq += __shfl_xor(sq, 32); sk += __shfl_xor(sk, 16); sk += __shfl_xor(sk, 32);
                if (fq == 0) { if (u.pn < 2) pq[(size_t)t * 8 + u.pn * 4 + wc] = sq; if (u.pn >= 1) pkv[(size_t)t * 8 + (u.pn - 1) * 4 + wc] = sk; }
                asm volatile("" ::: "memory"); }
    }
};
__device__ __forceinline__ float row_rms_scale(const float* part, int t, float inv_n, float eps) {
    const f32x4 a = *(const f32x4*)(part + (size_t)t * 8), b = *(const f32x4*)(part + (size_t)t * 8 + 4);
    const float s = ((a[0] + a[1]) + (a[2] + a[3])) + ((b[0] + b[1]) + (b[2] + b[3]));
    return 1.0f / sqrtf(s * inv_n + eps);
}
struct EpiQNope {
    static constexpr bool PERM = true; f16* Q; const float* pq;
    __device__ __forceinline__ void operator()(const f32x4 (&acc)[2][2][4][2], const pg8::Unit& u, int wr, int wc, int fr, int fq) const {
#pragma unroll
        for (int ai = 0; ai < 2; ++ai)
#pragma unroll
            for (int m = 0; m < 4; ++m) { const int t = EPI_ROW(u, ai, m); const float rs = row_rms_scale(pq, t, 1.0f / 384.0f, LAT_EPS);
#pragma unroll
                for (int bj = 0; bj < 2; ++bj) { const int c8 = u.pn * 256 + bj * 128 + wc * 32 + 8 * fq;
                    *(h8*)(Q + (size_t)t * 1536 + (c8 >> 7) * 192 + (c8 & 127)) = pack8(acc[ai][bj][m][0] * rs, acc[ai][bj][m][1] * rs); }
                asm volatile("" ::: "memory"); }
    }
};
struct EpiQRope {
    static constexpr bool PERM = true; f16* Q; const float* cosm; const float* sinm; const float* pq;
    __device__ __forceinline__ void operator()(const f32x4 (&acc)[2][2][4][2], const pg8::Unit& u, int wr, int wc, int fr, int fq) const {
#pragma unroll
        for (int ai = 0; ai < 2; ++ai)
#pragma unroll
            for (int m = 0; m < 4; ++m) { const int t = EPI_ROW(u, ai, m); const float rs = row_rms_scale(pq, t, 1.0f / 384.0f, LAT_EPS);
#pragma unroll
                for (int bj = 0; bj < 2; ++bj) { const int cc = u.pn * 256 + bj * 128 + wc * 32 + 8 * fq; const int h = cc >> 6, jj = cc & 63, i0 = jj >> 1;
                    f32x4 v0 = acc[ai][bj][m][0] * rs, v1 = acc[ai][bj][m][1] * rs;
                    const f32x4 cs = *(const f32x4*)(cosm + (size_t)t * 32 + i0), sn = *(const f32x4*)(sinm + (size_t)t * 32 + i0); rope4(v0, v1, cs, sn);
                    *(h8*)(Q + (size_t)t * 1536 + h * 192 + 128 + jj) = pack8(v0, v1); }
                asm volatile("" ::: "memory"); }
    }
};
struct EpiKV {
    static constexpr bool PERM = true; f16* Kp; f16* Vp; const float* pkv;
    __device__ __forceinline__ void operator()(const f32x4 (&acc)[2][2][4][2], const pg8::Unit& u, int wr, int wc, int fr, int fq) const {
#pragma unroll
        for (int ai = 0; ai < 2; ++ai)
#pragma unroll
            for (int m = 0; m < 4; ++m) { const int t = EPI_ROW(u, ai, m); const float rs = row_rms_scale(pkv, t, 1.0f / 256.0f, LAT_EPS);
#pragma unroll
                for (int bj = 0; bj < 2; ++bj) { const int c8 = u.pn * 256 + bj * 128 + wc * 32 + 8 * fq; const int h = c8 >> 8, j = c8 & 255;
                    f16* dst = (j < 128) ? (Kp + (size_t)t * 1536 + h * 192 + j) : (Vp + (size_t)t * 1024 + h * 128 + (j - 128));
                    *(h8*)dst = pack8(acc[ai][bj][m][0] * rs, acc[ai][bj][m][1] * rs); }
                asm volatile("" ::: "memory"); }
    }
};
template <bool XF16> struct EpiPre {
    static constexpr bool PERM = true; const void* xres; const float* gmod; f16* pre;
    __device__ __forceinline__ void operator()(const f32x4 (&acc)[2][2][4][2], const pg8::Unit& u, int wr, int wc, int fr, int fq) const {
#pragma unroll
        for (int ai = 0; ai < 2; ++ai)
#pragma unroll
            for (int m = 0; m < 4; ++m) { const int t = EPI_ROW(u, ai, m); const int b = t >> 12;
#pragma unroll
                for (int bj = 0; bj < 2; ++bj) { const int c8 = u.pn * 256 + bj * 128 + wc * 32 + 8 * fq;
                    const f32x4 g0 = *(const f32x4*)(gmod + b * 6144 + c8), g1 = *(const f32x4*)(gmod + b * 6144 + c8 + 4); f32x4 x0, x1;
                    if constexpr (XF16) { const h8 xv = *(const h8*)((const f16*)xres + (size_t)t * 1024 + c8);
                        x0 = (f32x4){(float)xv[0], (float)xv[1], (float)xv[2], (float)xv[3]}; x1 = (f32x4){(float)xv[4], (float)xv[5], (float)xv[6], (float)xv[7]}; }
                    else { x0 = *(const f32x4*)((const float*)xres + (size_t)t * 1024 + c8); x1 = *(const f32x4*)((const float*)xres + (size_t)t * 1024 + c8 + 4); }
                    *(h8*)(pre + (size_t)t * 1024 + c8) = pack8(x0 * ALPHA + (g0 + 1.0f) * acc[ai][bj][m][0], x1 * ALPHA + (g1 + 1.0f) * acc[ai][bj][m][1]); }
                asm volatile("" ::: "memory"); }
    }
};
struct EpiUp {
    static constexpr bool PERM = true; f16* act;
    __device__ __forceinline__ void operator()(const f32x4 (&acc)[2][2][4][2], const pg8::Unit& u, int wr, int wc, int fr, int fq) const {
#pragma unroll
        for (int ai = 0; ai < 2; ++ai)
#pragma unroll
            for (int m = 0; m < 4; ++m) { const int r = EPI_ROW(u, ai, m);
#pragma unroll
                for (int bj = 0; bj < 2; ++bj) { const int c8 = u.pn * 256 + bj * 128 + wc * 32 + 8 * fq;
                    const f32x4 gq = acc[ai][bj][m][0], uq = acc[ai][bj][m][1]; h4 o;
#pragma unroll
                    for (int i = 0; i < 4; ++i) { const float gg = gq[i]; o[i] = (f16)(gg * __builtin_amdgcn_rcpf(1.0f + __expf(-gg)) * uq[i]); }
                    *(h4*)(act + (size_t)r * 2048 + (c8 >> 1)) = o; } }
    }
};
struct EpiDown {
    static constexpr bool PERM = true; f16* y; const float* gate;
    __device__ __forceinline__ void operator()(const f32x4 (&acc)[2][2][4][2], const pg8::Unit& u, int wr, int wc, int fr, int fq) const {
#pragma unroll
        for (int ai = 0; ai < 2; ++ai)
#pragma unroll
            for (int m = 0; m < 4; ++m) { const int r = EPI_ROW(u, ai, m); const float gt = gate[r];
#pragma unroll
                for (int bj = 0; bj < 2; ++bj) { const int c8 = u.pn * 256 + bj * 128 + wc * 32 + 8 * fq;
                    *(h8*)(y + (size_t)r * 1024 + c8) = pack8(acc[ai][bj][m][0] * gt, acc[ai][bj][m][1] * gt); }
                asm volatile("" ::: "memory"); }
    }
};
struct EpiDiffIn {
    static constexpr bool PERM = true; f16* qkv; const float* cosd; const float* sind;
    __device__ __forceinline__ void operator()(const f32x4 (&acc)[2][2][4][2], const pg8::Unit& u, int wr, int wc, int fr, int fq) const {
#pragma unroll
        for (int ai = 0; ai < 2; ++ai)
#pragma unroll
            for (int m = 0; m < 4; ++m) { const int t = EPI_ROW(u, ai, m);
#pragma unroll
                for (int bj = 0; bj < 2; ++bj) { const int c8 = u.pn * 256 + bj * 128 + wc * 32 + 8 * fq;
                    f32x4 v0 = acc[ai][bj][m][0], v1 = acc[ai][bj][m][1];
                    if (c8 < 2048 && (c8 & 63) < 16) { const int i0 = (c8 & 15) >> 1; const f32x4 cs = *(const f32x4*)(cosd + (size_t)t * 8 + i0), sn = *(const f32x4*)(sind + (size_t)t * 8 + i0); rope4(v0, v1, cs, sn); }
                    *(h8*)(qkv + (size_t)t * 3072 + c8) = pack8(v0, v1); }
                asm volatile("" ::: "memory"); }
    }
};

namespace att {
constexpr int QBLK = 32, KVBLK = 64, DV = 128;
constexpr float THR = 8.f;
constexpr size_t SHM_V = KVBLK * DV * 2;
#define SBAR() __builtin_amdgcn_sched_barrier(0)
__device__ __forceinline__ int crow(int r, int hi) { return (r & 3) + 8 * (r >> 2) + 4 * hi; }
__device__ __forceinline__ unsigned cvtpk(float lo, float hi) { unsigned r; asm volatile("v_cvt_pk_f16_f32 %0, %1, %2" : "=v"(r) : "v"(lo), "v"(hi)); return r; }
template <int DQK> struct Cfg {
    static constexpr int ND0 = DQK / 16, KRB = DQK * 2, NKCH = DQK / 64, KCPR = DQK / 8;
    static constexpr size_t SHM_K = (size_t)KVBLK * KRB;
    static constexpr float SCALE = DQK == 192 ? 0.07216878364870322f : 0.125f;
    static constexpr size_t SHM_TOTAL = 2 * SHM_V + 2 * SHM_K + NWAVES * 64 * 4;
};
template <int DQK> __device__ __forceinline__ void partialSM(f32x16& p0, f32x16& p1, float& m_reg, float& mn, float& alpha) {
    constexpr float SCALE = Cfg<DQK>::SCALE, C = SCALE * 1.4426950408889634f;
    float pmax = p0[0];
#pragma unroll
    for (int r = 1; r < 16; ++r) pmax = fmaxf(pmax, p0[r]);
#pragma unroll
    for (int r = 0; r < 16; ++r) pmax = fmaxf(pmax, p1[r]);
    { auto rr = __builtin_amdgcn_permlane32_swap(__float_as_uint(pmax), __float_as_uint(pmax), false, false);
      pmax = fmaxf(__uint_as_float(rr[0]), __uint_as_float(rr[1])); }
    if (__builtin_expect(__all(pmax - m_reg <= THR / SCALE), 1)) { mn = m_reg; alpha = 1.f; }
    else { mn = fmaxf(m_reg, pmax); alpha = __builtin_amdgcn_exp2f((m_reg - mn) * C); m_reg = mn; }
    const float mnC = -mn * C;
#pragma unroll
    for (int r = 0; r < 16; ++r) p0[r] = fmaf(p0[r], C, mnC);
#pragma unroll
    for (int r = 0; r < 16; ++r) p1[r] = fmaf(p1[r], C, mnC);
#pragma unroll
    for (int r = 0; r < 16; ++r) p0[r] = __builtin_amdgcn_exp2f(p0[r]);
}
__device__ __forceinline__ void finishSM(f32x16& p0, f32x16& p1, float alpha, float& l_reg, h8& pa0, h8& pa1, h8& pa2, h8& pa3) {
#pragma unroll
    for (int r = 0; r < 16; ++r) p1[r] = __builtin_amdgcn_exp2f(p1[r]);
    float ps = 0;
#pragma unroll
    for (int r = 0; r < 16; ++r) ps += p0[r];
#pragma unroll
    for (int r = 0; r < 16; ++r) ps += p1[r];
    { auto rr = __builtin_amdgcn_permlane32_swap(__float_as_uint(ps), __float_as_uint(ps), false, false);
      ps = __uint_as_float(rr[0]) + __uint_as_float(rr[1]); }
    l_reg = l_reg * alpha + ps;
#define PK4(P, BASE, OUT) do { unsigned a0 = cvtpk(P[BASE + 0], P[BASE + 1]), a1 = cvtpk(P[BASE + 2], P[BASE + 3]);   \
    unsigned b0 = cvtpk(P[BASE + 4], P[BASE + 5]), b1 = cvtpk(P[BASE + 6], P[BASE + 7]);                              \
    auto r0 = __builtin_amdgcn_permlane32_swap(a0, b0, false, false); auto r1 = __builtin_amdgcn_permlane32_swap(a1, b1, false, false); \
    u32x4 w = {r0[0], r1[0], r0[1], r1[1]}; OUT = *reinterpret_cast<h8*>(&w); } while (0)
    PK4(p0, 0, pa0); PK4(p0, 8, pa1); PK4(p1, 0, pa2); PK4(p1, 8, pa3);
#undef PK4
}
#define KSWZ(row, colB) ((row) * KRB + ((colB) ^ (((row) & 7) << 4)))
template <int DQK> __device__ __forceinline__ void qkt(f32x16& p0, f32x16& p1, const char* Ks, const h8* qr, int r32, int hi) {
    constexpr int KRB = Cfg<DQK>::KRB;
    p0 = f32x16{}; p1 = f32x16{};
#pragma unroll
    for (int d0 = 0; d0 < Cfg<DQK>::ND0; ++d0) { const int cb = (d0 * 16 + hi * 8) * 2;
        const h8 b0 = *reinterpret_cast<const h8*>(Ks + KSWZ(r32, cb));
        const h8 b1 = *reinterpret_cast<const h8*>(Ks + KSWZ(32 + r32, cb));
        p0 = __builtin_amdgcn_mfma_f32_32x32x16_f16(b0, qr[d0], p0, 0, 0, 0);
        p1 = __builtin_amdgcn_mfma_f32_32x32x16_f16(b1, qr[d0], p1, 0, 0, 0); }
}
__device__ __forceinline__ int v_st(int k, int c) { const int kk = (k & ~0xC) | ((k & 4) << 1) | ((k & 8) >> 1); return ((kk >> 3) * 4 + (c >> 5)) * 512 + ((kk & 7) * 32 + (c & 31)) * 2; }
__device__ __forceinline__ int v_rd_base(int lane) { return ((lane & 3) << 3) | (((lane >> 2) & 3) << 6) | (((lane >> 4) & 1) << 5) | (((lane >> 5) & 1) << 8); }
constexpr int v_rd_off(int d0, int ks, int half) { return d0 * 512 + ks * 4096 + half * 2048; }
template <int OFF> __device__ __forceinline__ s16x4 tr_read(int vb) {
    s16x4 r; asm volatile("ds_read_b64_tr_b16 %0, %1 offset:%2" : "=&v"(r) : "v"(vb), "i"(OFF) : "memory"); return r;
}
template <int D0> __device__ __forceinline__ void pv_one(f32x16& od, int vb, h8 pa0, h8 pa1, h8 pa2, h8 pa3) {
    const s16x4 l0 = tr_read<v_rd_off(D0, 0, 0)>(vb), h0 = tr_read<v_rd_off(D0, 0, 1)>(vb), l1 = tr_read<v_rd_off(D0, 1, 0)>(vb), h1 = tr_read<v_rd_off(D0, 1, 1)>(vb);
    const s16x4 l2 = tr_read<v_rd_off(D0, 2, 0)>(vb), h2_ = tr_read<v_rd_off(D0, 2, 1)>(vb), l3 = tr_read<v_rd_off(D0, 3, 0)>(vb), h3 = tr_read<v_rd_off(D0, 3, 1)>(vb);
    asm volatile("s_waitcnt lgkmcnt(0)" ::: "memory"); SBAR();
#define PKV(L, H) __builtin_bit_cast(h8, (__attribute__((ext_vector_type(8))) short){L[0], L[1], L[2], L[3], H[0], H[1], H[2], H[3]})
    od = __builtin_amdgcn_mfma_f32_32x32x16_f16(pa0, PKV(l0, h0), od, 0, 0, 0);
    od = __builtin_amdgcn_mfma_f32_32x32x16_f16(pa1, PKV(l1, h1), od, 0, 0, 0);
    od = __builtin_amdgcn_mfma_f32_32x32x16_f16(pa2, PKV(l2, h2_), od, 0, 0, 0);
    od = __builtin_amdgcn_mfma_f32_32x32x16_f16(pa3, PKV(l3, h3), od, 0, 0, 0);
#undef PKV
}
__device__ __forceinline__ void pv_d0(f32x16* o, int vb, h8 pa0, h8 pa1, h8 pa2, h8 pa3) {
    pv_one<0>(o[0], vb, pa0, pa1, pa2, pa3); pv_one<1>(o[1], vb, pa0, pa1, pa2, pa3); pv_one<2>(o[2], vb, pa0, pa1, pa2, pa3); pv_one<3>(o[3], vb, pa0, pa1, pa2, pa3);
}
template <int LDO>
__device__ __forceinline__ void attn_epilogue(f32x16 (&o)[4], const float (&rli)[16], f16* Ow, int mode, float lam, const float* subln, int r32, int hi) {
    if (mode == 0) {
#pragma unroll
        for (int r = 0; r < 16; ++r) { const int orow = crow(r, hi);
#pragma unroll
            for (int d0 = 0; d0 < 4; ++d0) Ow[(long)orow * LDO + d0 * 32 + r32] = (f16)(o[d0][r] * rli[r]); }
    } else {
        float sl[4];
#pragma unroll
        for (int d0 = 0; d0 < 4; ++d0) sl[d0] = subln[d0 * 32 + r32] * (1.0f - LAMBDA_INIT);
        f16 t0[4][16];
#pragma unroll
        for (int r = 0; r < 16; ++r) { const int orow = crow(r, hi);
#pragma unroll
            for (int d0 = 0; d0 < 4; ++d0) t0[d0][r] = Ow[(long)orow * LDO + d0 * 32 + r32]; }
        asm volatile("s_waitcnt vmcnt(0)" ::: "memory");
#pragma unroll
        for (int r = 0; r < 16; ++r) { const int orow = crow(r, hi); float ss = 0.f;
#pragma unroll
            for (int d0 = 0; d0 < 4; ++d0) { const float x = (float)t0[d0][r] - lam * (o[d0][r] * rli[r]); o[d0][r] = x; ss += x * x; }
            ss += __shfl_xor(ss, 1); ss += __shfl_xor(ss, 2); ss += __shfl_xor(ss, 4); ss += __shfl_xor(ss, 8); ss += __shfl_xor(ss, 16);
            const float rs = 1.0f / sqrtf(ss * (1.0f / 128.0f) + LN_EPS);
#pragma unroll
            for (int d0 = 0; d0 < 4; ++d0) Ow[(long)orow * LDO + d0 * 32 + r32] = (f16)(o[d0][r] * rs * sl[d0]); }
    }
}
template <int DQK, int LDQ, int LDK, int LDV, int LDO, int SDEPTH>
__device__ __forceinline__ void attn_body(const f16* Qb, const f16* Kh, const f16* Vh, f16* Ob, char* lds, int mode = 0, float lam = 0.f, const float* subln = nullptr) {
    using C = Cfg<DQK>;
    constexpr int KRB = C::KRB, ND0 = C::ND0, NKCH = C::NKCH, KCPR = C::KCPR; constexpr size_t SHM_K = C::SHM_K;
    constexpr int seq = SEQ;
    int tid = threadIdx.x; asm volatile("" : "+v"(tid));
    const int wid = tid >> 6, lane = tid & 63, r32 = lane & 31, hi = lane >> 5;
    char* V_lds = lds; char* K_lds = lds + 2 * SHM_V;
    float* wsl = (float*)(lds + 2 * SHM_V + 2 * SHM_K) + wid * 64; float* li_l = wsl; float* al_l = wsl + 32;
    float m_reg = -1e30f, l_reg = 0; f32x16 o[4] = {}; h8 qr[ND0];
    const f16* Qw = Qb + (long)(wid * QBLK + r32) * LDQ + hi * 8;
#pragma unroll
    for (int d0 = 0; d0 < ND0; ++d0) qr[d0] = *reinterpret_cast<const h8*>(Qw + d0 * 16);
    const int sr = tid >> 4, sc = (tid & 15) * 8, vst0 = v_st(sr, sc), vst1 = v_st(32 + sr, sc);
    int krow[NKCH], kcb[NKCH];
#pragma unroll
    for (int i = 0; i < NKCH; ++i) { const int c = tid + i * 512; krow[i] = c / KCPR; kcb[i] = (c % KCPR) * 16; }
    const int vb0 = (int)(uintptr_t)V_lds + v_rd_base(lane);
    struct { h8 vs0, vs1; h8 ks[NKCH]; } sr_[SDEPTH];
#define SLOAD(i, k0) do { sr_[i].vs0 = *reinterpret_cast<const h8*>(&Vh[(long)((k0) + sr) * LDV + sc]); sr_[i].vs1 = *reinterpret_cast<const h8*>(&Vh[(long)((k0) + 32 + sr) * LDV + sc]); \
    _Pragma("unroll") for (int _c = 0; _c < NKCH; ++_c) sr_[i].ks[_c] = *reinterpret_cast<const h8*>((const char*)Kh + (long)((k0) + krow[_c]) * (LDK * 2) + kcb[_c]); } while (0)
#define SWRITE(b, i) do { *(h8*)(V_lds + (b) * SHM_V + vst0) = sr_[i].vs0; *(h8*)(V_lds + (b) * SHM_V + vst1) = sr_[i].vs1; \
    _Pragma("unroll") for (int _c = 0; _c < NKCH; ++_c) *(h8*)(K_lds + (b) * SHM_K + KSWZ(krow[_c], kcb[_c])) = sr_[i].ks[_c]; } while (0)
#define SWAIT() do { if constexpr (SDEPTH == 2) { if constexpr (NKCH == 3) asm volatile("s_waitcnt vmcnt(5)" ::: "memory"); else asm volatile("s_waitcnt vmcnt(3)" ::: "memory"); } \
    else asm volatile("s_waitcnt vmcnt(0)" ::: "memory"); } while (0)
#define RESC(a) do { if (__any((a) < 1.f)) { if (hi == 0) al_l[r32] = (a); asm volatile("s_waitcnt lgkmcnt(0)" ::: "memory"); \
    _Pragma("unroll") for (int d = 0; d < 4; ++d) _Pragma("unroll") for (int r = 0; r < 16; ++r) o[d][r] *= al_l[crow(r, hi)]; } } while (0)
    f32x16 pA0, pA1, pB0, pB1; float mnA, mnB, alA, alB; h8 pa0, pa1, pa2, pa3; constexpr int NT = seq / KVBLK;
    constexpr int SE = 0, SO = SDEPTH - 1;
    SLOAD(SE, 0); asm volatile("s_waitcnt vmcnt(0)" ::: "memory"); SWRITE(0, SE); __syncthreads();
    qkt<DQK>(pA0, pA1, K_lds, qr, r32, hi); partialSM<DQK>(pA0, pA1, m_reg, mnA, alA);
    SLOAD(SO, KVBLK); if constexpr (SDEPTH == 2) { if (2 < NT) SLOAD(SE, 2 * KVBLK); }
    SWAIT(); SWRITE(1, SO); __syncthreads();
    for (int j = 1; j + 1 < NT; j += 2) {
        SBAR(); qkt<DQK>(pB0, pB1, K_lds + SHM_K, qr, r32, hi);
        finishSM(pA0, pA1, alA, l_reg, pa0, pa1, pa2, pa3); SBAR();
        SLOAD(SO, (j + SDEPTH) * KVBLK); SBAR();
        pv_d0(o, vb0, pa0, pa1, pa2, pa3); partialSM<DQK>(pB0, pB1, m_reg, mnB, alB);
        __syncthreads(); SWAIT(); SWRITE(0, SE);
        RESC(alB); __syncthreads();
        SBAR(); qkt<DQK>(pA0, pA1, K_lds, qr, r32, hi);
        finishSM(pB0, pB1, alB, l_reg, pa0, pa1, pa2, pa3); SBAR();
        if (SDEPTH == 1 || j + 3 < NT) SLOAD(SE, (j + 1 + SDEPTH) * KVBLK); SBAR();
        pv_d0(o, vb0 + (int)SHM_V, pa0, pa1, pa2, pa3); partialSM<DQK>(pA0, pA1, m_reg, mnA, alA);
        __syncthreads(); SWAIT(); SWRITE(1, SO);
        RESC(alA); __syncthreads();
    }
    SBAR(); qkt<DQK>(pB0, pB1, K_lds + SHM_K, qr, r32, hi);
    finishSM(pA0, pA1, alA, l_reg, pa0, pa1, pa2, pa3); SBAR();
    pv_d0(o, vb0, pa0, pa1, pa2, pa3); partialSM<DQK>(pB0, pB1, m_reg, mnB, alB);
    __syncthreads(); RESC(alB);
    finishSM(pB0, pB1, alB, l_reg, pa0, pa1, pa2, pa3); SBAR();
    pv_d0(o, vb0 + (int)SHM_V, pa0, pa1, pa2, pa3);
    if (hi == 0) li_l[r32] = l_reg; asm volatile("s_waitcnt lgkmcnt(0)" ::: "memory");
    float rli[16];
#pragma unroll
    for (int r = 0; r < 16; ++r) rli[r] = __builtin_amdgcn_rcpf(li_l[crow(r, hi)]);
    attn_epilogue<LDO>(o, rli, Ob + (long)(wid * QBLK) * LDO, mode, lam, subln, r32, hi);
    asm volatile("s_waitcnt vmcnt(0) lgkmcnt(0)" ::: "memory");
    __syncthreads();
#undef SLOAD
#undef SWRITE
#undef SWAIT
#undef RESC
}

struct ConvStream {
    const float* win; const float* wout; f16* tin; f16* tout;
    int step, step_end, it, period;
    unsigned d[8]; f16* pend;
    char* acc; f16* dst0; int nacc;
};
constexpr int CONV_STEPS_IN = 16 * 64 * 128, CONV_STEPS_OUT = 16 * 16 * 256, CONV_STEPS = CONV_STEPS_IN + CONV_STEPS_OUT;
__device__ __forceinline__ void conv_drain(ConvStream& c, int lane) {
    if (c.nacc > 0) {
        asm volatile("s_waitcnt lgkmcnt(0)" ::: "memory");
        for (int q = 0; q < c.nacc; ++q) { const h8 v = *(const h8*)(c.acc + q * 1024 + lane * 16); *(h8*)(c.dst0 + q * 8) = v; }
        c.nacc = 0; }
}
__device__ __forceinline__ void conv_flush(ConvStream& c, int lane) {
    if (c.pend) { h8 o;
#pragma unroll
        for (int i = 0; i < 8; ++i) o[i] = (f16)__uint_as_float(c.d[i]);
        if (c.nacc == 0) c.dst0 = c.pend;
        *(h8*)(c.acc + c.nacc * 1024 + lane * 16) = o; ++c.nacc; c.pend = nullptr;
        if (c.nacc == 4) conv_drain(c, lane); }
}
__device__ __forceinline__ void conv_tick(ConvStream& c, int lane) {
    const bool go = ((c.it & (c.period - 1)) < 3) && (c.step < c.step_end); ++c.it;
    if (go) { const int s = c.step++;
        const float* src; f16* dst; int N;
        if (s < CONV_STEPS_IN) { const int strip = s >> 7, kb = s & 127, e = strip >> 6, n = (strip & 63) * 64 + lane; const int f = n & 2047, dr = (f >> 2) * 8 + (f & 3) + ((n >> 11) << 2);
            src = c.win + ((size_t)e * 1024 + kb * 8) * 4096 + n; dst = c.tin + ((size_t)e * 4096 + dr) * 1024 + kb * 8; N = 4096; }
        else { const int s2 = s - CONV_STEPS_IN; const int strip = s2 >> 8, kb = s2 & 255, e = strip >> 4, n = (strip & 15) * 64 + lane;
            src = c.wout + ((size_t)e * 2048 + kb * 8) * 1024 + n; dst = c.tout + ((size_t)e * 1024 + n) * 2048 + kb * 8; N = 1024; }
        if ((s & 3) == 0) conv_drain(c, lane);
#pragma unroll
        for (int i = 0; i < 8; ++i) c.d[i] = __float_as_uint(src[(size_t)i * N]);
        c.pend = dst; }
}
__device__ __forceinline__ void conv_init(ConvStream& cs, const float* win, const float* wout, f16* tin, f16* tout, int l, int gw, int NGW, int period, char* acc) {
    cs.acc = acc; cs.nacc = 0; cs.dst0 = nullptr;
    cs.win = win + (size_t)l * NE * 1024 * 4096; cs.wout = wout + (size_t)l * NE * 2048 * 1024; cs.tin = tin + (size_t)l * NE * 4096 * 1024; cs.tout = tout + (size_t)l * NE * 1024 * 2048;
    const int per = ((CONV_STEPS + NGW - 1) / NGW + 7) & ~7;
    cs.step = gw * per < CONV_STEPS ? gw * per : CONV_STEPS; cs.step_end = (gw + 1) * per < CONV_STEPS ? (gw + 1) * per : CONV_STEPS; cs.it = 0; cs.pend = nullptr; cs.period = period;
}
template <int DQK, int LDQ, int LDK, int LDV, int LDO, bool CONV = false>
__device__ __forceinline__ void attn_body_simple(const f16* Qb, const f16* Kh, const f16* Vh, f16* Ob, char* lds, int mode = 0, float lam = 0.f, const float* subln = nullptr, ConvStream* cs = nullptr) {
    using C = Cfg<DQK>;
    constexpr int KRB = C::KRB, ND0 = C::ND0, NKCH = C::NKCH, KCPR = C::KCPR; constexpr size_t SHM_K = C::SHM_K;
    int tid = threadIdx.x; asm volatile("" : "+v"(tid));
    const int wid = tid >> 6, lane = tid & 63, r32 = lane & 31, hi = lane >> 5;
    char* V_lds = lds; char* K_lds = lds + 2 * SHM_V;
    float* wsl = (float*)(lds + 2 * SHM_V + 2 * SHM_K) + wid * 64; float* li_l = wsl; float* al_l = wsl + 32;
    float m_reg = -1e30f, l_reg = 0; f32x16 o[4] = {}; h8 qr[ND0];
    const f16* Qw = Qb + (long)(wid * QBLK + r32) * LDQ + hi * 8;
#pragma unroll
    for (int d0 = 0; d0 < ND0; ++d0) qr[d0] = *reinterpret_cast<const h8*>(Qw + d0 * 16);
    const int sr = tid >> 4, sc = (tid & 15) * 8, vst0 = v_st(sr, sc), vst1 = v_st(32 + sr, sc);
    int krow[NKCH], kcb[NKCH];
#pragma unroll
    for (int i = 0; i < NKCH; ++i) { const int c = tid + i * 512; krow[i] = c / KCPR; kcb[i] = (c % KCPR) * 16; }
    const int vb0 = (int)(uintptr_t)V_lds + v_rd_base(lane);
    h8 vs0, vs1, ks[NKCH];
#define SLOAD1(k0) do { vs0 = *reinterpret_cast<const h8*>(&Vh[(long)((k0) + sr) * LDV + sc]); vs1 = *reinterpret_cast<const h8*>(&Vh[(long)((k0) + 32 + sr) * LDV + sc]); \
    _Pragma("unroll") for (int _c = 0; _c < NKCH; ++_c) ks[_c] = *reinterpret_cast<const h8*>((const char*)Kh + (long)((k0) + krow[_c]) * (LDK * 2) + kcb[_c]); } while (0)
#define SWRITE1(b) do { *(h8*)(V_lds + (b) * SHM_V + vst0) = vs0; *(h8*)(V_lds + (b) * SHM_V + vst1) = vs1; \
    _Pragma("unroll") for (int _c = 0; _c < NKCH; ++_c) *(h8*)(K_lds + (b) * SHM_K + KSWZ(krow[_c], kcb[_c])) = ks[_c]; } while (0)
    constexpr int NT = SEQ / KVBLK;
    SLOAD1(0); asm volatile("s_waitcnt vmcnt(0)" ::: "memory"); SWRITE1(0); __syncthreads();
#pragma unroll 1
    for (int j = 0; j < NT; ++j) {
        const int cb = j & 1;
        if constexpr (CONV) conv_tick(*cs, lane);
        if (j + 1 < NT) SLOAD1((j + 1) * KVBLK);
        SBAR();
        f32x16 p0, p1; float mn, al; h8 pa0, pa1, pa2, pa3;
        qkt<DQK>(p0, p1, K_lds + cb * SHM_K, qr, r32, hi);
        partialSM<DQK>(p0, p1, m_reg, mn, al);
        if (__any(al < 1.f)) { if (hi == 0) al_l[r32] = al; asm volatile("s_waitcnt lgkmcnt(0)" ::: "memory");
#pragma unroll
            for (int d = 0; d < 4; ++d)
#pragma unroll
                for (int r = 0; r < 16; ++r) o[d][r] *= al_l[crow(r, hi)]; }
        finishSM(p0, p1, al, l_reg, pa0, pa1, pa2, pa3); SBAR();
        pv_d0(o, vb0 + cb * (int)SHM_V, pa0, pa1, pa2, pa3);
        if (j + 1 < NT) { SWRITE1(cb ^ 1); }
        if constexpr (CONV) conv_flush(*cs, lane);
        __syncthreads();
    }
    if (hi == 0) li_l[r32] = l_reg; asm volatile("s_waitcnt lgkmcnt(0)" ::: "memory");
    float rli[16];
#pragma unroll
    for (int r = 0; r < 16; ++r) rli[r] = __builtin_amdgcn_rcpf(li_l[crow(r, hi)]);
    attn_epilogue<LDO>(o, rli, Ob + (long)(wid * QBLK) * LDO, mode, lam, subln, r32, hi);
    asm volatile("s_waitcnt vmcnt(0) lgkmcnt(0)" ::: "memory");
    __syncthreads();
#undef SLOAD1
#undef SWRITE1
}
#undef KSWZ
#undef SBAR
}

struct Args { const void* in[22]; float* out; unsigned char* ws; int ph_lo, ph_hi, li, pad; };
typedef const __attribute__((address_space(4))) Args* KArgs;
__device__ __forceinline__ KArgs kargs() { KArgs p = (KArgs)__builtin_amdgcn_kernarg_segment_ptr(); asm volatile("" : "+s"(p)); return p; }
struct Frame {
    LAS unsigned char* lds; char* ldsg;
    int tid, lane, wave, vcu, G;
    unsigned char* ws;
};
extern __shared__ __attribute__((aligned(16))) unsigned char g_lds[];
__device__ __forceinline__ Frame mkframe(KArgs a) {
    Frame F; int t = threadIdx.x; asm volatile("" : "+v"(t));
    F.lds = (LAS unsigned char*)g_lds; F.ldsg = (char*)g_lds;
    F.tid = t; F.lane = t & 63; F.wave = __builtin_amdgcn_readfirstlane(t >> 6);
    int g = gridDim.x, bx = blockIdx.x; asm volatile("" : "+s"(g), "+s"(bx));
    F.G = g; F.vcu = (g % 8 == 0) ? (bx % 8) * (g / 8) + bx / 8 : bx;
    F.ws = a->ws;
    return F;
}

__device__ __forceinline__ void sincos_d(double a, float& s, float& c) {
    const double k = __builtin_rint(a * 0.63661977236758134308);
    double r = __builtin_fma(-k, 1.57079632679489655800e+00, a); r = __builtin_fma(-k, 6.12323399573676603587e-17, r);
    const double r2 = r * r;
    double sp = -7.6471637318198164759e-13;
    sp = __builtin_fma(sp, r2, 1.6059043836821614599e-10);
    sp = __builtin_fma(sp, r2, -2.5052108385441718775e-08);
    sp = __builtin_fma(sp, r2, 2.7557319223985890653e-06);
    sp = __builtin_fma(sp, r2, -1.9841269841269841270e-04);
    sp = __builtin_fma(sp, r2, 8.3333333333333333333e-03);
    sp = __builtin_fma(sp, r2, -1.6666666666666666667e-01);
    const double sr = __builtin_fma(sp * r2, r, r);
    double cp = 4.7794773323873852974e-14;
    cp = __builtin_fma(cp, r2, -1.1470745597729724714e-11);
    cp = __builtin_fma(cp, r2, 2.0876756987868098979e-09);
    cp = __builtin_fma(cp, r2, -2.7557319223985890653e-07);
    cp = __builtin_fma(cp, r2, 2.4801587301587301587e-05);
    cp = __builtin_fma(cp, r2, -1.3888888888888888889e-03);
    cp = __builtin_fma(cp, r2, 4.1666666666666666667e-02);
    cp = __builtin_fma(cp, r2, -0.5);
    const double cr = __builtin_fma(cp, r2, 1.0);
    const int q = (int)((long long)k & 3);
    const double ss = (q & 1) ? cr : sr, cc = (q & 1) ? sr : cr;
    s = (float)((q & 2) ? -ss : ss); c = (float)(((q + 1) & 2) ? -cc : cc);
}
__device__ const double INV_M[32] = {
    1.0, 0.7498942093324559, 0.5623413251903491, 0.4216965034285822, 0.31622776601683794, 0.23713737056616552, 0.1778279410038923, 0.1333521432163324,
    0.1, 0.07498942093324558, 0.05623413251903491, 0.04216965034285822, 0.03162277660168379, 0.023713737056616554, 0.01778279410038923, 0.01333521432163324,
    0.01, 0.007498942093324559, 0.005623413251903491, 0.004216965034285822, 0.0031622776601683794, 0.0023713737056616554, 0.001778279410038923, 0.001333521432163324,
    0.001, 0.0007498942093324559, 0.0005623413251903491, 0.0004216965034285822, 0.00031622776601683794, 0.00023713737056616554, 0.0001778279410038923, 0.0001333521432163324 };
__device__ const double INV_D[8] = { 1.0, 0.19392274474868576, 0.03760603093086393, 0.007292664737217109, 0.001414213562373095, 0.0002742481756762073, 5.318295896944988e-05, 1.031338537721246e-05 };

template <class FD>
__device__ __forceinline__ void tr_item64(const float* W, int Nsrc, int K, f16* WT, FD dstrow, LAS float* scr, int kb, int cb, int lane, const float* kscale = nullptr) {
    const int k0 = 64 * kb, c0 = 64 * cb, r4 = lane >> 4, cq = (lane & 15) * 4;
    f32x4 v[16];
#pragma unroll
    for (int i = 0; i < 16; ++i) v[i] = *(const f32x4*)(W + (size_t)(k0 + 4 * i + r4) * Nsrc + c0 + cq);
    if (kscale) {
#pragma unroll
        for (int i = 0; i < 16; ++i) v[i] = v[i] * kscale[k0 + 4 * i + r4]; }
#pragma unroll
    for (int i = 0; i < 16; ++i) { const int k = 4 * i + r4, sw = (i >> 1) * 4;
#pragma unroll
        for (int w = 0; w < 4; ++w) scr[k * 64 + ((cq + w) ^ sw)] = v[i][w]; }
    LDS_WAIT(); asm volatile("" ::: "memory");
    const int c = lane & 7;
#pragma unroll
    for (int j = 0; j < 8; ++j) { const int col = (lane >> 3) + 8 * j; const int dr = dstrow(c0 + col); const LAS float* sp = scr + (8 * c) * 64 + (col ^ (c * 4));
        h8 o; o[0] = (f16)sp[0 * 64]; o[1] = (f16)sp[1 * 64]; o[2] = (f16)sp[2 * 64]; o[3] = (f16)sp[3 * 64]; o[4] = (f16)sp[4 * 64]; o[5] = (f16)sp[5 * 64]; o[6] = (f16)sp[6 * 64]; o[7] = (f16)sp[7 * 64];
        *(h8*)(WT + (size_t)dr * K + k0 + 8 * c) = o; }
    LDS_WAIT(); asm volatile("" ::: "memory");
}
struct RowId { __device__ __forceinline__ int operator()(int c) const { return c; } };
struct RowWin0 { __device__ __forceinline__ int operator()(int c) const { if (c < 640) return c; const int jj = c - 640; return 640 + 2 * (jj & 31) + (jj >> 5); } };
struct RowUq { __device__ __forceinline__ int operator()(int c) const { const int h = c / 192, j = c % 192; if (j < 128) return h * 128 + j; const int jj = j - 128; return 1024 + h * 64 + 2 * (jj & 31) + (jj >> 5); } };
struct RowDiff { __device__ __forceinline__ int operator()(int c) const { if (c >= 2048) return c; const int off = c & 63; if (off >= 16) return c; return (c & ~63) + 2 * (off & 7) + (off >> 3); } };
struct RowMoeIn { __device__ __forceinline__ int operator()(int c) const { const int f = c & 2047; return (f >> 2) * 8 + (f & 3) + ((c >> 11) << 2); } };

__device__ __forceinline__ void p0_prologue() {
    const KArgs a = kargs(); const Frame F = mkframe(a);
    const int tid = F.tid, lane = F.lane;
    {
        const float* cin = (const float*)a->in[1]; const float* ada_w = (const float*)a->in[3]; const float* ada_b = (const float*)a->in[4];
        float* mods = (float*)(F.ws + WS_MODS);
        LAS float* sc = (LAS float*)F.lds; LAS float* red = (LAS float*)(F.lds + 16384);
        for (int i = tid; i < 4096; i += NTHREADS) { const float v = cin[i]; sc[i] = v / (1.0f + __expf(-v)); }
        __syncthreads();
        for (int cb = blockIdx.x; cb < 256; cb += F.G) {
            const int f0 = cb * 48, l = f0 / 6144, e0 = f0 % 6144; const int g = tid / 12, cc = tid % 12;
            if (g < 40) { f32x4 a0 = {0.f, 0.f, 0.f, 0.f}, a1 = a0, a2 = a0, a3 = a0; const float* wp = ada_w + (size_t)l * 1024 * 6144 + e0 + 4 * cc;
                f32x4 w[26];
#pragma unroll
                for (int i = 0; i < 26; ++i) { const int d = g + 40 * i; w[i] = (d < 1024) ? *(const f32x4*)(wp + (size_t)d * 6144) : (f32x4){0.f, 0.f, 0.f, 0.f}; }
#pragma unroll
                for (int i = 0; i < 26; ++i) { const int d = (g + 40 * i) & 1023; a0 += w[i] * sc[d]; a1 += w[i] * sc[1024 + d]; a2 += w[i] * sc[2048 + d]; a3 += w[i] * sc[3072 + d]; }
                LAS f32x4* rp = (LAS f32x4*)red + (g * 12 + cc) * 4; rp[0] = a0; rp[1] = a1; rp[2] = a2; rp[3] = a3; }
            __syncthreads();
            if (tid < 192) { const int c2 = tid % 48, b = tid / 48; float s = 0.f;
#pragma unroll 8
                for (int gg = 0; gg < 40; ++gg) s += red[((gg * 12 + (c2 >> 2)) * 4 + b) * 4 + (c2 & 3)];
                mods[(size_t)(l * 4 + b) * 6144 + e0 + c2] = s + ada_b[l * 6144 + e0 + c2]; }
            __syncthreads();
        }
    }
    {
        const int* pos = (const int*)a->in[2];
        float* cosm = (float*)(F.ws + WS_COSM); float* sinm = (float*)(F.ws + WS_SINM); float* cosd = (float*)(F.ws + WS_COSD); float* sind = (float*)(F.ws + WS_SIND);
        for (int i = blockIdx.x * NTHREADS + tid; i < T * 40; i += F.G * NTHREADS) {
            const int t = i / 40, j = i % 40; const double p = (double)pos[t]; float s, c;
            if (j < 32) { sincos_d(p * INV_M[j], s, c); cosm[(size_t)t * 32 + j] = c; sinm[(size_t)t * 32 + j] = s; }
            else { sincos_d(p * INV_D[j - 32], s, c); cosd[(size_t)t * 8 + (j - 32)] = c; sind[(size_t)t * 8 + (j - 32)] = s; }
        }
    }
    {
        LAS float* scr = (LAS float*)(F.lds + F.wave * 16384);
        const int gw = F.vcu * NWAVES + F.wave, NGW = F.G * NWAVES;
        { f16* z = (f16*)(F.ws + WS_WIN0) + (size_t)704 * 1024; for (int i = blockIdx.x * NTHREADS + tid; i < 8192; i += F.G * NTHREADS) *(u32x4*)(z + (size_t)i * 8) = (u32x4){0u, 0u, 0u, 0u}; }
        __syncthreads();
        constexpr int I0 = 16 * 11, I1 = 6 * 24, I2 = 4 * 32, I3 = 16 * 16, I4 = 16 * 48, I5 = 16 * 16;
        constexpr int ISM = I0 + I1 + I2 + I3 + I4 + I5;
        constexpr int IMI = 16 * 64, IMO = 32 * 16;
        constexpr int NITEMS = ISM;
        for (int it = gw; it < NITEMS; it += NGW) {
            int r = it;
            if (r < I0) { tr_item64((const float*)a->in[9], 704, 1024, (f16*)(F.ws + WS_WIN0), RowWin0(), scr, r / 11, r % 11, lane); continue; } r -= I0;
            if (r < I1) { tr_item64((const float*)a->in[12], 1536, 384, (f16*)(F.ws + WS_WUQ), RowUq(), scr, r / 24, r % 24, lane, (const float*)a->in[10]); continue; } r -= I1;
            if (r < I2) { tr_item64((const float*)a->in[13], 2048, 256, (f16*)(F.ws + WS_WUKV), RowId(), scr, r / 32, r % 32, lane, (const float*)a->in[11]); continue; } r -= I2;
            if (r < I3) { tr_item64((const float*)a->in[14], 1024, 1024, (f16*)(F.ws + WS_WO0), RowId(), scr, r / 16, r % 16, lane); continue; } r -= I3;
            if (r < I4) { tr_item64((const float*)a->in[15], 3072, 1024, (f16*)(F.ws + WS_WIN1), RowDiff(), scr, r / 48, r % 48, lane); continue; } r -= I4;
            if (r < I5) { tr_item64((const float*)a->in[18], 1024, 1024, (f16*)(F.ws + WS_WO1), RowId(), scr, r / 16, r % 16, lane); continue; }
        }
    }
}

__device__ __forceinline__ void mod_rows_p1() {
    const KArgs a = kargs(); const Frame F = mkframe(a);
    const float* x = (const float*)a->in[0]; const float* mods_l = (const float*)(F.ws + WS_MODS); f16* out = (f16*)(F.ws + WS_HA);
    const int gw = F.vcu * NWAVES + F.wave, NGW = F.G * NWAVES, lane = F.lane;
    for (int m0 = gw; m0 < T; m0 += 2 * NGW) {
        f32x4 v[2][4];
#pragma unroll
        for (int u = 0; u < 2; ++u) { const int m = m0 + u * NGW; if (m < T) {
#pragma unroll
            for (int j = 0; j < 4; ++j) v[u][j] = *(const f32x4*)(x + (size_t)m * DM + 4 * lane + 256 * j); } }
#pragma unroll
        for (int u = 0; u < 2; ++u) { const int m = m0 + u * NGW; if (m < T) { const float* mb = mods_l + (m >> 12) * 6144;
#pragma unroll
            for (int j = 0; j < 4; ++j) { const int c = 4 * lane + 256 * j; const f32x4 sh = *(const f32x4*)(mb + c), sc = *(const f32x4*)(mb + 1024 + c);
                const f32x4 h = v[u][j] * (sc + 1.0f) + sh; h4 o; o[0] = (f16)h[0]; o[1] = (f16)h[1]; o[2] = (f16)h[2]; o[3] = (f16)h[3];
                *(h4*)(out + (size_t)m * DM + c) = o; } } }
    }
}

#define RCOL(lane, j) ((((j) >> 1) << 9) + 8 * (lane) + 4 * ((j) & 1))
__device__ __forceinline__ void h8_to_f4(const h8 v, f32x4& a, f32x4& b) { a = (f32x4){(float)v[0], (float)v[1], (float)v[2], (float)v[3]}; b = (f32x4){(float)v[4], (float)v[5], (float)v[6], (float)v[7]}; }
__device__ __forceinline__ void ln_router(int l) {
    const KArgs a = kargs(); const Frame F = mkframe(a);
    const float* lng = (const float*)a->in[5] + l * DM; const float* lnb = (const float*)a->in[6] + l * DM; const float* router_w = (const float*)a->in[19] + (size_t)l * DM * NE;
    const float* mods_l = (const float*)(F.ws + WS_MODS) + (size_t)l * 4 * 6144;
    const f16* pre = (const f16*)(F.ws + WS_PRE); float* stat = (float*)(F.ws + WS_STAT); f16* hB = (f16*)(F.ws + WS_HB); float* aff = (float*)(F.ws + WS_AFF);
    LAS float* rwT = (LAS float*)F.lds;
    for (int i = F.tid; i < 16384; i += NTHREADS) { const int d = i >> 4, e = i & 15; const int seg = d >> 9, w = d & 511; rwT[e * 1024 + seg * 512 + ((w >> 2) & 1) * 256 + (w >> 3) * 4 + (w & 3)] = router_w[i]; }
    __syncthreads();
    const int gw = F.vcu * NWAVES + F.wave, NGW = F.G * NWAVES, lane = F.lane;
    for (int m0 = gw; m0 < T; m0 += 2 * NGW) {
        h8 pv[2][2];
#pragma unroll
        for (int u = 0; u < 2; ++u) { const int m = (m0 + u * NGW < T) ? m0 + u * NGW : m0; pv[u][0] = *(const h8*)(pre + (size_t)m * DM + 8 * lane); pv[u][1] = *(const h8*)(pre + (size_t)m * DM + 512 + 8 * lane); }
#pragma unroll
        for (int u = 0; u < 2; ++u) { const int m = m0 + u * NGW; if (m < T) {
        const int b = m >> 12, s_ = m & 4095; const float* mb = mods_l + b * 6144;
        f32x4 v[4]; h8_to_f4(pv[u][0], v[0], v[1]); h8_to_f4(pv[u][1], v[2], v[3]); float s = 0.f;
#pragma unroll
        for (int j = 0; j < 4; ++j) s += (v[j][0] + v[j][1]) + (v[j][2] + v[j][3]);
        const float mean = wave_sum(s) * (1.f / DM); float s2 = 0.f;
#pragma unroll
        for (int j = 0; j < 4; ++j) { v[j] = v[j] - mean; s2 += (v[j][0] * v[j][0] + v[j][1] * v[j][1]) + (v[j][2] * v[j][2] + v[j][3] * v[j][3]); }
        const float rstd = 1.0f / sqrtf(wave_sum(s2) * (1.f / DM) + LN_EPS);
        if (lane == 0) { f32x2 st = {mean, rstd}; *(f32x2*)(stat + (size_t)m * 2) = st; }
        float lg[16];
#pragma unroll
        for (int e = 0; e < 16; ++e) lg[e] = 0.f;
        f32x4 hh[4];
#pragma unroll
        for (int j = 0; j < 4; ++j) { const int c = RCOL(lane, j);
            const f32x4 g = *(const f32x4*)(lng + c), bb = *(const f32x4*)(lnb + c), sh = *(const f32x4*)(mb + 3072 + c), sc = *(const f32x4*)(mb + 4096 + c);
            const f32x4 xn = v[j] * rstd * g + bb; const f32x4 h = xn * (sc + 1.0f) + sh; hh[j] = h;
#pragma unroll
            for (int e = 0; e < 16; ++e) { const f32x4 w = *(const LAS f32x4*)(rwT + e * 1024 + (j >> 1) * 512 + (j & 1) * 256 + lane * 4); lg[e] += (h[0] * w[0] + h[1] * w[1]) + (h[2] * w[2] + h[3] * w[3]); }
            asm volatile("" ::: "memory"); }
        *(h8*)(hB + (size_t)m * DM + 8 * lane) = pack8(hh[0], hh[1]); *(h8*)(hB + (size_t)m * DM + 512 + 8 * lane) = pack8(hh[2], hh[3]);
        float mx = -1e30f;
#pragma unroll
        for (int e = 0; e < 16; ++e) { lg[e] = wave_sum(lg[e]); mx = fmaxf(mx, lg[e]); }
        float den = 0.f;
#pragma unroll
        for (int e = 0; e < 16; ++e) { lg[e] = __expf(lg[e] - mx); den += lg[e]; }
        const float rden = 1.0f / den; float mine = 0.f;
#pragma unroll
        for (int e = 0; e < 16; ++e) mine = (lane == e) ? lg[e] * rden : mine;
        if (lane < 16) aff[(size_t)(b * 16 + lane) * SEQ + s_] = mine;
        } }
    }
    __syncthreads();
}

__device__ __forceinline__ int block_excl_scan(int v, LAS int* tmp, int tid, int& total) {
    const int lane = tid & 63, wid = tid >> 6; int x = v;
#pragma unroll
    for (int o = 1; o < 64; o <<= 1) { const int y = __shfl_up(x, o); if (lane >= o) x += y; }
    if (lane == 63) tmp[wid] = x;
    __syncthreads();
    int base = 0, tot = 0;
#pragma unroll
    for (int w = 0; w < 8; ++w) { const int t = tmp[w]; if (w < wid) base += t; tot += t; }
    __syncthreads();
    total = tot; return base + x - v;
}
__device__ __forceinline__ void topk_phase() {
    const KArgs a = kargs(); const Frame F = mkframe(a);
    const float* aff = (const float*)(F.ws + WS_AFF); float* gate = (float*)(F.ws + WS_GATE); int* rowtok = (int*)(F.ws + WS_ROWTOK); int* inv = (int*)(F.ws + WS_INV);
    LAS unsigned* hist = (LAS unsigned*)F.lds; LAS unsigned* selw = hist + 256; LAS int* tmp = (LAS int*)(hist + 272);
    const int tid = F.tid;
    for (int p = blockIdx.x; p < NB * NE; p += F.G) { const int b = p >> 4, e = p & 15;
        const float* ap = aff + (size_t)p * SEQ + 8 * tid; unsigned key[8];
        { const f32x4 a0 = *(const f32x4*)ap, a1 = *(const f32x4*)(ap + 4);
          key[0] = __float_as_uint(a0[0]); key[1] = __float_as_uint(a0[1]); key[2] = __float_as_uint(a0[2]); key[3] = __float_as_uint(a0[3]);
          key[4] = __float_as_uint(a1[0]); key[5] = __float_as_uint(a1[1]); key[6] = __float_as_uint(a1[2]); key[7] = __float_as_uint(a1[3]); }
        unsigned prefix = 0u, kk = CAP;
        for (int pass = 0; pass < 4; ++pass) { const int shift = 24 - 8 * pass;
            if (tid < 256) hist[tid] = 0u;
            __syncthreads();
#pragma unroll
            for (int j = 0; j < 8; ++j) { const bool match = (pass == 0) || ((key[j] >> (shift + 8)) == prefix); if (match) atomicAdd((unsigned*)&hist[(key[j] >> shift) & 255u], 1u); }
            __syncthreads();
            if (tid < 256) { unsigned S = 0u; for (int j = 0; j <= tid; ++j) S += hist[255 - j]; const unsigned Sp = S - hist[255 - tid];
                if (Sp < kk && kk <= S) { selw[0] = 255u - (unsigned)tid; selw[1] = kk - Sp; } }
            __syncthreads();
            prefix = (prefix << 8) | selw[0]; kk = selw[1];
            __syncthreads();
        }
        int ce = 0;
#pragma unroll
        for (int j = 0; j < 8; ++j) ce += (key[j] == prefix) ? 1 : 0;
        int tot; int eqr = block_excl_scan(ce, tmp, tid, tot);
        unsigned selm = 0u; int cs = 0;
#pragma unroll
        for (int j = 0; j < 8; ++j) { bool sel = key[j] > prefix; if (key[j] == prefix) { sel = (unsigned)eqr < kk; ++eqr; } if (sel) { selm |= 1u << j; ++cs; } }
        int slot = block_excl_scan(cs, tmp, tid, tot);
#pragma unroll
        for (int j = 0; j < 8; ++j) { const int s_ = 8 * tid + j; const int tok = b * SEQ + s_; const bool sel = (selm >> j) & 1u;
            if (sel) { const int row = e * EROWS + b * CAP + slot; rowtok[row] = tok; gate[row] = __uint_as_float(key[j]); inv[(size_t)tok * 16 + e] = slot; ++slot; }
            else inv[(size_t)tok * 16 + e] = -1; }
        __syncthreads();
    }
}
__device__ __forceinline__ void gather_rows() {
    const KArgs a = kargs(); const Frame F = mkframe(a);
    const int* rowtok = (const int*)(F.ws + WS_ROWTOK); const f16* hB = (const f16*)(F.ws + WS_HB); f16* xe = (f16*)(F.ws + WS_XE);
    const int gw = F.vcu * NWAVES + F.wave, NGW = F.G * NWAVES, lane = F.lane;
    for (int r0 = gw; r0 < MROWS; r0 += 4 * NGW) {
        int tok[4]; h8 d0[4], d1[4];
#pragma unroll
        for (int u = 0; u < 4; ++u) { const int r = r0 + u * NGW; tok[u] = (r < MROWS) ? rowtok[r] : 0; }
#pragma unroll
        for (int u = 0; u < 4; ++u) { d0[u] = *(const h8*)(hB + (size_t)tok[u] * DM + 8 * lane); d1[u] = *(const h8*)(hB + (size_t)tok[u] * DM + 512 + 8 * lane); }
#pragma unroll
        for (int u = 0; u < 4; ++u) { const int r = r0 + u * NGW; if (r < MROWS) { *(h8*)(xe + (size_t)r * DM + 8 * lane) = d0[u]; *(h8*)(xe + (size_t)r * DM + 512 + 8 * lane) = d1[u]; } }
    }
}
__device__ __forceinline__ void combine_ln(int l) {
    const KArgs a = kargs(); const Frame F = mkframe(a);
    const float* lng1 = (const float*)a->in[5] + l * DM; const float* lnb1 = (const float*)a->in[6] + l * DM;
    const float* lng = (const float*)a->in[7] + l * DM; const float* lnb = (const float*)a->in[8] + l * DM;
    const float* mods_l = (const float*)(F.ws + WS_MODS) + (size_t)l * 4 * 6144; const float* mods_next = (const float*)(F.ws + WS_MODS) + (size_t)4 * 6144;
    float* xo32 = a->out; f16* x2 = (f16*)(F.ws + WS_X2); f16* hA = (f16*)(F.ws + WS_HA);
    const f16* pre = (const f16*)(F.ws + WS_PRE); const float* stat = (const float*)(F.ws + WS_STAT); const f16* y = (const f16*)(F.ws + WS_Y); const int* inv = (const int*)(F.ws + WS_INV);
    const int gw = F.vcu * NWAVES + F.wave, NGW = F.G * NWAVES, lane = F.lane;
    for (int m0 = gw; m0 < T; m0 += 2 * NGW) {
        int myinv[2]; h8 pv[2][2]; f32x2 st[2];
#pragma unroll
        for (int u = 0; u < 2; ++u) { const int m = (m0 + u * NGW < T) ? m0 + u * NGW : m0; myinv[u] = inv[(size_t)m * 16 + (lane & 15)]; st[u] = *(const f32x2*)(stat + (size_t)m * 2);
            pv[u][0] = *(const h8*)(pre + (size_t)m * DM + 8 * lane); pv[u][1] = *(const h8*)(pre + (size_t)m * DM + 512 + 8 * lane); }
#pragma unroll
        for (int u = 0; u < 2; ++u) { const int m = m0 + u * NGW; if (m < T) {
        const int b = m >> 12; const float* mb = mods_l + b * 6144;
        f32x4 f[4];
#pragma unroll
        for (int j = 0; j < 4; ++j) f[j] = (f32x4){0.f, 0.f, 0.f, 0.f};
        unsigned mask = (unsigned)(__ballot(myinv[u] >= 0) & 0xFFFFull);
        while (mask) {
            const int e0 = __builtin_ctz(mask); mask &= mask - 1u; const bool two = mask != 0u; const int e1 = two ? __builtin_ctz(mask) : e0; mask &= mask - 1u;
            const int s0 = __shfl(myinv[u], e0), s1 = __shfl(myinv[u], e1);
            const f16* y0 = y + (size_t)(e0 * EROWS + b * CAP + s0) * DM; const f16* y1 = y + (size_t)(e1 * EROWS + b * CAP + s1) * DM;
            const h8 a00 = *(const h8*)(y0 + 8 * lane), a01 = *(const h8*)(y0 + 512 + 8 * lane), a10 = *(const h8*)(y1 + 8 * lane), a11 = *(const h8*)(y1 + 512 + 8 * lane);
            const float w1 = two ? 1.0f : 0.0f; f32x4 t0, t1;
            h8_to_f4(a00, t0, t1); f[0] += t0; f[1] += t1; h8_to_f4(a01, t0, t1); f[2] += t0; f[3] += t1;
            h8_to_f4(a10, t0, t1); f[0] += t0 * w1; f[1] += t1 * w1; h8_to_f4(a11, t0, t1); f[2] += t0 * w1; f[3] += t1 * w1;
        }
        f32x4 v[4]; h8_to_f4(pv[u][0], v[0], v[1]); h8_to_f4(pv[u][1], v[2], v[3]); float s = 0.f;
#pragma unroll
        for (int j = 0; j < 4; ++j) { const int c = RCOL(lane, j); const f32x4 g1 = *(const f32x4*)(lng1 + c), b1 = *(const f32x4*)(lnb1 + c), g2 = *(const f32x4*)(mb + 5120 + c);
            const f32x4 x1 = (v[j] - st[u][0]) * st[u][1] * g1 + b1;
            v[j] = x1 * ALPHA + (g2 + 1.0f) * f[j]; s += (v[j][0] + v[j][1]) + (v[j][2] + v[j][3]); }
        const float mean = wave_sum(s) * (1.f / DM); float s2 = 0.f;
#pragma unroll
        for (int j = 0; j < 4; ++j) { v[j] = v[j] - mean; s2 += (v[j][0] * v[j][0] + v[j][1] * v[j][1]) + (v[j][2] * v[j][2] + v[j][3] * v[j][3]); }
        const float rstd = 1.0f / sqrtf(wave_sum(s2) * (1.f / DM) + LN_EPS);
        f32x4 xn[4];
#pragma unroll
        for (int j = 0; j < 4; ++j) { const int c = RCOL(lane, j); const f32x4 g = *(const f32x4*)(lng + c), bb = *(const f32x4*)(lnb + c); xn[j] = v[j] * rstd * g + bb; }
        if (l == 0) {
            *(h8*)(x2 + (size_t)m * DM + 8 * lane) = pack8(xn[0], xn[1]); *(h8*)(x2 + (size_t)m * DM + 512 + 8 * lane) = pack8(xn[2], xn[3]);
            const float* mn = mods_next + b * 6144; f32x4 hv[4];
#pragma unroll
            for (int j = 0; j < 4; ++j) { const int c = RCOL(lane, j); const f32x4 sh = *(const f32x4*)(mn + c), sc = *(const f32x4*)(mn + 1024 + c); hv[j] = xn[j] * (sc + 1.0f) + sh; }
            *(h8*)(hA + (size_t)m * DM + 8 * lane) = pack8(hv[0], hv[1]); *(h8*)(hA + (size_t)m * DM + 512 + 8 * lane) = pack8(hv[2], hv[3]);
        } else {
#pragma unroll
            for (int j = 0; j < 4; ++j) *(f32x4*)(xo32 + (size_t)m * DM + RCOL(lane, j)) = xn[j];
        }
        } }
    }
}

__device__ __forceinline__ void attn_mla() {
    const KArgs a = kargs(); const Frame F = mkframe(a);
    const f16* Q = (const f16*)(F.ws + WS_Q); const f16* K = (const f16*)(F.ws + WS_K); const f16* V = (const f16*)(F.ws + WS_V); f16* O = (f16*)(F.ws + WS_O);
    att::ConvStream cs; att::conv_init(cs, (const float*)a->in[20], (const float*)a->in[21], (f16*)(F.ws + WS_MOEIN), (f16*)(F.ws + WS_MOEOUT), 0, F.vcu * NWAVES + F.wave, F.G * NWAVES, 4, F.ldsg + 83968 + F.wave * 4096);
    for (int u = F.vcu; u < NB * 8 * 16; u += F.G) { const int qb = u & 15, bh = u >> 4, h = bh & 7, b = bh >> 3;
        att::attn_body_simple<192, 1536, 1536, 1024, 1024, true>(Q + (size_t)(b * SEQ + qb * 256) * 1536 + h * 192, K + (size_t)(b * SEQ) * 1536 + h * 192, V + (size_t)(b * SEQ) * 1024 + h * 128,
                                                                 O + (size_t)(b * SEQ + qb * 256) * 1024 + h * 128, F.ldsg, 0, 0.f, nullptr, &cs); }
    while (cs.step < cs.step_end) { cs.it = 0; att::conv_tick(cs, F.lane); att::conv_flush(cs, F.lane); }
    att::conv_flush(cs, F.lane); att::conv_drain(cs, F.lane);
}
__device__ __forceinline__ void attn_diff() {
    const KArgs a = kargs(); const Frame F = mkframe(a);
    const f16* QKV = (const f16*)(F.ws + WS_QKV1); f16* O = (f16*)(F.ws + WS_O);
    const float* lamv = (const float*)a->in[16]; const float* subln = (const float*)a->in[17];
    const float l01 = wave_sum(lamv[F.lane] * lamv[64 + F.lane]), l23 = wave_sum(lamv[128 + F.lane] * lamv[192 + F.lane]);
    const float lam = expf(l01) - expf(l23) + LAMBDA_INIT;
    att::ConvStream cs; att::conv_init(cs, (const float*)a->in[20], (const float*)a->in[21], (f16*)(F.ws + WS_MOEIN), (f16*)(F.ws + WS_MOEOUT), 1, F.vcu * NWAVES + F.wave, F.G * NWAVES, 8, F.ldsg + 51200 + F.wave * 4096);
    for (int u = F.vcu; u < NB * 8 * 16; u += F.G) { const int qb = u & 15, bh = u >> 4, h = bh & 7, b = bh >> 3;
        f16* Ob = O + (size_t)(b * SEQ + qb * 256) * 1024 + h * 128; const f16* Vh = QKV + (size_t)(b * SEQ) * 3072 + 2048 + h * 128;
#pragma unroll 1
        for (int c = 0; c < 2; ++c) { const int hh = 2 * h + c;
            att::attn_body_simple<64, 3072, 3072, 3072, 1024, true>(QKV + (size_t)(b * SEQ + qb * 256) * 3072 + hh * 64, QKV + (size_t)(b * SEQ) * 3072 + 1024 + hh * 64, Vh, Ob, F.ldsg, c, lam, subln, &cs); } }
    cs.it = 0;
    while (cs.step < cs.step_end) { cs.it = 0; att::conv_tick(cs, F.lane); att::conv_flush(cs, F.lane); }
    att::conv_flush(cs, F.lane); att::conv_drain(cs, F.lane);
}

__device__ __forceinline__ void ph_gemm_lat() { const KArgs a = kargs(); const Frame F = mkframe(a);
    pg8::Gemm g{(const f16*)(F.ws + WS_HA), (const f16*)(F.ws + WS_WIN0), T, 768, 1024, 1 << 30, 0, nullptr}; pg8::StaticOrder S; S.init(T, 768, F.G, (int)blockIdx.x);
    EpiLat E{(f16*)(F.ws + WS_CQN), (f16*)(F.ws + WS_CKVN), (f16*)(F.ws + WS_K), (float*)(F.ws + WS_PQ), (float*)(F.ws + WS_PKV), (const float*)(F.ws + WS_COSM), (const float*)(F.ws + WS_SINM)}; pg8::gemm_phase<EpiLat>(F.lds, g, S, E); }
__device__ __forceinline__ void ph_gemm_q() { const KArgs a = kargs(); const Frame F = mkframe(a);
    pg8::Gemm g{(const f16*)(F.ws + WS_CQN), (const f16*)(F.ws + WS_WUQ), T, 1024, 384, 1 << 30, 0, nullptr}; pg8::StaticOrder S; S.init(T, 1024, F.G, (int)blockIdx.x);
    EpiQNope E{(f16*)(F.ws + WS_Q), (const float*)(F.ws + WS_PQ)}; pg8::gemm_phase<EpiQNope>(F.lds, g, S, E); }
__device__ __forceinline__ void ph_gemm_qr() { const KArgs a = kargs(); const Frame F = mkframe(a);
    pg8::Gemm g{(const f16*)(F.ws + WS_CQN), (const f16*)(F.ws + WS_WUQ) + (size_t)1024 * 384, T, 512, 384, 1 << 30, 0, nullptr}; pg8::StaticOrder S; S.init(T, 512, F.G, (int)blockIdx.x);
    EpiQRope E{(f16*)(F.ws + WS_Q), (const float*)(F.ws + WS_COSM), (const float*)(F.ws + WS_SINM), (const float*)(F.ws + WS_PQ)}; pg8::gemm_phase<EpiQRope>(F.lds, g, S, E); }
__device__ __forceinline__ void ph_gemm_kv() { const KArgs a = kargs(); const Frame F = mkframe(a);
    pg8::Gemm g{(const f16*)(F.ws + WS_CKVN), (const f16*)(F.ws + WS_WUKV), T, 2048, 256, 1 << 30, 0, nullptr}; pg8::StaticOrder S; S.init(T, 2048, F.G, (int)blockIdx.x);
    EpiKV E{(f16*)(F.ws + WS_K), (f16*)(F.ws + WS_V), (const float*)(F.ws + WS_PKV)}; pg8::gemm_phase<EpiKV>(F.lds, g, S, E); }
__device__ __forceinline__ void ph_gemm_o(int l) { const KArgs a = kargs(); const Frame F = mkframe(a);
    pg8::Gemm g{(const f16*)(F.ws + WS_O), (const f16*)(F.ws + (l == 0 ? WS_WO0 : WS_WO1)), T, 1024, 1024, 1 << 30, 0, nullptr}; pg8::StaticOrder S; S.init(T, 1024, F.G, (int)blockIdx.x);
    const float* gm = (const float*)(F.ws + WS_MODS) + (size_t)l * 4 * 6144 + 2048;
    if (l == 0) { EpiPre<false> E{a->in[0], gm, (f16*)(F.ws + WS_PRE)}; pg8::gemm_phase<EpiPre<false>>(F.lds, g, S, E); }
    else { EpiPre<true> E{(const void*)(F.ws + WS_X2), gm, (f16*)(F.ws + WS_PRE)}; pg8::gemm_phase<EpiPre<true>>(F.lds, g, S, E); } }
__device__ __forceinline__ void ph_gemm_diffin() { const KArgs a = kargs(); const Frame F = mkframe(a);
    pg8::Gemm g{(const f16*)(F.ws + WS_HA), (const f16*)(F.ws + WS_WIN1), T, 3072, 1024, 1 << 30, 0, nullptr}; pg8::StaticOrder S; S.init(T, 3072, F.G, (int)blockIdx.x);
    EpiDiffIn E{(f16*)(F.ws + WS_QKV1), (const float*)(F.ws + WS_COSD), (const float*)(F.ws + WS_SIND)}; pg8::gemm_phase<EpiDiffIn>(F.lds, g, S, E); }
__device__ __forceinline__ void ph_gemm_up(int l) { const KArgs a = kargs(); const Frame F = mkframe(a);
    pg8::Gemm g{(const f16*)(F.ws + WS_HB), (const f16*)(F.ws + WS_MOEIN) + (size_t)l * NE * 4096 * 1024, MROWS, 4096, 1024, EROWS / 256, (size_t)4096 * 1024, (const int*)(F.ws + WS_ROWTOK)}; pg8::StaticOrder S; S.init(MROWS, 4096, F.G, (int)blockIdx.x);
    EpiUp E{(f16*)(F.ws + WS_ACT)}; pg8::gemm_phase<EpiUp, true, true, true>(F.lds, g, S, E); }
__device__ __forceinline__ void ph_gemm_down(int l) { const KArgs a = kargs(); const Frame F = mkframe(a);
    pg8::Gemm g{(const f16*)(F.ws + WS_ACT), (const f16*)(F.ws + WS_MOEOUT) + (size_t)l * NE * 1024 * 2048, MROWS, 1024, 2048, EROWS / 256, (size_t)1024 * 2048, nullptr}; pg8::StaticOrder S; S.init(MROWS, 1024, F.G, (int)blockIdx.x);
    EpiDown E{(f16*)(F.ws + WS_Y), (const float*)(F.ws + WS_GATE)}; pg8::gemm_phase<EpiDown>(F.lds, g, S, E); }

constexpr int NPHASES = 24;
__global__ void __launch_bounds__(NTHREADS, 2) mk_fwd(Args args) {
    LAS unsigned char* ldsp = (LAS unsigned char*)g_lds;
    volatile LAS unsigned* MISC = (volatile LAS unsigned*)(ldsp + MISC_OFF);
    for (int u = threadIdx.x; u < (LDS_BYTES - LDSCTL_OFF) / 4; u += NTHREADS) ((LAS unsigned*)(ldsp + LDSCTL_OFF))[u] = 0u;
    __syncthreads();
    XcdBarrier bar = xcd_barrier_post((unsigned*)(args.ws + WS_CTL) + CW_BAR + args.li * XCD_BAR_WORDS, MISC + 8);
    const int lo = args.ph_lo, hi = args.ph_hi;
#ifndef PH_MASK
#define PH_MASK 0xFFFFFFFFu
#endif
#define IN(k) (((PH_MASK >> (k)) & 1u) && lo <= (k) && (k) < hi)
#define SEAM(k) do { if (lo <= (k) && (k) + 1 < hi) xcd_barrier(bar); } while (0)
#ifndef REP_MASK
#define REP_MASK 0u
#endif
#define RUN(k, call) do { if (IN(k)) { call; if ((REP_MASK >> (k)) & 1u) { __syncthreads(); call; } } } while (0)
    RUN(0, p0_prologue());      SEAM(0);
    RUN(1, mod_rows_p1());      SEAM(1);
    RUN(2, ph_gemm_lat());      SEAM(2);
    RUN(4, ph_gemm_q()); RUN(4, ph_gemm_qr());
    RUN(5, ph_gemm_kv());       SEAM(5);
    RUN(6, attn_mla());         SEAM(6);
#pragma unroll 1
    for (int l = 0; l < 2; ++l) {
        const int pb = (l == 0) ? 7 : 17;
        if (l == 1) {
            RUN(14, ph_gemm_diffin()); SEAM(14);
            RUN(15, attn_diff());      SEAM(15);
        }
        RUN(pb + 0, ph_gemm_o(l));     SEAM(pb + 0);
        RUN(pb + 1, ln_router(l));     SEAM(pb + 1);
        RUN(pb + 2, topk_phase());     SEAM(pb + 2);
        RUN(pb + 4, ph_gemm_up(l));    SEAM(pb + 4);
        RUN(pb + 5, ph_gemm_down(l));  SEAM(pb + 5);
        RUN(pb + 6, combine_ln(l));
        if (l == 0) SEAM(pb + 6);
    }
#undef IN
#undef SEAM
}

extern "C" void kernel_launch(void* const* d_in, const int* in_sizes, int n_in, void* d_out, int out_size, void* d_ws, size_t ws_size, hipStream_t stream) {
    static int grid = 0;
    if (grid == 0) {
        if (n_in != 22 || in_sizes[0] != T * DM || out_size != T * DM || ws_size < WS_END) {
            fprintf(stderr, "kernel_launch: shape/workspace mismatch: n_in %d in0 %d out %d ws %zu (need %zu)\n", n_in, n_in > 0 ? in_sizes[0] : -1, out_size, ws_size, (size_t)WS_END); grid = -1; return; }
        int dev = 0, cus = 0, per_cu = 0;
        if (hipGetDevice(&dev) != hipSuccess || hipDeviceGetAttribute(&cus, hipDeviceAttributeMultiprocessorCount, dev) != hipSuccess) { fprintf(stderr, "kernel_launch: device query failed\n"); grid = -1; return; }
        if (hipFuncSetAttribute((const void*)mk_fwd, hipFuncAttributeMaxDynamicSharedMemorySize, LDS_BYTES) != hipSuccess) { fprintf(stderr, "kernel_launch: hipFuncSetAttribute failed\n"); grid = -1; return; }
        if (hipOccupancyMaxActiveBlocksPerMultiprocessor(&per_cu, (const void*)mk_fwd, NTHREADS, LDS_BYTES) != hipSuccess || per_cu < 1)
            fprintf(stderr, "kernel_launch: note: occupancy query reports %d workgroups per CU\n", per_cu);
        (void)hipGetLastError();
        grid = cus;
    }
    if (grid < 0) return;
    if (hipMemsetAsync((char*)d_ws + WS_CTL, 0, CTL_ZERO_BYTES, stream) != hipSuccess) { fprintf(stderr, "kernel_launch: memset failed\n"); return; }
    Args a{};
    for (int i = 0; i < 22; ++i) a.in[i] = d_in[i];
    a.out = (float*)d_out; a.ws = (unsigned char*)d_ws;
#if MK_CUTS == 1
    a.ph_lo = 0; a.ph_hi = NPHASES; a.li = 0;
    hipLaunchKernelGGL(mk_fwd, dim3(grid), dim3(NTHREADS), LDS_BYTES, stream, a);
#else
    for (int p = 0; p < NPHASES; ++p) { a.ph_lo = p; a.ph_hi = p + 1; a.li = 0; hipLaunchKernelGGL(mk_fwd, dim3(grid), dim3(NTHREADS), LDS_BYTES, stream, a); }
#endif
    const hipError_t le = hipPeekAtLastError();
    if (le != hipSuccess) fprintf(stderr, "kernel_launch: launch failed: %s\n", hipGetErrorName(le));
}
```

```cpp
#include <hip/hip_runtime.h>
#include <cstdio>
#include <cstdint>

#ifndef MK_CUTS
#define MK_CUTS 1
#endif


#define LAS __attribute__((address_space(3)))
#define GAS __attribute__((address_space(1)))
typedef _Float16 f16;
typedef _Float16 h8 __attribute__((ext_vector_type(8)));
typedef _Float16 h4 __attribute__((ext_vector_type(4)));
typedef _Float16 h2 __attribute__((ext_vector_type(2)));
typedef short s16x4 __attribute__((ext_vector_type(4)));
typedef float f32x4 __attribute__((ext_vector_type(4)));
typedef float f32x2 __attribute__((ext_vector_type(2)));
typedef float f32x16 __attribute__((ext_vector_type(16)));
typedef unsigned u32x4 __attribute__((ext_vector_type(4)));
typedef unsigned u32x2 __attribute__((ext_vector_type(2)));

constexpr int NB = 4, SEQ = 4096, DM = 1024, T = NB * SEQ;
constexpr int NE = 16, FF = 2048, CAP = 512, EROWS = NB * CAP;
constexpr int MROWS = NE * EROWS;
constexpr float ALPHA = 1.4142135623730951f;
constexpr float LN_EPS = 1e-5f, LAT_EPS = 1e-6f;
constexpr float LAMBDA_INIT = 0.35550906759096926f;
constexpr int NWAVES = 8, NTHREADS = 512;

constexpr size_t MiB = 1u << 20;
constexpr size_t WS_CTL = 0, CTL_ZERO_BYTES = 1 * MiB;
constexpr size_t WS_MODS = 1 * MiB;
constexpr size_t WS_COSM = 2 * MiB, WS_SINM = 4 * MiB;
constexpr size_t WS_COSD = 6 * MiB, WS_SIND = 6 * MiB + 512 * 1024;
constexpr size_t WS_AFF = 7 * MiB;
constexpr size_t WS_GATE = 8 * MiB;
constexpr size_t WS_ROWTOK = 8 * MiB + 512 * 1024;
constexpr size_t WS_INV = 9 * MiB;
constexpr size_t WS_WIN0 = 16 * MiB;
constexpr size_t WS_WUQ = 18 * MiB;
constexpr size_t WS_WUKV = 20 * MiB;
constexpr size_t WS_WO0 = 22 * MiB;
constexpr size_t WS_WIN1 = 24 * MiB;
constexpr size_t WS_WO1 = 30 * MiB;
constexpr size_t WS_MOEIN = 32 * MiB;
constexpr size_t WS_MOEOUT = 288 * MiB;
constexpr size_t WS_HA = 416 * MiB;
constexpr size_t WS_HB = 448 * MiB;
constexpr size_t WS_PQ = 480 * MiB;
constexpr size_t WS_PKV = 481 * MiB;
constexpr size_t WS_CQN = 528 * MiB;
constexpr size_t WS_CKVN = 540 * MiB;
constexpr size_t WS_Q = 548 * MiB;
constexpr size_t WS_K = 596 * MiB;
constexpr size_t WS_V = 644 * MiB;
constexpr size_t WS_O = 676 * MiB;
constexpr size_t WS_PRE = 708 * MiB;
constexpr size_t WS_STAT = 772 * MiB;
constexpr size_t WS_X2 = 836 * MiB;
constexpr size_t WS_XE = 900 * MiB;
constexpr size_t WS_ACT = 964 * MiB;
constexpr size_t WS_Y = 1092 * MiB;
constexpr size_t WS_QKV1 = 1156 * MiB;
constexpr size_t WS_OD = 1252 * MiB;
constexpr size_t WS_END = 1316 * MiB;
constexpr int CW_BAR = 4096;

constexpr int RING_BYTES = 131072;
constexpr int LDSCTL_OFF = RING_BYTES, MISC_OFF = LDSCTL_OFF + 320;
constexpr int LDS_BYTES = 147456;

#define LDS_WAIT() asm volatile("s_waitcnt lgkmcnt(0)" ::: "memory")
#define VM_WAIT() asm volatile("s_waitcnt vmcnt(0)" ::: "memory")

__device__ __forceinline__ float wave_sum(float v) {
#pragma unroll
    for (int o = 1; o < 64; o <<= 1) v += __shfl_xor(v, o);
    return v;
}

#define XB_TMO      128
#define XB_XCNT(j)  (256  + 64 * (j))
#define XB_XSUB(j)  (1280 + 64 * (j))
#define XB_XGEN(j)  (2304 + 64 * (j))
#define XB_TOP      3328
#define XB_TOPGEN   3392
#define XCD_BAR_WORDS 3456
#define XB_SPIN_CAP (1u << 20)
__device__ __forceinline__ unsigned xb_ld(unsigned* p)              { return __hip_atomic_load(p, __ATOMIC_RELAXED, __HIP_MEMORY_SCOPE_AGENT); }
__device__ __forceinline__ unsigned xb_add(unsigned* p, unsigned v) { return __hip_atomic_fetch_add(p, v, __ATOMIC_RELAXED, __HIP_MEMORY_SCOPE_AGENT); }
__device__ __forceinline__ unsigned xb_xcc_id() { return (unsigned)__builtin_amdgcn_s_getreg((3 << 11) | 20) & 0xFu; }
#define XB_SPIN(cond, bar) do { unsigned _sp = 0; while (cond) { __builtin_amdgcn_s_sleep(1); \
    if ((++_sp & 255u) == 0u) { if (xb_ld(&(bar)[XB_TMO])) break; if (_sp > XB_SPIN_CAP) { atomicAdd(&(bar)[XB_TMO], 1u); break; } } } } while (0)
struct XcdBarrier { unsigned* bar; unsigned x; volatile LAS unsigned* st; };
__device__ __forceinline__ XcdBarrier xcd_barrier_post(unsigned* bar, volatile LAS unsigned* st) {
    XcdBarrier b; b.bar = bar; b.x = xb_xcc_id(); b.st = st;
    if (threadIdx.x == 0) (void)xb_add(&bar[XB_XCNT(b.x)], 1u);
    return b;
}
__device__ __forceinline__ void xcd_barrier_complete(unsigned* bar, unsigned x, unsigned& nloc, unsigned& nx) {
    const unsigned G = gridDim.x * gridDim.y * gridDim.z;
    unsigned sum, cnt, mine, sp = 0u;
    for (;;) {
        sum = 0u; cnt = 0u; mine = 0u;
#pragma unroll
        for (unsigned j = 0; j < 16; ++j) { const unsigned c = xb_ld(&bar[XB_XCNT(j)]); sum += c; cnt += (c > 0u) ? 1u : 0u; mine = (j == x) ? c : mine; }
        if (sum == G) break;
        __builtin_amdgcn_s_sleep(1);
        if ((++sp & 255u) == 0u) { if (xb_ld(&bar[XB_TMO])) break; if (sp > XB_SPIN_CAP) { atomicAdd(&bar[XB_TMO], 1u); break; } }
    }
    nloc = mine > 0u ? mine : 1u; nx = cnt > 0u ? cnt : 1u;
}
__device__ __forceinline__ void xcd_barrier(const XcdBarrier& b) {
    asm volatile("s_waitcnt vmcnt(0)" ::: "memory");
    __syncthreads();
    if (threadIdx.x == 0) {
        unsigned* bar = b.bar;
        __builtin_amdgcn_s_waitcnt(0);
        unsigned nloc = b.st[0], nx = b.st[1];
        if (nloc == 0u) { xcd_barrier_complete(bar, b.x, nloc, nx); b.st[0] = nloc; b.st[1] = nx; }
        const unsigned old = xb_add(&bar[XB_XSUB(b.x)], 1u);
        const unsigned gen = old / nloc;
        if (old + 1u == (gen + 1u) * nloc) {
            __builtin_amdgcn_fence(__ATOMIC_RELEASE, "agent");
            asm volatile("s_waitcnt vmcnt(0)" ::: "memory");
            const unsigned og = xb_add(&bar[XB_TOP], 1u);
            const unsigned tg = og / nx;
            if (og + 1u == (tg + 1u) * nx) xb_add(&bar[XB_TOPGEN], 1u);
            else XB_SPIN(xb_ld(&bar[XB_TOPGEN]) == tg, bar);
            __builtin_amdgcn_fence(__ATOMIC_ACQUIRE, "agent");
            xb_add(&bar[XB_XGEN(b.x)], 1u);
            asm volatile("s_waitcnt vmcnt(0)" ::: "memory");
        } else {
            XB_SPIN(xb_ld(&bar[XB_XGEN(b.x)]) == gen, bar);
            __builtin_amdgcn_fence(__ATOMIC_ACQUIRE, "agent");
            asm volatile("s_waitcnt vmcnt(0)" ::: "memory");
        }
    }
    __syncthreads();
}

namespace pg8 {
constexpr int BM = 256, BK = 64, HALF = 128, HTB = HALF * BK * 2, STAGE_BYTES = 8 * HTB, NXCD = 8, WGM = 8;
__host__ __device__ __forceinline__ int lds_byte(int r, int c) { const int st = (r >> 4) * 2 + (c >> 5), rr = r & 15, cc = c & 31, ob = rr * 64 + cc * 2; return st * 1024 + (ob ^ (((ob >> 9) & 1) << 5)); }
__host__ __device__ __forceinline__ void stage_rc(int b, int& R, int& C) { const int st = b / 1024, sb = b % 1024, swz = sb ^ (((sb >> 9) & 1) << 5); R = (st >> 1) * 16 + swz / 64; C = (st & 1) * 32 + (swz % 64) / 2; }
__host__ __device__ __forceinline__ int perm32(int rho) { const int n = rho >> 4, i = rho & 15; return 8 * (i >> 2) + 4 * n + (i & 3); }
struct Unit { int pm, pn; };
struct Gemm { const f16* A; const f16* Bt; int M, N, K; int grp_tiles; size_t grp_stride; const int* rowidx; };
struct StaticOrder {
    int nM, nN, nwg, G, c;
    __host__ __device__ void init(int M, int N, int G_, int c_) { nM = M / BM; nN = N / BM; nwg = nM * nN; G = G_; c = c_; }
    __host__ __device__ bool next(int i, Unit& u) const {
        const long L = (long)i * G + c; if (L >= nwg) return false;
        int wgid = (int)L; { const int q = nwg / NXCD, r = nwg % NXCD, xcd = wgid % NXCD, off = wgid / NXCD; wgid = (xcd < r ? xcd * (q + 1) : r * (q + 1) + (xcd - r) * q) + off; }
        const int nig = WGM * nN, gid = wgid / nig, fm = gid * WGM, gsz = (nM - fm) < WGM ? (nM - fm) : WGM;
        u.pm = fm + ((wgid % nig) % gsz); u.pn = (wgid % nig) / gsz; return true;
    }
};
constexpr int GATHER_MAX_UNITS = 15, GATHER_IDX_OFF = RING_BYTES + 1024;
template <class Epi, bool ALIGN_EPI = true, bool SP2 = true, bool GATHER = false>
__device__ __forceinline__ void gemm_phase(LAS unsigned char* lds, const Gemm g, const StaticOrder& S, const Epi& E) {
    int tid = threadIdx.x; asm volatile("" : "+v"(tid));
    const int wid = __builtin_amdgcn_readfirstlane(tid >> 6), lane = tid & 63, wr = wid >> 2, wc = wid & 3, fr = lane & 15, fq = lane >> 4;
    const int K = g.K, nt = K / BK;
    unsigned voffA[2], voffB[2];
#pragma unroll
    for (int i = 0; i < 2; ++i) { int R, C; stage_rc(tid * 16 + i * 8192, R, C); const int Rb = Epi::PERM ? ((R & ~31) + perm32(R & 31)) : R;
        voffA[i] = (unsigned)(R * K + C) * 2u; voffB[i] = (unsigned)(Rb * K + C) * 2u; }
    int gR[2]; unsigned gC[2];
#pragma unroll
    for (int i = 0; i < 2; ++i) { int R, C; stage_rc(tid * 16 + i * 8192, R, C); gR[i] = R; gC[i] = (unsigned)C * 2u; }
    LAS int* idxbuf = (LAS int*)(lds + GATHER_IDX_OFF);
    if constexpr (GATHER) {
        Unit uu;
        for (int q = 0; q < GATHER_MAX_UNITS; ++q) { if (!S.next(q, uu)) break; if (tid < 256) idxbuf[q * 256 + tid] = g.rowidx[uu.pm * 256 + tid]; }
        asm volatile("s_waitcnt vmcnt(0) lgkmcnt(0)" ::: "memory"); __builtin_amdgcn_s_barrier(); asm volatile("" ::: "memory");
    }
    unsigned gaC[2][2], gaN[2][2], ga2[2][2];
#define PG8_GA(dst, q) do { _Pragma("unroll") for (int _h = 0; _h < 2; ++_h) _Pragma("unroll") for (int _i = 0; _i < 2; ++_i) dst[_h][_i] = (unsigned)idxbuf[(q) * 256 + _h * 128 + gR[_i]] * (unsigned)(K * 2) + gC[_i]; } while (0)
    const size_t kstep = (size_t)(BK * 2);
    const size_t hstep = (size_t)HALF * K * 2;
    const size_t tstep = 2 * hstep;
    const unsigned ldsw = (unsigned)wid * 1024u;
    const int aoff = lds_byte(wr * 64 + fr, fq * 8), boff = lds_byte(wc * 32 + fr, fq * 8);
#define PG8_SA(b, h) (((b) * 2 + (h)) * HTB)
#define PG8_SB(b, h) ((4 + (b) * 2 + (h)) * HTB)
#define PG8_STAGE(bufoff, gbase, voff) do { _Pragma("unroll") for (int _i = 0; _i < 2; ++_i) \
        __builtin_amdgcn_global_load_lds((const unsigned*)((const char*)(gbase) + (voff)[_i]), (LAS unsigned*)(lds + (bufoff) + ldsw + _i * 8192), 16, 0, 0); } while (0)
#define PG8_LDA(dst, b, h) do { _Pragma("unroll") for (int m = 0; m < 4; ++m) _Pragma("unroll") for (int k = 0; k < 2; ++k) dst[m][k] = *(const LAS h8*)(lds + PG8_SA(b, h) + aoff + m * 2048 + k * 1024); } while (0)
#define PG8_LDB(dst, b, h) do { _Pragma("unroll") for (int n = 0; n < 2; ++n) _Pragma("unroll") for (int k = 0; k < 2; ++k) dst[n][k] = *(const LAS h8*)(lds + PG8_SB(b, h) + boff + n * 2048 + k * 1024); } while (0)
#define PG8_MMA(ai, bj, At, Bt) do { __builtin_amdgcn_s_setprio(1); _Pragma("unroll") for (int m = 0; m < 4; ++m) _Pragma("unroll") for (int n = 0; n < 2; ++n) _Pragma("unroll") for (int k = 0; k < 2; ++k) \
        acc[ai][bj][m][n] = __builtin_amdgcn_mfma_f32_16x16x32_f16(Bt[n][k], At[m][k], acc[ai][bj][m][n], 0, 0, 0); __builtin_amdgcn_s_setprio(0); } while (0)
#define PG8_WAIT_V(n) asm volatile("s_waitcnt vmcnt(" #n ")" ::: "memory")
#define PG8_WAIT_L(n) asm volatile("s_waitcnt lgkmcnt(" #n ")" ::: "memory")
#define PG8_BAR __builtin_amdgcn_s_barrier()
#define PG8_SCHED __builtin_amdgcn_sched_barrier(0)
#define PG8_STA(bufoff, tileptr, h, gaset, kbyte) do { if constexpr (GATHER) { PG8_STAGE(bufoff, (const char*)g.A + (kbyte), gaset[h]); } else { PG8_STAGE(bufoff, (tileptr) + (h) * hstep, voffA); } } while (0)
#define PG8_BBASE(u) ((const char*)g.Bt + ((size_t)((u).pm / g.grp_tiles) * g.grp_stride) * 2 + (size_t)(u).pn * tstep)
    Unit cur, nxt; int ui = 0;
    if (!S.next(0, cur)) return;
    f32x4 acc[2][2][4][2];
#pragma unroll
    for (int a = 0; a < 2; ++a)
#pragma unroll
        for (int b = 0; b < 2; ++b)
#pragma unroll
            for (int m = 0; m < 4; ++m)
#pragma unroll
                for (int n = 0; n < 2; ++n) acc[a][b][m][n] = (f32x4){0.f, 0.f, 0.f, 0.f};
    h8 At[4][2], B0[2][2], B1[2][2];
    const char* cA = (const char*)g.A + (size_t)cur.pm * tstep; const char* cB = PG8_BBASE(cur);
    if constexpr (GATHER) { PG8_GA(gaC, 0); }
    if constexpr (SP2) {
        PG8_STAGE(PG8_SB(0, 0), cB, voffB); PG8_STAGE(PG8_SB(0, 1), cB + hstep, voffB); PG8_STA(PG8_SA(0, 0), cA, 0, gaC, 0); PG8_STA(PG8_SA(0, 1), cA, 1, gaC, 0);
        if (wr == 1) PG8_BAR;
        PG8_WAIT_V(2); PG8_BAR;
        PG8_STAGE(PG8_SB(1, 0), cB + kstep, voffB); PG8_STA(PG8_SA(1, 0), cA + kstep, 0, gaC, kstep); PG8_STAGE(PG8_SB(1, 1), cB + hstep + kstep, voffB);
        PG8_WAIT_V(6); PG8_BAR;
    } else {
        PG8_STAGE(PG8_SB(0, 0), cB, voffB); PG8_STA(PG8_SA(0, 0), cA, 0, gaC, 0); PG8_STAGE(PG8_SB(0, 1), cB + hstep, voffB); PG8_STA(PG8_SA(0, 1), cA, 1, gaC, 0);
        if (wr == 1) PG8_BAR;
        PG8_WAIT_V(4); PG8_BAR;
        PG8_STAGE(PG8_SB(1, 0), cB + kstep, voffB); PG8_STA(PG8_SA(1, 0), cA + kstep, 0, gaC, kstep); PG8_STAGE(PG8_SB(1, 1), cB + hstep + kstep, voffB);
        PG8_WAIT_V(6); PG8_BAR;
    }
    for (;;) {
        const bool has_next = S.next(ui + 1, nxt);
        const char* nA = has_next ? (const char*)g.A + (size_t)nxt.pm * tstep : cA; const char* nB = has_next ? PG8_BBASE(nxt) : cB;
        if constexpr (GATHER) { const int qn = has_next ? ui + 1 : ui; PG8_GA(gaN, qn); }
#pragma unroll 1
        for (int t = 0; t < nt; t += 2) {
            const bool last = (t == nt - 2);
            const char* a1 = cA + (size_t)(t + 1) * kstep;
            const char* a2 = last ? nA : cA + (size_t)(t + 2) * kstep; const char* b2 = last ? nB : cB + (size_t)(t + 2) * kstep;
            const char* a3 = a2 + kstep; const char* b3 = b2 + kstep;
            const size_t k1 = (size_t)(t + 1) * kstep, k2 = last ? 0 : (size_t)(t + 2) * kstep, k3 = k2 + kstep;
            if constexpr (GATHER) { _Pragma("unroll") for (int _h = 0; _h < 2; ++_h) _Pragma("unroll") for (int _i = 0; _i < 2; ++_i) ga2[_h][_i] = last ? gaN[_h][_i] : gaC[_h][_i]; }
            if constexpr (SP2) {
            PG8_LDB(B0, 0, 0); PG8_LDB(B1, 0, 1); PG8_SCHED; PG8_LDA(At, 0, 0); PG8_STA(PG8_SA(1, 1), a1, 1, gaC, k1);
            PG8_WAIT_V(8); PG8_WAIT_L(0); PG8_BAR; PG8_MMA(0, 0, At, B0); PG8_MMA(0, 1, At, B1); PG8_BAR; PG8_SCHED;
            PG8_LDA(At, 0, 1); PG8_STAGE(PG8_SB(0, 0), b2, voffB); PG8_STAGE(PG8_SB(0, 1), b2 + hstep, voffB); PG8_STA(PG8_SA(0, 0), a2, 0, ga2, k2);
            PG8_WAIT_V(8); PG8_WAIT_L(0); PG8_BAR; PG8_MMA(1, 0, At, B0); PG8_MMA(1, 1, At, B1); PG8_BAR; PG8_SCHED;
            PG8_LDB(B0, 1, 0); PG8_LDB(B1, 1, 1); PG8_SCHED; PG8_LDA(At, 1, 0); PG8_STA(PG8_SA(0, 1), a2, 1, ga2, k2);
            PG8_WAIT_V(8); PG8_WAIT_L(0); PG8_BAR; PG8_MMA(0, 0, At, B0); PG8_MMA(0, 1, At, B1); PG8_BAR; PG8_SCHED;
            PG8_LDA(At, 1, 1); PG8_STAGE(PG8_SB(1, 0), b3, voffB); PG8_STAGE(PG8_SB(1, 1), b3 + hstep, voffB); PG8_STA(PG8_SA(1, 0), a3, 0, ga2, k3);
            PG8_WAIT_V(8); PG8_WAIT_L(0); PG8_BAR; PG8_MMA(1, 0, At, B0); PG8_MMA(1, 1, At, B1); PG8_BAR; PG8_SCHED;
            } else {
            PG8_LDB(B0, 0, 0); PG8_SCHED; PG8_LDA(At, 0, 0); PG8_STA(PG8_SA(1, 1), a1, 1, gaC, k1);
            PG8_WAIT_L(8); PG8_BAR; PG8_WAIT_L(0); PG8_MMA(0, 0, At, B0); PG8_BAR; PG8_SCHED;
            PG8_LDB(B1, 0, 1); PG8_STAGE(PG8_SB(0, 0), b2, voffB);
            PG8_BAR; PG8_WAIT_L(0); PG8_MMA(0, 1, At, B1); PG8_BAR;
            PG8_LDA(At, 0, 1); PG8_STA(PG8_SA(0, 0), a2, 0, ga2, k2);
            PG8_BAR; PG8_WAIT_L(0); PG8_MMA(1, 0, At, B0); PG8_BAR; PG8_SCHED;
            PG8_STAGE(PG8_SB(0, 1), b2 + hstep, voffB);
            PG8_WAIT_V(6); PG8_BAR; PG8_MMA(1, 1, At, B1); PG8_BAR;
            PG8_LDB(B0, 1, 0); PG8_SCHED; PG8_LDA(At, 1, 0); PG8_STA(PG8_SA(0, 1), a2, 1, ga2, k2);
            PG8_WAIT_L(8); PG8_BAR; PG8_WAIT_L(0); PG8_MMA(0, 0, At, B0); PG8_BAR; PG8_SCHED;
            PG8_LDB(B1, 1, 1); PG8_STAGE(PG8_SB(1, 0), b3, voffB);
            PG8_BAR; PG8_WAIT_L(0); PG8_MMA(0, 1, At, B1); PG8_BAR;
            PG8_LDA(At, 1, 1); PG8_STA(PG8_SA(1, 0), a3, 0, ga2, k3);
            PG8_BAR; PG8_WAIT_L(0); PG8_MMA(1, 0, At, B0); PG8_BAR; PG8_SCHED;
            PG8_STAGE(PG8_SB(1, 1), b3 + hstep, voffB);
            PG8_WAIT_V(6); PG8_BAR; PG8_MMA(1, 1, At, B1); PG8_BAR;
            }
        }
        if constexpr (ALIGN_EPI) { if (wr == 0) PG8_BAR; }
        E(acc, cur, wr, wc, fr, fq);
        if (!has_next) break;
#pragma unroll
        for (int a = 0; a < 2; ++a)
#pragma unroll
            for (int b = 0; b < 2; ++b)
#pragma unroll
                for (int m = 0; m < 4; ++m)
#pragma unroll
                    for (int n = 0; n < 2; ++n) acc[a][b][m][n] = (f32x4){0.f, 0.f, 0.f, 0.f};
        cur = nxt; cA = nA; cB = nB; ++ui;
        if constexpr (GATHER) { _Pragma("unroll") for (int _h = 0; _h < 2; ++_h) _Pragma("unroll") for (int _i = 0; _i < 2; ++_i) gaC[_h][_i] = gaN[_h][_i]; }
        if constexpr (ALIGN_EPI) { if (wr == 1) PG8_BAR; }
    }
    PG8_WAIT_V(0);
    if constexpr (!ALIGN_EPI) { if (wr == 0) PG8_BAR; }
    PG8_BAR;
#undef PG8_SA
#undef PG8_SB
#undef PG8_STAGE
#undef PG8_LDA
#undef PG8_LDB
#undef PG8_MMA
#undef PG8_WAIT_V
#undef PG8_WAIT_L
#undef PG8_BAR
#undef PG8_SCHED
#undef PG8_BBASE
#undef PG8_STA
#undef PG8_GA
}
}

#define EPI_ROW(u, ai, m) ((u).pm * 256 + (ai) * 128 + wr * 64 + (m) * 16 + fr)
__device__ __forceinline__ h8 pack8(f32x4 a, f32x4 b) { h8 o; o[0] = (f16)a[0]; o[1] = (f16)a[1]; o[2] = (f16)a[2]; o[3] = (f16)a[3]; o[4] = (f16)b[0]; o[5] = (f16)b[1]; o[6] = (f16)b[2]; o[7] = (f16)b[3]; return o; }
__device__ __forceinline__ void rope4(f32x4& v0, f32x4& v1, const f32x4 cs, const f32x4 sn) {
    const f32x4 a = v0, b = v1;
    v0[0] = a[0] * cs[0] - a[1] * sn[0]; v0[1] = a[1] * cs[0] + a[0] * sn[0];
    v0[2] = a[2] * cs[1] - a[3] * sn[1]; v0[3] = a[3] * cs[1] + a[2] * sn[1];
    v1[0] = b[0] * cs[2] - b[1] * sn[2]; v1[1] = b[1] * cs[2] + b[0] * sn[2];
    v1[2] = b[2] * cs[3] - b[3] * sn[3]; v1[3] = b[3] * cs[3] + b[2] * sn[3];
}
struct EpiLat {
    static constexpr bool PERM = true; f16* cq; f16* ckv; f16* Kp; float* pq; float* pkv; const float* cosm; const float* sinm;
    __device__ __forceinline__ void operator()(const f32x4 (&acc)[2][2][4][2], const pg8::Unit& u, int wr, int wc, int fr, int fq) const {
#pragma unroll
        for (int ai = 0; ai < 2; ++ai)
#pragma unroll
            for (int m = 0; m < 4; ++m) { const int t = EPI_ROW(u, ai, m); float sq = 0.f, sk = 0.f;
#pragma unroll
                for (int bj = 0; bj < 2; ++bj) { const int c8 = u.pn * 256 + bj * 128 + wc * 32 + 8 * fq; const int ht = u.pn * 2 + bj;
                    f32x4 v0 = acc[ai][bj][m][0], v1 = acc[ai][bj][m][1];
                    const float ss = (v0[0] * v0[0] + v0[1] * v0[1]) + (v0[2] * v0[2] + v0[3] * v0[3]) + (v1[0] * v1[0] + v1[1] * v1[1]) + (v1[2] * v1[2] + v1[3] * v1[3]);
                    if (ht < 3) { sq += ss; *(h8*)(cq + (size_t)t * 384 + c8) = pack8(v0, v1); }
                    else if (ht < 5) { sk += ss; *(h8*)(ckv + (size_t)t * 256 + (c8 - 384)) = pack8(v0, v1); }
                    else if (c8 < 704) { const int jj = c8 - 640, i0 = jj >> 1;
                        const f32x4 cs = *(const f32x4*)(cosm + (size_t)t * 32 + i0), sn = *(const f32x4*)(sinm + (size_t)t * 32 + i0); rope4(v0, v1, cs, sn);
                        const h8 o = pack8(v0, v1);
#pragma unroll
                        for (int h = 0; h < 8; ++h) *(h8*)(Kp + (size_t)t * 1536 + h * 192 + 128 + jj) = o; } }
                sq += __shfl_xor(sq, 16); sq += __shfl_xor(sq, 32); sk += __shfl_xor(sk, 16); sk += __shfl_xor(sk, 32);
                if (fq == 0) { if (u.pn < 2) pq[(size_t)t * 8 + u.pn * 4 + wc] = sq; if (u.pn >= 1) pkv[(size_t)t * 8 + (u.pn - 1) * 4 + wc] = sk; }
                asm volatile("" ::: "memory"); }
    }
};
__device__ __forceinline__ float row_rms_scale(const float* part, int t, float inv_n, float eps) {
    const f32x4 a = *(const f32x4*)(part + (size_t)t * 8), b = *(const f32x4*)(part + (size_t)t * 8 + 4);
    const float s = ((a[0] + a[1]) + (a[2] + a[3])) + ((b[0] + b[1]) + (b[2] + b[3]));
    return 1.0f / sqrtf(s * inv_n + eps);
}
struct EpiQNope {
    static constexpr bool PERM = true; f16* Q; const float* pq;
    __device__ __forceinline__ void operator()(const f32x4 (&acc)[2][2][4][2], const pg8::Unit& u, int wr, int wc, int fr, int fq) const {
#pragma unroll
        for (int ai = 0; ai < 2; ++ai)
#pragma unroll
            for (int m = 0; m < 4; ++m) { const int t = EPI_ROW(u, ai, m); const float rs = row_rms_scale(pq, t, 1.0f / 384.0f, LAT_EPS);
#pragma unroll
                for (int bj = 0; bj < 2; ++bj) { const int c8 = u.pn * 256 + bj * 128 + wc * 32 + 8 * fq;
                    *(h8*)(Q + (size_t)t * 1536 + (c8 >> 7) * 192 + (c8 & 127)) = pack8(acc[ai][bj][m][0] * rs, acc[ai][bj][m][1] * rs); }
                asm volatile("" ::: "memory"); }
    }
};
struct EpiQRope {
    static constexpr bool PERM = true; f16* Q; const float* cosm; const float* sinm; const float* pq;
    __device__ __forceinline__ void operator()(const f32x4 (&acc)[2][2][4][2], const pg8::Unit& u, int wr, int wc, int fr, int fq) const {
#pragma unroll
        for (int ai = 0; ai < 2; ++ai)
#pragma unroll
            for (int m = 0; m < 4; ++m) { const int t = EPI_ROW(u, ai, m); const float rs = row_rms_scale(pq, t, 1.0f / 384.0f, LAT_EPS);
#pragma unroll
                for (int bj = 0; bj < 2; ++bj) { const int cc = u.pn * 256 + bj * 128 + wc * 32 + 8 * fq; const int h = cc >> 6, jj = cc & 63, i0 = jj >> 1;
                    f32x4 v0 = acc[ai][bj][m][0] * rs, v1 = acc[ai][bj][m][1] * rs;
                    const f32x4 cs = *(const f32x4*)(cosm + (size_t)t * 32 + i0), sn = *(const f32x4*)(sinm + (size_t)t * 32 + i0); rope4(v0, v1, cs, sn);
                    *(h8*)(Q + (size_t)t * 1536 + h * 192 + 128 + jj) = pack8(v0, v1); }
                asm volatile("" ::: "memory"); }
    }
};
struct EpiKV {
    static constexpr bool PERM = true; f16* Kp; f16* Vp; const float* pkv;
    __device__ __forceinline__ void operator()(const f32x4 (&acc)[2][2][4][2], const pg8::Unit& u, int wr, int wc, int fr, int fq) const {
#pragma unroll
        for (int ai = 0; ai < 2; ++ai)
#pragma unroll
            for (int m = 0; m < 4; ++m) { const int t = EPI_ROW(u, ai, m); const float rs = row_rms_scale(pkv, t, 1.0f / 256.0f, LAT_EPS);
#pragma unroll
                for (int bj = 0; bj < 2; ++bj) { const int c8 = u.pn * 256 + bj * 128 + wc * 32 + 8 * fq; const int h = c8 >> 8, j = c8 & 255;
                    f16* dst = (j < 128) ? (Kp + (size_t)t * 1536 + h * 192 + j) : (Vp + (size_t)t * 1024 + h * 128 + (j - 128));
                    *(h8*)dst = pack8(acc[ai][bj][m][0] * rs, acc[ai][bj][m][1] * rs); }
                asm volatile("" ::: "memory"); }
    }
};
template <bool XF16> struct EpiPre {
    static constexpr bool PERM = true; const void* xres; const float* gmod; f16* pre;
    __device__ __forceinline__ void operator()(const f32x4 (&acc)[2][2][4][2], const pg8::Unit& u, int wr, int wc, int fr, int fq) const {
#pragma unroll
        for (int ai = 0; ai < 2; ++ai)
#pragma unroll
            for (int m = 0; m < 4; ++m) { const int t = EPI_ROW(u, ai, m); const int b = t >> 12;
#pragma unroll
                for (int bj = 0; bj < 2; ++bj) { const int c8 = u.pn * 256 + bj * 128 + wc * 32 + 8 * fq;
                    const f32x4 g0 = *(const f32x4*)(gmod + b * 6144 + c8), g1 = *(const f32x4*)(gmod + b * 6144 + c8 + 4); f32x4 x0, x1;
                    if constexpr (XF16) { const h8 xv = *(const h8*)((const f16*)xres + (size_t)t * 1024 + c8);
                        x0 = (f32x4){(float)xv[0], (float)xv[1], (float)xv[2], (float)xv[3]}; x1 = (f32x4){(float)xv[4], (float)xv[5], (float)xv[6], (float)xv[7]}; }
                    else { x0 = *(const f32x4*)((const float*)xres + (size_t)t * 1024 + c8); x1 = *(const f32x4*)((const float*)xres + (size_t)t * 1024 + c8 + 4); }
                    *(h8*)(pre + (size_t)t * 1024 + c8) = pack8(x0 * ALPHA + (g0 + 1.0f) * acc[ai][bj][m][0], x1 * ALPHA + (g1 + 1.0f) * acc[ai][bj][m][1]); }
                asm volatile("" ::: "memory"); }
    }
};
struct EpiUp {
    static constexpr bool PERM = true; f16* act;
    __device__ __forceinline__ void operator()(const f32x4 (&acc)[2][2][4][2], const pg8::Unit& u, int wr, int wc, int fr, int fq) const {
#pragma unroll
        for (int ai = 0; ai < 2; ++ai)
#pragma unroll
            for (int m = 0; m < 4; ++m) { const int r = EPI_ROW(u, ai, m);
#pragma unroll
                for (int bj = 0; bj < 2; ++bj) { const int c8 = u.pn * 256 + bj * 128 + wc * 32 + 8 * fq;
                    const f32x4 gq = acc[ai][bj][m][0], uq = acc[ai][bj][m][1]; h4 o;
#pragma unroll
                    for (int i = 0; i < 4; ++i) { const float gg = gq[i]; o[i] = (f16)(gg * __builtin_amdgcn_rcpf(1.0f + __expf(-gg)) * uq[i]); }
                    *(h4*)(act + (size_t)r * 2048 + (c8 >> 1)) = o; } }
    }
};
struct EpiDown {
    static constexpr bool PERM = true; f16* y; const float* gate;
    __device__ __forceinline__ void operator()(const f32x4 (&acc)[2][2][4][2], const pg8::Unit& u, int wr, int wc, int fr, int fq) const {
#pragma unroll
        for (int ai = 0; ai < 2; ++ai)
#pragma unroll
            for (int m = 0; m < 4; ++m) { const int r = EPI_ROW(u, ai, m); const float gt = gate[r];
#pragma unroll
                for (int bj = 0; bj < 2; ++bj) { const int c8 = u.pn * 256 + bj * 128 + wc * 32 + 8 * fq;
                    *(h8*)(y + (size_t)r * 1024 + c8) = pack8(acc[ai][bj][m][0] * gt, acc[ai][bj][m][1] * gt); }
                asm volatile("" ::: "memory"); }
    }
};
struct EpiDiffIn {
    static constexpr bool PERM = true; f16* qkv; const float* cosd; const float* sind;
    __device__ __forceinline__ void operator()(const f32x4 (&acc)[2][2][4][2], const pg8::Unit& u, int wr, int wc, int fr, int fq) const {
#pragma unroll
        for (int ai = 0; ai < 2; ++ai)
#pragma unroll
            for (int m = 0; m < 4; ++m) { const int t = EPI_ROW(u, ai, m);
#pragma unroll
                for (int bj = 0; bj < 2; ++bj) { const int c8 = u.pn * 256 + bj * 128 + wc * 32 + 8 * fq;
                    f32x4 v0 = acc[ai][bj][m][0], v1 = acc[ai][bj][m][1];
                    if (c8 < 2048 && (c8 & 63) < 16) { const int i0 = (c8 & 15) >> 1; const f32x4 cs = *(const f32x4*)(cosd + (size_t)t * 8 + i0), sn = *(const f32x4*)(sind + (size_t)t * 8 + i0); rope4(v0, v1, cs, sn); }
                    *(h8*)(qkv + (size_t)t * 3072 + c8) = pack8(v0, v1); }
                asm volatile("" ::: "memory"); }
    }
};

namespace att {
constexpr int QBLK = 32, KVBLK = 64, DV = 128;
constexpr float THR = 8.f;
constexpr size_t SHM_V = KVBLK * DV * 2;
#define SBAR() __builtin_amdgcn_sched_barrier(0)
__device__ __forceinline__ int crow(int r, int hi) { return (r & 3) + 8 * (r >> 2) + 4 * hi; }
__device__ __forceinline__ unsigned cvtpk(float lo, float hi) { unsigned r; asm volatile("v_cvt_pk_f16_f32 %0, %1, %2" : "=v"(r) : "v"(lo), "v"(hi)); return r; }
template <int DQK> struct Cfg {
    static constexpr int ND0 = DQK / 16, KRB = DQK * 2, NKCH = DQK / 64, KCPR = DQK / 8;
    static constexpr size_t SHM_K = (size_t)KVBLK * KRB;
    static constexpr float SCALE = DQK == 192 ? 0.07216878364870322f : 0.125f;
    static constexpr size_t SHM_TOTAL = 2 * SHM_V + 2 * SHM_K + NWAVES * 64 * 4;
};
template <int DQK> __device__ __forceinline__ void partialSM(f32x16& p0, f32x16& p1, float& m_reg, float& mn, float& alpha) {
    constexpr float SCALE = Cfg<DQK>::SCALE, C = SCALE * 1.4426950408889634f;
    float pmax = p0[0];
#pragma unroll
    for (int r = 1; r < 16; ++r) pmax = fmaxf(pmax, p0[r]);
#pragma unroll
    for (int r = 0; r < 16; ++r) pmax = fmaxf(pmax, p1[r]);
    { auto rr = __builtin_amdgcn_permlane32_swap(__float_as_uint(pmax), __float_as_uint(pmax), false, false);
      pmax = fmaxf(__uint_as_float(rr[0]), __uint_as_float(rr[1])); }
    if (__builtin_expect(__all(pmax - m_reg <= THR / SCALE), 1)) { mn = m_reg; alpha = 1.f; }
    else { mn = fmaxf(m_reg, pmax); alpha = __builtin_amdgcn_exp2f((m_reg - mn) * C); m_reg = mn; }
    const float mnC = -mn * C;
#pragma unroll
    for (int r = 0; r < 16; ++r) p0[r] = fmaf(p0[r], C, mnC);
#pragma unroll
    for (int r = 0; r < 16; ++r) p1[r] = fmaf(p1[r], C, mnC);
#pragma unroll
    for (int r = 0; r < 16; ++r) p0[r] = __builtin_amdgcn_exp2f(p0[r]);
}
__device__ __forceinline__ void finishSM(f32x16& p0, f32x16& p1, float alpha, float& l_reg, h8& pa0, h8& pa1, h8& pa2, h8& pa3) {
#pragma unroll
    for (int r = 0; r < 16; ++r) p1[r] = __builtin_amdgcn_exp2f(p1[r]);
    float ps = 0;
#pragma unroll
    for (int r = 0; r < 16; ++r) ps += p0[r];
#pragma unroll
    for (int r = 0; r < 16; ++r) ps += p1[r];
    { auto rr = __builtin_amdgcn_permlane32_swap(__float_as_uint(ps), __float_as_uint(ps), false, false);
      ps = __uint_as_float(rr[0]) + __uint_as_float(rr[1]); }
    l_reg = l_reg * alpha + ps;
#define PK4(P, BASE, OUT) do { unsigned a0 = cvtpk(P[BASE + 0], P[BASE + 1]), a1 = cvtpk(P[BASE + 2], P[BASE + 3]);   \
    unsigned b0 = cvtpk(P[BASE + 4], P[BASE + 5]), b1 = cvtpk(P[BASE + 6], P[BASE + 7]);                              \
    auto r0 = __builtin_amdgcn_permlane32_swap(a0, b0, false, false); auto r1 = __builtin_amdgcn_permlane32_swap(a1, b1, false, false); \
    u32x4 w = {r0[0], r1[0], r0[1], r1[1]}; OUT = *reinterpret_cast<h8*>(&w); } while (0)
    PK4(p0, 0, pa0); PK4(p0, 8, pa1); PK4(p1, 0, pa2); PK4(p1, 8, pa3);
#undef PK4
}
#define KSWZ(row, colB) ((row) * KRB + ((colB) ^ (((row) & 7) << 4)))
template <int DQK> __device__ __forceinline__ void qkt(f32x16& p0, f32x16& p1, const char* Ks, const h8* qr, int r32, int hi) {
    constexpr int KRB = Cfg<DQK>::KRB;
    p0 = f32x16{}; p1 = f32x16{};
#pragma unroll
    for (int d0 = 0; d0 < Cfg<DQK>::ND0; ++d0) { const int cb = (d0 * 16 + hi * 8) * 2;
        const h8 b0 = *reinterpret_cast<const h8*>(Ks + KSWZ(r32, cb));
        const h8 b1 = *reinterpret_cast<const h8*>(Ks + KSWZ(32 + r32, cb));
        p0 = __builtin_amdgcn_mfma_f32_32x32x16_f16(b0, qr[d0], p0, 0, 0, 0);
        p1 = __builtin_amdgcn_mfma_f32_32x32x16_f16(b1, qr[d0], p1, 0, 0, 0); }
}
__device__ __forceinline__ int v_st(int k, int c) { const int kk = (k & ~0xC) | ((k & 4) << 1) | ((k & 8) >> 1); return ((kk >> 3) * 4 + (c >> 5)) * 512 + ((kk & 7) * 32 + (c & 31)) * 2; }
__device__ __forceinline__ int v_rd_base(int lane) { return ((lane & 3) << 3) | (((lane >> 2) & 3) << 6) | (((lane >> 4) & 1) << 5) | (((lane >> 5) & 1) << 8); }
constexpr int v_rd_off(int d0, int ks, int half) { return d0 * 512 + ks * 4096 + half * 2048; }
template <int OFF> __device__ __forceinline__ s16x4 tr_read(int vb) {
    s16x4 r; asm volatile("ds_read_b64_tr_b16 %0, %1 offset:%2" : "=&v"(r) : "v"(vb), "i"(OFF) : "memory"); return r;
}
template <int D0> __device__ __forceinline__ void pv_one(f32x16& od, int vb, h8 pa0, h8 pa1, h8 pa2, h8 pa3) {
    const s16x4 l0 = tr_read<v_rd_off(D0, 0, 0)>(vb), h0 = tr_read<v_rd_off(D0, 0, 1)>(vb), l1 = tr_read<v_rd_off(D0, 1, 0)>(vb), h1 = tr_read<v_rd_off(D0, 1, 1)>(vb);
    const s16x4 l2 = tr_read<v_rd_off(D0, 2, 0)>(vb), h2_ = tr_read<v_rd_off(D0, 2, 1)>(vb), l3 = tr_read<v_rd_off(D0, 3, 0)>(vb), h3 = tr_read<v_rd_off(D0, 3, 1)>(vb);
    asm volatile("s_waitcnt lgkmcnt(0)" ::: "memory"); SBAR();
#define PKV(L, H) __builtin_bit_cast(h8, (__attribute__((ext_vector_type(8))) short){L[0], L[1], L[2], L[3], H[0], H[1], H[2], H[3]})
    od = __builtin_amdgcn_mfma_f32_32x32x16_f16(pa0, PKV(l0, h0), od, 0, 0, 0);
    od = __builtin_amdgcn_mfma_f32_32x32x16_f16(pa1, PKV(l1, h1), od, 0, 0, 0);
    od = __builtin_amdgcn_mfma_f32_32x32x16_f16(pa2, PKV(l2, h2_), od, 0, 0, 0);
    od = __builtin_amdgcn_mfma_f32_32x32x16_f16(pa3, PKV(l3, h3), od, 0, 0, 0);
#undef PKV
}
__device__ __forceinline__ void pv_d0(f32x16* o, int vb, h8 pa0, h8 pa1, h8 pa2, h8 pa3) {
    pv_one<0>(o[0], vb, pa0, pa1, pa2, pa3); pv_one<1>(o[1], vb, pa0, pa1, pa2, pa3); pv_one<2>(o[2], vb, pa0, pa1, pa2, pa3); pv_one<3>(o[3], vb, pa0, pa1, pa2, pa3);
}
template <int LDO>
__device__ __forceinline__ void attn_epilogue(f32x16 (&o)[4], const float (&rli)[16], f16* Ow, int mode, float lam, const float* subln, int r32, int hi) {
    if (mode == 0) {
#pragma unroll
        for (int r = 0; r < 16; ++r) { const int orow = crow(r, hi);
#pragma unroll
            for (int d0 = 0; d0 < 4; ++d0) Ow[(long)orow * LDO + d0 * 32 + r32] = (f16)(o[d0][r] * rli[r]); }
    } else {
        float sl[4];
#pragma unroll
        for (int d0 = 0; d0 < 4; ++d0) sl[d0] = subln[d0 * 32 + r32] * (1.0f - LAMBDA_INIT);
        f16 t0[4][16];
#pragma unroll
        for (int r = 0; r < 16; ++r) { const int orow = crow(r, hi);
#pragma unroll
            for (int d0 = 0; d0 < 4; ++d0) t0[d0][r] = Ow[(long)orow * LDO + d0 * 32 + r32]; }
        asm volatile("s_waitcnt vmcnt(0)" ::: "memory");
#pragma unroll
        for (int r = 0; r < 16; ++r) { const int orow = crow(r, hi); float ss = 0.f;
#pragma unroll
            for (int d0 = 0; d0 < 4; ++d0) { const float x = (float)t0[d0][r] - lam * (o[d0][r] * rli[r]); o[d0][r] = x; ss += x * x; }
            ss += __shfl_xor(ss, 1); ss += __shfl_xor(ss, 2); ss += __shfl_xor(ss, 4); ss += __shfl_xor(ss, 8); ss += __shfl_xor(ss, 16);
            const float rs = 1.0f / sqrtf(ss * (1.0f / 128.0f) + LN_EPS);
#pragma unroll
            for (int d0 = 0; d0 < 4; ++d0) Ow[(long)orow * LDO + d0 * 32 + r32] = (f16)(o[d0][r] * rs * sl[d0]); }
    }
}
template <int DQK, int LDQ, int LDK, int LDV, int LDO, int SDEPTH>
__device__ __forceinline__ void attn_body(const f16* Qb, const f16* Kh, const f16* Vh, f16* Ob, char* lds, int mode = 0, float lam = 0.f, const float* subln = nullptr) {
    using C = Cfg<DQK>;
    constexpr int KRB = C::KRB, ND0 = C::ND0, NKCH = C::NKCH, KCPR = C::KCPR; constexpr size_t SHM_K = C::SHM_K;
    constexpr int seq = SEQ;
    int tid = threadIdx.x; asm volatile("" : "+v"(tid));
    const int wid = tid >> 6, lane = tid & 63, r32 = lane & 31, hi = lane >> 5;
    char* V_lds = lds; char* K_lds = lds + 2 * SHM_V;
    float* wsl = (float*)(lds + 2 * SHM_V + 2 * SHM_K) + wid * 64; float* li_l = wsl; float* al_l = wsl + 32;
    float m_reg = -1e30f, l_reg = 0; f32x16 o[4] = {}; h8 qr[ND0];
    const f16* Qw = Qb + (long)(wid * QBLK + r32) * LDQ + hi * 8;
#pragma unroll
    for (int d0 = 0; d0 < ND0; ++d0) qr[d0] = *reinterpret_cast<const h8*>(Qw + d0 * 16);
    const int sr = tid >> 4, sc = (tid & 15) * 8, vst0 = v_st(sr, sc), vst1 = v_st(32 + sr, sc);
    int krow[NKCH], kcb[NKCH];
#pragma unroll
    for (int i = 0; i < NKCH; ++i) { const int c = tid + i * 512; krow[i] = c / KCPR; kcb[i] = (c % KCPR) * 16; }
    const int vb0 = (int)(uintptr_t)V_lds + v_rd_base(lane);
    struct { h8 vs0, vs1; h8 ks[NKCH]; } sr_[SDEPTH];
#define SLOAD(i, k0) do { sr_[i].vs0 = *reinterpret_cast<const h8*>(&Vh[(long)((k0) + sr) * LDV + sc]); sr_[i].vs1 = *reinterpret_cast<const h8*>(&Vh[(long)((k0) + 32 + sr) * LDV + sc]); \
    _Pragma("unroll") for (int _c = 0; _c < NKCH; ++_c) sr_[i].ks[_c] = *reinterpret_cast<const h8*>((const char*)Kh + (long)((k0) + krow[_c]) * (LDK * 2) + kcb[_c]); } while (0)
#define SWRITE(b, i) do { *(h8*)(V_lds + (b) * SHM_V + vst0) = sr_[i].vs0; *(h8*)(V_lds + (b) * SHM_V + vst1) = sr_[i].vs1; \
    _Pragma("unroll") for (int _c = 0; _c < NKCH; ++_c) *(h8*)(K_lds + (b) * SHM_K + KSWZ(krow[_c], kcb[_c])) = sr_[i].ks[_c]; } while (0)
#define SWAIT() do { if constexpr (SDEPTH == 2) { if constexpr (NKCH == 3) asm volatile("s_waitcnt vmcnt(5)" ::: "memory"); else asm volatile("s_waitcnt vmcnt(3)" ::: "memory"); } \
    else asm volatile("s_waitcnt vmcnt(0)" ::: "memory"); } while (0)
#define RESC(a) do { if (__any((a) < 1.f)) { if (hi == 0) al_l[r32] = (a); asm volatile("s_waitcnt lgkmcnt(0)" ::: "memory"); \
    _Pragma("unroll") for (int d = 0; d < 4; ++d) _Pragma("unroll") for (int r = 0; r < 16; ++r) o[d][r] *= al_l[crow(r, hi)]; } } while (0)
    f32x16 pA0, pA1, pB0, pB1; float mnA, mnB, alA, alB; h8 pa0, pa1, pa2, pa3; constexpr int NT = seq / KVBLK;
    constexpr int SE = 0, SO = SDEPTH - 1;
    SLOAD(SE, 0); asm volatile("s_waitcnt vmcnt(0)" ::: "memory"); SWRITE(0, SE); __syncthreads();
    qkt<DQK>(pA0, pA1, K_lds, qr, r32, hi); partialSM<DQK>(pA0, pA1, m_reg, mnA, alA);
    SLOAD(SO, KVBLK); if constexpr (SDEPTH == 2) { if (2 < NT) SLOAD(SE, 2 * KVBLK); }
    SWAIT(); SWRITE(1, SO); __syncthreads();
    for (int j = 1; j + 1 < NT; j += 2) {
        SBAR(); qkt<DQK>(pB0, pB1, K_lds + SHM_K, qr, r32, hi);
        finishSM(pA0, pA1, alA, l_reg, pa0, pa1, pa2, pa3); SBAR();
        SLOAD(SO, (j + SDEPTH) * KVBLK); SBAR();
        pv_d0(o, vb0, pa0, pa1, pa2, pa3); partialSM<DQK>(pB0, pB1, m_reg, mnB, alB);
        __syncthreads(); SWAIT(); SWRITE(0, SE);
        RESC(alB); __syncthreads();
        SBAR(); qkt<DQK>(pA0, pA1, K_lds, qr, r32, hi);
        finishSM(pB0, pB1, alB, l_reg, pa0, pa1, pa2, pa3); SBAR();
        if (SDEPTH == 1 || j + 3 < NT) SLOAD(SE, (j + 1 + SDEPTH) * KVBLK); SBAR();
        pv_d0(o, vb0 + (int)SHM_V, pa0, pa1, pa2, pa3); partialSM<DQK>(pA0, pA1, m_reg, mnA, alA);
        __syncthreads(); SWAIT(); SWRITE(1, SO);
        RESC(alA); __syncthreads();
    }
    SBAR(); qkt<DQK>(pB0, pB1, K_lds + SHM_K, qr, r32, hi);
    finishSM(pA0, pA1, alA, l_reg, pa0, pa1, pa2, pa3); SBAR();
    pv_d0(o, vb0, pa0, pa1, pa2, pa3); partialSM<DQK>(pB0, pB1, m_reg, mnB, alB);
    __syncthreads(); RESC(alB);
    finishSM(pB0, pB1, alB, l_reg, pa0, pa1, pa2, pa3); SBAR();
    pv_d0(o, vb0 + (int)SHM_V, pa0, pa1, pa2, pa3);
    if (hi == 0) li_l[r32] = l_reg; asm volatile("s_waitcnt lgkmcnt(0)" ::: "memory");
    float rli[16];
#pragma unroll
    for (int r = 0; r < 16; ++r) rli[r] = __builtin_amdgcn_rcpf(li_l[crow(r, hi)]);
    attn_epilogue<LDO>(o, rli, Ob + (long)(wid * QBLK) * LDO, mode, lam, subln, r32, hi);
    asm volatile("s_waitcnt vmcnt(0) lgkmcnt(0)" ::: "memory");
    __syncthreads();
#undef SLOAD
#undef SWRITE
#undef SWAIT
#undef RESC
}

struct ConvStream {
    const float* win; const float* wout; f16* tin; f16* tout;
    int step, step_end, it, period;
    unsigned d[8]; f16* pend;
    char* acc; f16* dst0; int nacc;
};
constexpr int CONV_STEPS_IN = 16 * 64 * 128, CONV_STEPS_OUT = 16 * 16 * 256, CONV_STEPS = CONV_STEPS_IN + CONV_STEPS_OUT;
__device__ __forceinline__ void conv_drain(ConvStream& c, int lane) {
    if (c.nacc > 0) {
        asm volatile("s_waitcnt lgkmcnt(0)" ::: "memory");
        for (int q = 0; q < c.nacc; ++q) { const h8 v = *(const h8*)(c.acc + q * 1024 + lane * 16); *(h8*)(c.dst0 + q * 8) = v; }
        c.nacc = 0; }
}
__device__ __forceinline__ void conv_flush(ConvStream& c, int lane) {
    if (c.pend) { h8 o;
#pragma unroll
        for (int i = 0; i < 8; ++i) o[i] = (f16)__uint_as_float(c.d[i]);
        if (c.nacc == 0) c.dst0 = c.pend;
        *(h8*)(c.acc + c.nacc * 1024 + lane * 16) = o; ++c.nacc; c.pend = nullptr;
        if (c.nacc == 4) conv_drain(c, lane); }
}
__device__ __forceinline__ void conv_tick(ConvStream& c, int lane) {
    const bool go = ((c.it & (c.period - 1)) < 3) && (c.step < c.step_end); ++c.it;
    if (go) { const int s = c.step++;
        const float* src; f16* dst; int N;
        if (s < CONV_STEPS_IN) { const int strip = s >> 7, kb = s & 127, e = strip >> 6, n = (strip & 63) * 64 + lane; const int f = n & 2047, dr = (f >> 2) * 8 + (f & 3) + ((n >> 11) << 2);
            src = c.win + ((size_t)e * 1024 + kb * 8) * 4096 + n; dst = c.tin + ((size_t)e * 4096 + dr) * 1024 + kb * 8; N = 4096; }
        else { const int s2 = s - CONV_STEPS_IN; const int strip = s2 >> 8, kb = s2 & 255, e = strip >> 4, n = (strip & 15) * 64 + lane;
            src = c.wout + ((size_t)e * 2048 + kb * 8) * 1024 + n; dst = c.tout + ((size_t)e * 1024 + n) * 2048 + kb * 8; N = 1024; }
        if ((s & 3) == 0) conv_drain(c, lane);
#pragma unroll
        for (int i = 0; i < 8; ++i) c.d[i] = __float_as_uint(src[(size_t)i * N]);
        c.pend = dst; }
}
__device__ __forceinline__ void conv_init(ConvStream& cs, const float* win, const float* wout, f16* tin, f16* tout, int l, int gw, int NGW, int period, char* acc) {
    cs.acc = acc; cs.nacc = 0; cs.dst0 = nullptr;
    cs.win = win + (size_t)l * NE * 1024 * 4096; cs.wout = wout + (size_t)l * NE * 2048 * 1024; cs.tin = tin + (size_t)l * NE * 4096 * 1024; cs.tout = tout + (size_t)l * NE * 1024 * 2048;
    const int per = ((CONV_STEPS + NGW - 1) / NGW + 7) & ~7;
    cs.step = gw * per < CONV_STEPS ? gw * per : CONV_STEPS; cs.step_end = (gw + 1) * per < CONV_STEPS ? (gw + 1) * per : CONV_STEPS; cs.it = 0; cs.pend = nullptr; cs.period = period;
}
template <int DQK, int LDQ, int LDK, int LDV, int LDO, bool CONV = false>
__device__ __forceinline__ void attn_body_simple(const f16* Qb, const f16* Kh, const f16* Vh, f16* Ob, char* lds, int mode = 0, float lam = 0.f, const float* subln = nullptr, ConvStream* cs = nullptr) {
    using C = Cfg<DQK>;
    constexpr int KRB = C::KRB, ND0 = C::ND0, NKCH = C::NKCH, KCPR = C::KCPR; constexpr size_t SHM_K = C::SHM_K;
    int tid = threadIdx.x; asm volatile("" : "+v"(tid));
    const int wid = tid >> 6, lane = tid & 63, r32 = lane & 31, hi = lane >> 5;
    char* V_lds = lds; char* K_lds = lds + 2 * SHM_V;
    float* wsl = (float*)(lds + 2 * SHM_V + 2 * SHM_K) + wid * 64; float* li_l = wsl; float* al_l = wsl + 32;
    float m_reg = -1e30f, l_reg = 0; f32x16 o[4] = {}; h8 qr[ND0];
    const f16* Qw = Qb + (long)(wid * QBLK + r32) * LDQ + hi * 8;
#pragma unroll
    for (int d0 = 0; d0 < ND0; ++d0) qr[d0] = *reinterpret_cast<const h8*>(Qw + d0 * 16);
    const int sr = tid >> 4, sc = (tid & 15) * 8, vst0 = v_st(sr, sc), vst1 = v_st(32 + sr, sc);
    int krow[NKCH], kcb[NKCH];
#pragma unroll
    for (int i = 0; i < NKCH; ++i) { const int c = tid + i * 512; krow[i] = c / KCPR; kcb[i] = (c % KCPR) * 16; }
    const int vb0 = (int)(uintptr_t)V_lds + v_rd_base(lane);
    h8 vs0, vs1, ks[NKCH];
#define SLOAD1(k0) do { vs0 = *reinterpret_cast<const h8*>(&Vh[(long)((k0) + sr) * LDV + sc]); vs1 = *reinterpret_cast<const h8*>(&Vh[(long)((k0) + 32 + sr) * LDV + sc]); \
    _Pragma("unroll") for (int _c = 0; _c < NKCH; ++_c) ks[_c] = *reinterpret_cast<const h8*>((const char*)Kh + (long)((k0) + krow[_c]) * (LDK * 2) + kcb[_c]); } while (0)
#define SWRITE1(b) do { *(h8*)(V_lds + (b) * SHM_V + vst0) = vs0; *(h8*)(V_lds + (b) * SHM_V + vst1) = vs1; \
    _Pragma("unroll") for (int _c = 0; _c < NKCH; ++_c) *(h8*)(K_lds + (b) * SHM_K + KSWZ(krow[_c], kcb[_c])) = ks[_c]; } while (0)
    constexpr int NT = SEQ / KVBLK;
    SLOAD1(0); asm volatile("s_waitcnt vmcnt(0)" ::: "memory"); SWRITE1(0); __syncthreads();
#pragma unroll 1
    for (int j = 0; j < NT; ++j) {
        const int cb = j & 1;
        if constexpr (CONV) conv_tick(*cs, lane);
        if (j + 1 < NT) SLOAD1((j + 1) * KVBLK);
        SBAR();
        f32x16 p0, p1; float mn, al; h8 pa0, pa1, pa2, pa3;
        qkt<DQK>(p0, p1, K_lds + cb * SHM_K, qr, r32, hi);
        partialSM<DQK>(p0, p1, m_reg, mn, al);
        if (__any(al < 1.f)) { if (hi == 0) al_l[r32] = al; asm volatile("s_waitcnt lgkmcnt(0)" ::: "memory");
#pragma unroll
            for (int d = 0; d < 4; ++d)
#pragma unroll
                for (int r = 0; r < 16; ++r) o[d][r] *= al_l[crow(r, hi)]; }
        finishSM(p0, p1, al, l_reg, pa0, pa1, pa2, pa3); SBAR();
        pv_d0(o, vb0 + cb * (int)SHM_V, pa0, pa1, pa2, pa3);
        if (j + 1 < NT) { SWRITE1(cb ^ 1); }
        if constexpr (CONV) conv_flush(*cs, lane);
        __syncthreads();
    }
    if (hi == 0) li_l[r32] = l_reg; asm volatile("s_waitcnt lgkmcnt(0)" ::: "memory");
    float rli[16];
#pragma unroll
    for (int r = 0; r < 16; ++r) rli[r] = __builtin_amdgcn_rcpf(li_l[crow(r, hi)]);
    attn_epilogue<LDO>(o, rli, Ob + (long)(wid * QBLK) * LDO, mode, lam, subln, r32, hi);
    asm volatile("s_waitcnt vmcnt(0) lgkmcnt(0)" ::: "memory");
    __syncthreads();
#undef SLOAD1
#undef SWRITE1
}
#undef KSWZ
#undef SBAR
}

struct Args { const void* in[22]; float* out; unsigned char* ws; int ph_lo, ph_hi, li, pad; };
typedef const __attribute__((address_space(4))) Args* KArgs;
__device__ __forceinline__ KArgs kargs() { KArgs p = (KArgs)__builtin_amdgcn_kernarg_segment_ptr(); asm volatile("" : "+s"(p)); return p; }
struct Frame {
    LAS unsigned char* lds; char* ldsg;
    int tid, lane, wave, vcu, G;
    unsigned char* ws;
};
extern __shared__ __attribute__((aligned(16))) unsigned char g_lds[];
__device__ __forceinline__ Frame mkframe(KArgs a) {
    Frame F; int t = threadIdx.x; asm volatile("" : "+v"(t));
    F.lds = (LAS unsigned char*)g_lds; F.ldsg = (char*)g_lds;
    F.tid = t; F.lane = t & 63; F.wave = __builtin_amdgcn_readfirstlane(t >> 6);
    int g = gridDim.x, bx = blockIdx.x; asm volatile("" : "+s"(g), "+s"(bx));
    F.G = g; F.vcu = (g % 8 == 0) ? (bx % 8) * (g / 8) + bx / 8 : bx;
    F.ws = a->ws;
    return F;
}

__device__ __forceinline__ void sincos_d(double a, float& s, float& c) {
    const double k = __builtin_rint(a * 0.63661977236758134308);
    double r = __builtin_fma(-k, 1.57079632679489655800e+00, a); r = __builtin_fma(-k, 6.12323399573676603587e-17, r);
    const double r2 = r * r;
    double sp = -7.6471637318198164759e-13;
    sp = __builtin_fma(sp, r2, 1.6059043836821614599e-10);
    sp = __builtin_fma(sp, r2, -2.5052108385441718775e-08);
    sp = __builtin_fma(sp, r2, 2.7557319223985890653e-06);
    sp = __builtin_fma(sp, r2, -1.9841269841269841270e-04);
    sp = __builtin_fma(sp, r2, 8.3333333333333333333e-03);
    sp = __builtin_fma(sp, r2, -1.6666666666666666667e-01);
    const double sr = __builtin_fma(sp * r2, r, r);
    double cp = 4.7794773323873852974e-14;
    cp = __builtin_fma(cp, r2, -1.1470745597729724714e-11);
    cp = __builtin_fma(cp, r2, 2.0876756987868098979e-09);
    cp = __builtin_fma(cp, r2, -2.7557319223985890653e-07);
    cp = __builtin_fma(cp, r2, 2.4801587301587301587e-05);
    cp = __builtin_fma(cp, r2, -1.3888888888888888889e-03);
    cp = __builtin_fma(cp, r2, 4.1666666666666666667e-02);
    cp = __builtin_fma(cp, r2, -0.5);
    const double cr = __builtin_fma(cp, r2, 1.0);
    const int q = (int)((long long)k & 3);
    const double ss = (q & 1) ? cr : sr, cc = (q & 1) ? sr : cr;
    s = (float)((q & 2) ? -ss : ss); c = (float)(((q + 1) & 2) ? -cc : cc);
}
__device__ const double INV_M[32] = {
    1.0, 0.7498942093324559, 0.5623413251903491, 0.4216965034285822, 0.31622776601683794, 0.23713737056616552, 0.1778279410038923, 0.1333521432163324,
    0.1, 0.07498942093324558, 0.05623413251903491, 0.04216965034285822, 0.03162277660168379, 0.023713737056616554, 0.01778279410038923, 0.01333521432163324,
    0.01, 0.007498942093324559, 0.005623413251903491, 0.004216965034285822, 0.0031622776601683794, 0.0023713737056616554, 0.001778279410038923, 0.001333521432163324,
    0.001, 0.0007498942093324559, 0.0005623413251903491, 0.0004216965034285822, 0.00031622776601683794, 0.00023713737056616554, 0.0001778279410038923, 0.0001333521432163324 };
__device__ const double INV_D[8] = { 1.0, 0.19392274474868576, 0.03760603093086393, 0.007292664737217109, 0.001414213562373095, 0.0002742481756762073, 5.318295896944988e-05, 1.031338537721246e-05 };

template <class FD>
__device__ __forceinline__ void tr_item64(const float* W, int Nsrc, int K, f16* WT, FD dstrow, LAS float* scr, int kb, int cb, int lane, const float* kscale = nullptr) {
    const int k0 = 64 * kb, c0 = 64 * cb, r4 = lane >> 4, cq = (lane & 15) * 4;
    f32x4 v[16];
#pragma unroll
    for (int i = 0; i < 16; ++i) v[i] = *(const f32x4*)(W + (size_t)(k0 + 4 * i + r4) * Nsrc + c0 + cq);
    if (kscale) {
#pragma unroll
        for (int i = 0; i < 16; ++i) v[i] = v[i] * kscale[k0 + 4 * i + r4]; }
#pragma unroll
    for (int i = 0; i < 16; ++i) { const int k = 4 * i + r4, sw = (i >> 1) * 4;
#pragma unroll
        for (int w = 0; w < 4; ++w) scr[k * 64 + ((cq + w) ^ sw)] = v[i][w]; }
    LDS_WAIT(); asm volatile("" ::: "memory");
    const int c = lane & 7;
#pragma unroll
    for (int j = 0; j < 8; ++j) { const int col = (lane >> 3) + 8 * j; const int dr = dstrow(c0 + col); const LAS float* sp = scr + (8 * c) * 64 + (col ^ (c * 4));
        h8 o; o[0] = (f16)sp[0 * 64]; o[1] = (f16)sp[1 * 64]; o[2] = (f16)sp[2 * 64]; o[3] = (f16)sp[3 * 64]; o[4] = (f16)sp[4 * 64]; o[5] = (f16)sp[5 * 64]; o[6] = (f16)sp[6 * 64]; o[7] = (f16)sp[7 * 64];
        *(h8*)(WT + (size_t)dr * K + k0 + 8 * c) = o; }
    LDS_WAIT(); asm volatile("" ::: "memory");
}
struct RowId { __device__ __forceinline__ int operator()(int c) const { return c; } };
struct RowWin0 { __device__ __forceinline__ int operator()(int c) const { if (c < 640) return c; const int jj = c - 640; return 640 + 2 * (jj & 31) + (jj >> 5); } };
struct RowUq { __device__ __forceinline__ int operator()(int c) const { const int h = c / 192, j = c % 192; if (j < 128) return h * 128 + j; const int jj = j - 128; return 1024 + h * 64 + 2 * (jj & 31) + (jj >> 5); } };
struct RowDiff { __device__ __forceinline__ int operator()(int c) const { if (c >= 2048) return c; const int off = c & 63; if (off >= 16) return c; return (c & ~63) + 2 * (off & 7) + (off >> 3); } };
struct RowMoeIn { __device__ __forceinline__ int operator()(int c) const { const int f = c & 2047; return (f >> 2) * 8 + (f & 3) + ((c >> 11) << 2); } };

__device__ __forceinline__ void p0_prologue() {
    const KArgs a = kargs(); const Frame F = mkframe(a);
    const int tid = F.tid, lane = F.lane;
    {
        const float* cin = (const float*)a->in[1]; const float* ada_w = (const float*)a->in[3]; const float* ada_b = (const float*)a->in[4];
        float* mods = (float*)(F.ws + WS_MODS);
        LAS float* sc = (LAS float*)F.lds; LAS float* red = (LAS float*)(F.lds + 16384);
        for (int i = tid; i < 4096; i += NTHREADS) { const float v = cin[i]; sc[i] = v / (1.0f + __expf(-v)); }
        __syncthreads();
        for (int cb = blockIdx.x; cb < 256; cb += F.G) {
            const int f0 = cb * 48, l = f0 / 6144, e0 = f0 % 6144; const int g = tid / 12, cc = tid % 12;
            if (g < 40) { f32x4 a0 = {0.f, 0.f, 0.f, 0.f}, a1 = a0, a2 = a0, a3 = a0; const float* wp = ada_w + (size_t)l * 1024 * 6144 + e0 + 4 * cc;
                f32x4 w[26];
#pragma unroll
                for (int i = 0; i < 26; ++i) { const int d = g + 40 * i; w[i] = (d < 1024) ? *(const f32x4*)(wp + (size_t)d * 6144) : (f32x4){0.f, 0.f, 0.f, 0.f}; }
#pragma unroll
                for (int i = 0; i < 26; ++i) { const int d = (g + 40 * i) & 1023; a0 += w[i] * sc[d]; a1 += w[i] * sc[1024 + d]; a2 += w[i] * sc[2048 + d]; a3 += w[i] * sc[3072 + d]; }
                LAS f32x4* rp = (LAS f32x4*)red + (g * 12 + cc) * 4; rp[0] = a0; rp[1] = a1; rp[2] = a2; rp[3] = a3; }
            __syncthreads();
            if (tid < 192) { const int c2 = tid % 48, b = tid / 48; float s = 0.f;
#pragma unroll 8
                for (int gg = 0; gg < 40; ++gg) s += red[((gg * 12 + (c2 >> 2)) * 4 + b) * 4 + (c2 & 3)];
                mods[(size_t)(l * 4 + b) * 6144 + e0 + c2] = s + ada_b[l * 6144 + e0 + c2]; }
            __syncthreads();
        }
    }
    {
        const int* pos = (const int*)a->in[2];
        float* cosm = (float*)(F.ws + WS_COSM); float* sinm = (float*)(F.ws + WS_SINM); float* cosd = (float*)(F.ws + WS_COSD); float* sind = (float*)(F.ws + WS_SIND);
        for (int i = blockIdx.x * NTHREADS + tid; i < T * 40; i += F.G * NTHREADS) {
            const int t = i / 40, j = i % 40; const double p = (double)pos[t]; float s, c;
            if (j < 32) { sincos_d(p * INV_M[j], s, c); cosm[(size_t)t * 32 + j] = c; sinm[(size_t)t * 32 + j] = s; }
            else { sincos_d(p * INV_D[j - 32], s, c); cosd[(size_t)t * 8 + (j - 32)] = c; sind[(size_t)t * 8 + (j - 32)] = s; }
        }
    }
    {
        LAS float* scr = (LAS float*)(F.lds + F.wave * 16384);
        const int gw = F.vcu * NWAVES + F.wave, NGW = F.G * NWAVES;
        { f16* z = (f16*)(F.ws + WS_WIN0) + (size_t)704 * 1024; for (int i = blockIdx.x * NTHREADS + tid; i < 8192; i += F.G * NTHREADS) *(u32x4*)(z + (size_t)i * 8) = (u32x4){0u, 0u, 0u, 0u}; }
        __syncthreads();
        constexpr int I0 = 16 * 11, I1 = 6 * 24, I2 = 4 * 32, I3 = 16 * 16, I4 = 16 * 48, I5 = 16 * 16;
        constexpr int ISM = I0 + I1 + I2 + I3 + I4 + I5;
        constexpr int IMI = 16 * 64, IMO = 32 * 16;
        constexpr int NITEMS = ISM;
        for (int it = gw; it < NITEMS; it += NGW) {
            int r = it;
            if (r < I0) { tr_item64((const float*)a->in[9], 704, 1024, (f16*)(F.ws + WS_WIN0), RowWin0(), scr, r / 11, r % 11, lane); continue; } r -= I0;
            if (r < I1) { tr_item64((const float*)a->in[12], 1536, 384, (f16*)(F.ws + WS_WUQ), RowUq(), scr, r / 24, r % 24, lane, (const float*)a->in[10]); continue; } r -= I1;
            if (r < I2) { tr_item64((const float*)a->in[13], 2048, 256, (f16*)(F.ws + WS_WUKV), RowId(), scr, r / 32, r % 32, lane, (const float*)a->in[11]); continue; } r -= I2;
            if (r < I3) { tr_item64((const float*)a->in[14], 1024, 1024, (f16*)(F.ws + WS_WO0), RowId(), scr, r / 16, r % 16, lane); continue; } r -= I3;
            if (r < I4) { tr_item64((const float*)a->in[15], 3072, 1024, (f16*)(F.ws + WS_WIN1), RowDiff(), scr, r / 48, r % 48, lane); continue; } r -= I4;
            if (r < I5) { tr_item64((const float*)a->in[18], 1024, 1024, (f16*)(F.ws + WS_WO1), RowId(), scr, r / 16, r % 16, lane); continue; }
        }
    }
}

__device__ __forceinline__ void mod_rows_p1() {
    const KArgs a = kargs(); const Frame F = mkframe(a);
    const float* x = (const float*)a->in[0]; const float* mods_l = (const float*)(F.ws + WS_MODS); f16* out = (f16*)(F.ws + WS_HA);
    const int gw = F.vcu * NWAVES + F.wave, NGW = F.G * NWAVES, lane = F.lane;
    for (int m0 = gw; m0 < T; m0 += 2 * NGW) {
        f32x4 v[2][4];
#pragma unroll
        for (int u = 0; u < 2; ++u) { const int m = m0 + u * NGW; if (m < T) {
#pragma unroll
            for (int j = 0; j < 4; ++j) v[u][j] = *(const f32x4*)(x + (size_t)m * DM + 4 * lane + 256 * j); } }
#pragma unroll
        for (int u = 0; u < 2; ++u) { const int m = m0 + u * NGW; if (m < T) { const float* mb = mods_l + (m >> 12) * 6144;
#pragma unroll
            for (int j = 0; j < 4; ++j) { const int c = 4 * lane + 256 * j; const f32x4 sh = *(const f32x4*)(mb + c), sc = *(const f32x4*)(mb + 1024 + c);
                const f32x4 h = v[u][j] * (sc + 1.0f) + sh; h4 o; o[0] = (f16)h[0]; o[1] = (f16)h[1]; o[2] = (f16)h[2]; o[3] = (f16)h[3];
                *(h4*)(out + (size_t)m * DM + c) = o; } } }
    }
}

#define RCOL(lane, j) ((((j) >> 1) << 9) + 8 * (lane) + 4 * ((j) & 1))
__device__ __forceinline__ void h8_to_f4(const h8 v, f32x4& a, f32x4& b) { a = (f32x4){(float)v[0], (float)v[1], (float)v[2], (float)v[3]}; b = (f32x4){(float)v[4], (float)v[5], (float)v[6], (float)v[7]}; }
__device__ __forceinline__ void ln_router(int l) {
    const KArgs a = kargs(); const Frame F = mkframe(a);
    const float* lng = (const float*)a->in[5] + l * DM; const float* lnb = (const float*)a->in[6] + l * DM; const float* router_w = (const float*)a->in[19] + (size_t)l * DM * NE;
    const float* mods_l = (const float*)(F.ws + WS_MODS) + (size_t)l * 4 * 6144;
    const f16* pre = (const f16*)(F.ws + WS_PRE); float* stat = (float*)(F.ws + WS_STAT); f16* hB = (f16*)(F.ws + WS_HB); float* aff = (float*)(F.ws + WS_AFF);
    LAS float* rwT = (LAS float*)F.lds;
    for (int i = F.tid; i < 16384; i += NTHREADS) { const int d = i >> 4, e = i & 15; const int seg = d >> 9, w = d & 511; rwT[e * 1024 + seg * 512 + ((w >> 2) & 1) * 256 + (w >> 3) * 4 + (w & 3)] = router_w[i]; }
    __syncthreads();
    const int gw = F.vcu * NWAVES + F.wave, NGW = F.G * NWAVES, lane = F.lane;
    for (int m0 = gw; m0 < T; m0 += 2 * NGW) {
        h8 pv[2][2];
#pragma unroll
        for (int u = 0; u < 2; ++u) { const int m = (m0 + u * NGW < T) ? m0 + u * NGW : m0; pv[u][0] = *(const h8*)(pre + (size_t)m * DM + 8 * lane); pv[u][1] = *(const h8*)(pre + (size_t)m * DM + 512 + 8 * lane); }
#pragma unroll
        for (int u = 0; u < 2; ++u) { const int m = m0 + u * NGW; if (m < T) {
        const int b = m >> 12, s_ = m & 4095; const float* mb = mods_l + b * 6144;
        f32x4 v[4]; h8_to_f4(pv[u][0], v[0], v[1]); h8_to_f4(pv[u][1], v[2], v[3]); float s = 0.f;
#pragma unroll
        for (int j = 0; j < 4; ++j) s += (v[j][0] + v[j][1]) + (v[j][2] + v[j][3]);
        const float mean = wave_sum(s) * (1.f / DM); float s2 = 0.f;
#pragma unroll
        for (int j = 0; j < 4; ++j) { v[j] = v[j] - mean; s2 += (v[j][0] * v[j][0] + v[j][1] * v[j][1]) + (v[j][2] * v[j][2] + v[j][3] * v[j][3]); }
        const float rstd = 1.0f / sqrtf(wave_sum(s2) * (1.f / DM) + LN_EPS);
        if (lane == 0) { f32x2 st = {mean, rstd}; *(f32x2*)(stat + (size_t)m * 2) = st; }
        float lg[16];
#pragma unroll
        for (int e = 0; e < 16; ++e) lg[e] = 0.f;
        f32x4 hh[4];
#pragma unroll
        for (int j = 0; j < 4; ++j) { const int c = RCOL(lane, j);
            const f32x4 g = *(const f32x4*)(lng + c), bb = *(const f32x4*)(lnb + c), sh = *(const f32x4*)(mb + 3072 + c), sc = *(const f32x4*)(mb + 4096 + c);
            const f32x4 xn = v[j] * rstd * g + bb; const f32x4 h = xn * (sc + 1.0f) + sh; hh[j] = h;
#pragma unroll
            for (int e = 0; e < 16; ++e) { const f32x4 w = *(const LAS f32x4*)(rwT + e * 1024 + (j >> 1) * 512 + (j & 1) * 256 + lane * 4); lg[e] += (h[0] * w[0] + h[1] * w[1]) + (h[2] * w[2] + h[3] * w[3]); }
            asm volatile("" ::: "memory"); }
        *(h8*)(hB + (size_t)m * DM + 8 * lane) = pack8(hh[0], hh[1]); *(h8*)(hB + (size_t)m * DM + 512 + 8 * lane) = pack8(hh[2], hh[3]);
        float mx = -1e30f;
#pragma unroll
        for (int e = 0; e < 16; ++e) { lg[e] = wave_sum(lg[e]); mx = fmaxf(mx, lg[e]); }
        float den = 0.f;
#pragma unroll
        for (int e = 0; e < 16; ++e) { lg[e] = __expf(lg[e] - mx); den += lg[e]; }
        const float rden = 1.0f / den; float mine = 0.f;
#pragma unroll
        for (int e = 0; e < 16; ++e) mine = (lane == e) ? lg[e] * rden : mine;
        if (lane < 16) aff[(size_t)(b * 16 + lane) * SEQ + s_] = mine;
        } }
    }
    __syncthreads();
}

__device__ __forceinline__ int block_excl_scan(int v, LAS int* tmp, int tid, int& total) {
    const int lane = tid & 63, wid = tid >> 6; int x = v;
#pragma unroll
    for (int o = 1; o < 64; o <<= 1) { const int y = __shfl_up(x, o); if (lane >= o) x += y; }
    if (lane == 63) tmp[wid] = x;
    __syncthreads();
    int base = 0, tot = 0;
#pragma unroll
    for (int w = 0; w < 8; ++w) { const int t = tmp[w]; if (w < wid) base += t; tot += t; }
    __syncthreads();
    total = tot; return base + x - v;
}
__device__ __forceinline__ void topk_phase() {
    const KArgs a = kargs(); const Frame F = mkframe(a);
    const float* aff = (const float*)(F.ws + WS_AFF); float* gate = (float*)(F.ws + WS_GATE); int* rowtok = (int*)(F.ws + WS_ROWTOK); int* inv = (int*)(F.ws + WS_INV);
    LAS unsigned* hist = (LAS unsigned*)F.lds; LAS unsigned* selw = hist + 256; LAS int* tmp = (LAS int*)(hist + 272);
    const int tid = F.tid;
    for (int p = blockIdx.x; p < NB * NE; p += F.G) { const int b = p >> 4, e = p & 15;
        const float* ap = aff + (size_t)p * SEQ + 8 * tid; unsigned key[8];
        { const f32x4 a0 = *(const f32x4*)ap, a1 = *(const f32x4*)(ap + 4);
          key[0] = __float_as_uint(a0[0]); key[1] = __float_as_uint(a0[1]); key[2] = __float_as_uint(a0[2]); key[3] = __float_as_uint(a0[3]);
          key[4] = __float_as_uint(a1[0]); key[5] = __float_as_uint(a1[1]); key[6] = __float_as_uint(a1[2]); key[7] = __float_as_uint(a1[3]); }
        unsigned prefix = 0u, kk = CAP;
        for (int pass = 0; pass < 4; ++pass) { const int shift = 24 - 8 * pass;
            if (tid < 256) hist[tid] = 0u;
            __syncthreads();
#pragma unroll
            for (int j = 0; j < 8; ++j) { const bool match = (pass == 0) || ((key[j] >> (shift + 8)) == prefix); if (match) atomicAdd((unsigned*)&hist[(key[j] >> shift) & 255u], 1u); }
            __syncthreads();
            { const int hv = (tid < 256) ? (int)hist[255 - tid] : 0; int tot_; const int Sp = block_excl_scan(hv, tmp, tid, tot_);
              if (tid < 256 && (unsigned)Sp < kk && kk <= (unsigned)(Sp + hv)) { selw[0] = 255u - (unsigned)tid; selw[1] = kk - (unsigned)Sp; } }
            __syncthreads();
            prefix = (prefix << 8) | selw[0]; kk = selw[1];
            __syncthreads();
        }
        int ce = 0;
#pragma unroll
        for (int j = 0; j < 8; ++j) ce += (key[j] == prefix) ? 1 : 0;
        int tot; int eqr = block_excl_scan(ce, tmp, tid, tot);
        unsigned selm = 0u; int cs = 0;
#pragma unroll
        for (int j = 0; j < 8; ++j) { bool sel = key[j] > prefix; if (key[j] == prefix) { sel = (unsigned)eqr < kk; ++eqr; } if (sel) { selm |= 1u << j; ++cs; } }
        int slot = block_excl_scan(cs, tmp, tid, tot);
#pragma unroll
        for (int j = 0; j < 8; ++j) { const int s_ = 8 * tid + j; const int tok = b * SEQ + s_; const bool sel = (selm >> j) & 1u;
            if (sel) { const int row = e * EROWS + b * CAP + slot; rowtok[row] = tok; gate[row] = __uint_as_float(key[j]); inv[(size_t)tok * 16 + e] = slot; ++slot; }
            else inv[(size_t)tok * 16 + e] = -1; }
        __syncthreads();
    }
}
__device__ __forceinline__ void gather_rows() {
    const KArgs a = kargs(); const Frame F = mkframe(a);
    const int* rowtok = (const int*)(F.ws + WS_ROWTOK); const f16* hB = (const f16*)(F.ws + WS_HB); f16* xe = (f16*)(F.ws + WS_XE);
    const int gw = F.vcu * NWAVES + F.wave, NGW = F.G * NWAVES, lane = F.lane;
    for (int r0 = gw; r0 < MROWS; r0 += 4 * NGW) {
        int tok[4]; h8 d0[4], d1[4];
#pragma unroll
        for (int u = 0; u < 4; ++u) { const int r = r0 + u * NGW; tok[u] = (r < MROWS) ? rowtok[r] : 0; }
#pragma unroll
        for (int u = 0; u < 4; ++u) { d0[u] = *(const h8*)(hB + (size_t)tok[u] * DM + 8 * lane); d1[u] = *(const h8*)(hB + (size_t)tok[u] * DM + 512 + 8 * lane); }
#pragma unroll
        for (int u = 0; u < 4; ++u) { const int r = r0 + u * NGW; if (r < MROWS) { *(h8*)(xe + (size_t)r * DM + 8 * lane) = d0[u]; *(h8*)(xe + (size_t)r * DM + 512 + 8 * lane) = d1[u]; } }
    }
}
__device__ __forceinline__ void combine_ln(int l) {
    const KArgs a = kargs(); const Frame F = mkframe(a);
    const float* lng1 = (const float*)a->in[5] + l * DM; const float* lnb1 = (const float*)a->in[6] + l * DM;
    const float* lng = (const float*)a->in[7] + l * DM; const float* lnb = (const float*)a->in[8] + l * DM;
    const float* mods_l = (const float*)(F.ws + WS_MODS) + (size_t)l * 4 * 6144; const float* mods_next = (const float*)(F.ws + WS_MODS) + (size_t)4 * 6144;
    float* xo32 = a->out; f16* x2 = (f16*)(F.ws + WS_X2); f16* hA = (f16*)(F.ws + WS_HA);
    const f16* pre = (const f16*)(F.ws + WS_PRE); const float* stat = (const float*)(F.ws + WS_STAT); const f16* y = (const f16*)(F.ws + WS_Y); const int* inv = (const int*)(F.ws + WS_INV);
    const int gw = F.vcu * NWAVES + F.wave, NGW = F.G * NWAVES, lane = F.lane;
    for (int m0 = gw; m0 < T; m0 += 2 * NGW) {
        int myinv[2]; h8 pv[2][2]; f32x2 st[2];
#pragma unroll
        for (int u = 0; u < 2; ++u) { const int m = (m0 + u * NGW < T) ? m0 + u * NGW : m0; myinv[u] = inv[(size_t)m * 16 + (lane & 15)]; st[u] = *(const f32x2*)(stat + (size_t)m * 2);
            pv[u][0] = *(const h8*)(pre + (size_t)m * DM + 8 * lane); pv[u][1] = *(const h8*)(pre + (size_t)m * DM + 512 + 8 * lane); }
#pragma unroll
        for (int u = 0; u < 2; ++u) { const int m = m0 + u * NGW; if (m < T) {
        const int b = m >> 12; const float* mb = mods_l + b * 6144;
        f32x4 f[4];
#pragma unroll
        for (int j = 0; j < 4; ++j) f[j] = (f32x4){0.f, 0.f, 0.f, 0.f};
        unsigned mask = (unsigned)(__ballot(myinv[u] >= 0) & 0xFFFFull);
        while (mask) {
            const int e0 = __builtin_ctz(mask); mask &= mask - 1u; const bool two = mask != 0u; const int e1 = two ? __builtin_ctz(mask) : e0; mask &= mask - 1u;
            const int s0 = __shfl(myinv[u], e0), s1 = __shfl(myinv[u], e1);
            const f16* y0 = y + (size_t)(e0 * EROWS + b * CAP + s0) * DM; const f16* y1 = y + (size_t)(e1 * EROWS + b * CAP + s1) * DM;
            const h8 a00 = *(const h8*)(y0 + 8 * lane), a01 = *(const h8*)(y0 + 512 + 8 * lane), a10 = *(const h8*)(y1 + 8 * lane), a11 = *(const h8*)(y1 + 512 + 8 * lane);
            const float w1 = two ? 1.0f : 0.0f; f32x4 t0, t1;
            h8_to_f4(a00, t0, t1); f[0] += t0; f[1] += t1; h8_to_f4(a01, t0, t1); f[2] += t0; f[3] += t1;
            h8_to_f4(a10, t0, t1); f[0] += t0 * w1; f[1] += t1 * w1; h8_to_f4(a11, t0, t1); f[2] += t0 * w1; f[3] += t1 * w1;
        }
        f32x4 v[4]; h8_to_f4(pv[u][0], v[0], v[1]); h8_to_f4(pv[u][1], v[2], v[3]); float s = 0.f;
#pragma unroll
        for (int j = 0; j < 4; ++j) { const int c = RCOL(lane, j); const f32x4 g1 = *(const f32x4*)(lng1 + c), b1 = *(const f32x4*)(lnb1 + c), g2 = *(const f32x4*)(mb + 5120 + c);
            const f32x4 x1 = (v[j] - st[u][0]) * st[u][1] * g1 + b1;
            v[j] = x1 * ALPHA + (g2 + 1.0f) * f[j]; s += (v[j][0] + v[j][1]) + (v[j][2] + v[j][3]); }
        const float mean = wave_sum(s) * (1.f / DM); float s2 = 0.f;
#pragma unroll
        for (int j = 0; j < 4; ++j) { v[j] = v[j] - mean; s2 += (v[j][0] * v[j][0] + v[j][1] * v[j][1]) + (v[j][2] * v[j][2] + v[j][3] * v[j][3]); }
        const float rstd = 1.0f / sqrtf(wave_sum(s2) * (1.f / DM) + LN_EPS);
        f32x4 xn[4];
#pragma unroll
        for (int j = 0; j < 4; ++j) { const int c = RCOL(lane, j); const f32x4 g = *(const f32x4*)(lng + c), bb = *(const f32x4*)(lnb + c); xn[j] = v[j] * rstd * g + bb; }
        if (l == 0) {
            *(h8*)(x2 + (size_t)m * DM + 8 * lane) = pack8(xn[0], xn[1]); *(h8*)(x2 + (size_t)m * DM + 512 + 8 * lane) = pack8(xn[2], xn[3]);
            const float* mn = mods_next + b * 6144; f32x4 hv[4];
#pragma unroll
            for (int j = 0; j < 4; ++j) { const int c = RCOL(lane, j); const f32x4 sh = *(const f32x4*)(mn + c), sc = *(const f32x4*)(mn + 1024 + c); hv[j] = xn[j] * (sc + 1.0f) + sh; }
            *(h8*)(hA + (size_t)m * DM + 8 * lane) = pack8(hv[0], hv[1]); *(h8*)(hA + (size_t)m * DM + 512 + 8 * lane) = pack8(hv[2], hv[3]);
        } else {
#pragma unroll
            for (int j = 0; j < 4; ++j) *(f32x4*)(xo32 + (size_t)m * DM + RCOL(lane, j)) = xn[j];
        }
        } }
    }
}

__device__ __forceinline__ void attn_mla() {
    const KArgs a = kargs(); const Frame F = mkframe(a);
    const f16* Q = (const f16*)(F.ws + WS_Q); const f16* K = (const f16*)(F.ws + WS_K); const f16* V = (const f16*)(F.ws + WS_V); f16* O = (f16*)(F.ws + WS_O);
    att::ConvStream cs; att::conv_init(cs, (const float*)a->in[20], (const float*)a->in[21], (f16*)(F.ws + WS_MOEIN), (f16*)(F.ws + WS_MOEOUT), 0, F.vcu * NWAVES + F.wave, F.G * NWAVES, 4, F.ldsg + 83968 + F.wave * 4096);
    for (int u = F.vcu; u < NB * 8 * 16; u += F.G) { const int qb = u & 15, bh = u >> 4, h = bh & 7, b = bh >> 3;
        att::attn_body_simple<192, 1536, 1536, 1024, 1024, true>(Q + (size_t)(b * SEQ + qb * 256) * 1536 + h * 192, K + (size_t)(b * SEQ) * 1536 + h * 192, V + (size_t)(b * SEQ) * 1024 + h * 128,
                                                                 O + (size_t)(b * SEQ + qb * 256) * 1024 + h * 128, F.ldsg, 0, 0.f, nullptr, &cs); }
    while (cs.step < cs.step_end) { cs.it = 0; att::conv_tick(cs, F.lane); att::conv_flush(cs, F.lane); }
    att::conv_flush(cs, F.lane); att::conv_drain(cs, F.lane);
}
__device__ __forceinline__ void attn_diff() {
    const KArgs a = kargs(); const Frame F = mkframe(a);
    const f16* QKV = (const f16*)(F.ws + WS_QKV1); f16* O = (f16*)(F.ws + WS_O);
    const float* lamv = (const float*)a->in[16]; const float* subln = (const float*)a->in[17];
    const float l01 = wave_sum(lamv[F.lane] * lamv[64 + F.lane]), l23 = wave_sum(lamv[128 + F.lane] * lamv[192 + F.lane]);
    const float lam = expf(l01) - expf(l23) + LAMBDA_INIT;
    att::ConvStream cs; att::conv_init(cs, (const float*)a->in[20], (const float*)a->in[21], (f16*)(F.ws + WS_MOEIN), (f16*)(F.ws + WS_MOEOUT), 1, F.vcu * NWAVES + F.wave, F.G * NWAVES, 8, F.ldsg + 51200 + F.wave * 4096);
    for (int u = F.vcu; u < NB * 8 * 16; u += F.G) { const int qb = u & 15, bh = u >> 4, h = bh & 7, b = bh >> 3;
        f16* Ob = O + (size_t)(b * SEQ + qb * 256) * 1024 + h * 128; const f16* Vh = QKV + (size_t)(b * SEQ) * 3072 + 2048 + h * 128;
#pragma unroll 1
        for (int c = 0; c < 2; ++c) { const int hh = 2 * h + c;
            att::attn_body_simple<64, 3072, 3072, 3072, 1024, true>(QKV + (size_t)(b * SEQ + qb * 256) * 3072 + hh * 64, QKV + (size_t)(b * SEQ) * 3072 + 1024 + hh * 64, Vh, Ob, F.ldsg, c, lam, subln, &cs); } }
    cs.it = 0;
    while (cs.step < cs.step_end) { cs.it = 0; att::conv_tick(cs, F.lane); att::conv_flush(cs, F.lane); }
    att::conv_flush(cs, F.lane); att::conv_drain(cs, F.lane);
}

__device__ __forceinline__ void ph_gemm_lat() { const KArgs a = kargs(); const Frame F = mkframe(a);
    pg8::Gemm g{(const f16*)(F.ws + WS_HA), (const f16*)(F.ws + WS_WIN0), T, 768, 1024, 1 << 30, 0, nullptr}; pg8::StaticOrder S; S.init(T, 768, F.G, (int)blockIdx.x);
    EpiLat E{(f16*)(F.ws + WS_CQN), (f16*)(F.ws + WS_CKVN), (f16*)(F.ws + WS_K), (float*)(F.ws + WS_PQ), (float*)(F.ws + WS_PKV), (const float*)(F.ws + WS_COSM), (const float*)(F.ws + WS_SINM)}; pg8::gemm_phase<EpiLat>(F.lds, g, S, E); }
__device__ __forceinline__ void ph_gemm_q() { const KArgs a = kargs(); const Frame F = mkframe(a);
    pg8::Gemm g{(const f16*)(F.ws + WS_CQN), (const f16*)(F.ws + WS_WUQ), T, 1024, 384, 1 << 30, 0, nullptr}; pg8::StaticOrder S; S.init(T, 1024, F.G, (int)blockIdx.x);
    EpiQNope E{(f16*)(F.ws + WS_Q), (const float*)(F.ws + WS_PQ)}; pg8::gemm_phase<EpiQNope>(F.lds, g, S, E); }
__device__ __forceinline__ void ph_gemm_qr() { const KArgs a = kargs(); const Frame F = mkframe(a);
    pg8::Gemm g{(const f16*)(F.ws + WS_CQN), (const f16*)(F.ws + WS_WUQ) + (size_t)1024 * 384, T, 512, 384, 1 << 30, 0, nullptr}; pg8::StaticOrder S; S.init(T, 512, F.G, (int)blockIdx.x);
    EpiQRope E{(f16*)(F.ws + WS_Q), (const float*)(F.ws + WS_COSM), (const float*)(F.ws + WS_SINM), (const float*)(F.ws + WS_PQ)}; pg8::gemm_phase<EpiQRope>(F.lds, g, S, E); }
__device__ __forceinline__ void ph_gemm_kv() { const KArgs a = kargs(); const Frame F = mkframe(a);
    pg8::Gemm g{(const f16*)(F.ws + WS_CKVN), (const f16*)(F.ws + WS_WUKV), T, 2048, 256, 1 << 30, 0, nullptr}; pg8::StaticOrder S; S.init(T, 2048, F.G, (int)blockIdx.x);
    EpiKV E{(f16*)(F.ws + WS_K), (f16*)(F.ws + WS_V), (const float*)(F.ws + WS_PKV)}; pg8::gemm_phase<EpiKV>(F.lds, g, S, E); }
__device__ __forceinline__ void ph_gemm_o(int l) { const KArgs a = kargs(); const Frame F = mkframe(a);
    pg8::Gemm g{(const f16*)(F.ws + WS_O), (const f16*)(F.ws + (l == 0 ? WS_WO0 : WS_WO1)), T, 1024, 1024, 1 << 30, 0, nullptr}; pg8::StaticOrder S; S.init(T, 1024, F.G, (int)blockIdx.x);
    const float* gm = (const float*)(F.ws + WS_MODS) + (size_t)l * 4 * 6144 + 2048;
    if (l == 0) { EpiPre<false> E{a->in[0], gm, (f16*)(F.ws + WS_PRE)}; pg8::gemm_phase<EpiPre<false>>(F.lds, g, S, E); }
    else { EpiPre<true> E{(const void*)(F.ws + WS_X2), gm, (f16*)(F.ws + WS_PRE)}; pg8::gemm_phase<EpiPre<true>>(F.lds, g, S, E); } }
__device__ __forceinline__ void ph_gemm_diffin() { const KArgs a = kargs(); const Frame F = mkframe(a);
    pg8::Gemm g{(const f16*)(F.ws + WS_HA), (const f16*)(F.ws + WS_WIN1), T, 3072, 1024, 1 << 30, 0, nullptr}; pg8::StaticOrder S; S.init(T, 3072, F.G, (int)blockIdx.x);
    EpiDiffIn E{(f16*)(F.ws + WS_QKV1), (const float*)(F.ws + WS_COSD), (const float*)(F.ws + WS_SIND)}; pg8::gemm_phase<EpiDiffIn>(F.lds, g, S, E); }
__device__ __forceinline__ void ph_gemm_up(int l) { const KArgs a = kargs(); const Frame F = mkframe(a);
    pg8::Gemm g{(const f16*)(F.ws + WS_HB), (const f16*)(F.ws + WS_MOEIN) + (size_t)l * NE * 4096 * 1024, MROWS, 4096, 1024, EROWS / 256, (size_t)4096 * 1024, (const int*)(F.ws + WS_ROWTOK)}; pg8::StaticOrder S; S.init(MROWS, 4096, F.G, (int)blockIdx.x);
    EpiUp E{(f16*)(F.ws + WS_ACT)}; pg8::gemm_phase<EpiUp, true, true, true>(F.lds, g, S, E); }
__device__ __forceinline__ void ph_gemm_down(int l) { const KArgs a = kargs(); const Frame F = mkframe(a);
    pg8::Gemm g{(const f16*)(F.ws + WS_ACT), (const f16*)(F.ws + WS_MOEOUT) + (size_t)l * NE * 1024 * 2048, MROWS, 1024, 2048, EROWS / 256, (size_t)1024 * 2048, nullptr}; pg8::StaticOrder S; S.init(MROWS, 1024, F.G, (int)blockIdx.x);
    EpiDown E{(f16*)(F.ws + WS_Y), (const float*)(F.ws + WS_GATE)}; pg8::gemm_phase<EpiDown>(F.lds, g, S, E); }

constexpr int NPHASES = 24;
__global__ void __launch_bounds__(NTHREADS, 2) mk_fwd(Args args) {
    LAS unsigned char* ldsp = (LAS unsigned char*)g_lds;
    volatile LAS unsigned* MISC = (volatile LAS unsigned*)(ldsp + MISC_OFF);
    for (int u = threadIdx.x; u < (LDS_BYTES - LDSCTL_OFF) / 4; u += NTHREADS) ((LAS unsigned*)(ldsp + LDSCTL_OFF))[u] = 0u;
    __syncthreads();
    XcdBarrier bar = xcd_barrier_post((unsigned*)(args.ws + WS_CTL) + CW_BAR + args.li * XCD_BAR_WORDS, MISC + 8);
    const int lo = args.ph_lo, hi = args.ph_hi;
#ifndef PH_MASK
#define PH_MASK 0xFFFFFFFFu
#endif
#define IN(k) (((PH_MASK >> (k)) & 1u) && lo <= (k) && (k) < hi)
#define SEAM(k) do { if (lo <= (k) && (k) + 1 < hi) xcd_barrier(bar); } while (0)
#ifndef REP_MASK
#define REP_MASK 0u
#endif
#define RUN(k, call) do { if (IN(k)) { call; if ((REP_MASK >> (k)) & 1u) { __syncthreads(); call; } } } while (0)
    RUN(0, p0_prologue());      SEAM(0);
    RUN(1, mod_rows_p1());      SEAM(1);
    RUN(2, ph_gemm_lat());      SEAM(2);
    RUN(4, ph_gemm_q()); RUN(4, ph_gemm_qr());
    RUN(5, ph_gemm_kv());       SEAM(5);
    RUN(6, attn_mla());         SEAM(6);
#pragma unroll 1
    for (int l = 0; l < 2; ++l) {
        const int pb = (l == 0) ? 7 : 17;
        if (l == 1) {
            RUN(14, ph_gemm_diffin()); SEAM(14);
            RUN(15, attn_diff());      SEAM(15);
        }
        RUN(pb + 0, ph_gemm_o(l));     SEAM(pb + 0);
        RUN(pb + 1, ln_router(l));     SEAM(pb + 1);
        RUN(pb + 2, topk_phase());     SEAM(pb + 2);
        RUN(pb + 4, ph_gemm_up(l));    SEAM(pb + 4);
        RUN(pb + 5, ph_gemm_down(l));  SEAM(pb + 5);
        RUN(pb + 6, combine_ln(l));
        if (l == 0) SEAM(pb + 6);
    }
#undef IN
#undef SEAM
}

extern "C" void kernel_launch(void* const* d_in, const int* in_sizes, int n_in, void* d_out, int out_size, void* d_ws, size_t ws_size, hipStream_t stream) {
    static int grid = 0;
    if (grid == 0) {
        if (n_in != 22 || in_sizes[0] != T * DM || out_size != T * DM || ws_size < WS_END) {
            fprintf(stderr, "kernel_launch: shape/workspace mismatch: n_in %d in0 %d out %d ws %zu (need %zu)\n", n_in, n_in > 0 ? in_sizes[0] : -1, out_size, ws_size, (size_t)WS_END); grid = -1; return; }
        int dev = 0, cus = 0, per_cu = 0;
        if (hipGetDevice(&dev) != hipSuccess || hipDeviceGetAttribute(&cus, hipDeviceAttributeMultiprocessorCount, dev) != hipSuccess) { fprintf(stderr, "kernel_launch: device query failed\n"); grid = -1; return; }
        if (hipFuncSetAttribute((const void*)mk_fwd, hipFuncAttributeMaxDynamicSharedMemorySize, LDS_BYTES) != hipSuccess) { fprintf(stderr, "kernel_launch: hipFuncSetAttribute failed\n"); grid = -1; return; }
        if (hipOccupancyMaxActiveBlocksPerMultiprocessor(&per_cu, (const void*)mk_fwd, NTHREADS, LDS_BYTES) != hipSuccess || per_cu < 1)
            fprintf(stderr, "kernel_launch: note: occupancy query reports %d workgroups per CU\n", per_cu);
        (void)hipGetLastError();
        grid = cus;
    }
    if (grid < 0) return;
    if (hipMemsetAsync((char*)d_ws + WS_CTL, 0, CTL_ZERO_BYTES, stream) != hipSuccess) { fprintf(stderr, "kernel_launch: memset failed\n"); return; }
    Args a{};
    for (int i = 0; i < 22; ++i) a.in[i] = d_in[i];
    a.out = (float*)d_out; a.ws = (unsigned char*)d_ws;
#if MK_CUTS == 1
    a.ph_lo = 0; a.ph_hi = NPHASES; a.li = 0;
    hipLaunchKernelGGL(mk_fwd, dim3(grid), dim3(NTHREADS), LDS_BYTES, stream, a);
#else
    for (int p = 0; p < NPHASES; ++p) { a.ph_lo = p; a.ph_hi = p + 1; a.li = 0; hipLaunchKernelGGL(mk_fwd, dim3(grid), dim3(NTHREADS), LDS_BYTES, stream, a); }
#endif
    const hipError_t le = hipPeekAtLastError();
    if (le != hipSuccess) fprintf(stderr, "kernel_launch: launch failed: %s\n", hipGetErrorName(le));
}
```

```cpp
#include <hip/hip_runtime.h>
#include <cstdio>
#include <cstdint>

#ifndef MK_CUTS
#define MK_CUTS 1
#endif


#define LAS __attribute__((address_space(3)))
#define GAS __attribute__((address_space(1)))
typedef _Float16 f16;
typedef _Float16 h8 __attribute__((ext_vector_type(8)));
typedef _Float16 h4 __attribute__((ext_vector_type(4)));
typedef _Float16 h2 __attribute__((ext_vector_type(2)));
typedef short s16x4 __attribute__((ext_vector_type(4)));
typedef float f32x4 __attribute__((ext_vector_type(4)));
typedef float f32x2 __attribute__((ext_vector_type(2)));
typedef float f32x16 __attribute__((ext_vector_type(16)));
typedef unsigned u32x4 __attribute__((ext_vector_type(4)));
typedef unsigned u32x2 __attribute__((ext_vector_type(2)));

constexpr int NB = 4, SEQ = 4096, DM = 1024, T = NB * SEQ;
constexpr int NE = 16, FF = 2048, CAP = 512, EROWS = NB * CAP;
constexpr int MROWS = NE * EROWS;
constexpr float ALPHA = 1.4142135623730951f;
constexpr float LN_EPS = 1e-5f, LAT_EPS = 1e-6f;
constexpr float LAMBDA_INIT = 0.35550906759096926f;
constexpr int NWAVES = 8, NTHREADS = 512;

constexpr size_t MiB = 1u << 20;
constexpr size_t WS_CTL = 0, CTL_ZERO_BYTES = 1 * MiB;
constexpr size_t WS_MODS = 1 * MiB;
constexpr size_t WS_COSM = 2 * MiB, WS_SINM = 4 * MiB;
constexpr size_t WS_COSD = 6 * MiB, WS_SIND = 6 * MiB + 512 * 1024;
constexpr size_t WS_AFF = 7 * MiB;
constexpr size_t WS_GATE = 8 * MiB;
constexpr size_t WS_ROWTOK = 8 * MiB + 512 * 1024;
constexpr size_t WS_INV = 9 * MiB;
constexpr size_t WS_WIN0 = 16 * MiB;
constexpr size_t WS_WUQ = 18 * MiB;
constexpr size_t WS_WUKV = 20 * MiB;
constexpr size_t WS_WO0 = 22 * MiB;
constexpr size_t WS_WIN1 = 24 * MiB;
constexpr size_t WS_WO1 = 30 * MiB;
constexpr size_t WS_MOEIN = 32 * MiB;
constexpr size_t WS_MOEOUT = 288 * MiB;
constexpr size_t WS_HA = 416 * MiB;
constexpr size_t WS_HB = 448 * MiB;
constexpr size_t WS_PQ = 480 * MiB;
constexpr size_t WS_PKV = 481 * MiB;
constexpr size_t WS_CQN = 528 * MiB;
constexpr size_t WS_CKVN = 540 * MiB;
constexpr size_t WS_Q = 548 * MiB;
constexpr size_t WS_K = 596 * MiB;
constexpr size_t WS_V = 644 * MiB;
constexpr size_t WS_O = 676 * MiB;
constexpr size_t WS_PRE = 708 * MiB;
constexpr size_t WS_STAT = 772 * MiB;
constexpr size_t WS_X2 = 836 * MiB;
constexpr size_t WS_XE = 900 * MiB;
constexpr size_t WS_ACT = 964 * MiB;
constexpr size_t WS_Y = 1092 * MiB;
constexpr size_t WS_QKV1 = 1156 * MiB;
constexpr size_t WS_OD = 1252 * MiB;
constexpr size_t WS_END = 1316 * MiB;
constexpr int CW_BAR = 4096;

constexpr int RING_BYTES = 131072;
constexpr int LDSCTL_OFF = RING_BYTES, MISC_OFF = LDSCTL_OFF + 320;
constexpr int LDS_BYTES = 147456;

#define LDS_WAIT() asm volatile("s_waitcnt lgkmcnt(0)" ::: "memory")
#define VM_WAIT() asm volatile("s_waitcnt vmcnt(0)" ::: "memory")

__device__ __forceinline__ float wave_sum(float v) {
#pragma unroll
    for (int o = 1; o < 64; o <<= 1) v += __shfl_xor(v, o);
    return v;
}

#define XB_TMO      128
#define XB_XCNT(j)  (256  + 64 * (j))
#define XB_XSUB(j)  (1280 + 64 * (j))
#define XB_XGEN(j)  (2304 + 64 * (j))
#define XB_TOP      3328
#define XB_TOPGEN   3392
#define XCD_BAR_WORDS 3456
#define XB_SPIN_CAP (1u << 20)
__device__ __forceinline__ unsigned xb_ld(unsigned* p)              { return __hip_atomic_load(p, __ATOMIC_RELAXED, __HIP_MEMORY_SCOPE_AGENT); }
__device__ __forceinline__ unsigned xb_add(unsigned* p, unsigned v) { return __hip_atomic_fetch_add(p, v, __ATOMIC_RELAXED, __HIP_MEMORY_SCOPE_AGENT); }
__device__ __forceinline__ unsigned xb_xcc_id() { return (unsigned)__builtin_amdgcn_s_getreg((3 << 11) | 20) & 0xFu; }
#define XB_SPIN(cond, bar) do { unsigned _sp = 0; while (cond) { __builtin_amdgcn_s_sleep(1); \
    if ((++_sp & 255u) == 0u) { if (xb_ld(&(bar)[XB_TMO])) break; if (_sp > XB_SPIN_CAP) { atomicAdd(&(bar)[XB_TMO], 1u); break; } } } } while (0)
struct XcdBarrier { unsigned* bar; unsigned x; volatile LAS unsigned* st; };
__device__ __forceinline__ XcdBarrier xcd_barrier_post(unsigned* bar, volatile LAS unsigned* st) {
    XcdBarrier b; b.bar = bar; b.x = xb_xcc_id(); b.st = st;
    if (threadIdx.x == 0) (void)xb_add(&bar[XB_XCNT(b.x)], 1u);
    return b;
}
__device__ __forceinline__ void xcd_barrier_complete(unsigned* bar, unsigned x, unsigned& nloc, unsigned& nx) {
    const unsigned G = gridDim.x * gridDim.y * gridDim.z;
    unsigned sum, cnt, mine, sp = 0u;
    for (;;) {
        sum = 0u; cnt = 0u; mine = 0u;
#pragma unroll
        for (unsigned j = 0; j < 16; ++j) { const unsigned c = xb_ld(&bar[XB_XCNT(j)]); sum += c; cnt += (c > 0u) ? 1u : 0u; mine = (j == x) ? c : mine; }
        if (sum == G) break;
        __builtin_amdgcn_s_sleep(1);
        if ((++sp & 255u) == 0u) { if (xb_ld(&bar[XB_TMO])) break; if (sp > XB_SPIN_CAP) { atomicAdd(&bar[XB_TMO], 1u); break; } }
    }
    nloc = mine > 0u ? mine : 1u; nx = cnt > 0u ? cnt : 1u;
}
__device__ __forceinline__ void xcd_barrier(const XcdBarrier& b) {
    asm volatile("s_waitcnt vmcnt(0)" ::: "memory");
    __syncthreads();
    if (threadIdx.x == 0) {
        unsigned* bar = b.bar;
        __builtin_amdgcn_s_waitcnt(0);
        unsigned nloc = b.st[0], nx = b.st[1];
        if (nloc == 0u) { xcd_barrier_complete(bar, b.x, nloc, nx); b.st[0] = nloc; b.st[1] = nx; }
        const unsigned old = xb_add(&bar[XB_XSUB(b.x)], 1u);
        const unsigned gen = old / nloc;
        if (old + 1u == (gen + 1u) * nloc) {
            __builtin_amdgcn_fence(__ATOMIC_RELEASE, "agent");
            asm volatile("s_waitcnt vmcnt(0)" ::: "memory");
            const unsigned og = xb_add(&bar[XB_TOP], 1u);
            const unsigned tg = og / nx;
            if (og + 1u == (tg + 1u) * nx) xb_add(&bar[XB_TOPGEN], 1u);
            else XB_SPIN(xb_ld(&bar[XB_TOPGEN]) == tg, bar);
            __builtin_amdgcn_fence(__ATOMIC_ACQUIRE, "agent");
            xb_add(&bar[XB_XGEN(b.x)], 1u);
            asm volatile("s_waitcnt vmcnt(0)" ::: "memory");
        } else {
            XB_SPIN(xb_ld(&bar[XB_XGEN(b.x)]) == gen, bar);
            __builtin_amdgcn_fence(__ATOMIC_ACQUIRE, "agent");
            asm volatile("s_waitcnt vmcnt(0)" ::: "memory");
        }
    }
    __syncthreads();
}

namespace pg8 {
constexpr int BM = 256, BK = 64, HALF = 128, HTB = HALF * BK * 2, STAGE_BYTES = 8 * HTB, NXCD = 8, WGM = 8;
__host__ __device__ __forceinline__ int lds_byte(int r, int c) { const int st = (r >> 4) * 2 + (c >> 5), rr = r & 15, cc = c & 31, ob = rr * 64 + cc * 2; return st * 1024 + (ob ^ (((ob >> 9) & 1) << 5)); }
__host__ __device__ __forceinline__ void stage_rc(int b, int& R, int& C) { const int st = b / 1024, sb = b % 1024, swz = sb ^ (((sb >> 9) & 1) << 5); R = (st >> 1) * 16 + swz / 64; C = (st & 1) * 32 + (swz % 64) / 2; }
__host__ __device__ __forceinline__ int perm32(int rho) { const int n = rho >> 4, i = rho & 15; return 8 * (i >> 2) + 4 * n + (i & 3); }
struct Unit { int pm, pn; };
struct Gemm { const f16* A; const f16* Bt; int M, N, K; int grp_tiles; size_t grp_stride; const int* rowidx; };
struct StaticOrder {
    int nM, nN, nwg, G, c;
    __host__ __device__ void init(int M, int N, int G_, int c_) { nM = M / BM; nN = N / BM; nwg = nM * nN; G = G_; c = c_; }
    __host__ __device__ bool next(int i, Unit& u) const {
        const long L = (long)i * G + c; if (L >= nwg) return false;
        int wgid = (int)L; { const int q = nwg / NXCD, r = nwg % NXCD, xcd = wgid % NXCD, off = wgid / NXCD; wgid = (xcd < r ? xcd * (q + 1) : r * (q + 1) + (xcd - r) * q) + off; }
        const int nig = WGM * nN, gid = wgid / nig, fm = gid * WGM, gsz = (nM - fm) < WGM ? (nM - fm) : WGM;
        u.pm = fm + ((wgid % nig) % gsz); u.pn = (wgid % nig) / gsz; return true;
    }
};
constexpr int GATHER_MAX_UNITS = 15, GATHER_IDX_OFF = RING_BYTES + 1024;
template <class Epi, bool ALIGN_EPI = true, bool SP2 = true, bool GATHER = false>
__device__ __forceinline__ void gemm_phase(LAS unsigned char* lds, const Gemm g, const StaticOrder& S, const Epi& E) {
    int tid = threadIdx.x; asm volatile("" : "+v"(tid));
    const int wid = __builtin_amdgcn_readfirstlane(tid >> 6), lane = tid & 63, wr = wid >> 2, wc = wid & 3, fr = lane & 15, fq = lane >> 4;
    const int K = g.K, nt = K / BK;
    unsigned voffA[2], voffB[2];
#pragma unroll
    for (int i = 0; i < 2; ++i) { int R, C; stage_rc(tid * 16 + i * 8192, R, C); const int Rb = Epi::PERM ? ((R & ~31) + perm32(R & 31)) : R;
        voffA[i] = (unsigned)(R * K + C) * 2u; voffB[i] = (unsigned)(Rb * K + C) * 2u; }
    int gR[2]; unsigned gC[2];
#pragma unroll
    for (int i = 0; i < 2; ++i) { int R, C; stage_rc(tid * 16 + i * 8192, R, C); gR[i] = R; gC[i] = (unsigned)C * 2u; }
    LAS int* idxbuf = (LAS int*)(lds + GATHER_IDX_OFF);
    if constexpr (GATHER) {
        Unit uu;
        for (int q = 0; q < GATHER_MAX_UNITS; ++q) { if (!S.next(q, uu)) break; if (tid < 256) idxbuf[q * 256 + tid] = g.rowidx[uu.pm * 256 + tid]; }
        asm volatile("s_waitcnt vmcnt(0) lgkmcnt(0)" ::: "memory"); __builtin_amdgcn_s_barrier(); asm volatile("" ::: "memory");
    }
    unsigned gaC[2][2], gaN[2][2], ga2[2][2];
#define PG8_GA(dst, q) do { _Pragma("unroll") for (int _h = 0; _h < 2; ++_h) _Pragma("unroll") for (int _i = 0; _i < 2; ++_i) dst[_h][_i] = (unsigned)idxbuf[(q) * 256 + _h * 128 + gR[_i]] * (unsigned)(K * 2) + gC[_i]; } while (0)
    const size_t kstep = (size_t)(BK * 2);
    const size_t hstep = (size_t)HALF * K * 2;
    const size_t tstep = 2 * hstep;
    const unsigned ldsw = (unsigned)wid * 1024u;
    const int aoff = lds_byte(wr * 64 + fr, fq * 8), boff = lds_byte(wc * 32 + fr, fq * 8);
#define PG8_SA(b, h) (((b) * 2 + (h)) * HTB)
#define PG8_SB(b, h) ((4 + (b) * 2 + (h)) * HTB)
#define PG8_STAGE(bufoff, gbase, voff) do { _Pragma("unroll") for (int _i = 0; _i < 2; ++_i) \
        __builtin_amdgcn_global_load_lds((const unsigned*)((const char*)(gbase) + (voff)[_i]), (LAS unsigned*)(lds + (bufoff) + ldsw + _i * 8192), 16, 0, 0); } while (0)
#define PG8_LDA(dst, b, h) do { _Pragma("unroll") for (int m = 0; m < 4; ++m) _Pragma("unroll") for (int k = 0; k < 2; ++k) dst[m][k] = *(const LAS h8*)(lds + PG8_SA(b, h) + aoff + m * 2048 + k * 1024); } while (0)
#define PG8_LDB(dst, b, h) do { _Pragma("unroll") for (int n = 0; n < 2; ++n) _Pragma("unroll") for (int k = 0; k < 2; ++k) dst[n][k] = *(const LAS h8*)(lds + PG8_SB(b, h) + boff + n * 2048 + k * 1024); } while (0)
#define PG8_MMA(ai, bj, At, Bt) do { __builtin_amdgcn_s_setprio(1); _Pragma("unroll") for (int m = 0; m < 4; ++m) _Pragma("unroll") for (int n = 0; n < 2; ++n) _Pragma("unroll") for (int k = 0; k < 2; ++k) \
        acc[ai][bj][m][n] = __builtin_amdgcn_mfma_f32_16x16x32_f16(Bt[n][k], At[m][k], acc[ai][bj][m][n], 0, 0, 0); __builtin_amdgcn_s_setprio(0); } while (0)
#define PG8_WAIT_V(n) asm volatile("s_waitcnt vmcnt(" #n ")" ::: "memory")
#define PG8_WAIT_L(n) asm volatile("s_waitcnt lgkmcnt(" #n ")" ::: "memory")
#define PG8_BAR __builtin_amdgcn_s_barrier()
#define PG8_SCHED __builtin_amdgcn_sched_barrier(0)
#define PG8_STA(bufoff, tileptr, h, gaset, kbyte) do { if constexpr (GATHER) { PG8_STAGE(bufoff, (const char*)g.A + (kbyte), gaset[h]); } else { PG8_STAGE(bufoff, (tileptr) + (h) * hstep, voffA); } } while (0)
#define PG8_BBASE(u) ((const char*)g.Bt + ((size_t)((u).pm / g.grp_tiles) * g.grp_stride) * 2 + (size_t)(u).pn * tstep)
    Unit cur, nxt; int ui = 0;
    if (!S.next(0, cur)) return;
    f32x4 acc[2][2][4][2];
#pragma unroll
    for (int a = 0; a < 2; ++a)
#pragma unroll
        for (int b = 0; b < 2; ++b)
#pragma unroll
            for (int m = 0; m < 4; ++m)
#pragma unroll
                for (int n = 0; n < 2; ++n) acc[a][b][m][n] = (f32x4){0.f, 0.f, 0.f, 0.f};
    h8 At[4][2], B0[2][2], B1[2][2];
    const char* cA = (const char*)g.A + (size_t)cur.pm * tstep; const char* cB = PG8_BBASE(cur);
    if constexpr (GATHER) { PG8_GA(gaC, 0); }
    if constexpr (SP2) {
        PG8_STAGE(PG8_SB(0, 0), cB, voffB); PG8_STAGE(PG8_SB(0, 1), cB + hstep, voffB); PG8_STA(PG8_SA(0, 0), cA, 0, gaC, 0); PG8_STA(PG8_SA(0, 1), cA, 1, gaC, 0);
        if (wr == 1) PG8_BAR;
        PG8_WAIT_V(2); PG8_BAR;
        PG8_STAGE(PG8_SB(1, 0), cB + kstep, voffB); PG8_STA(PG8_SA(1, 0), cA + kstep, 0, gaC, kstep); PG8_STAGE(PG8_SB(1, 1), cB + hstep + kstep, voffB);
        PG8_WAIT_V(6); PG8_BAR;
    } else {
        PG8_STAGE(PG8_SB(0, 0), cB, voffB); PG8_STA(PG8_SA(0, 0), cA, 0, gaC, 0); PG8_STAGE(PG8_SB(0, 1), cB + hstep, voffB); PG8_STA(PG8_SA(0, 1), cA, 1, gaC, 0);
        if (wr == 1) PG8_BAR;
        PG8_WAIT_V(4); PG8_BAR;
        PG8_STAGE(PG8_SB(1, 0), cB + kstep, voffB); PG8_STA(PG8_SA(1, 0), cA + kstep, 0, gaC, kstep); PG8_STAGE(PG8_SB(1, 1), cB + hstep + kstep, voffB);
        PG8_WAIT_V(6); PG8_BAR;
    }
    for (;;) {
        const bool has_next = S.next(ui + 1, nxt);
        const char* nA = has_next ? (const char*)g.A + (size_t)nxt.pm * tstep : cA; const char* nB = has_next ? PG8_BBASE(nxt) : cB;
        if constexpr (GATHER) { const int qn = has_next ? ui + 1 : ui; PG8_GA(gaN, qn); }
#pragma unroll 1
        for (int t = 0; t < nt; t += 2) {
            const bool last = (t == nt - 2);
            const char* a1 = cA + (size_t)(t + 1) * kstep;
            const char* a2 = last ? nA : cA + (size_t)(t + 2) * kstep; const char* b2 = last ? nB : cB + (size_t)(t + 2) * kstep;
            const char* a3 = a2 + kstep; const char* b3 = b2 + kstep;
            const size_t k1 = (size_t)(t + 1) * kstep, k2 = last ? 0 : (size_t)(t + 2) * kstep, k3 = k2 + kstep;
            if constexpr (GATHER) { _Pragma("unroll") for (int _h = 0; _h < 2; ++_h) _Pragma("unroll") for (int _i = 0; _i < 2; ++_i) ga2[_h][_i] = last ? gaN[_h][_i] : gaC[_h][_i]; }
            if constexpr (SP2) {
            PG8_LDB(B0, 0, 0); PG8_LDB(B1, 0, 1); PG8_SCHED; PG8_LDA(At, 0, 0); PG8_STA(PG8_SA(1, 1), a1, 1, gaC, k1);
            PG8_WAIT_V(8); PG8_WAIT_L(0); PG8_BAR; PG8_MMA(0, 0, At, B0); PG8_MMA(0, 1, At, B1); PG8_BAR; PG8_SCHED;
            PG8_LDA(At, 0, 1); PG8_STAGE(PG8_SB(0, 0), b2, voffB); PG8_STAGE(PG8_SB(0, 1), b2 + hstep, voffB); PG8_STA(PG8_SA(0, 0), a2, 0, ga2, k2);
            PG8_WAIT_V(8); PG8_WAIT_L(0); PG8_BAR; PG8_MMA(1, 0, At, B0); PG8_MMA(1, 1, At, B1); PG8_BAR; PG8_SCHED;
            PG8_LDB(B0, 1, 0); PG8_LDB(B1, 1, 1); PG8_SCHED; PG8_LDA(At, 1, 0); PG8_STA(PG8_SA(0, 1), a2, 1, ga2, k2);
            PG8_WAIT_V(8); PG8_WAIT_L(0); PG8_BAR; PG8_MMA(0, 0, At, B0); PG8_MMA(0, 1, At, B1); PG8_BAR; PG8_SCHED;
            PG8_LDA(At, 1, 1); PG8_STAGE(PG8_SB(1, 0), b3, voffB); PG8_STAGE(PG8_SB(1, 1), b3 + hstep, voffB); PG8_STA(PG8_SA(1, 0), a3, 0, ga2, k3);
            PG8_WAIT_V(8); PG8_WAIT_L(0); PG8_BAR; PG8_MMA(1, 0, At, B0); PG8_MMA(1, 1, At, B1); PG8_BAR; PG8_SCHED;
            } else {
            PG8_LDB(B0, 0, 0); PG8_SCHED; PG8_LDA(At, 0, 0); PG8_STA(PG8_SA(1, 1), a1, 1, gaC, k1);
            PG8_WAIT_L(8); PG8_BAR; PG8_WAIT_L(0); PG8_MMA(0, 0, At, B0); PG8_BAR; PG8_SCHED;
            PG8_LDB(B1, 0, 1); PG8_STAGE(PG8_SB(0, 0), b2, voffB);
            PG8_BAR; PG8_WAIT_L(0); PG8_MMA(0, 1, At, B1); PG8_BAR;
            PG8_LDA(At, 0, 1); PG8_STA(PG8_SA(0, 0), a2, 0, ga2, k2);
            PG8_BAR; PG8_WAIT_L(0); PG8_MMA(1, 0, At, B0); PG8_BAR; PG8_SCHED;
            PG8_STAGE(PG8_SB(0, 1), b2 + hstep, voffB);
            PG8_WAIT_V(6); PG8_BAR; PG8_MMA(1, 1, At, B1); PG8_BAR;
            PG8_LDB(B0, 1, 0); PG8_SCHED; PG8_LDA(At, 1, 0); PG8_STA(PG8_SA(0, 1), a2, 1, ga2, k2);
            PG8_WAIT_L(8); PG8_BAR; PG8_WAIT_L(0); PG8_MMA(0, 0, At, B0); PG8_BAR; PG8_SCHED;
            PG8_LDB(B1, 1, 1); PG8_STAGE(PG8_SB(1, 0), b3, voffB);
            PG8_BAR; PG8_WAIT_L(0); PG8_MMA(0, 1, At, B1); PG8_BAR;
            PG8_LDA(At, 1, 1); PG8_STA(PG8_SA(1, 0), a3, 0, ga2, k3);
            PG8_BAR; PG8_WAIT_L(0); PG8_MMA(1, 0, At, B0); PG8_BAR; PG8_SCHED;
            PG8_STAGE(PG8_SB(1, 1), b3 + hstep, voffB);
            PG8_WAIT_V(6); PG8_BAR; PG8_MMA(1, 1, At, B1); PG8_BAR;
            }
        }
        if constexpr (ALIGN_EPI) { if (wr == 0) PG8_BAR; }
        E(acc, cur, wr, wc, fr, fq);
        if (!has_next) break;
#pragma unroll
        for (int a = 0; a < 2; ++a)
#pragma unroll
            for (int b = 0; b < 2; ++b)
#pragma unroll
                for (int m = 0; m < 4; ++m)
#pragma unroll
                    for (int n = 0; n < 2; ++n) acc[a][b][m][n] = (f32x4){0.f, 0.f, 0.f, 0.f};
        cur = nxt; cA = nA; cB = nB; ++ui;
        if constexpr (GATHER) { _Pragma("unroll") for (int _h = 0; _h < 2; ++_h) _Pragma("unroll") for (int _i = 0; _i < 2; ++_i) gaC[_h][_i] = gaN[_h][_i]; }
        if constexpr (ALIGN_EPI) { if (wr == 1) PG8_BAR; }
    }
    PG8_WAIT_V(0);
    if constexpr (!ALIGN_EPI) { if (wr == 0) PG8_BAR; }
    PG8_BAR;
#undef PG8_SA
#undef PG8_SB
#undef PG8_STAGE
#undef PG8_LDA
#undef PG8_LDB
#undef PG8_MMA
#undef PG8_WAIT_V
#undef PG8_WAIT_L
#undef PG8_BAR
#undef PG8_SCHED
#undef PG8_BBASE
#undef PG8_STA
#undef PG8_GA
}
}

#define EPI_ROW(u, ai, m) ((u).pm * 256 + (ai) * 128 + wr * 64 + (m) * 16 + fr)
__device__ __forceinline__ h8 pack8(f32x4 a, f32x4 b) { h8 o; o[0] = (f16)a[0]; o[1] = (f16)a[1]; o[2] = (f16)a[2]; o[3] = (f16)a[3]; o[4] = (f16)b[0]; o[5] = (f16)b[1]; o[6] = (f16)b[2]; o[7] = (f16)b[3]; return o; }
__device__ __forceinline__ void rope4(f32x4& v0, f32x4& v1, const f32x4 cs, const f32x4 sn) {
    const f32x4 a = v0, b = v1;
    v0[0] = a[0] * cs[0] - a[1] * sn[0]; v0[1] = a[1] * cs[0] + a[0] * sn[0];
    v0[2] = a[2] * cs[1] - a[3] * sn[1]; v0[3] = a[3] * cs[1] + a[2] * sn[1];
    v1[0] = b[0] * cs[2] - b[1] * sn[2]; v1[1] = b[1] * cs[2] + b[0] * sn[2];
    v1[2] = b[2] * cs[3] - b[3] * sn[3]; v1[3] = b[3] * cs[3] + b[2] * sn[3];
}
struct EpiLat {
    static constexpr bool PERM = true; f16* cq; f16* ckv; f16* Kp; float* pq; float* pkv; const float* cosm; const float* sinm;
    __device__ __forceinline__ void operator()(const f32x4 (&acc)[2][2][4][2], const pg8::Unit& u, int wr, int wc, int fr, int fq) const {
#pragma unroll
        for (int ai = 0; ai < 2; ++ai)
#pragma unroll
            for (int m = 0; m < 4; ++m) { const int t = EPI_ROW(u, ai, m); float sq = 0.f, sk = 0.f;
#pragma unroll
                for (int bj = 0; bj < 2; ++bj) { const int c8 = u.pn * 256 + bj * 128 + wc * 32 + 8 * fq; const int ht = u.pn * 2 + bj;
                    f32x4 v0 = acc[ai][bj][m][0], v1 = acc[ai][bj][m][1];
                    const float ss = (v0[0] * v0[0] + v0[1] * v0[1]) + (v0[2] * v0[2] + v0[3] * v0[3]) + (v1[0] * v1[0] + v1[1] * v1[1]) + (v1[2] * v1[2] + v1[3] * v1[3]);
                    if (ht < 3) { sq += ss; *(h8*)(cq + (size_t)t * 384 + c8) = pack8(v0, v1); }
                    else if (ht < 5) { sk += ss; *(h8*)(ckv + (size_t)t * 256 + (c8 - 384)) = pack8(v0, v1); }
                    else if (c8 < 704) { const int jj = c8 - 640, i0 = jj >> 1;
                        const f32x4 cs = *(const f32x4*)(cosm + (size_t)t * 32 + i0), sn = *(const f32x4*)(sinm + (size_t)t * 32 + i0); rope4(v0, v1, cs, sn);
                        const h8 o = pack8(v0, v1);
#pragma unroll
                        for (int h = 0; h < 8; ++h) *(h8*)(Kp + (size_t)t * 1536 + h * 192 + 128 + jj) = o; } }
                sq += __shfl_xor(sq, 16); sq += __shfl_xor(sq, 32); sk += __shfl_xor(sk, 16); sk += __shfl_xor(sk, 32);
                if (fq == 0) { if (u.pn < 2) pq[(size_t)t * 8 + u.pn * 4 + wc] = sq; if (u.pn >= 1) pkv[(size_t)t * 8 + (u.pn - 1) * 4 + wc] = sk; }
                asm volatile("" ::: "memory"); }
    }
};
__device__ __forceinline__ float row_rms_scale(const float* part, int t, float inv_n, float eps) {
    const f32x4 a = *(const f32x4*)(part + (size_t)t * 8), b = *(const f32x4*)(part + (size_t)t * 8 + 4);
    const float s = ((a[0] + a[1]) + (a[2] + a[3])) + ((b[0] + b[1]) + (b[2] + b[3]));
    return 1.0f / sqrtf(s * inv_n + eps);
}
struct EpiQNope {
    static constexpr bool PERM = true; f16* Q; const float* pq;
    __device__ __forceinline__ void operator()(const f32x4 (&acc)[2][2][4][2], const pg8::Unit& u, int wr, int wc, int fr, int fq) const {
#pragma unroll
        for (int ai = 0; ai < 2; ++ai)
#pragma unroll
            for (int m = 0; m < 4; ++m) { const int t = EPI_ROW(u, ai, m); const float rs = row_rms_scale(pq, t, 1.0f / 384.0f, LAT_EPS);
#pragma unroll
                for (int bj = 0; bj < 2; ++bj) { const int c8 = u.pn * 256 + bj * 128 + wc * 32 + 8 * fq;
                    *(h8*)(Q + (size_t)t * 1536 + (c8 >> 7) * 192 + (c8 & 127)) = pack8(acc[ai][bj][m][0] * rs, acc[ai][bj][m][1] * rs); }
                asm volatile("" ::: "memory"); }
    }
};
struct EpiQRope {
    static constexpr bool PERM = true; f16* Q; const float* cosm; const float* sinm; const float* pq;
    __device__ __forceinline__ void operator()(const f32x4 (&acc)[2][2][4][2], const pg8::Unit& u, int wr, int wc, int fr, int fq) const {
#pragma unroll
        for (int ai = 0; ai < 2; ++ai)
#pragma unroll
            for (int m = 0; m < 4; ++m) { const int t = EPI_ROW(u, ai, m); const float rs = row_rms_scale(pq, t, 1.0f / 384.0f, LAT_EPS);
#pragma unroll
                for (int bj = 0; bj < 2; ++bj) { const int cc = u.pn * 256 + bj * 128 + wc * 32 + 8 * fq; const int h = cc >> 6, jj = cc & 63, i0 = jj >> 1;
                    f32x4 v0 = acc[ai][bj][m][0] * rs, v1 = acc[ai][bj][m][1] * rs;
                    const f32x4 cs = *(const f32x4*)(cosm + (size_t)t * 32 + i0), sn = *(const f32x4*)(sinm + (size_t)t * 32 + i0); rope4(v0, v1, cs, sn);
                    *(h8*)(Q + (size_t)t * 1536 + h * 192 + 128 + jj) = pack8(v0, v1); }
                asm volatile("" ::: "memory"); }
    }
};
struct EpiKV {
    static constexpr bool PERM = true; f16* Kp; f16* Vp; const float* pkv;
    __device__ __forceinline__ void operator()(const f32x4 (&acc)[2][2][4][2], const pg8::Unit& u, int wr, int wc, int fr, int fq) const {
#pragma unroll
        for (int ai = 0; ai < 2; ++ai)
#pragma unroll
            for (int m = 0; m < 4; ++m) { const int t = EPI_ROW(u, ai, m); const float rs = row_rms_scale(pkv, t, 1.0f / 256.0f, LAT_EPS);
#pragma unroll
                for (int bj = 0; bj < 2; ++bj) { const int c8 = u.pn * 256 + bj * 128 + wc * 32 + 8 * fq; const int h = c8 >> 8, j = c8 & 255;
                    f16* dst = (j < 128) ? (Kp + (size_t)t * 1536 + h * 192 + j) : (Vp + (size_t)t * 1024 + h * 128 + (j - 128));
                    *(h8*)dst = pack8(acc[ai][bj][m][0] * rs, acc[ai][bj][m][1] * rs); }
                asm volatile("" ::: "memory"); }
    }
};
template <bool XF16> struct EpiPre {
    static constexpr bool PERM = true; const void* xres; const float* gmod; f16* pre;
    __device__ __forceinline__ void operator()(const f32x4 (&acc)[2][2][4][2], const pg8::Unit& u, int wr, int wc, int fr, int fq) const {
#pragma unroll
        for (int ai = 0; ai < 2; ++ai)
#pragma unroll
            for (int m = 0; m < 4; ++m) { const int t = EPI_ROW(u, ai, m); const int b = t >> 12;
#pragma unroll
                for (int bj = 0; bj < 2; ++bj) { const int c8 = u.pn * 256 + bj * 128 + wc * 32 + 8 * fq;
                    const f32x4 g0 = *(const f32x4*)(gmod + b * 6144 + c8), g1 = *(const f32x4*)(gmod + b * 6144 + c8 + 4); f32x4 x0, x1;
                    if constexpr (XF16) { const h8 xv = *(const h8*)((const f16*)xres + (size_t)t * 1024 + c8);
                        x0 = (f32x4){(float)xv[0], (float)xv[1], (float)xv[2], (float)xv[3]}; x1 = (f32x4){(float)xv[4], (float)xv[5], (float)xv[6], (float)xv[7]}; }
                    else { x0 = *(const f32x4*)((const float*)xres + (size_t)t * 1024 + c8); x1 = *(const f32x4*)((const float*)xres + (size_t)t * 1024 + c8 + 4); }
                    *(h8*)(pre + (size_t)t * 1024 + c8) = pack8(x0 * ALPHA + (g0 + 1.0f) * acc[ai][bj][m][0], x1 * ALPHA + (g1 + 1.0f) * acc[ai][bj][m][1]); }
                asm volatile("" ::: "memory"); }
    }
};
struct EpiUp {
    static constexpr bool PERM = true; f16* act;
    __device__ __forceinline__ void operator()(const f32x4 (&acc)[2][2][4][2], const pg8::Unit& u, int wr, int wc, int fr, int fq) const {
#pragma unroll
        for (int ai = 0; ai < 2; ++ai)
#pragma unroll
            for (int m = 0; m < 4; ++m) { const int r = EPI_ROW(u, ai, m);
#pragma unroll
                for (int bj = 0; bj < 2; ++bj) { const int c8 = u.pn * 256 + bj * 128 + wc * 32 + 8 * fq;
                    const f32x4 gq = acc[ai][bj][m][0], uq = acc[ai][bj][m][1]; h4 o;
#pragma unroll
                    for (int i = 0; i < 4; ++i) { const float gg = gq[i]; o[i] = (f16)(gg * __builtin_amdgcn_rcpf(1.0f + __expf(-gg)) * uq[i]); }
                    *(h4*)(act + (size_t)r * 2048 + (c8 >> 1)) = o; } }
    }
};
struct EpiDown {
    static constexpr bool PERM = true; f16* y; const float* gate;
    __device__ __forceinline__ void operator()(const f32x4 (&acc)[2][2][4][2], const pg8::Unit& u, int wr, int wc, int fr, int fq) const {
#pragma unroll
        for (int ai = 0; ai < 2; ++ai)
#pragma unroll
            for (int m = 0; m < 4; ++m) { const int r = EPI_ROW(u, ai, m); const float gt = gate[r];
#pragma unroll
                for (int bj = 0; bj < 2; ++bj) { const int c8 = u.pn * 256 + bj * 128 + wc * 32 + 8 * fq;
                    *(h8*)(y + (size_t)r * 1024 + c8) = pack8(acc[ai][bj][m][0] * gt, acc[ai][bj][m][1] * gt); }
                asm volatile("" ::: "memory"); }
    }
};
struct EpiDiffIn {
    static constexpr bool PERM = true; f16* qkv; const float* cosd; const float* sind;
    __device__ __forceinline__ void operator()(const f32x4 (&acc)[2][2][4][2], const pg8::Unit& u, int wr, int wc, int fr, int fq) const {
#pragma unroll
        for (int ai = 0; ai < 2; ++ai)
#pragma unroll
            for (int m = 0; m < 4; ++m) { const int t = EPI_ROW(u, ai, m);
#pragma unroll
                for (int bj = 0; bj < 2; ++bj) { const int c8 = u.pn * 256 + bj * 128 + wc * 32 + 8 * fq;
                    f32x4 v0 = acc[ai][bj][m][0], v1 = acc[ai][bj][m][1];
                    if (c8 < 2048 && (c8 & 63) < 16) { const int i0 = (c8 & 15) >> 1; const f32x4 cs = *(const f32x4*)(cosd + (size_t)t * 8 + i0), sn = *(const f32x4*)(sind + (size_t)t * 8 + i0); rope4(v0, v1, cs, sn); }
                    *(h8*)(qkv + (size_t)t * 3072 + c8) = pack8(v0, v1); }
                asm volatile("" ::: "memory"); }
    }
};

namespace att {
constexpr int QBLK = 32, KVBLK = 64, DV = 128;
constexpr float THR = 8.f;
constexpr size_t SHM_V = KVBLK * DV * 2;
#define SBAR() __builtin_amdgcn_sched_barrier(0)
__device__ __forceinline__ int crow(int r, int hi) { return (r & 3) + 8 * (r >> 2) + 4 * hi; }
__device__ __forceinline__ unsigned cvtpk(float lo, float hi) { unsigned r; asm volatile("v_cvt_pk_f16_f32 %0, %1, %2" : "=v"(r) : "v"(lo), "v"(hi)); return r; }
template <int DQK> struct Cfg {
    static constexpr int ND0 = DQK / 16, KRB = DQK * 2, NKCH = DQK / 64, KCPR = DQK / 8;
    static constexpr size_t SHM_K = (size_t)KVBLK * KRB;
    static constexpr float SCALE = DQK == 192 ? 0.07216878364870322f : 0.125f;
    static constexpr size_t SHM_TOTAL = 2 * SHM_V + 2 * SHM_K + NWAVES * 64 * 4;
};
template <int DQK> __device__ __forceinline__ void partialSM(f32x16& p0, f32x16& p1, float& m_reg, float& mn, float& alpha) {
    constexpr float SCALE = Cfg<DQK>::SCALE, C = SCALE * 1.4426950408889634f;
    float pmax = p0[0];
#pragma unroll
    for (int r = 1; r < 16; ++r) pmax = fmaxf(pmax, p0[r]);
#pragma unroll
    for (int r = 0; r < 16; ++r) pmax = fmaxf(pmax, p1[r]);
    { auto rr = __builtin_amdgcn_permlane32_swap(__float_as_uint(pmax), __float_as_uint(pmax), false, false);
      pmax = fmaxf(__uint_as_float(rr[0]), __uint_as_float(rr[1])); }
    if (__builtin_expect(__all(pmax - m_reg <= THR / SCALE), 1)) { mn = m_reg; alpha = 1.f; }
    else { mn = fmaxf(m_reg, pmax); alpha = __builtin_amdgcn_exp2f((m_reg - mn) * C); m_reg = mn; }
    const float mnC = -mn * C;
#pragma unroll
    for (int r = 0; r < 16; ++r) p0[r] = fmaf(p0[r], C, mnC);
#pragma unroll
    for (int r = 0; r < 16; ++r) p1[r] = fmaf(p1[r], C, mnC);
#pragma unroll
    for (int r = 0; r < 16; ++r) p0[r] = __builtin_amdgcn_exp2f(p0[r]);
}
__device__ __forceinline__ void finishSM(f32x16& p0, f32x16& p1, float alpha, float& l_reg, h8& pa0, h8& pa1, h8& pa2, h8& pa3) {
#pragma unroll
    for (int r = 0; r < 16; ++r) p1[r] = __builtin_amdgcn_exp2f(p1[r]);
    float ps = 0;
#pragma unroll
    for (int r = 0; r < 16; ++r) ps += p0[r];
#pragma unroll
    for (int r = 0; r < 16; ++r) ps += p1[r];
    { auto rr = __builtin_amdgcn_permlane32_swap(__float_as_uint(ps), __float_as_uint(ps), false, false);
      ps = __uint_as_float(rr[0]) + __uint_as_float(rr[1]); }
    l_reg = l_reg * alpha + ps;
#define PK4(P, BASE, OUT) do { unsigned a0 = cvtpk(P[BASE + 0], P[BASE + 1]), a1 = cvtpk(P[BASE + 2], P[BASE + 3]);   \
    unsigned b0 = cvtpk(P[BASE + 4], P[BASE + 5]), b1 = cvtpk(P[BASE + 6], P[BASE + 7]);                              \
    auto r0 = __builtin_amdgcn_permlane32_swap(a0, b0, false, false); auto r1 = __builtin_amdgcn_permlane32_swap(a1, b1, false, false); \
    u32x4 w = {r0[0], r1[0], r0[1], r1[1]}; OUT = *reinterpret_cast<h8*>(&w); } while (0)
    PK4(p0, 0, pa0); PK4(p0, 8, pa1); PK4(p1, 0, pa2); PK4(p1, 8, pa3);
#undef PK4
}
#define KSWZ(row, colB) ((row) * KRB + ((colB) ^ (((row) & 7) << 4)))
template <int DQK> __device__ __forceinline__ void qkt(f32x16& p0, f32x16& p1, const char* Ks, const h8* qr, int r32, int hi) {
    constexpr int KRB = Cfg<DQK>::KRB;
    p0 = f32x16{}; p1 = f32x16{};
#pragma unroll
    for (int d0 = 0; d0 < Cfg<DQK>::ND0; ++d0) { const int cb = (d0 * 16 + hi * 8) * 2;
        const h8 b0 = *reinterpret_cast<const h8*>(Ks + KSWZ(r32, cb));
        const h8 b1 = *reinterpret_cast<const h8*>(Ks + KSWZ(32 + r32, cb));
        p0 = __builtin_amdgcn_mfma_f32_32x32x16_f16(b0, qr[d0], p0, 0, 0, 0);
        p1 = __builtin_amdgcn_mfma_f32_32x32x16_f16(b1, qr[d0], p1, 0, 0, 0); }
}
__device__ __forceinline__ int v_st(int k, int c) { const int kk = (k & ~0xC) | ((k & 4) << 1) | ((k & 8) >> 1); return ((kk >> 3) * 4 + (c >> 5)) * 512 + ((kk & 7) * 32 + (c & 31)) * 2; }
__device__ __forceinline__ int v_rd_base(int lane) { return ((lane & 3) << 3) | (((lane >> 2) & 3) << 6) | (((lane >> 4) & 1) << 5) | (((lane >> 5) & 1) << 8); }
constexpr int v_rd_off(int d0, int ks, int half) { return d0 * 512 + ks * 4096 + half * 2048; }
template <int OFF> __device__ __forceinline__ s16x4 tr_read(int vb) {
    s16x4 r; asm volatile("ds_read_b64_tr_b16 %0, %1 offset:%2" : "=&v"(r) : "v"(vb), "i"(OFF) : "memory"); return r;
}
template <int D0> __device__ __forceinline__ void pv_one(f32x16& od, int vb, h8 pa0, h8 pa1, h8 pa2, h8 pa3) {
    const s16x4 l0 = tr_read<v_rd_off(D0, 0, 0)>(vb), h0 = tr_read<v_rd_off(D0, 0, 1)>(vb), l1 = tr_read<v_rd_off(D0, 1, 0)>(vb), h1 = tr_read<v_rd_off(D0, 1, 1)>(vb);
    const s16x4 l2 = tr_read<v_rd_off(D0, 2, 0)>(vb), h2_ = tr_read<v_rd_off(D0, 2, 1)>(vb), l3 = tr_read<v_rd_off(D0, 3, 0)>(vb), h3 = tr_read<v_rd_off(D0, 3, 1)>(vb);
    asm volatile("s_waitcnt lgkmcnt(0)" ::: "memory"); SBAR();
#define PKV(L, H) __builtin_bit_cast(h8, (__attribute__((ext_vector_type(8))) short){L[0], L[1], L[2], L[3], H[0], H[1], H[2], H[3]})
    od = __builtin_amdgcn_mfma_f32_32x32x16_f16(pa0, PKV(l0, h0), od, 0, 0, 0);
    od = __builtin_amdgcn_mfma_f32_32x32x16_f16(pa1, PKV(l1, h1), od, 0, 0, 0);
    od = __builtin_amdgcn_mfma_f32_32x32x16_f16(pa2, PKV(l2, h2_), od, 0, 0, 0);
    od = __builtin_amdgcn_mfma_f32_32x32x16_f16(pa3, PKV(l3, h3), od, 0, 0, 0);
#undef PKV
}
__device__ __forceinline__ void pv_d0(f32x16* o, int vb, h8 pa0, h8 pa1, h8 pa2, h8 pa3) {
    pv_one<0>(o[0], vb, pa0, pa1, pa2, pa3); pv_one<1>(o[1], vb, pa0, pa1, pa2, pa3); pv_one<2>(o[2], vb, pa0, pa1, pa2, pa3); pv_one<3>(o[3], vb, pa0, pa1, pa2, pa3);
}
template <int LDO>
__device__ __forceinline__ void attn_epilogue(f32x16 (&o)[4], const float (&rli)[16], f16* Ow, int mode, float lam, const float* subln, int r32, int hi) {
    if (mode == 0) {
#pragma unroll
        for (int r = 0; r < 16; ++r) { const int orow = crow(r, hi);
#pragma unroll
            for (int d0 = 0; d0 < 4; ++d0) Ow[(long)orow * LDO + d0 * 32 + r32] = (f16)(o[d0][r] * rli[r]); }
    } else {
        float sl[4];
#pragma unroll
        for (int d0 = 0; d0 < 4; ++d0) sl[d0] = subln[d0 * 32 + r32] * (1.0f - LAMBDA_INIT);
        f16 t0[4][16];
#pragma unroll
        for (int r = 0; r < 16; ++r) { const int orow = crow(r, hi);
#pragma unroll
            for (int d0 = 0; d0 < 4; ++d0) t0[d0][r] = Ow[(long)orow * LDO + d0 * 32 + r32]; }
        asm volatile("s_waitcnt vmcnt(0)" ::: "memory");
#pragma unroll
        for (int r = 0; r < 16; ++r) { const int orow = crow(r, hi); float ss = 0.f;
#pragma unroll
            for (int d0 = 0; d0 < 4; ++d0) { const float x = (float)t0[d0][r] - lam * (o[d0][r] * rli[r]); o[d0][r] = x; ss += x * x; }
            ss += __shfl_xor(ss, 1); ss += __shfl_xor(ss, 2); ss += __shfl_xor(ss, 4); ss += __shfl_xor(ss, 8); ss += __shfl_xor(ss, 16);
            const float rs = 1.0f / sqrtf(ss * (1.0f / 128.0f) + LN_EPS);
#pragma unroll
            for (int d0 = 0; d0 < 4; ++d0) Ow[(long)orow * LDO + d0 * 32 + r32] = (f16)(o[d0][r] * rs * sl[d0]); }
    }
}
template <int DQK, int LDQ, int LDK, int LDV, int LDO, int SDEPTH>
__device__ __forceinline__ void attn_body(const f16* Qb, const f16* Kh, const f16* Vh, f16* Ob, char* lds, int mode = 0, float lam = 0.f, const float* subln = nullptr) {
    using C = Cfg<DQK>;
    constexpr int KRB = C::KRB, ND0 = C::ND0, NKCH = C::NKCH, KCPR = C::KCPR; constexpr size_t SHM_K = C::SHM_K;
    constexpr int seq = SEQ;
    int tid = threadIdx.x; asm volatile("" : "+v"(tid));
    const int wid = tid >> 6, lane = tid & 63, r32 = lane & 31, hi = lane >> 5;
    char* V_lds = lds; char* K_lds = lds + 2 * SHM_V;
    float* wsl = (float*)(lds + 2 * SHM_V + 2 * SHM_K) + wid * 64; float* li_l = wsl; float* al_l = wsl + 32;
    float m_reg = -1e30f, l_reg = 0; f32x16 o[4] = {}; h8 qr[ND0];
    const f16* Qw = Qb + (long)(wid * QBLK + r32) * LDQ + hi * 8;
#pragma unroll
    for (int d0 = 0; d0 < ND0; ++d0) qr[d0] = *reinterpret_cast<const h8*>(Qw + d0 * 16);
    const int sr = tid >> 4, sc = (tid & 15) * 8, vst0 = v_st(sr, sc), vst1 = v_st(32 + sr, sc);
    int krow[NKCH], kcb[NKCH];
#pragma unroll
    for (int i = 0; i < NKCH; ++i) { const int c = tid + i * 512; krow[i] = c / KCPR; kcb[i] = (c % KCPR) * 16; }
    const int vb0 = (int)(uintptr_t)V_lds + v_rd_base(lane);
    struct { h8 vs0, vs1; h8 ks[NKCH]; } sr_[SDEPTH];
#define SLOAD(i, k0) do { sr_[i].vs0 = *reinterpret_cast<const h8*>(&Vh[(long)((k0) + sr) * LDV + sc]); sr_[i].vs1 = *reinterpret_cast<const h8*>(&Vh[(long)((k0) + 32 + sr) * LDV + sc]); \
    _Pragma("unroll") for (int _c = 0; _c < NKCH; ++_c) sr_[i].ks[_c] = *reinterpret_cast<const h8*>((const char*)Kh + (long)((k0) + krow[_c]) * (LDK * 2) + kcb[_c]); } while (0)
#define SWRITE(b, i) do { *(h8*)(V_lds + (b) * SHM_V + vst0) = sr_[i].vs0; *(h8*)(V_lds + (b) * SHM_V + vst1) = sr_[i].vs1; \
    _Pragma("unroll") for (int _c = 0; _c < NKCH; ++_c) *(h8*)(K_lds + (b) * SHM_K + KSWZ(krow[_c], kcb[_c])) = sr_[i].ks[_c]; } while (0)
#define SWAIT() do { if constexpr (SDEPTH == 2) { if constexpr (NKCH == 3) asm volatile("s_waitcnt vmcnt(5)" ::: "memory"); else asm volatile("s_waitcnt vmcnt(3)" ::: "memory"); } \
    else asm volatile("s_waitcnt vmcnt(0)" ::: "memory"); } while (0)
#define RESC(a) do { if (__any((a) < 1.f)) { if (hi == 0) al_l[r32] = (a); asm volatile("s_waitcnt lgkmcnt(0)" ::: "memory"); \
    _Pragma("unroll") for (int d = 0; d < 4; ++d) _Pragma("unroll") for (int r = 0; r < 16; ++r) o[d][r] *= al_l[crow(r, hi)]; } } while (0)
    f32x16 pA0, pA1, pB0, pB1; float mnA, mnB, alA, alB; h8 pa0, pa1, pa2, pa3; constexpr int NT = seq / KVBLK;
    constexpr int SE = 0, SO = SDEPTH - 1;
    SLOAD(SE, 0); asm volatile("s_waitcnt vmcnt(0)" ::: "memory"); SWRITE(0, SE); __syncthreads();
    qkt<DQK>(pA0, pA1, K_lds, qr, r32, hi); partialSM<DQK>(pA0, pA1, m_reg, mnA, alA);
    SLOAD(SO, KVBLK); if constexpr (SDEPTH == 2) { if (2 < NT) SLOAD(SE, 2 * KVBLK); }
    SWAIT(); SWRITE(1, SO); __syncthreads();
    for (int j = 1; j + 1 < NT; j += 2) {
        SBAR(); qkt<DQK>(pB0, pB1, K_lds + SHM_K, qr, r32, hi);
        finishSM(pA0, pA1, alA, l_reg, pa0, pa1, pa2, pa3); SBAR();
        SLOAD(SO, (j + SDEPTH) * KVBLK); SBAR();
        pv_d0(o, vb0, pa0, pa1, pa2, pa3); partialSM<DQK>(pB0, pB1, m_reg, mnB, alB);
        __syncthreads(); SWAIT(); SWRITE(0, SE);
        RESC(alB); __syncthreads();
        SBAR(); qkt<DQK>(pA0, pA1, K_lds, qr, r32, hi);
        finishSM(pB0, pB1, alB, l_reg, pa0, pa1, pa2, pa3); SBAR();
        if (SDEPTH == 1 || j + 3 < NT) SLOAD(SE, (j + 1 + SDEPTH) * KVBLK); SBAR();
        pv_d0(o, vb0 + (int)SHM_V, pa0, pa1, pa2, pa3); partialSM<DQK>(pA0, pA1, m_reg, mnA, alA);
        __syncthreads(); SWAIT(); SWRITE(1, SO);
        RESC(alA); __syncthreads();
    }
    SBAR(); qkt<DQK>(pB0, pB1, K_lds + SHM_K, qr, r32, hi);
    finishSM(pA0, pA1, alA, l_reg, pa0, pa1, pa2, pa3); SBAR();
    pv_d0(o, vb0, pa0, pa1, pa2, pa3); partialSM<DQK>(pB0, pB1, m_reg, mnB, alB);
    __syncthreads(); RESC(alB);
    finishSM(pB0, pB1, alB, l_reg, pa0, pa1, pa2, pa3); SBAR();
    pv_d0(o, vb0 + (int)SHM_V, pa0, pa1, pa2, pa3);
    if (hi == 0) li_l[r32] = l_reg; asm volatile("s_waitcnt lgkmcnt(0)" ::: "memory");
    float rli[16];
#pragma unroll
    for (int r = 0; r < 16; ++r) rli[r] = __builtin_amdgcn_rcpf(li_l[crow(r, hi)]);
    attn_epilogue<LDO>(o, rli, Ob + (long)(wid * QBLK) * LDO, mode, lam, subln, r32, hi);
    asm volatile("s_waitcnt vmcnt(0) lgkmcnt(0)" ::: "memory");
    __syncthreads();
#undef SLOAD
#undef SWRITE
#undef SWAIT
#undef RESC
}

struct ConvStream {
    const float* win; const float* wout; f16* tin; f16* tout;
    int step, step_end, it, period;
    unsigned d[8]; f16* pend;
    char* acc; f16* dst0; int nacc;
};
constexpr int CONV_STEPS_IN = 16 * 64 * 128, CONV_STEPS_OUT = 16 * 16 * 256, CONV_STEPS = CONV_STEPS_IN + CONV_STEPS_OUT;
__device__ __forceinline__ void conv_drain(ConvStream& c, int lane) {
    if (c.nacc > 0) {
        asm volatile("s_waitcnt lgkmcnt(0)" ::: "memory");
        for (int q = 0; q < c.nacc; ++q) { const h8 v = *(const h8*)(c.acc + q * 1024 + lane * 16); *(h8*)(c.dst0 + q * 8) = v; }
        c.nacc = 0; }
}
__device__ __forceinline__ void conv_flush(ConvStream& c, int lane) {
    if (c.pend) { h8 o;
#pragma unroll
        for (int i = 0; i < 8; ++i) o[i] = (f16)__uint_as_float(c.d[i]);
        if (c.nacc == 0) c.dst0 = c.pend;
        *(h8*)(c.acc + c.nacc * 1024 + lane * 16) = o; ++c.nacc; c.pend = nullptr;
        if (c.nacc == 4) conv_drain(c, lane); }
}
__device__ __forceinline__ void conv_tick(ConvStream& c, int lane) {
    const bool go = ((c.it & (c.period - 1)) < 3) && (c.step < c.step_end); ++c.it;
    if (go) { const int s = c.step++;
        const float* src; f16* dst; int N;
        if (s < CONV_STEPS_IN) { const int strip = s >> 7, kb = s & 127, e = strip >> 6, n = (strip & 63) * 64 + lane; const int f = n & 2047, dr = (f >> 2) * 8 + (f & 3) + ((n >> 11) << 2);
            src = c.win + ((size_t)e * 1024 + kb * 8) * 4096 + n; dst = c.tin + ((size_t)e * 4096 + dr) * 1024 + kb * 8; N = 4096; }
        else { const int s2 = s - CONV_STEPS_IN; const int strip = s2 >> 8, kb = s2 & 255, e = strip >> 4, n = (strip & 15) * 64 + lane;
            src = c.wout + ((size_t)e * 2048 + kb * 8) * 1024 + n; dst = c.tout + ((size_t)e * 1024 + n) * 2048 + kb * 8; N = 1024; }
        if ((s & 3) == 0) conv_drain(c, lane);
#pragma unroll
        for (int i = 0; i < 8; ++i) c.d[i] = __float_as_uint(src[(size_t)i * N]);
        c.pend = dst; }
}
__device__ __forceinline__ void conv_init(ConvStream& cs, const float* win, const float* wout, f16* tin, f16* tout, int l, int gw, int NGW, int period, char* acc) {
    cs.acc = acc; cs.nacc = 0; cs.dst0 = nullptr;
    cs.win = win + (size_t)l * NE * 1024 * 4096; cs.wout = wout + (size_t)l * NE * 2048 * 1024; cs.tin = tin + (size_t)l * NE * 4096 * 1024; cs.tout = tout + (size_t)l * NE * 1024 * 2048;
    const int per = ((CONV_STEPS + NGW - 1) / NGW + 7) & ~7;
    cs.step = gw * per < CONV_STEPS ? gw * per : CONV_STEPS; cs.step_end = (gw + 1) * per < CONV_STEPS ? (gw + 1) * per : CONV_STEPS; cs.it = 0; cs.pend = nullptr; cs.period = period;
}
template <int DQK, int LDQ, int LDK, int LDV, int LDO, bool CONV = false>
__device__ __forceinline__ void attn_body_simple(const f16* Qb, const f16* Kh, const f16* Vh, f16* Ob, char* lds, int mode = 0, float lam = 0.f, const float* subln = nullptr, ConvStream* cs = nullptr) {
    using C = Cfg<DQK>;
    constexpr int KRB = C::KRB, ND0 = C::ND0, NKCH = C::NKCH, KCPR = C::KCPR; constexpr size_t SHM_K = C::SHM_K;
    int tid = threadIdx.x; asm volatile("" : "+v"(tid));
    const int wid = tid >> 6, lane = tid & 63, r32 = lane & 31, hi = lane >> 5;
    char* V_lds = lds; char* K_lds = lds + 2 * SHM_V;
    float* wsl = (float*)(lds + 2 * SHM_V + 2 * SHM_K) + wid * 64; float* li_l = wsl; float* al_l = wsl + 32;
    float m_reg = -1e30f, l_reg = 0; f32x16 o[4] = {}; h8 qr[ND0];
    const f16* Qw = Qb + (long)(wid * QBLK + r32) * LDQ + hi * 8;
#pragma unroll
    for (int d0 = 0; d0 < ND0; ++d0) qr[d0] = *reinterpret_cast<const h8*>(Qw + d0 * 16);
    const int sr = tid >> 4, sc = (tid & 15) * 8, vst0 = v_st(sr, sc), vst1 = v_st(32 + sr, sc);
    int krow[NKCH], kcb[NKCH];
#pragma unroll
    for (int i = 0; i < NKCH; ++i) { const int c = tid + i * 512; krow[i] = c / KCPR; kcb[i] = (c % KCPR) * 16; }
    const int vb0 = (int)(uintptr_t)V_lds + v_rd_base(lane);
    h8 vs0, vs1, ks[NKCH];
#define SLOAD1(k0) do { vs0 = *reinterpret_cast<const h8*>(&Vh[(long)((k0) + sr) * LDV + sc]); vs1 = *reinterpret_cast<const h8*>(&Vh[(long)((k0) + 32 + sr) * LDV + sc]); \
    _Pragma("unroll") for (int _c = 0; _c < NKCH; ++_c) ks[_c] = *reinterpret_cast<const h8*>((const char*)Kh + (long)((k0) + krow[_c]) * (LDK * 2) + kcb[_c]); } while (0)
#define SWRITE1(b) do { *(h8*)(V_lds + (b) * SHM_V + vst0) = vs0; *(h8*)(V_lds + (b) * SHM_V + vst1) = vs1; \
    _Pragma("unroll") for (int _c = 0; _c < NKCH; ++_c) *(h8*)(K_lds + (b) * SHM_K + KSWZ(krow[_c], kcb[_c])) = ks[_c]; } while (0)
    constexpr int NT = SEQ / KVBLK;
    SLOAD1(0); asm volatile("s_waitcnt vmcnt(0)" ::: "memory"); SWRITE1(0); __syncthreads();
#pragma unroll 1
    for (int j = 0; j < NT; ++j) {
        const int cb = j & 1;
        if constexpr (CONV) conv_tick(*cs, lane);
        if (j + 1 < NT) SLOAD1((j + 1) * KVBLK);
        SBAR();
        f32x16 p0, p1; float mn, al; h8 pa0, pa1, pa2, pa3;
        qkt<DQK>(p0, p1, K_lds + cb * SHM_K, qr, r32, hi);
        partialSM<DQK>(p0, p1, m_reg, mn, al);
        if (__any(al < 1.f)) { if (hi == 0) al_l[r32] = al; asm volatile("s_waitcnt lgkmcnt(0)" ::: "memory");
#pragma unroll
            for (int d = 0; d < 4; ++d)
#pragma unroll
                for (int r = 0; r < 16; ++r) o[d][r] *= al_l[crow(r, hi)]; }
        finishSM(p0, p1, al, l_reg, pa0, pa1, pa2, pa3); SBAR();
        pv_d0(o, vb0 + cb * (int)SHM_V, pa0, pa1, pa2, pa3);
        if (j + 1 < NT) { SWRITE1(cb ^ 1); }
        if constexpr (CONV) conv_flush(*cs, lane);
        __syncthreads();
    }
    if (hi == 0) li_l[r32] = l_reg; asm volatile("s_waitcnt lgkmcnt(0)" ::: "memory");
    float rli[16];
#pragma unroll
    for (int r = 0; r < 16; ++r) rli[r] = __builtin_amdgcn_rcpf(li_l[crow(r, hi)]);
    attn_epilogue<LDO>(o, rli, Ob + (long)(wid * QBLK) * LDO, mode, lam, subln, r32, hi);
    asm volatile("s_waitcnt vmcnt(0) lgkmcnt(0)" ::: "memory");
    __syncthreads();
#undef SLOAD1
#undef SWRITE1
}
#undef KSWZ
#undef SBAR
}

struct Args { const void* in[22]; float* out; unsigned char* ws; int ph_lo, ph_hi, li, pad; };
typedef const __attribute__((address_space(4))) Args* KArgs;
__device__ __forceinline__ KArgs kargs() { KArgs p = (KArgs)__builtin_amdgcn_kernarg_segment_ptr(); asm volatile("" : "+s"(p)); return p; }
struct Frame {
    LAS unsigned char* lds; char* ldsg;
    int tid, lane, wave, vcu, G;
    unsigned char* ws;
};
extern __shared__ __attribute__((aligned(16))) unsigned char g_lds[];
__device__ __forceinline__ Frame mkframe(KArgs a) {
    Frame F; int t = threadIdx.x; asm volatile("" : "+v"(t));
    F.lds = (LAS unsigned char*)g_lds; F.ldsg = (char*)g_lds;
    F.tid = t; F.lane = t & 63; F.wave = __builtin_amdgcn_readfirstlane(t >> 6);
    int g = gridDim.x, bx = blockIdx.x; asm volatile("" : "+s"(g), "+s"(bx));
    F.G = g; F.vcu = (g % 8 == 0) ? (bx % 8) * (g / 8) + bx / 8 : bx;
    F.ws = a->ws;
    return F;
}

__device__ __forceinline__ void sincos_d(double a, float& s, float& c) {
    const double k = __builtin_rint(a * 0.63661977236758134308);
    double r = __builtin_fma(-k, 1.57079632679489655800e+00, a); r = __builtin_fma(-k, 6.12323399573676603587e-17, r);
    const double r2 = r * r;
    double sp = -7.6471637318198164759e-13;
    sp = __builtin_fma(sp, r2, 1.6059043836821614599e-10);
    sp = __builtin_fma(sp, r2, -2.5052108385441718775e-08);
    sp = __builtin_fma(sp, r2, 2.7557319223985890653e-06);
    sp = __builtin_fma(sp, r2, -1.9841269841269841270e-04);
    sp = __builtin_fma(sp, r2, 8.3333333333333333333e-03);
    sp = __builtin_fma(sp, r2, -1.6666666666666666667e-01);
    const double sr = __builtin_fma(sp * r2, r, r);
    double cp = 4.7794773323873852974e-14;
    cp = __builtin_fma(cp, r2, -1.1470745597729724714e-11);
    cp = __builtin_fma(cp, r2, 2.0876756987868098979e-09);
    cp = __builtin_fma(cp, r2, -2.7557319223985890653e-07);
    cp = __builtin_fma(cp, r2, 2.4801587301587301587e-05);
    cp = __builtin_fma(cp, r2, -1.3888888888888888889e-03);
    cp = __builtin_fma(cp, r2, 4.1666666666666666667e-02);
    cp = __builtin_fma(cp, r2, -0.5);
    const double cr = __builtin_fma(cp, r2, 1.0);
    const int q = (int)((long long)k & 3);
    const double ss = (q & 1) ? cr : sr, cc = (q & 1) ? sr : cr;
    s = (float)((q & 2) ? -ss : ss); c = (float)(((q + 1) & 2) ? -cc : cc);
}
__device__ const double INV_M[32] = {
    1.0, 0.7498942093324559, 0.5623413251903491, 0.4216965034285822, 0.31622776601683794, 0.23713737056616552, 0.1778279410038923, 0.1333521432163324,
    0.1, 0.07498942093324558, 0.05623413251903491, 0.04216965034285822, 0.03162277660168379, 0.023713737056616554, 0.01778279410038923, 0.01333521432163324,
    0.01, 0.007498942093324559, 0.005623413251903491, 0.004216965034285822, 0.0031622776601683794, 0.0023713737056616554, 0.001778279410038923, 0.001333521432163324,
    0.001, 0.0007498942093324559, 0.0005623413251903491, 0.0004216965034285822, 0.00031622776601683794, 0.00023713737056616554, 0.0001778279410038923, 0.0001333521432163324 };
__device__ const double INV_D[8] = { 1.0, 0.19392274474868576, 0.03760603093086393, 0.007292664737217109, 0.001414213562373095, 0.0002742481756762073, 5.318295896944988e-05, 1.031338537721246e-05 };

template <class FD>
__device__ __forceinline__ void tr_item64(const float* W, int Nsrc, int K, f16* WT, FD dstrow, LAS float* scr, int kb, int cb, int lane, const float* kscale = nullptr) {
    const int k0 = 64 * kb, c0 = 64 * cb, r4 = lane >> 4, cq = (lane & 15) * 4;
    f32x4 v[16];
#pragma unroll
    for (int i = 0; i < 16; ++i) v[i] = *(const f32x4*)(W + (size_t)(k0 + 4 * i + r4) * Nsrc + c0 + cq);
    if (kscale) {
#pragma unroll
        for (int i = 0; i < 16; ++i) v[i] = v[i] * kscale[k0 + 4 * i + r4]; }
#pragma unroll
    for (int i = 0; i < 16; ++i) { const int k = 4 * i + r4, sw = (i >> 1) * 4;
#pragma unroll
        for (int w = 0; w < 4; ++w) scr[k * 64 + ((cq + w) ^ sw)] = v[i][w]; }
    LDS_WAIT(); asm volatile("" ::: "memory");
    const int c = lane & 7;
#pragma unroll
    for (int j = 0; j < 8; ++j) { const int col = (lane >> 3) + 8 * j; const int dr = dstrow(c0 + col); const LAS float* sp = scr + (8 * c) * 64 + (col ^ (c * 4));
        h8 o; o[0] = (f16)sp[0 * 64]; o[1] = (f16)sp[1 * 64]; o[2] = (f16)sp[2 * 64]; o[3] = (f16)sp[3 * 64]; o[4] = (f16)sp[4 * 64]; o[5] = (f16)sp[5 * 64]; o[6] = (f16)sp[6 * 64]; o[7] = (f16)sp[7 * 64];
        *(h8*)(WT + (size_t)dr * K + k0 + 8 * c) = o; }
    LDS_WAIT(); asm volatile("" ::: "memory");
}
struct RowId { __device__ __forceinline__ int operator()(int c) const { return c; } };
struct RowWin0 { __device__ __forceinline__ int operator()(int c) const { if (c < 640) return c; const int jj = c - 640; return 640 + 2 * (jj & 31) + (jj >> 5); } };
struct RowUq { __device__ __forceinline__ int operator()(int c) const { const int h = c / 192, j = c % 192; if (j < 128) return h * 128 + j; const int jj = j - 128; return 1024 + h * 64 + 2 * (jj & 31) + (jj >> 5); } };
struct RowDiff { __device__ __forceinline__ int operator()(int c) const { if (c >= 2048) return c; const int off = c & 63; if (off >= 16) return c; return (c & ~63) + 2 * (off & 7) + (off >> 3); } };
struct RowMoeIn { __device__ __forceinline__ int operator()(int c) const { const int f = c & 2047; return (f >> 2) * 8 + (f & 3) + ((c >> 11) << 2); } };

__device__ __forceinline__ void p0_prologue() {
    const KArgs a = kargs(); const Frame F = mkframe(a);
    const int tid = F.tid, lane = F.lane;
    {
        const float* cin = (const float*)a->in[1]; const float* ada_w = (const float*)a->in[3]; const float* ada_b = (const float*)a->in[4];
        float* mods = (float*)(F.ws + WS_MODS);
        LAS float* sc = (LAS float*)F.lds; LAS float* red = (LAS float*)(F.lds + 16384);
        for (int i = tid; i < 4096; i += NTHREADS) { const float v = cin[i]; sc[i] = v / (1.0f + __expf(-v)); }
        __syncthreads();
        for (int cb = blockIdx.x; cb < 256; cb += F.G) {
            const int f0 = cb * 48, l = f0 / 6144, e0 = f0 % 6144; const int g = tid / 12, cc = tid % 12;
            if (g < 40) { f32x4 a0 = {0.f, 0.f, 0.f, 0.f}, a1 = a0, a2 = a0, a3 = a0; const float* wp = ada_w + (size_t)l * 1024 * 6144 + e0 + 4 * cc;
                f32x4 w[26];
#pragma unroll
                for (int i = 0; i < 26; ++i) { const int d = g + 40 * i; w[i] = (d < 1024) ? *(const f32x4*)(wp + (size_t)d * 6144) : (f32x4){0.f, 0.f, 0.f, 0.f}; }
#pragma unroll
                for (int i = 0; i < 26; ++i) { const int d = (g + 40 * i) & 1023; a0 += w[i] * sc[d]; a1 += w[i] * sc[1024 + d]; a2 += w[i] * sc[2048 + d]; a3 += w[i] * sc[3072 + d]; }
                LAS f32x4* rp = (LAS f32x4*)red + (g * 12 + cc) * 4; rp[0] = a0; rp[1] = a1; rp[2] = a2; rp[3] = a3; }
            __syncthreads();
            if (tid < 192) { const int c2 = tid % 48, b = tid / 48; float s = 0.f;
#pragma unroll 8
                for (int gg = 0; gg < 40; ++gg) s += red[((gg * 12 + (c2 >> 2)) * 4 + b) * 4 + (c2 & 3)];
                mods[(size_t)(l * 4 + b) * 6144 + e0 + c2] = s + ada_b[l * 6144 + e0 + c2]; }
            __syncthreads();
        }
    }
    {
        const int* pos = (const int*)a->in[2];
        float* cosm = (float*)(F.ws + WS_COSM); float* sinm = (float*)(F.ws + WS_SINM); float* cosd = (float*)(F.ws + WS_COSD); float* sind = (float*)(F.ws + WS_SIND);
        for (int i = blockIdx.x * NTHREADS + tid; i < T * 40; i += F.G * NTHREADS) {
            const int t = i / 40, j = i % 40; const double p = (double)pos[t]; float s, c;
            if (j < 32) { sincos_d(p * INV_M[j], s, c); cosm[(size_t)t * 32 + j] = c; sinm[(size_t)t * 32 + j] = s; }
            else { sincos_d(p * INV_D[j - 32], s, c); cosd[(size_t)t * 8 + (j - 32)] = c; sind[(size_t)t * 8 + (j - 32)] = s; }
        }
    }
    {
        LAS float* scr = (LAS float*)(F.lds + F.wave * 16384);
        const int gw = F.vcu * NWAVES + F.wave, NGW = F.G * NWAVES;
        { f16* z = (f16*)(F.ws + WS_WIN0) + (size_t)704 * 1024; for (int i = blockIdx.x * NTHREADS + tid; i < 8192; i += F.G * NTHREADS) *(u32x4*)(z + (size_t)i * 8) = (u32x4){0u, 0u, 0u, 0u}; }
        __syncthreads();
        constexpr int I0 = 16 * 11, I1 = 6 * 24, I2 = 4 * 32, I3 = 16 * 16, I4 = 16 * 48, I5 = 16 * 16;
        constexpr int ISM = I0 + I1 + I2 + I3 + I4 + I5;
        constexpr int IMI = 16 * 64, IMO = 32 * 16;
        constexpr int NITEMS = ISM;
        for (int it = gw; it < NITEMS; it += NGW) {
            int r = it;
            if (r < I0) { tr_item64((const float*)a->in[9], 704, 1024, (f16*)(F.ws + WS_WIN0), RowWin0(), scr, r / 11, r % 11, lane); continue; } r -= I0;
            if (r < I1) { tr_item64((const float*)a->in[12], 1536, 384, (f16*)(F.ws + WS_WUQ), RowUq(), scr, r / 24, r % 24, lane, (const float*)a->in[10]); continue; } r -= I1;
            if (r < I2) { tr_item64((const float*)a->in[13], 2048, 256, (f16*)(F.ws + WS_WUKV), RowId(), scr, r / 32, r % 32, lane, (const float*)a->in[11]); continue; } r -= I2;
            if (r < I3) { tr_item64((const float*)a->in[14], 1024, 1024, (f16*)(F.ws + WS_WO0), RowId(), scr, r / 16, r % 16, lane); continue; } r -= I3;
            if (r < I4) { tr_item64((const float*)a->in[15], 3072, 1024, (f16*)(F.ws + WS_WIN1), RowDiff(), scr, r / 48, r % 48, lane); continue; } r -= I4;
            if (r < I5) { tr_item64((const float*)a->in[18], 1024, 1024, (f16*)(F.ws + WS_WO1), RowId(), scr, r / 16, r % 16, lane); continue; }
        }
    }
}

__device__ __forceinline__ void mod_rows_p1() {
    const KArgs a = kargs(); const Frame F = mkframe(a);
    const float* x = (const float*)a->in[0]; const float* mods_l = (const float*)(F.ws + WS_MODS); f16* out = (f16*)(F.ws + WS_HA);
    const int gw = F.vcu * NWAVES + F.wave, NGW = F.G * NWAVES, lane = F.lane;
    for (int m0 = gw; m0 < T; m0 += 2 * NGW) {
        f32x4 v[2][4];
#pragma unroll
        for (int u = 0; u < 2; ++u) { const int m = m0 + u * NGW; if (m < T) {
#pragma unroll
            for (int j = 0; j < 4; ++j) v[u][j] = *(const f32x4*)(x + (size_t)m * DM + 4 * lane + 256 * j); } }
#pragma unroll
        for (int u = 0; u < 2; ++u) { const int m = m0 + u * NGW; if (m < T) { const float* mb = mods_l + (m >> 12) * 6144;
#pragma unroll
            for (int j = 0; j < 4; ++j) { const int c = 4 * lane + 256 * j; const f32x4 sh = *(const f32x4*)(mb + c), sc = *(const f32x4*)(mb + 1024 + c);
                const f32x4 h = v[u][j] * (sc + 1.0f) + sh; h4 o; o[0] = (f16)h[0]; o[1] = (f16)h[1]; o[2] = (f16)h[2]; o[3] = (f16)h[3];
                *(h4*)(out + (size_t)m * DM + c) = o; } } }
    }
}

#define RCOL(lane, j) ((((j) >> 1) << 9) + 8 * (lane) + 4 * ((j) & 1))
__device__ __forceinline__ void h8_to_f4(const h8 v, f32x4& a, f32x4& b) { a = (f32x4){(float)v[0], (float)v[1], (float)v[2], (float)v[3]}; b = (f32x4){(float)v[4], (float)v[5], (float)v[6], (float)v[7]}; }
__device__ __forceinline__ void ln_router(int l) {
    const KArgs a = kargs(); const Frame F = mkframe(a);
    const float* lng = (const float*)a->in[5] + l * DM; const float* lnb = (const float*)a->in[6] + l * DM; const float* router_w = (const float*)a->in[19] + (size_t)l * DM * NE;
    const float* mods_l = (const float*)(F.ws + WS_MODS) + (size_t)l * 4 * 6144;
    const f16* pre = (const f16*)(F.ws + WS_PRE); float* stat = (float*)(F.ws + WS_STAT); f16* hB = (f16*)(F.ws + WS_HB); float* aff = (float*)(F.ws + WS_AFF);
    LAS float* rwT = (LAS float*)F.lds;
    for (int i = F.tid; i < 16384; i += NTHREADS) { const int d = i >> 4, e = i & 15; const int seg = d >> 9, w = d & 511; rwT[e * 1024 + seg * 512 + ((w >> 2) & 1) * 256 + (w >> 3) * 4 + (w & 3)] = router_w[i]; }
    __syncthreads();
    const int gw = F.vcu * NWAVES + F.wave, NGW = F.G * NWAVES, lane = F.lane;
    for (int m0 = gw; m0 < T; m0 += 2 * NGW) {
        h8 pv[2][2];
#pragma unroll
        for (int u = 0; u < 2; ++u) { const int m = (m0 + u * NGW < T) ? m0 + u * NGW : m0; pv[u][0] = *(const h8*)(pre + (size_t)m * DM + 8 * lane); pv[u][1] = *(const h8*)(pre + (size_t)m * DM + 512 + 8 * lane); }
#pragma unroll
        for (int u = 0; u < 2; ++u) { const int m = m0 + u * NGW; if (m < T) {
        const int b = m >> 12, s_ = m & 4095; const float* mb = mods_l + b * 6144;
        f32x4 v[4]; h8_to_f4(pv[u][0], v[0], v[1]); h8_to_f4(pv[u][1], v[2], v[3]); float s = 0.f;
#pragma unroll
        for (int j = 0; j < 4; ++j) s += (v[j][0] + v[j][1]) + (v[j][2] + v[j][3]);
        const float mean = wave_sum(s) * (1.f / DM); float s2 = 0.f;
#pragma unroll
        for (int j = 0; j < 4; ++j) { v[j] = v[j] - mean; s2 += (v[j][0] * v[j][0] + v[j][1] * v[j][1]) + (v[j][2] * v[j][2] + v[j][3] * v[j][3]); }
        const float rstd = 1.0f / sqrtf(wave_sum(s2) * (1.f / DM) + LN_EPS);
        if (lane == 0) { f32x2 st = {mean, rstd}; *(f32x2*)(stat + (size_t)m * 2) = st; }
        float lg[16];
#pragma unroll
        for (int e = 0; e < 16; ++e) lg[e] = 0.f;
        f32x4 hh[4];
#pragma unroll
        for (int j = 0; j < 4; ++j) { const int c = RCOL(lane, j);
            const f32x4 g = *(const f32x4*)(lng + c), bb = *(const f32x4*)(lnb + c), sh = *(const f32x4*)(mb + 3072 + c), sc = *(const f32x4*)(mb + 4096 + c);
            const f32x4 xn = v[j] * rstd * g + bb; const f32x4 h = xn * (sc + 1.0f) + sh; hh[j] = h;
#pragma unroll
            for (int e = 0; e < 16; ++e) { const f32x4 w = *(const LAS f32x4*)(rwT + e * 1024 + (j >> 1) * 512 + (j & 1) * 256 + lane * 4); lg[e] += (h[0] * w[0] + h[1] * w[1]) + (h[2] * w[2] + h[3] * w[3]); }
            asm volatile("" ::: "memory"); }
        *(h8*)(hB + (size_t)m * DM + 8 * lane) = pack8(hh[0], hh[1]); *(h8*)(hB + (size_t)m * DM + 512 + 8 * lane) = pack8(hh[2], hh[3]);
        float mx = -1e30f;
#pragma unroll
        for (int e = 0; e < 16; ++e) { lg[e] = wave_sum(lg[e]); mx = fmaxf(mx, lg[e]); }
        float den = 0.f;
#pragma unroll
        for (int e = 0; e < 16; ++e) { lg[e] = __expf(lg[e] - mx); den += lg[e]; }
        const float rden = 1.0f / den; float mine = 0.f;
#pragma unroll
        for (int e = 0; e < 16; ++e) mine = (lane == e) ? lg[e] * rden : mine;
        if (lane < 16) aff[(size_t)(b * 16 + lane) * SEQ + s_] = mine;
        } }
    }
    __syncthreads();
}

__device__ __forceinline__ int block_excl_scan(int v, LAS int* tmp, int tid, int& total) {
    const int lane = tid & 63, wid = tid >> 6; int x = v;
#pragma unroll
    for (int o = 1; o < 64; o <<= 1) { const int y = __shfl_up(x, o); if (lane >= o) x += y; }
    if (lane == 63) tmp[wid] = x;
    __syncthreads();
    int base = 0, tot = 0;
#pragma unroll
    for (int w = 0; w < 8; ++w) { const int t = tmp[w]; if (w < wid) base += t; tot += t; }
    __syncthreads();
    total = tot; return base + x - v;
}
__device__ __forceinline__ void topk_phase() {
    const KArgs a = kargs(); const Frame F = mkframe(a);
    const float* aff = (const float*)(F.ws + WS_AFF); float* gate = (float*)(F.ws + WS_GATE); int* rowtok = (int*)(F.ws + WS_ROWTOK); int* inv = (int*)(F.ws + WS_INV);
    LAS unsigned* hist = (LAS unsigned*)F.lds; LAS unsigned* selw = hist + 256; LAS int* tmp = (LAS int*)(hist + 272);
    const int tid = F.tid;
    for (int p = blockIdx.x; p < NB * NE; p += F.G) { const int b = p >> 4, e = p & 15;
        const float* ap = aff + (size_t)p * SEQ + 8 * tid; unsigned key[8];
        { const f32x4 a0 = *(const f32x4*)ap, a1 = *(const f32x4*)(ap + 4);
          key[0] = __float_as_uint(a0[0]); key[1] = __float_as_uint(a0[1]); key[2] = __float_as_uint(a0[2]); key[3] = __float_as_uint(a0[3]);
          key[4] = __float_as_uint(a1[0]); key[5] = __float_as_uint(a1[1]); key[6] = __float_as_uint(a1[2]); key[7] = __float_as_uint(a1[3]); }
        unsigned prefix = 0u, kk = CAP;
        for (int pass = 0; pass < 4; ++pass) { const int shift = 24 - 8 * pass;
            if (tid < 256) hist[tid] = 0u;
            __syncthreads();
#pragma unroll
            for (int j = 0; j < 8; ++j) { const bool match = (pass == 0) || ((key[j] >> (shift + 8)) == prefix); if (match) atomicAdd((unsigned*)&hist[(key[j] >> shift) & 255u], 1u); }
            __syncthreads();
            { const int hv = (tid < 256) ? (int)hist[255 - tid] : 0; int tot_; const int Sp = block_excl_scan(hv, tmp, tid, tot_);
              if (tid < 256 && (unsigned)Sp < kk && kk <= (unsigned)(Sp + hv)) { selw[0] = 255u - (unsigned)tid; selw[1] = kk - (unsigned)Sp; } }
            __syncthreads();
            prefix = (prefix << 8) | selw[0]; kk = selw[1];
            __syncthreads();
        }
        int ce = 0;
#pragma unroll
        for (int j = 0; j < 8; ++j) ce += (key[j] == prefix) ? 1 : 0;
        int tot; int eqr = block_excl_scan(ce, tmp, tid, tot);
        unsigned selm = 0u; int cs = 0;
#pragma unroll
        for (int j = 0; j < 8; ++j) { bool sel = key[j] > prefix; if (key[j] == prefix) { sel = (unsigned)eqr < kk; ++eqr; } if (sel) { selm |= 1u << j; ++cs; } }
        int slot = block_excl_scan(cs, tmp, tid, tot);
#pragma unroll
        for (int j = 0; j < 8; ++j) { const int s_ = 8 * tid + j; const int tok = b * SEQ + s_; const bool sel = (selm >> j) & 1u;
            if (sel) { const int row = e * EROWS + b * CAP + slot; rowtok[row] = tok; gate[row] = __uint_as_float(key[j]); inv[(size_t)tok * 16 + e] = slot; ++slot; }
            else inv[(size_t)tok * 16 + e] = -1; }
        __syncthreads();
    }
}
__device__ __forceinline__ void combine_ln(int l) {
    const KArgs a = kargs(); const Frame F = mkframe(a);
    const float* lng1 = (const float*)a->in[5] + l * DM; const float* lnb1 = (const float*)a->in[6] + l * DM;
    const float* lng = (const float*)a->in[7] + l * DM; const float* lnb = (const float*)a->in[8] + l * DM;
    const float* mods_l = (const float*)(F.ws + WS_MODS) + (size_t)l * 4 * 6144; const float* mods_next = (const float*)(F.ws + WS_MODS) + (size_t)4 * 6144;
    float* xo32 = a->out; f16* x2 = (f16*)(F.ws + WS_X2); f16* hA = (f16*)(F.ws + WS_HA);
    const f16* pre = (const f16*)(F.ws + WS_PRE); const float* stat = (const float*)(F.ws + WS_STAT); const f16* y = (const f16*)(F.ws + WS_Y); const int* inv = (const int*)(F.ws + WS_INV);
    const int gw = F.vcu * NWAVES + F.wave, NGW = F.G * NWAVES, lane = F.lane;
    for (int m0 = gw; m0 < T; m0 += 2 * NGW) {
        int myinv[2]; h8 pv[2][2]; f32x2 st[2];
#pragma unroll
        for (int u = 0; u < 2; ++u) { const int m = (m0 + u * NGW < T) ? m0 + u * NGW : m0; myinv[u] = inv[(size_t)m * 16 + (lane & 15)]; st[u] = *(const f32x2*)(stat + (size_t)m * 2);
            pv[u][0] = *(const h8*)(pre + (size_t)m * DM + 8 * lane); pv[u][1] = *(const h8*)(pre + (size_t)m * DM + 512 + 8 * lane); }
#pragma unroll
        for (int u = 0; u < 2; ++u) { const int m = m0 + u * NGW; if (m < T) {
        const int b = m >> 12; const float* mb = mods_l + b * 6144;
        f32x4 f[4];
#pragma unroll
        for (int j = 0; j < 4; ++j) f[j] = (f32x4){0.f, 0.f, 0.f, 0.f};
        unsigned mask = (unsigned)(__ballot(myinv[u] >= 0) & 0xFFFFull);
        while (mask) {
            const int e0 = __builtin_ctz(mask); mask &= mask - 1u; const bool two = mask != 0u; const int e1 = two ? __builtin_ctz(mask) : e0; mask &= mask - 1u;
            const int s0 = __shfl(myinv[u], e0), s1 = __shfl(myinv[u], e1);
            const f16* y0 = y + (size_t)(e0 * EROWS + b * CAP + s0) * DM; const f16* y1 = y + (size_t)(e1 * EROWS + b * CAP + s1) * DM;
            const h8 a00 = *(const h8*)(y0 + 8 * lane), a01 = *(const h8*)(y0 + 512 + 8 * lane), a10 = *(const h8*)(y1 + 8 * lane), a11 = *(const h8*)(y1 + 512 + 8 * lane);
            const float w1 = two ? 1.0f : 0.0f; f32x4 t0, t1;
            h8_to_f4(a00, t0, t1); f[0] += t0; f[1] += t1; h8_to_f4(a01, t0, t1); f[2] += t0; f[3] += t1;
            h8_to_f4(a10, t0, t1); f[0] += t0 * w1; f[1] += t1 * w1; h8_to_f4(a11, t0, t1); f[2] += t0 * w1; f[3] += t1 * w1;
        }
        f32x4 v[4]; h8_to_f4(pv[u][0], v[0], v[1]); h8_to_f4(pv[u][1], v[2], v[3]); float s = 0.f;
#pragma unroll
        for (int j = 0; j < 4; ++j) { const int c = RCOL(lane, j); const f32x4 g1 = *(const f32x4*)(lng1 + c), b1 = *(const f32x4*)(lnb1 + c), g2 = *(const f32x4*)(mb + 5120 + c);
            const f32x4 x1 = (v[j] - st[u][0]) * st[u][1] * g1 + b1;
            v[j] = x1 * ALPHA + (g2 + 1.0f) * f[j]; s += (v[j][0] + v[j][1]) + (v[j][2] + v[j][3]); }
        const float mean = wave_sum(s) * (1.f / DM); float s2 = 0.f;
#pragma unroll
        for (int j = 0; j < 4; ++j) { v[j] = v[j] - mean; s2 += (v[j][0] * v[j][0] + v[j][1] * v[j][1]) + (v[j][2] * v[j][2] + v[j][3] * v[j][3]); }
        const float rstd = 1.0f / sqrtf(wave_sum(s2) * (1.f / DM) + LN_EPS);
        f32x4 xn[4];
#pragma unroll
        for (int j = 0; j < 4; ++j) { const int c = RCOL(lane, j); const f32x4 g = *(const f32x4*)(lng + c), bb = *(const f32x4*)(lnb + c); xn[j] = v[j] * rstd * g + bb; }
        if (l == 0) {
            *(h8*)(x2 + (size_t)m * DM + 8 * lane) = pack8(xn[0], xn[1]); *(h8*)(x2 + (size_t)m * DM + 512 + 8 * lane) = pack8(xn[2], xn[3]);
            const float* mn = mods_next + b * 6144; f32x4 hv[4];
#pragma unroll
            for (int j = 0; j < 4; ++j) { const int c = RCOL(lane, j); const f32x4 sh = *(const f32x4*)(mn + c), sc = *(const f32x4*)(mn + 1024 + c); hv[j] = xn[j] * (sc + 1.0f) + sh; }
            *(h8*)(hA + (size_t)m * DM + 8 * lane) = pack8(hv[0], hv[1]); *(h8*)(hA + (size_t)m * DM + 512 + 8 * lane) = pack8(hv[2], hv[3]);
        } else {
#pragma unroll
            for (int j = 0; j < 4; ++j) *(f32x4*)(xo32 + (size_t)m * DM + RCOL(lane, j)) = xn[j];
        }
        } }
    }
}

__device__ __forceinline__ void attn_mla() {
    const KArgs a = kargs(); const Frame F = mkframe(a);
    const f16* Q = (const f16*)(F.ws + WS_Q); const f16* K = (const f16*)(F.ws + WS_K); const f16* V = (const f16*)(F.ws + WS_V); f16* O = (f16*)(F.ws + WS_O);
    att::ConvStream cs; att::conv_init(cs, (const float*)a->in[20], (const float*)a->in[21], (f16*)(F.ws + WS_MOEIN), (f16*)(F.ws + WS_MOEOUT), 0, F.vcu * NWAVES + F.wave, F.G * NWAVES, 4, F.ldsg + 83968 + F.wave * 4096);
    for (int u = F.vcu; u < NB * 8 * 16; u += F.G) { const int qb = u & 15, bh = u >> 4, h = bh & 7, b = bh >> 3;
        att::attn_body_simple<192, 1536, 1536, 1024, 1024, true>(Q + (size_t)(b * SEQ + qb * 256) * 1536 + h * 192, K + (size_t)(b * SEQ) * 1536 + h * 192, V + (size_t)(b * SEQ) * 1024 + h * 128,
                                                                 O + (size_t)(b * SEQ + qb * 256) * 1024 + h * 128, F.ldsg, 0, 0.f, nullptr, &cs); }
    while (cs.step < cs.step_end) { cs.it = 0; att::conv_tick(cs, F.lane); att::conv_flush(cs, F.lane); }
    att::conv_flush(cs, F.lane); att::conv_drain(cs, F.lane);
}
__device__ __forceinline__ void attn_diff() {
    const KArgs a = kargs(); const Frame F = mkframe(a);
    const f16* QKV = (const f16*)(F.ws + WS_QKV1); f16* O = (f16*)(F.ws + WS_O);
    const float* lamv = (const float*)a->in[16]; const float* subln = (const float*)a->in[17];
    const float l01 = wave_sum(lamv[F.lane] * lamv[64 + F.lane]), l23 = wave_sum(lamv[128 + F.lane] * lamv[192 + F.lane]);
    const float lam = expf(l01) - expf(l23) + LAMBDA_INIT;
    att::ConvStream cs; att::conv_init(cs, (const float*)a->in[20], (const float*)a->in[21], (f16*)(F.ws + WS_MOEIN), (f16*)(F.ws + WS_MOEOUT), 1, F.vcu * NWAVES + F.wave, F.G * NWAVES, 8, F.ldsg + 51200 + F.wave * 4096);
    for (int u = F.vcu; u < NB * 8 * 16; u += F.G) { const int qb = u & 15, bh = u >> 4, h = bh & 7, b = bh >> 3;
        f16* Ob = O + (size_t)(b * SEQ + qb * 256) * 1024 + h * 128; const f16* Vh = QKV + (size_t)(b * SEQ) * 3072 + 2048 + h * 128;
#pragma unroll 1
        for (int c = 0; c < 2; ++c) { const int hh = 2 * h + c;
            att::attn_body_simple<64, 3072, 3072, 3072, 1024, true>(QKV + (size_t)(b * SEQ + qb * 256) * 3072 + hh * 64, QKV + (size_t)(b * SEQ) * 3072 + 1024 + hh * 64, Vh, Ob, F.ldsg, c, lam, subln, &cs); } }
    cs.it = 0;
    while (cs.step < cs.step_end) { cs.it = 0; att::conv_tick(cs, F.lane); att::conv_flush(cs, F.lane); }
    att::conv_flush(cs, F.lane); att::conv_drain(cs, F.lane);
}

__device__ __forceinline__ void ph_gemm_lat() { const KArgs a = kargs(); const Frame F = mkframe(a);
    pg8::Gemm g{(const f16*)(F.ws + WS_HA), (const f16*)(F.ws + WS_WIN0), T, 768, 1024, 1 << 30, 0, nullptr}; pg8::StaticOrder S; S.init(T, 768, F.G, (int)blockIdx.x);
    EpiLat E{(f16*)(F.ws + WS_CQN), (f16*)(F.ws + WS_CKVN), (f16*)(F.ws + WS_K), (float*)(F.ws + WS_PQ), (float*)(F.ws + WS_PKV), (const float*)(F.ws + WS_COSM), (const float*)(F.ws + WS_SINM)}; pg8::gemm_phase<EpiLat>(F.lds, g, S, E); }
__device__ __forceinline__ void ph_gemm_q() { const KArgs a = kargs(); const Frame F = mkframe(a);
    pg8::Gemm g{(const f16*)(F.ws + WS_CQN), (const f16*)(F.ws + WS_WUQ), T, 1024, 384, 1 << 30, 0, nullptr}; pg8::StaticOrder S; S.init(T, 1024, F.G, (int)blockIdx.x);
    EpiQNope E{(f16*)(F.ws + WS_Q), (const float*)(F.ws + WS_PQ)}; pg8::gemm_phase<EpiQNope>(F.lds, g, S, E); }
__device__ __forceinline__ void ph_gemm_qr() { const KArgs a = kargs(); const Frame F = mkframe(a);
    pg8::Gemm g{(const f16*)(F.ws + WS_CQN), (const f16*)(F.ws + WS_WUQ) + (size_t)1024 * 384, T, 512, 384, 1 << 30, 0, nullptr}; pg8::StaticOrder S; S.init(T, 512, F.G, (int)blockIdx.x);
    EpiQRope E{(f16*)(F.ws + WS_Q), (const float*)(F.ws + WS_COSM), (const float*)(F.ws + WS_SINM), (const float*)(F.ws + WS_PQ)}; pg8::gemm_phase<EpiQRope>(F.lds, g, S, E); }
__device__ __forceinline__ void ph_gemm_kv() { const KArgs a = kargs(); const Frame F = mkframe(a);
    pg8::Gemm g{(const f16*)(F.ws + WS_CKVN), (const f16*)(F.ws + WS_WUKV), T, 2048, 256, 1 << 30, 0, nullptr}; pg8::StaticOrder S; S.init(T, 2048, F.G, (int)blockIdx.x);
    EpiKV E{(f16*)(F.ws + WS_K), (f16*)(F.ws + WS_V), (const float*)(F.ws + WS_PKV)}; pg8::gemm_phase<EpiKV>(F.lds, g, S, E); }
__device__ __forceinline__ void ph_gemm_o(int l) { const KArgs a = kargs(); const Frame F = mkframe(a);
    pg8::Gemm g{(const f16*)(F.ws + WS_O), (const f16*)(F.ws + (l == 0 ? WS_WO0 : WS_WO1)), T, 1024, 1024, 1 << 30, 0, nullptr}; pg8::StaticOrder S; S.init(T, 1024, F.G, (int)blockIdx.x);
    const float* gm = (const float*)(F.ws + WS_MODS) + (size_t)l * 4 * 6144 + 2048;
    if (l == 0) { EpiPre<false> E{a->in[0], gm, (f16*)(F.ws + WS_PRE)}; pg8::gemm_phase<EpiPre<false>>(F.lds, g, S, E); }
    else { EpiPre<true> E{(const void*)(F.ws + WS_X2), gm, (f16*)(F.ws + WS_PRE)}; pg8::gemm_phase<EpiPre<true>>(F.lds, g, S, E); } }
__device__ __forceinline__ void ph_gemm_diffin() { const KArgs a = kargs(); const Frame F = mkframe(a);
    pg8::Gemm g{(const f16*)(F.ws + WS_HA), (const f16*)(F.ws + WS_WIN1), T, 3072, 1024, 1 << 30, 0, nullptr}; pg8::StaticOrder S; S.init(T, 3072, F.G, (int)blockIdx.x);
    EpiDiffIn E{(f16*)(F.ws + WS_QKV1), (const float*)(F.ws + WS_COSD), (const float*)(F.ws + WS_SIND)}; pg8::gemm_phase<EpiDiffIn>(F.lds, g, S, E); }
__device__ __forceinline__ void ph_gemm_up(int l) { const KArgs a = kargs(); const Frame F = mkframe(a);
    pg8::Gemm g{(const f16*)(F.ws + WS_HB), (const f16*)(F.ws + WS_MOEIN) + (size_t)l * NE * 4096 * 1024, MROWS, 4096, 1024, EROWS / 256, (size_t)4096 * 1024, (const int*)(F.ws + WS_ROWTOK)}; pg8::StaticOrder S; S.init(MROWS, 4096, F.G, (int)blockIdx.x);
    EpiUp E{(f16*)(F.ws + WS_ACT)}; pg8::gemm_phase<EpiUp, true, true, true>(F.lds, g, S, E); }
__device__ __forceinline__ void ph_gemm_down(int l) { const KArgs a = kargs(); const Frame F = mkframe(a);
    pg8::Gemm g{(const f16*)(F.ws + WS_ACT), (const f16*)(F.ws + WS_MOEOUT) + (size_t)l * NE * 1024 * 2048, MROWS, 1024, 2048, EROWS / 256, (size_t)1024 * 2048, nullptr}; pg8::StaticOrder S; S.init(MROWS, 1024, F.G, (int)blockIdx.x);
    EpiDown E{(f16*)(F.ws + WS_Y), (const float*)(F.ws + WS_GATE)}; pg8::gemm_phase<EpiDown>(F.lds, g, S, E); }

constexpr int NPHASES = 24;
__global__ void __launch_bounds__(NTHREADS, 2) mk_fwd(Args args) {
    LAS unsigned char* ldsp = (LAS unsigned char*)g_lds;
    volatile LAS unsigned* MISC = (volatile LAS unsigned*)(ldsp + MISC_OFF);
    for (int u = threadIdx.x; u < (LDS_BYTES - LDSCTL_OFF) / 4; u += NTHREADS) ((LAS unsigned*)(ldsp + LDSCTL_OFF))[u] = 0u;
    __syncthreads();
    XcdBarrier bar = xcd_barrier_post((unsigned*)(args.ws + WS_CTL) + CW_BAR + args.li * XCD_BAR_WORDS, MISC + 8);
    const int lo = args.ph_lo, hi = args.ph_hi;
#ifndef PH_MASK
#define PH_MASK 0xFFFFFFFFu
#endif
#define IN(k) (((PH_MASK >> (k)) & 1u) && lo <= (k) && (k) < hi)
#define SEAM(k) do { if (lo <= (k) && (k) + 1 < hi) xcd_barrier(bar); } while (0)
#ifndef REP_MASK
#define REP_MASK 0u
#endif
#define RUN(k, call) do { if (IN(k)) { call; if ((REP_MASK >> (k)) & 1u) { __syncthreads(); call; } } } while (0)
    RUN(0, p0_prologue());      SEAM(0);
    RUN(1, mod_rows_p1());      SEAM(1);
    RUN(2, ph_gemm_lat());      SEAM(2);
    RUN(4, ph_gemm_q()); RUN(4, ph_gemm_qr());
    RUN(5, ph_gemm_kv());       SEAM(5);
    RUN(6, attn_mla());         SEAM(6);
#pragma unroll 1
    for (int l = 0; l < 2; ++l) {
        const int pb = (l == 0) ? 7 : 17;
        if (l == 1) {
            RUN(14, ph_gemm_diffin()); SEAM(14);
            RUN(15, attn_diff());      SEAM(15);
        }
        RUN(pb + 0, ph_gemm_o(l));     SEAM(pb + 0);
        RUN(pb + 1, ln_router(l));     SEAM(pb + 1);
        RUN(pb + 2, topk_phase());     SEAM(pb + 2);
        RUN(pb + 4, ph_gemm_up(l));    SEAM(pb + 4);
        RUN(pb + 5, ph_gemm_down(l));  SEAM(pb + 5);
        RUN(pb + 6, combine_ln(l));
        if (l == 0) SEAM(pb + 6);
    }
#undef IN
#undef SEAM
}

extern "C" void kernel_launch(void* const* d_in, const int* in_sizes, int n_in, void* d_out, int out_size, void* d_ws, size_t ws_size, hipStream_t stream) {
    static int grid = 0;
    if (grid == 0) {
        if (n_in != 22 || in_sizes[0] != T * DM || out_size != T * DM || ws_size < WS_END) {
            fprintf(stderr, "kernel_launch: shape/workspace mismatch: n_in %d in0 %d out %d ws %zu (need %zu)\n", n_in, n_in > 0 ? in_sizes[0] : -1, out_size, ws_size, (size_t)WS_END); grid = -1; return; }
        int dev = 0, cus = 0, per_cu = 0;
        if (hipGetDevice(&dev) != hipSuccess || hipDeviceGetAttribute(&cus, hipDeviceAttributeMultiprocessorCount, dev) != hipSuccess) { fprintf(stderr, "kernel_launch: device query failed\n"); grid = -1; return; }
        if (hipFuncSetAttribute((const void*)mk_fwd, hipFuncAttributeMaxDynamicSharedMemorySize, LDS_BYTES) != hipSuccess) { fprintf(stderr, "kernel_launch: hipFuncSetAttribute failed\n"); grid = -1; return; }
        if (hipOccupancyMaxActiveBlocksPerMultiprocessor(&per_cu, (const void*)mk_fwd, NTHREADS, LDS_BYTES) != hipSuccess || per_cu < 1)
            fprintf(stderr, "kernel_launch: note: occupancy query reports %d workgroups per CU\n", per_cu);
        (void)hipGetLastError();
        grid = cus;
    }
    if (grid < 0) return;
    if (hipMemsetAsync((char*)d_ws + WS_CTL, 0, CTL_ZERO_BYTES, stream) != hipSuccess) { fprintf(stderr, "kernel_launch: memset failed\n"); return; }
    Args a{};
    for (int i = 0; i < 22; ++i) a.in[i] = d_in[i];
    a.out = (float*)d_out; a.ws = (unsigned char*)d_ws;
#if MK_CUTS == 1
    a.ph_lo = 0; a.ph_hi = NPHASES; a.li = 0;
    hipLaunchKernelGGL(mk_fwd, dim3(grid), dim3(NTHREADS), LDS_BYTES, stream, a);
#else
    for (int p = 0; p < NPHASES; ++p) { a.ph_lo = p; a.ph_hi = p + 1; a.li = 0; hipLaunchKernelGGL(mk_fwd, dim3(grid), dim3(NTHREADS), LDS_BYTES, stream, a); }
#endif
    const hipError_t le = hipPeekAtLastError();
    if (le != hipSuccess) fprintf(stderr, "kernel_launch: launch failed: %s\n", hipGetErrorName(le));
}
```

```cpp
#include <hip/hip_runtime.h>
#include <cstdio>
#include <cstdint>

#ifndef MK_CUTS
#define MK_CUTS 1
#endif


#define LAS __attribute__((address_space(3)))
#define GAS __attribute__((address_space(1)))
typedef _Float16 f16;
typedef _Float16 h8 __attribute__((ext_vector_type(8)));
typedef _Float16 h4 __attribute__((ext_vector_type(4)));
typedef _Float16 h2 __attribute__((ext_vector_type(2)));
typedef short s16x4 __attribute__((ext_vector_type(4)));
typedef float f32x4 __attribute__((ext_vector_type(4)));
typedef float f32x2 __attribute__((ext_vector_type(2)));
typedef float f32x16 __attribute__((ext_vector_type(16)));
typedef unsigned u32x4 __attribute__((ext_vector_type(4)));
typedef unsigned u32x2 __attribute__((ext_vector_type(2)));

constexpr int NB = 4, SEQ = 4096, DM = 1024, T = NB * SEQ;
constexpr int NE = 16, FF = 2048, CAP = 512, EROWS = NB * CAP;
constexpr int MROWS = NE * EROWS;
constexpr float ALPHA = 1.4142135623730951f;
constexpr float LN_EPS = 1e-5f, LAT_EPS = 1e-6f;
constexpr float LAMBDA_INIT = 0.35550906759096926f;
constexpr int NWAVES = 8, NTHREADS = 512;

constexpr size_t MiB = 1u << 20;
constexpr size_t WS_CTL = 0, CTL_ZERO_BYTES = 1 * MiB;
constexpr size_t WS_MODS = 1 * MiB;
constexpr size_t WS_COSM = 2 * MiB, WS_SINM = 4 * MiB;
constexpr size_t WS_COSD = 6 * MiB, WS_SIND = 6 * MiB + 512 * 1024;
constexpr size_t WS_AFF = 7 * MiB;
constexpr size_t WS_GATE = 8 * MiB;
constexpr size_t WS_ROWTOK = 8 * MiB + 512 * 1024;
constexpr size_t WS_INV = 9 * MiB;
constexpr size_t WS_WIN0 = 16 * MiB;
constexpr size_t WS_WUQ = 18 * MiB;
constexpr size_t WS_WUKV = 20 * MiB;
constexpr size_t WS_WO0 = 22 * MiB;
constexpr size_t WS_WIN1 = 24 * MiB;
constexpr size_t WS_WO1 = 30 * MiB;
constexpr size_t WS_MOEIN = 32 * MiB;
constexpr size_t WS_MOEOUT = 288 * MiB;
constexpr size_t WS_HA = 416 * MiB;
constexpr size_t WS_HB = 448 * MiB;
constexpr size_t WS_PQ = 480 * MiB;
constexpr size_t WS_PKV = 481 * MiB;
constexpr size_t WS_CQN = 528 * MiB;
constexpr size_t WS_CKVN = 540 * MiB;
constexpr size_t WS_Q = 548 * MiB;
constexpr size_t WS_K = 596 * MiB;
constexpr size_t WS_V = 644 * MiB;
constexpr size_t WS_O = 676 * MiB;
constexpr size_t WS_PRE = 708 * MiB;
constexpr size_t WS_STAT = 772 * MiB;
constexpr size_t WS_X2 = 836 * MiB;
constexpr size_t WS_XE = 900 * MiB;
constexpr size_t WS_ACT = 964 * MiB;
constexpr size_t WS_Y = 1092 * MiB;
constexpr size_t WS_QKV1 = 1156 * MiB;
constexpr size_t WS_OD = 1252 * MiB;
constexpr size_t WS_END = 1316 * MiB;
constexpr int CW_BAR = 4096;

constexpr int RING_BYTES = 131072;
constexpr int LDSCTL_OFF = RING_BYTES, MISC_OFF = LDSCTL_OFF + 320;
constexpr int LDS_BYTES = 147456;

#define LDS_WAIT() asm volatile("s_waitcnt lgkmcnt(0)" ::: "memory")
#define VM_WAIT() asm volatile("s_waitcnt vmcnt(0)" ::: "memory")

__device__ __forceinline__ float wave_sum(float v) {
#pragma unroll
    for (int o = 1; o < 64; o <<= 1) v += __shfl_xor(v, o);
    return v;
}

#define XB_TMO      128
#define XB_XCNT(j)  (256  + 64 * (j))
#define XB_XSUB(j)  (1280 + 64 * (j))
#define XB_XGEN(j)  (2304 + 64 * (j))
#define XB_TOP      3328
#define XB_TOPGEN   3392
#define XCD_BAR_WORDS 3456
#define XB_SPIN_CAP (1u << 20)
__device__ __forceinline__ unsigned xb_ld(unsigned* p)              { return __hip_atomic_load(p, __ATOMIC_RELAXED, __HIP_MEMORY_SCOPE_AGENT); }
__device__ __forceinline__ unsigned xb_add(unsigned* p, unsigned v) { return __hip_atomic_fetch_add(p, v, __ATOMIC_RELAXED, __HIP_MEMORY_SCOPE_AGENT); }
__device__ __forceinline__ unsigned xb_xcc_id() { return (unsigned)__builtin_amdgcn_s_getreg((3 << 11) | 20) & 0xFu; }
#define XB_SPIN(cond, bar) do { unsigned _sp = 0; while (cond) { __builtin_amdgcn_s_sleep(1); \
    if ((++_sp & 255u) == 0u) { if (xb_ld(&(bar)[XB_TMO])) break; if (_sp > XB_SPIN_CAP) { atomicAdd(&(bar)[XB_TMO], 1u); break; } } } } while (0)
struct XcdBarrier { unsigned* bar; unsigned x; volatile LAS unsigned* st; };
__device__ __forceinline__ XcdBarrier xcd_barrier_post(unsigned* bar, volatile LAS unsigned* st) {
    XcdBarrier b; b.bar = bar; b.x = xb_xcc_id(); b.st = st;
    if (threadIdx.x == 0) (void)xb_add(&bar[XB_XCNT(b.x)], 1u);
    return b;
}
__device__ __forceinline__ void xcd_barrier_complete(unsigned* bar, unsigned x, unsigned& nloc, unsigned& nx) {
    const unsigned G = gridDim.x * gridDim.y * gridDim.z;
    unsigned sum, cnt, mine, sp = 0u;
    for (;;) {
        sum = 0u; cnt = 0u; mine = 0u;
#pragma unroll
        for (unsigned j = 0; j < 16; ++j) { const unsigned c = xb_ld(&bar[XB_XCNT(j)]); sum += c; cnt += (c > 0u) ? 1u : 0u; mine = (j == x) ? c : mine; }
        if (sum == G) break;
        __builtin_amdgcn_s_sleep(1);
        if ((++sp & 255u) == 0u) { if (xb_ld(&bar[XB_TMO])) break; if (sp > XB_SPIN_CAP) { atomicAdd(&bar[XB_TMO], 1u); break; } }
    }
    nloc = mine > 0u ? mine : 1u; nx = cnt > 0u ? cnt : 1u;
}
__device__ __forceinline__ void xcd_barrier(const XcdBarrier& b) {
    asm volatile("s_waitcnt vmcnt(0)" ::: "memory");
    __syncthreads();
    if (threadIdx.x == 0) {
        unsigned* bar = b.bar;
        __builtin_amdgcn_s_waitcnt(0);
        unsigned nloc = b.st[0], nx = b.st[1];
        if (nloc == 0u) { xcd_barrier_complete(bar, b.x, nloc, nx); b.st[0] = nloc; b.st[1] = nx; }
        const unsigned old = xb_add(&bar[XB_XSUB(b.x)], 1u);
        const unsigned gen = old / nloc;
        if (old + 1u == (gen + 1u) * nloc) {
            __builtin_amdgcn_fence(__ATOMIC_RELEASE, "agent");
            asm volatile("s_waitcnt vmcnt(0)" ::: "memory");
            const unsigned og = xb_add(&bar[XB_TOP], 1u);
            const unsigned tg = og / nx;
            if (og + 1u == (tg + 1u) * nx) xb_add(&bar[XB_TOPGEN], 1u);
            else XB_SPIN(xb_ld(&bar[XB_TOPGEN]) == tg, bar);
            __builtin_amdgcn_fence(__ATOMIC_ACQUIRE, "agent");
            xb_add(&bar[XB_XGEN(b.x)], 1u);
            asm volatile("s_waitcnt vmcnt(0)" ::: "memory");
        } else {
            XB_SPIN(xb_ld(&bar[XB_XGEN(b.x)]) == gen, bar);
            __builtin_amdgcn_fence(__ATOMIC_ACQUIRE, "agent");
            asm volatile("s_waitcnt vmcnt(0)" ::: "memory");
        }
    }
    __syncthreads();
}

namespace pg8 {
constexpr int BM = 256, BK = 64, HALF = 128, HTB = HALF * BK * 2, STAGE_BYTES = 8 * HTB, NXCD = 8, WGM = 8;
__host__ __device__ __forceinline__ int lds_byte(int r, int c) { const int st = (r >> 4) * 2 + (c >> 5), rr = r & 15, cc = c & 31, ob = rr * 64 + cc * 2; return st * 1024 + (ob ^ (((ob >> 9) & 1) << 5)); }
__host__ __device__ __forceinline__ void stage_rc(int b, int& R, int& C) { const int st = b / 1024, sb = b % 1024, swz = sb ^ (((sb >> 9) & 1) << 5); R = (st >> 1) * 16 + swz / 64; C = (st & 1) * 32 + (swz % 64) / 2; }
__host__ __device__ __forceinline__ int perm32(int rho) { const int n = rho >> 4, i = rho & 15; return 8 * (i >> 2) + 4 * n + (i & 3); }
struct Unit { int pm, pn; };
struct Gemm { const f16* A; const f16* Bt; int M, N, K; int grp_tiles; size_t grp_stride; const int* rowidx; };
struct StaticOrder {
    int nM, nN, nwg, G, c;
    __host__ __device__ void init(int M, int N, int G_, int c_) { nM = M / BM; nN = N / BM; nwg = nM * nN; G = G_; c = c_; }
    __host__ __device__ bool next(int i, Unit& u) const {
        const long L = (long)i * G + c; if (L >= nwg) return false;
        int wgid = (int)L; { const int q = nwg / NXCD, r = nwg % NXCD, xcd = wgid % NXCD, off = wgid / NXCD; wgid = (xcd < r ? xcd * (q + 1) : r * (q + 1) + (xcd - r) * q) + off; }
        const int nig = WGM * nN, gid = wgid / nig, fm = gid * WGM, gsz = (nM - fm) < WGM ? (nM - fm) : WGM;
        u.pm = fm + ((wgid % nig) % gsz); u.pn = (wgid % nig) / gsz; return true;
    }
};
constexpr int GATHER_MAX_UNITS = 15, GATHER_IDX_OFF = RING_BYTES + 1024;
template <class Epi, bool ALIGN_EPI = true, bool SP2 = true, bool GATHER = false>
__device__ __forceinline__ void gemm_phase(LAS unsigned char* lds, const Gemm g, const StaticOrder& S, const Epi& E) {
    int tid = threadIdx.x; asm volatile("" : "+v"(tid));
    const int wid = __builtin_amdgcn_readfirstlane(tid >> 6), lane = tid & 63, wr = wid >> 2, wc = wid & 3, fr = lane & 15, fq = lane >> 4;
    const int K = g.K, nt = K / BK;
    unsigned voffA[2], voffB[2];
#pragma unroll
    for (int i = 0; i < 2; ++i) { int R, C; stage_rc(tid * 16 + i * 8192, R, C); const int Rb = Epi::PERM ? ((R & ~31) + perm32(R & 31)) : R;
        voffA[i] = (unsigned)(R * K + C) * 2u; voffB[i] = (unsigned)(Rb * K + C) * 2u; }
    int gR[2]; unsigned gC[2];
#pragma unroll
    for (int i = 0; i < 2; ++i) { int R, C; stage_rc(tid * 16 + i * 8192, R, C); gR[i] = R; gC[i] = (unsigned)C * 2u; }
    LAS int* idxbuf = (LAS int*)(lds + GATHER_IDX_OFF);
    if constexpr (GATHER) {
        Unit uu;
        for (int q = 0; q < GATHER_MAX_UNITS; ++q) { if (!S.next(q, uu)) break; if (tid < 256) idxbuf[q * 256 + tid] = g.rowidx[uu.pm * 256 + tid]; }
        asm volatile("s_waitcnt vmcnt(0) lgkmcnt(0)" ::: "memory"); __builtin_amdgcn_s_barrier(); asm volatile("" ::: "memory");
    }
    unsigned gaC[2][2], gaN[2][2], ga2[2][2];
#define PG8_GA(dst, q) do { _Pragma("unroll") for (int _h = 0; _h < 2; ++_h) _Pragma("unroll") for (int _i = 0; _i < 2; ++_i) dst[_h][_i] = (unsigned)idxbuf[(q) * 256 + _h * 128 + gR[_i]] * (unsigned)(K * 2) + gC[_i]; } while (0)
    const size_t kstep = (size_t)(BK * 2);
    const size_t hstep = (size_t)HALF * K * 2;
    const size_t tstep = 2 * hstep;
    const unsigned ldsw = (unsigned)wid * 1024u;
    const int aoff = lds_byte(wr * 64 + fr, fq * 8), boff = lds_byte(wc * 32 + fr, fq * 8);
#define PG8_SA(b, h) (((b) * 2 + (h)) * HTB)
#define PG8_SB(b, h) ((4 + (b) * 2 + (h)) * HTB)
#define PG8_STAGE(bufoff, gbase, voff) do { _Pragma("unroll") for (int _i = 0; _i < 2; ++_i) \
        __builtin_amdgcn_global_load_lds((const unsigned*)((const char*)(gbase) + (voff)[_i]), (LAS unsigned*)(lds + (bufoff) + ldsw + _i * 8192), 16, 0, 0); } while (0)
#define PG8_LDA(dst, b, h) do { _Pragma("unroll") for (int m = 0; m < 4; ++m) _Pragma("unroll") for (int k = 0; k < 2; ++k) dst[m][k] = *(const LAS h8*)(lds + PG8_SA(b, h) + aoff + m * 2048 + k * 1024); } while (0)
#define PG8_LDB(dst, b, h) do { _Pragma("unroll") for (int n = 0; n < 2; ++n) _Pragma("unroll") for (int k = 0; k < 2; ++k) dst[n][k] = *(const LAS h8*)(lds + PG8_SB(b, h) + boff + n * 2048 + k * 1024); } while (0)
#define PG8_MMA(ai, bj, At, Bt) do { __builtin_amdgcn_s_setprio(1); _Pragma("unroll") for (int m = 0; m < 4; ++m) _Pragma("unroll") for (int n = 0; n < 2; ++n) _Pragma("unroll") for (int k = 0; k < 2; ++k) \
        acc[ai][bj][m][n] = __builtin_amdgcn_mfma_f32_16x16x32_f16(Bt[n][k], At[m][k], acc[ai][bj][m][n], 0, 0, 0); __builtin_amdgcn_s_setprio(0); } while (0)
#define PG8_WAIT_V(n) asm volatile("s_waitcnt vmcnt(" #n ")" ::: "memory")
#define PG8_WAIT_L(n) asm volatile("s_waitcnt lgkmcnt(" #n ")" ::: "memory")
#define PG8_BAR __builtin_amdgcn_s_barrier()
#define PG8_SCHED __builtin_amdgcn_sched_barrier(0)
#define PG8_STA(bufoff, tileptr, h, gaset, kbyte) do { if constexpr (GATHER) { PG8_STAGE(bufoff, (const char*)g.A + (kbyte), gaset[h]); } else { PG8_STAGE(bufoff, (tileptr) + (h) * hstep, voffA); } } while (0)
#define PG8_BBASE(u) ((const char*)g.Bt + ((size_t)((u).pm / g.grp_tiles) * g.grp_stride) * 2 + (size_t)(u).pn * tstep)
    Unit cur, nxt; int ui = 0;
    if (!S.next(0, cur)) return;
    f32x4 acc[2][2][4][2];
#pragma unroll
    for (int a = 0; a < 2; ++a)
#pragma unroll
        for (int b = 0; b < 2; ++b)
#pragma unroll
            for (int m = 0; m < 4; ++m)
#pragma unroll
                for (int n = 0; n < 2; ++n) acc[a][b][m][n] = (f32x4){0.f, 0.f, 0.f, 0.f};
    h8 At[4][2], B0[2][2], B1[2][2];
    const char* cA = (const char*)g.A + (size_t)cur.pm * tstep; const char* cB = PG8_BBASE(cur);
    if constexpr (GATHER) { PG8_GA(gaC, 0); }
    if constexpr (SP2) {
        PG8_STAGE(PG8_SB(0, 0), cB, voffB); PG8_STAGE(PG8_SB(0, 1), cB + hstep, voffB); PG8_STA(PG8_SA(0, 0), cA, 0, gaC, 0); PG8_STA(PG8_SA(0, 1), cA, 1, gaC, 0);
        if (wr == 1) PG8_BAR;
        PG8_WAIT_V(2); PG8_BAR;
        PG8_STAGE(PG8_SB(1, 0), cB + kstep, voffB); PG8_STA(PG8_SA(1, 0), cA + kstep, 0, gaC, kstep); PG8_STAGE(PG8_SB(1, 1), cB + hstep + kstep, voffB);
        PG8_WAIT_V(6); PG8_BAR;
    } else {
        PG8_STAGE(PG8_SB(0, 0), cB, voffB); PG8_STA(PG8_SA(0, 0), cA, 0, gaC, 0); PG8_STAGE(PG8_SB(0, 1), cB + hstep, voffB); PG8_STA(PG8_SA(0, 1), cA, 1, gaC, 0);
        if (wr == 1) PG8_BAR;
        PG8_WAIT_V(4); PG8_BAR;
        PG8_STAGE(PG8_SB(1, 0), cB + kstep, voffB); PG8_STA(PG8_SA(1, 0), cA + kstep, 0, gaC, kstep); PG8_STAGE(PG8_SB(1, 1), cB + hstep + kstep, voffB);
        PG8_WAIT_V(6); PG8_BAR;
    }
    for (;;) {
        const bool has_next = S.next(ui + 1, nxt);
        const char* nA = has_next ? (const char*)g.A + (size_t)nxt.pm * tstep : cA; const char* nB = has_next ? PG8_BBASE(nxt) : cB;
        if constexpr (GATHER) { const int qn = has_next ? ui + 1 : ui; PG8_GA(gaN, qn); }
#pragma unroll 1
        for (int t = 0; t < nt; t += 2) {
            const bool last = (t == nt - 2);
            const char* a1 = cA + (size_t)(t + 1) * kstep;
            const char* a2 = last ? nA : cA + (size_t)(t + 2) * kstep; const char* b2 = last ? nB : cB + (size_t)(t + 2) * kstep;
            const char* a3 = a2 + kstep; const char* b3 = b2 + kstep;
            const size_t k1 = (size_t)(t + 1) * kstep, k2 = last ? 0 : (size_t)(t + 2) * kstep, k3 = k2 + kstep;
            if constexpr (GATHER) { _Pragma("unroll") for (int _h = 0; _h < 2; ++_h) _Pragma("unroll") for (int _i = 0; _i < 2; ++_i) ga2[_h][_i] = last ? gaN[_h][_i] : gaC[_h][_i]; }
            if constexpr (SP2) {
            PG8_LDB(B0, 0, 0); PG8_LDB(B1, 0, 1); PG8_SCHED; PG8_LDA(At, 0, 0); PG8_STA(PG8_SA(1, 1), a1, 1, gaC, k1);
            PG8_WAIT_V(8); PG8_WAIT_L(0); PG8_BAR; PG8_MMA(0, 0, At, B0); PG8_MMA(0, 1, At, B1); PG8_BAR; PG8_SCHED;
            PG8_LDA(At, 0, 1); PG8_STAGE(PG8_SB(0, 0), b2, voffB); PG8_STAGE(PG8_SB(0, 1), b2 + hstep, voffB); PG8_STA(PG8_SA(0, 0), a2, 0, ga2, k2);
            PG8_WAIT_V(8); PG8_WAIT_L(0); PG8_BAR; PG8_MMA(1, 0, At, B0); PG8_MMA(1, 1, At, B1); PG8_BAR; PG8_SCHED;
            PG8_LDB(B0, 1, 0); PG8_LDB(B1, 1, 1); PG8_SCHED; PG8_LDA(At, 1, 0); PG8_STA(PG8_SA(0, 1), a2, 1, ga2, k2);
            PG8_WAIT_V(8); PG8_WAIT_L(0); PG8_BAR; PG8_MMA(0, 0, At, B0); PG8_MMA(0, 1, At, B1); PG8_BAR; PG8_SCHED;
            PG8_LDA(At, 1, 1); PG8_STAGE(PG8_SB(1, 0), b3, voffB); PG8_STAGE(PG8_SB(1, 1), b3 + hstep, voffB); PG8_STA(PG8_SA(1, 0), a3, 0, ga2, k3);
            PG8_WAIT_V(8); PG8_WAIT_L(0); PG8_BAR; PG8_MMA(1, 0, At, B0); PG8_MMA(1, 1, At, B1); PG8_BAR; PG8_SCHED;
            } else {
            PG8_LDB(B0, 0, 0); PG8_SCHED; PG8_LDA(At, 0, 0); PG8_STA(PG8_SA(1, 1), a1, 1, gaC, k1);
            PG8_WAIT_L(8); PG8_BAR; PG8_WAIT_L(0); PG8_MMA(0, 0, At, B0); PG8_BAR; PG8_SCHED;
            PG8_LDB(B1, 0, 1); PG8_STAGE(PG8_SB(0, 0), b2, voffB);
            PG8_BAR; PG8_WAIT_L(0); PG8_MMA(0, 1, At, B1); PG8_BAR;
            PG8_LDA(At, 0, 1); PG8_STA(PG8_SA(0, 0), a2, 0, ga2, k2);
            PG8_BAR; PG8_WAIT_L(0); PG8_MMA(1, 0, At, B0); PG8_BAR; PG8_SCHED;
            PG8_STAGE(PG8_SB(0, 1), b2 + hstep, voffB);
            PG8_WAIT_V(6); PG8_BAR; PG8_MMA(1, 1, At, B1); PG8_BAR;
            PG8_LDB(B0, 1, 0); PG8_SCHED; PG8_LDA(At, 1, 0); PG8_STA(PG8_SA(0, 1), a2, 1, ga2, k2);
            PG8_WAIT_L(8); PG8_BAR; PG8_WAIT_L(0); PG8_MMA(0, 0, At, B0); PG8_BAR; PG8_SCHED;
            PG8_LDB(B1, 1, 1); PG8_STAGE(PG8_SB(1, 0), b3, voffB);
            PG8_BAR; PG8_WAIT_L(0); PG8_MMA(0, 1, At, B1); PG8_BAR;
            PG8_LDA(At, 1, 1); PG8_STA(PG8_SA(1, 0), a3, 0, ga2, k3);
            PG8_BAR; PG8_WAIT_L(0); PG8_MMA(1, 0, At, B0); PG8_BAR; PG8_SCHED;
            PG8_STAGE(PG8_SB(1, 1), b3 + hstep, voffB);
            PG8_WAIT_V(6); PG8_BAR; PG8_MMA(1, 1, At, B1); PG8_BAR;
            }
        }
        if constexpr (ALIGN_EPI) { if (wr == 0) PG8_BAR; }
        E(acc, cur, wr, wc, fr, fq);
        if (!has_next) break;
#pragma unroll
        for (int a = 0; a < 2; ++a)
#pragma unroll
            for (int b = 0; b < 2; ++b)
#pragma unroll
                for (int m = 0; m < 4; ++m)
#pragma unroll
                    for (int n = 0; n < 2; ++n) acc[a][b][m][n] = (f32x4){0.f, 0.f, 0.f, 0.f};
        cur = nxt; cA = nA; cB = nB; ++ui;
        if constexpr (GATHER) { _Pragma("unroll") for (int _h = 0; _h < 2; ++_h) _Pragma("unroll") for (int _i = 0; _i < 2; ++_i) gaC[_h][_i] = gaN[_h][_i]; }
        if constexpr (ALIGN_EPI) { if (wr == 1) PG8_BAR; }
    }
    PG8_WAIT_V(0);
    if constexpr (!ALIGN_EPI) { if (wr == 0) PG8_BAR; }
    PG8_BAR;
#undef PG8_SA
#undef PG8_SB
#undef PG8_STAGE
#undef PG8_LDA
#undef PG8_LDB
#undef PG8_MMA
#undef PG8_WAIT_V
#undef PG8_WAIT_L
#undef PG8_BAR
#undef PG8_SCHED
#undef PG8_BBASE
#undef PG8_STA
#undef PG8_GA
}
}

#define EPI_ROW(u, ai, m) ((u).pm * 256 + (ai) * 128 + wr * 64 + (m) * 16 + fr)
__device__ __forceinline__ h8 pack8(f32x4 a, f32x4 b) { h8 o; o[0] = (f16)a[0]; o[1] = (f16)a[1]; o[2] = (f16)a[2]; o[3] = (f16)a[3]; o[4] = (f16)b[0]; o[5] = (f16)b[1]; o[6] = (f16)b[2]; o[7] = (f16)b[3]; return o; }
__device__ __forceinline__ void rope4(f32x4& v0, f32x4& v1, const f32x4 cs, const f32x4 sn) {
    const f32x4 a = v0, b = v1;
    v0[0] = a[0] * cs[0] - a[1] * sn[0]; v0[1] = a[1] * cs[0] + a[0] * sn[0];
    v0[2] = a[2] * cs[1] - a[3] * sn[1]; v0[3] = a[3] * cs[1] + a[2] * sn[1];
    v1[0] = b[0] * cs[2] - b[1] * sn[2]; v1[1] = b[1] * cs[2] + b[0] * sn[2];
    v1[2] = b[2] * cs[3] - b[3] * sn[3]; v1[3] = b[3] * cs[3] + b[2] * sn[3];
}
struct EpiLat {
    static constexpr bool PERM = true; f16* cq; f16* ckv; f16* Kp; float* pq; float* pkv; const float* cosm; const float* sinm;
    __device__ __forceinline__ void operator()(const f32x4 (&acc)[2][2][4][2], const pg8::Unit& u, int wr, int wc, int fr, int fq) const {
#pragma unroll
        for (int ai = 0; ai < 2; ++ai)
#pragma unroll
            for (int m = 0; m < 4; ++m) { const int t = EPI_ROW(u, ai, m); float sq = 0.f, sk = 0.f;
#pragma unroll
                for (int bj = 0; bj < 2; ++bj) { const int c8 = u.pn * 256 + bj * 128 + wc * 32 + 8 * fq; const int ht = u.pn * 2 + bj;
                    f32x4 v0 = acc[ai][bj][m][0], v1 = acc[ai][bj][m][1];
                    const float ss = (v0[0] * v0[0] + v0[1] * v0[1]) + (v0[2] * v0[2] + v0[3] * v0[3]) + (v1[0] * v1[0] + v1[1] * v1[1]) + (v1[2] * v1[2] + v1[3] * v1[3]);
                    if (ht < 3) { sq += ss; *(h8*)(cq + (size_t)t * 384 + c8) = pack8(v0, v1); }
                    else if (ht < 5) { sk += ss; *(h8*)(ckv + (size_t)t * 256 + (c8 - 384)) = pack8(v0, v1); }
                    else if (c8 < 704) { const int jj = c8 - 640, i0 = jj >> 1;
                        const f32x4 cs = *(const f32x4*)(cosm + (size_t)t * 32 + i0), sn = *(const f32x4*)(sinm + (size_t)t * 32 + i0); rope4(v0, v1, cs, sn);
                        const h8 o = pack8(v0, v1);
#pragma unroll
                        for (int h = 0; h < 8; ++h) *(h8*)(Kp + (size_t)t * 1536 + h * 192 + 128 + jj) = o; } }
                sq += __shfl_xor(sq, 16); sq += __shfl_xor(sq, 32); sk += __shfl_xor(sk, 16); sk += __shfl_xor(sk, 32);
                if (fq == 0) { if (u.pn < 2) pq[(size_t)t * 8 + u.pn * 4 + wc] = sq; if (u.pn >= 1) pkv[(size_t)t * 8 + (u.pn - 1) * 4 + wc] = sk; }
                asm volatile("" ::: "memory"); }
    }
};
__device__ __forceinline__ float row_rms_scale(const float* part, int t, float inv_n, float eps) {
    const f32x4 a = *(const f32x4*)(part + (size_t)t * 8), b = *(const f32x4*)(part + (size_t)t * 8 + 4);
    const float s = ((a[0] + a[1]) + (a[2] + a[3])) + ((b[0] + b[1]) + (b[2] + b[3]));
    return 1.0f / sqrtf(s * inv_n + eps);
}
struct EpiQNope {
    static constexpr bool PERM = true; f16* Q; const float* pq;
    __device__ __forceinline__ void operator()(const f32x4 (&acc)[2][2][4][2], const pg8::Unit& u, int wr, int wc, int fr, int fq) const {
#pragma unroll
        for (int ai = 0; ai < 2; ++ai)
#pragma unroll
            for (int m = 0; m < 4; ++m) { const int t = EPI_ROW(u, ai, m); const float rs = row_rms_scale(pq, t, 1.0f / 384.0f, LAT_EPS);
#pragma unroll
                for (int bj = 0; bj < 2; ++bj) { const int c8 = u.pn * 256 + bj * 128 + wc * 32 + 8 * fq;
                    *(h8*)(Q + (size_t)t * 1536 + (c8 >> 7) * 192 + (c8 & 127)) = pack8(acc[ai][bj][m][0] * rs, acc[ai][bj][m][1] * rs); }
                asm volatile("" ::: "memory"); }
    }
};
struct EpiQRope {
    static constexpr bool PERM = true; f16* Q; const float* cosm; const float* sinm; const float* pq;
    __device__ __forceinline__ void operator()(const f32x4 (&acc)[2][2][4][2], const pg8::Unit& u, int wr, int wc, int fr, int fq) const {
#pragma unroll
        for (int ai = 0; ai < 2; ++ai)
#pragma unroll
            for (int m = 0; m < 4; ++m) { const int t = EPI_ROW(u, ai, m); const float rs = row_rms_scale(pq, t, 1.0f / 384.0f, LAT_EPS);
#pragma unroll
                for (int bj = 0; bj < 2; ++bj) { const int cc = u.pn * 256 + bj * 128 + wc * 32 + 8 * fq; const int h = cc >> 6, jj = cc & 63, i0 = jj >> 1;
                    f32x4 v0 = acc[ai][bj][m][0] * rs, v1 = acc[ai][bj][m][1] * rs;
                    const f32x4 cs = *(const f32x4*)(cosm + (size_t)t * 32 + i0), sn = *(const f32x4*)(sinm + (size_t)t * 32 + i0); rope4(v0, v1, cs, sn);
                    *(h8*)(Q + (size_t)t * 1536 + h * 192 + 128 + jj) = pack8(v0, v1); }
                asm volatile("" ::: "memory"); }
    }
};
struct EpiKV {
    static constexpr bool PERM = true; f16* Kp; f16* Vp; const float* pkv;
    __device__ __forceinline__ void operator()(const f32x4 (&acc)[2][2][4][2], const pg8::Unit& u, int wr, int wc, int fr, int fq) const {
#pragma unroll
        for (int ai = 0; ai < 2; ++ai)
#pragma unroll
            for (int m = 0; m < 4; ++m) { const int t = EPI_ROW(u, ai, m); const float rs = row_rms_scale(pkv, t, 1.0f / 256.0f, LAT_EPS);
#pragma unroll
                for (int bj = 0; bj < 2; ++bj) { const int c8 = u.pn * 256 + bj * 128 + wc * 32 + 8 * fq; const int h = c8 >> 8, j = c8 & 255;
                    f16* dst = (j < 128) ? (Kp + (size_t)t * 1536 + h * 192 + j) : (Vp + (size_t)t * 1024 + h * 128 + (j - 128));
                    *(h8*)dst = pack8(acc[ai][bj][m][0] * rs, acc[ai][bj][m][1] * rs); }
                asm volatile("" ::: "memory"); }
    }
};
template <bool XF16> struct EpiPre {
    static constexpr bool PERM = true; const void* xres; const float* gmod; f16* pre;
    __device__ __forceinline__ void operator()(const f32x4 (&acc)[2][2][4][2], const pg8::Unit& u, int wr, int wc, int fr, int fq) const {
#pragma unroll
        for (int ai = 0; ai < 2; ++ai)
#pragma unroll
            for (int m = 0; m < 4; ++m) { const int t = EPI_ROW(u, ai, m); const int b = t >> 12;
#pragma unroll
                for (int bj = 0; bj < 2; ++bj) { const int c8 = u.pn * 256 + bj * 128 + wc * 32 + 8 * fq;
                    const f32x4 g0 = *(const f32x4*)(gmod + b * 6144 + c8), g1 = *(const f32x4*)(gmod + b * 6144 + c8 + 4); f32x4 x0, x1;
                    if constexpr (XF16) { const h8 xv = *(const h8*)((const f16*)xres + (size_t)t * 1024 + c8);
                        x0 = (f32x4){(float)xv[0], (float)xv[1], (float)xv[2], (float)xv[3]}; x1 = (f32x4){(float)xv[4], (float)xv[5], (float)xv[6], (float)xv[7]}; }
                    else { x0 = *(const f32x4*)((const float*)xres + (size_t)t * 1024 + c8); x1 = *(const f32x4*)((const float*)xres + (size_t)t * 1024 + c8 + 4); }
                    *(h8*)(pre + (size_t)t * 1024 + c8) = pack8(x0 * ALPHA + (g0 + 1.0f) * acc[ai][bj][m][0], x1 * ALPHA + (g1 + 1.0f) * acc[ai][bj][m][1]); }
                asm volatile("" ::: "memory"); }
    }
};
struct EpiUp {
    static constexpr bool PERM = true; f16* act;
    __device__ __forceinline__ void operator()(const f32x4 (&acc)[2][2][4][2], const pg8::Unit& u, int wr, int wc, int fr, int fq) const {
#pragma unroll
        for (int ai = 0; ai < 2; ++ai)
#pragma unroll
            for (int m = 0; m < 4; ++m) { const int r = EPI_ROW(u, ai, m);
#pragma unroll
                for (int bj = 0; bj < 2; ++bj) { const int c8 = u.pn * 256 + bj * 128 + wc * 32 + 8 * fq;
                    const f32x4 gq = acc[ai][bj][m][0], uq = acc[ai][bj][m][1]; h4 o;
#pragma unroll
                    for (int i = 0; i < 4; ++i) { const float gg = gq[i]; o[i] = (f16)(gg * __builtin_amdgcn_rcpf(1.0f + __expf(-gg)) * uq[i]); }
                    *(h4*)(act + (size_t)r * 2048 + (c8 >> 1)) = o; } }
    }
};
struct EpiDown {
    static constexpr bool PERM = true; f16* y; const float* gate;
    __device__ __forceinline__ void operator()(const f32x4 (&acc)[2][2][4][2], const pg8::Unit& u, int wr, int wc, int fr, int fq) const {
#pragma unroll
        for (int ai = 0; ai < 2; ++ai)
#pragma unroll
            for (int m = 0; m < 4; ++m) { const int r = EPI_ROW(u, ai, m); const float gt = gate[r];
#pragma unroll
                for (int bj = 0; bj < 2; ++bj) { const int c8 = u.pn * 256 + bj * 128 + wc * 32 + 8 * fq;
                    *(h8*)(y + (size_t)r * 1024 + c8) = pack8(acc[ai][bj][m][0] * gt, acc[ai][bj][m][1] * gt); }
                asm volatile("" ::: "memory"); }
    }
};
struct EpiDiffIn {
    static constexpr bool PERM = true; f16* qkv; const float* cosd; const float* sind;
    __device__ __forceinline__ void operator()(const f32x4 (&acc)[2][2][4][2], const pg8::Unit& u, int wr, int wc, int fr, int fq) const {
#pragma unroll
        for (int ai = 0; ai < 2; ++ai)
#pragma unroll
            for (int m = 0; m < 4; ++m) { const int t = EPI_ROW(u, ai, m);
#pragma unroll
                for (int bj = 0; bj < 2; ++bj) { const int c8 = u.pn * 256 + bj * 128 + wc * 32 + 8 * fq;
                    f32x4 v0 = acc[ai][bj][m][0], v1 = acc[ai][bj][m][1];
                    if (c8 < 2048 && (c8 & 63) < 16) { const int i0 = (c8 & 15) >> 1; const f32x4 cs = *(const f32x4*)(cosd + (size_t)t * 8 + i0), sn = *(const f32x4*)(sind + (size_t)t * 8 + i0); rope4(v0, v1, cs, sn); }
                    *(h8*)(qkv + (size_t)t * 3072 + c8) = pack8(v0, v1); }
                asm volatile("" ::: "memory"); }
    }
};

namespace att {
constexpr int QBLK = 32, KVBLK = 64, DV = 128;
constexpr float THR = 8.f;
constexpr size_t SHM_V = KVBLK * DV * 2;
#define SBAR() __builtin_amdgcn_sched_barrier(0)
__device__ __forceinline__ int crow(int r, int hi) { return (r & 3) + 8 * (r >> 2) + 4 * hi; }
__device__ __forceinline__ unsigned cvtpk(float lo, float hi) { unsigned r; asm volatile("v_cvt_pk_f16_f32 %0, %1, %2" : "=v"(r) : "v"(lo), "v"(hi)); return r; }
template <int DQK> struct Cfg {
    static constexpr int ND0 = DQK / 16, KRB = DQK * 2, NKCH = DQK / 64, KCPR = DQK / 8;
    static constexpr size_t SHM_K = (size_t)KVBLK * KRB;
    static constexpr float SCALE = DQK == 192 ? 0.07216878364870322f : 0.125f;
    static constexpr size_t SHM_TOTAL = 2 * SHM_V + 2 * SHM_K + NWAVES * 64 * 4;
};
template <int DQK> __device__ __forceinline__ void partialSM(f32x16& p0, f32x16& p1, float& m_reg, float& mn, float& alpha) {
    constexpr float SCALE = Cfg<DQK>::SCALE, C = SCALE * 1.4426950408889634f;
    float pmax = p0[0];
#pragma unroll
    for (int r = 1; r < 16; ++r) pmax = fmaxf(pmax, p0[r]);
#pragma unroll
    for (int r = 0; r < 16; ++r) pmax = fmaxf(pmax, p1[r]);
    { auto rr = __builtin_amdgcn_permlane32_swap(__float_as_uint(pmax), __float_as_uint(pmax), false, false);
      pmax = fmaxf(__uint_as_float(rr[0]), __uint_as_float(rr[1])); }
    if (__builtin_expect(__all(pmax - m_reg <= THR / SCALE), 1)) { mn = m_reg; alpha = 1.f; }
    else { mn = fmaxf(m_reg, pmax); alpha = __builtin_amdgcn_exp2f((m_reg - mn) * C); m_reg = mn; }
    const float mnC = -mn * C;
#pragma unroll
    for (int r = 0; r < 16; ++r) p0[r] = fmaf(p0[r], C, mnC);
#pragma unroll
    for (int r = 0; r < 16; ++r) p1[r] = fmaf(p1[r], C, mnC);
#pragma unroll
    for (int r = 0; r < 16; ++r) p0[r] = __builtin_amdgcn_exp2f(p0[r]);
}
__device__ __forceinline__ void finishSM(f32x16& p0, f32x16& p1, float alpha, float& l_reg, h8& pa0, h8& pa1, h8& pa2, h8& pa3) {
#pragma unroll
    for (int r = 0; r < 16; ++r) p1[r] = __builtin_amdgcn_exp2f(p1[r]);
    float ps = 0;
#pragma unroll
    for (int r = 0; r < 16; ++r) ps += p0[r];
#pragma unroll
    for (int r = 0; r < 16; ++r) ps += p1[r];
    { auto rr = __builtin_amdgcn_permlane32_swap(__float_as_uint(ps), __float_as_uint(ps), false, false);
      ps = __uint_as_float(rr[0]) + __uint_as_float(rr[1]); }
    l_reg = l_reg * alpha + ps;
#define PK4(P, BASE, OUT) do { unsigned a0 = cvtpk(P[BASE + 0], P[BASE + 1]), a1 = cvtpk(P[BASE + 2], P[BASE + 3]);   \
    unsigned b0 = cvtpk(P[BASE + 4], P[BASE + 5]), b1 = cvtpk(P[BASE + 6], P[BASE + 7]);                              \
    auto r0 = __builtin_amdgcn_permlane32_swap(a0, b0, false, false); auto r1 = __builtin_amdgcn_permlane32_swap(a1, b1, false, false); \
    u32x4 w = {r0[0], r1[0], r0[1], r1[1]}; OUT = *reinterpret_cast<h8*>(&w); } while (0)
    PK4(p0, 0, pa0); PK4(p0, 8, pa1); PK4(p1, 0, pa2); PK4(p1, 8, pa3);
#undef PK4
}
#define KSWZ(row, colB) ((row) * KRB + ((colB) ^ (((row) & 7) << 4)))
template <int DQK> __device__ __forceinline__ void qkt(f32x16& p0, f32x16& p1, const char* Ks, const h8* qr, int r32, int hi) {
    constexpr int KRB = Cfg<DQK>::KRB;
    p0 = f32x16{}; p1 = f32x16{};
#pragma unroll
    for (int d0 = 0; d0 < Cfg<DQK>::ND0; ++d0) { const int cb = (d0 * 16 + hi * 8) * 2;
        const h8 b0 = *reinterpret_cast<const h8*>(Ks + KSWZ(r32, cb));
        const h8 b1 = *reinterpret_cast<const h8*>(Ks + KSWZ(32 + r32, cb));
        p0 = __builtin_amdgcn_mfma_f32_32x32x16_f16(b0, qr[d0], p0, 0, 0, 0);
        p1 = __builtin_amdgcn_mfma_f32_32x32x16_f16(b1, qr[d0], p1, 0, 0, 0); }
}
template <int OFF> __device__ __forceinline__ h8 lds_read128(int addr) { h8 r; asm volatile("ds_read_b128 %0, %1 offset:%2" : "=&v"(r) : "v"(addr), "i"(OFF) : "memory"); return r; }
template <int N> __device__ __forceinline__ void lgkm_wait() { asm volatile("s_waitcnt lgkmcnt(%0)" :: "i"(N) : "memory"); }
template <int DQK, int W, int I> struct QkStep {
    static constexpr int NF = 2 * Cfg<DQK>::ND0, KRB = Cfg<DQK>::KRB;
    static constexpr int koff(int i) { return ((i >> 1) >> 2) * 128 + (i & 1) * 32 * KRB; }
    static __device__ __forceinline__ void issue(h8 (&kf)[W], const int (&ka)[4]) { if constexpr (I < NF) kf[I % W] = lds_read128<koff(I)>(ka[(I >> 1) & 3]); }
    static __device__ __forceinline__ void run(h8 (&kf)[W], f32x16& p0, f32x16& p1, const h8* qr, const int (&ka)[4]) {
        if constexpr (I < NF) {
            constexpr int OUT = (NF - 1 - I) < (W - 1) ? (NF - 1 - I) : (W - 1);
            lgkm_wait<OUT>(); SBAR();
            if constexpr ((I & 1) == 0) p0 = __builtin_amdgcn_mfma_f32_32x32x16_f16(kf[I % W], qr[I >> 1], p0, 0, 0, 0);
            else p1 = __builtin_amdgcn_mfma_f32_32x32x16_f16(kf[I % W], qr[I >> 1], p1, 0, 0, 0);
            SBAR();
            QkStep<DQK, W, I + W>::issue(kf, ka);
            QkStep<DQK, W, I + 1>::run(kf, p0, p1, qr, ka);
        }
    }
};
template <int DQK, int W, int I> struct QkPrime { static __device__ __forceinline__ void run(h8 (&kf)[W], const int (&ka)[4]) { if constexpr (I < W && I < 2 * Cfg<DQK>::ND0) { QkStep<DQK, W, I>::issue(kf, ka); QkPrime<DQK, W, I + 1>::run(kf, ka); } } };
template <int DQK, int W> __device__ __forceinline__ void qkt_pipe(f32x16& p0, f32x16& p1, int kbase, const h8* qr, int r32, int hi) {
    constexpr int KRB = Cfg<DQK>::KRB;
    int ka[4];
#pragma unroll
    for (int q = 0; q < 4; ++q) ka[q] = kbase + r32 * KRB + ((q * 32 + hi * 16) ^ ((r32 & 7) << 4));
    p0 = f32x16{}; p1 = f32x16{};
    h8 kf[W];
    QkPrime<DQK, W, 0>::run(kf, ka);
    QkStep<DQK, W, 0>::run(kf, p0, p1, qr, ka);
}
__device__ __forceinline__ int v_st(int k, int c) { const int kk = (k & ~0xC) | ((k & 4) << 1) | ((k & 8) >> 1); return ((kk >> 3) * 4 + (c >> 5)) * 512 + ((kk & 7) * 32 + (c & 31)) * 2; }
__device__ __forceinline__ int v_rd_base(int lane) { return ((lane & 3) << 3) | (((lane >> 2) & 3) << 6) | (((lane >> 4) & 1) << 5) | (((lane >> 5) & 1) << 8); }
constexpr int v_rd_off(int d0, int ks, int half) { return d0 * 512 + ks * 4096 + half * 2048; }
template <int OFF> __device__ __forceinline__ s16x4 tr_read(int vb) {
    s16x4 r; asm volatile("ds_read_b64_tr_b16 %0, %1 offset:%2" : "=&v"(r) : "v"(vb), "i"(OFF) : "memory"); return r;
}
template <int D0> __device__ __forceinline__ void pv_one(f32x16& od, int vb, h8 pa0, h8 pa1, h8 pa2, h8 pa3) {
    const s16x4 l0 = tr_read<v_rd_off(D0, 0, 0)>(vb), h0 = tr_read<v_rd_off(D0, 0, 1)>(vb), l1 = tr_read<v_rd_off(D0, 1, 0)>(vb), h1 = tr_read<v_rd_off(D0, 1, 1)>(vb);
    const s16x4 l2 = tr_read<v_rd_off(D0, 2, 0)>(vb), h2_ = tr_read<v_rd_off(D0, 2, 1)>(vb), l3 = tr_read<v_rd_off(D0, 3, 0)>(vb), h3 = tr_read<v_rd_off(D0, 3, 1)>(vb);
    asm volatile("s_waitcnt lgkmcnt(0)" ::: "memory"); SBAR();
#define PKV(L, H) __builtin_bit_cast(h8, (__attribute__((ext_vector_type(8))) short){L[0], L[1], L[2], L[3], H[0], H[1], H[2], H[3]})
    od = __builtin_amdgcn_mfma_f32_32x32x16_f16(pa0, PKV(l0, h0), od, 0, 0, 0);
    od = __builtin_amdgcn_mfma_f32_32x32x16_f16(pa1, PKV(l1, h1), od, 0, 0, 0);
    od = __builtin_amdgcn_mfma_f32_32x32x16_f16(pa2, PKV(l2, h2_), od, 0, 0, 0);
    od = __builtin_amdgcn_mfma_f32_32x32x16_f16(pa3, PKV(l3, h3), od, 0, 0, 0);
#undef PKV
}
struct VFrag { s16x4 l0, h0, l1, h1, l2, h2, l3, h3; };
template <int D0> __device__ __forceinline__ void v_read8(VFrag& f, int vb) {
    f.l0 = tr_read<v_rd_off(D0, 0, 0)>(vb); f.h0 = tr_read<v_rd_off(D0, 0, 1)>(vb); f.l1 = tr_read<v_rd_off(D0, 1, 0)>(vb); f.h1 = tr_read<v_rd_off(D0, 1, 1)>(vb);
    f.l2 = tr_read<v_rd_off(D0, 2, 0)>(vb); f.h2 = tr_read<v_rd_off(D0, 2, 1)>(vb); f.l3 = tr_read<v_rd_off(D0, 3, 0)>(vb); f.h3 = tr_read<v_rd_off(D0, 3, 1)>(vb);
}
__device__ __forceinline__ void pv_mma4(f32x16& od, const VFrag& f, h8 pa0, h8 pa1, h8 pa2, h8 pa3) {
#define PKV(L, H) __builtin_bit_cast(h8, (__attribute__((ext_vector_type(8))) short){L[0], L[1], L[2], L[3], H[0], H[1], H[2], H[3]})
    od = __builtin_amdgcn_mfma_f32_32x32x16_f16(pa0, PKV(f.l0, f.h0), od, 0, 0, 0);
    od = __builtin_amdgcn_mfma_f32_32x32x16_f16(pa1, PKV(f.l1, f.h1), od, 0, 0, 0);
    od = __builtin_amdgcn_mfma_f32_32x32x16_f16(pa2, PKV(f.l2, f.h2), od, 0, 0, 0);
    od = __builtin_amdgcn_mfma_f32_32x32x16_f16(pa3, PKV(f.l3, f.h3), od, 0, 0, 0);
#undef PKV
}
__device__ __forceinline__ void pv_d0(f32x16* o, int vb, h8 pa0, h8 pa1, h8 pa2, h8 pa3) {
    VFrag A, B;
    v_read8<0>(A, vb); v_read8<1>(B, vb);
    asm volatile("s_waitcnt lgkmcnt(8)" ::: "memory"); SBAR(); pv_mma4(o[0], A, pa0, pa1, pa2, pa3); SBAR();
    v_read8<2>(A, vb);
    asm volatile("s_waitcnt lgkmcnt(8)" ::: "memory"); SBAR(); pv_mma4(o[1], B, pa0, pa1, pa2, pa3); SBAR();
    v_read8<3>(B, vb);
    asm volatile("s_waitcnt lgkmcnt(8)" ::: "memory"); SBAR(); pv_mma4(o[2], A, pa0, pa1, pa2, pa3); SBAR();
    asm volatile("s_waitcnt lgkmcnt(0)" ::: "memory"); SBAR(); pv_mma4(o[3], B, pa0, pa1, pa2, pa3);
}
template <int LDO>
__device__ __forceinline__ void attn_epilogue(f32x16 (&o)[4], const float (&rli)[16], f16* Ow, int mode, float lam, const float* subln, int r32, int hi) {
    if (mode == 0) {
#pragma unroll
        for (int r = 0; r < 16; ++r) { const int orow = crow(r, hi);
#pragma unroll
            for (int d0 = 0; d0 < 4; ++d0) Ow[(long)orow * LDO + d0 * 32 + r32] = (f16)(o[d0][r] * rli[r]); }
    } else {
        float sl[4];
#pragma unroll
        for (int d0 = 0; d0 < 4; ++d0) sl[d0] = subln[d0 * 32 + r32] * (1.0f - LAMBDA_INIT);
        f16 t0[4][16];
#pragma unroll
        for (int r = 0; r < 16; ++r) { const int orow = crow(r, hi);
#pragma unroll
            for (int d0 = 0; d0 < 4; ++d0) t0[d0][r] = Ow[(long)orow * LDO + d0 * 32 + r32]; }
        asm volatile("s_waitcnt vmcnt(0)" ::: "memory");
#pragma unroll
        for (int r = 0; r < 16; ++r) { const int orow = crow(r, hi); float ss = 0.f;
#pragma unroll
            for (int d0 = 0; d0 < 4; ++d0) { const float x = (float)t0[d0][r] - lam * (o[d0][r] * rli[r]); o[d0][r] = x; ss += x * x; }
            ss += __shfl_xor(ss, 1); ss += __shfl_xor(ss, 2); ss += __shfl_xor(ss, 4); ss += __shfl_xor(ss, 8); ss += __shfl_xor(ss, 16);
            const float rs = 1.0f / sqrtf(ss * (1.0f / 128.0f) + LN_EPS);
#pragma unroll
            for (int d0 = 0; d0 < 4; ++d0) Ow[(long)orow * LDO + d0 * 32 + r32] = (f16)(o[d0][r] * rs * sl[d0]); }
    }
}
template <int DQK, int LDQ, int LDK, int LDV, int LDO, int SDEPTH>
__device__ __forceinline__ void attn_body(const f16* Qb, const f16* Kh, const f16* Vh, f16* Ob, char* lds, int mode = 0, float lam = 0.f, const float* subln = nullptr) {
    using C = Cfg<DQK>;
    constexpr int KRB = C::KRB, ND0 = C::ND0, NKCH = C::NKCH, KCPR = C::KCPR; constexpr size_t SHM_K = C::SHM_K;
    constexpr int seq = SEQ;
    int tid = threadIdx.x; asm volatile("" : "+v"(tid));
    const int wid = tid >> 6, lane = tid & 63, r32 = lane & 31, hi = lane >> 5;
    char* V_lds = lds; char* K_lds = lds + 2 * SHM_V;
    float* wsl = (float*)(lds + 2 * SHM_V + 2 * SHM_K) + wid * 64; float* li_l = wsl; float* al_l = wsl + 32;
    float m_reg = -1e30f, l_reg = 0; f32x16 o[4] = {}; h8 qr[ND0];
    const f16* Qw = Qb + (long)(wid * QBLK + r32) * LDQ + hi * 8;
#pragma unroll
    for (int d0 = 0; d0 < ND0; ++d0) qr[d0] = *reinterpret_cast<const h8*>(Qw + d0 * 16);
    const int sr = tid >> 4, sc = (tid & 15) * 8, vst0 = v_st(sr, sc), vst1 = v_st(32 + sr, sc);
    int krow[NKCH], kcb[NKCH];
#pragma unroll
    for (int i = 0; i < NKCH; ++i) { const int c = tid + i * 512; krow[i] = c / KCPR; kcb[i] = (c % KCPR) * 16; }
    const int vb0 = (int)(uintptr_t)V_lds + v_rd_base(lane);
    struct { h8 vs0, vs1; h8 ks[NKCH]; } sr_[SDEPTH];
#define SLOAD(i, k0) do { sr_[i].vs0 = *reinterpret_cast<const h8*>(&Vh[(long)((k0) + sr) * LDV + sc]); sr_[i].vs1 = *reinterpret_cast<const h8*>(&Vh[(long)((k0) + 32 + sr) * LDV + sc]); \
    _Pragma("unroll") for (int _c = 0; _c < NKCH; ++_c) sr_[i].ks[_c] = *reinterpret_cast<const h8*>((const char*)Kh + (long)((k0) + krow[_c]) * (LDK * 2) + kcb[_c]); } while (0)
#define SWRITE(b, i) do { *(h8*)(V_lds + (b) * SHM_V + vst0) = sr_[i].vs0; *(h8*)(V_lds + (b) * SHM_V + vst1) = sr_[i].vs1; \
    _Pragma("unroll") for (int _c = 0; _c < NKCH; ++_c) *(h8*)(K_lds + (b) * SHM_K + KSWZ(krow[_c], kcb[_c])) = sr_[i].ks[_c]; } while (0)
#define SWAIT() do { if constexpr (SDEPTH == 2) { if constexpr (NKCH == 3) asm volatile("s_waitcnt vmcnt(5)" ::: "memory"); else asm volatile("s_waitcnt vmcnt(3)" ::: "memory"); } \
    else asm volatile("s_waitcnt vmcnt(0)" ::: "memory"); } while (0)
#define RESC(a) do { if (__any((a) < 1.f)) { if (hi == 0) al_l[r32] = (a); asm volatile("s_waitcnt lgkmcnt(0)" ::: "memory"); \
    _Pragma("unroll") for (int d = 0; d < 4; ++d) _Pragma("unroll") for (int r = 0; r < 16; ++r) o[d][r] *= al_l[crow(r, hi)]; } } while (0)
    f32x16 pA0, pA1, pB0, pB1; float mnA, mnB, alA, alB; h8 pa0, pa1, pa2, pa3; constexpr int NT = seq / KVBLK;
    constexpr int SE = 0, SO = SDEPTH - 1;
    SLOAD(SE, 0); asm volatile("s_waitcnt vmcnt(0)" ::: "memory"); SWRITE(0, SE); __syncthreads();
    qkt<DQK>(pA0, pA1, K_lds, qr, r32, hi); partialSM<DQK>(pA0, pA1, m_reg, mnA, alA);
    SLOAD(SO, KVBLK); if constexpr (SDEPTH == 2) { if (2 < NT) SLOAD(SE, 2 * KVBLK); }
    SWAIT(); SWRITE(1, SO); __syncthreads();
    for (int j = 1; j + 1 < NT; j += 2) {
        SBAR(); qkt<DQK>(pB0, pB1, K_lds + SHM_K, qr, r32, hi);
        finishSM(pA0, pA1, alA, l_reg, pa0, pa1, pa2, pa3); SBAR();
        SLOAD(SO, (j + SDEPTH) * KVBLK); SBAR();
        pv_d0(o, vb0, pa0, pa1, pa2, pa3); partialSM<DQK>(pB0, pB1, m_reg, mnB, alB);
        __syncthreads(); SWAIT(); SWRITE(0, SE);
        RESC(alB); __syncthreads();
        SBAR(); qkt<DQK>(pA0, pA1, K_lds, qr, r32, hi);
        finishSM(pB0, pB1, alB, l_reg, pa0, pa1, pa2, pa3); SBAR();
        if (SDEPTH == 1 || j + 3 < NT) SLOAD(SE, (j + 1 + SDEPTH) * KVBLK); SBAR();
        pv_d0(o, vb0 + (int)SHM_V, pa0, pa1, pa2, pa3); partialSM<DQK>(pA0, pA1, m_reg, mnA, alA);
        __syncthreads(); SWAIT(); SWRITE(1, SO);
        RESC(alA); __syncthreads();
    }
    SBAR(); qkt<DQK>(pB0, pB1, K_lds + SHM_K, qr, r32, hi);
    finishSM(pA0, pA1, alA, l_reg, pa0, pa1, pa2, pa3); SBAR();
    pv_d0(o, vb0, pa0, pa1, pa2, pa3); partialSM<DQK>(pB0, pB1, m_reg, mnB, alB);
    __syncthreads(); RESC(alB);
    finishSM(pB0, pB1, alB, l_reg, pa0, pa1, pa2, pa3); SBAR();
    pv_d0(o, vb0 + (int)SHM_V, pa0, pa1, pa2, pa3);
    if (hi == 0) li_l[r32] = l_reg; asm volatile("s_waitcnt lgkmcnt(0)" ::: "memory");
    float rli[16];
#pragma unroll
    for (int r = 0; r < 16; ++r) rli[r] = __builtin_amdgcn_rcpf(li_l[crow(r, hi)]);
    attn_epilogue<LDO>(o, rli, Ob + (long)(wid * QBLK) * LDO, mode, lam, subln, r32, hi);
    asm volatile("s_waitcnt vmcnt(0) lgkmcnt(0)" ::: "memory");
    __syncthreads();
#undef SLOAD
#undef SWRITE
#undef SWAIT
#undef RESC
}

struct ConvStream {
    const float* win; const float* wout; f16* tin; f16* tout;
    int step, step_end, it, period;
    unsigned d[8]; f16* pend;
    char* acc; f16* dst0; int nacc;
};
constexpr int CONV_STEPS_IN = 16 * 64 * 128, CONV_STEPS_OUT = 16 * 16 * 256, CONV_STEPS = CONV_STEPS_IN + CONV_STEPS_OUT;
__device__ __forceinline__ void conv_drain(ConvStream& c, int lane) {
    if (c.nacc > 0) {
        asm volatile("s_waitcnt lgkmcnt(0)" ::: "memory");
        for (int q = 0; q < c.nacc; ++q) { const h8 v = *(const h8*)(c.acc + q * 1024 + lane * 16); *(h8*)(c.dst0 + q * 8) = v; }
        c.nacc = 0; }
}
__device__ __forceinline__ void conv_flush(ConvStream& c, int lane) {
    if (c.pend) { h8 o;
#pragma unroll
        for (int i = 0; i < 8; ++i) o[i] = (f16)__uint_as_float(c.d[i]);
        if (c.nacc == 0) c.dst0 = c.pend;
        *(h8*)(c.acc + c.nacc * 1024 + lane * 16) = o; ++c.nacc; c.pend = nullptr;
        if (c.nacc == 4) conv_drain(c, lane); }
}
__device__ __forceinline__ void conv_tick(ConvStream& c, int lane) {
    const bool go = ((c.it & (c.period - 1)) < 3) && (c.step < c.step_end); ++c.it;
    if (go) { const int s = c.step++;
        const float* src; f16* dst; int N;
        if (s < CONV_STEPS_IN) { const int strip = s >> 7, kb = s & 127, e = strip >> 6, n = (strip & 63) * 64 + lane; const int f = n & 2047, dr = (f >> 2) * 8 + (f & 3) + ((n >> 11) << 2);
            src = c.win + ((size_t)e * 1024 + kb * 8) * 4096 + n; dst = c.tin + ((size_t)e * 4096 + dr) * 1024 + kb * 8; N = 4096; }
        else { const int s2 = s - CONV_STEPS_IN; const int strip = s2 >> 8, kb = s2 & 255, e = strip >> 4, n = (strip & 15) * 64 + lane;
            src = c.wout + ((size_t)e * 2048 + kb * 8) * 1024 + n; dst = c.tout + ((size_t)e * 1024 + n) * 2048 + kb * 8; N = 1024; }
        if ((s & 3) == 0) conv_drain(c, lane);
#pragma unroll
        for (int i = 0; i < 8; ++i) c.d[i] = __float_as_uint(src[(size_t)i * N]);
        c.pend = dst; }
}
__device__ __forceinline__ void conv_init(ConvStream& cs, const float* win, const float* wout, f16* tin, f16* tout, int l, int gw, int NGW, int period, char* acc) {
    cs.acc = acc; cs.nacc = 0; cs.dst0 = nullptr;
    cs.win = win + (size_t)l * NE * 1024 * 4096; cs.wout = wout + (size_t)l * NE * 2048 * 1024; cs.tin = tin + (size_t)l * NE * 4096 * 1024; cs.tout = tout + (size_t)l * NE * 1024 * 2048;
    const int per = ((CONV_STEPS + NGW - 1) / NGW + 7) & ~7;
    cs.step = gw * per < CONV_STEPS ? gw * per : CONV_STEPS; cs.step_end = (gw + 1) * per < CONV_STEPS ? (gw + 1) * per : CONV_STEPS; cs.it = 0; cs.pend = nullptr; cs.period = period;
}
template <int DQK, int LDQ, int LDK, int LDV, int LDO, bool CONV = false>
__device__ __forceinline__ void attn_body_simple(const f16* Qb, const f16* Kh, const f16* Vh, f16* Ob, char* lds, int mode = 0, float lam = 0.f, const float* subln = nullptr, ConvStream* cs = nullptr) {
    using C = Cfg<DQK>;
    constexpr int KRB = C::KRB, ND0 = C::ND0, NKCH = C::NKCH, KCPR = C::KCPR; constexpr size_t SHM_K = C::SHM_K;
    int tid = threadIdx.x; asm volatile("" : "+v"(tid));
    const int wid = tid >> 6, lane = tid & 63, r32 = lane & 31, hi = lane >> 5;
    char* V_lds = lds; char* K_lds = lds + 2 * SHM_V;
    float* wsl = (float*)(lds + 2 * SHM_V + 2 * SHM_K) + wid * 64; float* li_l = wsl; float* al_l = wsl + 32;
    float m_reg = -1e30f, l_reg = 0; f32x16 o[4] = {}; h8 qr[ND0];
    const f16* Qw = Qb + (long)(wid * QBLK + r32) * LDQ + hi * 8;
#pragma unroll
    for (int d0 = 0; d0 < ND0; ++d0) qr[d0] = *reinterpret_cast<const h8*>(Qw + d0 * 16);
    const int sr = tid >> 4, sc = (tid & 15) * 8, vst0 = v_st(sr, sc), vst1 = v_st(32 + sr, sc);
    int krow[NKCH], kcb[NKCH];
#pragma unroll
    for (int i = 0; i < NKCH; ++i) { const int c = tid + i * 512; krow[i] = c / KCPR; kcb[i] = (c % KCPR) * 16; }
    const int vb0 = (int)(uintptr_t)V_lds + v_rd_base(lane);
    h8 vs0, vs1, ks[NKCH];
#define SLOAD1(k0) do { vs0 = *reinterpret_cast<const h8*>(&Vh[(long)((k0) + sr) * LDV + sc]); vs1 = *reinterpret_cast<const h8*>(&Vh[(long)((k0) + 32 + sr) * LDV + sc]); \
    _Pragma("unroll") for (int _c = 0; _c < NKCH; ++_c) ks[_c] = *reinterpret_cast<const h8*>((const char*)Kh + (long)((k0) + krow[_c]) * (LDK * 2) + kcb[_c]); } while (0)
#define SWRITE1(b) do { *(h8*)(V_lds + (b) * SHM_V + vst0) = vs0; *(h8*)(V_lds + (b) * SHM_V + vst1) = vs1; \
    _Pragma("unroll") for (int _c = 0; _c < NKCH; ++_c) *(h8*)(K_lds + (b) * SHM_K + KSWZ(krow[_c], kcb[_c])) = ks[_c]; } while (0)
    constexpr int NT = SEQ / KVBLK;
    SLOAD1(0); asm volatile("s_waitcnt vmcnt(0)" ::: "memory"); SWRITE1(0); __syncthreads();
#pragma unroll 1
    for (int j = 0; j < NT; ++j) {
        const int cb = j & 1;
        if constexpr (CONV) conv_tick(*cs, lane);
        if (j + 1 < NT) SLOAD1((j + 1) * KVBLK);
        SBAR();
        f32x16 p0, p1; float mn, al; h8 pa0, pa1, pa2, pa3;
        qkt_pipe<DQK, (DQK == 192 ? 6 : 8)>(p0, p1, (int)(uintptr_t)K_lds + cb * (int)SHM_K, qr, r32, hi);
        partialSM<DQK>(p0, p1, m_reg, mn, al);
        if (__any(al < 1.f)) { if (hi == 0) al_l[r32] = al; asm volatile("s_waitcnt lgkmcnt(0)" ::: "memory");
#pragma unroll
            for (int d = 0; d < 4; ++d)
#pragma unroll
                for (int r = 0; r < 16; ++r) o[d][r] *= al_l[crow(r, hi)]; }
        finishSM(p0, p1, al, l_reg, pa0, pa1, pa2, pa3); SBAR();
        pv_d0(o, vb0 + cb * (int)SHM_V, pa0, pa1, pa2, pa3);
        if (j + 1 < NT) { SWRITE1(cb ^ 1); }
        if constexpr (CONV) conv_flush(*cs, lane);
        __syncthreads();
    }
    if (hi == 0) li_l[r32] = l_reg; asm volatile("s_waitcnt lgkmcnt(0)" ::: "memory");
    float rli[16];
#pragma unroll
    for (int r = 0; r < 16; ++r) rli[r] = __builtin_amdgcn_rcpf(li_l[crow(r, hi)]);
    attn_epilogue<LDO>(o, rli, Ob + (long)(wid * QBLK) * LDO, mode, lam, subln, r32, hi);
    asm volatile("s_waitcnt vmcnt(0) lgkmcnt(0)" ::: "memory");
    __syncthreads();
#undef SLOAD1
#undef SWRITE1
}
#undef KSWZ
#undef SBAR
}

struct Args { const void* in[22]; float* out; unsigned char* ws; int ph_lo, ph_hi, li, pad; };
typedef const __attribute__((address_space(4))) Args* KArgs;
__device__ __forceinline__ KArgs kargs() { KArgs p = (KArgs)__builtin_amdgcn_kernarg_segment_ptr(); asm volatile("" : "+s"(p)); return p; }
struct Frame {
    LAS unsigned char* lds; char* ldsg;
    int tid, lane, wave, vcu, G;
    unsigned char* ws;
};
extern __shared__ __attribute__((aligned(16))) unsigned char g_lds[];
__device__ __forceinline__ Frame mkframe(KArgs a) {
    Frame F; int t = threadIdx.x; asm volatile("" : "+v"(t));
    F.lds = (LAS unsigned char*)g_lds; F.ldsg = (char*)g_lds;
    F.tid = t; F.lane = t & 63; F.wave = __builtin_amdgcn_readfirstlane(t >> 6);
    int g = gridDim.x, bx = blockIdx.x; asm volatile("" : "+s"(g), "+s"(bx));
    F.G = g; F.vcu = (g % 8 == 0) ? (bx % 8) * (g / 8) + bx / 8 : bx;
    F.ws = a->ws;
    return F;
}

__device__ __forceinline__ void sincos_d(double a, float& s, float& c) {
    const double k = __builtin_rint(a * 0.63661977236758134308);
    double r = __builtin_fma(-k, 1.57079632679489655800e+00, a); r = __builtin_fma(-k, 6.12323399573676603587e-17, r);
    const double r2 = r * r;
    double sp = -7.6471637318198164759e-13;
    sp = __builtin_fma(sp, r2, 1.6059043836821614599e-10);
    sp = __builtin_fma(sp, r2, -2.5052108385441718775e-08);
    sp = __builtin_fma(sp, r2, 2.7557319223985890653e-06);
    sp = __builtin_fma(sp, r2, -1.9841269841269841270e-04);
    sp = __builtin_fma(sp, r2, 8.3333333333333333333e-03);
    sp = __builtin_fma(sp, r2, -1.6666666666666666667e-01);
    const double sr = __builtin_fma(sp * r2, r, r);
    double cp = 4.7794773323873852974e-14;
    cp = __builtin_fma(cp, r2, -1.1470745597729724714e-11);
    cp = __builtin_fma(cp, r2, 2.0876756987868098979e-09);
    cp = __builtin_fma(cp, r2, -2.7557319223985890653e-07);
    cp = __builtin_fma(cp, r2, 2.4801587301587301587e-05);
    cp = __builtin_fma(cp, r2, -1.3888888888888888889e-03);
    cp = __builtin_fma(cp, r2, 4.1666666666666666667e-02);
    cp = __builtin_fma(cp, r2, -0.5);
    const double cr = __builtin_fma(cp, r2, 1.0);
    const int q = (int)((long long)k & 3);
    const double ss = (q & 1) ? cr : sr, cc = (q & 1) ? sr : cr;
    s = (float)((q & 2) ? -ss : ss); c = (float)(((q + 1) & 2) ? -cc : cc);
}
__device__ const double INV_M[32] = {
    1.0, 0.7498942093324559, 0.5623413251903491, 0.4216965034285822, 0.31622776601683794, 0.23713737056616552, 0.1778279410038923, 0.1333521432163324,
    0.1, 0.07498942093324558, 0.05623413251903491, 0.04216965034285822, 0.03162277660168379, 0.023713737056616554, 0.01778279410038923, 0.01333521432163324,
    0.01, 0.007498942093324559, 0.005623413251903491, 0.004216965034285822, 0.0031622776601683794, 0.0023713737056616554, 0.001778279410038923, 0.001333521432163324,
    0.001, 0.0007498942093324559, 0.0005623413251903491, 0.0004216965034285822, 0.00031622776601683794, 0.00023713737056616554, 0.0001778279410038923, 0.0001333521432163324 };
__device__ const double INV_D[8] = { 1.0, 0.19392274474868576, 0.03760603093086393, 0.007292664737217109, 0.001414213562373095, 0.0002742481756762073, 5.318295896944988e-05, 1.031338537721246e-05 };

template <class FD>
__device__ __forceinline__ void tr_item64(const float* W, int Nsrc, int K, f16* WT, FD dstrow, LAS float* scr, int kb, int cb, int lane, const float* kscale = nullptr) {
    const int k0 = 64 * kb, c0 = 64 * cb, r4 = lane >> 4, cq = (lane & 15) * 4;
    f32x4 v[16];
#pragma unroll
    for (int i = 0; i < 16; ++i) v[i] = *(const f32x4*)(W + (size_t)(k0 + 4 * i + r4) * Nsrc + c0 + cq);
    if (kscale) {
#pragma unroll
        for (int i = 0; i < 16; ++i) v[i] = v[i] * kscale[k0 + 4 * i + r4]; }
#pragma unroll
    for (int i = 0; i < 16; ++i) { const int k = 4 * i + r4, sw = (i >> 1) * 4;
#pragma unroll
        for (int w = 0; w < 4; ++w) scr[k * 64 + ((cq + w) ^ sw)] = v[i][w]; }
    LDS_WAIT(); asm volatile("" ::: "memory");
    const int c = lane & 7;
#pragma unroll
    for (int j = 0; j < 8; ++j) { const int col = (lane >> 3) + 8 * j; const int dr = dstrow(c0 + col); const LAS float* sp = scr + (8 * c) * 64 + (col ^ (c * 4));
        h8 o; o[0] = (f16)sp[0 * 64]; o[1] = (f16)sp[1 * 64]; o[2] = (f16)sp[2 * 64]; o[3] = (f16)sp[3 * 64]; o[4] = (f16)sp[4 * 64]; o[5] = (f16)sp[5 * 64]; o[6] = (f16)sp[6 * 64]; o[7] = (f16)sp[7 * 64];
        *(h8*)(WT + (size_t)dr * K + k0 + 8 * c) = o; }
    LDS_WAIT(); asm volatile("" ::: "memory");
}
struct RowId { __device__ __forceinline__ int operator()(int c) const { return c; } };
struct RowWin0 { __device__ __forceinline__ int operator()(int c) const { if (c < 640) return c; const int jj = c - 640; return 640 + 2 * (jj & 31) + (jj >> 5); } };
struct RowUq { __device__ __forceinline__ int operator()(int c) const { const int h = c / 192, j = c % 192; if (j < 128) return h * 128 + j; const int jj = j - 128; return 1024 + h * 64 + 2 * (jj & 31) + (jj >> 5); } };
struct RowDiff { __device__ __forceinline__ int operator()(int c) const { if (c >= 2048) return c; const int off = c & 63; if (off >= 16) return c; return (c & ~63) + 2 * (off & 7) + (off >> 3); } };
struct RowMoeIn { __device__ __forceinline__ int operator()(int c) const { const int f = c & 2047; return (f >> 2) * 8 + (f & 3) + ((c >> 11) << 2); } };

__device__ __forceinline__ void p0_prologue() {
    const KArgs a = kargs(); const Frame F = mkframe(a);
    const int tid = F.tid, lane = F.lane;
    {
        const float* cin = (const float*)a->in[1]; const float* ada_w = (const float*)a->in[3]; const float* ada_b = (const float*)a->in[4];
        float* mods = (float*)(F.ws + WS_MODS);
        LAS float* sc = (LAS float*)F.lds; LAS float* red = (LAS float*)(F.lds + 16384);
        for (int i = tid; i < 4096; i += NTHREADS) { const float v = cin[i]; sc[i] = v / (1.0f + __expf(-v)); }
        __syncthreads();
        for (int cb = blockIdx.x; cb < 256; cb += F.G) {
            const int f0 = cb * 48, l = f0 / 6144, e0 = f0 % 6144; const int g = tid / 12, cc = tid % 12;
            if (g < 40) { f32x4 a0 = {0.f, 0.f, 0.f, 0.f}, a1 = a0, a2 = a0, a3 = a0; const float* wp = ada_w + (size_t)l * 1024 * 6144 + e0 + 4 * cc;
                f32x4 w[26];
#pragma unroll
                for (int i = 0; i < 26; ++i) { const int d = g + 40 * i; w[i] = (d < 1024) ? *(const f32x4*)(wp + (size_t)d * 6144) : (f32x4){0.f, 0.f, 0.f, 0.f}; }
#pragma unroll
                for (int i = 0; i < 26; ++i) { const int d = (g + 40 * i) & 1023; a0 += w[i] * sc[d]; a1 += w[i] * sc[1024 + d]; a2 += w[i] * sc[2048 + d]; a3 += w[i] * sc[3072 + d]; }
                LAS f32x4* rp = (LAS f32x4*)red + (g * 12 + cc) * 4; rp[0] = a0; rp[1] = a1; rp[2] = a2; rp[3] = a3; }
            __syncthreads();
            if (tid < 192) { const int c2 = tid % 48, b = tid / 48; float s = 0.f;
#pragma unroll 8
                for (int gg = 0; gg < 40; ++gg) s += red[((gg * 12 + (c2 >> 2)) * 4 + b) * 4 + (c2 & 3)];
                mods[(size_t)(l * 4 + b) * 6144 + e0 + c2] = s + ada_b[l * 6144 + e0 + c2]; }
            __syncthreads();
        }
    }
    {
        const int* pos = (const int*)a->in[2];
        float* cosm = (float*)(F.ws + WS_COSM); float* sinm = (float*)(F.ws + WS_SINM); float* cosd = (float*)(F.ws + WS_COSD); float* sind = (float*)(F.ws + WS_SIND);
        for (int i = blockIdx.x * NTHREADS + tid; i < T * 40; i += F.G * NTHREADS) {
            const int t = i / 40, j = i % 40; const double p = (double)pos[t]; float s, c;
            if (j < 32) { sincos_d(p * INV_M[j], s, c); cosm[(size_t)t * 32 + j] = c; sinm[(size_t)t * 32 + j] = s; }
            else { sincos_d(p * INV_D[j - 32], s, c); cosd[(size_t)t * 8 + (j - 32)] = c; sind[(size_t)t * 8 + (j - 32)] = s; }
        }
    }
    {
        LAS float* scr = (LAS float*)(F.lds + F.wave * 16384);
        const int gw = F.vcu * NWAVES + F.wave, NGW = F.G * NWAVES;
        { f16* z = (f16*)(F.ws + WS_WIN0) + (size_t)704 * 1024; for (int i = blockIdx.x * NTHREADS + tid; i < 8192; i += F.G * NTHREADS) *(u32x4*)(z + (size_t)i * 8) = (u32x4){0u, 0u, 0u, 0u}; }
        __syncthreads();
        constexpr int I0 = 16 * 11, I1 = 6 * 24, I2 = 4 * 32, I3 = 16 * 16, I4 = 16 * 48, I5 = 16 * 16;
        constexpr int ISM = I0 + I1 + I2 + I3 + I4 + I5;
        constexpr int IMI = 16 * 64, IMO = 32 * 16;
        constexpr int NITEMS = ISM;
        for (int it = gw; it < NITEMS; it += NGW) {
            int r = it;
            if (r < I0) { tr_item64((const float*)a->in[9], 704, 1024, (f16*)(F.ws + WS_WIN0), RowWin0(), scr, r / 11, r % 11, lane); continue; } r -= I0;
            if (r < I1) { tr_item64((const float*)a->in[12], 1536, 384, (f16*)(F.ws + WS_WUQ), RowUq(), scr, r / 24, r % 24, lane, (const float*)a->in[10]); continue; } r -= I1;
            if (r < I2) { tr_item64((const float*)a->in[13], 2048, 256, (f16*)(F.ws + WS_WUKV), RowId(), scr, r / 32, r % 32, lane, (const float*)a->in[11]); continue; } r -= I2;
            if (r < I3) { tr_item64((const float*)a->in[14], 1024, 1024, (f16*)(F.ws + WS_WO0), RowId(), scr, r / 16, r % 16, lane); continue; } r -= I3;
            if (r < I4) { tr_item64((const float*)a->in[15], 3072, 1024, (f16*)(F.ws + WS_WIN1), RowDiff(), scr, r / 48, r % 48, lane); continue; } r -= I4;
            if (r < I5) { tr_item64((const float*)a->in[18], 1024, 1024, (f16*)(F.ws + WS_WO1), RowId(), scr, r / 16, r % 16, lane); continue; }
        }
    }
}

__device__ __forceinline__ void mod_rows_p1() {
    const KArgs a = kargs(); const Frame F = mkframe(a);
    const float* x = (const float*)a->in[0]; const float* mods_l = (const float*)(F.ws + WS_MODS); f16* out = (f16*)(F.ws + WS_HA);
    const int gw = F.vcu * NWAVES + F.wave, NGW = F.G * NWAVES, lane = F.lane;
    for (int m0 = gw; m0 < T; m0 += 2 * NGW) {
        f32x4 v[2][4];
#pragma unroll
        for (int u = 0; u < 2; ++u) { const int m = m0 + u * NGW; if (m < T) {
#pragma unroll
            for (int j = 0; j < 4; ++j) v[u][j] = *(const f32x4*)(x + (size_t)m * DM + 4 * lane + 256 * j); } }
#pragma unroll
        for (int u = 0; u < 2; ++u) { const int m = m0 + u * NGW; if (m < T) { const float* mb = mods_l + (m >> 12) * 6144;
#pragma unroll
            for (int j = 0; j < 4; ++j) { const int c = 4 * lane + 256 * j; const f32x4 sh = *(const f32x4*)(mb + c), sc = *(const f32x4*)(mb + 1024 + c);
                const f32x4 h = v[u][j] * (sc + 1.0f) + sh; h4 o; o[0] = (f16)h[0]; o[1] = (f16)h[1]; o[2] = (f16)h[2]; o[3] = (f16)h[3];
                *(h4*)(out + (size_t)m * DM + c) = o; } } }
    }
}

#define RCOL(lane, j) ((((j) >> 1) << 9) + 8 * (lane) + 4 * ((j) & 1))
__device__ __forceinline__ void h8_to_f4(const h8 v, f32x4& a, f32x4& b) { a = (f32x4){(float)v[0], (float)v[1], (float)v[2], (float)v[3]}; b = (f32x4){(float)v[4], (float)v[5], (float)v[6], (float)v[7]}; }
__device__ __forceinline__ void ln_router(int l) {
    const KArgs a = kargs(); const Frame F = mkframe(a);
    const float* lng = (const float*)a->in[5] + l * DM; const float* lnb = (const float*)a->in[6] + l * DM; const float* router_w = (const float*)a->in[19] + (size_t)l * DM * NE;
    const float* mods_l = (const float*)(F.ws + WS_MODS) + (size_t)l * 4 * 6144;
    const f16* pre = (const f16*)(F.ws + WS_PRE); float* stat = (float*)(F.ws + WS_STAT); f16* hB = (f16*)(F.ws + WS_HB); float* aff = (float*)(F.ws + WS_AFF);
    LAS float* rwT = (LAS float*)F.lds;
    for (int i = F.tid; i < 16384; i += NTHREADS) { const int d = i >> 4, e = i & 15; const int seg = d >> 9, w = d & 511; rwT[e * 1024 + seg * 512 + ((w >> 2) & 1) * 256 + (w >> 3) * 4 + (w & 3)] = router_w[i]; }
    __syncthreads();
    const int gw = F.vcu * NWAVES + F.wave, NGW = F.G * NWAVES, lane = F.lane;
    for (int m0 = gw; m0 < T; m0 += 2 * NGW) {
        h8 pv[2][2];
#pragma unroll
        for (int u = 0; u < 2; ++u) { const int m = (m0 + u * NGW < T) ? m0 + u * NGW : m0; pv[u][0] = *(const h8*)(pre + (size_t)m * DM + 8 * lane); pv[u][1] = *(const h8*)(pre + (size_t)m * DM + 512 + 8 * lane); }
#pragma unroll
        for (int u = 0; u < 2; ++u) { const int m = m0 + u * NGW; if (m < T) {
        const int b = m >> 12, s_ = m & 4095; const float* mb = mods_l + b * 6144;
        f32x4 v[4]; h8_to_f4(pv[u][0], v[0], v[1]); h8_to_f4(pv[u][1], v[2], v[3]); float s = 0.f;
#pragma unroll
        for (int j = 0; j < 4; ++j) s += (v[j][0] + v[j][1]) + (v[j][2] + v[j][3]);
        const float mean = wave_sum(s) * (1.f / DM); float s2 = 0.f;
#pragma unroll
        for (int j = 0; j < 4; ++j) { v[j] = v[j] - mean; s2 += (v[j][0] * v[j][0] + v[j][1] * v[j][1]) + (v[j][2] * v[j][2] + v[j][3] * v[j][3]); }
        const float rstd = 1.0f / sqrtf(wave_sum(s2) * (1.f / DM) + LN_EPS);
        if (lane == 0) { f32x2 st = {mean, rstd}; *(f32x2*)(stat + (size_t)m * 2) = st; }
        float lg[16];
#pragma unroll
        for (int e = 0; e < 16; ++e) lg[e] = 0.f;
        f32x4 hh[4];
#pragma unroll
        for (int j = 0; j < 4; ++j) { const int c = RCOL(lane, j);
            const f32x4 g = *(const f32x4*)(lng + c), bb = *(const f32x4*)(lnb + c), sh = *(const f32x4*)(mb + 3072 + c), sc = *(const f32x4*)(mb + 4096 + c);
            const f32x4 xn = v[j] * rstd * g + bb; const f32x4 h = xn * (sc + 1.0f) + sh; hh[j] = h;
#pragma unroll
            for (int e = 0; e < 16; ++e) { const f32x4 w = *(const LAS f32x4*)(rwT + e * 1024 + (j >> 1) * 512 + (j & 1) * 256 + lane * 4); lg[e] += (h[0] * w[0] + h[1] * w[1]) + (h[2] * w[2] + h[3] * w[3]); }
            asm volatile("" ::: "memory"); }
        *(h8*)(hB + (size_t)m * DM + 8 * lane) = pack8(hh[0], hh[1]); *(h8*)(hB + (size_t)m * DM + 512 + 8 * lane) = pack8(hh[2], hh[3]);
        float mx = -1e30f;
#pragma unroll
        for (int e = 0; e < 16; ++e) { lg[e] = wave_sum(lg[e]); mx = fmaxf(mx, lg[e]); }
        float den = 0.f;
#pragma unroll
        for (int e = 0; e < 16; ++e) { lg[e] = __expf(lg[e] - mx); den += lg[e]; }
        const float rden = 1.0f / den; float mine = 0.f;
#pragma unroll
        for (int e = 0; e < 16; ++e) mine = (lane == e) ? lg[e] * rden : mine;
        if (lane < 16) aff[(size_t)(b * 16 + lane) * SEQ + s_] = mine;
        } }
    }
    __syncthreads();
}

__device__ __forceinline__ int block_excl_scan(int v, LAS int* tmp, int tid, int& total) {
    const int lane = tid & 63, wid = tid >> 6; int x = v;
#pragma unroll
    for (int o = 1; o < 64; o <<= 1) { const int y = __shfl_up(x, o); if (lane >= o) x += y; }
    if (lane == 63) tmp[wid] = x;
    __syncthreads();
    int base = 0, tot = 0;
#pragma unroll
    for (int w = 0; w < 8; ++w) { const int t = tmp[w]; if (w < wid) base += t; tot += t; }
    __syncthreads();
    total = tot; return base + x - v;
}
__device__ __forceinline__ void topk_phase() {
    const KArgs a = kargs(); const Frame F = mkframe(a);
    const float* aff = (const float*)(F.ws + WS_AFF); float* gate = (float*)(F.ws + WS_GATE); int* rowtok = (int*)(F.ws + WS_ROWTOK); int* inv = (int*)(F.ws + WS_INV);
    LAS unsigned* hist = (LAS unsigned*)F.lds; LAS unsigned* selw = hist + 256; LAS int* tmp = (LAS int*)(hist + 272);
    const int tid = F.tid;
    for (int p = blockIdx.x; p < NB * NE; p += F.G) { const int b = p >> 4, e = p & 15;
        const float* ap = aff + (size_t)p * SEQ + 8 * tid; unsigned key[8];
        { const f32x4 a0 = *(const f32x4*)ap, a1 = *(const f32x4*)(ap + 4);
          key[0] = __float_as_uint(a0[0]); key[1] = __float_as_uint(a0[1]); key[2] = __float_as_uint(a0[2]); key[3] = __float_as_uint(a0[3]);
          key[4] = __float_as_uint(a1[0]); key[5] = __float_as_uint(a1[1]); key[6] = __float_as_uint(a1[2]); key[7] = __float_as_uint(a1[3]); }
        unsigned prefix = 0u, kk = CAP;
        for (int pass = 0; pass < 4; ++pass) { const int shift = 24 - 8 * pass;
            if (tid < 256) hist[tid] = 0u;
            __syncthreads();
#pragma unroll
            for (int j = 0; j < 8; ++j) { const bool match = (pass == 0) || ((key[j] >> (shift + 8)) == prefix); if (match) atomicAdd((unsigned*)&hist[(key[j] >> shift) & 255u], 1u); }
            __syncthreads();
            { const int hv = (tid < 256) ? (int)hist[255 - tid] : 0; int tot_; const int Sp = block_excl_scan(hv, tmp, tid, tot_);
              if (tid < 256 && (unsigned)Sp < kk && kk <= (unsigned)(Sp + hv)) { selw[0] = 255u - (unsigned)tid; selw[1] = kk - (unsigned)Sp; } }
            __syncthreads();
            prefix = (prefix << 8) | selw[0]; kk = selw[1];
            __syncthreads();
        }
        int ce = 0;
#pragma unroll
        for (int j = 0; j < 8; ++j) ce += (key[j] == prefix) ? 1 : 0;
        int tot; int eqr = block_excl_scan(ce, tmp, tid, tot);
        unsigned selm = 0u; int cs = 0;
#pragma unroll
        for (int j = 0; j < 8; ++j) { bool sel = key[j] > prefix; if (key[j] == prefix) { sel = (unsigned)eqr < kk; ++eqr; } if (sel) { selm |= 1u << j; ++cs; } }
        int slot = block_excl_scan(cs, tmp, tid, tot);
#pragma unroll
        for (int j = 0; j < 8; ++j) { const int s_ = 8 * tid + j; const int tok = b * SEQ + s_; const bool sel = (selm >> j) & 1u;
            if (sel) { const int row = e * EROWS + b * CAP + slot; rowtok[row] = tok; gate[row] = __uint_as_float(key[j]); inv[(size_t)tok * 16 + e] = slot; ++slot; }
            else inv[(size_t)tok * 16 + e] = -1; }
        __syncthreads();
    }
}
__device__ __forceinline__ void combine_ln(int l) {
    const KArgs a = kargs(); const Frame F = mkframe(a);
    const float* lng1 = (const float*)a->in[5] + l * DM; const float* lnb1 = (const float*)a->in[6] + l * DM;
    const float* lng = (const float*)a->in[7] + l * DM; const float* lnb = (const float*)a->in[8] + l * DM;
    const float* mods_l = (const float*)(F.ws + WS_MODS) + (size_t)l * 4 * 6144; const float* mods_next = (const float*)(F.ws + WS_MODS) + (size_t)4 * 6144;
    float* xo32 = a->out; f16* x2 = (f16*)(F.ws + WS_X2); f16* hA = (f16*)(F.ws + WS_HA);
    const f16* pre = (const f16*)(F.ws + WS_PRE); const float* stat = (const float*)(F.ws + WS_STAT); const f16* y = (const f16*)(F.ws + WS_Y); const int* inv = (const int*)(F.ws + WS_INV);
    const int gw = F.vcu * NWAVES + F.wave, NGW = F.G * NWAVES, lane = F.lane;
    for (int m0 = gw; m0 < T; m0 += 2 * NGW) {
        int myinv[2]; h8 pv[2][2]; f32x2 st[2];
#pragma unroll
        for (int u = 0; u < 2; ++u) { const int m = (m0 + u * NGW < T) ? m0 + u * NGW : m0; myinv[u] = inv[(size_t)m * 16 + (lane & 15)]; st[u] = *(const f32x2*)(stat + (size_t)m * 2);
            pv[u][0] = *(const h8*)(pre + (size_t)m * DM + 8 * lane); pv[u][1] = *(const h8*)(pre + (size_t)m * DM + 512 + 8 * lane); }
#pragma unroll
        for (int u = 0; u < 2; ++u) { const int m = m0 + u * NGW; if (m < T) {
        const int b = m >> 12; const float* mb = mods_l + b * 6144;
        f32x4 f[4];
#pragma unroll
        for (int j = 0; j < 4; ++j) f[j] = (f32x4){0.f, 0.f, 0.f, 0.f};
        unsigned mask = (unsigned)(__ballot(myinv[u] >= 0) & 0xFFFFull);
        while (mask) {
            const int e0 = __builtin_ctz(mask); mask &= mask - 1u; const bool two = mask != 0u; const int e1 = two ? __builtin_ctz(mask) : e0; mask &= mask - 1u;
            const int s0 = __shfl(myinv[u], e0), s1 = __shfl(myinv[u], e1);
            const f16* y0 = y + (size_t)(e0 * EROWS + b * CAP + s0) * DM; const f16* y1 = y + (size_t)(e1 * EROWS + b * CAP + s1) * DM;
            const h8 a00 = *(const h8*)(y0 + 8 * lane), a01 = *(const h8*)(y0 + 512 + 8 * lane), a10 = *(const h8*)(y1 + 8 * lane), a11 = *(const h8*)(y1 + 512 + 8 * lane);
            const float w1 = two ? 1.0f : 0.0f; f32x4 t0, t1;
            h8_to_f4(a00, t0, t1); f[0] += t0; f[1] += t1; h8_to_f4(a01, t0, t1); f[2] += t0; f[3] += t1;
            h8_to_f4(a10, t0, t1); f[0] += t0 * w1; f[1] += t1 * w1; h8_to_f4(a11, t0, t1); f[2] += t0 * w1; f[3] += t1 * w1;
        }
        f32x4 v[4]; h8_to_f4(pv[u][0], v[0], v[1]); h8_to_f4(pv[u][1], v[2], v[3]); float s = 0.f;
#pragma unroll
        for (int j = 0; j < 4; ++j) { const int c = RCOL(lane, j); const f32x4 g1 = *(const f32x4*)(lng1 + c), b1 = *(const f32x4*)(lnb1 + c), g2 = *(const f32x4*)(mb + 5120 + c);
            const f32x4 x1 = (v[j] - st[u][0]) * st[u][1] * g1 + b1;
            v[j] = x1 * ALPHA + (g2 + 1.0f) * f[j]; s += (v[j][0] + v[j][1]) + (v[j][2] + v[j][3]); }
        const float mean = wave_sum(s) * (1.f / DM); float s2 = 0.f;
#pragma unroll
        for (int j = 0; j < 4; ++j) { v[j] = v[j] - mean; s2 += (v[j][0] * v[j][0] + v[j][1] * v[j][1]) + (v[j][2] * v[j][2] + v[j][3] * v[j][3]); }
        const float rstd = 1.0f / sqrtf(wave_sum(s2) * (1.f / DM) + LN_EPS);
        f32x4 xn[4];
#pragma unroll
        for (int j = 0; j < 4; ++j) { const int c = RCOL(lane, j); const f32x4 g = *(const f32x4*)(lng + c), bb = *(const f32x4*)(lnb + c); xn[j] = v[j] * rstd * g + bb; }
        if (l == 0) {
            *(h8*)(x2 + (size_t)m * DM + 8 * lane) = pack8(xn[0], xn[1]); *(h8*)(x2 + (size_t)m * DM + 512 + 8 * lane) = pack8(xn[2], xn[3]);
            const float* mn = mods_next + b * 6144; f32x4 hv[4];
#pragma unroll
            for (int j = 0; j < 4; ++j) { const int c = RCOL(lane, j); const f32x4 sh = *(const f32x4*)(mn + c), sc = *(const f32x4*)(mn + 1024 + c); hv[j] = xn[j] * (sc + 1.0f) + sh; }
            *(h8*)(hA + (size_t)m * DM + 8 * lane) = pack8(hv[0], hv[1]); *(h8*)(hA + (size_t)m * DM + 512 + 8 * lane) = pack8(hv[2], hv[3]);
        } else {
#pragma unroll
            for (int j = 0; j < 4; ++j) *(f32x4*)(xo32 + (size_t)m * DM + RCOL(lane, j)) = xn[j];
        }
        } }
    }
}

__device__ __forceinline__ void attn_mla() {
    const KArgs a = kargs(); const Frame F = mkframe(a);
    const f16* Q = (const f16*)(F.ws + WS_Q); const f16* K = (const f16*)(F.ws + WS_K); const f16* V = (const f16*)(F.ws + WS_V); f16* O = (f16*)(F.ws + WS_O);
    att::ConvStream cs; att::conv_init(cs, (const float*)a->in[20], (const float*)a->in[21], (f16*)(F.ws + WS_MOEIN), (f16*)(F.ws + WS_MOEOUT), 0, F.vcu * NWAVES + F.wave, F.G * NWAVES, 4, F.ldsg + 83968 + F.wave * 4096);
    for (int u = F.vcu; u < NB * 8 * 16; u += F.G) { const int qb = u & 15, bh = u >> 4, h = bh & 7, b = bh >> 3;
        att::attn_body_simple<192, 1536, 1536, 1024, 1024, true>(Q + (size_t)(b * SEQ + qb * 256) * 1536 + h * 192, K + (size_t)(b * SEQ) * 1536 + h * 192, V + (size_t)(b * SEQ) * 1024 + h * 128,
                                                                 O + (size_t)(b * SEQ + qb * 256) * 1024 + h * 128, F.ldsg, 0, 0.f, nullptr, &cs); }
    while (cs.step < cs.step_end) { cs.it = 0; att::conv_tick(cs, F.lane); att::conv_flush(cs, F.lane); }
    att::conv_flush(cs, F.lane); att::conv_drain(cs, F.lane);
}
__device__ __forceinline__ void attn_diff() {
    const KArgs a = kargs(); const Frame F = mkframe(a);
    const f16* QKV = (const f16*)(F.ws + WS_QKV1); f16* O = (f16*)(F.ws + WS_O);
    const float* lamv = (const float*)a->in[16]; const float* subln = (const float*)a->in[17];
    const float l01 = wave_sum(lamv[F.lane] * lamv[64 + F.lane]), l23 = wave_sum(lamv[128 + F.lane] * lamv[192 + F.lane]);
    const float lam = expf(l01) - expf(l23) + LAMBDA_INIT;
    att::ConvStream cs; att::conv_init(cs, (const float*)a->in[20], (const float*)a->in[21], (f16*)(F.ws + WS_MOEIN), (f16*)(F.ws + WS_MOEOUT), 1, F.vcu * NWAVES + F.wave, F.G * NWAVES, 8, F.ldsg + 51200 + F.wave * 4096);
    for (int u = F.vcu; u < NB * 8 * 16; u += F.G) { const int qb = u & 15, bh = u >> 4, h = bh & 7, b = bh >> 3;
        f16* Ob = O + (size_t)(b * SEQ + qb * 256) * 1024 + h * 128; const f16* Vh = QKV + (size_t)(b * SEQ) * 3072 + 2048 + h * 128;
#pragma unroll 1
        for (int c = 0; c < 2; ++c) { const int hh = 2 * h + c;
            att::attn_body_simple<64, 3072, 3072, 3072, 1024, true>(QKV + (size_t)(b * SEQ + qb * 256) * 3072 + hh * 64, QKV + (size_t)(b * SEQ) * 3072 + 1024 + hh * 64, Vh, Ob, F.ldsg, c, lam, subln, &cs); } }
    cs.it = 0;
    while (cs.step < cs.step_end) { cs.it = 0; att::conv_tick(cs, F.lane); att::conv_flush(cs, F.lane); }
    att::conv_flush(cs, F.lane); att::conv_drain(cs, F.lane);
}

__device__ __forceinline__ void ph_gemm_lat() { const KArgs a = kargs(); const Frame F = mkframe(a);
    pg8::Gemm g{(const f16*)(F.ws + WS_HA), (const f16*)(F.ws + WS_WIN0), T, 768, 1024, 1 << 30, 0, nullptr}; pg8::StaticOrder S; S.init(T, 768, F.G, (int)blockIdx.x);
    EpiLat E{(f16*)(F.ws + WS_CQN), (f16*)(F.ws + WS_CKVN), (f16*)(F.ws + WS_K), (float*)(F.ws + WS_PQ), (float*)(F.ws + WS_PKV), (const float*)(F.ws + WS_COSM), (const float*)(F.ws + WS_SINM)}; pg8::gemm_phase<EpiLat>(F.lds, g, S, E); }
__device__ __forceinline__ void ph_gemm_q() { const KArgs a = kargs(); const Frame F = mkframe(a);
    pg8::Gemm g{(const f16*)(F.ws + WS_CQN), (const f16*)(F.ws + WS_WUQ), T, 1024, 384, 1 << 30, 0, nullptr}; pg8::StaticOrder S; S.init(T, 1024, F.G, (int)blockIdx.x);
    EpiQNope E{(f16*)(F.ws + WS_Q), (const float*)(F.ws + WS_PQ)}; pg8::gemm_phase<EpiQNope>(F.lds, g, S, E); }
__device__ __forceinline__ void ph_gemm_qr() { const KArgs a = kargs(); const Frame F = mkframe(a);
    pg8::Gemm g{(const f16*)(F.ws + WS_CQN), (const f16*)(F.ws + WS_WUQ) + (size_t)1024 * 384, T, 512, 384, 1 << 30, 0, nullptr}; pg8::StaticOrder S; S.init(T, 512, F.G, (int)blockIdx.x);
    EpiQRope E{(f16*)(F.ws + WS_Q), (const float*)(F.ws + WS_COSM), (const float*)(F.ws + WS_SINM), (const float*)(F.ws + WS_PQ)}; pg8::gemm_phase<EpiQRope>(F.lds, g, S, E); }
__device__ __forceinline__ void ph_gemm_kv() { const KArgs a = kargs(); const Frame F = mkframe(a);
    pg8::Gemm g{(const f16*)(F.ws + WS_CKVN), (const f16*)(F.ws + WS_WUKV), T, 2048, 256, 1 << 30, 0, nullptr}; pg8::StaticOrder S; S.init(T, 2048, F.G, (int)blockIdx.x);
    EpiKV E{(f16*)(F.ws + WS_K), (f16*)(F.ws + WS_V), (const float*)(F.ws + WS_PKV)}; pg8::gemm_phase<EpiKV>(F.lds, g, S, E); }
__device__ __forceinline__ void ph_gemm_o(int l) { const KArgs a = kargs(); const Frame F = mkframe(a);
    pg8::Gemm g{(const f16*)(F.ws + WS_O), (const f16*)(F.ws + (l == 0 ? WS_WO0 : WS_WO1)), T, 1024, 1024, 1 << 30, 0, nullptr}; pg8::StaticOrder S; S.init(T, 1024, F.G, (int)blockIdx.x);
    const float* gm = (const float*)(F.ws + WS_MODS) + (size_t)l * 4 * 6144 + 2048;
    if (l == 0) { EpiPre<false> E{a->in[0], gm, (f16*)(F.ws + WS_PRE)}; pg8::gemm_phase<EpiPre<false>>(F.lds, g, S, E); }
    else { EpiPre<true> E{(const void*)(F.ws + WS_X2), gm, (f16*)(F.ws + WS_PRE)}; pg8::gemm_phase<EpiPre<true>>(F.lds, g, S, E); } }
__device__ __forceinline__ void ph_gemm_diffin() { const KArgs a = kargs(); const Frame F = mkframe(a);
    pg8::Gemm g{(const f16*)(F.ws + WS_HA), (const f16*)(F.ws + WS_WIN1), T, 3072, 1024, 1 << 30, 0, nullptr}; pg8::StaticOrder S; S.init(T, 3072, F.G, (int)blockIdx.x);
    EpiDiffIn E{(f16*)(F.ws + WS_QKV1), (const float*)(F.ws + WS_COSD), (const float*)(F.ws + WS_SIND)}; pg8::gemm_phase<EpiDiffIn>(F.lds, g, S, E); }
__device__ __forceinline__ void ph_gemm_up(int l) { const KArgs a = kargs(); const Frame F = mkframe(a);
    pg8::Gemm g{(const f16*)(F.ws + WS_HB), (const f16*)(F.ws + WS_MOEIN) + (size_t)l * NE * 4096 * 1024, MROWS, 4096, 1024, EROWS / 256, (size_t)4096 * 1024, (const int*)(F.ws + WS_ROWTOK)}; pg8::StaticOrder S; S.init(MROWS, 4096, F.G, (int)blockIdx.x);
    EpiUp E{(f16*)(F.ws + WS_ACT)}; pg8::gemm_phase<EpiUp, true, true, true>(F.lds, g, S, E); }
__device__ __forceinline__ void ph_gemm_down(int l) { const KArgs a = kargs(); const Frame F = mkframe(a);
    pg8::Gemm g{(const f16*)(F.ws + WS_ACT), (const f16*)(F.ws + WS_MOEOUT) + (size_t)l * NE * 1024 * 2048, MROWS, 1024, 2048, EROWS / 256, (size_t)1024 * 2048, nullptr}; pg8::StaticOrder S; S.init(MROWS, 1024, F.G, (int)blockIdx.x);
    EpiDown E{(f16*)(F.ws + WS_Y), (const float*)(F.ws + WS_GATE)}; pg8::gemm_phase<EpiDown>(F.lds, g, S, E); }

constexpr int NPHASES = 24;
__global__ void __launch_bounds__(NTHREADS, 2) mk_fwd(Args args) {
    LAS unsigned char* ldsp = (LAS unsigned char*)g_lds;
    volatile LAS unsigned* MISC = (volatile LAS unsigned*)(ldsp + MISC_OFF);
    for (int u = threadIdx.x; u < (LDS_BYTES - LDSCTL_OFF) / 4; u += NTHREADS) ((LAS unsigned*)(ldsp + LDSCTL_OFF))[u] = 0u;
    __syncthreads();
    XcdBarrier bar = xcd_barrier_post((unsigned*)(args.ws + WS_CTL) + CW_BAR + args.li * XCD_BAR_WORDS, MISC + 8);
    const int lo = args.ph_lo, hi = args.ph_hi;
#ifndef PH_MASK
#define PH_MASK 0xFFFFFFFFu
#endif
#define IN(k) (((PH_MASK >> (k)) & 1u) && lo <= (k) && (k) < hi)
#define SEAM(k) do { if (lo <= (k) && (k) + 1 < hi) xcd_barrier(bar); } while (0)
#ifndef REP_MASK
#define REP_MASK 0u
#endif
#define RUN(k, call) do { if (IN(k)) { call; if ((REP_MASK >> (k)) & 1u) { __syncthreads(); call; } } } while (0)
    RUN(0, p0_prologue());      SEAM(0);
    RUN(1, mod_rows_p1());      SEAM(1);
    RUN(2, ph_gemm_lat());      SEAM(2);
    RUN(4, ph_gemm_q()); RUN(4, ph_gemm_qr());
    RUN(5, ph_gemm_kv());       SEAM(5);
    RUN(6, attn_mla());         SEAM(6);
#pragma unroll 1
    for (int l = 0; l < 2; ++l) {
        const int pb = (l == 0) ? 7 : 17;
        if (l == 1) {
            RUN(14, ph_gemm_diffin()); SEAM(14);
            RUN(15, attn_diff());      SEAM(15);
        }
        RUN(pb + 0, ph_gemm_o(l));     SEAM(pb + 0);
        RUN(pb + 1, ln_router(l));     SEAM(pb + 1);
        RUN(pb + 2, topk_phase());     SEAM(pb + 2);
        RUN(pb + 4, ph_gemm_up(l));    SEAM(pb + 4);
        RUN(pb + 5, ph_gemm_down(l));  SEAM(pb + 5);
        RUN(pb + 6, combine_ln(l));
        if (l == 0) SEAM(pb + 6);
    }
#undef IN
#undef SEAM
}

extern "C" void kernel_launch(void* const* d_in, const int* in_sizes, int n_in, void* d_out, int out_size, void* d_ws, size_t ws_size, hipStream_t stream) {
    static int grid = 0;
    if (grid == 0) {
        if (n_in != 22 || in_sizes[0] != T * DM || out_size != T * DM || ws_size < WS_END) {
            fprintf(stderr, "kernel_launch: shape/workspace mismatch: n_in %d in0 %d out %d ws %zu (need %zu)\n", n_in, n_in > 0 ? in_sizes[0] : -1, out_size, ws_size, (size_t)WS_END); grid = -1; return; }
        int dev = 0, cus = 0, per_cu = 0;
        if (hipGetDevice(&dev) != hipSuccess || hipDeviceGetAttribute(&cus, hipDeviceAttributeMultiprocessorCount, dev) != hipSuccess) { fprintf(stderr, "kernel_launch: device query failed\n"); grid = -1; return; }
        if (hipFuncSetAttribute((const void*)mk_fwd, hipFuncAttributeMaxDynamicSharedMemorySize, LDS_BYTES) != hipSuccess) { fprintf(stderr, "kernel_launch: hipFuncSetAttribute failed\n"); grid = -1; return; }
        if (hipOccupancyMaxActiveBlocksPerMultiprocessor(&per_cu, (const void*)mk_fwd, NTHREADS, LDS_BYTES) != hipSuccess || per_cu < 1)
            fprintf(stderr, "kernel_launch: note: occupancy query reports %d workgroups per CU\n", per_cu);
        (void)hipGetLastError();
        grid = cus;
    }
    if (grid < 0) return;
    if (hipMemsetAsync((char*)d_ws + WS_CTL, 0, CTL_ZERO_BYTES, stream) != hipSuccess) { fprintf(stderr, "kernel_launch: memset failed\n"); return; }
    Args a{};
    for (int i = 0; i < 22; ++i) a.in[i] = d_in[i];
    a.out = (float*)d_out; a.ws = (unsigned char*)d_ws;
#if MK_CUTS == 1
    a.ph_lo = 0; a.ph_hi = NPHASES; a.li = 0;
    hipLaunchKernelGGL(mk_fwd, dim3(grid), dim3(NTHREADS), LDS_BYTES, stream, a);
#else
    for (int p = 0; p < NPHASES; ++p) { a.ph_lo = p; a.ph_hi = p + 1; a.li = 0; hipLaunchKernelGGL(mk_fwd, dim3(grid), dim3(NTHREADS), LDS_BYTES, stream, a); }
#endif
    const hipError_t le = hipPeekAtLastError();
    if (le != hipSuccess) fprintf(stderr, "kernel_launch: launch failed: %s\n", hipGetErrorName(le));
}
```

```cpp
#include <hip/hip_runtime.h>
#include <cstdio>
#include <cstdint>

#ifndef MK_CUTS
#define MK_CUTS 1
#endif


#define LAS __attribute__((address_space(3)))
#define GAS __attribute__((address_space(1)))
typedef _Float16 f16;
typedef _Float16 h8 __attribute__((ext_vector_type(8)));
typedef _Float16 h4 __attribute__((ext_vector_type(4)));
typedef _Float16 h2 __attribute__((ext_vector_type(2)));
typedef short s16x4 __attribute__((ext_vector_type(4)));
typedef float f32x4 __attribute__((ext_vector_type(4)));
typedef float f32x2 __attribute__((ext_vector_type(2)));
typedef float f32x16 __attribute__((ext_vector_type(16)));
typedef unsigned u32x4 __attribute__((ext_vector_type(4)));
typedef unsigned u32x2 __attribute__((ext_vector_type(2)));

constexpr int NB = 4, SEQ = 4096, DM = 1024, T = NB * SEQ;
constexpr int NE = 16, FF = 2048, CAP = 512, EROWS = NB * CAP;
constexpr int MROWS = NE * EROWS;
constexpr float ALPHA = 1.4142135623730951f;
constexpr float LN_EPS = 1e-5f, LAT_EPS = 1e-6f;
constexpr float LAMBDA_INIT = 0.35550906759096926f;
constexpr int NWAVES = 8, NTHREADS = 512;

constexpr size_t MiB = 1u << 20;
constexpr size_t WS_CTL = 0, CTL_ZERO_BYTES = 1 * MiB;
constexpr size_t WS_MODS = 1 * MiB;
constexpr size_t WS_COSM = 2 * MiB, WS_SINM = 4 * MiB;
constexpr size_t WS_COSD = 6 * MiB, WS_SIND = 6 * MiB + 512 * 1024;
constexpr size_t WS_AFF = 7 * MiB;
constexpr size_t WS_GATE = 8 * MiB;
constexpr size_t WS_ROWTOK = 8 * MiB + 512 * 1024;
constexpr size_t WS_INV = 9 * MiB;
constexpr size_t WS_WIN0 = 16 * MiB;
constexpr size_t WS_WUQ = 18 * MiB;
constexpr size_t WS_WUKV = 20 * MiB;
constexpr size_t WS_WO0 = 22 * MiB;
constexpr size_t WS_WIN1 = 24 * MiB;
constexpr size_t WS_WO1 = 30 * MiB;
constexpr size_t WS_MOEIN = 32 * MiB;
constexpr size_t WS_MOEOUT = 288 * MiB;
constexpr size_t WS_HA = 416 * MiB;
constexpr size_t WS_HB = 448 * MiB;
constexpr size_t WS_PQ = 480 * MiB;
constexpr size_t WS_PKV = 481 * MiB;
constexpr size_t WS_CQN = 528 * MiB;
constexpr size_t WS_CKVN = 540 * MiB;
constexpr size_t WS_Q = 548 * MiB;
constexpr size_t WS_K = 596 * MiB;
constexpr size_t WS_V = 644 * MiB;
constexpr size_t WS_O = 676 * MiB;
constexpr size_t WS_PRE = 708 * MiB;
constexpr size_t WS_STAT = 772 * MiB;
constexpr size_t WS_X2 = 836 * MiB;
constexpr size_t WS_XE = 900 * MiB;
constexpr size_t WS_ACT = 964 * MiB;
constexpr size_t WS_Y = 1092 * MiB;
constexpr size_t WS_QKV1 = 1156 * MiB;
constexpr size_t WS_OD = 1252 * MiB;
constexpr size_t WS_END = 1316 * MiB;
constexpr int CW_BAR = 4096;

constexpr int RING_BYTES = 131072;
constexpr int LDSCTL_OFF = RING_BYTES, MISC_OFF = LDSCTL_OFF + 320;
constexpr int LDS_BYTES = 147456;

#define LDS_WAIT() asm volatile("s_waitcnt lgkmcnt(0)" ::: "memory")
#define VM_WAIT() asm volatile("s_waitcnt vmcnt(0)" ::: "memory")

__device__ __forceinline__ float wave_sum(float v) {
#pragma unroll
    for (int o = 1; o < 64; o <<= 1) v += __shfl_xor(v, o);
    return v;
}

#define XB_TMO      128
#define XB_XCNT(j)  (256  + 64 * (j))
#define XB_XSUB(j)  (1280 + 64 * (j))
#define XB_XGEN(j)  (2304 + 64 * (j))
#define XB_TOP      3328
#define XB_TOPGEN   3392
#define XCD_BAR_WORDS 3456
#define XB_SPIN_CAP (1u << 20)
__device__ __forceinline__ unsigned xb_ld(unsigned* p)              { return __hip_atomic_load(p, __ATOMIC_RELAXED, __HIP_MEMORY_SCOPE_AGENT); }
__device__ __forceinline__ unsigned xb_add(unsigned* p, unsigned v) { return __hip_atomic_fetch_add(p, v, __ATOMIC_RELAXED, __HIP_MEMORY_SCOPE_AGENT); }
__device__ __forceinline__ unsigned xb_xcc_id() { return (unsigned)__builtin_amdgcn_s_getreg((3 << 11) | 20) & 0xFu; }
#define XB_SPIN(cond, bar) do { unsigned _sp = 0; while (cond) { __builtin_amdgcn_s_sleep(1); \
    if ((++_sp & 255u) == 0u) { if (xb_ld(&(bar)[XB_TMO])) break; if (_sp > XB_SPIN_CAP) { atomicAdd(&(bar)[XB_TMO], 1u); break; } } } } while (0)
struct XcdBarrier { unsigned* bar; unsigned x; volatile LAS unsigned* st; };
__device__ __forceinline__ XcdBarrier xcd_barrier_post(unsigned* bar, volatile LAS unsigned* st) {
    XcdBarrier b; b.bar = bar; b.x = xb_xcc_id(); b.st = st;
    if (threadIdx.x == 0) (void)xb_add(&bar[XB_XCNT(b.x)], 1u);
    return b;
}
__device__ __forceinline__ void xcd_barrier_complete(unsigned* bar, unsigned x, unsigned& nloc, unsigned& nx) {
    const unsigned G = gridDim.x * gridDim.y * gridDim.z;
    unsigned sum, cnt, mine, sp = 0u;
    for (;;) {
        sum = 0u; cnt = 0u; mine = 0u;
#pragma unroll
        for (unsigned j = 0; j < 16; ++j) { const unsigned c = xb_ld(&bar[XB_XCNT(j)]); sum += c; cnt += (c > 0u) ? 1u : 0u; mine = (j == x) ? c : mine; }
        if (sum == G) break;
        __builtin_amdgcn_s_sleep(1);
        if ((++sp & 255u) == 0u) { if (xb_ld(&bar[XB_TMO])) break; if (sp > XB_SPIN_CAP) { atomicAdd(&bar[XB_TMO], 1u); break; } }
    }
    nloc = mine > 0u ? mine : 1u; nx = cnt > 0u ? cnt : 1u;
}
__device__ __forceinline__ void xcd_barrier(const XcdBarrier& b) {
    asm volatile("s_waitcnt vmcnt(0)" ::: "memory");
    __syncthreads();
    if (threadIdx.x == 0) {
        unsigned* bar = b.bar;
        __builtin_amdgcn_s_waitcnt(0);
        unsigned nloc = b.st[0], nx = b.st[1];
        if (nloc == 0u) { xcd_barrier_complete(bar, b.x, nloc, nx); b.st[0] = nloc; b.st[1] = nx; }
        const unsigned old = xb_add(&bar[XB_XSUB(b.x)], 1u);
        const unsigned gen = old / nloc;
        if (old + 1u == (gen + 1u) * nloc) {
            __builtin_amdgcn_fence(__ATOMIC_RELEASE, "agent");
            asm volatile("s_waitcnt vmcnt(0)" ::: "memory");
            const unsigned og = xb_add(&bar[XB_TOP], 1u);
            const unsigned tg = og / nx;
            if (og + 1u == (tg + 1u) * nx) xb_add(&bar[XB_TOPGEN], 1u);
            else XB_SPIN(xb_ld(&bar[XB_TOPGEN]) == tg, bar);
            __builtin_amdgcn_fence(__ATOMIC_ACQUIRE, "agent");
            xb_add(&bar[XB_XGEN(b.x)], 1u);
            asm volatile("s_waitcnt vmcnt(0)" ::: "memory");
        } else {
            XB_SPIN(xb_ld(&bar[XB_XGEN(b.x)]) == gen, bar);
            __builtin_amdgcn_fence(__ATOMIC_ACQUIRE, "agent");
            asm volatile("s_waitcnt vmcnt(0)" ::: "memory");
        }
    }
    __syncthreads();
}

namespace pg8 {
constexpr int BM = 256, BK = 64, HALF = 128, HTB = HALF * BK * 2, STAGE_BYTES = 8 * HTB, NXCD = 8, WGM = 8;
__host__ __device__ __forceinline__ int lds_byte(int r, int c) { const int st = (r >> 4) * 2 + (c >> 5), rr = r & 15, cc = c & 31, ob = rr * 64 + cc * 2; return st * 1024 + (ob ^ (((ob >> 9) & 1) << 5)); }
__host__ __device__ __forceinline__ void stage_rc(int b, int& R, int& C) { const int st = b / 1024, sb = b % 1024, swz = sb ^ (((sb >> 9) & 1) << 5); R = (st >> 1) * 16 + swz / 64; C = (st & 1) * 32 + (swz % 64) / 2; }
__host__ __device__ __forceinline__ int perm32(int rho) { const int n = rho >> 4, i = rho & 15; return 8 * (i >> 2) + 4 * n + (i & 3); }
struct Unit { int pm, pn; };
struct Gemm { const f16* A; const f16* Bt; int M, N, K; int grp_tiles; size_t grp_stride; const int* rowidx; };
struct StaticOrder {
    int nM, nN, nwg, G, c;
    __host__ __device__ void init(int M, int N, int G_, int c_) { nM = M / BM; nN = N / BM; nwg = nM * nN; G = G_; c = c_; }
    __host__ __device__ bool next(int i, Unit& u) const {
        const long L = (long)i * G + c; if (L >= nwg) return false;
        int wgid = (int)L; { const int q = nwg / NXCD, r = nwg % NXCD, xcd = wgid % NXCD, off = wgid / NXCD; wgid = (xcd < r ? xcd * (q + 1) : r * (q + 1) + (xcd - r) * q) + off; }
        const int nig = WGM * nN, gid = wgid / nig, fm = gid * WGM, gsz = (nM - fm) < WGM ? (nM - fm) : WGM;
        u.pm = fm + ((wgid % nig) % gsz); u.pn = (wgid % nig) / gsz; return true;
    }
};
constexpr int GATHER_MAX_UNITS = 15, GATHER_IDX_OFF = RING_BYTES + 1024;
template <class Epi, bool ALIGN_EPI = true, bool SP2 = true, bool GATHER = false>
__device__ __forceinline__ void gemm_phase(LAS unsigned char* lds, const Gemm g, const StaticOrder& S, const Epi& E) {
    int tid = threadIdx.x; asm volatile("" : "+v"(tid));
    const int wid = __builtin_amdgcn_readfirstlane(tid >> 6), lane = tid & 63, wr = wid >> 2, wc = wid & 3, fr = lane & 15, fq = lane >> 4;
    const int K = g.K, nt = K / BK;
    unsigned voffA[2], voffB[2];
#pragma unroll
    for (int i = 0; i < 2; ++i) { int R, C; stage_rc(tid * 16 + i * 8192, R, C); const int Rb = Epi::PERM ? ((R & ~31) + perm32(R & 31)) : R;
        voffA[i] = (unsigned)(R * K + C) * 2u; voffB[i] = (unsigned)(Rb * K + C) * 2u; }
    int gR[2]; unsigned gC[2];
#pragma unroll
    for (int i = 0; i < 2; ++i) { int R, C; stage_rc(tid * 16 + i * 8192, R, C); gR[i] = R; gC[i] = (unsigned)C * 2u; }
    LAS int* idxbuf = (LAS int*)(lds + GATHER_IDX_OFF);
    if constexpr (GATHER) {
        Unit uu;
        for (int q = 0; q < GATHER_MAX_UNITS; ++q) { if (!S.next(q, uu)) break; if (tid < 256) idxbuf[q * 256 + tid] = g.rowidx[uu.pm * 256 + tid]; }
        asm volatile("s_waitcnt vmcnt(0) lgkmcnt(0)" ::: "memory"); __builtin_amdgcn_s_barrier(); asm volatile("" ::: "memory");
    }
    unsigned gaC[2][2], gaN[2][2], ga2[2][2];
#define PG8_GA(dst, q) do { _Pragma("unroll") for (int _h = 0; _h < 2; ++_h) _Pragma("unroll") for (int _i = 0; _i < 2; ++_i) dst[_h][_i] = (unsigned)idxbuf[(q) * 256 + _h * 128 + gR[_i]] * (unsigned)(K * 2) + gC[_i]; } while (0)
    const size_t kstep = (size_t)(BK * 2);
    const size_t hstep = (size_t)HALF * K * 2;
    const size_t tstep = 2 * hstep;
    const unsigned ldsw = (unsigned)wid * 1024u;
    const int aoff = lds_byte(wr * 64 + fr, fq * 8), boff = lds_byte(wc * 32 + fr, fq * 8);
#define PG8_SA(b, h) (((b) * 2 + (h)) * HTB)
#define PG8_SB(b, h) ((4 + (b) * 2 + (h)) * HTB)
#define PG8_STAGE(bufoff, gbase, voff) do { _Pragma("unroll") for (int _i = 0; _i < 2; ++_i) \
        __builtin_amdgcn_global_load_lds((const unsigned*)((const char*)(gbase) + (voff)[_i]), (LAS unsigned*)(lds + (bufoff) + ldsw + _i * 8192), 16, 0, 0); } while (0)
#define PG8_LDA(dst, b, h) do { _Pragma("unroll") for (int m = 0; m < 4; ++m) _Pragma("unroll") for (int k = 0; k < 2; ++k) dst[m][k] = *(const LAS h8*)(lds + PG8_SA(b, h) + aoff + m * 2048 + k * 1024); } while (0)
#define PG8_LDB(dst, b, h) do { _Pragma("unroll") for (int n = 0; n < 2; ++n) _Pragma("unroll") for (int k = 0; k < 2; ++k) dst[n][k] = *(const LAS h8*)(lds + PG8_SB(b, h) + boff + n * 2048 + k * 1024); } while (0)
#define PG8_MMA(ai, bj, At, Bt) do { __builtin_amdgcn_s_setprio(1); _Pragma("unroll") for (int m = 0; m < 4; ++m) _Pragma("unroll") for (int n = 0; n < 2; ++n) _Pragma("unroll") for (int k = 0; k < 2; ++k) \
        acc[ai][bj][m][n] = __builtin_amdgcn_mfma_f32_16x16x32_f16(Bt[n][k], At[m][k], acc[ai][bj][m][n], 0, 0, 0); __builtin_amdgcn_s_setprio(0); } while (0)
#define PG8_WAIT_V(n) asm volatile("s_waitcnt vmcnt(" #n ")" ::: "memory")
#define PG8_WAIT_L(n) asm volatile("s_waitcnt lgkmcnt(" #n ")" ::: "memory")
#define PG8_BAR __builtin_amdgcn_s_barrier()
#define PG8_SCHED __builtin_amdgcn_sched_barrier(0)
#define PG8_STA(bufoff, tileptr, h, gaset, kbyte) do { if constexpr (GATHER) { PG8_STAGE(bufoff, (const char*)g.A + (kbyte), gaset[h]); } else { PG8_STAGE(bufoff, (tileptr) + (h) * hstep, voffA); } } while (0)
#define PG8_BBASE(u) ((const char*)g.Bt + ((size_t)((u).pm / g.grp_tiles) * g.grp_stride) * 2 + (size_t)(u).pn * tstep)
    Unit cur, nxt; int ui = 0;
    if (!S.next(0, cur)) return;
    f32x4 acc[2][2][4][2];
#pragma unroll
    for (int a = 0; a < 2; ++a)
#pragma unroll
        for (int b = 0; b < 2; ++b)
#pragma unroll
            for (int m = 0; m < 4; ++m)
#pragma unroll
                for (int n = 0; n < 2; ++n) acc[a][b][m][n] = (f32x4){0.f, 0.f, 0.f, 0.f};
    h8 At[4][2], B0[2][2], B1[2][2];
    const char* cA = (const char*)g.A + (size_t)cur.pm * tstep; const char* cB = PG8_BBASE(cur);
    if constexpr (GATHER) { PG8_GA(gaC, 0); }
    if constexpr (SP2) {
        PG8_STAGE(PG8_SB(0, 0), cB, voffB); PG8_STAGE(PG8_SB(0, 1), cB + hstep, voffB); PG8_STA(PG8_SA(0, 0), cA, 0, gaC, 0); PG8_STA(PG8_SA(0, 1), cA, 1, gaC, 0);
        if (wr == 1) PG8_BAR;
        PG8_WAIT_V(2); PG8_BAR;
        PG8_STAGE(PG8_SB(1, 0), cB + kstep, voffB); PG8_STA(PG8_SA(1, 0), cA + kstep, 0, gaC, kstep); PG8_STAGE(PG8_SB(1, 1), cB + hstep + kstep, voffB);
        PG8_WAIT_V(6); PG8_BAR;
    } else {
        PG8_STAGE(PG8_SB(0, 0), cB, voffB); PG8_STA(PG8_SA(0, 0), cA, 0, gaC, 0); PG8_STAGE(PG8_SB(0, 1), cB + hstep, voffB); PG8_STA(PG8_SA(0, 1), cA, 1, gaC, 0);
        if (wr == 1) PG8_BAR;
        PG8_WAIT_V(4); PG8_BAR;
        PG8_STAGE(PG8_SB(1, 0), cB + kstep, voffB); PG8_STA(PG8_SA(1, 0), cA + kstep, 0, gaC, kstep); PG8_STAGE(PG8_SB(1, 1), cB + hstep + kstep, voffB);
        PG8_WAIT_V(6); PG8_BAR;
    }
    for (;;) {
        const bool has_next = S.next(ui + 1, nxt);
        const char* nA = has_next ? (const char*)g.A + (size_t)nxt.pm * tstep : cA; const char* nB = has_next ? PG8_BBASE(nxt) : cB;
        if constexpr (GATHER) { const int qn = has_next ? ui + 1 : ui; PG8_GA(gaN, qn); }
#pragma unroll 1
        for (int t = 0; t < nt; t += 2) {
            const bool last = (t == nt - 2);
            const char* a1 = cA + (size_t)(t + 1) * kstep;
            const char* a2 = last ? nA : cA + (size_t)(t + 2) * kstep; const char* b2 = last ? nB : cB + (size_t)(t + 2) * kstep;
            const char* a3 = a2 + kstep; const char* b3 = b2 + kstep;
            const size_t k1 = (size_t)(t + 1) * kstep, k2 = last ? 0 : (size_t)(t + 2) * kstep, k3 = k2 + kstep;
            if constexpr (GATHER) { _Pragma("unroll") for (int _h = 0; _h < 2; ++_h) _Pragma("unroll") for (int _i = 0; _i < 2; ++_i) ga2[_h][_i] = last ? gaN[_h][_i] : gaC[_h][_i]; }
            if constexpr (SP2) {
            PG8_LDB(B0, 0, 0); PG8_LDB(B1, 0, 1); PG8_SCHED; PG8_LDA(At, 0, 0); PG8_STA(PG8_SA(1, 1), a1, 1, gaC, k1);
            PG8_WAIT_V(8); PG8_WAIT_L(0); PG8_BAR; PG8_MMA(0, 0, At, B0); PG8_MMA(0, 1, At, B1); PG8_BAR; PG8_SCHED;
            PG8_LDA(At, 0, 1); PG8_STAGE(PG8_SB(0, 0), b2, voffB); PG8_STAGE(PG8_SB(0, 1), b2 + hstep, voffB); PG8_STA(PG8_SA(0, 0), a2, 0, ga2, k2);
            PG8_WAIT_V(8); PG8_WAIT_L(0); PG8_BAR; PG8_MMA(1, 0, At, B0); PG8_MMA(1, 1, At, B1); PG8_BAR; PG8_SCHED;
            PG8_LDB(B0, 1, 0); PG8_LDB(B1, 1, 1); PG8_SCHED; PG8_LDA(At, 1, 0); PG8_STA(PG8_SA(0, 1), a2, 1, ga2, k2);
            PG8_WAIT_V(8); PG8_WAIT_L(0); PG8_BAR; PG8_MMA(0, 0, At, B0); PG8_MMA(0, 1, At, B1); PG8_BAR; PG8_SCHED;
            PG8_LDA(At, 1, 1); PG8_STAGE(PG8_SB(1, 0), b3, voffB); PG8_STAGE(PG8_SB(1, 1), b3 + hstep, voffB); PG8_STA(PG8_SA(1, 0), a3, 0, ga2, k3);
            PG8_WAIT_V(8); PG8_WAIT_L(0); PG8_BAR; PG8_MMA(1, 0, At, B0); PG8_MMA(1, 1, At, B1); PG8_BAR; PG8_SCHED;
            } else {
            PG8_LDB(B0, 0, 0); PG8_SCHED; PG8_LDA(At, 0, 0); PG8_STA(PG8_SA(1, 1), a1, 1, gaC, k1);
            PG8_WAIT_L(8); PG8_BAR; PG8_WAIT_L(0); PG8_MMA(0, 0, At, B0); PG8_BAR; PG8_SCHED;
            PG8_LDB(B1, 0, 1); PG8_STAGE(PG8_SB(0, 0), b2, voffB);
            PG8_BAR; PG8_WAIT_L(0); PG8_MMA(0, 1, At, B1); PG8_BAR;
            PG8_LDA(At, 0, 1); PG8_STA(PG8_SA(0, 0), a2, 0, ga2, k2);
            PG8_BAR; PG8_WAIT_L(0); PG8_MMA(1, 0, At, B0); PG8_BAR; PG8_SCHED;
            PG8_STAGE(PG8_SB(0, 1), b2 + hstep, voffB);
            PG8_WAIT_V(6); PG8_BAR; PG8_MMA(1, 1, At, B1); PG8_BAR;
            PG8_LDB(B0, 1, 0); PG8_SCHED; PG8_LDA(At, 1, 0); PG8_STA(PG8_SA(0, 1), a2, 1, ga2, k2);
            PG8_WAIT_L(8); PG8_BAR; PG8_WAIT_L(0); PG8_MMA(0, 0, At, B0); PG8_BAR; PG8_SCHED;
            PG8_LDB(B1, 1, 1); PG8_STAGE(PG8_SB(1, 0), b3, voffB);
            PG8_BAR; PG8_WAIT_L(0); PG8_MMA(0, 1, At, B1); PG8_BAR;
            PG8_LDA(At, 1, 1); PG8_STA(PG8_SA(1, 0), a3, 0, ga2, k3);
            PG8_BAR; PG8_WAIT_L(0); PG8_MMA(1, 0, At, B0); PG8_BAR; PG8_SCHED;
            PG8_STAGE(PG8_SB(1, 1), b3 + hstep, voffB);
            PG8_WAIT_V(6); PG8_BAR; PG8_MMA(1, 1, At, B1); PG8_BAR;
            }
        }
        if constexpr (ALIGN_EPI) { if (wr == 0) PG8_BAR; }
        E(acc, cur, wr, wc, fr, fq);
        if (!has_next) break;
#pragma unroll
        for (int a = 0; a < 2; ++a)
#pragma unroll
            for (int b = 0; b < 2; ++b)
#pragma unroll
                for (int m = 0; m < 4; ++m)
#pragma unroll
                    for (int n = 0; n < 2; ++n) acc[a][b][m][n] = (f32x4){0.f, 0.f, 0.f, 0.f};
        cur = nxt; cA = nA; cB = nB; ++ui;
        if constexpr (GATHER) { _Pragma("unroll") for (int _h = 0; _h < 2; ++_h) _Pragma("unroll") for (int _i = 0; _i < 2; ++_i) gaC[_h][_i] = gaN[_h][_i]; }
        if constexpr (ALIGN_EPI) { if (wr == 1) PG8_BAR; }
    }
    PG8_WAIT_V(0);
    if constexpr (!ALIGN_EPI) { if (wr == 0) PG8_BAR; }
    PG8_BAR;
#undef PG8_SA
#undef PG8_SB
#undef PG8_STAGE
#undef PG8_LDA
#undef PG8_LDB
#undef PG8_MMA
#undef PG8_WAIT_V
#undef PG8_WAIT_L
#undef PG8_BAR
#undef PG8_SCHED
#undef PG8_BBASE
#undef PG8_STA
#undef PG8_GA
}
}

#define EPI_ROW(u, ai, m) ((u).pm * 256 + (ai) * 128 + wr * 64 + (m) * 16 + fr)
__device__ __forceinline__ h8 pack8(f32x4 a, f32x4 b) { h8 o; o[0] = (f16)a[0]; o[1] = (f16)a[1]; o[2] = (f16)a[2]; o[3] = (f16)a[3]; o[4] = (f16)b[0]; o[5] = (f16)b[1]; o[6] = (f16)b[2]; o[7] = (f16)b[3]; return o; }
__device__ __forceinline__ void rope4(f32x4& v0, f32x4& v1, const f32x4 cs, const f32x4 sn) {
    const f32x4 a = v0, b = v1;
    v0[0] = a[0] * cs[0] - a[1] * sn[0]; v0[1] = a[1] * cs[0] + a[0] * sn[0];
    v0[2] = a[2] * cs[1] - a[3] * sn[1]; v0[3] = a[3] * cs[1] + a[2] * sn[1];
    v1[0] = b[0] * cs[2] - b[1] * sn[2]; v1[1] = b[1] * cs[2] + b[0] * sn[2];
    v1[2] = b[2] * cs[3] - b[3] * sn[3]; v1[3] = b[3] * cs[3] + b[2] * sn[3];
}
struct EpiLat {
    static constexpr bool PERM = true; f16* cq; f16* ckv; f16* Kp; float* pq; float* pkv; const float* cosm; const float* sinm;
    __device__ __forceinline__ void operator()(const f32x4 (&acc)[2][2][4][2], const pg8::Unit& u, int wr, int wc, int fr, int fq) const {
#pragma unroll
        for (int ai = 0; ai < 2; ++ai)
#pragma unroll
            for (int m = 0; m < 4; ++m) { const int t = EPI_ROW(u, ai, m); float sq = 0.f, sk = 0.f;
#pragma unroll
                for (int bj = 0; bj < 2; ++bj) { const int c8 = u.pn * 256 + bj * 128 + wc * 32 + 8 * fq; const int ht = u.pn * 2 + bj;
                    f32x4 v0 = acc[ai][bj][m][0], v1 = acc[ai][bj][m][1];
                    const float ss = (v0[0] * v0[0] + v0[1] * v0[1]) + (v0[2] * v0[2] + v0[3] * v0[3]) + (v1[0] * v1[0] + v1[1] * v1[1]) + (v1[2] * v1[2] + v1[3] * v1[3]);
                    if (ht < 3) { sq += ss; *(h8*)(cq + (size_t)t * 384 + c8) = pack8(v0, v1); }
                    else if (ht < 5) { sk += ss; *(h8*)(ckv + (size_t)t * 256 + (c8 - 384)) = pack8(v0, v1); }
                    else if (c8 < 704) { const int jj = c8 - 640, i0 = jj >> 1;
                        const f32x4 cs = *(const f32x4*)(cosm + (size_t)t * 32 + i0), sn = *(const f32x4*)(sinm + (size_t)t * 32 + i0); rope4(v0, v1, cs, sn);
                        const h8 o = pack8(v0, v1);
#pragma unroll
                        for (int h = 0; h < 8; ++h) *(h8*)(Kp + (size_t)t * 1536 + h * 192 + 128 + jj) = o; } }
                sq += __shfl_xor(sq, 16); sq += __shfl_xor(sq, 32); sk += __shfl_xor(sk, 16); sk += __shfl_xor(sk, 32);
                if (fq == 0) { if (u.pn < 2) pq[(size_t)t * 8 + u.pn * 4 + wc] = sq; if (u.pn >= 1) pkv[(size_t)t * 8 + (u.pn - 1) * 4 + wc] = sk; }
                asm volatile("" ::: "memory"); }
    }
};
__device__ __forceinline__ float row_rms_scale(const float* part, int t, float inv_n, float eps) {
    const f32x4 a = *(const f32x4*)(part + (size_t)t * 8), b = *(const f32x4*)(part + (size_t)t * 8 + 4);
    const float s = ((a[0] + a[1]) + (a[2] + a[3])) + ((b[0] + b[1]) + (b[2] + b[3]));
    return 1.0f / sqrtf(s * inv_n + eps);
}
struct EpiQNope {
    static constexpr bool PERM = true; f16* Q; const float* pq;
    __device__ __forceinline__ void operator()(const f32x4 (&acc)[2][2][4][2], const pg8::Unit& u, int wr, int wc, int fr, int fq) const {
#pragma unroll
        for (int ai = 0; ai < 2; ++ai)
#pragma unroll
            for (int m = 0; m < 4; ++m) { const int t = EPI_ROW(u, ai, m); const float rs = row_rms_scale(pq, t, 1.0f / 384.0f, LAT_EPS);
#pragma unroll
                for (int bj = 0; bj < 2; ++bj) { const int c8 = u.pn * 256 + bj * 128 + wc * 32 + 8 * fq;
                    *(h8*)(Q + (size_t)t * 1536 + (c8 >> 7) * 192 + (c8 & 127)) = pack8(acc[ai][bj][m][0] * rs, acc[ai][bj][m][1] * rs); }
                asm volatile("" ::: "memory"); }
    }
};
struct EpiQRope {
    static constexpr bool PERM = true; f16* Q; const float* cosm; const float* sinm; const float* pq;
    __device__ __forceinline__ void operator()(const f32x4 (&acc)[2][2][4][2], const pg8::Unit& u, int wr, int wc, int fr, int fq) const {
#pragma unroll
        for (int ai = 0; ai < 2; ++ai)
#pragma unroll
            for (int m = 0; m < 4; ++m) { const int t = EPI_ROW(u, ai, m); const float rs = row_rms_scale(pq, t, 1.0f / 384.0f, LAT_EPS);
#pragma unroll
                for (int bj = 0; bj < 2; ++bj) { const int cc = u.pn * 256 + bj * 128 + wc * 32 + 8 * fq; const int h = cc >> 6, jj = cc & 63, i0 = jj >> 1;
                    f32x4 v0 = acc[ai][bj][m][0] * rs, v1 = acc[ai][bj][m][1] * rs;
                    const f32x4 cs = *(const f32x4*)(cosm + (size_t)t * 32 + i0), sn = *(const f32x4*)(sinm + (size_t)t * 32 + i0); rope4(v0, v1, cs, sn);
                    *(h8*)(Q + (size_t)t * 1536 + h * 192 + 128 + jj) = pack8(v0, v1); }
                asm volatile("" ::: "memory"); }
    }
};
struct EpiKV {
    static constexpr bool PERM = true; f16* Kp; f16* Vp; const float* pkv;
    __device__ __forceinline__ void operator()(const f32x4 (&acc)[2][2][4][2], const pg8::Unit& u, int wr, int wc, int fr, int fq) const {
#pragma unroll
        for (int ai = 0; ai < 2; ++ai)
#pragma unroll
            for (int m = 0; m < 4; ++m) { const int t = EPI_ROW(u, ai, m); const float rs = row_rms_scale(pkv, t, 1.0f / 256.0f, LAT_EPS);
#pragma unroll
                for (int bj = 0; bj < 2; ++bj) { const int c8 = u.pn * 256 + bj * 128 + wc * 32 + 8 * fq; const int h = c8 >> 8, j = c8 & 255;
                    f16* dst = (j < 128) ? (Kp + (size_t)t * 1536 + h * 192 + j) : (Vp + (size_t)t * 1024 + h * 128 + (j - 128));
                    *(h8*)dst = pack8(acc[ai][bj][m][0] * rs, acc[ai][bj][m][1] * rs); }
                asm volatile("" ::: "memory"); }
    }
};
template <bool XF16> struct EpiPre {
    static constexpr bool PERM = true; const void* xres; const float* gmod; f16* pre;
    __device__ __forceinline__ void operator()(const f32x4 (&acc)[2][2][4][2], const pg8::Unit& u, int wr, int wc, int fr, int fq) const {
#pragma unroll
        for (int ai = 0; ai < 2; ++ai)
#pragma unroll
            for (int m = 0; m < 4; ++m) { const int t = EPI_ROW(u, ai, m); const int b = t >> 12;
#pragma unroll
                for (int bj = 0; bj < 2; ++bj) { const int c8 = u.pn * 256 + bj * 128 + wc * 32 + 8 * fq;
                    const f32x4 g0 = *(const f32x4*)(gmod + b * 6144 + c8), g1 = *(const f32x4*)(gmod + b * 6144 + c8 + 4); f32x4 x0, x1;
                    if constexpr (XF16) { const h8 xv = *(const h8*)((const f16*)xres + (size_t)t * 1024 + c8);
                        x0 = (f32x4){(float)xv[0], (float)xv[1], (float)xv[2], (float)xv[3]}; x1 = (f32x4){(float)xv[4], (float)xv[5], (float)xv[6], (float)xv[7]}; }
                    else { x0 = *(const f32x4*)((const float*)xres + (size_t)t * 1024 + c8); x1 = *(const f32x4*)((const float*)xres + (size_t)t * 1024 + c8 + 4); }
                    *(h8*)(pre + (size_t)t * 1024 + c8) = pack8(x0 * ALPHA + (g0 + 1.0f) * acc[ai][bj][m][0], x1 * ALPHA + (g1 + 1.0f) * acc[ai][bj][m][1]); }
                asm volatile("" ::: "memory"); }
    }
};
struct EpiUp {
    static constexpr bool PERM = true; f16* act;
    __device__ __forceinline__ void operator()(const f32x4 (&acc)[2][2][4][2], const pg8::Unit& u, int wr, int wc, int fr, int fq) const {
#pragma unroll
        for (int ai = 0; ai < 2; ++ai)
#pragma unroll
            for (int m = 0; m < 4; ++m) { const int r = EPI_ROW(u, ai, m);
#pragma unroll
                for (int bj = 0; bj < 2; ++bj) { const int c8 = u.pn * 256 + bj * 128 + wc * 32 + 8 * fq;
                    const f32x4 gq = acc[ai][bj][m][0], uq = acc[ai][bj][m][1]; h4 o;
#pragma unroll
                    for (int i = 0; i < 4; ++i) { const float gg = gq[i]; o[i] = (f16)(gg * __builtin_amdgcn_rcpf(1.0f + __expf(-gg)) * uq[i]); }
                    *(h4*)(act + (size_t)r * 2048 + (c8 >> 1)) = o; } }
    }
};
struct EpiDown {
    static constexpr bool PERM = true; f16* y; const float* gate;
    __device__ __forceinline__ void operator()(const f32x4 (&acc)[2][2][4][2], const pg8::Unit& u, int wr, int wc, int fr, int fq) const {
#pragma unroll
        for (int ai = 0; ai < 2; ++ai)
#pragma unroll
            for (int m = 0; m < 4; ++m) { const int r = EPI_ROW(u, ai, m); const float gt = gate[r];
#pragma unroll
                for (int bj = 0; bj < 2; ++bj) { const int c8 = u.pn * 256 + bj * 128 + wc * 32 + 8 * fq;
                    *(h8*)(y + (size_t)r * 1024 + c8) = pack8(acc[ai][bj][m][0] * gt, acc[ai][bj][m][1] * gt); }
                asm volatile("" ::: "memory"); }
    }
};
struct EpiDiffIn {
    static constexpr bool PERM = true; f16* qkv; const float* cosd; const float* sind;
    __device__ __forceinline__ void operator()(const f32x4 (&acc)[2][2][4][2], const pg8::Unit& u, int wr, int wc, int fr, int fq) const {
#pragma unroll
        for (int ai = 0; ai < 2; ++ai)
#pragma unroll
            for (int m = 0; m < 4; ++m) { const int t = EPI_ROW(u, ai, m);
#pragma unroll
                for (int bj = 0; bj < 2; ++bj) { const int c8 = u.pn * 256 + bj * 128 + wc * 32 + 8 * fq;
                    f32x4 v0 = acc[ai][bj][m][0], v1 = acc[ai][bj][m][1];
                    if (c8 < 2048 && (c8 & 63) < 16) { const int i0 = (c8 & 15) >> 1; const f32x4 cs = *(const f32x4*)(cosd + (size_t)t * 8 + i0), sn = *(const f32x4*)(sind + (size_t)t * 8 + i0); rope4(v0, v1, cs, sn); }
                    *(h8*)(qkv + (size_t)t * 3072 + c8) = pack8(v0, v1); }
                asm volatile("" ::: "memory"); }
    }
};

namespace att {
constexpr int QBLK = 32, KVBLK = 64, DV = 128;
constexpr float THR = 8.f;
constexpr size_t SHM_V = KVBLK * DV * 2;
#define SBAR() __builtin_amdgcn_sched_barrier(0)
__device__ __forceinline__ int crow(int r, int hi) { return (r & 3) + 8 * (r >> 2) + 4 * hi; }
__device__ __forceinline__ unsigned cvtpk(float lo, float hi) { unsigned r; asm volatile("v_cvt_pk_f16_f32 %0, %1, %2" : "=v"(r) : "v"(lo), "v"(hi)); return r; }
template <int DQK> struct Cfg {
    static constexpr int ND0 = DQK / 16, KRB = DQK * 2, NKCH = DQK / 64, KCPR = DQK / 8;
    static constexpr size_t SHM_K = (size_t)KVBLK * KRB;
    static constexpr float SCALE = DQK == 192 ? 0.07216878364870322f : 0.125f;
    static constexpr size_t SHM_TOTAL = 2 * SHM_V + 2 * SHM_K + NWAVES * 64 * 4;
};
template <int DQK> __device__ __forceinline__ void partialSM(f32x16& p0, f32x16& p1, float& m_reg, float& mn, float& alpha) {
    constexpr float SCALE = Cfg<DQK>::SCALE, C = SCALE * 1.4426950408889634f;
    float pmax = p0[0];
#pragma unroll
    for (int r = 1; r < 16; ++r) pmax = fmaxf(pmax, p0[r]);
#pragma unroll
    for (int r = 0; r < 16; ++r) pmax = fmaxf(pmax, p1[r]);
    { auto rr = __builtin_amdgcn_permlane32_swap(__float_as_uint(pmax), __float_as_uint(pmax), false, false);
      pmax = fmaxf(__uint_as_float(rr[0]), __uint_as_float(rr[1])); }
    if (__builtin_expect(__all(pmax - m_reg <= THR / SCALE), 1)) { mn = m_reg; alpha = 1.f; }
    else { mn = fmaxf(m_reg, pmax); alpha = __builtin_amdgcn_exp2f((m_reg - mn) * C); m_reg = mn; }
    const float mnC = -mn * C;
#pragma unroll
    for (int r = 0; r < 16; ++r) p0[r] = fmaf(p0[r], C, mnC);
#pragma unroll
    for (int r = 0; r < 16; ++r) p1[r] = fmaf(p1[r], C, mnC);
#pragma unroll
    for (int r = 0; r < 16; ++r) p0[r] = __builtin_amdgcn_exp2f(p0[r]);
}
__device__ __forceinline__ void finishSM(f32x16& p0, f32x16& p1, float alpha, float& l_reg, h8& pa0, h8& pa1, h8& pa2, h8& pa3) {
#pragma unroll
    for (int r = 0; r < 16; ++r) p1[r] = __builtin_amdgcn_exp2f(p1[r]);
    float ps = 0;
#pragma unroll
    for (int r = 0; r < 16; ++r) ps += p0[r];
#pragma unroll
    for (int r = 0; r < 16; ++r) ps += p1[r];
    { auto rr = __builtin_amdgcn_permlane32_swap(__float_as_uint(ps), __float_as_uint(ps), false, false);
      ps = __uint_as_float(rr[0]) + __uint_as_float(rr[1]); }
    l_reg = l_reg * alpha + ps;
#define PK4(P, BASE, OUT) do { unsigned a0 = cvtpk(P[BASE + 0], P[BASE + 1]), a1 = cvtpk(P[BASE + 2], P[BASE + 3]);   \
    unsigned b0 = cvtpk(P[BASE + 4], P[BASE + 5]), b1 = cvtpk(P[BASE + 6], P[BASE + 7]);                              \
    auto r0 = __builtin_amdgcn_permlane32_swap(a0, b0, false, false); auto r1 = __builtin_amdgcn_permlane32_swap(a1, b1, false, false); \
    u32x4 w = {r0[0], r1[0], r0[1], r1[1]}; OUT = *reinterpret_cast<h8*>(&w); } while (0)
    PK4(p0, 0, pa0); PK4(p0, 8, pa1); PK4(p1, 0, pa2); PK4(p1, 8, pa3);
#undef PK4
}
#define KSWZ(row, colB) ((row) * KRB + ((colB) ^ (((row) & 7) << 4)))
template <int DQK> __device__ __forceinline__ void qkt(f32x16& p0, f32x16& p1, const char* Ks, const h8* qr, int r32, int hi) {
    constexpr int KRB = Cfg<DQK>::KRB;
    p0 = f32x16{}; p1 = f32x16{};
#pragma unroll
    for (int d0 = 0; d0 < Cfg<DQK>::ND0; ++d0) { const int cb = (d0 * 16 + hi * 8) * 2;
        const h8 b0 = *reinterpret_cast<const h8*>(Ks + KSWZ(r32, cb));
        const h8 b1 = *reinterpret_cast<const h8*>(Ks + KSWZ(32 + r32, cb));
        p0 = __builtin_amdgcn_mfma_f32_32x32x16_f16(b0, qr[d0], p0, 0, 0, 0);
        p1 = __builtin_amdgcn_mfma_f32_32x32x16_f16(b1, qr[d0], p1, 0, 0, 0); }
}
template <int OFF> __device__ __forceinline__ h8 lds_read128(int addr) { h8 r; asm volatile("ds_read_b128 %0, %1 offset:%2" : "=&v"(r) : "v"(addr), "i"(OFF) : "memory"); return r; }
template <int N> __device__ __forceinline__ void lgkm_wait() { asm volatile("s_waitcnt lgkmcnt(%0)" :: "i"(N) : "memory"); }
template <int DQK, int W, int I> struct QkStep {
    static constexpr int NF = 2 * Cfg<DQK>::ND0, KRB = Cfg<DQK>::KRB;
    static constexpr int koff(int i) { return ((i >> 1) >> 2) * 128 + (i & 1) * 32 * KRB; }
    static __device__ __forceinline__ void issue(h8 (&kf)[W], const int (&ka)[4]) { if constexpr (I < NF) kf[I % W] = lds_read128<koff(I)>(ka[(I >> 1) & 3]); }
    static __device__ __forceinline__ void run(h8 (&kf)[W], f32x16& p0, f32x16& p1, const h8* qr, const int (&ka)[4]) {
        if constexpr (I < NF) {
            constexpr int OUT = (NF - 1 - I) < (W - 1) ? (NF - 1 - I) : (W - 1);
            lgkm_wait<OUT>(); SBAR();
            if constexpr ((I & 1) == 0) p0 = __builtin_amdgcn_mfma_f32_32x32x16_f16(kf[I % W], qr[I >> 1], p0, 0, 0, 0);
            else p1 = __builtin_amdgcn_mfma_f32_32x32x16_f16(kf[I % W], qr[I >> 1], p1, 0, 0, 0);
            SBAR();
            QkStep<DQK, W, I + W>::issue(kf, ka);
            QkStep<DQK, W, I + 1>::run(kf, p0, p1, qr, ka);
        }
    }
};
template <int DQK, int W, int I> struct QkPrime { static __device__ __forceinline__ void run(h8 (&kf)[W], const int (&ka)[4]) { if constexpr (I < W && I < 2 * Cfg<DQK>::ND0) { QkStep<DQK, W, I>::issue(kf, ka); QkPrime<DQK, W, I + 1>::run(kf, ka); } } };
template <int DQK, int W> __device__ __forceinline__ void qkt_pipe(f32x16& p0, f32x16& p1, int kbase, const h8* qr, int r32, int hi) {
    constexpr int KRB = Cfg<DQK>::KRB;
    int ka[4];
#pragma unroll
    for (int q = 0; q < 4; ++q) ka[q] = kbase + r32 * KRB + ((q * 32 + hi * 16) ^ ((r32 & 7) << 4));
    p0 = f32x16{}; p1 = f32x16{};
    h8 kf[W];
    QkPrime<DQK, W, 0>::run(kf, ka);
    QkStep<DQK, W, 0>::run(kf, p0, p1, qr, ka);
}
__device__ __forceinline__ int v_st(int k, int c) { const int kk = (k & ~0xC) | ((k & 4) << 1) | ((k & 8) >> 1); return ((kk >> 3) * 4 + (c >> 5)) * 512 + ((kk & 7) * 32 + (c & 31)) * 2; }
__device__ __forceinline__ int v_rd_base(int lane) { return ((lane & 3) << 3) | (((lane >> 2) & 3) << 6) | (((lane >> 4) & 1) << 5) | (((lane >> 5) & 1) << 8); }
constexpr int v_rd_off(int d0, int ks, int half) { return d0 * 512 + ks * 4096 + half * 2048; }
template <int OFF> __device__ __forceinline__ s16x4 tr_read(int vb) {
    s16x4 r; asm volatile("ds_read_b64_tr_b16 %0, %1 offset:%2" : "=&v"(r) : "v"(vb), "i"(OFF) : "memory"); return r;
}
template <int D0> __device__ __forceinline__ void pv_one(f32x16& od, int vb, h8 pa0, h8 pa1, h8 pa2, h8 pa3) {
    const s16x4 l0 = tr_read<v_rd_off(D0, 0, 0)>(vb), h0 = tr_read<v_rd_off(D0, 0, 1)>(vb), l1 = tr_read<v_rd_off(D0, 1, 0)>(vb), h1 = tr_read<v_rd_off(D0, 1, 1)>(vb);
    const s16x4 l2 = tr_read<v_rd_off(D0, 2, 0)>(vb), h2_ = tr_read<v_rd_off(D0, 2, 1)>(vb), l3 = tr_read<v_rd_off(D0, 3, 0)>(vb), h3 = tr_read<v_rd_off(D0, 3, 1)>(vb);
    asm volatile("s_waitcnt lgkmcnt(0)" ::: "memory"); SBAR();
#define PKV(L, H) __builtin_bit_cast(h8, (__attribute__((ext_vector_type(8))) short){L[0], L[1], L[2], L[3], H[0], H[1], H[2], H[3]})
    od = __builtin_amdgcn_mfma_f32_32x32x16_f16(pa0, PKV(l0, h0), od, 0, 0, 0);
    od = __builtin_amdgcn_mfma_f32_32x32x16_f16(pa1, PKV(l1, h1), od, 0, 0, 0);
    od = __builtin_amdgcn_mfma_f32_32x32x16_f16(pa2, PKV(l2, h2_), od, 0, 0, 0);
    od = __builtin_amdgcn_mfma_f32_32x32x16_f16(pa3, PKV(l3, h3), od, 0, 0, 0);
#undef PKV
}
struct VFrag { s16x4 l0, h0, l1, h1, l2, h2, l3, h3; };
template <int D0> __device__ __forceinline__ void v_read8(VFrag& f, int vb) {
    f.l0 = tr_read<v_rd_off(D0, 0, 0)>(vb); f.h0 = tr_read<v_rd_off(D0, 0, 1)>(vb); f.l1 = tr_read<v_rd_off(D0, 1, 0)>(vb); f.h1 = tr_read<v_rd_off(D0, 1, 1)>(vb);
    f.l2 = tr_read<v_rd_off(D0, 2, 0)>(vb); f.h2 = tr_read<v_rd_off(D0, 2, 1)>(vb); f.l3 = tr_read<v_rd_off(D0, 3, 0)>(vb); f.h3 = tr_read<v_rd_off(D0, 3, 1)>(vb);
}
__device__ __forceinline__ void pv_mma4(f32x16& od, const VFrag& f, h8 pa0, h8 pa1, h8 pa2, h8 pa3) {
#define PKV(L, H) __builtin_bit_cast(h8, (__attribute__((ext_vector_type(8))) short){L[0], L[1], L[2], L[3], H[0], H[1], H[2], H[3]})
    od = __builtin_amdgcn_mfma_f32_32x32x16_f16(pa0, PKV(f.l0, f.h0), od, 0, 0, 0);
    od = __builtin_amdgcn_mfma_f32_32x32x16_f16(pa1, PKV(f.l1, f.h1), od, 0, 0, 0);
    od = __builtin_amdgcn_mfma_f32_32x32x16_f16(pa2, PKV(f.l2, f.h2), od, 0, 0, 0);
    od = __builtin_amdgcn_mfma_f32_32x32x16_f16(pa3, PKV(f.l3, f.h3), od, 0, 0, 0);
#undef PKV
}
__device__ __forceinline__ void pv_d0(f32x16* o, int vb, h8 pa0, h8 pa1, h8 pa2, h8 pa3) {
    VFrag A, B;
    v_read8<0>(A, vb); v_read8<1>(B, vb);
    asm volatile("s_waitcnt lgkmcnt(8)" ::: "memory"); SBAR(); pv_mma4(o[0], A, pa0, pa1, pa2, pa3); SBAR();
    v_read8<2>(A, vb);
    asm volatile("s_waitcnt lgkmcnt(8)" ::: "memory"); SBAR(); pv_mma4(o[1], B, pa0, pa1, pa2, pa3); SBAR();
    v_read8<3>(B, vb);
    asm volatile("s_waitcnt lgkmcnt(8)" ::: "memory"); SBAR(); pv_mma4(o[2], A, pa0, pa1, pa2, pa3); SBAR();
    asm volatile("s_waitcnt lgkmcnt(0)" ::: "memory"); SBAR(); pv_mma4(o[3], B, pa0, pa1, pa2, pa3);
}
template <int LDO>
__device__ __forceinline__ void attn_epilogue(f32x16 (&o)[4], const float (&rli)[16], f16* Ow, int mode, float lam, const float* subln, int r32, int hi) {
    if (mode == 0) {
#pragma unroll
        for (int r = 0; r < 16; ++r) { const int orow = crow(r, hi);
#pragma unroll
            for (int d0 = 0; d0 < 4; ++d0) Ow[(long)orow * LDO + d0 * 32 + r32] = (f16)(o[d0][r] * rli[r]); }
    } else {
        float sl[4];
#pragma unroll
        for (int d0 = 0; d0 < 4; ++d0) sl[d0] = subln[d0 * 32 + r32] * (1.0f - LAMBDA_INIT);
        f16 t0[4][16];
#pragma unroll
        for (int r = 0; r < 16; ++r) { const int orow = crow(r, hi);
#pragma unroll
            for (int d0 = 0; d0 < 4; ++d0) t0[d0][r] = Ow[(long)orow * LDO + d0 * 32 + r32]; }
        asm volatile("s_waitcnt vmcnt(0)" ::: "memory");
#pragma unroll
        for (int r = 0; r < 16; ++r) { const int orow = crow(r, hi); float ss = 0.f;
#pragma unroll
            for (int d0 = 0; d0 < 4; ++d0) { const float x = (float)t0[d0][r] - lam * (o[d0][r] * rli[r]); o[d0][r] = x; ss += x * x; }
            ss += __shfl_xor(ss, 1); ss += __shfl_xor(ss, 2); ss += __shfl_xor(ss, 4); ss += __shfl_xor(ss, 8); ss += __shfl_xor(ss, 16);
            const float rs = 1.0f / sqrtf(ss * (1.0f / 128.0f) + LN_EPS);
#pragma unroll
            for (int d0 = 0; d0 < 4; ++d0) Ow[(long)orow * LDO + d0 * 32 + r32] = (f16)(o[d0][r] * rs * sl[d0]); }
    }
}
template <int DQK, int LDQ, int LDK, int LDV, int LDO, int SDEPTH>
__device__ __forceinline__ void attn_body(const f16* Qb, const f16* Kh, const f16* Vh, f16* Ob, char* lds, int mode = 0, float lam = 0.f, const float* subln = nullptr) {
    using C = Cfg<DQK>;
    constexpr int KRB = C::KRB, ND0 = C::ND0, NKCH = C::NKCH, KCPR = C::KCPR; constexpr size_t SHM_K = C::SHM_K;
    constexpr int seq = SEQ;
    int tid = threadIdx.x; asm volatile("" : "+v"(tid));
    const int wid = tid >> 6, lane = tid & 63, r32 = lane & 31, hi = lane >> 5;
    char* V_lds = lds; char* K_lds = lds + 2 * SHM_V;
    float* wsl = (float*)(lds + 2 * SHM_V + 2 * SHM_K) + wid * 64; float* li_l = wsl; float* al_l = wsl + 32;
    float m_reg = -1e30f, l_reg = 0; f32x16 o[4] = {}; h8 qr[ND0];
    const f16* Qw = Qb + (long)(wid * QBLK + r32) * LDQ + hi * 8;
#pragma unroll
    for (int d0 = 0; d0 < ND0; ++d0) qr[d0] = *reinterpret_cast<const h8*>(Qw + d0 * 16);
    const int sr = tid >> 4, sc = (tid & 15) * 8, vst0 = v_st(sr, sc), vst1 = v_st(32 + sr, sc);
    int krow[NKCH], kcb[NKCH];
#pragma unroll
    for (int i = 0; i < NKCH; ++i) { const int c = tid + i * 512; krow[i] = c / KCPR; kcb[i] = (c % KCPR) * 16; }
    const int vb0 = (int)(uintptr_t)V_lds + v_rd_base(lane);
    struct { h8 vs0, vs1; h8 ks[NKCH]; } sr_[SDEPTH];
#define SLOAD(i, k0) do { sr_[i].vs0 = *reinterpret_cast<const h8*>(&Vh[(long)((k0) + sr) * LDV + sc]); sr_[i].vs1 = *reinterpret_cast<const h8*>(&Vh[(long)((k0) + 32 + sr) * LDV + sc]); \
    _Pragma("unroll") for (int _c = 0; _c < NKCH; ++_c) sr_[i].ks[_c] = *reinterpret_cast<const h8*>((const char*)Kh + (long)((k0) + krow[_c]) * (LDK * 2) + kcb[_c]); } while (0)
#define SWRITE(b, i) do { *(h8*)(V_lds + (b) * SHM_V + vst0) = sr_[i].vs0; *(h8*)(V_lds + (b) * SHM_V + vst1) = sr_[i].vs1; \
    _Pragma("unroll") for (int _c = 0; _c < NKCH; ++_c) *(h8*)(K_lds + (b) * SHM_K + KSWZ(krow[_c], kcb[_c])) = sr_[i].ks[_c]; } while (0)
#define SWAIT() do { if constexpr (SDEPTH == 2) { if constexpr (NKCH == 3) asm volatile("s_waitcnt vmcnt(5)" ::: "memory"); else asm volatile("s_waitcnt vmcnt(3)" ::: "memory"); } \
    else asm volatile("s_waitcnt vmcnt(0)" ::: "memory"); } while (0)
#define RESC(a) do { if (__any((a) < 1.f)) { if (hi == 0) al_l[r32] = (a); asm volatile("s_waitcnt lgkmcnt(0)" ::: "memory"); \
    _Pragma("unroll") for (int d = 0; d < 4; ++d) _Pragma("unroll") for (int r = 0; r < 16; ++r) o[d][r] *= al_l[crow(r, hi)]; } } while (0)
    f32x16 pA0, pA1, pB0, pB1; float mnA, mnB, alA, alB; h8 pa0, pa1, pa2, pa3; constexpr int NT = seq / KVBLK;
    constexpr int SE = 0, SO = SDEPTH - 1;
    SLOAD(SE, 0); asm volatile("s_waitcnt vmcnt(0)" ::: "memory"); SWRITE(0, SE); __syncthreads();
    qkt<DQK>(pA0, pA1, K_lds, qr, r32, hi); partialSM<DQK>(pA0, pA1, m_reg, mnA, alA);
    SLOAD(SO, KVBLK); if constexpr (SDEPTH == 2) { if (2 < NT) SLOAD(SE, 2 * KVBLK); }
    SWAIT(); SWRITE(1, SO); __syncthreads();
    for (int j = 1; j + 1 < NT; j += 2) {
        SBAR(); qkt<DQK>(pB0, pB1, K_lds + SHM_K, qr, r32, hi);
        finishSM(pA0, pA1, alA, l_reg, pa0, pa1, pa2, pa3); SBAR();
        SLOAD(SO, (j + SDEPTH) * KVBLK); SBAR();
        pv_d0(o, vb0, pa0, pa1, pa2, pa3); partialSM<DQK>(pB0, pB1, m_reg, mnB, alB);
        __syncthreads(); SWAIT(); SWRITE(0, SE);
        RESC(alB); __syncthreads();
        SBAR(); qkt<DQK>(pA0, pA1, K_lds, qr, r32, hi);
        finishSM(pB0, pB1, alB, l_reg, pa0, pa1, pa2, pa3); SBAR();
        if (SDEPTH == 1 || j + 3 < NT) SLOAD(SE, (j + 1 + SDEPTH) * KVBLK); SBAR();
        pv_d0(o, vb0 + (int)SHM_V, pa0, pa1, pa2, pa3); partialSM<DQK>(pA0, pA1, m_reg, mnA, alA);
        __syncthreads(); SWAIT(); SWRITE(1, SO);
        RESC(alA); __syncthreads();
    }
    SBAR(); qkt<DQK>(pB0, pB1, K_lds + SHM_K, qr, r32, hi);
    finishSM(pA0, pA1, alA, l_reg, pa0, pa1, pa2, pa3); SBAR();
    pv_d0(o, vb0, pa0, pa1, pa2, pa3); partialSM<DQK>(pB0, pB1, m_reg, mnB, alB);
    __syncthreads(); RESC(alB);
    finishSM(pB0, pB1, alB, l_reg, pa0, pa1, pa2, pa3); SBAR();
    pv_d0(o, vb0 + (int)SHM_V, pa0, pa1, pa2, pa3);
    if (hi == 0) li_l[r32] = l_reg; asm volatile("s_waitcnt lgkmcnt(0)" ::: "memory");
    float rli[16];
#pragma unroll
    for (int r = 0; r < 16; ++r) rli[r] = __builtin_amdgcn_rcpf(li_l[crow(r, hi)]);
    attn_epilogue<LDO>(o, rli, Ob + (long)(wid * QBLK) * LDO, mode, lam, subln, r32, hi);
    asm volatile("s_waitcnt vmcnt(0) lgkmcnt(0)" ::: "memory");
    __syncthreads();
#undef SLOAD
#undef SWRITE
#undef SWAIT
#undef RESC
}

struct ConvStream {
    const float* win; const float* wout; f16* tin; f16* tout;
    int step, step_end, it, period;
    unsigned d[8]; f16* pend;
    char* acc; f16* dst0; int nacc;
};
constexpr int CONV_STEPS_IN = 16 * 64 * 128, CONV_STEPS_OUT = 16 * 16 * 256, CONV_STEPS = CONV_STEPS_IN + CONV_STEPS_OUT;
__device__ __forceinline__ void conv_drain(ConvStream& c, int lane) {
    if (c.nacc > 0) {
        asm volatile("s_waitcnt lgkmcnt(0)" ::: "memory");
        for (int q = 0; q < c.nacc; ++q) { const h8 v = *(const h8*)(c.acc + q * 1024 + lane * 16); *(h8*)(c.dst0 + q * 8) = v; }
        c.nacc = 0; }
}
__device__ __forceinline__ void conv_flush(ConvStream& c, int lane) {
    if (c.pend) { h8 o;
#pragma unroll
        for (int i = 0; i < 8; ++i) o[i] = (f16)__uint_as_float(c.d[i]);
        if (c.nacc == 0) c.dst0 = c.pend;
        *(h8*)(c.acc + c.nacc * 1024 + lane * 16) = o; ++c.nacc; c.pend = nullptr;
        if (c.nacc == 4) conv_drain(c, lane); }
}
__device__ __forceinline__ void conv_tick(ConvStream& c, int lane) {
    const bool go = ((c.it & (c.period - 1)) < 3) && (c.step < c.step_end); ++c.it;
    if (go) { const int s = c.step++;
        const float* src; f16* dst; int N;
        if (s < CONV_STEPS_IN) { const int strip = s >> 7, kb = s & 127, e = strip >> 6, n = (strip & 63) * 64 + lane; const int f = n & 2047, dr = (f >> 2) * 8 + (f & 3) + ((n >> 11) << 2);
            src = c.win + ((size_t)e * 1024 + kb * 8) * 4096 + n; dst = c.tin + ((size_t)e * 4096 + dr) * 1024 + kb * 8; N = 4096; }
        else { const int s2 = s - CONV_STEPS_IN; const int strip = s2 >> 8, kb = s2 & 255, e = strip >> 4, n = (strip & 15) * 64 + lane;
            src = c.wout + ((size_t)e * 2048 + kb * 8) * 1024 + n; dst = c.tout + ((size_t)e * 1024 + n) * 2048 + kb * 8; N = 1024; }
        if ((s & 3) == 0) conv_drain(c, lane);
#pragma unroll
        for (int i = 0; i < 8; ++i) c.d[i] = __float_as_uint(src[(size_t)i * N]);
        c.pend = dst; }
}
__device__ __forceinline__ void conv_init(ConvStream& cs, const float* win, const float* wout, f16* tin, f16* tout, int l, int gw, int NGW, int period, char* acc) {
    cs.acc = acc; cs.nacc = 0; cs.dst0 = nullptr;
    cs.win = win + (size_t)l * NE * 1024 * 4096; cs.wout = wout + (size_t)l * NE * 2048 * 1024; cs.tin = tin + (size_t)l * NE * 4096 * 1024; cs.tout = tout + (size_t)l * NE * 1024 * 2048;
    const int per = ((CONV_STEPS + NGW - 1) / NGW + 7) & ~7;
    cs.step = gw * per < CONV_STEPS ? gw * per : CONV_STEPS; cs.step_end = (gw + 1) * per < CONV_STEPS ? (gw + 1) * per : CONV_STEPS; cs.it = 0; cs.pend = nullptr; cs.period = period;
}
template <int DQK, int LDQ, int LDK, int LDV, int LDO, bool CONV = false>
__device__ __forceinline__ void attn_body_simple(const f16* Qb, const f16* Kh, const f16* Vh, f16* Ob, char* lds, int mode = 0, float lam = 0.f, const float* subln = nullptr, ConvStream* cs = nullptr) {
    using C = Cfg<DQK>;
    constexpr int KRB = C::KRB, ND0 = C::ND0, NKCH = C::NKCH, KCPR = C::KCPR; constexpr size_t SHM_K = C::SHM_K;
    int tid = threadIdx.x; asm volatile("" : "+v"(tid));
    const int wid = tid >> 6, lane = tid & 63, r32 = lane & 31, hi = lane >> 5;
    char* V_lds = lds; char* K_lds = lds + 2 * SHM_V;
    float* wsl = (float*)(lds + 2 * SHM_V + 2 * SHM_K) + wid * 64; float* li_l = wsl; float* al_l = wsl + 32;
    float m_reg = -1e30f, l_reg = 0; f32x16 o[4] = {}; h8 qr[ND0];
    const f16* Qw = Qb + (long)(wid * QBLK + r32) * LDQ + hi * 8;
#pragma unroll
    for (int d0 = 0; d0 < ND0; ++d0) qr[d0] = *reinterpret_cast<const h8*>(Qw + d0 * 16);
    const int sr = tid >> 4, sc = (tid & 15) * 8, vst0 = v_st(sr, sc), vst1 = v_st(32 + sr, sc);
    int krow[NKCH], kcb[NKCH];
#pragma unroll
    for (int i = 0; i < NKCH; ++i) { const int c = tid + i * 512; krow[i] = c / KCPR; kcb[i] = (c % KCPR) * 16; }
    const int vb0 = (int)(uintptr_t)V_lds + v_rd_base(lane);
    h8 vs0, vs1, ks[NKCH];
#define SLOAD1(k0) do { vs0 = *reinterpret_cast<const h8*>(&Vh[(long)((k0) + sr) * LDV + sc]); vs1 = *reinterpret_cast<const h8*>(&Vh[(long)((k0) + 32 + sr) * LDV + sc]); \
    _Pragma("unroll") for (int _c = 0; _c < NKCH; ++_c) ks[_c] = *reinterpret_cast<const h8*>((const char*)Kh + (long)((k0) + krow[_c]) * (LDK * 2) + kcb[_c]); } while (0)
#define SWRITE1(b) do { *(h8*)(V_lds + (b) * SHM_V + vst0) = vs0; *(h8*)(V_lds + (b) * SHM_V + vst1) = vs1; \
    _Pragma("unroll") for (int _c = 0; _c < NKCH; ++_c) *(h8*)(K_lds + (b) * SHM_K + KSWZ(krow[_c], kcb[_c])) = ks[_c]; } while (0)
    constexpr int NT = SEQ / KVBLK;
    SLOAD1(0); asm volatile("s_waitcnt vmcnt(0)" ::: "memory"); SWRITE1(0); __syncthreads();
#pragma unroll 1
    for (int j = 0; j < NT; ++j) {
        const int cb = j & 1;
        if constexpr (CONV) conv_tick(*cs, lane);
        if (j + 1 < NT) SLOAD1((j + 1) * KVBLK);
        SBAR();
        f32x16 p0, p1; float mn, al; h8 pa0, pa1, pa2, pa3;
        qkt_pipe<DQK, (DQK == 192 ? 6 : 8)>(p0, p1, (int)(uintptr_t)K_lds + cb * (int)SHM_K, qr, r32, hi);
        partialSM<DQK>(p0, p1, m_reg, mn, al);
        if (__any(al < 1.f)) { if (hi == 0) al_l[r32] = al; asm volatile("s_waitcnt lgkmcnt(0)" ::: "memory");
#pragma unroll
            for (int d = 0; d < 4; ++d)
#pragma unroll
                for (int r = 0; r < 16; ++r) o[d][r] *= al_l[crow(r, hi)]; }
        finishSM(p0, p1, al, l_reg, pa0, pa1, pa2, pa3); SBAR();
        pv_d0(o, vb0 + cb * (int)SHM_V, pa0, pa1, pa2, pa3);
        if (j + 1 < NT) { SWRITE1(cb ^ 1); }
        if constexpr (CONV) conv_flush(*cs, lane);
        __syncthreads();
    }
    if (hi == 0) li_l[r32] = l_reg; asm volatile("s_waitcnt lgkmcnt(0)" ::: "memory");
    float rli[16];
#pragma unroll
    for (int r = 0; r < 16; ++r) rli[r] = __builtin_amdgcn_rcpf(li_l[crow(r, hi)]);
    attn_epilogue<LDO>(o, rli, Ob + (long)(wid * QBLK) * LDO, mode, lam, subln, r32, hi);
    asm volatile("s_waitcnt vmcnt(0) lgkmcnt(0)" ::: "memory");
    __syncthreads();
#undef SLOAD1
#undef SWRITE1
}
#undef KSWZ
#undef SBAR
}

struct Args { const void* in[22]; float* out; unsigned char* ws; int ph_lo, ph_hi, li, pad; };
typedef const __attribute__((address_space(4))) Args* KArgs;
__device__ __forceinline__ KArgs kargs() { KArgs p = (KArgs)__builtin_amdgcn_kernarg_segment_ptr(); asm volatile("" : "+s"(p)); return p; }
struct Frame {
    LAS unsigned char* lds; char* ldsg;
    int tid, lane, wave, vcu, G;
    unsigned char* ws;
};
extern __shared__ __attribute__((aligned(16))) unsigned char g_lds[];
__device__ __forceinline__ Frame mkframe(KArgs a) {
    Frame F; int t = threadIdx.x; asm volatile("" : "+v"(t));
    F.lds = (LAS unsigned char*)g_lds; F.ldsg = (char*)g_lds;
    F.tid = t; F.lane = t & 63; F.wave = __builtin_amdgcn_readfirstlane(t >> 6);
    int g = gridDim.x, bx = blockIdx.x; asm volatile("" : "+s"(g), "+s"(bx));
    F.G = g; F.vcu = (g % 8 == 0) ? (bx % 8) * (g / 8) + bx / 8 : bx;
    F.ws = a->ws;
    return F;
}

__device__ __forceinline__ void sincos_d(double a, float& s, float& c) {
    const double k = __builtin_rint(a * 0.63661977236758134308);
    double r = __builtin_fma(-k, 1.57079632679489655800e+00, a); r = __builtin_fma(-k, 6.12323399573676603587e-17, r);
    const double r2 = r * r;
    double sp = -7.6471637318198164759e-13;
    sp = __builtin_fma(sp, r2, 1.6059043836821614599e-10);
    sp = __builtin_fma(sp, r2, -2.5052108385441718775e-08);
    sp = __builtin_fma(sp, r2, 2.7557319223985890653e-06);
    sp = __builtin_fma(sp, r2, -1.9841269841269841270e-04);
    sp = __builtin_fma(sp, r2, 8.3333333333333333333e-03);
    sp = __builtin_fma(sp, r2, -1.6666666666666666667e-01);
    const double sr = __builtin_fma(sp * r2, r, r);
    double cp = 4.7794773323873852974e-14;
    cp = __builtin_fma(cp, r2, -1.1470745597729724714e-11);
    cp = __builtin_fma(cp, r2, 2.0876756987868098979e-09);
    cp = __builtin_fma(cp, r2, -2.7557319223985890653e-07);
    cp = __builtin_fma(cp, r2, 2.4801587301587301587e-05);
    cp = __builtin_fma(cp, r2, -1.3888888888888888889e-03);
    cp = __builtin_fma(cp, r2, 4.1666666666666666667e-02);
    cp = __builtin_fma(cp, r2, -0.5);
    const double cr = __builtin_fma(cp, r2, 1.0);
    const int q = (int)((long long)k & 3);
    const double ss = (q & 1) ? cr : sr, cc = (q & 1) ? sr : cr;
    s = (float)((q & 2) ? -ss : ss); c = (float)(((q + 1) & 2) ? -cc : cc);
}
__device__ const double INV_M[32] = {
    1.0, 0.7498942093324559, 0.5623413251903491, 0.4216965034285822, 0.31622776601683794, 0.23713737056616552, 0.1778279410038923, 0.1333521432163324,
    0.1, 0.07498942093324558, 0.05623413251903491, 0.04216965034285822, 0.03162277660168379, 0.023713737056616554, 0.01778279410038923, 0.01333521432163324,
    0.01, 0.007498942093324559, 0.005623413251903491, 0.004216965034285822, 0.0031622776601683794, 0.0023713737056616554, 0.001778279410038923, 0.001333521432163324,
    0.001, 0.0007498942093324559, 0.0005623413251903491, 0.0004216965034285822, 0.00031622776601683794, 0.00023713737056616554, 0.0001778279410038923, 0.0001333521432163324 };
__device__ const double INV_D[8] = { 1.0, 0.19392274474868576, 0.03760603093086393, 0.007292664737217109, 0.001414213562373095, 0.0002742481756762073, 5.318295896944988e-05, 1.031338537721246e-05 };

template <class FD>
__device__ __forceinline__ void tr_item64(const float* W, int Nsrc, int K, f16* WT, FD dstrow, LAS float* scr, int kb, int cb, int lane, const float* kscale = nullptr) {
    const int k0 = 64 * kb, c0 = 64 * cb, r4 = lane >> 4, cq = (lane & 15) * 4;
    f32x4 v[16];
#pragma unroll
    for (int i = 0; i < 16; ++i) v[i] = *(const f32x4*)(W + (size_t)(k0 + 4 * i + r4) * Nsrc + c0 + cq);
    if (kscale) {
#pragma unroll
        for (int i = 0; i < 16; ++i) v[i] = v[i] * kscale[k0 + 4 * i + r4]; }
#pragma unroll
    for (int i = 0; i < 16; ++i) { const int k = 4 * i + r4, sw = (i >> 1) * 4;
#pragma unroll
        for (int w = 0; w < 4; ++w) scr[k * 64 + ((cq + w) ^ sw)] = v[i][w]; }
    LDS_WAIT(); asm volatile("" ::: "memory");
    const int c = lane & 7;
#pragma unroll
    for (int j = 0; j < 8; ++j) { const int col = (lane >> 3) + 8 * j; const int dr = dstrow(c0 + col); const LAS float* sp = scr + (8 * c) * 64 + (col ^ (c * 4));
        h8 o; o[0] = (f16)sp[0 * 64]; o[1] = (f16)sp[1 * 64]; o[2] = (f16)sp[2 * 64]; o[3] = (f16)sp[3 * 64]; o[4] = (f16)sp[4 * 64]; o[5] = (f16)sp[5 * 64]; o[6] = (f16)sp[6 * 64]; o[7] = (f16)sp[7 * 64];
        *(h8*)(WT + (size_t)dr * K + k0 + 8 * c) = o; }
    LDS_WAIT(); asm volatile("" ::: "memory");
}
struct RowId { __device__ __forceinline__ int operator()(int c) const { return c; } };
struct RowWin0 { __device__ __forceinline__ int operator()(int c) const { if (c < 640) return c; const int jj = c - 640; return 640 + 2 * (jj & 31) + (jj >> 5); } };
struct RowUq { __device__ __forceinline__ int operator()(int c) const { const int h = c / 192, j = c % 192; if (j < 128) return h * 128 + j; const int jj = j - 128; return 1024 + h * 64 + 2 * (jj & 31) + (jj >> 5); } };
struct RowDiff { __device__ __forceinline__ int operator()(int c) const { if (c >= 2048) return c; const int off = c & 63; if (off >= 16) return c; return (c & ~63) + 2 * (off & 7) + (off >> 3); } };
struct RowMoeIn { __device__ __forceinline__ int operator()(int c) const { const int f = c & 2047; return (f >> 2) * 8 + (f & 3) + ((c >> 11) << 2); } };

__device__ __forceinline__ void p0_prologue() {
    const KArgs a = kargs(); const Frame F = mkframe(a);
    const int tid = F.tid, lane = F.lane;
    {
        const float* cin = (const float*)a->in[1]; const float* ada_w = (const float*)a->in[3]; const float* ada_b = (const float*)a->in[4];
        float* mods = (float*)(F.ws + WS_MODS);
        LAS float* sc = (LAS float*)F.lds; LAS float* red = (LAS float*)(F.lds + 16384);
        for (int i = tid; i < 4096; i += NTHREADS) { const float v = cin[i]; sc[i] = v / (1.0f + __expf(-v)); }
        __syncthreads();
        for (int cb = blockIdx.x; cb < 256; cb += F.G) {
            const int f0 = cb * 48, l = f0 / 6144, e0 = f0 % 6144; const int g = tid / 12, cc = tid % 12;
            if (g < 40) { f32x4 a0 = {0.f, 0.f, 0.f, 0.f}, a1 = a0, a2 = a0, a3 = a0; const float* wp = ada_w + (size_t)l * 1024 * 6144 + e0 + 4 * cc;
                f32x4 w[26];
#pragma unroll
                for (int i = 0; i < 26; ++i) { const int d = g + 40 * i; w[i] = (d < 1024) ? *(const f32x4*)(wp + (size_t)d * 6144) : (f32x4){0.f, 0.f, 0.f, 0.f}; }
#pragma unroll
                for (int i = 0; i < 26; ++i) { const int d = (g + 40 * i) & 1023; a0 += w[i] * sc[d]; a1 += w[i] * sc[1024 + d]; a2 += w[i] * sc[2048 + d]; a3 += w[i] * sc[3072 + d]; }
                LAS f32x4* rp = (LAS f32x4*)red + (g * 12 + cc) * 4; rp[0] = a0; rp[1] = a1; rp[2] = a2; rp[3] = a3; }
            __syncthreads();
            if (tid < 192) { const int c2 = tid % 48, b = tid / 48; float s = 0.f;
#pragma unroll 8
                for (int gg = 0; gg < 40; ++gg) s += red[((gg * 12 + (c2 >> 2)) * 4 + b) * 4 + (c2 & 3)];
                mods[(size_t)(l * 4 + b) * 6144 + e0 + c2] = s + ada_b[l * 6144 + e0 + c2]; }
            __syncthreads();
        }
    }
    {
        const int* pos = (const int*)a->in[2];
        float* cosm = (float*)(F.ws + WS_COSM); float* sinm = (float*)(F.ws + WS_SINM); float* cosd = (float*)(F.ws + WS_COSD); float* sind = (float*)(F.ws + WS_SIND);
        for (int i = blockIdx.x * NTHREADS + tid; i < T * 40; i += F.G * NTHREADS) {
            const int t = i / 40, j = i % 40; const double p = (double)pos[t]; float s, c;
            if (j < 32) { sincos_d(p * INV_M[j], s, c); cosm[(size_t)t * 32 + j] = c; sinm[(size_t)t * 32 + j] = s; }
            else { sincos_d(p * INV_D[j - 32], s, c); cosd[(size_t)t * 8 + (j - 32)] = c; sind[(size_t)t * 8 + (j - 32)] = s; }
        }
    }
    {
        LAS float* scr = (LAS float*)(F.lds + F.wave * 16384);
        const int gw = F.vcu * NWAVES + F.wave, NGW = F.G * NWAVES;
        { f16* z = (f16*)(F.ws + WS_WIN0) + (size_t)704 * 1024; for (int i = blockIdx.x * NTHREADS + tid; i < 8192; i += F.G * NTHREADS) *(u32x4*)(z + (size_t)i * 8) = (u32x4){0u, 0u, 0u, 0u}; }
        __syncthreads();
        constexpr int I0 = 16 * 11, I1 = 6 * 24, I2 = 4 * 32, I3 = 16 * 16, I4 = 16 * 48, I5 = 16 * 16;
        constexpr int ISM = I0 + I1 + I2 + I3 + I4 + I5;
        constexpr int IMI = 16 * 64, IMO = 32 * 16;
        constexpr int NITEMS = ISM;
        for (int it = gw; it < NITEMS; it += NGW) {
            int r = it;
            if (r < I0) { tr_item64((const float*)a->in[9], 704, 1024, (f16*)(F.ws + WS_WIN0), RowWin0(), scr, r / 11, r % 11, lane); continue; } r -= I0;
            if (r < I1) { tr_item64((const float*)a->in[12], 1536, 384, (f16*)(F.ws + WS_WUQ), RowUq(), scr, r / 24, r % 24, lane, (const float*)a->in[10]); continue; } r -= I1;
            if (r < I2) { tr_item64((const float*)a->in[13], 2048, 256, (f16*)(F.ws + WS_WUKV), RowId(), scr, r / 32, r % 32, lane, (const float*)a->in[11]); continue; } r -= I2;
            if (r < I3) { tr_item64((const float*)a->in[14], 1024, 1024, (f16*)(F.ws + WS_WO0), RowId(), scr, r / 16, r % 16, lane); continue; } r -= I3;
            if (r < I4) { tr_item64((const float*)a->in[15], 3072, 1024, (f16*)(F.ws + WS_WIN1), RowDiff(), scr, r / 48, r % 48, lane); continue; } r -= I4;
            if (r < I5) { tr_item64((const float*)a->in[18], 1024, 1024, (f16*)(F.ws + WS_WO1), RowId(), scr, r / 16, r % 16, lane); continue; }
        }
    }
}

__device__ __forceinline__ void mod_rows_p1() {
    const KArgs a = kargs(); const Frame F = mkframe(a);
    const float* x = (const float*)a->in[0]; const float* mods_l = (const float*)(F.ws + WS_MODS); f16* out = (f16*)(F.ws + WS_HA);
    const int gw = F.vcu * NWAVES + F.wave, NGW = F.G * NWAVES, lane = F.lane;
    for (int m0 = gw; m0 < T; m0 += 2 * NGW) {
        f32x4 v[2][4];
#pragma unroll
        for (int u = 0; u < 2; ++u) { const int m = m0 + u * NGW; if (m < T) {
#pragma unroll
            for (int j = 0; j < 4; ++j) v[u][j] = *(const f32x4*)(x + (size_t)m * DM + 4 * lane + 256 * j); } }
#pragma unroll
        for (int u = 0; u < 2; ++u) { const int m = m0 + u * NGW; if (m < T) { const float* mb = mods_l + (m >> 12) * 6144;
#pragma unroll
            for (int j = 0; j < 4; ++j) { const int c = 4 * lane + 256 * j; const f32x4 sh = *(const f32x4*)(mb + c), sc = *(const f32x4*)(mb + 1024 + c);
                const f32x4 h = v[u][j] * (sc + 1.0f) + sh; h4 o; o[0] = (f16)h[0]; o[1] = (f16)h[1]; o[2] = (f16)h[2]; o[3] = (f16)h[3];
                *(h4*)(out + (size_t)m * DM + c) = o; } } }
    }
}

#define RCOL(lane, j) ((((j) >> 1) << 9) + 8 * (lane) + 4 * ((j) & 1))
__device__ __forceinline__ void h8_to_f4(const h8 v, f32x4& a, f32x4& b) { a = (f32x4){(float)v[0], (float)v[1], (float)v[2], (float)v[3]}; b = (f32x4){(float)v[4], (float)v[5], (float)v[6], (float)v[7]}; }
__device__ __forceinline__ void ln_router(int l) {
    const KArgs a = kargs(); const Frame F = mkframe(a);
    const float* lng = (const float*)a->in[5] + l * DM; const float* lnb = (const float*)a->in[6] + l * DM; const float* router_w = (const float*)a->in[19] + (size_t)l * DM * NE;
    const float* mods_l = (const float*)(F.ws + WS_MODS) + (size_t)l * 4 * 6144;
    const f16* pre = (const f16*)(F.ws + WS_PRE); float* stat = (float*)(F.ws + WS_STAT); f16* hB = (f16*)(F.ws + WS_HB); float* aff = (float*)(F.ws + WS_AFF);
    LAS float* rwT = (LAS float*)F.lds;
    for (int i = F.tid; i < 16384; i += NTHREADS) { const int d = i >> 4, e = i & 15; const int seg = d >> 9, w = d & 511; rwT[e * 1024 + seg * 512 + ((w >> 2) & 1) * 256 + (w >> 3) * 4 + (w & 3)] = router_w[i]; }
    __syncthreads();
    const int gw = F.vcu * NWAVES + F.wave, NGW = F.G * NWAVES, lane = F.lane;
    for (int m0 = gw; m0 < T; m0 += 2 * NGW) {
        h8 pv[2][2];
#pragma unroll
        for (int u = 0; u < 2; ++u) { const int m = (m0 + u * NGW < T) ? m0 + u * NGW : m0; pv[u][0] = *(const h8*)(pre + (size_t)m * DM + 8 * lane); pv[u][1] = *(const h8*)(pre + (size_t)m * DM + 512 + 8 * lane); }
#pragma unroll
        for (int u = 0; u < 2; ++u) { const int m = m0 + u * NGW; if (m < T) {
        const int b = m >> 12, s_ = m & 4095; const float* mb = mods_l + b * 6144;
        f32x4 v[4]; h8_to_f4(pv[u][0], v[0], v[1]); h8_to_f4(pv[u][1], v[2], v[3]); float s = 0.f;
#pragma unroll
        for (int j = 0; j < 4; ++j) s += (v[j][0] + v[j][1]) + (v[j][2] + v[j][3]);
        const float mean = wave_sum(s) * (1.f / DM); float s2 = 0.f;
#pragma unroll
        for (int j = 0; j < 4; ++j) { v[j] = v[j] - mean; s2 += (v[j][0] * v[j][0] + v[j][1] * v[j][1]) + (v[j][2] * v[j][2] + v[j][3] * v[j][3]); }
        const float rstd = 1.0f / sqrtf(wave_sum(s2) * (1.f / DM) + LN_EPS);
        if (lane == 0) { f32x2 st = {mean, rstd}; *(f32x2*)(stat + (size_t)m * 2) = st; }
        float lg[16];
#pragma unroll
        for (int e = 0; e < 16; ++e) lg[e] = 0.f;
        f32x4 hh[4];
#pragma unroll
        for (int j = 0; j < 4; ++j) { const int c = RCOL(lane, j);
            const f32x4 g = *(const f32x4*)(lng + c), bb = *(const f32x4*)(lnb + c), sh = *(const f32x4*)(mb + 3072 + c), sc = *(const f32x4*)(mb + 4096 + c);
            const f32x4 xn = v[j] * rstd * g + bb; const f32x4 h = xn * (sc + 1.0f) + sh; hh[j] = h;
#pragma unroll
            for (int e = 0; e < 16; ++e) { const f32x4 w = *(const LAS f32x4*)(rwT + e * 1024 + (j >> 1) * 512 + (j & 1) * 256 + lane * 4); lg[e] += (h[0] * w[0] + h[1] * w[1]) + (h[2] * w[2] + h[3] * w[3]); }
            asm volatile("" ::: "memory"); }
        *(h8*)(hB + (size_t)m * DM + 8 * lane) = pack8(hh[0], hh[1]); *(h8*)(hB + (size_t)m * DM + 512 + 8 * lane) = pack8(hh[2], hh[3]);
        float r8[8], r4[4], r2[2], r1;
        { const bool up = (lane & 32) != 0;
#pragma unroll
          for (int i = 0; i < 8; ++i) { const float keep = up ? lg[8 + i] : lg[i], give = up ? lg[i] : lg[8 + i]; r8[i] = keep + __shfl_xor(give, 32); } }
        { const bool up = (lane & 16) != 0;
#pragma unroll
          for (int i = 0; i < 4; ++i) { const float keep = up ? r8[4 + i] : r8[i], give = up ? r8[i] : r8[4 + i]; r4[i] = keep + __shfl_xor(give, 16); } }
        { const bool up = (lane & 8) != 0;
#pragma unroll
          for (int i = 0; i < 2; ++i) { const float keep = up ? r4[2 + i] : r4[i], give = up ? r4[i] : r4[2 + i]; r2[i] = keep + __shfl_xor(give, 8); } }
        { const bool up = (lane & 4) != 0; const float keep = up ? r2[1] : r2[0], give = up ? r2[0] : r2[1]; r1 = keep + __shfl_xor(give, 4); }
        r1 += __shfl_xor(r1, 1); r1 += __shfl_xor(r1, 2);
        float mx = r1;
        mx = fmaxf(mx, __shfl_xor(mx, 4)); mx = fmaxf(mx, __shfl_xor(mx, 8)); mx = fmaxf(mx, __shfl_xor(mx, 16)); mx = fmaxf(mx, __shfl_xor(mx, 32));
        const float pe = __expf(r1 - mx); float den = pe;
        den += __shfl_xor(den, 4); den += __shfl_xor(den, 8); den += __shfl_xor(den, 16); den += __shfl_xor(den, 32);
        if ((lane & 3) == 0) aff[(size_t)(b * 16 + (lane >> 2)) * SEQ + s_] = pe / den;
        } }
    }
    __syncthreads();
}

__device__ __forceinline__ int block_excl_scan(int v, LAS int* tmp, int tid, int& total) {
    const int lane = tid & 63, wid = tid >> 6; int x = v;
#pragma unroll
    for (int o = 1; o < 64; o <<= 1) { const int y = __shfl_up(x, o); if (lane >= o) x += y; }
    if (lane == 63) tmp[wid] = x;
    __syncthreads();
    int base = 0, tot = 0;
#pragma unroll
    for (int w = 0; w < 8; ++w) { const int t = tmp[w]; if (w < wid) base += t; tot += t; }
    __syncthreads();
    total = tot; return base + x - v;
}
__device__ __forceinline__ void topk_phase() {
    const KArgs a = kargs(); const Frame F = mkframe(a);
    const float* aff = (const float*)(F.ws + WS_AFF); float* gate = (float*)(F.ws + WS_GATE); int* rowtok = (int*)(F.ws + WS_ROWTOK); int* inv = (int*)(F.ws + WS_INV);
    LAS unsigned* hist = (LAS unsigned*)F.lds; LAS unsigned* selw = hist + 256; LAS int* tmp = (LAS int*)(hist + 272);
    const int tid = F.tid;
    for (int p = blockIdx.x; p < NB * NE; p += F.G) { const int b = p >> 4, e = p & 15;
        const float* ap = aff + (size_t)p * SEQ + 8 * tid; unsigned key[8];
        { const f32x4 a0 = *(const f32x4*)ap, a1 = *(const f32x4*)(ap + 4);
          key[0] = __float_as_uint(a0[0]); key[1] = __float_as_uint(a0[1]); key[2] = __float_as_uint(a0[2]); key[3] = __float_as_uint(a0[3]);
          key[4] = __float_as_uint(a1[0]); key[5] = __float_as_uint(a1[1]); key[6] = __float_as_uint(a1[2]); key[7] = __float_as_uint(a1[3]); }
        unsigned prefix = 0u, kk = CAP;
        for (int pass = 0; pass < 4; ++pass) { const int shift = 24 - 8 * pass;
            if (tid < 256) hist[tid] = 0u;
            __syncthreads();
#pragma unroll
            for (int j = 0; j < 8; ++j) { const bool match = (pass == 0) || ((key[j] >> (shift + 8)) == prefix); if (match) atomicAdd((unsigned*)&hist[(key[j] >> shift) & 255u], 1u); }
            __syncthreads();
            { const int hv = (tid < 256) ? (int)hist[255 - tid] : 0; int tot_; const int Sp = block_excl_scan(hv, tmp, tid, tot_);
              if (tid < 256 && (unsigned)Sp < kk && kk <= (unsigned)(Sp + hv)) { selw[0] = 255u - (unsigned)tid; selw[1] = kk - (unsigned)Sp; } }
            __syncthreads();
            prefix = (prefix << 8) | selw[0]; kk = selw[1];
            __syncthreads();
        }
        int ce = 0;
#pragma unroll
        for (int j = 0; j < 8; ++j) ce += (key[j] == prefix) ? 1 : 0;
        int tot; int eqr = block_excl_scan(ce, tmp, tid, tot);
        unsigned selm = 0u; int cs = 0;
#pragma unroll
        for (int j = 0; j < 8; ++j) { bool sel = key[j] > prefix; if (key[j] == prefix) { sel = (unsigned)eqr < kk; ++eqr; } if (sel) { selm |= 1u << j; ++cs; } }
        int slot = block_excl_scan(cs, tmp, tid, tot);
#pragma unroll
        for (int j = 0; j < 8; ++j) { const int s_ = 8 * tid + j; const int tok = b * SEQ + s_; const bool sel = (selm >> j) & 1u;
            if (sel) { const int row = e * EROWS + b * CAP + slot; rowtok[row] = tok; gate[row] = __uint_as_float(key[j]); inv[(size_t)tok * 16 + e] = slot; ++slot; }
            else inv[(size_t)tok * 16 + e] = -1; }
        __syncthreads();
    }
}
__device__ __forceinline__ void combine_ln(int l) {
    const KArgs a = kargs(); const Frame F = mkframe(a);
    const float* lng1 = (const float*)a->in[5] + l * DM; const float* lnb1 = (const float*)a->in[6] + l * DM;
    const float* lng = (const float*)a->in[7] + l * DM; const float* lnb = (const float*)a->in[8] + l * DM;
    const float* mods_l = (const float*)(F.ws + WS_MODS) + (size_t)l * 4 * 6144; const float* mods_next = (const float*)(F.ws + WS_MODS) + (size_t)4 * 6144;
    float* xo32 = a->out; f16* x2 = (f16*)(F.ws + WS_X2); f16* hA = (f16*)(F.ws + WS_HA);
    const f16* pre = (const f16*)(F.ws + WS_PRE); const float* stat = (const float*)(F.ws + WS_STAT); const f16* y = (const f16*)(F.ws + WS_Y); const int* inv = (const int*)(F.ws + WS_INV);
    const int gw = F.vcu * NWAVES + F.wave, NGW = F.G * NWAVES, lane = F.lane;
    for (int m0 = gw; m0 < T; m0 += 2 * NGW) {
        int myinv[2]; h8 pv[2][2]; f32x2 st[2];
#pragma unroll
        for (int u = 0; u < 2; ++u) { const int m = (m0 + u * NGW < T) ? m0 + u * NGW : m0; myinv[u] = inv[(size_t)m * 16 + (lane & 15)]; st[u] = *(const f32x2*)(stat + (size_t)m * 2);
            pv[u][0] = *(const h8*)(pre + (size_t)m * DM + 8 * lane); pv[u][1] = *(const h8*)(pre + (size_t)m * DM + 512 + 8 * lane); }
#pragma unroll
        for (int u = 0; u < 2; ++u) { const int m = m0 + u * NGW; if (m < T) {
        const int b = m >> 12; const float* mb = mods_l + b * 6144;
        f32x4 f[4];
#pragma unroll
        for (int j = 0; j < 4; ++j) f[j] = (f32x4){0.f, 0.f, 0.f, 0.f};
        unsigned mask = (unsigned)(__ballot(myinv[u] >= 0) & 0xFFFFull);
        while (mask) {
            const int e0 = __builtin_ctz(mask); mask &= mask - 1u; const bool two = mask != 0u; const int e1 = two ? __builtin_ctz(mask) : e0; mask &= mask - 1u;
            const int s0 = __shfl(myinv[u], e0), s1 = __shfl(myinv[u], e1);
            const f16* y0 = y + (size_t)(e0 * EROWS + b * CAP + s0) * DM; const f16* y1 = y + (size_t)(e1 * EROWS + b * CAP + s1) * DM;
            const h8 a00 = *(const h8*)(y0 + 8 * lane), a01 = *(const h8*)(y0 + 512 + 8 * lane), a10 = *(const h8*)(y1 + 8 * lane), a11 = *(const h8*)(y1 + 512 + 8 * lane);
            const float w1 = two ? 1.0f : 0.0f; f32x4 t0, t1;
            h8_to_f4(a00, t0, t1); f[0] += t0; f[1] += t1; h8_to_f4(a01, t0, t1); f[2] += t0; f[3] += t1;
            h8_to_f4(a10, t0, t1); f[0] += t0 * w1; f[1] += t1 * w1; h8_to_f4(a11, t0, t1); f[2] += t0 * w1; f[3] += t1 * w1;
        }
        f32x4 v[4]; h8_to_f4(pv[u][0], v[0], v[1]); h8_to_f4(pv[u][1], v[2], v[3]); float s = 0.f;
#pragma unroll
        for (int j = 0; j < 4; ++j) { const int c = RCOL(lane, j); const f32x4 g1 = *(const f32x4*)(lng1 + c), b1 = *(const f32x4*)(lnb1 + c), g2 = *(const f32x4*)(mb + 5120 + c);
            const f32x4 x1 = (v[j] - st[u][0]) * st[u][1] * g1 + b1;
            v[j] = x1 * ALPHA + (g2 + 1.0f) * f[j]; s += (v[j][0] + v[j][1]) + (v[j][2] + v[j][3]); }
        const float mean = wave_sum(s) * (1.f / DM); float s2 = 0.f;
#pragma unroll
        for (int j = 0; j < 4; ++j) { v[j] = v[j] - mean; s2 += (v[j][0] * v[j][0] + v[j][1] * v[j][1]) + (v[j][2] * v[j][2] + v[j][3] * v[j][3]); }
        const float rstd = 1.0f / sqrtf(wave_sum(s2) * (1.f / DM) + LN_EPS);
        f32x4 xn[4];
#pragma unroll
        for (int j = 0; j < 4; ++j) { const int c = RCOL(lane, j); const f32x4 g = *(const f32x4*)(lng + c), bb = *(const f32x4*)(lnb + c); xn[j] = v[j] * rstd * g + bb; }
        if (l == 0) {
            *(h8*)(x2 + (size_t)m * DM + 8 * lane) = pack8(xn[0], xn[1]); *(h8*)(x2 + (size_t)m * DM + 512 + 8 * lane) = pack8(xn[2], xn[3]);
            const float* mn = mods_next + b * 6144; f32x4 hv[4];
#pragma unroll
            for (int j = 0; j < 4; ++j) { const int c = RCOL(lane, j); const f32x4 sh = *(const f32x4*)(mn + c), sc = *(const f32x4*)(mn + 1024 + c); hv[j] = xn[j] * (sc + 1.0f) + sh; }
            *(h8*)(hA + (size_t)m * DM + 8 * lane) = pack8(hv[0], hv[1]); *(h8*)(hA + (size_t)m * DM + 512 + 8 * lane) = pack8(hv[2], hv[3]);
        } else {
#pragma unroll
            for (int j = 0; j < 4; ++j) *(f32x4*)(xo32 + (size_t)m * DM + RCOL(lane, j)) = xn[j];
        }
        } }
    }
}

__device__ __forceinline__ void attn_mla() {
    const KArgs a = kargs(); const Frame F = mkframe(a);
    const f16* Q = (const f16*)(F.ws + WS_Q); const f16* K = (const f16*)(F.ws + WS_K); const f16* V = (const f16*)(F.ws + WS_V); f16* O = (f16*)(F.ws + WS_O);
    att::ConvStream cs; att::conv_init(cs, (const float*)a->in[20], (const float*)a->in[21], (f16*)(F.ws + WS_MOEIN), (f16*)(F.ws + WS_MOEOUT), 0, F.vcu * NWAVES + F.wave, F.G * NWAVES, 4, F.ldsg + 83968 + F.wave * 4096);
    for (int u = F.vcu; u < NB * 8 * 16; u += F.G) { const int qb = u & 15, bh = u >> 4, h = bh & 7, b = bh >> 3;
        att::attn_body_simple<192, 1536, 1536, 1024, 1024, true>(Q + (size_t)(b * SEQ + qb * 256) * 1536 + h * 192, K + (size_t)(b * SEQ) * 1536 + h * 192, V + (size_t)(b * SEQ) * 1024 + h * 128,
                                                                 O + (size_t)(b * SEQ + qb * 256) * 1024 + h * 128, F.ldsg, 0, 0.f, nullptr, &cs); }
    while (cs.step < cs.step_end) { cs.it = 0; att::conv_tick(cs, F.lane); att::conv_flush(cs, F.lane); }
    att::conv_flush(cs, F.lane); att::conv_drain(cs, F.lane);
}
__device__ __forceinline__ void attn_diff() {
    const KArgs a = kargs(); const Frame F = mkframe(a);
    const f16* QKV = (const f16*)(F.ws + WS_QKV1); f16* O = (f16*)(F.ws + WS_O);
    const float* lamv = (const float*)a->in[16]; const float* subln = (const float*)a->in[17];
    const float l01 = wave_sum(lamv[F.lane] * lamv[64 + F.lane]), l23 = wave_sum(lamv[128 + F.lane] * lamv[192 + F.lane]);
    const float lam = expf(l01) - expf(l23) + LAMBDA_INIT;
    att::ConvStream cs; att::conv_init(cs, (const float*)a->in[20], (const float*)a->in[21], (f16*)(F.ws + WS_MOEIN), (f16*)(F.ws + WS_MOEOUT), 1, F.vcu * NWAVES + F.wave, F.G * NWAVES, 8, F.ldsg + 51200 + F.wave * 4096);
    for (int u = F.vcu; u < NB * 8 * 16; u += F.G) { const int qb = u & 15, bh = u >> 4, h = bh & 7, b = bh >> 3;
        f16* Ob = O + (size_t)(b * SEQ + qb * 256) * 1024 + h * 128; const f16* Vh = QKV + (size_t)(b * SEQ) * 3072 + 2048 + h * 128;
#pragma unroll 1
        for (int c = 0; c < 2; ++c) { const int hh = 2 * h + c;
            att::attn_body_simple<64, 3072, 3072, 3072, 1024, true>(QKV + (size_t)(b * SEQ + qb * 256) * 3072 + hh * 64, QKV + (size_t)(b * SEQ) * 3072 + 1024 + hh * 64, Vh, Ob, F.ldsg, c, lam, subln, &cs); } }
    cs.it = 0;
    while (cs.step < cs.step_end) { cs.it = 0; att::conv_tick(cs, F.lane); att::conv_flush(cs, F.lane); }
    att::conv_flush(cs, F.lane); att::conv_drain(cs, F.lane);
}

__device__ __forceinline__ void ph_gemm_lat() { const KArgs a = kargs(); const Frame F = mkframe(a);
    pg8::Gemm g{(const f16*)(F.ws + WS_HA), (const f16*)(F.ws + WS_WIN0), T, 768, 1024, 1 << 30, 0, nullptr}; pg8::StaticOrder S; S.init(T, 768, F.G, (int)blockIdx.x);
    EpiLat E{(f16*)(F.ws + WS_CQN), (f16*)(F.ws + WS_CKVN), (f16*)(F.ws + WS_K), (float*)(F.ws + WS_PQ), (float*)(F.ws + WS_PKV), (const float*)(F.ws + WS_COSM), (const float*)(F.ws + WS_SINM)}; pg8::gemm_phase<EpiLat>(F.lds, g, S, E); }
__device__ __forceinline__ void ph_gemm_q() { const KArgs a = kargs(); const Frame F = mkframe(a);
    pg8::Gemm g{(const f16*)(F.ws + WS_CQN), (const f16*)(F.ws + WS_WUQ), T, 1024, 384, 1 << 30, 0, nullptr}; pg8::StaticOrder S; S.init(T, 1024, F.G, (int)blockIdx.x);
    EpiQNope E{(f16*)(F.ws + WS_Q), (const float*)(F.ws + WS_PQ)}; pg8::gemm_phase<EpiQNope>(F.lds, g, S, E); }
__device__ __forceinline__ void ph_gemm_qr() { const KArgs a = kargs(); const Frame F = mkframe(a);
    pg8::Gemm g{(const f16*)(F.ws + WS_CQN), (const f16*)(F.ws + WS_WUQ) + (size_t)1024 * 384, T, 512, 384, 1 << 30, 0, nullptr}; pg8::StaticOrder S; S.init(T, 512, F.G, (int)blockIdx.x);
    EpiQRope E{(f16*)(F.ws + WS_Q), (const float*)(F.ws + WS_COSM), (const float*)(F.ws + WS_SINM), (const float*)(F.ws + WS_PQ)}; pg8::gemm_phase<EpiQRope>(F.lds, g, S, E); }
__device__ __forceinline__ void ph_gemm_kv() { const KArgs a = kargs(); const Frame F = mkframe(a);
    pg8::Gemm g{(const f16*)(F.ws + WS_CKVN), (const f16*)(F.ws + WS_WUKV), T, 2048, 256, 1 << 30, 0, nullptr}; pg8::StaticOrder S; S.init(T, 2048, F.G, (int)blockIdx.x);
    EpiKV E{(f16*)(F.ws + WS_K), (f16*)(F.ws + WS_V), (const float*)(F.ws + WS_PKV)}; pg8::gemm_phase<EpiKV>(F.lds, g, S, E); }
__device__ __forceinline__ void ph_gemm_o(int l) { const KArgs a = kargs(); const Frame F = mkframe(a);
    pg8::Gemm g{(const f16*)(F.ws + WS_O), (const f16*)(F.ws + (l == 0 ? WS_WO0 : WS_WO1)), T, 1024, 1024, 1 << 30, 0, nullptr}; pg8::StaticOrder S; S.init(T, 1024, F.G, (int)blockIdx.x);
    const float* gm = (const float*)(F.ws + WS_MODS) + (size_t)l * 4 * 6144 + 2048;
    if (l == 0) { EpiPre<false> E{a->in[0], gm, (f16*)(F.ws + WS_PRE)}; pg8::gemm_phase<EpiPre<false>>(F.lds, g, S, E); }
    else { EpiPre<true> E{(const void*)(F.ws + WS_X2), gm, (f16*)(F.ws + WS_PRE)}; pg8::gemm_phase<EpiPre<true>>(F.lds, g, S, E); } }
__device__ __forceinline__ void ph_gemm_diffin() { const KArgs a = kargs(); const Frame F = mkframe(a);
    pg8::Gemm g{(const f16*)(F.ws + WS_HA), (const f16*)(F.ws + WS_WIN1), T, 3072, 1024, 1 << 30, 0, nullptr}; pg8::StaticOrder S; S.init(T, 3072, F.G, (int)blockIdx.x);
    EpiDiffIn E{(f16*)(F.ws + WS_QKV1), (const float*)(F.ws + WS_COSD), (const float*)(F.ws + WS_SIND)}; pg8::gemm_phase<EpiDiffIn>(F.lds, g, S, E); }
__device__ __forceinline__ void ph_gemm_up(int l) { const KArgs a = kargs(); const Frame F = mkframe(a);
    pg8::Gemm g{(const f16*)(F.ws + WS_HB), (const f16*)(F.ws + WS_MOEIN) + (size_t)l * NE * 4096 * 1024, MROWS, 4096, 1024, EROWS / 256, (size_t)4096 * 1024, (const int*)(F.ws + WS_ROWTOK)}; pg8::StaticOrder S; S.init(MROWS, 4096, F.G, (int)blockIdx.x);
    EpiUp E{(f16*)(F.ws + WS_ACT)}; pg8::gemm_phase<EpiUp, true, true, true>(F.lds, g, S, E); }
__device__ __forceinline__ void ph_gemm_down(int l) { const KArgs a = kargs(); const Frame F = mkframe(a);
    pg8::Gemm g{(const f16*)(F.ws + WS_ACT), (const f16*)(F.ws + WS_MOEOUT) + (size_t)l * NE * 1024 * 2048, MROWS, 1024, 2048, EROWS / 256, (size_t)1024 * 2048, nullptr}; pg8::StaticOrder S; S.init(MROWS, 1024, F.G, (int)blockIdx.x);
    EpiDown E{(f16*)(F.ws + WS_Y), (const float*)(F.ws + WS_GATE)}; pg8::gemm_phase<EpiDown>(F.lds, g, S, E); }

constexpr int NPHASES = 24;
__global__ void __launch_bounds__(NTHREADS, 2) mk_fwd(Args args) {
    LAS unsigned char* ldsp = (LAS unsigned char*)g_lds;
    volatile LAS unsigned* MISC = (volatile LAS unsigned*)(ldsp + MISC_OFF);
    for (int u = threadIdx.x; u < (LDS_BYTES - LDSCTL_OFF) / 4; u += NTHREADS) ((LAS unsigned*)(ldsp + LDSCTL_OFF))[u] = 0u;
    __syncthreads();
    XcdBarrier bar = xcd_barrier_post((unsigned*)(args.ws + WS_CTL) + CW_BAR + args.li * XCD_BAR_WORDS, MISC + 8);
    const int lo = args.ph_lo, hi = args.ph_hi;
#ifndef PH_MASK
#define PH_MASK 0xFFFFFFFFu
#endif
#define IN(k) (((PH_MASK >> (k)) & 1u) && lo <= (k) && (k) < hi)
#define SEAM(k) do { if (lo <= (k) && (k) + 1 < hi) xcd_barrier(bar); } while (0)
#ifndef REP_MASK
#define REP_MASK 0u
#endif
#define RUN(k, call) do { if (IN(k)) { call; if ((REP_MASK >> (k)) & 1u) { __syncthreads(); call; } } } while (0)
    RUN(0, p0_prologue());      SEAM(0);
    RUN(1, mod_rows_p1());      SEAM(1);
    RUN(2, ph_gemm_lat());      SEAM(2);
    RUN(4, ph_gemm_q()); RUN(4, ph_gemm_qr());
    RUN(5, ph_gemm_kv());       SEAM(5);
    RUN(6, attn_mla());         SEAM(6);
#pragma unroll 1
    for (int l = 0; l < 2; ++l) {
        const int pb = (l == 0) ? 7 : 17;
        if (l == 1) {
            RUN(14, ph_gemm_diffin()); SEAM(14);
            RUN(15, attn_diff());      SEAM(15);
        }
        RUN(pb + 0, ph_gemm_o(l));     SEAM(pb + 0);
        RUN(pb + 1, ln_router(l));     SEAM(pb + 1);
        RUN(pb + 2, topk_phase());     SEAM(pb + 2);
        RUN(pb + 4, ph_gemm_up(l));    SEAM(pb + 4);
        RUN(pb + 5, ph_gemm_down(l));  SEAM(pb + 5);
        RUN(pb + 6, combine_ln(l));
        if (l == 0) SEAM(pb + 6);
    }
#undef IN
#undef SEAM
}

extern "C" void kernel_launch(void* const* d_in, const int* in_sizes, int n_in, void* d_out, int out_size, void* d_ws, size_t ws_size, hipStream_t stream) {
    static int grid = 0;
    if (grid == 0) {
        if (n_in != 22 || in_sizes[0] != T * DM || out_size != T * DM || ws_size < WS_END) {
            fprintf(stderr, "kernel_launch: shape/workspace mismatch: n_in %d in0 %d out %d ws %zu (need %zu)\n", n_in, n_in > 0 ? in_sizes[0] : -1, out_size, ws_size, (size_t)WS_END); grid = -1; return; }
        int dev = 0, cus = 0, per_cu = 0;
        if (hipGetDevice(&dev) != hipSuccess || hipDeviceGetAttribute(&cus, hipDeviceAttributeMultiprocessorCount, dev) != hipSuccess) { fprintf(stderr, "kernel_launch: device query failed\n"); grid = -1; return; }
        if (hipFuncSetAttribute((const void*)mk_fwd, hipFuncAttributeMaxDynamicSharedMemorySize, LDS_BYTES) != hipSuccess) { fprintf(stderr, "kernel_launch: hipFuncSetAttribute failed\n"); grid = -1; return; }
        if (hipOccupancyMaxActiveBlocksPerMultiprocessor(&per_cu, (const void*)mk_fwd, NTHREADS, LDS_BYTES) != hipSuccess || per_cu < 1)
            fprintf(stderr, "kernel_launch: note: occupancy query reports %d workgroups per CU\n", per_cu);
        (void)hipGetLastError();
        grid = cus;
    }
    if (grid < 0) return;
    if (hipMemsetAsync((char*)d_ws + WS_CTL, 0, CTL_ZERO_BYTES, stream) != hipSuccess) { fprintf(stderr, "kernel_launch: memset failed\n"); return; }
    Args a{};
    for (int i = 0; i < 22; ++i) a.in[i] = d_in[i];
    a.out = (float*)d_out; a.ws = (unsigned char*)d_ws;
#if MK_CUTS == 1
    a.ph_lo = 0; a.ph_hi = NPHASES; a.li = 0;
    hipLaunchKernelGGL(mk_fwd, dim3(grid), dim3(NTHREADS), LDS_BYTES, stream, a);
#else
    for (int p = 0; p < NPHASES; ++p) { a.ph_lo = p; a.ph_hi = p + 1; a.li = 0; hipLaunchKernelGGL(mk_fwd, dim3(grid), dim3(NTHREADS), LDS_BYTES, stream, a); }
#endif
    const hipError_t le = hipPeekAtLastError();
    if (le != hipSuccess) fprintf(stderr, "kernel_launch: launch failed: %s\n", hipGetErrorName(le));
}
```

```cpp
#include <hip/hip_runtime.h>
#include <cstdio>
#include <cstdint>

#ifndef MK_CUTS
#define MK_CUTS 1
#endif


#define LAS __attribute__((address_space(3)))
#define GAS __attribute__((address_space(1)))
typedef _Float16 f16;
typedef _Float16 h8 __attribute__((ext_vector_type(8)));
typedef _Float16 h4 __attribute__((ext_vector_type(4)));
typedef _Float16 h2 __attribute__((ext_vector_type(2)));
typedef short s16x4 __attribute__((ext_vector_type(4)));
typedef float f32x4 __attribute__((ext_vector_type(4)));
typedef float f32x2 __attribute__((ext_vector_type(2)));
typedef float f32x16 __attribute__((ext_vector_type(16)));
typedef unsigned u32x4 __attribute__((ext_vector_type(4)));
typedef unsigned u32x2 __attribute__((ext_vector_type(2)));

constexpr int NB = 4, SEQ = 4096, DM = 1024, T = NB * SEQ;
constexpr int NE = 16, FF = 2048, CAP = 512, EROWS = NB * CAP;
constexpr int MROWS = NE * EROWS;
constexpr float ALPHA = 1.4142135623730951f;
constexpr float LN_EPS = 1e-5f, LAT_EPS = 1e-6f;
constexpr float LAMBDA_INIT = 0.35550906759096926f;
constexpr int NWAVES = 8, NTHREADS = 512;

constexpr size_t MiB = 1u << 20;
constexpr size_t WS_CTL = 0, CTL_ZERO_BYTES = 1 * MiB;
constexpr size_t WS_MODS = 1 * MiB;
constexpr size_t WS_COSM = 2 * MiB, WS_SINM = 4 * MiB;
constexpr size_t WS_COSD = 6 * MiB, WS_SIND = 6 * MiB + 512 * 1024;
constexpr size_t WS_AFF = 7 * MiB;
constexpr size_t WS_GATE = 8 * MiB;
constexpr size_t WS_ROWTOK = 8 * MiB + 512 * 1024;
constexpr size_t WS_INV = 9 * MiB;
constexpr size_t WS_WIN0 = 16 * MiB;
constexpr size_t WS_WUQ = 18 * MiB;
constexpr size_t WS_WUKV = 20 * MiB;
constexpr size_t WS_WO0 = 22 * MiB;
constexpr size_t WS_WIN1 = 24 * MiB;
constexpr size_t WS_WO1 = 30 * MiB;
constexpr size_t WS_MOEIN = 32 * MiB;
constexpr size_t WS_MOEOUT = 288 * MiB;
constexpr size_t WS_HA = 416 * MiB;
constexpr size_t WS_HB = 448 * MiB;
constexpr size_t WS_PQ = 480 * MiB;
constexpr size_t WS_PKV = 481 * MiB;
constexpr size_t WS_CQN = 528 * MiB;
constexpr size_t WS_CKVN = 540 * MiB;
constexpr size_t WS_Q = 548 * MiB;
constexpr size_t WS_K = 596 * MiB;
constexpr size_t WS_V = 644 * MiB;
constexpr size_t WS_O = 676 * MiB;
constexpr size_t WS_PRE = 708 * MiB;
constexpr size_t WS_STAT = 772 * MiB;
constexpr size_t WS_X2 = 836 * MiB;
constexpr size_t WS_XE = 900 * MiB;
constexpr size_t WS_ACT = 964 * MiB;
constexpr size_t WS_Y = 1092 * MiB;
constexpr size_t WS_QKV1 = 1156 * MiB;
constexpr size_t WS_OD = 1252 * MiB;
constexpr size_t WS_END = 1316 * MiB;
constexpr int CW_BAR = 4096;

constexpr int RING_BYTES = 131072;
constexpr int LDSCTL_OFF = RING_BYTES, MISC_OFF = LDSCTL_OFF + 320;
constexpr int LDS_BYTES = 147456;

#define LDS_WAIT() asm volatile("s_waitcnt lgkmcnt(0)" ::: "memory")
#define VM_WAIT() asm volatile("s_waitcnt vmcnt(0)" ::: "memory")

__device__ __forceinline__ float wave_sum(float v) {
#pragma unroll
    for (int o = 1; o < 64; o <<= 1) v += __shfl_xor(v, o);
    return v;
}

#define XB_TMO      128
#define XB_XCNT(j)  (256  + 64 * (j))
#define XB_XSUB(j)  (1280 + 64 * (j))
#define XB_XGEN(j)  (2304 + 64 * (j))
#define XB_TOP      3328
#define XB_TOPGEN   3392
#define XCD_BAR_WORDS 3456
#define XB_SPIN_CAP (1u << 20)
__device__ __forceinline__ unsigned xb_ld(unsigned* p)              { return __hip_atomic_load(p, __ATOMIC_RELAXED, __HIP_MEMORY_SCOPE_AGENT); }
__device__ __forceinline__ unsigned xb_add(unsigned* p, unsigned v) { return __hip_atomic_fetch_add(p, v, __ATOMIC_RELAXED, __HIP_MEMORY_SCOPE_AGENT); }
__device__ __forceinline__ unsigned xb_xcc_id() { return (unsigned)__builtin_amdgcn_s_getreg((3 << 11) | 20) & 0xFu; }
#define XB_SPIN(cond, bar) do { unsigned _sp = 0; while (cond) { __builtin_amdgcn_s_sleep(1); \
    if ((++_sp & 255u) == 0u) { if (xb_ld(&(bar)[XB_TMO])) break; if (_sp > XB_SPIN_CAP) { atomicAdd(&(bar)[XB_TMO], 1u); break; } } } } while (0)
struct XcdBarrier { unsigned* bar; unsigned x; volatile LAS unsigned* st; };
__device__ __forceinline__ XcdBarrier xcd_barrier_post(unsigned* bar, volatile LAS unsigned* st) {
    XcdBarrier b; b.bar = bar; b.x = xb_xcc_id(); b.st = st;
    if (threadIdx.x == 0) (void)xb_add(&bar[XB_XCNT(b.x)], 1u);
    return b;
}
__device__ __forceinline__ void xcd_barrier_complete(unsigned* bar, unsigned x, unsigned& nloc, unsigned& nx) {
    const unsigned G = gridDim.x * gridDim.y * gridDim.z;
    unsigned sum, cnt, mine, sp = 0u;
    for (;;) {
        sum = 0u; cnt = 0u; mine = 0u;
#pragma unroll
        for (unsigned j = 0; j < 16; ++j) { const unsigned c = xb_ld(&bar[XB_XCNT(j)]); sum += c; cnt += (c > 0u) ? 1u : 0u; mine = (j == x) ? c : mine; }
        if (sum == G) break;
        __builtin_amdgcn_s_sleep(1);
        if ((++sp & 255u) == 0u) { if (xb_ld(&bar[XB_TMO])) break; if (sp > XB_SPIN_CAP) { atomicAdd(&bar[XB_TMO], 1u); break; } }
    }
    nloc = mine > 0u ? mine : 1u; nx = cnt > 0u ? cnt : 1u;
}
__device__ __forceinline__ void xcd_barrier(const XcdBarrier& b) {
    asm volatile("s_waitcnt vmcnt(0)" ::: "memory");
    __syncthreads();
    if (threadIdx.x == 0) {
        unsigned* bar = b.bar;
        __builtin_amdgcn_s_waitcnt(0);
        unsigned nloc = b.st[0], nx = b.st[1];
        if (nloc == 0u) { xcd_barrier_complete(bar, b.x, nloc, nx); b.st[0] = nloc; b.st[1] = nx; }
        const unsigned old = xb_add(&bar[XB_XSUB(b.x)], 1u);
        const unsigned gen = old / nloc;
        if (old + 1u == (gen + 1u) * nloc) {
            __builtin_amdgcn_fence(__ATOMIC_RELEASE, "agent");
            asm volatile("s_waitcnt vmcnt(0)" ::: "memory");
            const unsigned og = xb_add(&bar[XB_TOP], 1u);
            const unsigned tg = og / nx;
            if (og + 1u == (tg + 1u) * nx) xb_add(&bar[XB_TOPGEN], 1u);
            else XB_SPIN(xb_ld(&bar[XB_TOPGEN]) == tg, bar);
            __builtin_amdgcn_fence(__ATOMIC_ACQUIRE, "agent");
            xb_add(&bar[XB_XGEN(b.x)], 1u);
            asm volatile("s_waitcnt vmcnt(0)" ::: "memory");
        } else {
            XB_SPIN(xb_ld(&bar[XB_XGEN(b.x)]) == gen, bar);
            __builtin_amdgcn_fence(__ATOMIC_ACQUIRE, "agent");
            asm volatile("s_waitcnt vmcnt(0)" ::: "memory");
        }
    }
    __syncthreads();
}

namespace pg8 {
constexpr int BM = 256, BK = 64, HALF = 128, HTB = HALF * BK * 2, STAGE_BYTES = 8 * HTB, NXCD = 8, WGM = 8;
__host__ __device__ __forceinline__ int lds_byte(int r, int c) { const int st = (r >> 4) * 2 + (c >> 5), rr = r & 15, cc = c & 31, ob = rr * 64 + cc * 2; return st * 1024 + (ob ^ (((ob >> 9) & 1) << 5)); }
__host__ __device__ __forceinline__ void stage_rc(int b, int& R, int& C) { const int st = b / 1024, sb = b % 1024, swz = sb ^ (((sb >> 9) & 1) << 5); R = (st >> 1) * 16 + swz / 64; C = (st & 1) * 32 + (swz % 64) / 2; }
__host__ __device__ __forceinline__ int perm32(int rho) { const int n = rho >> 4, i = rho & 15; return 8 * (i >> 2) + 4 * n + (i & 3); }
struct Unit { int pm, pn; };
struct Gemm { const f16* A; const f16* Bt; int M, N, K; int grp_tiles; size_t grp_stride; const int* rowidx; };
struct StaticOrder {
    int nM, nN, nwg, G, c;
    __host__ __device__ void init(int M, int N, int G_, int c_) { nM = M / BM; nN = N / BM; nwg = nM * nN; G = G_; c = c_; }
    __host__ __device__ bool next(int i, Unit& u) const {
        const long L = (long)i * G + c; if (L >= nwg) return false;
        int wgid = (int)L; { const int q = nwg / NXCD, r = nwg % NXCD, xcd = wgid % NXCD, off = wgid / NXCD; wgid = (xcd < r ? xcd * (q + 1) : r * (q + 1) + (xcd - r) * q) + off; }
        const int nig = WGM * nN, gid = wgid / nig, fm = gid * WGM, gsz = (nM - fm) < WGM ? (nM - fm) : WGM;
        u.pm = fm + ((wgid % nig) % gsz); u.pn = (wgid % nig) / gsz; return true;
    }
};
constexpr int GATHER_MAX_UNITS = 15, GATHER_IDX_OFF = RING_BYTES + 1024;
template <class Epi, bool ALIGN_EPI = true, bool SP2 = true, bool GATHER = false>
__device__ __forceinline__ void gemm_phase(LAS unsigned char* lds, const Gemm g, const StaticOrder& S, const Epi& E) {
    int tid = threadIdx.x; asm volatile("" : "+v"(tid));
    const int wid = __builtin_amdgcn_readfirstlane(tid >> 6), lane = tid & 63, wr = wid >> 2, wc = wid & 3, fr = lane & 15, fq = lane >> 4;
    const int K = g.K, nt = K / BK;
    unsigned voffA[2], voffB[2];
#pragma unroll
    for (int i = 0; i < 2; ++i) { int R, C; stage_rc(tid * 16 + i * 8192, R, C); const int Rb = Epi::PERM ? ((R & ~31) + perm32(R & 31)) : R;
        voffA[i] = (unsigned)(R * K + C) * 2u; voffB[i] = (unsigned)(Rb * K + C) * 2u; }
    int gR[2]; unsigned gC[2];
#pragma unroll
    for (int i = 0; i < 2; ++i) { int R, C; stage_rc(tid * 16 + i * 8192, R, C); gR[i] = R; gC[i] = (unsigned)C * 2u; }
    LAS int* idxbuf = (LAS int*)(lds + GATHER_IDX_OFF);
    if constexpr (GATHER) {
        Unit uu;
        for (int q = 0; q < GATHER_MAX_UNITS; ++q) { if (!S.next(q, uu)) break; if (tid < 256) idxbuf[q * 256 + tid] = g.rowidx[uu.pm * 256 + tid]; }
        asm volatile("s_waitcnt vmcnt(0) lgkmcnt(0)" ::: "memory"); __builtin_amdgcn_s_barrier(); asm volatile("" ::: "memory");
    }
    unsigned gaC[2][2], gaN[2][2], ga2[2][2];
#define PG8_GA(dst, q) do { _Pragma("unroll") for (int _h = 0; _h < 2; ++_h) _Pragma("unroll") for (int _i = 0; _i < 2; ++_i) dst[_h][_i] = (unsigned)idxbuf[(q) * 256 + _h * 128 + gR[_i]] * (unsigned)(K * 2) + gC[_i]; } while (0)
    const size_t kstep = (size_t)(BK * 2);
    const size_t hstep = (size_t)HALF * K * 2;
    const size_t tstep = 2 * hstep;
    const unsigned ldsw = (unsigned)wid * 1024u;
    const int aoff = lds_byte(wr * 64 + fr, fq * 8), boff = lds_byte(wc * 32 + fr, fq * 8);
#define PG8_SA(b, h) (((b) * 2 + (h)) * HTB)
#define PG8_SB(b, h) ((4 + (b) * 2 + (h)) * HTB)
#define PG8_STAGE(bufoff, gbase, voff) do { _Pragma("unroll") for (int _i = 0; _i < 2; ++_i) \
        __builtin_amdgcn_global_load_lds((const unsigned*)((const char*)(gbase) + (voff)[_i]), (LAS unsigned*)(lds + (bufoff) + ldsw + _i * 8192), 16, 0, 0); } while (0)
#define PG8_LDA(dst, b, h) do { _Pragma("unroll") for (int m = 0; m < 4; ++m) _Pragma("unroll") for (int k = 0; k < 2; ++k) dst[m][k] = *(const LAS h8*)(lds + PG8_SA(b, h) + aoff + m * 2048 + k * 1024); } while (0)
#define PG8_LDB(dst, b, h) do { _Pragma("unroll") for (int n = 0; n < 2; ++n) _Pragma("unroll") for (int k = 0; k < 2; ++k) dst[n][k] = *(const LAS h8*)(lds + PG8_SB(b, h) + boff + n * 2048 + k * 1024); } while (0)
#define PG8_MMA(ai, bj, At, Bt) do { __builtin_amdgcn_s_setprio(1); _Pragma("unroll") for (int m = 0; m < 4; ++m) _Pragma("unroll") for (int n = 0; n < 2; ++n) _Pragma("unroll") for (int k = 0; k < 2; ++k) \
        acc[ai][bj][m][n] = __builtin_amdgcn_mfma_f32_16x16x32_f16(Bt[n][k], At[m][k], acc[ai][bj][m][n], 0, 0, 0); __builtin_amdgcn_s_setprio(0); } while (0)
#define PG8_WAIT_V(n) asm volatile("s_waitcnt vmcnt(" #n ")" ::: "memory")
#define PG8_WAIT_L(n) asm volatile("s_waitcnt lgkmcnt(" #n ")" ::: "memory")
#define PG8_BAR __builtin_amdgcn_s_barrier()
#define PG8_SCHED __builtin_amdgcn_sched_barrier(0)
#define PG8_STA(bufoff, tileptr, h, gaset, kbyte) do { if constexpr (GATHER) { PG8_STAGE(bufoff, (const char*)g.A + (kbyte), gaset[h]); } else { PG8_STAGE(bufoff, (tileptr) + (h) * hstep, voffA); } } while (0)
#define PG8_BBASE(u) ((const char*)g.Bt + ((size_t)((u).pm / g.grp_tiles) * g.grp_stride) * 2 + (size_t)(u).pn * tstep)
    Unit cur, nxt; int ui = 0;
    if (!S.next(0, cur)) return;
    f32x4 acc[2][2][4][2];
#pragma unroll
    for (int a = 0; a < 2; ++a)
#pragma unroll
        for (int b = 0; b < 2; ++b)
#pragma unroll
            for (int m = 0; m < 4; ++m)
#pragma unroll
                for (int n = 0; n < 2; ++n) acc[a][b][m][n] = (f32x4){0.f, 0.f, 0.f, 0.f};
    h8 At[4][2], B0[2][2], B1[2][2];
    const char* cA = (const char*)g.A + (size_t)cur.pm * tstep; const char* cB = PG8_BBASE(cur);
    if constexpr (GATHER) { PG8_GA(gaC, 0); }
    if constexpr (SP2) {
        PG8_STAGE(PG8_SB(0, 0), cB, voffB); PG8_STAGE(PG8_SB(0, 1), cB + hstep, voffB); PG8_STA(PG8_SA(0, 0), cA, 0, gaC, 0); PG8_STA(PG8_SA(0, 1), cA, 1, gaC, 0);
        if (wr == 1) PG8_BAR;
        PG8_WAIT_V(2); PG8_BAR;
        PG8_STAGE(PG8_SB(1, 0), cB + kstep, voffB); PG8_STA(PG8_SA(1, 0), cA + kstep, 0, gaC, kstep); PG8_STAGE(PG8_SB(1, 1), cB + hstep + kstep, voffB);
        PG8_WAIT_V(6); PG8_BAR;
    } else {
        PG8_STAGE(PG8_SB(0, 0), cB, voffB); PG8_STA(PG8_SA(0, 0), cA, 0, gaC, 0); PG8_STAGE(PG8_SB(0, 1), cB + hstep, voffB); PG8_STA(PG8_SA(0, 1), cA, 1, gaC, 0);
        if (wr == 1) PG8_BAR;
        PG8_WAIT_V(4); PG8_BAR;
        PG8_STAGE(PG8_SB(1, 0), cB + kstep, voffB); PG8_STA(PG8_SA(1, 0), cA + kstep, 0, gaC, kstep); PG8_STAGE(PG8_SB(1, 1), cB + hstep + kstep, voffB);
        PG8_WAIT_V(6); PG8_BAR;
    }
    for (;;) {
        const bool has_next = S.next(ui + 1, nxt);
        const char* nA = has_next ? (const char*)g.A + (size_t)nxt.pm * tstep : cA; const char* nB = has_next ? PG8_BBASE(nxt) : cB;
        if constexpr (GATHER) { const int qn = has_next ? ui + 1 : ui; PG8_GA(gaN, qn); }
#pragma unroll 1
        for (int t = 0; t < nt; t += 2) {
            const bool last = (t == nt - 2);
            const char* a1 = cA + (size_t)(t + 1) * kstep;
            const char* a2 = last ? nA : cA + (size_t)(t + 2) * kstep; const char* b2 = last ? nB : cB + (size_t)(t + 2) * kstep;
            const char* a3 = a2 + kstep; const char* b3 = b2 + kstep;
            const size_t k1 = (size_t)(t + 1) * kstep, k2 = last ? 0 : (size_t)(t + 2) * kstep, k3 = k2 + kstep;
            if constexpr (GATHER) { _Pragma("unroll") for (int _h = 0; _h < 2; ++_h) _Pragma("unroll") for (int _i = 0; _i < 2; ++_i) ga2[_h][_i] = last ? gaN[_h][_i] : gaC[_h][_i]; }
            if constexpr (SP2) {
            PG8_LDB(B0, 0, 0); PG8_LDB(B1, 0, 1); PG8_SCHED; PG8_LDA(At, 0, 0); PG8_STA(PG8_SA(1, 1), a1, 1, gaC, k1);
            PG8_WAIT_V(8); PG8_WAIT_L(0); PG8_BAR; PG8_MMA(0, 0, At, B0); PG8_MMA(0, 1, At, B1); PG8_BAR; PG8_SCHED;
            PG8_LDA(At, 0, 1); PG8_STAGE(PG8_SB(0, 0), b2, voffB); PG8_STAGE(PG8_SB(0, 1), b2 + hstep, voffB); PG8_STA(PG8_SA(0, 0), a2, 0, ga2, k2);
            PG8_WAIT_V(8); PG8_WAIT_L(0); PG8_BAR; PG8_MMA(1, 0, At, B0); PG8_MMA(1, 1, At, B1); PG8_BAR; PG8_SCHED;
            PG8_LDB(B0, 1, 0); PG8_LDB(B1, 1, 1); PG8_SCHED; PG8_LDA(At, 1, 0); PG8_STA(PG8_SA(0, 1), a2, 1, ga2, k2);
            PG8_WAIT_V(8); PG8_WAIT_L(0); PG8_BAR; PG8_MMA(0, 0, At, B0); PG8_MMA(0, 1, At, B1); PG8_BAR; PG8_SCHED;
            PG8_LDA(At, 1, 1); PG8_STAGE(PG8_SB(1, 0), b3, voffB); PG8_STAGE(PG8_SB(1, 1), b3 + hstep, voffB); PG8_STA(PG8_SA(1, 0), a3, 0, ga2, k3);
            PG8_WAIT_V(8); PG8_WAIT_L(0); PG8_BAR; PG8_MMA(1, 0, At, B0); PG8_MMA(1, 1, At, B1); PG8_BAR; PG8_SCHED;
            } else {
            PG8_LDB(B0, 0, 0); PG8_SCHED; PG8_LDA(At, 0, 0); PG8_STA(PG8_SA(1, 1), a1, 1, gaC, k1);
            PG8_WAIT_L(8); PG8_BAR; PG8_WAIT_L(0); PG8_MMA(0, 0, At, B0); PG8_BAR; PG8_SCHED;
            PG8_LDB(B1, 0, 1); PG8_STAGE(PG8_SB(0, 0), b2, voffB);
            PG8_BAR; PG8_WAIT_L(0); PG8_MMA(0, 1, At, B1); PG8_BAR;
            PG8_LDA(At, 0, 1); PG8_STA(PG8_SA(0, 0), a2, 0, ga2, k2);
            PG8_BAR; PG8_WAIT_L(0); PG8_MMA(1, 0, At, B0); PG8_BAR; PG8_SCHED;
            PG8_STAGE(PG8_SB(0, 1), b2 + hstep, voffB);
            PG8_WAIT_V(6); PG8_BAR; PG8_MMA(1, 1, At, B1); PG8_BAR;
            PG8_LDB(B0, 1, 0); PG8_SCHED; PG8_LDA(At, 1, 0); PG8_STA(PG8_SA(0, 1), a2, 1, ga2, k2);
            PG8_WAIT_L(8); PG8_BAR; PG8_WAIT_L(0); PG8_MMA(0, 0, At, B0); PG8_BAR; PG8_SCHED;
            PG8_LDB(B1, 1, 1); PG8_STAGE(PG8_SB(1, 0), b3, voffB);
            PG8_BAR; PG8_WAIT_L(0); PG8_MMA(0, 1, At, B1); PG8_BAR;
            PG8_LDA(At, 1, 1); PG8_STA(PG8_SA(1, 0), a3, 0, ga2, k3);
            PG8_BAR; PG8_WAIT_L(0); PG8_MMA(1, 0, At, B0); PG8_BAR; PG8_SCHED;
            PG8_STAGE(PG8_SB(1, 1), b3 + hstep, voffB);
            PG8_WAIT_V(6); PG8_BAR; PG8_MMA(1, 1, At, B1); PG8_BAR;
            }
        }
        if constexpr (ALIGN_EPI) { if (wr == 0) PG8_BAR; }
        E(acc, cur, wr, wc, fr, fq);
        if (!has_next) break;
#pragma unroll
        for (int a = 0; a < 2; ++a)
#pragma unroll
            for (int b = 0; b < 2; ++b)
#pragma unroll
                for (int m = 0; m < 4; ++m)
#pragma unroll
                    for (int n = 0; n < 2; ++n) acc[a][b][m][n] = (f32x4){0.f, 0.f, 0.f, 0.f};
        cur = nxt; cA = nA; cB = nB; ++ui;
        if constexpr (GATHER) { _Pragma("unroll") for (int _h = 0; _h < 2; ++_h) _Pragma("unroll") for (int _i = 0; _i < 2; ++_i) gaC[_h][_i] = gaN[_h][_i]; }
        if constexpr (ALIGN_EPI) { if (wr == 1) PG8_BAR; }
    }
    PG8_WAIT_V(0);
    if constexpr (!ALIGN_EPI) { if (wr == 0) PG8_BAR; }
    PG8_BAR;
#undef PG8_SA
#undef PG8_SB
#undef PG8_STAGE
#undef PG8_LDA
#undef PG8_LDB
#undef PG8_MMA
#undef PG8_WAIT_V
#undef PG8_WAIT_L
#undef PG8_BAR
#undef PG8_SCHED
#undef PG8_BBASE
#undef PG8_STA
#undef PG8_GA
}
}

#define EPI_ROW(u, ai, m) ((u).pm * 256 + (ai) * 128 + wr * 64 + (m) * 16 + fr)
__device__ __forceinline__ h8 pack8(f32x4 a, f32x4 b) { h8 o; o[0] = (f16)a[0]; o[1] = (f16)a[1]; o[2] = (f16)a[2]; o[3] = (f16)a[3]; o[4] = (f16)b[0]; o[5] = (f16)b[1]; o[6] = (f16)b[2]; o[7] = (f16)b[3]; return o; }
__device__ __forceinline__ void rope4(f32x4& v0, f32x4& v1, const f32x4 cs, const f32x4 sn) {
    const f32x4 a = v0, b = v1;
    v0[0] = a[0] * cs[0] - a[1] * sn[0]; v0[1] = a[1] * cs[0] + a[0] * sn[0];
    v0[2] = a[2] * cs[1] - a[3] * sn[1]; v0[3] = a[3] * cs[1] + a[2] * sn[1];
    v1[0] = b[0] * cs[2] - b[1] * sn[2]; v1[1] = b[1] * cs[2] + b[0] * sn[2];
    v1[2] = b[2] * cs[3] - b[3] * sn[3]; v1[3] = b[3] * cs[3] + b[2] * sn[3];
}
struct EpiLat {
    static constexpr bool PERM = true; f16* cq; f16* ckv; f16* Kp; float* pq; float* pkv; const float* cosm; const float* sinm;
    __device__ __forceinline__ void operator()(const f32x4 (&acc)[2][2][4][2], const pg8::Unit& u, int wr, int wc, int fr, int fq) const {
#pragma unroll
        for (int ai = 0; ai < 2; ++ai)
#pragma unroll
            for (int m = 0; m < 4; ++m) { const int t = EPI_ROW(u, ai, m); float sq = 0.f, sk = 0.f;
#pragma unroll
                for (int bj = 0; bj < 2; ++bj) { const int c8 = u.pn * 256 + bj * 128 + wc * 32 + 8 * fq; const int ht = u.pn * 2 + bj;
                    f32x4 v0 = acc[ai][bj][m][0], v1 = acc[ai][bj][m][1];
                    const float ss = (v0[0] * v0[0] + v0[1] * v0[1]) + (v0[2] * v0[2] + v0[3] * v0[3]) + (v1[0] * v1[0] + v1[1] * v1[1]) + (v1[2] * v1[2] + v1[3] * v1[3]);
                    if (ht < 3) { sq += ss; *(h8*)(cq + (size_t)t * 384 + c8) = pack8(v0, v1); }
                    else if (ht < 5) { sk += ss; *(h8*)(ckv + (size_t)t * 256 + (c8 - 384)) = pack8(v0, v1); }
                    else if (c8 < 704) { const int jj = c8 - 640, i0 = jj >> 1;
                        const f32x4 cs = *(const f32x4*)(cosm + (size_t)t * 32 + i0), sn = *(const f32x4*)(sinm + (size_t)t * 32 + i0); rope4(v0, v1, cs, sn);
                        const h8 o = pack8(v0, v1);
#pragma unroll
                        for (int h = 0; h < 8; ++h) *(h8*)(Kp + (size_t)t * 1536 + h * 192 + 128 + jj) = o; } }
                sq += __shfl_xor(sq, 16); sq += __shfl_xor(sq, 32); sk += __shfl_xor(sk, 16); sk += __shfl_xor(sk, 32);
                if (fq == 0) { if (u.pn < 2) pq[(size_t)t * 8 + u.pn * 4 + wc] = sq; if (u.pn >= 1) pkv[(size_t)t * 8 + (u.pn - 1) * 4 + wc] = sk; }
                asm volatile("" ::: "memory"); }
    }
};
__device__ __forceinline__ float row_rms_scale(const float* part, int t, float inv_n, float eps) {
    const f32x4 a = *(const f32x4*)(part + (size_t)t * 8), b = *(const f32x4*)(part + (size_t)t * 8 + 4);
    const float s = ((a[0] + a[1]) + (a[2] + a[3])) + ((b[0] + b[1]) + (b[2] + b[3]));
    return 1.0f / sqrtf(s * inv_n + eps);
}
struct EpiQNope {
    static constexpr bool PERM = true; f16* Q; const float* pq;
    __device__ __forceinline__ void operator()(const f32x4 (&acc)[2][2][4][2], const pg8::Unit& u, int wr, int wc, int fr, int fq) const {
#pragma unroll
        for (int ai = 0; ai < 2; ++ai)
#pragma unroll
            for (int m = 0; m < 4; ++m) { const int t = EPI_ROW(u, ai, m); const float rs = row_rms_scale(pq, t, 1.0f / 384.0f, LAT_EPS);
#pragma unroll
                for (int bj = 0; bj < 2; ++bj) { const int c8 = u.pn * 256 + bj * 128 + wc * 32 + 8 * fq;
                    *(h8*)(Q + (size_t)t * 1536 + (c8 >> 7) * 192 + (c8 & 127)) = pack8(acc[ai][bj][m][0] * rs, acc[ai][bj][m][1] * rs); }
                asm volatile("" ::: "memory"); }
    }
};
struct EpiQRope {
    static constexpr bool PERM = true; f16* Q; const float* cosm; const float* sinm; const float* pq;
    __device__ __forceinline__ void operator()(const f32x4 (&acc)[2][2][4][2], const pg8::Unit& u, int wr, int wc, int fr, int fq) const {
#pragma unroll
        for (int ai = 0; ai < 2; ++ai)
#pragma unroll
            for (int m = 0; m < 4; ++m) { const int t = EPI_ROW(u, ai, m); const float rs = row_rms_scale(pq, t, 1.0f / 384.0f, LAT_EPS);
#pragma unroll
                for (int bj = 0; bj < 2; ++bj) { const int cc = u.pn * 256 + bj * 128 + wc * 32 + 8 * fq; const int h = cc >> 6, jj = cc & 63, i0 = jj >> 1;
                    f32x4 v0 = acc[ai][bj][m][0] * rs, v1 = acc[ai][bj][m][1] * rs;
                    const f32x4 cs = *(const f32x4*)(cosm + (size_t)t * 32 + i0), sn = *(const f32x4*)(sinm + (size_t)t * 32 + i0); rope4(v0, v1, cs, sn);
                    *(h8*)(Q + (size_t)t * 1536 + h * 192 + 128 + jj) = pack8(v0, v1); }
                asm volatile("" ::: "memory"); }
    }
};
struct EpiKV {
    static constexpr bool PERM = true; f16* Kp; f16* Vp; const float* pkv;
    __device__ __forceinline__ void operator()(const f32x4 (&acc)[2][2][4][2], const pg8::Unit& u, int wr, int wc, int fr, int fq) const {
#pragma unroll
        for (int ai = 0; ai < 2; ++ai)
#pragma unroll
            for (int m = 0; m < 4; ++m) { const int t = EPI_ROW(u, ai, m); const float rs = row_rms_scale(pkv, t, 1.0f / 256.0f, LAT_EPS);
#pragma unroll
                for (int bj = 0; bj < 2; ++bj) { const int c8 = u.pn * 256 + bj * 128 + wc * 32 + 8 * fq; const int h = c8 >> 8, j = c8 & 255;
                    f16* dst = (j < 128) ? (Kp + (size_t)t * 1536 + h * 192 + j) : (Vp + (size_t)t * 1024 + h * 128 + (j - 128));
                    *(h8*)dst = pack8(acc[ai][bj][m][0] * rs, acc[ai][bj][m][1] * rs); }
                asm volatile("" ::: "memory"); }
    }
};
template <bool XF16> struct EpiPre {
    static constexpr bool PERM = true; const void* xres; const float* gmod; f16* pre;
    __device__ __forceinline__ void operator()(const f32x4 (&acc)[2][2][4][2], const pg8::Unit& u, int wr, int wc, int fr, int fq) const {
#pragma unroll
        for (int ai = 0; ai < 2; ++ai)
#pragma unroll
            for (int m = 0; m < 4; ++m) { const int t = EPI_ROW(u, ai, m); const int b = t >> 12;
#pragma unroll
                for (int bj = 0; bj < 2; ++bj) { const int c8 = u.pn * 256 + bj * 128 + wc * 32 + 8 * fq;
                    const f32x4 g0 = *(const f32x4*)(gmod + b * 6144 + c8), g1 = *(const f32x4*)(gmod + b * 6144 + c8 + 4); f32x4 x0, x1;
                    if constexpr (XF16) { const h8 xv = *(const h8*)((const f16*)xres + (size_t)t * 1024 + c8);
                        x0 = (f32x4){(float)xv[0], (float)xv[1], (float)xv[2], (float)xv[3]}; x1 = (f32x4){(float)xv[4], (float)xv[5], (float)xv[6], (float)xv[7]}; }
                    else { x0 = *(const f32x4*)((const float*)xres + (size_t)t * 1024 + c8); x1 = *(const f32x4*)((const float*)xres + (size_t)t * 1024 + c8 + 4); }
                    *(h8*)(pre + (size_t)t * 1024 + c8) = pack8(x0 * ALPHA + (g0 + 1.0f) * acc[ai][bj][m][0], x1 * ALPHA + (g1 + 1.0f) * acc[ai][bj][m][1]); }
                asm volatile("" ::: "memory"); }
    }
};
struct EpiUp {
    static constexpr bool PERM = true; f16* act;
    __device__ __forceinline__ void operator()(const f32x4 (&acc)[2][2][4][2], const pg8::Unit& u, int wr, int wc, int fr, int fq) const {
#pragma unroll
        for (int ai = 0; ai < 2; ++ai)
#pragma unroll
            for (int m = 0; m < 4; ++m) { const int r = EPI_ROW(u, ai, m);
#pragma unroll
                for (int bj = 0; bj < 2; ++bj) { const int c8 = u.pn * 256 + bj * 128 + wc * 32 + 8 * fq;
                    const f32x4 gq = acc[ai][bj][m][0], uq = acc[ai][bj][m][1]; h4 o;
#pragma unroll
                    for (int i = 0; i < 4; ++i) { const float gg = gq[i]; o[i] = (f16)(gg * __builtin_amdgcn_rcpf(1.0f + __expf(-gg)) * uq[i]); }
                    *(h4*)(act + (size_t)r * 2048 + (c8 >> 1)) = o; } }
    }
};
struct EpiDown {
    static constexpr bool PERM = true; f16* y; const float* gate;
    __device__ __forceinline__ void operator()(const f32x4 (&acc)[2][2][4][2], const pg8::Unit& u, int wr, int wc, int fr, int fq) const {
#pragma unroll
        for (int ai = 0; ai < 2; ++ai)
#pragma unroll
            for (int m = 0; m < 4; ++m) { const int r = EPI_ROW(u, ai, m); const float gt = gate[r];
#pragma unroll
                for (int bj = 0; bj < 2; ++bj) { const int c8 = u.pn * 256 + bj * 128 + wc * 32 + 8 * fq;
                    *(h8*)(y + (size_t)r * 1024 + c8) = pack8(acc[ai][bj][m][0] * gt, acc[ai][bj][m][1] * gt); }
                asm volatile("" ::: "memory"); }
    }
};
struct EpiDiffIn {
    static constexpr bool PERM = true; f16* qkv; const float* cosd; const float* sind;
    __device__ __forceinline__ void operator()(const f32x4 (&acc)[2][2][4][2], const pg8::Unit& u, int wr, int wc, int fr, int fq) const {
#pragma unroll
        for (int ai = 0; ai < 2; ++ai)
#pragma unroll
            for (int m = 0; m < 4; ++m) { const int t = EPI_ROW(u, ai, m);
#pragma unroll
                for (int bj = 0; bj < 2; ++bj) { const int c8 = u.pn * 256 + bj * 128 + wc * 32 + 8 * fq;
                    f32x4 v0 = acc[ai][bj][m][0], v1 = acc[ai][bj][m][1];
                    if (c8 < 2048 && (c8 & 63) < 16) { const int i0 = (c8 & 15) >> 1; const f32x4 cs = *(const f32x4*)(cosd + (size_t)t * 8 + i0), sn = *(const f32x4*)(sind + (size_t)t * 8 + i0); rope4(v0, v1, cs, sn); }
                    *(h8*)(qkv + (size_t)t * 3072 + c8) = pack8(v0, v1); }
                asm volatile("" ::: "memory"); }
    }
};

namespace att {
constexpr int QBLK = 32, KVBLK = 64, DV = 128;
constexpr float THR = 8.f;
constexpr size_t SHM_V = KVBLK * DV * 2;
#define SBAR() __builtin_amdgcn_sched_barrier(0)
__device__ __forceinline__ int crow(int r, int hi) { return (r & 3) + 8 * (r >> 2) + 4 * hi; }
__device__ __forceinline__ unsigned cvtpk(float lo, float hi) { unsigned r; asm volatile("v_cvt_pk_f16_f32 %0, %1, %2" : "=v"(r) : "v"(lo), "v"(hi)); return r; }
template <int DQK> struct Cfg {
    static constexpr int ND0 = DQK / 16, KRB = DQK * 2, NKCH = DQK / 64, KCPR = DQK / 8;
    static constexpr size_t SHM_K = (size_t)KVBLK * KRB;
    static constexpr float SCALE = DQK == 192 ? 0.07216878364870322f : 0.125f;
    static constexpr size_t SHM_TOTAL = 2 * SHM_V + 2 * SHM_K + NWAVES * 64 * 4;
};
template <int DQK> __device__ __forceinline__ void partialSM(f32x16& p0, f32x16& p1, float& m_reg, float& mn, float& alpha) {
    constexpr float SCALE = Cfg<DQK>::SCALE, C = SCALE * 1.4426950408889634f;
    float pmax = p0[0];
#pragma unroll
    for (int r = 1; r < 16; ++r) pmax = fmaxf(pmax, p0[r]);
#pragma unroll
    for (int r = 0; r < 16; ++r) pmax = fmaxf(pmax, p1[r]);
    { auto rr = __builtin_amdgcn_permlane32_swap(__float_as_uint(pmax), __float_as_uint(pmax), false, false);
      pmax = fmaxf(__uint_as_float(rr[0]), __uint_as_float(rr[1])); }
    if (__builtin_expect(__all(pmax - m_reg <= THR / SCALE), 1)) { mn = m_reg; alpha = 1.f; }
    else { mn = fmaxf(m_reg, pmax); alpha = __builtin_amdgcn_exp2f((m_reg - mn) * C); m_reg = mn; }
    const float mnC = -mn * C;
#pragma unroll
    for (int r = 0; r < 16; ++r) p0[r] = fmaf(p0[r], C, mnC);
#pragma unroll
    for (int r = 0; r < 16; ++r) p1[r] = fmaf(p1[r], C, mnC);
#pragma unroll
    for (int r = 0; r < 16; ++r) p0[r] = __builtin_amdgcn_exp2f(p0[r]);
}
__device__ __forceinline__ void finishSM(f32x16& p0, f32x16& p1, float alpha, float& l_reg, h8& pa0, h8& pa1, h8& pa2, h8& pa3) {
#pragma unroll
    for (int r = 0; r < 16; ++r) p1[r] = __builtin_amdgcn_exp2f(p1[r]);
    float ps = 0;
#pragma unroll
    for (int r = 0; r < 16; ++r) ps += p0[r];
#pragma unroll
    for (int r = 0; r < 16; ++r) ps += p1[r];
    { auto rr = __builtin_amdgcn_permlane32_swap(__float_as_uint(ps), __float_as_uint(ps), false, false);
      ps = __uint_as_float(rr[0]) + __uint_as_float(rr[1]); }
    l_reg = l_reg * alpha + ps;
#define PK4(P, BASE, OUT) do { unsigned a0 = cvtpk(P[BASE + 0], P[BASE + 1]), a1 = cvtpk(P[BASE + 2], P[BASE + 3]);   \
    unsigned b0 = cvtpk(P[BASE + 4], P[BASE + 5]), b1 = cvtpk(P[BASE + 6], P[BASE + 7]);                              \
    auto r0 = __builtin_amdgcn_permlane32_swap(a0, b0, false, false); auto r1 = __builtin_amdgcn_permlane32_swap(a1, b1, false, false); \
    u32x4 w = {r0[0], r1[0], r0[1], r1[1]}; OUT = *reinterpret_cast<h8*>(&w); } while (0)
    PK4(p0, 0, pa0); PK4(p0, 8, pa1); PK4(p1, 0, pa2); PK4(p1, 8, pa3);
#undef PK4
}
#define KSWZ(row, colB) ((row) * KRB + ((colB) ^ (((row) & 7) << 4)))
template <int DQK> __device__ __forceinline__ void qkt(f32x16& p0, f32x16& p1, const char* Ks, const h8* qr, int r32, int hi) {
    constexpr int KRB = Cfg<DQK>::KRB;
    p0 = f32x16{}; p1 = f32x16{};
#pragma unroll
    for (int d0 = 0; d0 < Cfg<DQK>::ND0; ++d0) { const int cb = (d0 * 16 + hi * 8) * 2;
        const h8 b0 = *reinterpret_cast<const h8*>(Ks + KSWZ(r32, cb));
        const h8 b1 = *reinterpret_cast<const h8*>(Ks + KSWZ(32 + r32, cb));
        p0 = __builtin_amdgcn_mfma_f32_32x32x16_f16(b0, qr[d0], p0, 0, 0, 0);
        p1 = __builtin_amdgcn_mfma_f32_32x32x16_f16(b1, qr[d0], p1, 0, 0, 0); }
}
template <int OFF> __device__ __forceinline__ h8 lds_read128(int addr) { h8 r; asm volatile("ds_read_b128 %0, %1 offset:%2" : "=&v"(r) : "v"(addr), "i"(OFF) : "memory"); return r; }
template <int N> __device__ __forceinline__ void lgkm_wait() { asm volatile("s_waitcnt lgkmcnt(%0)" :: "i"(N) : "memory"); }
template <int DQK, int W, int I> struct QkStep {
    static constexpr int NF = 2 * Cfg<DQK>::ND0, KRB = Cfg<DQK>::KRB;
    static constexpr int koff(int i) { return ((i >> 1) >> 2) * 128 + (i & 1) * 32 * KRB; }
    static __device__ __forceinline__ void issue(h8 (&kf)[W], const int (&ka)[4]) { if constexpr (I < NF) kf[I % W] = lds_read128<koff(I)>(ka[(I >> 1) & 3]); }
    static __device__ __forceinline__ void run(h8 (&kf)[W], f32x16& p0, f32x16& p1, const h8* qr, const int (&ka)[4]) {
        if constexpr (I < NF) {
            constexpr int OUT = (NF - 1 - I) < (W - 1) ? (NF - 1 - I) : (W - 1);
            lgkm_wait<OUT>(); SBAR();
            if constexpr ((I & 1) == 0) p0 = __builtin_amdgcn_mfma_f32_32x32x16_f16(kf[I % W], qr[I >> 1], p0, 0, 0, 0);
            else p1 = __builtin_amdgcn_mfma_f32_32x32x16_f16(kf[I % W], qr[I >> 1], p1, 0, 0, 0);
            SBAR();
            QkStep<DQK, W, I + W>::issue(kf, ka);
            QkStep<DQK, W, I + 1>::run(kf, p0, p1, qr, ka);
        }
    }
};
template <int DQK, int W, int I> struct QkPrime { static __device__ __forceinline__ void run(h8 (&kf)[W], const int (&ka)[4]) { if constexpr (I < W && I < 2 * Cfg<DQK>::ND0) { QkStep<DQK, W, I>::issue(kf, ka); QkPrime<DQK, W, I + 1>::run(kf, ka); } } };
template <int DQK, int W> __device__ __forceinline__ void qkt_pipe(f32x16& p0, f32x16& p1, int kbase, const h8* qr, int r32, int hi) {
    constexpr int KRB = Cfg<DQK>::KRB;
    int ka[4];
#pragma unroll
    for (int q = 0; q < 4; ++q) ka[q] = kbase + r32 * KRB + ((q * 32 + hi * 16) ^ ((r32 & 7) << 4));
    p0 = f32x16{}; p1 = f32x16{};
    h8 kf[W];
    QkPrime<DQK, W, 0>::run(kf, ka);
    QkStep<DQK, W, 0>::run(kf, p0, p1, qr, ka);
}
__device__ __forceinline__ int v_st(int k, int c) { const int kk = (k & ~0xC) | ((k & 4) << 1) | ((k & 8) >> 1); return ((kk >> 3) * 4 + (c >> 5)) * 512 + ((kk & 7) * 32 + (c & 31)) * 2; }
__device__ __forceinline__ int v_rd_base(int lane) { return ((lane & 3) << 3) | (((lane >> 2) & 3) << 6) | (((lane >> 4) & 1) << 5) | (((lane >> 5) & 1) << 8); }
constexpr int v_rd_off(int d0, int ks, int half) { return d0 * 512 + ks * 4096 + half * 2048; }
template <int OFF> __device__ __forceinline__ s16x4 tr_read(int vb) {
    s16x4 r; asm volatile("ds_read_b64_tr_b16 %0, %1 offset:%2" : "=&v"(r) : "v"(vb), "i"(OFF) : "memory"); return r;
}
template <int D0> __device__ __forceinline__ void pv_one(f32x16& od, int vb, h8 pa0, h8 pa1, h8 pa2, h8 pa3) {
    const s16x4 l0 = tr_read<v_rd_off(D0, 0, 0)>(vb), h0 = tr_read<v_rd_off(D0, 0, 1)>(vb), l1 = tr_read<v_rd_off(D0, 1, 0)>(vb), h1 = tr_read<v_rd_off(D0, 1, 1)>(vb);
    const s16x4 l2 = tr_read<v_rd_off(D0, 2, 0)>(vb), h2_ = tr_read<v_rd_off(D0, 2, 1)>(vb), l3 = tr_read<v_rd_off(D0, 3, 0)>(vb), h3 = tr_read<v_rd_off(D0, 3, 1)>(vb);
    asm volatile("s_waitcnt lgkmcnt(0)" ::: "memory"); SBAR();
#define PKV(L, H) __builtin_bit_cast(h8, (__attribute__((ext_vector_type(8))) short){L[0], L[1], L[2], L[3], H[0], H[1], H[2], H[3]})
    od = __builtin_amdgcn_mfma_f32_32x32x16_f16(pa0, PKV(l0, h0), od, 0, 0, 0);
    od = __builtin_amdgcn_mfma_f32_32x32x16_f16(pa1, PKV(l1, h1), od, 0, 0, 0);
    od = __builtin_amdgcn_mfma_f32_32x32x16_f16(pa2, PKV(l2, h2_), od, 0, 0, 0);
    od = __builtin_amdgcn_mfma_f32_32x32x16_f16(pa3, PKV(l3, h3), od, 0, 0, 0);
#undef PKV
}
struct VFrag { s16x4 l0, h0, l1, h1, l2, h2, l3, h3; };
template <int D0> __device__ __forceinline__ void v_read8(VFrag& f, int vb) {
    f.l0 = tr_read<v_rd_off(D0, 0, 0)>(vb); f.h0 = tr_read<v_rd_off(D0, 0, 1)>(vb); f.l1 = tr_read<v_rd_off(D0, 1, 0)>(vb); f.h1 = tr_read<v_rd_off(D0, 1, 1)>(vb);
    f.l2 = tr_read<v_rd_off(D0, 2, 0)>(vb); f.h2 = tr_read<v_rd_off(D0, 2, 1)>(vb); f.l3 = tr_read<v_rd_off(D0, 3, 0)>(vb); f.h3 = tr_read<v_rd_off(D0, 3, 1)>(vb);
}
__device__ __forceinline__ void pv_mma4(f32x16& od, const VFrag& f, h8 pa0, h8 pa1, h8 pa2, h8 pa3) {
#define PKV(L, H) __builtin_bit_cast(h8, (__attribute__((ext_vector_type(8))) short){L[0], L[1], L[2], L[3], H[0], H[1], H[2], H[3]})
    od = __builtin_amdgcn_mfma_f32_32x32x16_f16(pa0, PKV(f.l0, f.h0), od, 0, 0, 0);
    od = __builtin_amdgcn_mfma_f32_32x32x16_f16(pa1, PKV(f.l1, f.h1), od, 0, 0, 0);
    od = __builtin_amdgcn_mfma_f32_32x32x16_f16(pa2, PKV(f.l2, f.h2), od, 0, 0, 0);
    od = __builtin_amdgcn_mfma_f32_32x32x16_f16(pa3, PKV(f.l3, f.h3), od, 0, 0, 0);
#undef PKV
}
__device__ __forceinline__ void pv_d0(f32x16* o, int vb, h8 pa0, h8 pa1, h8 pa2, h8 pa3) {
    VFrag A, B;
    v_read8<0>(A, vb); v_read8<1>(B, vb);
    asm volatile("s_waitcnt lgkmcnt(8)" ::: "memory"); SBAR(); pv_mma4(o[0], A, pa0, pa1, pa2, pa3); SBAR();
    v_read8<2>(A, vb);
    asm volatile("s_waitcnt lgkmcnt(8)" ::: "memory"); SBAR(); pv_mma4(o[1], B, pa0, pa1, pa2, pa3); SBAR();
    v_read8<3>(B, vb);
    asm volatile("s_waitcnt lgkmcnt(8)" ::: "memory"); SBAR(); pv_mma4(o[2], A, pa0, pa1, pa2, pa3); SBAR();
    asm volatile("s_waitcnt lgkmcnt(0)" ::: "memory"); SBAR(); pv_mma4(o[3], B, pa0, pa1, pa2, pa3);
}
template <int LDO>
__device__ __forceinline__ void attn_epilogue(f32x16 (&o)[4], const float (&rli)[16], f16* Ow, int mode, float lam, const float* subln, int r32, int hi) {
    if (mode == 0) {
#pragma unroll
        for (int r = 0; r < 16; ++r) { const int orow = crow(r, hi);
#pragma unroll
            for (int d0 = 0; d0 < 4; ++d0) Ow[(long)orow * LDO + d0 * 32 + r32] = (f16)(o[d0][r] * rli[r]); }
    } else {
        float sl[4];
#pragma unroll
        for (int d0 = 0; d0 < 4; ++d0) sl[d0] = subln[d0 * 32 + r32] * (1.0f - LAMBDA_INIT);
        f16 t0[4][16];
#pragma unroll
        for (int r = 0; r < 16; ++r) { const int orow = crow(r, hi);
#pragma unroll
            for (int d0 = 0; d0 < 4; ++d0) t0[d0][r] = Ow[(long)orow * LDO + d0 * 32 + r32]; }
        asm volatile("s_waitcnt vmcnt(0)" ::: "memory");
#pragma unroll
        for (int r = 0; r < 16; ++r) { const int orow = crow(r, hi); float ss = 0.f;
#pragma unroll
            for (int d0 = 0; d0 < 4; ++d0) { const float x = (float)t0[d0][r] - lam * (o[d0][r] * rli[r]); o[d0][r] = x; ss += x * x; }
            ss += __shfl_xor(ss, 1); ss += __shfl_xor(ss, 2); ss += __shfl_xor(ss, 4); ss += __shfl_xor(ss, 8); ss += __shfl_xor(ss, 16);
            const float rs = 1.0f / sqrtf(ss * (1.0f / 128.0f) + LN_EPS);
#pragma unroll
            for (int d0 = 0; d0 < 4; ++d0) Ow[(long)orow * LDO + d0 * 32 + r32] = (f16)(o[d0][r] * rs * sl[d0]); }
    }
}
template <int DQK, int LDQ, int LDK, int LDV, int LDO, int SDEPTH>
__device__ __forceinline__ void attn_body(const f16* Qb, const f16* Kh, const f16* Vh, f16* Ob, char* lds, int mode = 0, float lam = 0.f, const float* subln = nullptr) {
    using C = Cfg<DQK>;
    constexpr int KRB = C::KRB, ND0 = C::ND0, NKCH = C::NKCH, KCPR = C::KCPR; constexpr size_t SHM_K = C::SHM_K;
    constexpr int seq = SEQ;
    int tid = threadIdx.x; asm volatile("" : "+v"(tid));
    const int wid = tid >> 6, lane = tid & 63, r32 = lane & 31, hi = lane >> 5;
    char* V_lds = lds; char* K_lds = lds + 2 * SHM_V;
    float* wsl = (float*)(lds + 2 * SHM_V + 2 * SHM_K) + wid * 64; float* li_l = wsl; float* al_l = wsl + 32;
    float m_reg = -1e30f, l_reg = 0; f32x16 o[4] = {}; h8 qr[ND0];
    const f16* Qw = Qb + (long)(wid * QBLK + r32) * LDQ + hi * 8;
#pragma unroll
    for (int d0 = 0; d0 < ND0; ++d0) qr[d0] = *reinterpret_cast<const h8*>(Qw + d0 * 16);
    const int sr = tid >> 4, sc = (tid & 15) * 8, vst0 = v_st(sr, sc), vst1 = v_st(32 + sr, sc);
    int krow[NKCH], kcb[NKCH];
#pragma unroll
    for (int i = 0; i < NKCH; ++i) { const int c = tid + i * 512; krow[i] = c / KCPR; kcb[i] = (c % KCPR) * 16; }
    const int vb0 = (int)(uintptr_t)V_lds + v_rd_base(lane);
    struct { h8 vs0, vs1; h8 ks[NKCH]; } sr_[SDEPTH];
#define SLOAD(i, k0) do { sr_[i].vs0 = *reinterpret_cast<const h8*>(&Vh[(long)((k0) + sr) * LDV + sc]); sr_[i].vs1 = *reinterpret_cast<const h8*>(&Vh[(long)((k0) + 32 + sr) * LDV + sc]); \
    _Pragma("unroll") for (int _c = 0; _c < NKCH; ++_c) sr_[i].ks[_c] = *reinterpret_cast<const h8*>((const char*)Kh + (long)((k0) + krow[_c]) * (LDK * 2) + kcb[_c]); } while (0)
#define SWRITE(b, i) do { *(h8*)(V_lds + (b) * SHM_V + vst0) = sr_[i].vs0; *(h8*)(V_lds + (b) * SHM_V + vst1) = sr_[i].vs1; \
    _Pragma("unroll") for (int _c = 0; _c < NKCH; ++_c) *(h8*)(K_lds + (b) * SHM_K + KSWZ(krow[_c], kcb[_c])) = sr_[i].ks[_c]; } while (0)
#define SWAIT() do { if constexpr (SDEPTH == 2) { if constexpr (NKCH == 3) asm volatile("s_waitcnt vmcnt(5)" ::: "memory"); else asm volatile("s_waitcnt vmcnt(3)" ::: "memory"); } \
    else asm volatile("s_waitcnt vmcnt(0)" ::: "memory"); } while (0)
#define RESC(a) do { if (__any((a) < 1.f)) { if (hi == 0) al_l[r32] = (a); asm volatile("s_waitcnt lgkmcnt(0)" ::: "memory"); \
    _Pragma("unroll") for (int d = 0; d < 4; ++d) _Pragma("unroll") for (int r = 0; r < 16; ++r) o[d][r] *= al_l[crow(r, hi)]; } } while (0)
    f32x16 pA0, pA1, pB0, pB1; float mnA, mnB, alA, alB; h8 pa0, pa1, pa2, pa3; constexpr int NT = seq / KVBLK;
    constexpr int SE = 0, SO = SDEPTH - 1;
    SLOAD(SE, 0); asm volatile("s_waitcnt vmcnt(0)" ::: "memory"); SWRITE(0, SE); __syncthreads();
    qkt<DQK>(pA0, pA1, K_lds, qr, r32, hi); partialSM<DQK>(pA0, pA1, m_reg, mnA, alA);
    SLOAD(SO, KVBLK); if constexpr (SDEPTH == 2) { if (2 < NT) SLOAD(SE, 2 * KVBLK); }
    SWAIT(); SWRITE(1, SO); __syncthreads();
    for (int j = 1; j + 1 < NT; j += 2) {
        SBAR(); qkt<DQK>(pB0, pB1, K_lds + SHM_K, qr, r32, hi);
        finishSM(pA0, pA1, alA, l_reg, pa0, pa1, pa2, pa3); SBAR();
        SLOAD(SO, (j + SDEPTH) * KVBLK); SBAR();
        pv_d0(o, vb0, pa0, pa1, pa2, pa3); partialSM<DQK>(pB0, pB1, m_reg, mnB, alB);
        __syncthreads(); SWAIT(); SWRITE(0, SE);
        RESC(alB); __syncthreads();
        SBAR(); qkt<DQK>(pA0, pA1, K_lds, qr, r32, hi);
        finishSM(pB0, pB1, alB, l_reg, pa0, pa1, pa2, pa3); SBAR();
        if (SDEPTH == 1 || j + 3 < NT) SLOAD(SE, (j + 1 + SDEPTH) * KVBLK); SBAR();
        pv_d0(o, vb0 + (int)SHM_V, pa0, pa1, pa2, pa3); partialSM<DQK>(pA0, pA1, m_reg, mnA, alA);
        __syncthreads(); SWAIT(); SWRITE(1, SO);
        RESC(alA); __syncthreads();
    }
    SBAR(); qkt<DQK>(pB0, pB1, K_lds + SHM_K, qr, r32, hi);
    finishSM(pA0, pA1, alA, l_reg, pa0, pa1, pa2, pa3); SBAR();
    pv_d0(o, vb0, pa0, pa1, pa2, pa3); partialSM<DQK>(pB0, pB1, m_reg, mnB, alB);
    __syncthreads(); RESC(alB);
    finishSM(pB0, pB1, alB, l_reg, pa0, pa1, pa2, pa3); SBAR();
    pv_d0(o, vb0 + (int)SHM_V, pa0, pa1, pa2, pa3);
    if (hi == 0) li_l[r32] = l_reg; asm volatile("s_waitcnt lgkmcnt(0)" ::: "memory");
    float rli[16];
#pragma unroll
    for (int r = 0; r < 16; ++r) rli[r] = __builtin_amdgcn_rcpf(li_l[crow(r, hi)]);
    attn_epilogue<LDO>(o, rli, Ob + (long)(wid * QBLK) * LDO, mode, lam, subln, r32, hi);
    asm volatile("s_waitcnt vmcnt(0) lgkmcnt(0)" ::: "memory");
    __syncthreads();
#undef SLOAD
#undef SWRITE
#undef SWAIT
#undef RESC
}

struct ConvStream {
    const float* win; const float* wout; f16* tin; f16* tout;
    int step, step_end, it, period;
    unsigned d[8]; f16* pend;
    char* acc; f16* dst0; int nacc;
};
constexpr int CONV_STEPS_IN = 16 * 64 * 128, CONV_STEPS_OUT = 16 * 16 * 256, CONV_STEPS = CONV_STEPS_IN + CONV_STEPS_OUT;
__device__ __forceinline__ void conv_drain(ConvStream& c, int lane) {
    if (c.nacc > 0) {
        asm volatile("s_waitcnt lgkmcnt(0)" ::: "memory");
        for (int q = 0; q < c.nacc; ++q) { const h8 v = *(const h8*)(c.acc + q * 1024 + lane * 16); *(h8*)(c.dst0 + q * 8) = v; }
        c.nacc = 0; }
}
__device__ __forceinline__ void conv_flush(ConvStream& c, int lane) {
    if (c.pend) { h8 o;
#pragma unroll
        for (int i = 0; i < 8; ++i) o[i] = (f16)__uint_as_float(c.d[i]);
        if (c.nacc == 0) c.dst0 = c.pend;
        *(h8*)(c.acc + c.nacc * 1024 + lane * 16) = o; ++c.nacc; c.pend = nullptr;
        if (c.nacc == 4) conv_drain(c, lane); }
}
__device__ __forceinline__ void conv_tick(ConvStream& c, int lane) {
    const bool go = ((c.it & (c.period - 1)) < 3) && (c.step < c.step_end); ++c.it;
    if (go) { const int s = c.step++;
        const float* src; f16* dst; int N;
        if (s < CONV_STEPS_IN) { const int strip = s >> 7, kb = s & 127, e = strip >> 6, n = (strip & 63) * 64 + lane; const int f = n & 2047, dr = (f >> 2) * 8 + (f & 3) + ((n >> 11) << 2);
            src = c.win + ((size_t)e * 1024 + kb * 8) * 4096 + n; dst = c.tin + ((size_t)e * 4096 + dr) * 1024 + kb * 8; N = 4096; }
        else { const int s2 = s - CONV_STEPS_IN; const int strip = s2 >> 8, kb = s2 & 255, e = strip >> 4, n = (strip & 15) * 64 + lane;
            src = c.wout + ((size_t)e * 2048 + kb * 8) * 1024 + n; dst = c.tout + ((size_t)e * 1024 + n) * 2048 + kb * 8; N = 1024; }
        if ((s & 3) == 0) conv_drain(c, lane);
#pragma unroll
        for (int i = 0; i < 8; ++i) c.d[i] = __float_as_uint(src[(size_t)i * N]);
        c.pend = dst; }
}
__device__ __forceinline__ void conv_init(ConvStream& cs, const float* win, const float* wout, f16* tin, f16* tout, int l, int gw, int NGW, int period, char* acc) {
    cs.acc = acc; cs.nacc = 0; cs.dst0 = nullptr;
    cs.win = win + (size_t)l * NE * 1024 * 4096; cs.wout = wout + (size_t)l * NE * 2048 * 1024; cs.tin = tin + (size_t)l * NE * 4096 * 1024; cs.tout = tout + (size_t)l * NE * 1024 * 2048;
    const int per = ((CONV_STEPS + NGW - 1) / NGW + 7) & ~7;
    cs.step = gw * per < CONV_STEPS ? gw * per : CONV_STEPS; cs.step_end = (gw + 1) * per < CONV_STEPS ? (gw + 1) * per : CONV_STEPS; cs.it = 0; cs.pend = nullptr; cs.period = period;
}
template <int DQK, int LDQ, int LDK, int LDV, int LDO, bool CONV = false, bool GLDS = false>
__device__ __forceinline__ void attn_body_simple(const f16* Qb, const f16* Kh, const f16* Vh, f16* Ob, char* lds, int mode = 0, float lam = 0.f, const float* subln = nullptr, ConvStream* cs = nullptr) {
    using C = Cfg<DQK>;
    constexpr int KRB = C::KRB, ND0 = C::ND0, NKCH = C::NKCH, KCPR = C::KCPR; constexpr size_t SHM_K = C::SHM_K;
    int tid = threadIdx.x; asm volatile("" : "+v"(tid));
    const int wid = tid >> 6, lane = tid & 63, r32 = lane & 31, hi = lane >> 5;
    char* V_lds = lds; char* K_lds = lds + 2 * SHM_V;
    float* wsl = (float*)(lds + 2 * SHM_V + 2 * SHM_K) + wid * 64; float* li_l = wsl; float* al_l = wsl + 32;
    float m_reg = -1e30f, l_reg = 0; f32x16 o[4] = {}; h8 qr[ND0];
    const f16* Qw = Qb + (long)(wid * QBLK + r32) * LDQ + hi * 8;
#pragma unroll
    for (int d0 = 0; d0 < ND0; ++d0) qr[d0] = *reinterpret_cast<const h8*>(Qw + d0 * 16);
    const int sr = tid >> 4, sc = (tid & 15) * 8, vst0 = v_st(sr, sc), vst1 = v_st(32 + sr, sc);
    int krow[NKCH], kcb[NKCH];
#pragma unroll
    for (int i = 0; i < NKCH; ++i) { const int c = tid + i * 512; krow[i] = c / KCPR; kcb[i] = (c % KCPR) * 16; }
    const int vb0 = (int)(uintptr_t)V_lds + v_rd_base(lane);
    h8 vs0, vs1, ks[NKCH];
    unsigned gvoff[2], gkoff[NKCH]; const int wuni = __builtin_amdgcn_readfirstlane(wid);
    if constexpr (GLDS) {
#pragma unroll
        for (int i = 0; i < 2; ++i) { const int p = i * 512 + tid; const int kk = ((p >> 7) & 7) * 8 + ((p >> 2) & 7), c = ((p >> 5) & 3) * 32 + (p & 3) * 8;
            const int k = (kk & ~0xC) | ((kk & 4) << 1) | ((kk & 8) >> 1); gvoff[i] = (unsigned)(k * LDV + c) * 2u; }
#pragma unroll
        for (int i = 0; i < NKCH; ++i) { const int p = i * 512 + tid; const int row = p / KCPR, cp = p % KCPR; const int cs_ = (cp & ~7) | ((cp & 7) ^ (row & 7));
            gkoff[i] = (unsigned)(row * LDK + cs_ * 8) * 2u; }
    }
#define GSTAGE(b, k0) do { _Pragma("unroll") for (int _i = 0; _i < 2; ++_i) __builtin_amdgcn_global_load_lds((const unsigned*)((const char*)Vh + (size_t)(k0) * (LDV * 2) + gvoff[_i]), \
        (LAS unsigned*)(uintptr_t)(unsigned)((int)(uintptr_t)V_lds + (b) * (int)SHM_V + (_i * 512 + wuni * 64) * 16), 16, 0, 0); \
    _Pragma("unroll") for (int _i = 0; _i < NKCH; ++_i) __builtin_amdgcn_global_load_lds((const unsigned*)((const char*)Kh + (size_t)(k0) * (LDK * 2) + gkoff[_i]), \
        (LAS unsigned*)(uintptr_t)(unsigned)((int)(uintptr_t)K_lds + (b) * (int)SHM_K + (_i * 512 + wuni * 64) * 16), 16, 0, 0); } while (0)
#define SLOAD1(k0) do { vs0 = *reinterpret_cast<const h8*>(&Vh[(long)((k0) + sr) * LDV + sc]); vs1 = *reinterpret_cast<const h8*>(&Vh[(long)((k0) + 32 + sr) * LDV + sc]); \
    _Pragma("unroll") for (int _c = 0; _c < NKCH; ++_c) ks[_c] = *reinterpret_cast<const h8*>((const char*)Kh + (long)((k0) + krow[_c]) * (LDK * 2) + kcb[_c]); } while (0)
#define SWRITE1(b) do { *(h8*)(V_lds + (b) * SHM_V + vst0) = vs0; *(h8*)(V_lds + (b) * SHM_V + vst1) = vs1; \
    _Pragma("unroll") for (int _c = 0; _c < NKCH; ++_c) *(h8*)(K_lds + (b) * SHM_K + KSWZ(krow[_c], kcb[_c])) = ks[_c]; } while (0)
    constexpr int NT = SEQ / KVBLK;
    if constexpr (GLDS) { GSTAGE(0, 0); asm volatile("s_waitcnt vmcnt(0)" ::: "memory"); __syncthreads(); }
    else { SLOAD1(0); asm volatile("s_waitcnt vmcnt(0)" ::: "memory"); SWRITE1(0); __syncthreads(); }
#pragma unroll 1
    for (int j = 0; j < NT; ++j) {
        const int cb = j & 1;
        if constexpr (CONV) conv_tick(*cs, lane);
        if constexpr (GLDS) { if (j + 1 < NT) GSTAGE(cb ^ 1, (j + 1) * KVBLK); } else { if (j + 1 < NT) SLOAD1((j + 1) * KVBLK); }
        SBAR();
        f32x16 p0, p1; float mn, al; h8 pa0, pa1, pa2, pa3;
        qkt_pipe<DQK, (DQK == 192 ? 6 : 8)>(p0, p1, (int)(uintptr_t)K_lds + cb * (int)SHM_K, qr, r32, hi);
        partialSM<DQK>(p0, p1, m_reg, mn, al);
        if (__any(al < 1.f)) { if (hi == 0) al_l[r32] = al; asm volatile("s_waitcnt lgkmcnt(0)" ::: "memory");
#pragma unroll
            for (int d = 0; d < 4; ++d)
#pragma unroll
                for (int r = 0; r < 16; ++r) o[d][r] *= al_l[crow(r, hi)]; }
        finishSM(p0, p1, al, l_reg, pa0, pa1, pa2, pa3); SBAR();
        pv_d0(o, vb0 + cb * (int)SHM_V, pa0, pa1, pa2, pa3);
        if constexpr (GLDS) { asm volatile("s_waitcnt vmcnt(0)" ::: "memory"); } else { if (j + 1 < NT) { SWRITE1(cb ^ 1); } }
        if constexpr (CONV) conv_flush(*cs, lane);
        __syncthreads();
    }
    if (hi == 0) li_l[r32] = l_reg; asm volatile("s_waitcnt lgkmcnt(0)" ::: "memory");
    float rli[16];
#pragma unroll
    for (int r = 0; r < 16; ++r) rli[r] = __builtin_amdgcn_rcpf(li_l[crow(r, hi)]);
    attn_epilogue<LDO>(o, rli, Ob + (long)(wid * QBLK) * LDO, mode, lam, subln, r32, hi);
    asm volatile("s_waitcnt vmcnt(0) lgkmcnt(0)" ::: "memory");
    __syncthreads();
#undef SLOAD1
#undef SWRITE1
#undef GSTAGE
}
#undef KSWZ
#undef SBAR
}

struct Args { const void* in[22]; float* out; unsigned char* ws; int ph_lo, ph_hi, li, pad; };
typedef const __attribute__((address_space(4))) Args* KArgs;
__device__ __forceinline__ KArgs kargs() { KArgs p = (KArgs)__builtin_amdgcn_kernarg_segment_ptr(); asm volatile("" : "+s"(p)); return p; }
struct Frame {
    LAS unsigned char* lds; char* ldsg;
    int tid, lane, wave, vcu, G;
    unsigned char* ws;
};
extern __shared__ __attribute__((aligned(16))) unsigned char g_lds[];
__device__ __forceinline__ Frame mkframe(KArgs a) {
    Frame F; int t = threadIdx.x; asm volatile("" : "+v"(t));
    F.lds = (LAS unsigned char*)g_lds; F.ldsg = (char*)g_lds;
    F.tid = t; F.lane = t & 63; F.wave = __builtin_amdgcn_readfirstlane(t >> 6);
    int g = gridDim.x, bx = blockIdx.x; asm volatile("" : "+s"(g), "+s"(bx));
    F.G = g; F.vcu = (g % 8 == 0) ? (bx % 8) * (g / 8) + bx / 8 : bx;
    F.ws = a->ws;
    return F;
}

__device__ __forceinline__ void sincos_d(double a, float& s, float& c) {
    const double k = __builtin_rint(a * 0.63661977236758134308);
    double r = __builtin_fma(-k, 1.57079632679489655800e+00, a); r = __builtin_fma(-k, 6.12323399573676603587e-17, r);
    const double r2 = r * r;
    double sp = -7.6471637318198164759e-13;
    sp = __builtin_fma(sp, r2, 1.6059043836821614599e-10);
    sp = __builtin_fma(sp, r2, -2.5052108385441718775e-08);
    sp = __builtin_fma(sp, r2, 2.7557319223985890653e-06);
    sp = __builtin_fma(sp, r2, -1.9841269841269841270e-04);
    sp = __builtin_fma(sp, r2, 8.3333333333333333333e-03);
    sp = __builtin_fma(sp, r2, -1.6666666666666666667e-01);
    const double sr = __builtin_fma(sp * r2, r, r);
    double cp = 4.7794773323873852974e-14;
    cp = __builtin_fma(cp, r2, -1.1470745597729724714e-11);
    cp = __builtin_fma(cp, r2, 2.0876756987868098979e-09);
    cp = __builtin_fma(cp, r2, -2.7557319223985890653e-07);
    cp = __builtin_fma(cp, r2, 2.4801587301587301587e-05);
    cp = __builtin_fma(cp, r2, -1.3888888888888888889e-03);
    cp = __builtin_fma(cp, r2, 4.1666666666666666667e-02);
    cp = __builtin_fma(cp, r2, -0.5);
    const double cr = __builtin_fma(cp, r2, 1.0);
    const int q = (int)((long long)k & 3);
    const double ss = (q & 1) ? cr : sr, cc = (q & 1) ? sr : cr;
    s = (float)((q & 2) ? -ss : ss); c = (float)(((q + 1) & 2) ? -cc : cc);
}
__device__ const double INV_M[32] = {
    1.0, 0.7498942093324559, 0.5623413251903491, 0.4216965034285822, 0.31622776601683794, 0.23713737056616552, 0.1778279410038923, 0.1333521432163324,
    0.1, 0.07498942093324558, 0.05623413251903491, 0.04216965034285822, 0.03162277660168379, 0.023713737056616554, 0.01778279410038923, 0.01333521432163324,
    0.01, 0.007498942093324559, 0.005623413251903491, 0.004216965034285822, 0.0031622776601683794, 0.0023713737056616554, 0.001778279410038923, 0.001333521432163324,
    0.001, 0.0007498942093324559, 0.0005623413251903491, 0.0004216965034285822, 0.00031622776601683794, 0.00023713737056616554, 0.0001778279410038923, 0.0001333521432163324 };
__device__ const double INV_D[8] = { 1.0, 0.19392274474868576, 0.03760603093086393, 0.007292664737217109, 0.001414213562373095, 0.0002742481756762073, 5.318295896944988e-05, 1.031338537721246e-05 };

template <class FD>
__device__ __forceinline__ void tr_item64(const float* W, int Nsrc, int K, f16* WT, FD dstrow, LAS float* scr, int kb, int cb, int lane, const float* kscale = nullptr) {
    const int k0 = 64 * kb, c0 = 64 * cb, r4 = lane >> 4, cq = (lane & 15) * 4;
    f32x4 v[16];
#pragma unroll
    for (int i = 0; i < 16; ++i) v[i] = *(const f32x4*)(W + (size_t)(k0 + 4 * i + r4) * Nsrc + c0 + cq);
    if (kscale) {
#pragma unroll
        for (int i = 0; i < 16; ++i) v[i] = v[i] * kscale[k0 + 4 * i + r4]; }
#pragma unroll
    for (int i = 0; i < 16; ++i) { const int k = 4 * i + r4, sw = (i >> 1) * 4;
#pragma unroll
        for (int w = 0; w < 4; ++w) scr[k * 64 + ((cq + w) ^ sw)] = v[i][w]; }
    LDS_WAIT(); asm volatile("" ::: "memory");
    const int c = lane & 7;
#pragma unroll
    for (int j = 0; j < 8; ++j) { const int col = (lane >> 3) + 8 * j; const int dr = dstrow(c0 + col); const LAS float* sp = scr + (8 * c) * 64 + (col ^ (c * 4));
        h8 o; o[0] = (f16)sp[0 * 64]; o[1] = (f16)sp[1 * 64]; o[2] = (f16)sp[2 * 64]; o[3] = (f16)sp[3 * 64]; o[4] = (f16)sp[4 * 64]; o[5] = (f16)sp[5 * 64]; o[6] = (f16)sp[6 * 64]; o[7] = (f16)sp[7 * 64];
        *(h8*)(WT + (size_t)dr * K + k0 + 8 * c) = o; }
    LDS_WAIT(); asm volatile("" ::: "memory");
}
struct RowId { __device__ __forceinline__ int operator()(int c) const { return c; } };
struct RowWin0 { __device__ __forceinline__ int operator()(int c) const { if (c < 640) return c; const int jj = c - 640; return 640 + 2 * (jj & 31) + (jj >> 5); } };
struct RowUq { __device__ __forceinline__ int operator()(int c) const { const int h = c / 192, j = c % 192; if (j < 128) return h * 128 + j; const int jj = j - 128; return 1024 + h * 64 + 2 * (jj & 31) + (jj >> 5); } };
struct RowDiff { __device__ __forceinline__ int operator()(int c) const { if (c >= 2048) return c; const int off = c & 63; if (off >= 16) return c; return (c & ~63) + 2 * (off & 7) + (off >> 3); } };
struct RowMoeIn { __device__ __forceinline__ int operator()(int c) const { const int f = c & 2047; return (f >> 2) * 8 + (f & 3) + ((c >> 11) << 2); } };

__device__ __forceinline__ void p0_prologue() {
    const KArgs a = kargs(); const Frame F = mkframe(a);
    const int tid = F.tid, lane = F.lane;
    {
        const float* cin = (const float*)a->in[1]; const float* ada_w = (const float*)a->in[3]; const float* ada_b = (const float*)a->in[4];
        float* mods = (float*)(F.ws + WS_MODS);
        LAS float* sc = (LAS float*)F.lds; LAS float* red = (LAS float*)(F.lds + 16384);
        for (int i = tid; i < 4096; i += NTHREADS) { const float v = cin[i]; sc[i] = v / (1.0f + __expf(-v)); }
        __syncthreads();
        for (int cb = blockIdx.x; cb < 256; cb += F.G) {
            const int f0 = cb * 48, l = f0 / 6144, e0 = f0 % 6144; const int g = tid / 12, cc = tid % 12;
            if (g < 40) { f32x4 a0 = {0.f, 0.f, 0.f, 0.f}, a1 = a0, a2 = a0, a3 = a0; const float* wp = ada_w + (size_t)l * 1024 * 6144 + e0 + 4 * cc;
                f32x4 w[26];
#pragma unroll
                for (int i = 0; i < 26; ++i) { const int d = g + 40 * i; w[i] = (d < 1024) ? *(const f32x4*)(wp + (size_t)d * 6144) : (f32x4){0.f, 0.f, 0.f, 0.f}; }
#pragma unroll
                for (int i = 0; i < 26; ++i) { const int d = (g + 40 * i) & 1023; a0 += w[i] * sc[d]; a1 += w[i] * sc[1024 + d]; a2 += w[i] * sc[2048 + d]; a3 += w[i] * sc[3072 + d]; }
                LAS f32x4* rp = (LAS f32x4*)red + (g * 12 + cc) * 4; rp[0] = a0; rp[1] = a1; rp[2] = a2; rp[3] = a3; }
            __syncthreads();
            if (tid < 192) { const int c2 = tid % 48, b = tid / 48; float s = 0.f;
#pragma unroll 8
                for (int gg = 0; gg < 40; ++gg) s += red[((gg * 12 + (c2 >> 2)) * 4 + b) * 4 + (c2 & 3)];
                mods[(size_t)(l * 4 + b) * 6144 + e0 + c2] = s + ada_b[l * 6144 + e0 + c2]; }
            __syncthreads();
        }
    }
    {
        const int* pos = (const int*)a->in[2];
        float* cosm = (float*)(F.ws + WS_COSM); float* sinm = (float*)(F.ws + WS_SINM); float* cosd = (float*)(F.ws + WS_COSD); float* sind = (float*)(F.ws + WS_SIND);
        for (int i = blockIdx.x * NTHREADS + tid; i < T * 40; i += F.G * NTHREADS) {
            const int t = i / 40, j = i % 40; const double p = (double)pos[t]; float s, c;
            if (j < 32) { sincos_d(p * INV_M[j], s, c); cosm[(size_t)t * 32 + j] = c; sinm[(size_t)t * 32 + j] = s; }
            else { sincos_d(p * INV_D[j - 32], s, c); cosd[(size_t)t * 8 + (j - 32)] = c; sind[(size_t)t * 8 + (j - 32)] = s; }
        }
    }
    {
        LAS float* scr = (LAS float*)(F.lds + F.wave * 16384);
        const int gw = F.vcu * NWAVES + F.wave, NGW = F.G * NWAVES;
        { f16* z = (f16*)(F.ws + WS_WIN0) + (size_t)704 * 1024; for (int i = blockIdx.x * NTHREADS + tid; i < 8192; i += F.G * NTHREADS) *(u32x4*)(z + (size_t)i * 8) = (u32x4){0u, 0u, 0u, 0u}; }
        __syncthreads();
        constexpr int I0 = 16 * 11, I1 = 6 * 24, I2 = 4 * 32, I3 = 16 * 16, I4 = 16 * 48, I5 = 16 * 16;
        constexpr int ISM = I0 + I1 + I2 + I3 + I4 + I5;
        constexpr int IMI = 16 * 64, IMO = 32 * 16;
        constexpr int NITEMS = ISM;
        for (int it = gw; it < NITEMS; it += NGW) {
            int r = it;
            if (r < I0) { tr_item64((const float*)a->in[9], 704, 1024, (f16*)(F.ws + WS_WIN0), RowWin0(), scr, r / 11, r % 11, lane); continue; } r -= I0;
            if (r < I1) { tr_item64((const float*)a->in[12], 1536, 384, (f16*)(F.ws + WS_WUQ), RowUq(), scr, r / 24, r % 24, lane, (const float*)a->in[10]); continue; } r -= I1;
            if (r < I2) { tr_item64((const float*)a->in[13], 2048, 256, (f16*)(F.ws + WS_WUKV), RowId(), scr, r / 32, r % 32, lane, (const float*)a->in[11]); continue; } r -= I2;
            if (r < I3) { tr_item64((const float*)a->in[14], 1024, 1024, (f16*)(F.ws + WS_WO0), RowId(), scr, r / 16, r % 16, lane); continue; } r -= I3;
            if (r < I4) { tr_item64((const float*)a->in[15], 3072, 1024, (f16*)(F.ws + WS_WIN1), RowDiff(), scr, r / 48, r % 48, lane); continue; } r -= I4;
            if (r < I5) { tr_item64((const float*)a->in[18], 1024, 1024, (f16*)(F.ws + WS_WO1), RowId(), scr, r / 16, r % 16, lane); continue; }
        }
    }
}

__device__ __forceinline__ void mod_rows_p1() {
    const KArgs a = kargs(); const Frame F = mkframe(a);
    const float* x = (const float*)a->in[0]; const float* mods_l = (const float*)(F.ws + WS_MODS); f16* out = (f16*)(F.ws + WS_HA);
    const int gw = F.vcu * NWAVES + F.wave, NGW = F.G * NWAVES, lane = F.lane;
    for (int m0 = gw; m0 < T; m0 += 2 * NGW) {
        f32x4 v[2][4];
#pragma unroll
        for (int u = 0; u < 2; ++u) { const int m = m0 + u * NGW; if (m < T) {
#pragma unroll
            for (int j = 0; j < 4; ++j) v[u][j] = *(const f32x4*)(x + (size_t)m * DM + 4 * lane + 256 * j); } }
#pragma unroll
        for (int u = 0; u < 2; ++u) { const int m = m0 + u * NGW; if (m < T) { const float* mb = mods_l + (m >> 12) * 6144;
#pragma unroll
            for (int j = 0; j < 4; ++j) { const int c = 4 * lane + 256 * j; const f32x4 sh = *(const f32x4*)(mb + c), sc = *(const f32x4*)(mb + 1024 + c);
                const f32x4 h = v[u][j] * (sc + 1.0f) + sh; h4 o; o[0] = (f16)h[0]; o[1] = (f16)h[1]; o[2] = (f16)h[2]; o[3] = (f16)h[3];
                *(h4*)(out + (size_t)m * DM + c) = o; } } }
    }
}

#define RCOL(lane, j) ((((j) >> 1) << 9) + 8 * (lane) + 4 * ((j) & 1))
__device__ __forceinline__ void h8_to_f4(const h8 v, f32x4& a, f32x4& b) { a = (f32x4){(float)v[0], (float)v[1], (float)v[2], (float)v[3]}; b = (f32x4){(float)v[4], (float)v[5], (float)v[6], (float)v[7]}; }
__device__ __forceinline__ void ln_router(int l) {
    const KArgs a = kargs(); const Frame F = mkframe(a);
    const float* lng = (const float*)a->in[5] + l * DM; const float* lnb = (const float*)a->in[6] + l * DM; const float* router_w = (const float*)a->in[19] + (size_t)l * DM * NE;
    const float* mods_l = (const float*)(F.ws + WS_MODS) + (size_t)l * 4 * 6144;
    const f16* pre = (const f16*)(F.ws + WS_PRE); float* stat = (float*)(F.ws + WS_STAT); f16* hB = (f16*)(F.ws + WS_HB); float* aff = (float*)(F.ws + WS_AFF);
    LAS float* rwT = (LAS float*)F.lds;
    for (int i = F.tid; i < 16384; i += NTHREADS) { const int d = i >> 4, e = i & 15; const int seg = d >> 9, w = d & 511; rwT[e * 1024 + seg * 512 + ((w >> 2) & 1) * 256 + (w >> 3) * 4 + (w & 3)] = router_w[i]; }
    __syncthreads();
    const int gw = F.vcu * NWAVES + F.wave, NGW = F.G * NWAVES, lane = F.lane;
    for (int m0 = gw; m0 < T; m0 += 2 * NGW) {
        h8 pv[2][2];
#pragma unroll
        for (int u = 0; u < 2; ++u) { const int m = (m0 + u * NGW < T) ? m0 + u * NGW : m0; pv[u][0] = *(const h8*)(pre + (size_t)m * DM + 8 * lane); pv[u][1] = *(const h8*)(pre + (size_t)m * DM + 512 + 8 * lane); }
#pragma unroll
        for (int u = 0; u < 2; ++u) { const int m = m0 + u * NGW; if (m < T) {
        const int b = m >> 12, s_ = m & 4095; const float* mb = mods_l + b * 6144;
        f32x4 v[4]; h8_to_f4(pv[u][0], v[0], v[1]); h8_to_f4(pv[u][1], v[2], v[3]); float s = 0.f;
#pragma unroll
        for (int j = 0; j < 4; ++j) s += (v[j][0] + v[j][1]) + (v[j][2] + v[j][3]);
        const float mean = wave_sum(s) * (1.f / DM); float s2 = 0.f;
#pragma unroll
        for (int j = 0; j < 4; ++j) { v[j] = v[j] - mean; s2 += (v[j][0] * v[j][0] + v[j][1] * v[j][1]) + (v[j][2] * v[j][2] + v[j][3] * v[j][3]); }
        const float rstd = 1.0f / sqrtf(wave_sum(s2) * (1.f / DM) + LN_EPS);
        if (lane == 0) { f32x2 st = {mean, rstd}; *(f32x2*)(stat + (size_t)m * 2) = st; }
        float lg[16];
#pragma unroll
        for (int e = 0; e < 16; ++e) lg[e] = 0.f;
        f32x4 hh[4];
#pragma unroll
        for (int j = 0; j < 4; ++j) { const int c = RCOL(lane, j);
            const f32x4 g = *(const f32x4*)(lng + c), bb = *(const f32x4*)(lnb + c), sh = *(const f32x4*)(mb + 3072 + c), sc = *(const f32x4*)(mb + 4096 + c);
            const f32x4 xn = v[j] * rstd * g + bb; const f32x4 h = xn * (sc + 1.0f) + sh; hh[j] = h;
#pragma unroll
            for (int e = 0; e < 16; ++e) { const f32x4 w = *(const LAS f32x4*)(rwT + e * 1024 + (j >> 1) * 512 + (j & 1) * 256 + lane * 4); lg[e] += (h[0] * w[0] + h[1] * w[1]) + (h[2] * w[2] + h[3] * w[3]); }
            asm volatile("" ::: "memory"); }
        *(h8*)(hB + (size_t)m * DM + 8 * lane) = pack8(hh[0], hh[1]); *(h8*)(hB + (size_t)m * DM + 512 + 8 * lane) = pack8(hh[2], hh[3]);
        float r8[8], r4[4], r2[2], r1;
        { const bool up = (lane & 32) != 0;
#pragma unroll
          for (int i = 0; i < 8; ++i) { const float keep = up ? lg[8 + i] : lg[i], give = up ? lg[i] : lg[8 + i]; r8[i] = keep + __shfl_xor(give, 32); } }
        { const bool up = (lane & 16) != 0;
#pragma unroll
          for (int i = 0; i < 4; ++i) { const float keep = up ? r8[4 + i] : r8[i], give = up ? r8[i] : r8[4 + i]; r4[i] = keep + __shfl_xor(give, 16); } }
        { const bool up = (lane & 8) != 0;
#pragma unroll
          for (int i = 0; i < 2; ++i) { const float keep = up ? r4[2 + i] : r4[i], give = up ? r4[i] : r4[2 + i]; r2[i] = keep + __shfl_xor(give, 8); } }
        { const bool up = (lane & 4) != 0; const float keep = up ? r2[1] : r2[0], give = up ? r2[0] : r2[1]; r1 = keep + __shfl_xor(give, 4); }
        r1 += __shfl_xor(r1, 1); r1 += __shfl_xor(r1, 2);
        float mx = r1;
        mx = fmaxf(mx, __shfl_xor(mx, 4)); mx = fmaxf(mx, __shfl_xor(mx, 8)); mx = fmaxf(mx, __shfl_xor(mx, 16)); mx = fmaxf(mx, __shfl_xor(mx, 32));
        const float pe = __expf(r1 - mx); float den = pe;
        den += __shfl_xor(den, 4); den += __shfl_xor(den, 8); den += __shfl_xor(den, 16); den += __shfl_xor(den, 32);
        if ((lane & 3) == 0) aff[(size_t)(b * 16 + (lane >> 2)) * SEQ + s_] = pe / den;
        } }
    }
    __syncthreads();
}

__device__ __forceinline__ int block_excl_scan(int v, LAS int* tmp, int tid, int& total) {
    const int lane = tid & 63, wid = tid >> 6; int x = v;
#pragma unroll
    for (int o = 1; o < 64; o <<= 1) { const int y = __shfl_up(x, o); if (lane >= o) x += y; }
    if (lane == 63) tmp[wid] = x;
    __syncthreads();
    int base = 0, tot = 0;
#pragma unroll
    for (int w = 0; w < 8; ++w) { const int t = tmp[w]; if (w < wid) base += t; tot += t; }
    __syncthreads();
    total = tot; return base + x - v;
}
__device__ __forceinline__ void topk_phase() {
    const KArgs a = kargs(); const Frame F = mkframe(a);
    const float* aff = (const float*)(F.ws + WS_AFF); float* gate = (float*)(F.ws + WS_GATE); int* rowtok = (int*)(F.ws + WS_ROWTOK); int* inv = (int*)(F.ws + WS_INV);
    LAS unsigned* hist = (LAS unsigned*)F.lds; LAS unsigned* selw = hist + 256; LAS int* tmp = (LAS int*)(hist + 272);
    const int tid = F.tid;
    for (int p = blockIdx.x; p < NB * NE; p += F.G) { const int b = p >> 4, e = p & 15;
        const float* ap = aff + (size_t)p * SEQ + 8 * tid; unsigned key[8];
        { const f32x4 a0 = *(const f32x4*)ap, a1 = *(const f32x4*)(ap + 4);
          key[0] = __float_as_uint(a0[0]); key[1] = __float_as_uint(a0[1]); key[2] = __float_as_uint(a0[2]); key[3] = __float_as_uint(a0[3]);
          key[4] = __float_as_uint(a1[0]); key[5] = __float_as_uint(a1[1]); key[6] = __float_as_uint(a1[2]); key[7] = __float_as_uint(a1[3]); }
        unsigned prefix = 0u, kk = CAP;
        for (int pass = 0; pass < 4; ++pass) { const int shift = 24 - 8 * pass;
            if (tid < 256) hist[tid] = 0u;
            __syncthreads();
#pragma unroll
            for (int j = 0; j < 8; ++j) { const bool match = (pass == 0) || ((key[j] >> (shift + 8)) == prefix); if (match) atomicAdd((unsigned*)&hist[(key[j] >> shift) & 255u], 1u); }
            __syncthreads();
            { const int hv = (tid < 256) ? (int)hist[255 - tid] : 0; int tot_; const int Sp = block_excl_scan(hv, tmp, tid, tot_);
              if (tid < 256 && (unsigned)Sp < kk && kk <= (unsigned)(Sp + hv)) { selw[0] = 255u - (unsigned)tid; selw[1] = kk - (unsigned)Sp; } }
            __syncthreads();
            prefix = (prefix << 8) | selw[0]; kk = selw[1];
            __syncthreads();
        }
        int ce = 0;
#pragma unroll
        for (int j = 0; j < 8; ++j) ce += (key[j] == prefix) ? 1 : 0;
        int tot; int eqr = block_excl_scan(ce, tmp, tid, tot);
        unsigned selm = 0u; int cs = 0;
#pragma unroll
        for (int j = 0; j < 8; ++j) { bool sel = key[j] > prefix; if (key[j] == prefix) { sel = (unsigned)eqr < kk; ++eqr; } if (sel) { selm |= 1u << j; ++cs; } }
        int slot = block_excl_scan(cs, tmp, tid, tot);
#pragma unroll
        for (int j = 0; j < 8; ++j) { const int s_ = 8 * tid + j; const int tok = b * SEQ + s_; const bool sel = (selm >> j) & 1u;
            if (sel) { const int row = e * EROWS + b * CAP + slot; rowtok[row] = tok; gate[row] = __uint_as_float(key[j]); inv[(size_t)tok * 16 + e] = slot; ++slot; }
            else inv[(size_t)tok * 16 + e] = -1; }
        __syncthreads();
    }
}
__device__ __forceinline__ void combine_ln(int l) {
    const KArgs a = kargs(); const Frame F = mkframe(a);
    const float* lng1 = (const float*)a->in[5] + l * DM; const float* lnb1 = (const float*)a->in[6] + l * DM;
    const float* lng = (const float*)a->in[7] + l * DM; const float* lnb = (const float*)a->in[8] + l * DM;
    const float* mods_l = (const float*)(F.ws + WS_MODS) + (size_t)l * 4 * 6144; const float* mods_next = (const float*)(F.ws + WS_MODS) + (size_t)4 * 6144;
    float* xo32 = a->out; f16* x2 = (f16*)(F.ws + WS_X2); f16* hA = (f16*)(F.ws + WS_HA);
    const f16* pre = (const f16*)(F.ws + WS_PRE); const float* stat = (const float*)(F.ws + WS_STAT); const f16* y = (const f16*)(F.ws + WS_Y); const int* inv = (const int*)(F.ws + WS_INV);
    const int gw = F.vcu * NWAVES + F.wave, NGW = F.G * NWAVES, lane = F.lane;
    for (int m0 = gw; m0 < T; m0 += 2 * NGW) {
        int myinv[2]; h8 pv[2][2]; f32x2 st[2];
#pragma unroll
        for (int u = 0; u < 2; ++u) { const int m = (m0 + u * NGW < T) ? m0 + u * NGW : m0; myinv[u] = inv[(size_t)m * 16 + (lane & 15)]; st[u] = *(const f32x2*)(stat + (size_t)m * 2);
            pv[u][0] = *(const h8*)(pre + (size_t)m * DM + 8 * lane); pv[u][1] = *(const h8*)(pre + (size_t)m * DM + 512 + 8 * lane); }
#pragma unroll
        for (int u = 0; u < 2; ++u) { const int m = m0 + u * NGW; if (m < T) {
        const int b = m >> 12; const float* mb = mods_l + b * 6144;
        f32x4 f[4];
#pragma unroll
        for (int j = 0; j < 4; ++j) f[j] = (f32x4){0.f, 0.f, 0.f, 0.f};
        unsigned mask = (unsigned)(__ballot(myinv[u] >= 0) & 0xFFFFull);
        while (mask) {
            const int e0 = __builtin_ctz(mask); mask &= mask - 1u; const bool two = mask != 0u; const int e1 = two ? __builtin_ctz(mask) : e0; mask &= mask - 1u;
            const int s0 = __shfl(myinv[u], e0), s1 = __shfl(myinv[u], e1);
            const f16* y0 = y + (size_t)(e0 * EROWS + b * CAP + s0) * DM; const f16* y1 = y + (size_t)(e1 * EROWS + b * CAP + s1) * DM;
            const h8 a00 = *(const h8*)(y0 + 8 * lane), a01 = *(const h8*)(y0 + 512 + 8 * lane), a10 = *(const h8*)(y1 + 8 * lane), a11 = *(const h8*)(y1 + 512 + 8 * lane);
            const float w1 = two ? 1.0f : 0.0f; f32x4 t0, t1;
            h8_to_f4(a00, t0, t1); f[0] += t0; f[1] += t1; h8_to_f4(a01, t0, t1); f[2] += t0; f[3] += t1;
            h8_to_f4(a10, t0, t1); f[0] += t0 * w1; f[1] += t1 * w1; h8_to_f4(a11, t0, t1); f[2] += t0 * w1; f[3] += t1 * w1;
        }
        f32x4 v[4]; h8_to_f4(pv[u][0], v[0], v[1]); h8_to_f4(pv[u][1], v[2], v[3]); float s = 0.f;
#pragma unroll
        for (int j = 0; j < 4; ++j) { const int c = RCOL(lane, j); const f32x4 g1 = *(const f32x4*)(lng1 + c), b1 = *(const f32x4*)(lnb1 + c), g2 = *(const f32x4*)(mb + 5120 + c);
            const f32x4 x1 = (v[j] - st[u][0]) * st[u][1] * g1 + b1;
            v[j] = x1 * ALPHA + (g2 + 1.0f) * f[j]; s += (v[j][0] + v[j][1]) + (v[j][2] + v[j][3]); }
        const float mean = wave_sum(s) * (1.f / DM); float s2 = 0.f;
#pragma unroll
        for (int j = 0; j < 4; ++j) { v[j] = v[j] - mean; s2 += (v[j][0] * v[j][0] + v[j][1] * v[j][1]) + (v[j][2] * v[j][2] + v[j][3] * v[j][3]); }
        const float rstd = 1.0f / sqrtf(wave_sum(s2) * (1.f / DM) + LN_EPS);
        f32x4 xn[4];
#pragma unroll
        for (int j = 0; j < 4; ++j) { const int c = RCOL(lane, j); const f32x4 g = *(const f32x4*)(lng + c), bb = *(const f32x4*)(lnb + c); xn[j] = v[j] * rstd * g + bb; }
        if (l == 0) {
            *(h8*)(x2 + (size_t)m * DM + 8 * lane) = pack8(xn[0], xn[1]); *(h8*)(x2 + (size_t)m * DM + 512 + 8 * lane) = pack8(xn[2], xn[3]);
            const float* mn = mods_next + b * 6144; f32x4 hv[4];
#pragma unroll
            for (int j = 0; j < 4; ++j) { const int c = RCOL(lane, j); const f32x4 sh = *(const f32x4*)(mn + c), sc = *(const f32x4*)(mn + 1024 + c); hv[j] = xn[j] * (sc + 1.0f) + sh; }
            *(h8*)(hA + (size_t)m * DM + 8 * lane) = pack8(hv[0], hv[1]); *(h8*)(hA + (size_t)m * DM + 512 + 8 * lane) = pack8(hv[2], hv[3]);
        } else {
#pragma unroll
            for (int j = 0; j < 4; ++j) *(f32x4*)(xo32 + (size_t)m * DM + RCOL(lane, j)) = xn[j];
        }
        } }
    }
}

__device__ __forceinline__ void attn_mla() {
    const KArgs a = kargs(); const Frame F = mkframe(a);
    const f16* Q = (const f16*)(F.ws + WS_Q); const f16* K = (const f16*)(F.ws + WS_K); const f16* V = (const f16*)(F.ws + WS_V); f16* O = (f16*)(F.ws + WS_O);
    att::ConvStream cs; att::conv_init(cs, (const float*)a->in[20], (const float*)a->in[21], (f16*)(F.ws + WS_MOEIN), (f16*)(F.ws + WS_MOEOUT), 0, F.vcu * NWAVES + F.wave, F.G * NWAVES, 4, F.ldsg + 83968 + F.wave * 4096);
    for (int u = F.vcu; u < NB * 8 * 16; u += F.G) { const int qb = u & 15, bh = u >> 4, h = bh & 7, b = bh >> 3;
        att::attn_body_simple<192, 1536, 1536, 1024, 1024, true, true>(Q + (size_t)(b * SEQ + qb * 256) * 1536 + h * 192, K + (size_t)(b * SEQ) * 1536 + h * 192, V + (size_t)(b * SEQ) * 1024 + h * 128,
                                                                 O + (size_t)(b * SEQ + qb * 256) * 1024 + h * 128, F.ldsg, 0, 0.f, nullptr, &cs); }
    while (cs.step < cs.step_end) { cs.it = 0; att::conv_tick(cs, F.lane); att::conv_flush(cs, F.lane); }
    att::conv_flush(cs, F.lane); att::conv_drain(cs, F.lane);
}
__device__ __forceinline__ void attn_diff() {
    const KArgs a = kargs(); const Frame F = mkframe(a);
    const f16* QKV = (const f16*)(F.ws + WS_QKV1); f16* O = (f16*)(F.ws + WS_O);
    const float* lamv = (const float*)a->in[16]; const float* subln = (const float*)a->in[17];
    const float l01 = wave_sum(lamv[F.lane] * lamv[64 + F.lane]), l23 = wave_sum(lamv[128 + F.lane] * lamv[192 + F.lane]);
    const float lam = expf(l01) - expf(l23) + LAMBDA_INIT;
    att::ConvStream cs; att::conv_init(cs, (const float*)a->in[20], (const float*)a->in[21], (f16*)(F.ws + WS_MOEIN), (f16*)(F.ws + WS_MOEOUT), 1, F.vcu * NWAVES + F.wave, F.G * NWAVES, 8, F.ldsg + 51200 + F.wave * 4096);
    for (int u = F.vcu; u < NB * 8 * 16; u += F.G) { const int qb = u & 15, bh = u >> 4, h = bh & 7, b = bh >> 3;
        f16* Ob = O + (size_t)(b * SEQ + qb * 256) * 1024 + h * 128; const f16* Vh = QKV + (size_t)(b * SEQ) * 3072 + 2048 + h * 128;
#pragma unroll 1
        for (int c = 0; c < 2; ++c) { const int hh = 2 * h + c;
            att::attn_body_simple<64, 3072, 3072, 3072, 1024, true, true>(QKV + (size_t)(b * SEQ + qb * 256) * 3072 + hh * 64, QKV + (size_t)(b * SEQ) * 3072 + 1024 + hh * 64, Vh, Ob, F.ldsg, c, lam, subln, &cs); } }
    cs.it = 0;
    while (cs.step < cs.step_end) { cs.it = 0; att::conv_tick(cs, F.lane); att::conv_flush(cs, F.lane); }
    att::conv_flush(cs, F.lane); att::conv_drain(cs, F.lane);
}

__device__ __forceinline__ void ph_gemm_lat() { const KArgs a = kargs(); const Frame F = mkframe(a);
    pg8::Gemm g{(const f16*)(F.ws + WS_HA), (const f16*)(F.ws + WS_WIN0), T, 768, 1024, 1 << 30, 0, nullptr}; pg8::StaticOrder S; S.init(T, 768, F.G, (int)blockIdx.x);
    EpiLat E{(f16*)(F.ws + WS_CQN), (f16*)(F.ws + WS_CKVN), (f16*)(F.ws + WS_K), (float*)(F.ws + WS_PQ), (float*)(F.ws + WS_PKV), (const float*)(F.ws + WS_COSM), (const float*)(F.ws + WS_SINM)}; pg8::gemm_phase<EpiLat>(F.lds, g, S, E); }
__device__ __forceinline__ void ph_gemm_q() { const KArgs a = kargs(); const Frame F = mkframe(a);
    pg8::Gemm g{(const f16*)(F.ws + WS_CQN), (const f16*)(F.ws + WS_WUQ), T, 1024, 384, 1 << 30, 0, nullptr}; pg8::StaticOrder S; S.init(T, 1024, F.G, (int)blockIdx.x);
    EpiQNope E{(f16*)(F.ws + WS_Q), (const float*)(F.ws + WS_PQ)}; pg8::gemm_phase<EpiQNope>(F.lds, g, S, E); }
__device__ __forceinline__ void ph_gemm_qr() { const KArgs a = kargs(); const Frame F = mkframe(a);
    pg8::Gemm g{(const f16*)(F.ws + WS_CQN), (const f16*)(F.ws + WS_WUQ) + (size_t)1024 * 384, T, 512, 384, 1 << 30, 0, nullptr}; pg8::StaticOrder S; S.init(T, 512, F.G, (int)blockIdx.x);
    EpiQRope E{(f16*)(F.ws + WS_Q), (const float*)(F.ws + WS_COSM), (const float*)(F.ws + WS_SINM), (const float*)(F.ws + WS_PQ)}; pg8::gemm_phase<EpiQRope>(F.lds, g, S, E); }
__device__ __forceinline__ void ph_gemm_kv() { const KArgs a = kargs(); const Frame F = mkframe(a);
    pg8::Gemm g{(const f16*)(F.ws + WS_CKVN), (const f16*)(F.ws + WS_WUKV), T, 2048, 256, 1 << 30, 0, nullptr}; pg8::StaticOrder S; S.init(T, 2048, F.G, (int)blockIdx.x);
    EpiKV E{(f16*)(F.ws + WS_K), (f16*)(F.ws + WS_V), (const float*)(F.ws + WS_PKV)}; pg8::gemm_phase<EpiKV>(F.lds, g, S, E); }
__device__ __forceinline__ void ph_gemm_o(int l) { const KArgs a = kargs(); const Frame F = mkframe(a);
    pg8::Gemm g{(const f16*)(F.ws + WS_O), (const f16*)(F.ws + (l == 0 ? WS_WO0 : WS_WO1)), T, 1024, 1024, 1 << 30, 0, nullptr}; pg8::StaticOrder S; S.init(T, 1024, F.G, (int)blockIdx.x);
    const float* gm = (const float*)(F.ws + WS_MODS) + (size_t)l * 4 * 6144 + 2048;
    if (l == 0) { EpiPre<false> E{a->in[0], gm, (f16*)(F.ws + WS_PRE)}; pg8::gemm_phase<EpiPre<false>>(F.lds, g, S, E); }
    else { EpiPre<true> E{(const void*)(F.ws + WS_X2), gm, (f16*)(F.ws + WS_PRE)}; pg8::gemm_phase<EpiPre<true>>(F.lds, g, S, E); } }
__device__ __forceinline__ void ph_gemm_diffin() { const KArgs a = kargs(); const Frame F = mkframe(a);
    pg8::Gemm g{(const f16*)(F.ws + WS_HA), (const f16*)(F.ws + WS_WIN1), T, 3072, 1024, 1 << 30, 0, nullptr}; pg8::StaticOrder S; S.init(T, 3072, F.G, (int)blockIdx.x);
    EpiDiffIn E{(f16*)(F.ws + WS_QKV1), (const float*)(F.ws + WS_COSD), (const float*)(F.ws + WS_SIND)}; pg8::gemm_phase<EpiDiffIn>(F.lds, g, S, E); }
__device__ __forceinline__ void ph_gemm_up(int l) { const KArgs a = kargs(); const Frame F = mkframe(a);
    pg8::Gemm g{(const f16*)(F.ws + WS_HB), (const f16*)(F.ws + WS_MOEIN) + (size_t)l * NE * 4096 * 1024, MROWS, 4096, 1024, EROWS / 256, (size_t)4096 * 1024, (const int*)(F.ws + WS_ROWTOK)}; pg8::StaticOrder S; S.init(MROWS, 4096, F.G, (int)blockIdx.x);
    EpiUp E{(f16*)(F.ws + WS_ACT)}; pg8::gemm_phase<EpiUp, true, true, true>(F.lds, g, S, E); }
__device__ __forceinline__ void ph_gemm_down(int l) { const KArgs a = kargs(); const Frame F = mkframe(a);
    pg8::Gemm g{(const f16*)(F.ws + WS_ACT), (const f16*)(F.ws + WS_MOEOUT) + (size_t)l * NE * 1024 * 2048, MROWS, 1024, 2048, EROWS / 256, (size_t)1024 * 2048, nullptr}; pg8::StaticOrder S; S.init(MROWS, 1024, F.G, (int)blockIdx.x);
    EpiDown E{(f16*)(F.ws + WS_Y), (const float*)(F.ws + WS_GATE)}; pg8::gemm_phase<EpiDown>(F.lds, g, S, E); }

constexpr int NPHASES = 24;
__global__ void __launch_bounds__(NTHREADS, 2) mk_fwd(Args args) {
    LAS unsigned char* ldsp = (LAS unsigned char*)g_lds;
    volatile LAS unsigned* MISC = (volatile LAS unsigned*)(ldsp + MISC_OFF);
    for (int u = threadIdx.x; u < (LDS_BYTES - LDSCTL_OFF) / 4; u += NTHREADS) ((LAS unsigned*)(ldsp + LDSCTL_OFF))[u] = 0u;
    __syncthreads();
    XcdBarrier bar = xcd_barrier_post((unsigned*)(args.ws + WS_CTL) + CW_BAR + args.li * XCD_BAR_WORDS, MISC + 8);
    const int lo = args.ph_lo, hi = args.ph_hi;
#ifndef PH_MASK
#define PH_MASK 0xFFFFFFFFu
#endif
#define IN(k) (((PH_MASK >> (k)) & 1u) && lo <= (k) && (k) < hi)
#define SEAM(k) do { if (lo <= (k) && (k) + 1 < hi) xcd_barrier(bar); } while (0)
#ifndef REP_MASK
#define REP_MASK 0u
#endif
#define RUN(k, call) do { if (IN(k)) { call; if ((REP_MASK >> (k)) & 1u) { __syncthreads(); call; } } } while (0)
    RUN(0, p0_prologue());      SEAM(0);
    RUN(1, mod_rows_p1());      SEAM(1);
    RUN(2, ph_gemm_lat());      SEAM(2);
    RUN(4, ph_gemm_q()); RUN(4, ph_gemm_qr());
    RUN(5, ph_gemm_kv());       SEAM(5);
    RUN(6, attn_mla());         SEAM(6);
#pragma unroll 1
    for (int l = 0; l < 2; ++l) {
        const int pb = (l == 0) ? 7 : 17;
        if (l == 1) {
            RUN(14, ph_gemm_diffin()); SEAM(14);
            RUN(15, attn_diff());      SEAM(15);
        }
        RUN(pb + 0, ph_gemm_o(l));     SEAM(pb + 0);
        RUN(pb + 1, ln_router(l));     SEAM(pb + 1);
        RUN(pb + 2, topk_phase());     SEAM(pb + 2);
        RUN(pb + 4, ph_gemm_up(l));    SEAM(pb + 4);
        RUN(pb + 5, ph_gemm_down(l));  SEAM(pb + 5);
        RUN(pb + 6, combine_ln(l));
        if (l == 0) SEAM(pb + 6);
    }
#undef IN
#undef SEAM
}

extern "C" void kernel_launch(void* const* d_in, const int* in_sizes, int n_in, void* d_out, int out_size, void* d_ws, size_t ws_size, hipStream_t stream) {
    static int grid = 0;
    if (grid == 0) {
        if (n_in != 22 || in_sizes[0] != T * DM || out_size != T * DM || ws_size < WS_END) {
            fprintf(stderr, "kernel_launch: shape/workspace mismatch: n_in %d in0 %d out %d ws %zu (need %zu)\n", n_in, n_in > 0 ? in_sizes[0] : -1, out_size, ws_size, (size_t)WS_END); grid = -1; return; }
        int dev = 0, cus = 0, per_cu = 0;
        if (hipGetDevice(&dev) != hipSuccess || hipDeviceGetAttribute(&cus, hipDeviceAttributeMultiprocessorCount, dev) != hipSuccess) { fprintf(stderr, "kernel_launch: device query failed\n"); grid = -1; return; }
        if (hipFuncSetAttribute((const void*)mk_fwd, hipFuncAttributeMaxDynamicSharedMemorySize, LDS_BYTES) != hipSuccess) { fprintf(stderr, "kernel_launch: hipFuncSetAttribute failed\n"); grid = -1; return; }
        if (hipOccupancyMaxActiveBlocksPerMultiprocessor(&per_cu, (const void*)mk_fwd, NTHREADS, LDS_BYTES) != hipSuccess || per_cu < 1)
            fprintf(stderr, "kernel_launch: note: occupancy query reports %d workgroups per CU\n", per_cu);
        (void)hipGetLastError();
        grid = cus;
    }
    if (grid < 0) return;
    if (hipMemsetAsync((char*)d_ws + WS_CTL, 0, CTL_ZERO_BYTES, stream) != hipSuccess) { fprintf(stderr, "kernel_launch: memset failed\n"); return; }
    Args a{};
    for (int i = 0; i < 22; ++i) a.in[i] = d_in[i];
    a.out = (float*)d_out; a.ws = (unsigned char*)d_ws;
#if MK_CUTS == 1
    a.ph_lo = 0; a.ph_hi = NPHASES; a.li = 0;
    hipLaunchKernelGGL(mk_fwd, dim3(grid), dim3(NTHREADS), LDS_BYTES, stream, a);
#else
    for (int p = 0; p < NPHASES; ++p) { a.ph_lo = p; a.ph_hi = p + 1; a.li = 0; hipLaunchKernelGGL(mk_fwd, dim3(grid), dim3(NTHREADS), LDS_BYTES, stream, a); }
#endif
    const hipError_t le = hipPeekAtLastError();
    if (le != hipSuccess) fprintf(stderr, "kernel_launch: launch failed: %s\n", hipGetErrorName(le));
}
```

```cpp
#include <hip/hip_runtime.h>
#include <cstdio>
#include <cstdint>

#ifndef MK_CUTS
#define MK_CUTS 1
#endif


#define LAS __attribute__((address_space(3)))
#define GAS __attribute__((address_space(1)))
typedef _Float16 f16;
typedef _Float16 h8 __attribute__((ext_vector_type(8)));
typedef _Float16 h4 __attribute__((ext_vector_type(4)));
typedef _Float16 h2 __attribute__((ext_vector_type(2)));
typedef short s16x4 __attribute__((ext_vector_type(4)));
typedef float f32x4 __attribute__((ext_vector_type(4)));
typedef float f32x2 __attribute__((ext_vector_type(2)));
typedef float f32x16 __attribute__((ext_vector_type(16)));
typedef unsigned u32x4 __attribute__((ext_vector_type(4)));
typedef unsigned u32x2 __attribute__((ext_vector_type(2)));

constexpr int NB = 4, SEQ = 4096, DM = 1024, T = NB * SEQ;
constexpr int NE = 16, FF = 2048, CAP = 512, EROWS = NB * CAP;
constexpr int MROWS = NE * EROWS;
constexpr float ALPHA = 1.4142135623730951f;
constexpr float LN_EPS = 1e-5f, LAT_EPS = 1e-6f;
constexpr float LAMBDA_INIT = 0.35550906759096926f;
constexpr int NWAVES = 8, NTHREADS = 512;

constexpr size_t MiB = 1u << 20;
constexpr size_t WS_CTL = 0, CTL_ZERO_BYTES = 1 * MiB;
constexpr size_t WS_MODS = 1 * MiB;
constexpr size_t WS_COSM = 2 * MiB, WS_SINM = 4 * MiB;
constexpr size_t WS_COSD = 6 * MiB, WS_SIND = 6 * MiB + 512 * 1024;
constexpr size_t WS_AFF = 7 * MiB;
constexpr size_t WS_GATE = 8 * MiB;
constexpr size_t WS_ROWTOK = 8 * MiB + 512 * 1024;
constexpr size_t WS_INV = 9 * MiB;
constexpr size_t WS_WIN0 = 16 * MiB;
constexpr size_t WS_WUQ = 18 * MiB;
constexpr size_t WS_WUKV = 20 * MiB;
constexpr size_t WS_WO0 = 22 * MiB;
constexpr size_t WS_WIN1 = 24 * MiB;
constexpr size_t WS_WO1 = 30 * MiB;
constexpr size_t WS_MOEIN = 32 * MiB;
constexpr size_t WS_MOEOUT = 288 * MiB;
constexpr size_t WS_HA = 416 * MiB;
constexpr size_t WS_HB = 448 * MiB;
constexpr size_t WS_PQ = 480 * MiB;
constexpr size_t WS_PKV = 481 * MiB;
constexpr size_t WS_CQN = 528 * MiB;
constexpr size_t WS_CKVN = 540 * MiB;
constexpr size_t WS_Q = 548 * MiB;
constexpr size_t WS_K = 596 * MiB;
constexpr size_t WS_V = 644 * MiB;
constexpr size_t WS_O = 676 * MiB;
constexpr size_t WS_PRE = 708 * MiB;
constexpr size_t WS_STAT = 772 * MiB;
constexpr size_t WS_X2 = 836 * MiB;
constexpr size_t WS_XE = 900 * MiB;
constexpr size_t WS_ACT = 964 * MiB;
constexpr size_t WS_Y = 1092 * MiB;
constexpr size_t WS_QKV1 = 1156 * MiB;
constexpr size_t WS_OD = 1252 * MiB;
constexpr size_t WS_END = 1316 * MiB;
constexpr int CW_BAR = 4096;

constexpr int RING_BYTES = 131072;
constexpr int LDSCTL_OFF = RING_BYTES, MISC_OFF = LDSCTL_OFF + 320;
constexpr int LDS_BYTES = 147456;

#define LDS_WAIT() asm volatile("s_waitcnt lgkmcnt(0)" ::: "memory")
#define VM_WAIT() asm volatile("s_waitcnt vmcnt(0)" ::: "memory")

template <int CTRL> __device__ __forceinline__ float dpp_mov(float v) { return __builtin_bit_cast(float, __builtin_amdgcn_update_dpp(0, __builtin_bit_cast(int, v), CTRL, 0xF, 0xF, true)); }
__device__ __forceinline__ float wave_sum(float v) {
    v += dpp_mov<0xB1>(v); v += dpp_mov<0x4E>(v); v += dpp_mov<0x141>(v); v += dpp_mov<0x140>(v);
    { auto r = __builtin_amdgcn_permlane16_swap(__float_as_uint(v), __float_as_uint(v), false, false); v = __uint_as_float(r[0]) + __uint_as_float(r[1]); }
    { auto r = __builtin_amdgcn_permlane32_swap(__float_as_uint(v), __float_as_uint(v), false, false); v = __uint_as_float(r[0]) + __uint_as_float(r[1]); }
    return v;
}

#define XB_TMO      128
#define XB_XCNT(j)  (256  + 64 * (j))
#define XB_XSUB(j)  (1280 + 64 * (j))
#define XB_XGEN(j)  (2304 + 64 * (j))
#define XB_TOP      3328
#define XB_TOPGEN   3392
#define XCD_BAR_WORDS 3456
#define XB_SPIN_CAP (1u << 20)
__device__ __forceinline__ unsigned xb_ld(unsigned* p)              { return __hip_atomic_load(p, __ATOMIC_RELAXED, __HIP_MEMORY_SCOPE_AGENT); }
__device__ __forceinline__ unsigned xb_add(unsigned* p, unsigned v) { return __hip_atomic_fetch_add(p, v, __ATOMIC_RELAXED, __HIP_MEMORY_SCOPE_AGENT); }
__device__ __forceinline__ unsigned xb_xcc_id() { return (unsigned)__builtin_amdgcn_s_getreg((3 << 11) | 20) & 0xFu; }
#define XB_SPIN(cond, bar) do { unsigned _sp = 0; while (cond) { __builtin_amdgcn_s_sleep(1); \
    if ((++_sp & 255u) == 0u) { if (xb_ld(&(bar)[XB_TMO])) break; if (_sp > XB_SPIN_CAP) { atomicAdd(&(bar)[XB_TMO], 1u); break; } } } } while (0)
struct XcdBarrier { unsigned* bar; unsigned x; volatile LAS unsigned* st; };
__device__ __forceinline__ XcdBarrier xcd_barrier_post(unsigned* bar, volatile LAS unsigned* st) {
    XcdBarrier b; b.bar = bar; b.x = xb_xcc_id(); b.st = st;
    if (threadIdx.x == 0) (void)xb_add(&bar[XB_XCNT(b.x)], 1u);
    return b;
}
__device__ __forceinline__ void xcd_barrier_complete(unsigned* bar, unsigned x, unsigned& nloc, unsigned& nx) {
    const unsigned G = gridDim.x * gridDim.y * gridDim.z;
    unsigned sum, cnt, mine, sp = 0u;
    for (;;) {
        sum = 0u; cnt = 0u; mine = 0u;
#pragma unroll
        for (unsigned j = 0; j < 16; ++j) { const unsigned c = xb_ld(&bar[XB_XCNT(j)]); sum += c; cnt += (c > 0u) ? 1u : 0u; mine = (j == x) ? c : mine; }
        if (sum == G) break;
        __builtin_amdgcn_s_sleep(1);
        if ((++sp & 255u) == 0u) { if (xb_ld(&bar[XB_TMO])) break; if (sp > XB_SPIN_CAP) { atomicAdd(&bar[XB_TMO], 1u); break; } }
    }
    nloc = mine > 0u ? mine : 1u; nx = cnt > 0u ? cnt : 1u;
}
__device__ __forceinline__ void xcd_barrier(const XcdBarrier& b) {
    asm volatile("s_waitcnt vmcnt(0)" ::: "memory");
    __syncthreads();
    if (threadIdx.x == 0) {
        unsigned* bar = b.bar;
        __builtin_amdgcn_s_waitcnt(0);
        unsigned nloc = b.st[0], nx = b.st[1];
        if (nloc == 0u) { xcd_barrier_complete(bar, b.x, nloc, nx); b.st[0] = nloc; b.st[1] = nx; }
        const unsigned old = xb_add(&bar[XB_XSUB(b.x)], 1u);
        const unsigned gen = old / nloc;
        if (old + 1u == (gen + 1u) * nloc) {
            __builtin_amdgcn_fence(__ATOMIC_RELEASE, "agent");
            asm volatile("s_waitcnt vmcnt(0)" ::: "memory");
            const unsigned og = xb_add(&bar[XB_TOP], 1u);
            const unsigned tg = og / nx;
            if (og + 1u == (tg + 1u) * nx) xb_add(&bar[XB_TOPGEN], 1u);
            else XB_SPIN(xb_ld(&bar[XB_TOPGEN]) == tg, bar);
            __builtin_amdgcn_fence(__ATOMIC_ACQUIRE, "agent");
            xb_add(&bar[XB_XGEN(b.x)], 1u);
            asm volatile("s_waitcnt vmcnt(0)" ::: "memory");
        } else {
            XB_SPIN(xb_ld(&bar[XB_XGEN(b.x)]) == gen, bar);
            __builtin_amdgcn_fence(__ATOMIC_ACQUIRE, "agent");
            asm volatile("s_waitcnt vmcnt(0)" ::: "memory");
        }
    }
    __syncthreads();
}

namespace pg8 {
constexpr int BM = 256, BK = 64, HALF = 128, HTB = HALF * BK * 2, STAGE_BYTES = 8 * HTB, NXCD = 8, WGM = 8;
__host__ __device__ __forceinline__ int lds_byte(int r, int c) { const int st = (r >> 4) * 2 + (c >> 5), rr = r & 15, cc = c & 31, ob = rr * 64 + cc * 2; return st * 1024 + (ob ^ (((ob >> 9) & 1) << 5)); }
__host__ __device__ __forceinline__ void stage_rc(int b, int& R, int& C) { const int st = b / 1024, sb = b % 1024, swz = sb ^ (((sb >> 9) & 1) << 5); R = (st >> 1) * 16 + swz / 64; C = (st & 1) * 32 + (swz % 64) / 2; }
__host__ __device__ __forceinline__ int perm32(int rho) { const int n = rho >> 4, i = rho & 15; return 8 * (i >> 2) + 4 * n + (i & 3); }
struct Unit { int pm, pn; };
struct Gemm { const f16* A; const f16* Bt; int M, N, K; int grp_tiles; size_t grp_stride; const int* rowidx; };
struct StaticOrder {
    int nM, nN, nwg, G, c;
    __host__ __device__ void init(int M, int N, int G_, int c_) { nM = M / BM; nN = N / BM; nwg = nM * nN; G = G_; c = c_; }
    __host__ __device__ bool next(int i, Unit& u) const {
        const long L = (long)i * G + c; if (L >= nwg) return false;
        int wgid = (int)L; { const int q = nwg / NXCD, r = nwg % NXCD, xcd = wgid % NXCD, off = wgid / NXCD; wgid = (xcd < r ? xcd * (q + 1) : r * (q + 1) + (xcd - r) * q) + off; }
        const int nig = WGM * nN, gid = wgid / nig, fm = gid * WGM, gsz = (nM - fm) < WGM ? (nM - fm) : WGM;
        u.pm = fm + ((wgid % nig) % gsz); u.pn = (wgid % nig) / gsz; return true;
    }
};
constexpr int GATHER_MAX_UNITS = 15, GATHER_IDX_OFF = RING_BYTES + 1024;
template <class Epi, bool ALIGN_EPI = true, bool SP2 = true, bool GATHER = false>
__device__ __forceinline__ void gemm_phase(LAS unsigned char* lds, const Gemm g, const StaticOrder& S, const Epi& E) {
    int tid = threadIdx.x; asm volatile("" : "+v"(tid));
    const int wid = __builtin_amdgcn_readfirstlane(tid >> 6), lane = tid & 63, wr = wid >> 2, wc = wid & 3, fr = lane & 15, fq = lane >> 4;
    const int K = g.K, nt = K / BK;
    unsigned voffA[2], voffB[2];
#pragma unroll
    for (int i = 0; i < 2; ++i) { int R, C; stage_rc(tid * 16 + i * 8192, R, C); const int Rb = Epi::PERM ? ((R & ~31) + perm32(R & 31)) : R;
        voffA[i] = (unsigned)(R * K + C) * 2u; voffB[i] = (unsigned)(Rb * K + C) * 2u; }
    int gR[2]; unsigned gC[2];
#pragma unroll
    for (int i = 0; i < 2; ++i) { int R, C; stage_rc(tid * 16 + i * 8192, R, C); gR[i] = R; gC[i] = (unsigned)C * 2u; }
    LAS int* idxbuf = (LAS int*)(lds + GATHER_IDX_OFF);
    if constexpr (GATHER) {
        Unit uu;
        for (int q = 0; q < GATHER_MAX_UNITS; ++q) { if (!S.next(q, uu)) break; if (tid < 256) idxbuf[q * 256 + tid] = g.rowidx[uu.pm * 256 + tid]; }
        asm volatile("s_waitcnt vmcnt(0) lgkmcnt(0)" ::: "memory"); __builtin_amdgcn_s_barrier(); asm volatile("" ::: "memory");
    }
    unsigned gaC[2][2], gaN[2][2], ga2[2][2];
#define PG8_GA(dst, q) do { _Pragma("unroll") for (int _h = 0; _h < 2; ++_h) _Pragma("unroll") for (int _i = 0; _i < 2; ++_i) dst[_h][_i] = (unsigned)idxbuf[(q) * 256 + _h * 128 + gR[_i]] * (unsigned)(K * 2) + gC[_i]; } while (0)
    const size_t kstep = (size_t)(BK * 2);
    const size_t hstep = (size_t)HALF * K * 2;
    const size_t tstep = 2 * hstep;
    const unsigned ldsw = (unsigned)wid * 1024u;
    const int aoff = lds_byte(wr * 64 + fr, fq * 8), boff = lds_byte(wc * 32 + fr, fq * 8);
#define PG8_SA(b, h) (((b) * 2 + (h)) * HTB)
#define PG8_SB(b, h) ((4 + (b) * 2 + (h)) * HTB)
#define PG8_STAGE(bufoff, gbase, voff) do { _Pragma("unroll") for (int _i = 0; _i < 2; ++_i) \
        __builtin_amdgcn_global_load_lds((const unsigned*)((const char*)(gbase) + (voff)[_i]), (LAS unsigned*)(lds + (bufoff) + ldsw + _i * 8192), 16, 0, 0); } while (0)
#define PG8_LDA(dst, b, h) do { _Pragma("unroll") for (int m = 0; m < 4; ++m) _Pragma("unroll") for (int k = 0; k < 2; ++k) dst[m][k] = *(const LAS h8*)(lds + PG8_SA(b, h) + aoff + m * 2048 + k * 1024); } while (0)
#define PG8_LDB(dst, b, h) do { _Pragma("unroll") for (int n = 0; n < 2; ++n) _Pragma("unroll") for (int k = 0; k < 2; ++k) dst[n][k] = *(const LAS h8*)(lds + PG8_SB(b, h) + boff + n * 2048 + k * 1024); } while (0)
#define PG8_MMA(ai, bj, At, Bt) do { __builtin_amdgcn_s_setprio(1); _Pragma("unroll") for (int m = 0; m < 4; ++m) _Pragma("unroll") for (int n = 0; n < 2; ++n) _Pragma("unroll") for (int k = 0; k < 2; ++k) \
        acc[ai][bj][m][n] = __builtin_amdgcn_mfma_f32_16x16x32_f16(Bt[n][k], At[m][k], acc[ai][bj][m][n], 0, 0, 0); __builtin_amdgcn_s_setprio(0); } while (0)
#define PG8_WAIT_V(n) asm volatile("s_waitcnt vmcnt(" #n ")" ::: "memory")
#define PG8_WAIT_L(n) asm volatile("s_waitcnt lgkmcnt(" #n ")" ::: "memory")
#define PG8_BAR __builtin_amdgcn_s_barrier()
#define PG8_SCHED __builtin_amdgcn_sched_barrier(0)
#define PG8_STA(bufoff, tileptr, h, gaset, kbyte) do { if constexpr (GATHER) { PG8_STAGE(bufoff, (const char*)g.A + (kbyte), gaset[h]); } else { PG8_STAGE(bufoff, (tileptr) + (h) * hstep, voffA); } } while (0)
#define PG8_BBASE(u) ((const char*)g.Bt + ((size_t)((u).pm / g.grp_tiles) * g.grp_stride) * 2 + (size_t)(u).pn * tstep)
    Unit cur, nxt; int ui = 0;
    if (!S.next(0, cur)) return;
    f32x4 acc[2][2][4][2];
#pragma unroll
    for (int a = 0; a < 2; ++a)
#pragma unroll
        for (int b = 0; b < 2; ++b)
#pragma unroll
            for (int m = 0; m < 4; ++m)
#pragma unroll
                for (int n = 0; n < 2; ++n) acc[a][b][m][n] = (f32x4){0.f, 0.f, 0.f, 0.f};
    h8 At[4][2], B0[2][2], B1[2][2];
    const char* cA = (const char*)g.A + (size_t)cur.pm * tstep; const char* cB = PG8_BBASE(cur);
    if constexpr (GATHER) { PG8_GA(gaC, 0); }
    if constexpr (SP2) {
        PG8_STAGE(PG8_SB(0, 0), cB, voffB); PG8_STAGE(PG8_SB(0, 1), cB + hstep, voffB); PG8_STA(PG8_SA(0, 0), cA, 0, gaC, 0); PG8_STA(PG8_SA(0, 1), cA, 1, gaC, 0);
        if (wr == 1) PG8_BAR;
        PG8_WAIT_V(2); PG8_BAR;
        PG8_STAGE(PG8_SB(1, 0), cB + kstep, voffB); PG8_STA(PG8_SA(1, 0), cA + kstep, 0, gaC, kstep); PG8_STAGE(PG8_SB(1, 1), cB + hstep + kstep, voffB);
        PG8_WAIT_V(6); PG8_BAR;
    } else {
        PG8_STAGE(PG8_SB(0, 0), cB, voffB); PG8_STA(PG8_SA(0, 0), cA, 0, gaC, 0); PG8_STAGE(PG8_SB(0, 1), cB + hstep, voffB); PG8_STA(PG8_SA(0, 1), cA, 1, gaC, 0);
        if (wr == 1) PG8_BAR;
        PG8_WAIT_V(4); PG8_BAR;
        PG8_STAGE(PG8_SB(1, 0), cB + kstep, voffB); PG8_STA(PG8_SA(1, 0), cA + kstep, 0, gaC, kstep); PG8_STAGE(PG8_SB(1, 1), cB + hstep + kstep, voffB);
        PG8_WAIT_V(6); PG8_BAR;
    }
    for (;;) {
        const bool has_next = S.next(ui + 1, nxt);
        const char* nA = has_next ? (const char*)g.A + (size_t)nxt.pm * tstep : cA; const char* nB = has_next ? PG8_BBASE(nxt) : cB;
        if constexpr (GATHER) { const int qn = has_next ? ui + 1 : ui; PG8_GA(gaN, qn); }
#pragma unroll 1
        for (int t = 0; t < nt; t += 2) {
            const bool last = (t == nt - 2);
            const char* a1 = cA + (size_t)(t + 1) * kstep;
            const char* a2 = last ? nA : cA + (size_t)(t + 2) * kstep; const char* b2 = last ? nB : cB + (size_t)(t + 2) * kstep;
            const char* a3 = a2 + kstep; const char* b3 = b2 + kstep;
            const size_t k1 = (size_t)(t + 1) * kstep, k2 = last ? 0 : (size_t)(t + 2) * kstep, k3 = k2 + kstep;
            if constexpr (GATHER) { _Pragma("unroll") for (int _h = 0; _h < 2; ++_h) _Pragma("unroll") for (int _i = 0; _i < 2; ++_i) ga2[_h][_i] = last ? gaN[_h][_i] : gaC[_h][_i]; }
            if constexpr (SP2) {
            PG8_LDB(B0, 0, 0); PG8_LDB(B1, 0, 1); PG8_SCHED; PG8_LDA(At, 0, 0); PG8_STA(PG8_SA(1, 1), a1, 1, gaC, k1);
            PG8_WAIT_V(8); PG8_WAIT_L(0); PG8_BAR; PG8_MMA(0, 0, At, B0); PG8_MMA(0, 1, At, B1); PG8_BAR; PG8_SCHED;
            PG8_LDA(At, 0, 1); PG8_STAGE(PG8_SB(0, 0), b2, voffB); PG8_STAGE(PG8_SB(0, 1), b2 + hstep, voffB); PG8_STA(PG8_SA(0, 0), a2, 0, ga2, k2);
            PG8_WAIT_V(8); PG8_WAIT_L(0); PG8_BAR; PG8_MMA(1, 0, At, B0); PG8_MMA(1, 1, At, B1); PG8_BAR; PG8_SCHED;
            PG8_LDB(B0, 1, 0); PG8_LDB(B1, 1, 1); PG8_SCHED; PG8_LDA(At, 1, 0); PG8_STA(PG8_SA(0, 1), a2, 1, ga2, k2);
            PG8_WAIT_V(8); PG8_WAIT_L(0); PG8_BAR; PG8_MMA(0, 0, At, B0); PG8_MMA(0, 1, At, B1); PG8_BAR; PG8_SCHED;
            PG8_LDA(At, 1, 1); PG8_STAGE(PG8_SB(1, 0), b3, voffB); PG8_STAGE(PG8_SB(1, 1), b3 + hstep, voffB); PG8_STA(PG8_SA(1, 0), a3, 0, ga2, k3);
            PG8_WAIT_V(8); PG8_WAIT_L(0); PG8_BAR; PG8_MMA(1, 0, At, B0); PG8_MMA(1, 1, At, B1); PG8_BAR; PG8_SCHED;
            } else {
            PG8_LDB(B0, 0, 0); PG8_SCHED; PG8_LDA(At, 0, 0); PG8_STA(PG8_SA(1, 1), a1, 1, gaC, k1);
            PG8_WAIT_L(8); PG8_BAR; PG8_WAIT_L(0); PG8_MMA(0, 0, At, B0); PG8_BAR; PG8_SCHED;
            PG8_LDB(B1, 0, 1); PG8_STAGE(PG8_SB(0, 0), b2, voffB);
            PG8_BAR; PG8_WAIT_L(0); PG8_MMA(0, 1, At, B1); PG8_BAR;
            PG8_LDA(At, 0, 1); PG8_STA(PG8_SA(0, 0), a2, 0, ga2, k2);
            PG8_BAR; PG8_WAIT_L(0); PG8_MMA(1, 0, At, B0); PG8_BAR; PG8_SCHED;
            PG8_STAGE(PG8_SB(0, 1), b2 + hstep, voffB);
            PG8_WAIT_V(6); PG8_BAR; PG8_MMA(1, 1, At, B1); PG8_BAR;
            PG8_LDB(B0, 1, 0); PG8_SCHED; PG8_LDA(At, 1, 0); PG8_STA(PG8_SA(0, 1), a2, 1, ga2, k2);
            PG8_WAIT_L(8); PG8_BAR; PG8_WAIT_L(0); PG8_MMA(0, 0, At, B0); PG8_BAR; PG8_SCHED;
            PG8_LDB(B1, 1, 1); PG8_STAGE(PG8_SB(1, 0), b3, voffB);
            PG8_BAR; PG8_WAIT_L(0); PG8_MMA(0, 1, At, B1); PG8_BAR;
            PG8_LDA(At, 1, 1); PG8_STA(PG8_SA(1, 0), a3, 0, ga2, k3);
            PG8_BAR; PG8_WAIT_L(0); PG8_MMA(1, 0, At, B0); PG8_BAR; PG8_SCHED;
            PG8_STAGE(PG8_SB(1, 1), b3 + hstep, voffB);
            PG8_WAIT_V(6); PG8_BAR; PG8_MMA(1, 1, At, B1); PG8_BAR;
            }
        }
        if constexpr (ALIGN_EPI) { if (wr == 0) PG8_BAR; }
        E(acc, cur, wr, wc, fr, fq);
        if (!has_next) break;
#pragma unroll
        for (int a = 0; a < 2; ++a)
#pragma unroll
            for (int b = 0; b < 2; ++b)
#pragma unroll
                for (int m = 0; m < 4; ++m)
#pragma unroll
                    for (int n = 0; n < 2; ++n) acc[a][b][m][n] = (f32x4){0.f, 0.f, 0.f, 0.f};
        cur = nxt; cA = nA; cB = nB; ++ui;
        if constexpr (GATHER) { _Pragma("unroll") for (int _h = 0; _h < 2; ++_h) _Pragma("unroll") for (int _i = 0; _i < 2; ++_i) gaC[_h][_i] = gaN[_h][_i]; }
        if constexpr (ALIGN_EPI) { if (wr == 1) PG8_BAR; }
    }
    PG8_WAIT_V(0);
    if constexpr (!ALIGN_EPI) { if (wr == 0) PG8_BAR; }
    PG8_BAR;
#undef PG8_SA
#undef PG8_SB
#undef PG8_STAGE
#undef PG8_LDA
#undef PG8_LDB
#undef PG8_MMA
#undef PG8_WAIT_V
#undef PG8_WAIT_L
#undef PG8_BAR
#undef PG8_SCHED
#undef PG8_BBASE
#undef PG8_STA
#undef PG8_GA
}
}

#define EPI_ROW(u, ai, m) ((u).pm * 256 + (ai) * 128 + wr * 64 + (m) * 16 + fr)
__device__ __forceinline__ h8 pack8(f32x4 a, f32x4 b) { h8 o; o[0] = (f16)a[0]; o[1] = (f16)a[1]; o[2] = (f16)a[2]; o[3] = (f16)a[3]; o[4] = (f16)b[0]; o[5] = (f16)b[1]; o[6] = (f16)b[2]; o[7] = (f16)b[3]; return o; }
__device__ __forceinline__ void rope4(f32x4& v0, f32x4& v1, const f32x4 cs, const f32x4 sn) {
    const f32x4 a = v0, b = v1;
    v0[0] = a[0] * cs[0] - a[1] * sn[0]; v0[1] = a[1] * cs[0] + a[0] * sn[0];
    v0[2] = a[2] * cs[1] - a[3] * sn[1]; v0[3] = a[3] * cs[1] + a[2] * sn[1];
    v1[0] = b[0] * cs[2] - b[1] * sn[2]; v1[1] = b[1] * cs[2] + b[0] * sn[2];
    v1[2] = b[2] * cs[3] - b[3] * sn[3]; v1[3] = b[3] * cs[3] + b[2] * sn[3];
}
struct EpiLat {
    static constexpr bool PERM = true; f16* cq; f16* ckv; f16* Kp; float* pq; float* pkv; const float* cosm; const float* sinm;
    __device__ __forceinline__ void operator()(const f32x4 (&acc)[2][2][4][2], const pg8::Unit& u, int wr, int wc, int fr, int fq) const {
#pragma unroll
        for (int ai = 0; ai < 2; ++ai)
#pragma unroll
            for (int m = 0; m < 4; ++m) { const int t = EPI_ROW(u, ai, m); float sq = 0.f, sk = 0.f;
#pragma unroll
                for (int bj = 0; bj < 2; ++bj) { const int c8 = u.pn * 256 + bj * 128 + wc * 32 + 8 * fq; const int ht = u.pn * 2 + bj;
                    f32x4 v0 = acc[ai][bj][m][0], v1 = acc[ai][bj][m][1];
                    const float ss = (v0[0] * v0[0] + v0[1] * v0[1]) + (v0[2] * v0[2] + v0[3] * v0[3]) + (v1[0] * v1[0] + v1[1] * v1[1]) + (v1[2] * v1[2] + v1[3] * v1[3]);
                    if (ht < 3) { sq += ss; *(h8*)(cq + (size_t)t * 384 + c8) = pack8(v0, v1); }
                    else if (ht < 5) { sk += ss; *(h8*)(ckv + (size_t)t * 256 + (c8 - 384)) = pack8(v0, v1); }
                    else if (c8 < 704) { const int jj = c8 - 640, i0 = jj >> 1;
                        const f32x4 cs = *(const f32x4*)(cosm + (size_t)t * 32 + i0), sn = *(const f32x4*)(sinm + (size_t)t * 32 + i0); rope4(v0, v1, cs, sn);
                        const h8 o = pack8(v0, v1);
#pragma unroll
                        for (int h = 0; h < 8; ++h) *(h8*)(Kp + (size_t)t * 1536 + h * 192 + 128 + jj) = o; } }
                sq += __shfl_xor(sq, 16); sq += __shfl_xor(sq, 32); sk += __shfl_xor(sk, 16); sk += __shfl_xor(sk, 32);
                if (fq == 0) { if (u.pn < 2) pq[(size_t)t * 8 + u.pn * 4 + wc] = sq; if (u.pn >= 1) pkv[(size_t)t * 8 + (u.pn - 1) * 4 + wc] = sk; }
                asm volatile("" ::: "memory"); }
    }
};
__device__ __forceinline__ float row_rms_scale(const float* part, int t, float inv_n, float eps) {
    const f32x4 a = *(const f32x4*)(part + (size_t)t * 8), b = *(const f32x4*)(part + (size_t)t * 8 + 4);
    const float s = ((a[0] + a[1]) + (a[2] + a[3])) + ((b[0] + b[1]) + (b[2] + b[3]));
    return 1.0f / sqrtf(s * inv_n + eps);
}
struct EpiQNope {
    static constexpr bool PERM = true; f16* Q; const float* pq;
    __device__ __forceinline__ void operator()(const f32x4 (&acc)[2][2][4][2], const pg8::Unit& u, int wr, int wc, int fr, int fq) const {
#pragma unroll
        for (int ai = 0; ai < 2; ++ai)
#pragma unroll
            for (int m = 0; m < 4; ++m) { const int t = EPI_ROW(u, ai, m); const float rs = row_rms_scale(pq, t, 1.0f / 384.0f, LAT_EPS);
#pragma unroll
                for (int bj = 0; bj < 2; ++bj) { const int c8 = u.pn * 256 + bj * 128 + wc * 32 + 8 * fq;
                    *(h8*)(Q + (size_t)t * 1536 + (c8 >> 7) * 192 + (c8 & 127)) = pack8(acc[ai][bj][m][0] * rs, acc[ai][bj][m][1] * rs); }
                asm volatile("" ::: "memory"); }
    }
};
struct EpiQRope {
    static constexpr bool PERM = true; f16* Q; const float* cosm; const float* sinm; const float* pq;
    __device__ __forceinline__ void operator()(const f32x4 (&acc)[2][2][4][2], const pg8::Unit& u, int wr, int wc, int fr, int fq) const {
#pragma unroll
        for (int ai = 0; ai < 2; ++ai)
#pragma unroll
            for (int m = 0; m < 4; ++m) { const int t = EPI_ROW(u, ai, m); const float rs = row_rms_scale(pq, t, 1.0f / 384.0f, LAT_EPS);
#pragma unroll
                for (int bj = 0; bj < 2; ++bj) { const int cc = u.pn * 256 + bj * 128 + wc * 32 + 8 * fq; const int h = cc >> 6, jj = cc & 63, i0 = jj >> 1;
                    f32x4 v0 = acc[ai][bj][m][0] * rs, v1 = acc[ai][bj][m][1] * rs;
                    const f32x4 cs = *(const f32x4*)(cosm + (size_t)t * 32 + i0), sn = *(const f32x4*)(sinm + (size_t)t * 32 + i0); rope4(v0, v1, cs, sn);
                    *(h8*)(Q + (size_t)t * 1536 + h * 192 + 128 + jj) = pack8(v0, v1); }
                asm volatile("" ::: "memory"); }
    }
};
struct EpiKV {
    static constexpr bool PERM = true; f16* Kp; f16* Vp; const float* pkv;
    __device__ __forceinline__ void operator()(const f32x4 (&acc)[2][2][4][2], const pg8::Unit& u, int wr, int wc, int fr, int fq) const {
#pragma unroll
        for (int ai = 0; ai < 2; ++ai)
#pragma unroll
            for (int m = 0; m < 4; ++m) { const int t = EPI_ROW(u, ai, m); const float rs = row_rms_scale(pkv, t, 1.0f / 256.0f, LAT_EPS);
#pragma unroll
                for (int bj = 0; bj < 2; ++bj) { const int c8 = u.pn * 256 + bj * 128 + wc * 32 + 8 * fq; const int h = c8 >> 8, j = c8 & 255;
                    f16* dst = (j < 128) ? (Kp + (size_t)t * 1536 + h * 192 + j) : (Vp + (size_t)t * 1024 + h * 128 + (j - 128));
                    *(h8*)dst = pack8(acc[ai][bj][m][0] * rs, acc[ai][bj][m][1] * rs); }
                asm volatile("" ::: "memory"); }
    }
};
template <bool XF16> struct EpiPre {
    static constexpr bool PERM = true; const void* xres; const float* gmod; f16* pre;
    __device__ __forceinline__ void operator()(const f32x4 (&acc)[2][2][4][2], const pg8::Unit& u, int wr, int wc, int fr, int fq) const {
        const int b = (u.pm * 256) >> 12;
        f32x4 g0[2], g1[2];
#pragma unroll
        for (int bj = 0; bj < 2; ++bj) { const int c8 = u.pn * 256 + bj * 128 + wc * 32 + 8 * fq; g0[bj] = *(const f32x4*)(gmod + b * 6144 + c8) + 1.0f; g1[bj] = *(const f32x4*)(gmod + b * 6144 + c8 + 4) + 1.0f; }
#pragma unroll
        for (int ai = 0; ai < 2; ++ai)
#pragma unroll
        for (int mh = 0; mh < 2; ++mh) {
            f32x4 x0[2][2], x1[2][2];
#pragma unroll
            for (int mm = 0; mm < 2; ++mm) { const int t = EPI_ROW(u, ai, 2 * mh + mm);
#pragma unroll
                for (int bj = 0; bj < 2; ++bj) { const int c8 = u.pn * 256 + bj * 128 + wc * 32 + 8 * fq;
                    if constexpr (XF16) { const h8 xv = *(const h8*)((const f16*)xres + (size_t)t * 1024 + c8);
                        x0[mm][bj] = (f32x4){(float)xv[0], (float)xv[1], (float)xv[2], (float)xv[3]}; x1[mm][bj] = (f32x4){(float)xv[4], (float)xv[5], (float)xv[6], (float)xv[7]}; }
                    else { x0[mm][bj] = *(const f32x4*)((const float*)xres + (size_t)t * 1024 + c8); x1[mm][bj] = *(const f32x4*)((const float*)xres + (size_t)t * 1024 + c8 + 4); } } }
#pragma unroll
            for (int mm = 0; mm < 2; ++mm) { const int m = 2 * mh + mm; const int t = EPI_ROW(u, ai, m);
#pragma unroll
                for (int bj = 0; bj < 2; ++bj) { const int c8 = u.pn * 256 + bj * 128 + wc * 32 + 8 * fq;
                    *(h8*)(pre + (size_t)t * 1024 + c8) = pack8(x0[mm][bj] * ALPHA + g0[bj] * acc[ai][bj][m][0], x1[mm][bj] * ALPHA + g1[bj] * acc[ai][bj][m][1]); } }
            asm volatile("" ::: "memory"); }
    }
};
struct EpiUp {
    static constexpr bool PERM = true; f16* act;
    __device__ __forceinline__ void operator()(const f32x4 (&acc)[2][2][4][2], const pg8::Unit& u, int wr, int wc, int fr, int fq) const {
#pragma unroll
        for (int ai = 0; ai < 2; ++ai)
#pragma unroll
            for (int m = 0; m < 4; ++m) { const int r = EPI_ROW(u, ai, m);
#pragma unroll
                for (int bj = 0; bj < 2; ++bj) { const int c8 = u.pn * 256 + bj * 128 + wc * 32 + 8 * fq;
                    const f32x4 gq = acc[ai][bj][m][0], uq = acc[ai][bj][m][1]; h4 o;
#pragma unroll
                    for (int i = 0; i < 4; ++i) { const float gg = gq[i]; o[i] = (f16)(gg * __builtin_amdgcn_rcpf(1.0f + __expf(-gg)) * uq[i]); }
                    *(h4*)(act + (size_t)r * 2048 + (c8 >> 1)) = o; } }
    }
};
struct EpiDown {
    static constexpr bool PERM = true; f16* y; const float* gate;
    __device__ __forceinline__ void operator()(const f32x4 (&acc)[2][2][4][2], const pg8::Unit& u, int wr, int wc, int fr, int fq) const {
#pragma unroll
        for (int ai = 0; ai < 2; ++ai)
#pragma unroll
            for (int m = 0; m < 4; ++m) { const int r = EPI_ROW(u, ai, m); const float gt = gate[r];
#pragma unroll
                for (int bj = 0; bj < 2; ++bj) { const int c8 = u.pn * 256 + bj * 128 + wc * 32 + 8 * fq;
                    *(h8*)(y + (size_t)r * 1024 + c8) = pack8(acc[ai][bj][m][0] * gt, acc[ai][bj][m][1] * gt); }
                asm volatile("" ::: "memory"); }
    }
};
struct EpiDiffIn {
    static constexpr bool PERM = true; f16* qkv; const float* cosd; const float* sind;
    __device__ __forceinline__ void operator()(const f32x4 (&acc)[2][2][4][2], const pg8::Unit& u, int wr, int wc, int fr, int fq) const {
#pragma unroll
        for (int ai = 0; ai < 2; ++ai)
#pragma unroll
            for (int m = 0; m < 4; ++m) { const int t = EPI_ROW(u, ai, m);
#pragma unroll
                for (int bj = 0; bj < 2; ++bj) { const int c8 = u.pn * 256 + bj * 128 + wc * 32 + 8 * fq;
                    f32x4 v0 = acc[ai][bj][m][0], v1 = acc[ai][bj][m][1];
                    if (c8 < 2048 && (c8 & 63) < 16) { const int i0 = (c8 & 15) >> 1; const f32x4 cs = *(const f32x4*)(cosd + (size_t)t * 8 + i0), sn = *(const f32x4*)(sind + (size_t)t * 8 + i0); rope4(v0, v1, cs, sn); }
                    *(h8*)(qkv + (size_t)t * 3072 + c8) = pack8(v0, v1); }
                asm volatile("" ::: "memory"); }
    }
};

namespace att {
constexpr int QBLK = 32, KVBLK = 64, DV = 128;
constexpr float THR = 8.f;
constexpr size_t SHM_V = KVBLK * DV * 2;
#define SBAR() __builtin_amdgcn_sched_barrier(0)
__device__ __forceinline__ int crow(int r, int hi) { return (r & 3) + 8 * (r >> 2) + 4 * hi; }
__device__ __forceinline__ unsigned cvtpk(float lo, float hi) { unsigned r; asm volatile("v_cvt_pk_f16_f32 %0, %1, %2" : "=v"(r) : "v"(lo), "v"(hi)); return r; }
template <int DQK> struct Cfg {
    static constexpr int ND0 = DQK / 16, KRB = DQK * 2, NKCH = DQK / 64, KCPR = DQK / 8;
    static constexpr size_t SHM_K = (size_t)KVBLK * KRB;
    static constexpr float SCALE = DQK == 192 ? 0.07216878364870322f : 0.125f;
    static constexpr size_t SHM_TOTAL = 2 * SHM_V + 2 * SHM_K + NWAVES * 64 * 4;
};
template <int DQK> __device__ __forceinline__ void partialSM(f32x16& p0, f32x16& p1, float& m_reg, float& mn, float& alpha) {
    constexpr float SCALE = Cfg<DQK>::SCALE, C = SCALE * 1.4426950408889634f;
    float pmax = p0[0];
#pragma unroll
    for (int r = 1; r < 16; ++r) pmax = fmaxf(pmax, p0[r]);
#pragma unroll
    for (int r = 0; r < 16; ++r) pmax = fmaxf(pmax, p1[r]);
    { auto rr = __builtin_amdgcn_permlane32_swap(__float_as_uint(pmax), __float_as_uint(pmax), false, false);
      pmax = fmaxf(__uint_as_float(rr[0]), __uint_as_float(rr[1])); }
    if (__builtin_expect(__all(pmax - m_reg <= THR / SCALE), 1)) { mn = m_reg; alpha = 1.f; }
    else { mn = fmaxf(m_reg, pmax); alpha = __builtin_amdgcn_exp2f((m_reg - mn) * C); m_reg = mn; }
    const float mnC = -mn * C;
#pragma unroll
    for (int r = 0; r < 16; ++r) p0[r] = fmaf(p0[r], C, mnC);
#pragma unroll
    for (int r = 0; r < 16; ++r) p1[r] = fmaf(p1[r], C, mnC);
#pragma unroll
    for (int r = 0; r < 16; ++r) p0[r] = __builtin_amdgcn_exp2f(p0[r]);
}
__device__ __forceinline__ void finishSM(f32x16& p0, f32x16& p1, float alpha, float& l_reg, h8& pa0, h8& pa1, h8& pa2, h8& pa3) {
#pragma unroll
    for (int r = 0; r < 16; ++r) p1[r] = __builtin_amdgcn_exp2f(p1[r]);
    float ps = 0;
#pragma unroll
    for (int r = 0; r < 16; ++r) ps += p0[r];
#pragma unroll
    for (int r = 0; r < 16; ++r) ps += p1[r];
    { auto rr = __builtin_amdgcn_permlane32_swap(__float_as_uint(ps), __float_as_uint(ps), false, false);
      ps = __uint_as_float(rr[0]) + __uint_as_float(rr[1]); }
    l_reg = l_reg * alpha + ps;
#define PK4(P, BASE, OUT) do { unsigned a0 = cvtpk(P[BASE + 0], P[BASE + 1]), a1 = cvtpk(P[BASE + 2], P[BASE + 3]);   \
    unsigned b0 = cvtpk(P[BASE + 4], P[BASE + 5]), b1 = cvtpk(P[BASE + 6], P[BASE + 7]);                              \
    auto r0 = __builtin_amdgcn_permlane32_swap(a0, b0, false, false); auto r1 = __builtin_amdgcn_permlane32_swap(a1, b1, false, false); \
    u32x4 w = {r0[0], r1[0], r0[1], r1[1]}; OUT = *reinterpret_cast<h8*>(&w); } while (0)
    PK4(p0, 0, pa0); PK4(p0, 8, pa1); PK4(p1, 0, pa2); PK4(p1, 8, pa3);
#undef PK4
}
#define KSWZ(row, colB) ((row) * KRB + ((colB) ^ (((row) & 7) << 4)))
template <int DQK> __device__ __forceinline__ void qkt(f32x16& p0, f32x16& p1, const char* Ks, const h8* qr, int r32, int hi) {
    constexpr int KRB = Cfg<DQK>::KRB;
    p0 = f32x16{}; p1 = f32x16{};
#pragma unroll
    for (int d0 = 0; d0 < Cfg<DQK>::ND0; ++d0) { const int cb = (d0 * 16 + hi * 8) * 2;
        const h8 b0 = *reinterpret_cast<const h8*>(Ks + KSWZ(r32, cb));
        const h8 b1 = *reinterpret_cast<const h8*>(Ks + KSWZ(32 + r32, cb));
        p0 = __builtin_amdgcn_mfma_f32_32x32x16_f16(b0, qr[d0], p0, 0, 0, 0);
        p1 = __builtin_amdgcn_mfma_f32_32x32x16_f16(b1, qr[d0], p1, 0, 0, 0); }
}
template <int OFF> __device__ __forceinline__ h8 lds_read128(int addr) { h8 r; asm volatile("ds_read_b128 %0, %1 offset:%2" : "=&v"(r) : "v"(addr), "i"(OFF) : "memory"); return r; }
template <int N> __device__ __forceinline__ void lgkm_wait() { asm volatile("s_waitcnt lgkmcnt(%0)" :: "i"(N) : "memory"); }
template <int DQK, int W, int I> struct QkStep {
    static constexpr int NF = 2 * Cfg<DQK>::ND0, KRB = Cfg<DQK>::KRB;
    static constexpr int koff(int i) { return ((i >> 1) >> 2) * 128 + (i & 1) * 32 * KRB; }
    static __device__ __forceinline__ void issue(h8 (&kf)[W], const int (&ka)[4]) { if constexpr (I < NF) kf[I % W] = lds_read128<koff(I)>(ka[(I >> 1) & 3]); }
    static __device__ __forceinline__ void run(h8 (&kf)[W], f32x16& p0, f32x16& p1, const h8* qr, const int (&ka)[4]) {
        if constexpr (I < NF) {
            constexpr int OUT = (NF - 1 - I) < (W - 1) ? (NF - 1 - I) : (W - 1);
            lgkm_wait<OUT>(); SBAR();
            if constexpr ((I & 1) == 0) p0 = __builtin_amdgcn_mfma_f32_32x32x16_f16(kf[I % W], qr[I >> 1], p0, 0, 0, 0);
            else p1 = __builtin_amdgcn_mfma_f32_32x32x16_f16(kf[I % W], qr[I >> 1], p1, 0, 0, 0);
            SBAR();
            QkStep<DQK, W, I + W>::issue(kf, ka);
            QkStep<DQK, W, I + 1>::run(kf, p0, p1, qr, ka);
        }
    }
};
template <int DQK, int W, int I> struct QkPrime { static __device__ __forceinline__ void run(h8 (&kf)[W], const int (&ka)[4]) { if constexpr (I < W && I < 2 * Cfg<DQK>::ND0) { QkStep<DQK, W, I>::issue(kf, ka); QkPrime<DQK, W, I + 1>::run(kf, ka); } } };
template <int DQK, int W> __device__ __forceinline__ void qkt_pipe(f32x16& p0, f32x16& p1, int kbase, const h8* qr, int r32, int hi) {
    constexpr int KRB = Cfg<DQK>::KRB;
    int ka[4];
#pragma unroll
    for (int q = 0; q < 4; ++q) ka[q] = kbase + r32 * KRB + ((q * 32 + hi * 16) ^ ((r32 & 7) << 4));
    p0 = f32x16{}; p1 = f32x16{};
    h8 kf[W];
    QkPrime<DQK, W, 0>::run(kf, ka);
    QkStep<DQK, W, 0>::run(kf, p0, p1, qr, ka);
}
__device__ __forceinline__ int v_st(int k, int c) { const int kk = (k & ~0xC) | ((k & 4) << 1) | ((k & 8) >> 1); return ((kk >> 3) * 4 + (c >> 5)) * 512 + ((kk & 7) * 32 + (c & 31)) * 2; }
__device__ __forceinline__ int v_rd_base(int lane) { return ((lane & 3) << 3) | (((lane >> 2) & 3) << 6) | (((lane >> 4) & 1) << 5) | (((lane >> 5) & 1) << 8); }
constexpr int v_rd_off(int d0, int ks, int half) { return d0 * 512 + ks * 4096 + half * 2048; }
template <int OFF> __device__ __forceinline__ s16x4 tr_read(int vb) {
    s16x4 r; asm volatile("ds_read_b64_tr_b16 %0, %1 offset:%2" : "=&v"(r) : "v"(vb), "i"(OFF) : "memory"); return r;
}
template <int D0> __device__ __forceinline__ void pv_one(f32x16& od, int vb, h8 pa0, h8 pa1, h8 pa2, h8 pa3) {
    const s16x4 l0 = tr_read<v_rd_off(D0, 0, 0)>(vb), h0 = tr_read<v_rd_off(D0, 0, 1)>(vb), l1 = tr_read<v_rd_off(D0, 1, 0)>(vb), h1 = tr_read<v_rd_off(D0, 1, 1)>(vb);
    const s16x4 l2 = tr_read<v_rd_off(D0, 2, 0)>(vb), h2_ = tr_read<v_rd_off(D0, 2, 1)>(vb), l3 = tr_read<v_rd_off(D0, 3, 0)>(vb), h3 = tr_read<v_rd_off(D0, 3, 1)>(vb);
    asm volatile("s_waitcnt lgkmcnt(0)" ::: "memory"); SBAR();
#define PKV(L, H) __builtin_bit_cast(h8, (__attribute__((ext_vector_type(8))) short){L[0], L[1], L[2], L[3], H[0], H[1], H[2], H[3]})
    od = __builtin_amdgcn_mfma_f32_32x32x16_f16(pa0, PKV(l0, h0), od, 0, 0, 0);
    od = __builtin_amdgcn_mfma_f32_32x32x16_f16(pa1, PKV(l1, h1), od, 0, 0, 0);
    od = __builtin_amdgcn_mfma_f32_32x32x16_f16(pa2, PKV(l2, h2_), od, 0, 0, 0);
    od = __builtin_amdgcn_mfma_f32_32x32x16_f16(pa3, PKV(l3, h3), od, 0, 0, 0);
#undef PKV
}
struct VFrag { s16x4 l0, h0, l1, h1, l2, h2, l3, h3; };
template <int D0> __device__ __forceinline__ void v_read8(VFrag& f, int vb) {
    f.l0 = tr_read<v_rd_off(D0, 0, 0)>(vb); f.h0 = tr_read<v_rd_off(D0, 0, 1)>(vb); f.l1 = tr_read<v_rd_off(D0, 1, 0)>(vb); f.h1 = tr_read<v_rd_off(D0, 1, 1)>(vb);
    f.l2 = tr_read<v_rd_off(D0, 2, 0)>(vb); f.h2 = tr_read<v_rd_off(D0, 2, 1)>(vb); f.l3 = tr_read<v_rd_off(D0, 3, 0)>(vb); f.h3 = tr_read<v_rd_off(D0, 3, 1)>(vb);
}
__device__ __forceinline__ void pv_mma4(f32x16& od, const VFrag& f, h8 pa0, h8 pa1, h8 pa2, h8 pa3) {
#define PKV(L, H) __builtin_bit_cast(h8, (__attribute__((ext_vector_type(8))) short){L[0], L[1], L[2], L[3], H[0], H[1], H[2], H[3]})
    od = __builtin_amdgcn_mfma_f32_32x32x16_f16(pa0, PKV(f.l0, f.h0), od, 0, 0, 0);
    od = __builtin_amdgcn_mfma_f32_32x32x16_f16(pa1, PKV(f.l1, f.h1), od, 0, 0, 0);
    od = __builtin_amdgcn_mfma_f32_32x32x16_f16(pa2, PKV(f.l2, f.h2), od, 0, 0, 0);
    od = __builtin_amdgcn_mfma_f32_32x32x16_f16(pa3, PKV(f.l3, f.h3), od, 0, 0, 0);
#undef PKV
}
__device__ __forceinline__ void pv_d0(f32x16* o, int vb, h8 pa0, h8 pa1, h8 pa2, h8 pa3) {
    VFrag A, B;
    v_read8<0>(A, vb); v_read8<1>(B, vb);
    asm volatile("s_waitcnt lgkmcnt(8)" ::: "memory"); SBAR(); pv_mma4(o[0], A, pa0, pa1, pa2, pa3); SBAR();
    v_read8<2>(A, vb);
    asm volatile("s_waitcnt lgkmcnt(8)" ::: "memory"); SBAR(); pv_mma4(o[1], B, pa0, pa1, pa2, pa3); SBAR();
    v_read8<3>(B, vb);
    asm volatile("s_waitcnt lgkmcnt(8)" ::: "memory"); SBAR(); pv_mma4(o[2], A, pa0, pa1, pa2, pa3); SBAR();
    asm volatile("s_waitcnt lgkmcnt(0)" ::: "memory"); SBAR(); pv_mma4(o[3], B, pa0, pa1, pa2, pa3);
}
template <int LDO>
__device__ __forceinline__ void attn_epilogue(f32x16 (&o)[4], const float (&rli)[16], f16* Ow, int mode, float lam, const float* subln, int r32, int hi) {
    if (mode == 0) {
#pragma unroll
        for (int r = 0; r < 16; ++r) { const int orow = crow(r, hi);
#pragma unroll
            for (int d0 = 0; d0 < 4; ++d0) Ow[(long)orow * LDO + d0 * 32 + r32] = (f16)(o[d0][r] * rli[r]); }
    } else {
        float sl[4];
#pragma unroll
        for (int d0 = 0; d0 < 4; ++d0) sl[d0] = subln[d0 * 32 + r32] * (1.0f - LAMBDA_INIT);
        f16 t0[4][16];
#pragma unroll
        for (int r = 0; r < 16; ++r) { const int orow = crow(r, hi);
#pragma unroll
            for (int d0 = 0; d0 < 4; ++d0) t0[d0][r] = Ow[(long)orow * LDO + d0 * 32 + r32]; }
        asm volatile("s_waitcnt vmcnt(0)" ::: "memory");
#pragma unroll
        for (int r = 0; r < 16; ++r) { const int orow = crow(r, hi); float ss = 0.f;
#pragma unroll
            for (int d0 = 0; d0 < 4; ++d0) { const float x = (float)t0[d0][r] - lam * (o[d0][r] * rli[r]); o[d0][r] = x; ss += x * x; }
            ss += __shfl_xor(ss, 1); ss += __shfl_xor(ss, 2); ss += __shfl_xor(ss, 4); ss += __shfl_xor(ss, 8); ss += __shfl_xor(ss, 16);
            const float rs = 1.0f / sqrtf(ss * (1.0f / 128.0f) + LN_EPS);
#pragma unroll
            for (int d0 = 0; d0 < 4; ++d0) Ow[(long)orow * LDO + d0 * 32 + r32] = (f16)(o[d0][r] * rs * sl[d0]); }
    }
}
template <int DQK, int LDQ, int LDK, int LDV, int LDO, int SDEPTH>
__device__ __forceinline__ void attn_body(const f16* Qb, const f16* Kh, const f16* Vh, f16* Ob, char* lds, int mode = 0, float lam = 0.f, const float* subln = nullptr) {
    using C = Cfg<DQK>;
    constexpr int KRB = C::KRB, ND0 = C::ND0, NKCH = C::NKCH, KCPR = C::KCPR; constexpr size_t SHM_K = C::SHM_K;
    constexpr int seq = SEQ;
    int tid = threadIdx.x; asm volatile("" : "+v"(tid));
    const int wid = tid >> 6, lane = tid & 63, r32 = lane & 31, hi = lane >> 5;
    char* V_lds = lds; char* K_lds = lds + 2 * SHM_V;
    float* wsl = (float*)(lds + 2 * SHM_V + 2 * SHM_K) + wid * 64; float* li_l = wsl; float* al_l = wsl + 32;
    float m_reg = -1e30f, l_reg = 0; f32x16 o[4] = {}; h8 qr[ND0];
    const f16* Qw = Qb + (long)(wid * QBLK + r32) * LDQ + hi * 8;
#pragma unroll
    for (int d0 = 0; d0 < ND0; ++d0) qr[d0] = *reinterpret_cast<const h8*>(Qw + d0 * 16);
    const int sr = tid >> 4, sc = (tid & 15) * 8, vst0 = v_st(sr, sc), vst1 = v_st(32 + sr, sc);
    int krow[NKCH], kcb[NKCH];
#pragma unroll
    for (int i = 0; i < NKCH; ++i) { const int c = tid + i * 512; krow[i] = c / KCPR; kcb[i] = (c % KCPR) * 16; }
    const int vb0 = (int)(uintptr_t)V_lds + v_rd_base(lane);
    struct { h8 vs0, vs1; h8 ks[NKCH]; } sr_[SDEPTH];
#define SLOAD(i, k0) do { sr_[i].vs0 = *reinterpret_cast<const h8*>(&Vh[(long)((k0) + sr) * LDV + sc]); sr_[i].vs1 = *reinterpret_cast<const h8*>(&Vh[(long)((k0) + 32 + sr) * LDV + sc]); \
    _Pragma("unroll") for (int _c = 0; _c < NKCH; ++_c) sr_[i].ks[_c] = *reinterpret_cast<const h8*>((const char*)Kh + (long)((k0) + krow[_c]) * (LDK * 2) + kcb[_c]); } while (0)
#define SWRITE(b, i) do { *(h8*)(V_lds + (b) * SHM_V + vst0) = sr_[i].vs0; *(h8*)(V_lds + (b) * SHM_V + vst1) = sr_[i].vs1; \
    _Pragma("unroll") for (int _c = 0; _c < NKCH; ++_c) *(h8*)(K_lds + (b) * SHM_K + KSWZ(krow[_c], kcb[_c])) = sr_[i].ks[_c]; } while (0)
#define SWAIT() do { if constexpr (SDEPTH == 2) { if constexpr (NKCH == 3) asm volatile("s_waitcnt vmcnt(5)" ::: "memory"); else asm volatile("s_waitcnt vmcnt(3)" ::: "memory"); } \
    else asm volatile("s_waitcnt vmcnt(0)" ::: "memory"); } while (0)
#define RESC(a) do { if (__any((a) < 1.f)) { if (hi == 0) al_l[r32] = (a); asm volatile("s_waitcnt lgkmcnt(0)" ::: "memory"); \
    _Pragma("unroll") for (int d = 0; d < 4; ++d) _Pragma("unroll") for (int r = 0; r < 16; ++r) o[d][r] *= al_l[crow(r, hi)]; } } while (0)
    f32x16 pA0, pA1, pB0, pB1; float mnA, mnB, alA, alB; h8 pa0, pa1, pa2, pa3; constexpr int NT = seq / KVBLK;
    constexpr int SE = 0, SO = SDEPTH - 1;
    SLOAD(SE, 0); asm volatile("s_waitcnt vmcnt(0)" ::: "memory"); SWRITE(0, SE); __syncthreads();
    qkt<DQK>(pA0, pA1, K_lds, qr, r32, hi); partialSM<DQK>(pA0, pA1, m_reg, mnA, alA);
    SLOAD(SO, KVBLK); if constexpr (SDEPTH == 2) { if (2 < NT) SLOAD(SE, 2 * KVBLK); }
    SWAIT(); SWRITE(1, SO); __syncthreads();
    for (int j = 1; j + 1 < NT; j += 2) {
        SBAR(); qkt<DQK>(pB0, pB1, K_lds + SHM_K, qr, r32, hi);
        finishSM(pA0, pA1, alA, l_reg, pa0, pa1, pa2, pa3); SBAR();
        SLOAD(SO, (j + SDEPTH) * KVBLK); SBAR();
        pv_d0(o, vb0, pa0, pa1, pa2, pa3); partialSM<DQK>(pB0, pB1, m_reg, mnB, alB);
        __syncthreads(); SWAIT(); SWRITE(0, SE);
        RESC(alB); __syncthreads();
        SBAR(); qkt<DQK>(pA0, pA1, K_lds, qr, r32, hi);
        finishSM(pB0, pB1, alB, l_reg, pa0, pa1, pa2, pa3); SBAR();
        if (SDEPTH == 1 || j + 3 < NT) SLOAD(SE, (j + 1 + SDEPTH) * KVBLK); SBAR();
        pv_d0(o, vb0 + (int)SHM_V, pa0, pa1, pa2, pa3); partialSM<DQK>(pA0, pA1, m_reg, mnA, alA);
        __syncthreads(); SWAIT(); SWRITE(1, SO);
        RESC(alA); __syncthreads();
    }
    SBAR(); qkt<DQK>(pB0, pB1, K_lds + SHM_K, qr, r32, hi);
    finishSM(pA0, pA1, alA, l_reg, pa0, pa1, pa2, pa3); SBAR();
    pv_d0(o, vb0, pa0, pa1, pa2, pa3); partialSM<DQK>(pB0, pB1, m_reg, mnB, alB);
    __syncthreads(); RESC(alB);
    finishSM(pB0, pB1, alB, l_reg, pa0, pa1, pa2, pa3); SBAR();
    pv_d0(o, vb0 + (int)SHM_V, pa0, pa1, pa2, pa3);
    if (hi == 0) li_l[r32] = l_reg; asm volatile("s_waitcnt lgkmcnt(0)" ::: "memory");
    float rli[16];
#pragma unroll
    for (int r = 0; r < 16; ++r) rli[r] = __builtin_amdgcn_rcpf(li_l[crow(r, hi)]);
    attn_epilogue<LDO>(o, rli, Ob + (long)(wid * QBLK) * LDO, mode, lam, subln, r32, hi);
    asm volatile("s_waitcnt vmcnt(0) lgkmcnt(0)" ::: "memory");
    __syncthreads();
#undef SLOAD
#undef SWRITE
#undef SWAIT
#undef RESC
}

struct ConvStream {
    const float* win; const float* wout; f16* tin; f16* tout;
    int step, step_end, it, period;
    unsigned d[8]; f16* pend;
    char* acc; f16* dst0; int nacc;
};
constexpr int CONV_STEPS_IN = 16 * 64 * 128, CONV_STEPS_OUT = 16 * 16 * 256, CONV_STEPS = CONV_STEPS_IN + CONV_STEPS_OUT;
__device__ __forceinline__ void conv_drain(ConvStream& c, int lane) {
    if (c.nacc > 0) {
        asm volatile("s_waitcnt lgkmcnt(0)" ::: "memory");
        for (int q = 0; q < c.nacc; ++q) { const h8 v = *(const h8*)(c.acc + q * 1024 + lane * 16); *(h8*)(c.dst0 + q * 8) = v; }
        c.nacc = 0; }
}
__device__ __forceinline__ void conv_flush(ConvStream& c, int lane) {
    if (c.pend) { h8 o;
#pragma unroll
        for (int i = 0; i < 8; ++i) o[i] = (f16)__uint_as_float(c.d[i]);
        if (c.nacc == 0) c.dst0 = c.pend;
        *(h8*)(c.acc + c.nacc * 1024 + lane * 16) = o; ++c.nacc; c.pend = nullptr;
        if (c.nacc == 4) conv_drain(c, lane); }
}
__device__ __forceinline__ void conv_tick(ConvStream& c, int lane) {
    const bool go = ((c.it & (c.period - 1)) < 3) && (c.step < c.step_end); ++c.it;
    if (go) { const int s = c.step++;
        const float* src; f16* dst; int N;
        if (s < CONV_STEPS_IN) { const int strip = s >> 7, kb = s & 127, e = strip >> 6, n = (strip & 63) * 64 + lane; const int f = n & 2047, dr = (f >> 2) * 8 + (f & 3) + ((n >> 11) << 2);
            src = c.win + ((size_t)e * 1024 + kb * 8) * 4096 + n; dst = c.tin + ((size_t)e * 4096 + dr) * 1024 + kb * 8; N = 4096; }
        else { const int s2 = s - CONV_STEPS_IN; const int strip = s2 >> 8, kb = s2 & 255, e = strip >> 4, n = (strip & 15) * 64 + lane;
            src = c.wout + ((size_t)e * 2048 + kb * 8) * 1024 + n; dst = c.tout + ((size_t)e * 1024 + n) * 2048 + kb * 8; N = 1024; }
        if ((s & 3) == 0) conv_drain(c, lane);
#pragma unroll
        for (int i = 0; i < 8; ++i) c.d[i] = __float_as_uint(src[(size_t)i * N]);
        c.pend = dst; }
}
__device__ __forceinline__ void conv_init(ConvStream& cs, const float* win, const float* wout, f16* tin, f16* tout, int l, int gw, int NGW, int period, char* acc) {
    cs.acc = acc; cs.nacc = 0; cs.dst0 = nullptr;
    cs.win = win + (size_t)l * NE * 1024 * 4096; cs.wout = wout + (size_t)l * NE * 2048 * 1024; cs.tin = tin + (size_t)l * NE * 4096 * 1024; cs.tout = tout + (size_t)l * NE * 1024 * 2048;
    const int per = ((CONV_STEPS + NGW - 1) / NGW + 7) & ~7;
    cs.step = gw * per < CONV_STEPS ? gw * per : CONV_STEPS; cs.step_end = (gw + 1) * per < CONV_STEPS ? (gw + 1) * per : CONV_STEPS; cs.it = 0; cs.pend = nullptr; cs.period = period;
}
template <int DQK, int LDQ, int LDK, int LDV, int LDO, bool CONV = false, bool GLDS = false>
__device__ __forceinline__ void attn_body_simple(const f16* Qb, const f16* Kh, const f16* Vh, f16* Ob, char* lds, int mode = 0, float lam = 0.f, const float* subln = nullptr, ConvStream* cs = nullptr) {
    using C = Cfg<DQK>;
    constexpr int KRB = C::KRB, ND0 = C::ND0, NKCH = C::NKCH, KCPR = C::KCPR; constexpr size_t SHM_K = C::SHM_K;
    int tid = threadIdx.x; asm volatile("" : "+v"(tid));
    const int wid = tid >> 6, lane = tid & 63, r32 = lane & 31, hi = lane >> 5;
    char* V_lds = lds; char* K_lds = lds + 2 * SHM_V;
    float* wsl = (float*)(lds + 2 * SHM_V + 2 * SHM_K) + wid * 64; float* li_l = wsl; float* al_l = wsl + 32;
    float m_reg = -1e30f, l_reg = 0; f32x16 o[4] = {}; h8 qr[ND0];
    const f16* Qw = Qb + (long)(wid * QBLK + r32) * LDQ + hi * 8;
#pragma unroll
    for (int d0 = 0; d0 < ND0; ++d0) qr[d0] = *reinterpret_cast<const h8*>(Qw + d0 * 16);
    const int sr = tid >> 4, sc = (tid & 15) * 8, vst0 = v_st(sr, sc), vst1 = v_st(32 + sr, sc);
    int krow[NKCH], kcb[NKCH];
#pragma unroll
    for (int i = 0; i < NKCH; ++i) { const int c = tid + i * 512; krow[i] = c / KCPR; kcb[i] = (c % KCPR) * 16; }
    const int vb0 = (int)(uintptr_t)V_lds + v_rd_base(lane);
    h8 vs0, vs1, ks[NKCH];
    unsigned gvoff[2], gkoff[NKCH]; const int wuni = __builtin_amdgcn_readfirstlane(wid);
    if constexpr (GLDS) {
#pragma unroll
        for (int i = 0; i < 2; ++i) { const int p = i * 512 + tid; const int kk = ((p >> 7) & 7) * 8 + ((p >> 2) & 7), c = ((p >> 5) & 3) * 32 + (p & 3) * 8;
            const int k = (kk & ~0xC) | ((kk & 4) << 1) | ((kk & 8) >> 1); gvoff[i] = (unsigned)(k * LDV + c) * 2u; }
#pragma unroll
        for (int i = 0; i < NKCH; ++i) { const int p = i * 512 + tid; const int row = p / KCPR, cp = p % KCPR; const int cs_ = (cp & ~7) | ((cp & 7) ^ (row & 7));
            gkoff[i] = (unsigned)(row * LDK + cs_ * 8) * 2u; }
    }
#define GSTAGE(b, k0) do { _Pragma("unroll") for (int _i = 0; _i < 2; ++_i) __builtin_amdgcn_global_load_lds((const unsigned*)((const char*)Vh + (size_t)(k0) * (LDV * 2) + gvoff[_i]), \
        (LAS unsigned*)(uintptr_t)(unsigned)((int)(uintptr_t)V_lds + (b) * (int)SHM_V + (_i * 512 + wuni * 64) * 16), 16, 0, 0); \
    _Pragma("unroll") for (int _i = 0; _i < NKCH; ++_i) __builtin_amdgcn_global_load_lds((const unsigned*)((const char*)Kh + (size_t)(k0) * (LDK * 2) + gkoff[_i]), \
        (LAS unsigned*)(uintptr_t)(unsigned)((int)(uintptr_t)K_lds + (b) * (int)SHM_K + (_i * 512 + wuni * 64) * 16), 16, 0, 0); } while (0)
#define SLOAD1(k0) do { vs0 = *reinterpret_cast<const h8*>(&Vh[(long)((k0) + sr) * LDV + sc]); vs1 = *reinterpret_cast<const h8*>(&Vh[(long)((k0) + 32 + sr) * LDV + sc]); \
    _Pragma("unroll") for (int _c = 0; _c < NKCH; ++_c) ks[_c] = *reinterpret_cast<const h8*>((const char*)Kh + (long)((k0) + krow[_c]) * (LDK * 2) + kcb[_c]); } while (0)
#define SWRITE1(b) do { *(h8*)(V_lds + (b) * SHM_V + vst0) = vs0; *(h8*)(V_lds + (b) * SHM_V + vst1) = vs1; \
    _Pragma("unroll") for (int _c = 0; _c < NKCH; ++_c) *(h8*)(K_lds + (b) * SHM_K + KSWZ(krow[_c], kcb[_c])) = ks[_c]; } while (0)
    constexpr int NT = SEQ / KVBLK;
    if constexpr (GLDS) { GSTAGE(0, 0); asm volatile("s_waitcnt vmcnt(0)" ::: "memory"); __syncthreads(); }
    else { SLOAD1(0); asm volatile("s_waitcnt vmcnt(0)" ::: "memory"); SWRITE1(0); __syncthreads(); }
#pragma unroll 1
    for (int j = 0; j < NT; ++j) {
        const int cb = j & 1;
        if constexpr (CONV) conv_tick(*cs, lane);
        if constexpr (GLDS) { if (j + 1 < NT) GSTAGE(cb ^ 1, (j + 1) * KVBLK); } else { if (j + 1 < NT) SLOAD1((j + 1) * KVBLK); }
        SBAR();
        f32x16 p0, p1; float mn, al; h8 pa0, pa1, pa2, pa3;
        qkt_pipe<DQK, (DQK == 192 ? 6 : 8)>(p0, p1, (int)(uintptr_t)K_lds + cb * (int)SHM_K, qr, r32, hi);
        partialSM<DQK>(p0, p1, m_reg, mn, al);
        if (__any(al < 1.f)) { if (hi == 0) al_l[r32] = al; asm volatile("s_waitcnt lgkmcnt(0)" ::: "memory");
#pragma unroll
            for (int d = 0; d < 4; ++d)
#pragma unroll
                for (int r = 0; r < 16; ++r) o[d][r] *= al_l[crow(r, hi)]; }
        finishSM(p0, p1, al, l_reg, pa0, pa1, pa2, pa3); SBAR();
        pv_d0(o, vb0 + cb * (int)SHM_V, pa0, pa1, pa2, pa3);
        if constexpr (GLDS) { asm volatile("s_waitcnt vmcnt(0)" ::: "memory"); } else { if (j + 1 < NT) { SWRITE1(cb ^ 1); } }
        if constexpr (CONV) conv_flush(*cs, lane);
        __syncthreads();
    }
    if (hi == 0) li_l[r32] = l_reg; asm volatile("s_waitcnt lgkmcnt(0)" ::: "memory");
    float rli[16];
#pragma unroll
    for (int r = 0; r < 16; ++r) rli[r] = __builtin_amdgcn_rcpf(li_l[crow(r, hi)]);
    attn_epilogue<LDO>(o, rli, Ob + (long)(wid * QBLK) * LDO, mode, lam, subln, r32, hi);
    asm volatile("s_waitcnt vmcnt(0) lgkmcnt(0)" ::: "memory");
    __syncthreads();
#undef SLOAD1
#undef SWRITE1
#undef GSTAGE
}
#undef KSWZ
#undef SBAR
}

struct Args { const void* in[22]; float* out; unsigned char* ws; int ph_lo, ph_hi, li, pad; };
typedef const __attribute__((address_space(4))) Args* KArgs;
__device__ __forceinline__ KArgs kargs() { KArgs p = (KArgs)__builtin_amdgcn_kernarg_segment_ptr(); asm volatile("" : "+s"(p)); return p; }
struct Frame {
    LAS unsigned char* lds; char* ldsg;
    int tid, lane, wave, vcu, G;
    unsigned char* ws;
};
extern __shared__ __attribute__((aligned(16))) unsigned char g_lds[];
__device__ __forceinline__ Frame mkframe(KArgs a) {
    Frame F; int t = threadIdx.x; asm volatile("" : "+v"(t));
    F.lds = (LAS unsigned char*)g_lds; F.ldsg = (char*)g_lds;
    F.tid = t; F.lane = t & 63; F.wave = __builtin_amdgcn_readfirstlane(t >> 6);
    int g = gridDim.x, bx = blockIdx.x; asm volatile("" : "+s"(g), "+s"(bx));
    F.G = g; F.vcu = (g % 8 == 0) ? (bx % 8) * (g / 8) + bx / 8 : bx;
    F.ws = a->ws;
    return F;
}

__device__ __forceinline__ void sincos_d(double a, float& s, float& c) {
    const double k = __builtin_rint(a * 0.63661977236758134308);
    double r = __builtin_fma(-k, 1.57079632679489655800e+00, a); r = __builtin_fma(-k, 6.12323399573676603587e-17, r);
    const double r2 = r * r;
    double sp = -7.6471637318198164759e-13;
    sp = __builtin_fma(sp, r2, 1.6059043836821614599e-10);
    sp = __builtin_fma(sp, r2, -2.5052108385441718775e-08);
    sp = __builtin_fma(sp, r2, 2.7557319223985890653e-06);
    sp = __builtin_fma(sp, r2, -1.9841269841269841270e-04);
    sp = __builtin_fma(sp, r2, 8.3333333333333333333e-03);
    sp = __builtin_fma(sp, r2, -1.6666666666666666667e-01);
    const double sr = __builtin_fma(sp * r2, r, r);
    double cp = 4.7794773323873852974e-14;
    cp = __builtin_fma(cp, r2, -1.1470745597729724714e-11);
    cp = __builtin_fma(cp, r2, 2.0876756987868098979e-09);
    cp = __builtin_fma(cp, r2, -2.7557319223985890653e-07);
    cp = __builtin_fma(cp, r2, 2.4801587301587301587e-05);
    cp = __builtin_fma(cp, r2, -1.3888888888888888889e-03);
    cp = __builtin_fma(cp, r2, 4.1666666666666666667e-02);
    cp = __builtin_fma(cp, r2, -0.5);
    const double cr = __builtin_fma(cp, r2, 1.0);
    const int q = (int)((long long)k & 3);
    const double ss = (q & 1) ? cr : sr, cc = (q & 1) ? sr : cr;
    s = (float)((q & 2) ? -ss : ss); c = (float)(((q + 1) & 2) ? -cc : cc);
}
__device__ const double INV_M[32] = {
    1.0, 0.7498942093324559, 0.5623413251903491, 0.4216965034285822, 0.31622776601683794, 0.23713737056616552, 0.1778279410038923, 0.1333521432163324,
    0.1, 0.07498942093324558, 0.05623413251903491, 0.04216965034285822, 0.03162277660168379, 0.023713737056616554, 0.01778279410038923, 0.01333521432163324,
    0.01, 0.007498942093324559, 0.005623413251903491, 0.004216965034285822, 0.0031622776601683794, 0.0023713737056616554, 0.001778279410038923, 0.001333521432163324,
    0.001, 0.0007498942093324559, 0.0005623413251903491, 0.0004216965034285822, 0.00031622776601683794, 0.00023713737056616554, 0.0001778279410038923, 0.0001333521432163324 };
__device__ const double INV_D[8] = { 1.0, 0.19392274474868576, 0.03760603093086393, 0.007292664737217109, 0.001414213562373095, 0.0002742481756762073, 5.318295896944988e-05, 1.031338537721246e-05 };

template <class FD>
__device__ __forceinline__ void tr_item64(const float* W, int Nsrc, int K, f16* WT, FD dstrow, LAS float* scr, int kb, int cb, int lane, const float* kscale = nullptr) {
    const int k0 = 64 * kb, c0 = 64 * cb, r4 = lane >> 4, cq = (lane & 15) * 4;
    f32x4 v[16];
#pragma unroll
    for (int i = 0; i < 16; ++i) v[i] = *(const f32x4*)(W + (size_t)(k0 + 4 * i + r4) * Nsrc + c0 + cq);
    if (kscale) {
#pragma unroll
        for (int i = 0; i < 16; ++i) v[i] = v[i] * kscale[k0 + 4 * i + r4]; }
#pragma unroll
    for (int i = 0; i < 16; ++i) { const int k = 4 * i + r4, sw = (i >> 1) * 4;
#pragma unroll
        for (int w = 0; w < 4; ++w) scr[k * 64 + ((cq + w) ^ sw)] = v[i][w]; }
    LDS_WAIT(); asm volatile("" ::: "memory");
    const int c = lane & 7;
#pragma unroll
    for (int j = 0; j < 8; ++j) { const int col = (lane >> 3) + 8 * j; const int dr = dstrow(c0 + col); const LAS float* sp = scr + (8 * c) * 64 + (col ^ (c * 4));
        h8 o; o[0] = (f16)sp[0 * 64]; o[1] = (f16)sp[1 * 64]; o[2] = (f16)sp[2 * 64]; o[3] = (f16)sp[3 * 64]; o[4] = (f16)sp[4 * 64]; o[5] = (f16)sp[5 * 64]; o[6] = (f16)sp[6 * 64]; o[7] = (f16)sp[7 * 64];
        *(h8*)(WT + (size_t)dr * K + k0 + 8 * c) = o; }
    LDS_WAIT(); asm volatile("" ::: "memory");
}
struct RowId { __device__ __forceinline__ int operator()(int c) const { return c; } };
struct RowWin0 { __device__ __forceinline__ int operator()(int c) const { if (c < 640) return c; const int jj = c - 640; return 640 + 2 * (jj & 31) + (jj >> 5); } };
struct RowUq { __device__ __forceinline__ int operator()(int c) const { const int h = c / 192, j = c % 192; if (j < 128) return h * 128 + j; const int jj = j - 128; return 1024 + h * 64 + 2 * (jj & 31) + (jj >> 5); } };
struct RowDiff { __device__ __forceinline__ int operator()(int c) const { if (c >= 2048) return c; const int off = c & 63; if (off >= 16) return c; return (c & ~63) + 2 * (off & 7) + (off >> 3); } };
struct RowMoeIn { __device__ __forceinline__ int operator()(int c) const { const int f = c & 2047; return (f >> 2) * 8 + (f & 3) + ((c >> 11) << 2); } };

__device__ __forceinline__ void p0_prologue() {
    const KArgs a = kargs(); const Frame F = mkframe(a);
    const int tid = F.tid, lane = F.lane;
    {
        const float* cin = (const float*)a->in[1]; const float* ada_w = (const float*)a->in[3]; const float* ada_b = (const float*)a->in[4];
        float* mods = (float*)(F.ws + WS_MODS);
        LAS float* sc = (LAS float*)F.lds; LAS float* red = (LAS float*)(F.lds + 16384);
        for (int i = tid; i < 4096; i += NTHREADS) { const float v = cin[i]; sc[i] = v / (1.0f + __expf(-v)); }
        __syncthreads();
        for (int cb = blockIdx.x; cb < 256; cb += F.G) {
            const int f0 = cb * 48, l = f0 / 6144, e0 = f0 % 6144; const int g = tid / 12, cc = tid % 12;
            if (g < 40) { f32x4 a0 = {0.f, 0.f, 0.f, 0.f}, a1 = a0, a2 = a0, a3 = a0; const float* wp = ada_w + (size_t)l * 1024 * 6144 + e0 + 4 * cc;
                f32x4 w[26];
#pragma unroll
                for (int i = 0; i < 26; ++i) { const int d = g + 40 * i; w[i] = (d < 1024) ? *(const f32x4*)(wp + (size_t)d * 6144) : (f32x4){0.f, 0.f, 0.f, 0.f}; }
#pragma unroll
                for (int i = 0; i < 26; ++i) { const int d = (g + 40 * i) & 1023; a0 += w[i] * sc[d]; a1 += w[i] * sc[1024 + d]; a2 += w[i] * sc[2048 + d]; a3 += w[i] * sc[3072 + d]; }
                LAS f32x4* rp = (LAS f32x4*)red + (g * 12 + cc) * 4; rp[0] = a0; rp[1] = a1; rp[2] = a2; rp[3] = a3; }
            __syncthreads();
            if (tid < 192) { const int c2 = tid % 48, b = tid / 48; float s = 0.f;
#pragma unroll 8
                for (int gg = 0; gg < 40; ++gg) s += red[((gg * 12 + (c2 >> 2)) * 4 + b) * 4 + (c2 & 3)];
                mods[(size_t)(l * 4 + b) * 6144 + e0 + c2] = s + ada_b[l * 6144 + e0 + c2]; }
            __syncthreads();
        }
    }
    {
        const int* pos = (const int*)a->in[2];
        float* cosm = (float*)(F.ws + WS_COSM); float* sinm = (float*)(F.ws + WS_SINM); float* cosd = (float*)(F.ws + WS_COSD); float* sind = (float*)(F.ws + WS_SIND);
        for (int i = blockIdx.x * NTHREADS + tid; i < T * 40; i += F.G * NTHREADS) {
            const int t = i / 40, j = i % 40; const double p = (double)pos[t]; float s, c;
            if (j < 32) { sincos_d(p * INV_M[j], s, c); cosm[(size_t)t * 32 + j] = c; sinm[(size_t)t * 32 + j] = s; }
            else { sincos_d(p * INV_D[j - 32], s, c); cosd[(size_t)t * 8 + (j - 32)] = c; sind[(size_t)t * 8 + (j - 32)] = s; }
        }
    }
    {
        LAS float* scr = (LAS float*)(F.lds + F.wave * 16384);
        const int gw = F.vcu * NWAVES + F.wave, NGW = F.G * NWAVES;
        { f16* z = (f16*)(F.ws + WS_WIN0) + (size_t)704 * 1024; for (int i = blockIdx.x * NTHREADS + tid; i < 8192; i += F.G * NTHREADS) *(u32x4*)(z + (size_t)i * 8) = (u32x4){0u, 0u, 0u, 0u}; }
        __syncthreads();
        constexpr int I0 = 16 * 11, I1 = 6 * 24, I2 = 4 * 32, I3 = 16 * 16, I4 = 16 * 48, I5 = 16 * 16;
        constexpr int ISM = I0 + I1 + I2 + I3 + I4 + I5;
        constexpr int IMI = 16 * 64, IMO = 32 * 16;
        constexpr int NITEMS = ISM;
        for (int it = gw; it < NITEMS; it += NGW) {
            int r = it;
            if (r < I0) { tr_item64((const float*)a->in[9], 704, 1024, (f16*)(F.ws + WS_WIN0), RowWin0(), scr, r / 11, r % 11, lane); continue; } r -= I0;
            if (r < I1) { tr_item64((const float*)a->in[12], 1536, 384, (f16*)(F.ws + WS_WUQ), RowUq(), scr, r / 24, r % 24, lane, (const float*)a->in[10]); continue; } r -= I1;
            if (r < I2) { tr_item64((const float*)a->in[13], 2048, 256, (f16*)(F.ws + WS_WUKV), RowId(), scr, r / 32, r % 32, lane, (const float*)a->in[11]); continue; } r -= I2;
            if (r < I3) { tr_item64((const float*)a->in[14], 1024, 1024, (f16*)(F.ws + WS_WO0), RowId(), scr, r / 16, r % 16, lane); continue; } r -= I3;
            if (r < I4) { tr_item64((const float*)a->in[15], 3072, 1024, (f16*)(F.ws + WS_WIN1), RowDiff(), scr, r / 48, r % 48, lane); continue; } r -= I4;
            if (r < I5) { tr_item64((const float*)a->in[18], 1024, 1024, (f16*)(F.ws + WS_WO1), RowId(), scr, r / 16, r % 16, lane); continue; }
        }
    }
}

__device__ __forceinline__ void mod_rows_p1() {
    const KArgs a = kargs(); const Frame F = mkframe(a);
    const float* x = (const float*)a->in[0]; const float* mods_l = (const float*)(F.ws + WS_MODS); f16* out = (f16*)(F.ws + WS_HA);
    const int gw = F.vcu * NWAVES + F.wave, NGW = F.G * NWAVES, lane = F.lane;
    for (int m0 = gw; m0 < T; m0 += 2 * NGW) {
        f32x4 v[2][4];
#pragma unroll
        for (int u = 0; u < 2; ++u) { const int m = m0 + u * NGW; if (m < T) {
#pragma unroll
            for (int j = 0; j < 4; ++j) v[u][j] = *(const f32x4*)(x + (size_t)m * DM + 4 * lane + 256 * j); } }
#pragma unroll
        for (int u = 0; u < 2; ++u) { const int m = m0 + u * NGW; if (m < T) { const float* mb = mods_l + (m >> 12) * 6144;
#pragma unroll
            for (int j = 0; j < 4; ++j) { const int c = 4 * lane + 256 * j; const f32x4 sh = *(const f32x4*)(mb + c), sc = *(const f32x4*)(mb + 1024 + c);
                const f32x4 h = v[u][j] * (sc + 1.0f) + sh; h4 o; o[0] = (f16)h[0]; o[1] = (f16)h[1]; o[2] = (f16)h[2]; o[3] = (f16)h[3];
                *(h4*)(out + (size_t)m * DM + c) = o; } } }
    }
}

#define RCOL(lane, j) ((((j) >> 1) << 9) + 8 * (lane) + 4 * ((j) & 1))
__device__ __forceinline__ void h8_to_f4(const h8 v, f32x4& a, f32x4& b) { a = (f32x4){(float)v[0], (float)v[1], (float)v[2], (float)v[3]}; b = (f32x4){(float)v[4], (float)v[5], (float)v[6], (float)v[7]}; }
__device__ __forceinline__ void ln_router(int l) {
    const KArgs a = kargs(); const Frame F = mkframe(a);
    const float* lng = (const float*)a->in[5] + l * DM; const float* lnb = (const float*)a->in[6] + l * DM; const float* router_w = (const float*)a->in[19] + (size_t)l * DM * NE;
    const float* mods_l = (const float*)(F.ws + WS_MODS) + (size_t)l * 4 * 6144;
    const f16* pre = (const f16*)(F.ws + WS_PRE); float* stat = (float*)(F.ws + WS_STAT); f16* hB = (f16*)(F.ws + WS_HB); float* aff = (float*)(F.ws + WS_AFF);
    LAS float* rwT = (LAS float*)F.lds;
    for (int d = F.tid; d < 1024; d += NTHREADS) {
        const int seg = d >> 9, w = d & 511, pos = seg * 512 + ((w >> 2) & 1) * 256 + (w >> 3) * 4 + (w & 3);
        f32x4 r[4];
#pragma unroll
        for (int q = 0; q < 4; ++q) r[q] = *(const f32x4*)(router_w + (size_t)d * 16 + 4 * q);
#pragma unroll
        for (int q = 0; q < 4; ++q) { rwT[(4 * q + 0) * 1024 + pos] = r[q][0]; rwT[(4 * q + 1) * 1024 + pos] = r[q][1]; rwT[(4 * q + 2) * 1024 + pos] = r[q][2]; rwT[(4 * q + 3) * 1024 + pos] = r[q][3]; } }
    __syncthreads();
    const int gw = F.vcu * NWAVES + F.wave, NGW = F.G * NWAVES, lane = F.lane;
    f32x4 gpar[4], bpar[4];
#pragma unroll
    for (int j = 0; j < 4; ++j) { gpar[j] = *(const f32x4*)(lng + RCOL(lane, j)); bpar[j] = *(const f32x4*)(lnb + RCOL(lane, j)); }
    for (int m0 = gw; m0 < T; m0 += 2 * NGW) {
        h8 pv[2][2]; f32x4 shv[2][4], scv[2][4];
#pragma unroll
        for (int u = 0; u < 2; ++u) { const int m = (m0 + u * NGW < T) ? m0 + u * NGW : m0; pv[u][0] = *(const h8*)(pre + (size_t)m * DM + 8 * lane); pv[u][1] = *(const h8*)(pre + (size_t)m * DM + 512 + 8 * lane);
            const float* mbu = mods_l + (m >> 12) * 6144;
#pragma unroll
            for (int j = 0; j < 4; ++j) { shv[u][j] = *(const f32x4*)(mbu + 3072 + RCOL(lane, j)); scv[u][j] = *(const f32x4*)(mbu + 4096 + RCOL(lane, j)); } }
#pragma unroll
        for (int u = 0; u < 2; ++u) { const int m = m0 + u * NGW; if (m < T) {
        const int b = m >> 12, s_ = m & 4095; const float* mb = mods_l + b * 6144;
        f32x4 v[4]; h8_to_f4(pv[u][0], v[0], v[1]); h8_to_f4(pv[u][1], v[2], v[3]); float s = 0.f;
#pragma unroll
        for (int j = 0; j < 4; ++j) s += (v[j][0] + v[j][1]) + (v[j][2] + v[j][3]);
        const float mean = wave_sum(s) * (1.f / DM); float s2 = 0.f;
#pragma unroll
        for (int j = 0; j < 4; ++j) { v[j] = v[j] - mean; s2 += (v[j][0] * v[j][0] + v[j][1] * v[j][1]) + (v[j][2] * v[j][2] + v[j][3] * v[j][3]); }
        const float rstd = 1.0f / sqrtf(wave_sum(s2) * (1.f / DM) + LN_EPS);
        if (lane == 0) { f32x2 st = {mean, rstd}; *(f32x2*)(stat + (size_t)m * 2) = st; }
        float lg[16];
#pragma unroll
        for (int e = 0; e < 16; ++e) lg[e] = 0.f;
        f32x4 hh[4];
#pragma unroll
        for (int j = 0; j < 4; ++j) { const int c = RCOL(lane, j);
            const f32x4 g = gpar[j], bb = bpar[j], sh = shv[u][j], sc = scv[u][j];
            const f32x4 xn = v[j] * rstd * g + bb; const f32x4 h = xn * (sc + 1.0f) + sh; hh[j] = h;
#pragma unroll
            for (int e = 0; e < 16; ++e) { const f32x4 w = *(const LAS f32x4*)(rwT + e * 1024 + (j >> 1) * 512 + (j & 1) * 256 + lane * 4); lg[e] = __builtin_fmaf(h[3], w[3], __builtin_fmaf(h[2], w[2], __builtin_fmaf(h[1], w[1], __builtin_fmaf(h[0], w[0], lg[e])))); }
            asm volatile("" ::: "memory"); }
        *(h8*)(hB + (size_t)m * DM + 8 * lane) = pack8(hh[0], hh[1]); *(h8*)(hB + (size_t)m * DM + 512 + 8 * lane) = pack8(hh[2], hh[3]);
        float r8[8], r4[4], r2[2], r1;
#pragma unroll
        for (int i = 0; i < 8; ++i) { auto r = __builtin_amdgcn_permlane32_swap(__float_as_uint(lg[i]), __float_as_uint(lg[8 + i]), false, false); r8[i] = __uint_as_float(r[0]) + __uint_as_float(r[1]); }
#pragma unroll
        for (int i = 0; i < 4; ++i) { auto r = __builtin_amdgcn_permlane16_swap(__float_as_uint(r8[i]), __float_as_uint(r8[4 + i]), false, false); r4[i] = __uint_as_float(r[0]) + __uint_as_float(r[1]); }
        { const bool up = (lane & 8) != 0;
#pragma unroll
          for (int i = 0; i < 2; ++i) { const float keep = up ? r4[2 + i] : r4[i], give = up ? r4[i] : r4[2 + i]; r2[i] = keep + __shfl_xor(give, 8); } }
        { const bool up = (lane & 4) != 0; const float keep = up ? r2[1] : r2[0], give = up ? r2[0] : r2[1]; r1 = keep + __shfl_xor(give, 4); }
        r1 += __shfl_xor(r1, 1); r1 += __shfl_xor(r1, 2);
        float mx = r1;
        mx = fmaxf(mx, __shfl_xor(mx, 4)); mx = fmaxf(mx, __shfl_xor(mx, 8)); mx = fmaxf(mx, __shfl_xor(mx, 16)); mx = fmaxf(mx, __shfl_xor(mx, 32));
        const float pe = __expf(r1 - mx); float den = pe;
        den += __shfl_xor(den, 4); den += __shfl_xor(den, 8); den += __shfl_xor(den, 16); den += __shfl_xor(den, 32);
        if ((lane & 3) == 0) aff[(size_t)(b * 16 + (lane >> 2)) * SEQ + s_] = pe / den;
        } }
    }
    __syncthreads();
}

__device__ __forceinline__ int block_excl_scan(int v, LAS int* tmp, int tid, int& total) {
    const int lane = tid & 63, wid = tid >> 6; int x = v;
#pragma unroll
    for (int o = 1; o < 64; o <<= 1) { const int y = __shfl_up(x, o); if (lane >= o) x += y; }
    if (lane == 63) tmp[wid] = x;
    __syncthreads();
    int base = 0, tot = 0;
#pragma unroll
    for (int w = 0; w < 8; ++w) { const int t = tmp[w]; if (w < wid) base += t; tot += t; }
    __syncthreads();
    total = tot; return base + x - v;
}
__device__ __forceinline__ void topk_phase() {
    const KArgs a = kargs(); const Frame F = mkframe(a);
    const float* aff = (const float*)(F.ws + WS_AFF); float* gate = (float*)(F.ws + WS_GATE); int* rowtok = (int*)(F.ws + WS_ROWTOK); int* inv = (int*)(F.ws + WS_INV);
    LAS unsigned* hist = (LAS unsigned*)F.lds; LAS unsigned* selw = hist + 256; LAS int* tmp = (LAS int*)(hist + 272);
    const int tid = F.tid;
    for (int p = blockIdx.x; p < NB * NE; p += F.G) { const int b = p >> 4, e = p & 15;
        const float* ap = aff + (size_t)p * SEQ + 8 * tid; unsigned key[8];
        { const f32x4 a0 = *(const f32x4*)ap, a1 = *(const f32x4*)(ap + 4);
          key[0] = __float_as_uint(a0[0]); key[1] = __float_as_uint(a0[1]); key[2] = __float_as_uint(a0[2]); key[3] = __float_as_uint(a0[3]);
          key[4] = __float_as_uint(a1[0]); key[5] = __float_as_uint(a1[1]); key[6] = __float_as_uint(a1[2]); key[7] = __float_as_uint(a1[3]); }
        unsigned prefix = 0u, kk = CAP;
        for (int pass = 0; pass < 4; ++pass) { const int shift = 24 - 8 * pass;
            if (tid < 256) hist[tid] = 0u;
            __syncthreads();
#pragma unroll
            for (int j = 0; j < 8; ++j) { const bool match = (pass == 0) || ((key[j] >> (shift + 8)) == prefix); if (match) atomicAdd((unsigned*)&hist[(key[j] >> shift) & 255u], 1u); }
            __syncthreads();
            { const int hv = (tid < 256) ? (int)hist[255 - tid] : 0; int tot_; const int Sp = block_excl_scan(hv, tmp, tid, tot_);
              if (tid < 256 && (unsigned)Sp < kk && kk <= (unsigned)(Sp + hv)) { selw[0] = 255u - (unsigned)tid; selw[1] = kk - (unsigned)Sp; } }
            __syncthreads();
            prefix = (prefix << 8) | selw[0]; kk = selw[1];
            __syncthreads();
        }
        int ce = 0;
#pragma unroll
        for (int j = 0; j < 8; ++j) ce += (key[j] == prefix) ? 1 : 0;
        int tot; int eqr = block_excl_scan(ce, tmp, tid, tot);
        unsigned selm = 0u; int cs = 0;
#pragma unroll
        for (int j = 0; j < 8; ++j) { bool sel = key[j] > prefix; if (key[j] == prefix) { sel = (unsigned)eqr < kk; ++eqr; } if (sel) { selm |= 1u << j; ++cs; } }
        int slot = block_excl_scan(cs, tmp, tid, tot);
#pragma unroll
        for (int j = 0; j < 8; ++j) { const int s_ = 8 * tid + j; const int tok = b * SEQ + s_; const bool sel = (selm >> j) & 1u;
            if (sel) { const int row = e * EROWS + b * CAP + slot; rowtok[row] = tok; gate[row] = __uint_as_float(key[j]); inv[(size_t)tok * 16 + e] = slot; ++slot; }
            else inv[(size_t)tok * 16 + e] = -1; }
        __syncthreads();
    }
}
__device__ __forceinline__ void combine_ln(int l) {
    const KArgs a = kargs(); const Frame F = mkframe(a);
    const float* lng1 = (const float*)a->in[5] + l * DM; const float* lnb1 = (const float*)a->in[6] + l * DM;
    const float* lng = (const float*)a->in[7] + l * DM; const float* lnb = (const float*)a->in[8] + l * DM;
    const float* mods_l = (const float*)(F.ws + WS_MODS) + (size_t)l * 4 * 6144; const float* mods_next = (const float*)(F.ws + WS_MODS) + (size_t)4 * 6144;
    float* xo32 = a->out; f16* x2 = (f16*)(F.ws + WS_X2); f16* hA = (f16*)(F.ws + WS_HA);
    const f16* pre = (const f16*)(F.ws + WS_PRE); const float* stat = (const float*)(F.ws + WS_STAT); const f16* y = (const f16*)(F.ws + WS_Y); const int* inv = (const int*)(F.ws + WS_INV);
    const int gw = F.vcu * NWAVES + F.wave, NGW = F.G * NWAVES, lane = F.lane;
    for (int m0 = gw; m0 < T; m0 += 2 * NGW) {
        int myinv[2]; h8 pv[2][2]; f32x2 st[2];
#pragma unroll
        for (int u = 0; u < 2; ++u) { const int m = (m0 + u * NGW < T) ? m0 + u * NGW : m0; myinv[u] = inv[(size_t)m * 16 + (lane & 15)]; st[u] = *(const f32x2*)(stat + (size_t)m * 2);
            pv[u][0] = *(const h8*)(pre + (size_t)m * DM + 8 * lane); pv[u][1] = *(const h8*)(pre + (size_t)m * DM + 512 + 8 * lane); }
#pragma unroll
        for (int u = 0; u < 2; ++u) { const int m = m0 + u * NGW; if (m < T) {
        const int b = m >> 12; const float* mb = mods_l + b * 6144;
        f32x4 f[4];
#pragma unroll
        for (int j = 0; j < 4; ++j) f[j] = (f32x4){0.f, 0.f, 0.f, 0.f};
        unsigned mask = (unsigned)(__ballot(myinv[u] >= 0) & 0xFFFFull);
        while (mask) {
            const int e0 = __builtin_ctz(mask); mask &= mask - 1u; const bool two = mask != 0u; const int e1 = two ? __builtin_ctz(mask) : e0; mask &= mask - 1u;
            const int s0 = __shfl(myinv[u], e0), s1 = __shfl(myinv[u], e1);
            const f16* y0 = y + (size_t)(e0 * EROWS + b * CAP + s0) * DM; const f16* y1 = y + (size_t)(e1 * EROWS + b * CAP + s1) * DM;
            const h8 a00 = *(const h8*)(y0 + 8 * lane), a01 = *(const h8*)(y0 + 512 + 8 * lane), a10 = *(const h8*)(y1 + 8 * lane), a11 = *(const h8*)(y1 + 512 + 8 * lane);
            const float w1 = two ? 1.0f : 0.0f; f32x4 t0, t1;
            h8_to_f4(a00, t0, t1); f[0] += t0; f[1] += t1; h8_to_f4(a01, t0, t1); f[2] += t0; f[3] += t1;
            h8_to_f4(a10, t0, t1); f[0] += t0 * w1; f[1] += t1 * w1; h8_to_f4(a11, t0, t1); f[2] += t0 * w1; f[3] += t1 * w1;
        }
        f32x4 v[4]; h8_to_f4(pv[u][0], v[0], v[1]); h8_to_f4(pv[u][1], v[2], v[3]); float s = 0.f;
#pragma unroll
        for (int j = 0; j < 4; ++j) { const int c = RCOL(lane, j); const f32x4 g1 = *(const f32x4*)(lng1 + c), b1 = *(const f32x4*)(lnb1 + c), g2 = *(const f32x4*)(mb + 5120 + c);
            const f32x4 x1 = (v[j] - st[u][0]) * st[u][1] * g1 + b1;
            v[j] = x1 * ALPHA + (g2 + 1.0f) * f[j]; s += (v[j][0] + v[j][1]) + (v[j][2] + v[j][3]); }
        const float mean = wave_sum(s) * (1.f / DM); float s2 = 0.f;
#pragma unroll
        for (int j = 0; j < 4; ++j) { v[j] = v[j] - mean; s2 += (v[j][0] * v[j][0] + v[j][1] * v[j][1]) + (v[j][2] * v[j][2] + v[j][3] * v[j][3]); }
        const float rstd = 1.0f / sqrtf(wave_sum(s2) * (1.f / DM) + LN_EPS);
        f32x4 xn[4];
#pragma unroll
        for (int j = 0; j < 4; ++j) { const int c = RCOL(lane, j); const f32x4 g = *(const f32x4*)(lng + c), bb = *(const f32x4*)(lnb + c); xn[j] = v[j] * rstd * g + bb; }
        if (l == 0) {
            *(h8*)(x2 + (size_t)m * DM + 8 * lane) = pack8(xn[0], xn[1]); *(h8*)(x2 + (size_t)m * DM + 512 + 8 * lane) = pack8(xn[2], xn[3]);
            const float* mn = mods_next + b * 6144; f32x4 hv[4];
#pragma unroll
            for (int j = 0; j < 4; ++j) { const int c = RCOL(lane, j); const f32x4 sh = *(const f32x4*)(mn + c), sc = *(const f32x4*)(mn + 1024 + c); hv[j] = xn[j] * (sc + 1.0f) + sh; }
            *(h8*)(hA + (size_t)m * DM + 8 * lane) = pack8(hv[0], hv[1]); *(h8*)(hA + (size_t)m * DM + 512 + 8 * lane) = pack8(hv[2], hv[3]);
        } else {
#pragma unroll
            for (int j = 0; j < 4; ++j) *(f32x4*)(xo32 + (size_t)m * DM + RCOL(lane, j)) = xn[j];
        }
        } }
    }
}

__device__ __forceinline__ void attn_mla() {
    const KArgs a = kargs(); const Frame F = mkframe(a);
    const f16* Q = (const f16*)(F.ws + WS_Q); const f16* K = (const f16*)(F.ws + WS_K); const f16* V = (const f16*)(F.ws + WS_V); f16* O = (f16*)(F.ws + WS_O);
    att::ConvStream cs; att::conv_init(cs, (const float*)a->in[20], (const float*)a->in[21], (f16*)(F.ws + WS_MOEIN), (f16*)(F.ws + WS_MOEOUT), 0, F.vcu * NWAVES + F.wave, F.G * NWAVES, 4, F.ldsg + 83968 + F.wave * 4096);
    for (int u = F.vcu; u < NB * 8 * 16; u += F.G) { const int qb = u & 15, bh = u >> 4, h = bh & 7, b = bh >> 3;
        att::attn_body_simple<192, 1536, 1536, 1024, 1024, true, true>(Q + (size_t)(b * SEQ + qb * 256) * 1536 + h * 192, K + (size_t)(b * SEQ) * 1536 + h * 192, V + (size_t)(b * SEQ) * 1024 + h * 128,
                                                                 O + (size_t)(b * SEQ + qb * 256) * 1024 + h * 128, F.ldsg, 0, 0.f, nullptr, &cs); }
    while (cs.step < cs.step_end) { cs.it = 0; att::conv_tick(cs, F.lane); att::conv_flush(cs, F.lane); }
    att::conv_flush(cs, F.lane); att::conv_drain(cs, F.lane);
}
__device__ __forceinline__ void attn_diff() {
    const KArgs a = kargs(); const Frame F = mkframe(a);
    const f16* QKV = (const f16*)(F.ws + WS_QKV1); f16* O = (f16*)(F.ws + WS_O);
    const float* lamv = (const float*)a->in[16]; const float* subln = (const float*)a->in[17];
    const float l01 = wave_sum(lamv[F.lane] * lamv[64 + F.lane]), l23 = wave_sum(lamv[128 + F.lane] * lamv[192 + F.lane]);
    const float lam = expf(l01) - expf(l23) + LAMBDA_INIT;
    att::ConvStream cs; att::conv_init(cs, (const float*)a->in[20], (const float*)a->in[21], (f16*)(F.ws + WS_MOEIN), (f16*)(F.ws + WS_MOEOUT), 1, F.vcu * NWAVES + F.wave, F.G * NWAVES, 8, F.ldsg + 51200 + F.wave * 4096);
    for (int u = F.vcu; u < NB * 8 * 16; u += F.G) { const int qb = u & 15, bh = u >> 4, h = bh & 7, b = bh >> 3;
        f16* Ob = O + (size_t)(b * SEQ + qb * 256) * 1024 + h * 128; const f16* Vh = QKV + (size_t)(b * SEQ) * 3072 + 2048 + h * 128;
#pragma unroll 1
        for (int c = 0; c < 2; ++c) { const int hh = 2 * h + c;
            att::attn_body_simple<64, 3072, 3072, 3072, 1024, true, true>(QKV + (size_t)(b * SEQ + qb * 256) * 3072 + hh * 64, QKV + (size_t)(b * SEQ) * 3072 + 1024 + hh * 64, Vh, Ob, F.ldsg, c, lam, subln, &cs); } }
    cs.it = 0;
    while (cs.step < cs.step_end) { cs.it = 0; att::conv_tick(cs, F.lane); att::conv_flush(cs, F.lane); }
    att::conv_flush(cs, F.lane); att::conv_drain(cs, F.lane);
}

__device__ __forceinline__ void ph_gemm_lat() { const KArgs a = kargs(); const Frame F = mkframe(a);
    pg8::Gemm g{(const f16*)(F.ws + WS_HA), (const f16*)(F.ws + WS_WIN0), T, 768, 1024, 1 << 30, 0, nullptr}; pg8::StaticOrder S; S.init(T, 768, F.G, (int)blockIdx.x);
    EpiLat E{(f16*)(F.ws + WS_CQN), (f16*)(F.ws + WS_CKVN), (f16*)(F.ws + WS_K), (float*)(F.ws + WS_PQ), (float*)(F.ws + WS_PKV), (const float*)(F.ws + WS_COSM), (const float*)(F.ws + WS_SINM)}; pg8::gemm_phase<EpiLat>(F.lds, g, S, E); }
__device__ __forceinline__ void ph_gemm_q() { const KArgs a = kargs(); const Frame F = mkframe(a);
    pg8::Gemm g{(const f16*)(F.ws + WS_CQN), (const f16*)(F.ws + WS_WUQ), T, 1024, 384, 1 << 30, 0, nullptr}; pg8::StaticOrder S; S.init(T, 1024, F.G, (int)blockIdx.x);
    EpiQNope E{(f16*)(F.ws + WS_Q), (const float*)(F.ws + WS_PQ)}; pg8::gemm_phase<EpiQNope>(F.lds, g, S, E); }
__device__ __forceinline__ void ph_gemm_qr() { const KArgs a = kargs(); const Frame F = mkframe(a);
    pg8::Gemm g{(const f16*)(F.ws + WS_CQN), (const f16*)(F.ws + WS_WUQ) + (size_t)1024 * 384, T, 512, 384, 1 << 30, 0, nullptr}; pg8::StaticOrder S; S.init(T, 512, F.G, (int)blockIdx.x);
    EpiQRope E{(f16*)(F.ws + WS_Q), (const float*)(F.ws + WS_COSM), (const float*)(F.ws + WS_SINM), (const float*)(F.ws + WS_PQ)}; pg8::gemm_phase<EpiQRope>(F.lds, g, S, E); }
__device__ __forceinline__ void ph_gemm_kv() { const KArgs a = kargs(); const Frame F = mkframe(a);
    pg8::Gemm g{(const f16*)(F.ws + WS_CKVN), (const f16*)(F.ws + WS_WUKV), T, 2048, 256, 1 << 30, 0, nullptr}; pg8::StaticOrder S; S.init(T, 2048, F.G, (int)blockIdx.x);
    EpiKV E{(f16*)(F.ws + WS_K), (f16*)(F.ws + WS_V), (const float*)(F.ws + WS_PKV)}; pg8::gemm_phase<EpiKV>(F.lds, g, S, E); }
__device__ __forceinline__ void ph_gemm_o(int l) { const KArgs a = kargs(); const Frame F = mkframe(a);
    pg8::Gemm g{(const f16*)(F.ws + WS_O), (const f16*)(F.ws + (l == 0 ? WS_WO0 : WS_WO1)), T, 1024, 1024, 1 << 30, 0, nullptr}; pg8::StaticOrder S; S.init(T, 1024, F.G, (int)blockIdx.x);
    const float* gm = (const float*)(F.ws + WS_MODS) + (size_t)l * 4 * 6144 + 2048;
    if (l == 0) { EpiPre<false> E{a->in[0], gm, (f16*)(F.ws + WS_PRE)}; pg8::gemm_phase<EpiPre<false>>(F.lds, g, S, E); }
    else { EpiPre<true> E{(const void*)(F.ws + WS_X2), gm, (f16*)(F.ws + WS_PRE)}; pg8::gemm_phase<EpiPre<true>>(F.lds, g, S, E); } }
__device__ __forceinline__ void ph_gemm_diffin() { const KArgs a = kargs(); const Frame F = mkframe(a);
    pg8::Gemm g{(const f16*)(F.ws + WS_HA), (const f16*)(F.ws + WS_WIN1), T, 3072, 1024, 1 << 30, 0, nullptr}; pg8::StaticOrder S; S.init(T, 3072, F.G, (int)blockIdx.x);
    EpiDiffIn E{(f16*)(F.ws + WS_QKV1), (const float*)(F.ws + WS_COSD), (const float*)(F.ws + WS_SIND)}; pg8::gemm_phase<EpiDiffIn>(F.lds, g, S, E); }
__device__ __forceinline__ void ph_gemm_up(int l) { const KArgs a = kargs(); const Frame F = mkframe(a);
    pg8::Gemm g{(const f16*)(F.ws + WS_HB), (const f16*)(F.ws + WS_MOEIN) + (size_t)l * NE * 4096 * 1024, MROWS, 4096, 1024, EROWS / 256, (size_t)4096 * 1024, (const int*)(F.ws + WS_ROWTOK)}; pg8::StaticOrder S; S.init(MROWS, 4096, F.G, (int)blockIdx.x);
    EpiUp E{(f16*)(F.ws + WS_ACT)}; pg8::gemm_phase<EpiUp, true, true, true>(F.lds, g, S, E); }
__device__ __forceinline__ void ph_gemm_down(int l) { const KArgs a = kargs(); const Frame F = mkframe(a);
    pg8::Gemm g{(const f16*)(F.ws + WS_ACT), (const f16*)(F.ws + WS_MOEOUT) + (size_t)l * NE * 1024 * 2048, MROWS, 1024, 2048, EROWS / 256, (size_t)1024 * 2048, nullptr}; pg8::StaticOrder S; S.init(MROWS, 1024, F.G, (int)blockIdx.x);
    EpiDown E{(f16*)(F.ws + WS_Y), (const float*)(F.ws + WS_GATE)}; pg8::gemm_phase<EpiDown>(F.lds, g, S, E); }

constexpr int NPHASES = 24;
__global__ void __launch_bounds__(NTHREADS, 2) mk_fwd(Args args) {
    LAS unsigned char* ldsp = (LAS unsigned char*)g_lds;
    volatile LAS unsigned* MISC = (volatile LAS unsigned*)(ldsp + MISC_OFF);
    for (int u = threadIdx.x; u < (LDS_BYTES - LDSCTL_OFF) / 4; u += NTHREADS) ((LAS unsigned*)(ldsp + LDSCTL_OFF))[u] = 0u;
    __syncthreads();
    XcdBarrier bar = xcd_barrier_post((unsigned*)(args.ws + WS_CTL) + CW_BAR + args.li * XCD_BAR_WORDS, MISC + 8);
    const int lo = args.ph_lo, hi = args.ph_hi;
#ifndef PH_MASK
#define PH_MASK 0xFFFFFFFFu
#endif
#define IN(k) (((PH_MASK >> (k)) & 1u) && lo <= (k) && (k) < hi)
#define SEAM(k) do { if (lo <= (k) && (k) + 1 < hi) xcd_barrier(bar); } while (0)
#ifndef REP_MASK
#define REP_MASK 0u
#endif
#define RUN(k, call) do { if (IN(k)) { call; if ((REP_MASK >> (k)) & 1u) { __syncthreads(); call; } } } while (0)
    RUN(0, p0_prologue());      SEAM(0);
    RUN(1, mod_rows_p1());      SEAM(1);
    RUN(2, ph_gemm_lat());      SEAM(2);
    RUN(4, ph_gemm_q()); RUN(4, ph_gemm_qr());
    RUN(5, ph_gemm_kv());       SEAM(5);
    RUN(6, attn_mla());         SEAM(6);
#pragma unroll 1
    for (int l = 0; l < 2; ++l) {
        const int pb = (l == 0) ? 7 : 17;
        if (l == 1) {
            RUN(14, ph_gemm_diffin()); SEAM(14);
            RUN(15, attn_diff());      SEAM(15);
        }
        RUN(pb + 0, ph_gemm_o(l));     SEAM(pb + 0);
        RUN(pb + 1, ln_router(l));     SEAM(pb + 1);
        RUN(pb + 2, topk_phase());     SEAM(pb + 2);
        RUN(pb + 4, ph_gemm_up(l));    SEAM(pb + 4);
        RUN(pb + 5, ph_gemm_down(l));  SEAM(pb + 5);
        RUN(pb + 6, combine_ln(l));
        if (l == 0) SEAM(pb + 6);
    }
#undef IN
#undef SEAM
}

extern "C" void kernel_launch(void* const* d_in, const int* in_sizes, int n_in, void* d_out, int out_size, void* d_ws, size_t ws_size, hipStream_t stream) {
    static int grid = 0;
    if (grid == 0) {
        if (n_in != 22 || in_sizes[0] != T * DM || out_size != T * DM || ws_size < WS_END) {
            fprintf(stderr, "kernel_launch: shape/workspace mismatch: n_in %d in0 %d out %d ws %zu (need %zu)\n", n_in, n_in > 0 ? in_sizes[0] : -1, out_size, ws_size, (size_t)WS_END); grid = -1; return; }
        int dev = 0, cus = 0, per_cu = 0;
        if (hipGetDevice(&dev) != hipSuccess || hipDeviceGetAttribute(&cus, hipDeviceAttributeMultiprocessorCount, dev) != hipSuccess) { fprintf(stderr, "kernel_launch: device query failed\n"); grid = -1; return; }
        if (hipFuncSetAttribute((const void*)mk_fwd, hipFuncAttributeMaxDynamicSharedMemorySize, LDS_BYTES) != hipSuccess) { fprintf(stderr, "kernel_launch: hipFuncSetAttribute failed\n"); grid = -1; return; }
        if (hipOccupancyMaxActiveBlocksPerMultiprocessor(&per_cu, (const void*)mk_fwd, NTHREADS, LDS_BYTES) != hipSuccess || per_cu < 1)
            fprintf(stderr, "kernel_launch: note: occupancy query reports %d workgroups per CU\n", per_cu);
        (void)hipGetLastError();
        grid = cus;
    }
    if (grid < 0) return;
    if (hipMemsetAsync((char*)d_ws + WS_CTL, 0, CTL_ZERO_BYTES, stream) != hipSuccess) { fprintf(stderr, "kernel_launch: memset failed\n"); return; }
    Args a{};
    for (int i = 0; i < 22; ++i) a.in[i] = d_in[i];
    a.out = (float*)d_out; a.ws = (unsigned char*)d_ws;
#if MK_CUTS == 1
    a.ph_lo = 0; a.ph_hi = NPHASES; a.li = 0;
    hipLaunchKernelGGL(mk_fwd, dim3(grid), dim3(NTHREADS), LDS_BYTES, stream, a);
#else
    for (int p = 0; p < NPHASES; ++p) { a.ph_lo = p; a.ph_hi = p + 1; a.li = 0; hipLaunchKernelGGL(mk_fwd, dim3(grid), dim3(NTHREADS), LDS_BYTES, stream, a); }
#endif
    const hipError_t le = hipPeekAtLastError();
    if (le != hipSuccess) fprintf(stderr, "kernel_launch: launch failed: %s\n", hipGetErrorName(le));
}
```

```cpp
#include <hip/hip_runtime.h>
#include <cstdio>
#include <cstdint>

#ifndef MK_CUTS
#define MK_CUTS 1
#endif


#define LAS __attribute__((address_space(3)))
#define GAS __attribute__((address_space(1)))
typedef _Float16 f16;
typedef _Float16 h8 __attribute__((ext_vector_type(8)));
typedef _Float16 h4 __attribute__((ext_vector_type(4)));
typedef _Float16 h2 __attribute__((ext_vector_type(2)));
typedef short s16x4 __attribute__((ext_vector_type(4)));
typedef float f32x4 __attribute__((ext_vector_type(4)));
typedef float f32x2 __attribute__((ext_vector_type(2)));
typedef float f32x16 __attribute__((ext_vector_type(16)));
typedef unsigned u32x4 __attribute__((ext_vector_type(4)));
typedef unsigned u32x2 __attribute__((ext_vector_type(2)));

constexpr int NB = 4, SEQ = 4096, DM = 1024, T = NB * SEQ;
constexpr int NE = 16, FF = 2048, CAP = 512, EROWS = NB * CAP;
constexpr int MROWS = NE * EROWS;
constexpr float ALPHA = 1.4142135623730951f;
constexpr float LN_EPS = 1e-5f, LAT_EPS = 1e-6f;
constexpr float LAMBDA_INIT = 0.35550906759096926f;
constexpr int NWAVES = 8, NTHREADS = 512;

constexpr size_t MiB = 1u << 20;
constexpr size_t WS_CTL = 0, CTL_ZERO_BYTES = 1 * MiB;
constexpr size_t WS_MODS = 1 * MiB;
constexpr size_t WS_COSM = 2 * MiB, WS_SINM = 4 * MiB;
constexpr size_t WS_COSD = 6 * MiB, WS_SIND = 6 * MiB + 512 * 1024;
constexpr size_t WS_AFF = 7 * MiB;
constexpr size_t WS_GATE = 8 * MiB;
constexpr size_t WS_ROWTOK = 8 * MiB + 512 * 1024;
constexpr size_t WS_INV = 9 * MiB;
constexpr size_t WS_WIN0 = 16 * MiB;
constexpr size_t WS_WUQ = 18 * MiB;
constexpr size_t WS_WUKV = 20 * MiB;
constexpr size_t WS_WO0 = 22 * MiB;
constexpr size_t WS_WIN1 = 24 * MiB;
constexpr size_t WS_WO1 = 30 * MiB;
constexpr size_t WS_MOEIN = 32 * MiB;
constexpr size_t WS_MOEOUT = 288 * MiB;
constexpr size_t WS_HA = 416 * MiB;
constexpr size_t WS_HB = 448 * MiB;
constexpr size_t WS_PQ = 480 * MiB;
constexpr size_t WS_PKV = 481 * MiB;
constexpr size_t WS_CQN = 528 * MiB;
constexpr size_t WS_CKVN = 540 * MiB;
constexpr size_t WS_Q = 548 * MiB;
constexpr size_t WS_K = 596 * MiB;
constexpr size_t WS_V = 644 * MiB;
constexpr size_t WS_O = 676 * MiB;
constexpr size_t WS_PRE = 708 * MiB;
constexpr size_t WS_STAT = 772 * MiB;
constexpr size_t WS_X2 = 836 * MiB;
constexpr size_t WS_XE = 900 * MiB;
constexpr size_t WS_ACT = 964 * MiB;
constexpr size_t WS_Y = 1092 * MiB;
constexpr size_t WS_QKV1 = 1156 * MiB;
constexpr size_t WS_OD = 1252 * MiB;
constexpr size_t WS_END = 1316 * MiB;
constexpr int CW_BAR = 4096;

constexpr int RING_BYTES = 131072;
constexpr int LDSCTL_OFF = RING_BYTES, MISC_OFF = LDSCTL_OFF + 320;
constexpr int LDS_BYTES = 147456;

#define LDS_WAIT() asm volatile("s_waitcnt lgkmcnt(0)" ::: "memory")
#define VM_WAIT() asm volatile("s_waitcnt vmcnt(0)" ::: "memory")

template <int CTRL> __device__ __forceinline__ float dpp_mov(float v) { return __builtin_bit_cast(float, __builtin_amdgcn_update_dpp(0, __builtin_bit_cast(int, v), CTRL, 0xF, 0xF, true)); }
__device__ __forceinline__ float wave_sum(float v) {
    v += dpp_mov<0xB1>(v); v += dpp_mov<0x4E>(v); v += dpp_mov<0x141>(v); v += dpp_mov<0x140>(v);
    { auto r = __builtin_amdgcn_permlane16_swap(__float_as_uint(v), __float_as_uint(v), false, false); v = __uint_as_float(r[0]) + __uint_as_float(r[1]); }
    { auto r = __builtin_amdgcn_permlane32_swap(__float_as_uint(v), __float_as_uint(v), false, false); v = __uint_as_float(r[0]) + __uint_as_float(r[1]); }
    return v;
}

#define XB_TMO      128
#define XB_XCNT(j)  (256  + 64 * (j))
#define XB_XSUB(j)  (1280 + 64 * (j))
#define XB_XGEN(j)  (2304 + 64 * (j))
#define XB_TOP      3328
#define XB_TOPGEN   3392
#define XCD_BAR_WORDS 3456
#define XB_SPIN_CAP (1u << 20)
__device__ __forceinline__ unsigned xb_ld(unsigned* p)              { return __hip_atomic_load(p, __ATOMIC_RELAXED, __HIP_MEMORY_SCOPE_AGENT); }
__device__ __forceinline__ unsigned xb_add(unsigned* p, unsigned v) { return __hip_atomic_fetch_add(p, v, __ATOMIC_RELAXED, __HIP_MEMORY_SCOPE_AGENT); }
__device__ __forceinline__ unsigned xb_xcc_id() { return (unsigned)__builtin_amdgcn_s_getreg((3 << 11) | 20) & 0xFu; }
#define XB_SPIN(cond, bar) do { unsigned _sp = 0; while (cond) { __builtin_amdgcn_s_sleep(1); \
    if ((++_sp & 255u) == 0u) { if (xb_ld(&(bar)[XB_TMO])) break; if (_sp > XB_SPIN_CAP) { atomicAdd(&(bar)[XB_TMO], 1u); break; } } } } while (0)
struct XcdBarrier { unsigned* bar; unsigned x; volatile LAS unsigned* st; };
__device__ __forceinline__ XcdBarrier xcd_barrier_post(unsigned* bar, volatile LAS unsigned* st) {
    XcdBarrier b; b.bar = bar; b.x = xb_xcc_id(); b.st = st;
    if (threadIdx.x == 0) (void)xb_add(&bar[XB_XCNT(b.x)], 1u);
    return b;
}
__device__ __forceinline__ void xcd_barrier_complete(unsigned* bar, unsigned x, unsigned& nloc, unsigned& nx) {
    const unsigned G = gridDim.x * gridDim.y * gridDim.z;
    unsigned sum, cnt, mine, sp = 0u;
    for (;;) {
        sum = 0u; cnt = 0u; mine = 0u;
#pragma unroll
        for (unsigned j = 0; j < 16; ++j) { const unsigned c = xb_ld(&bar[XB_XCNT(j)]); sum += c; cnt += (c > 0u) ? 1u : 0u; mine = (j == x) ? c : mine; }
        if (sum == G) break;
        __builtin_amdgcn_s_sleep(1);
        if ((++sp & 255u) == 0u) { if (xb_ld(&bar[XB_TMO])) break; if (sp > XB_SPIN_CAP) { atomicAdd(&bar[XB_TMO], 1u); break; } }
    }
    nloc = mine > 0u ? mine : 1u; nx = cnt > 0u ? cnt : 1u;
}
__device__ __forceinline__ void xcd_barrier(const XcdBarrier& b) {
    asm volatile("s_waitcnt vmcnt(0)" ::: "memory");
    __syncthreads();
    if (threadIdx.x == 0) {
        unsigned* bar = b.bar;
        __builtin_amdgcn_s_waitcnt(0);
        unsigned nloc = b.st[0], nx = b.st[1];
        if (nloc == 0u) { xcd_barrier_complete(bar, b.x, nloc, nx); b.st[0] = nloc; b.st[1] = nx; }
        const unsigned old = xb_add(&bar[XB_XSUB(b.x)], 1u);
        const unsigned gen = old / nloc;
        if (old + 1u == (gen + 1u) * nloc) {
            __builtin_amdgcn_fence(__ATOMIC_RELEASE, "agent");
            asm volatile("s_waitcnt vmcnt(0)" ::: "memory");
            const unsigned og = xb_add(&bar[XB_TOP], 1u);
            const unsigned tg = og / nx;
            if (og + 1u == (tg + 1u) * nx) xb_add(&bar[XB_TOPGEN], 1u);
            else XB_SPIN(xb_ld(&bar[XB_TOPGEN]) == tg, bar);
            __builtin_amdgcn_fence(__ATOMIC_ACQUIRE, "agent");
            xb_add(&bar[XB_XGEN(b.x)], 1u);
            asm volatile("s_waitcnt vmcnt(0)" ::: "memory");
        } else {
            XB_SPIN(xb_ld(&bar[XB_XGEN(b.x)]) == gen, bar);
            __builtin_amdgcn_fence(__ATOMIC_ACQUIRE, "agent");
            asm volatile("s_waitcnt vmcnt(0)" ::: "memory");
        }
    }
    __syncthreads();
}

namespace pg8 {
constexpr int BM = 256, BK = 64, HALF = 128, HTB = HALF * BK * 2, STAGE_BYTES = 8 * HTB, NXCD = 8, WGM = 8;
__host__ __device__ __forceinline__ int lds_byte(int r, int c) { const int st = (r >> 4) * 2 + (c >> 5), rr = r & 15, cc = c & 31, ob = rr * 64 + cc * 2; return st * 1024 + (ob ^ (((ob >> 9) & 1) << 5)); }
__host__ __device__ __forceinline__ void stage_rc(int b, int& R, int& C) { const int st = b / 1024, sb = b % 1024, swz = sb ^ (((sb >> 9) & 1) << 5); R = (st >> 1) * 16 + swz / 64; C = (st & 1) * 32 + (swz % 64) / 2; }
__host__ __device__ __forceinline__ int perm32(int rho) { const int n = rho >> 4, i = rho & 15; return 8 * (i >> 2) + 4 * n + (i & 3); }
struct Unit { int pm, pn; };
struct Gemm { const f16* A; const f16* Bt; int M, N, K; int grp_tiles; size_t grp_stride; const int* rowidx; };
struct StaticOrder {
    int nM, nN, nwg, G, c;
    __host__ __device__ void init(int M, int N, int G_, int c_) { nM = M / BM; nN = N / BM; nwg = nM * nN; G = G_; c = c_; }
    __host__ __device__ bool next(int i, Unit& u) const {
        const long L = (long)i * G + c; if (L >= nwg) return false;
        int wgid = (int)L; { const int q = nwg / NXCD, r = nwg % NXCD, xcd = wgid % NXCD, off = wgid / NXCD; wgid = (xcd < r ? xcd * (q + 1) : r * (q + 1) + (xcd - r) * q) + off; }
        const int nig = WGM * nN, gid = wgid / nig, fm = gid * WGM, gsz = (nM - fm) < WGM ? (nM - fm) : WGM;
        u.pm = fm + ((wgid % nig) % gsz); u.pn = (wgid % nig) / gsz; return true;
    }
};
constexpr int GATHER_MAX_UNITS = 15, GATHER_IDX_OFF = RING_BYTES + 1024;
template <class Epi, bool ALIGN_EPI = true, bool SP2 = true, bool GATHER = false>
__device__ __forceinline__ void gemm_phase(LAS unsigned char* lds, const Gemm g, const StaticOrder& S, const Epi& E) {
    int tid = threadIdx.x; asm volatile("" : "+v"(tid));
    const int wid = __builtin_amdgcn_readfirstlane(tid >> 6), lane = tid & 63, wr = wid >> 2, wc = wid & 3, fr = lane & 15, fq = lane >> 4;
    const int K = g.K, nt = K / BK;
    unsigned voffA[2], voffB[2];
#pragma unroll
    for (int i = 0; i < 2; ++i) { int R, C; stage_rc(tid * 16 + i * 8192, R, C); const int Rb = Epi::PERM ? ((R & ~31) + perm32(R & 31)) : R;
        voffA[i] = (unsigned)(R * K + C) * 2u; voffB[i] = (unsigned)(Rb * K + C) * 2u; }
    int gR[2]; unsigned gC[2];
#pragma unroll
    for (int i = 0; i < 2; ++i) { int R, C; stage_rc(tid * 16 + i * 8192, R, C); gR[i] = R; gC[i] = (unsigned)C * 2u; }
    LAS int* idxbuf = (LAS int*)(lds + GATHER_IDX_OFF);
    if constexpr (GATHER) {
        Unit uu;
        for (int q = 0; q < GATHER_MAX_UNITS; ++q) { if (!S.next(q, uu)) break; if (tid < 256) idxbuf[q * 256 + tid] = g.rowidx[uu.pm * 256 + tid]; }
        asm volatile("s_waitcnt vmcnt(0) lgkmcnt(0)" ::: "memory"); __builtin_amdgcn_s_barrier(); asm volatile("" ::: "memory");
    }
    unsigned gaC[2][2], gaN[2][2], ga2[2][2];
#define PG8_GA(dst, q) do { _Pragma("unroll") for (int _h = 0; _h < 2; ++_h) _Pragma("unroll") for (int _i = 0; _i < 2; ++_i) dst[_h][_i] = (unsigned)idxbuf[(q) * 256 + _h * 128 + gR[_i]] * (unsigned)(K * 2) + gC[_i]; } while (0)
    const size_t kstep = (size_t)(BK * 2);
    const size_t hstep = (size_t)HALF * K * 2;
    const size_t tstep = 2 * hstep;
    const unsigned ldsw = (unsigned)wid * 1024u;
    const int aoff = lds_byte(wr * 64 + fr, fq * 8), boff = lds_byte(wc * 32 + fr, fq * 8);
#define PG8_SA(b, h) (((b) * 2 + (h)) * HTB)
#define PG8_SB(b, h) ((4 + (b) * 2 + (h)) * HTB)
#define PG8_STAGE(bufoff, gbase, voff) do { _Pragma("unroll") for (int _i = 0; _i < 2; ++_i) \
        __builtin_amdgcn_global_load_lds((const unsigned*)((const char*)(gbase) + (voff)[_i]), (LAS unsigned*)(lds + (bufoff) + ldsw + _i * 8192), 16, 0, 0); } while (0)
#define PG8_LDA(dst, b, h) do { _Pragma("unroll") for (int m = 0; m < 4; ++m) _Pragma("unroll") for (int k = 0; k < 2; ++k) dst[m][k] = *(const LAS h8*)(lds + PG8_SA(b, h) + aoff + m * 2048 + k * 1024); } while (0)
#define PG8_LDB(dst, b, h) do { _Pragma("unroll") for (int n = 0; n < 2; ++n) _Pragma("unroll") for (int k = 0; k < 2; ++k) dst[n][k] = *(const LAS h8*)(lds + PG8_SB(b, h) + boff + n * 2048 + k * 1024); } while (0)
#define PG8_MMA(ai, bj, At, Bt) do { __builtin_amdgcn_s_setprio(1); _Pragma("unroll") for (int m = 0; m < 4; ++m) _Pragma("unroll") for (int n = 0; n < 2; ++n) _Pragma("unroll") for (int k = 0; k < 2; ++k) \
        acc[ai][bj][m][n] = __builtin_amdgcn_mfma_f32_16x16x32_f16(Bt[n][k], At[m][k], acc[ai][bj][m][n], 0, 0, 0); __builtin_amdgcn_s_setprio(0); } while (0)
#define PG8_WAIT_V(n) asm volatile("s_waitcnt vmcnt(" #n ")" ::: "memory")
#define PG8_WAIT_L(n) asm volatile("s_waitcnt lgkmcnt(" #n ")" ::: "memory")
#define PG8_BAR __builtin_amdgcn_s_barrier()
#define PG8_SCHED __builtin_amdgcn_sched_barrier(0)
#define PG8_STA(bufoff, tileptr, h, gaset, kbyte) do { if constexpr (GATHER) { PG8_STAGE(bufoff, (const char*)g.A + (kbyte), gaset[h]); } else { PG8_STAGE(bufoff, (tileptr) + (h) * hstep, voffA); } } while (0)
#define PG8_BBASE(u) ((const char*)g.Bt + ((size_t)((u).pm / g.grp_tiles) * g.grp_stride) * 2 + (size_t)(u).pn * tstep)
    Unit cur, nxt; int ui = 0;
    if (!S.next(0, cur)) return;
    f32x4 acc[2][2][4][2];
#pragma unroll
    for (int a = 0; a < 2; ++a)
#pragma unroll
        for (int b = 0; b < 2; ++b)
#pragma unroll
            for (int m = 0; m < 4; ++m)
#pragma unroll
                for (int n = 0; n < 2; ++n) acc[a][b][m][n] = (f32x4){0.f, 0.f, 0.f, 0.f};
    h8 At[4][2], B0[2][2], B1[2][2];
    const char* cA = (const char*)g.A + (size_t)cur.pm * tstep; const char* cB = PG8_BBASE(cur);
    if constexpr (GATHER) { PG8_GA(gaC, 0); }
    if constexpr (SP2) {
        PG8_STAGE(PG8_SB(0, 0), cB, voffB); PG8_STAGE(PG8_SB(0, 1), cB + hstep, voffB); PG8_STA(PG8_SA(0, 0), cA, 0, gaC, 0); PG8_STA(PG8_SA(0, 1), cA, 1, gaC, 0);
        if (wr == 1) PG8_BAR;
        PG8_WAIT_V(2); PG8_BAR;
        PG8_STAGE(PG8_SB(1, 0), cB + kstep, voffB); PG8_STA(PG8_SA(1, 0), cA + kstep, 0, gaC, kstep); PG8_STAGE(PG8_SB(1, 1), cB + hstep + kstep, voffB);
        PG8_WAIT_V(6); PG8_BAR;
    } else {
        PG8_STAGE(PG8_SB(0, 0), cB, voffB); PG8_STA(PG8_SA(0, 0), cA, 0, gaC, 0); PG8_STAGE(PG8_SB(0, 1), cB + hstep, voffB); PG8_STA(PG8_SA(0, 1), cA, 1, gaC, 0);
        if (wr == 1) PG8_BAR;
        PG8_WAIT_V(4); PG8_BAR;
        PG8_STAGE(PG8_SB(1, 0), cB + kstep, voffB); PG8_STA(PG8_SA(1, 0), cA + kstep, 0, gaC, kstep); PG8_STAGE(PG8_SB(1, 1), cB + hstep + kstep, voffB);
        PG8_WAIT_V(6); PG8_BAR;
    }
    for (;;) {
        const bool has_next = S.next(ui + 1, nxt);
        const char* nA = has_next ? (const char*)g.A + (size_t)nxt.pm * tstep : cA; const char* nB = has_next ? PG8_BBASE(nxt) : cB;
        if constexpr (GATHER) { const int qn = has_next ? ui + 1 : ui; PG8_GA(gaN, qn); }
#pragma unroll 1
        for (int t = 0; t < nt; t += 2) {
            const bool last = (t == nt - 2);
            const char* a1 = cA + (size_t)(t + 1) * kstep;
            const char* a2 = last ? nA : cA + (size_t)(t + 2) * kstep; const char* b2 = last ? nB : cB + (size_t)(t + 2) * kstep;
            const char* a3 = a2 + kstep; const char* b3 = b2 + kstep;
            const size_t k1 = (size_t)(t + 1) * kstep, k2 = last ? 0 : (size_t)(t + 2) * kstep, k3 = k2 + kstep;
            if constexpr (GATHER) { _Pragma("unroll") for (int _h = 0; _h < 2; ++_h) _Pragma("unroll") for (int _i = 0; _i < 2; ++_i) ga2[_h][_i] = last ? gaN[_h][_i] : gaC[_h][_i]; }
            if constexpr (SP2) {
            PG8_LDB(B0, 0, 0); PG8_LDB(B1, 0, 1); PG8_SCHED; PG8_LDA(At, 0, 0); PG8_STA(PG8_SA(1, 1), a1, 1, gaC, k1);
            PG8_WAIT_V(8); PG8_WAIT_L(0); PG8_BAR; PG8_MMA(0, 0, At, B0); PG8_MMA(0, 1, At, B1); PG8_BAR; PG8_SCHED;
            PG8_LDA(At, 0, 1); PG8_STAGE(PG8_SB(0, 0), b2, voffB); PG8_STAGE(PG8_SB(0, 1), b2 + hstep, voffB); PG8_STA(PG8_SA(0, 0), a2, 0, ga2, k2);
            PG8_WAIT_V(8); PG8_WAIT_L(0); PG8_BAR; PG8_MMA(1, 0, At, B0); PG8_MMA(1, 1, At, B1); PG8_BAR; PG8_SCHED;
            PG8_LDB(B0, 1, 0); PG8_LDB(B1, 1, 1); PG8_SCHED; PG8_LDA(At, 1, 0); PG8_STA(PG8_SA(0, 1), a2, 1, ga2, k2);
            PG8_WAIT_V(8); PG8_WAIT_L(0); PG8_BAR; PG8_MMA(0, 0, At, B0); PG8_MMA(0, 1, At, B1); PG8_BAR; PG8_SCHED;
            PG8_LDA(At, 1, 1); PG8_STAGE(PG8_SB(1, 0), b3, voffB); PG8_STAGE(PG8_SB(1, 1), b3 + hstep, voffB); PG8_STA(PG8_SA(1, 0), a3, 0, ga2, k3);
            PG8_WAIT_V(8); PG8_WAIT_L(0); PG8_BAR; PG8_MMA(1, 0, At, B0); PG8_MMA(1, 1, At, B1); PG8_BAR; PG8_SCHED;
            } else {
            PG8_LDB(B0, 0, 0); PG8_SCHED; PG8_LDA(At, 0, 0); PG8_STA(PG8_SA(1, 1), a1, 1, gaC, k1);
            PG8_WAIT_L(8); PG8_BAR; PG8_WAIT_L(0); PG8_MMA(0, 0, At, B0); PG8_BAR; PG8_SCHED;
            PG8_LDB(B1, 0, 1); PG8_STAGE(PG8_SB(0, 0), b2, voffB);
            PG8_BAR; PG8_WAIT_L(0); PG8_MMA(0, 1, At, B1); PG8_BAR;
            PG8_LDA(At, 0, 1); PG8_STA(PG8_SA(0, 0), a2, 0, ga2, k2);
            PG8_BAR; PG8_WAIT_L(0); PG8_MMA(1, 0, At, B0); PG8_BAR; PG8_SCHED;
            PG8_STAGE(PG8_SB(0, 1), b2 + hstep, voffB);
            PG8_WAIT_V(6); PG8_BAR; PG8_MMA(1, 1, At, B1); PG8_BAR;
            PG8_LDB(B0, 1, 0); PG8_SCHED; PG8_LDA(At, 1, 0); PG8_STA(PG8_SA(0, 1), a2, 1, ga2, k2);
            PG8_WAIT_L(8); PG8_BAR; PG8_WAIT_L(0); PG8_MMA(0, 0, At, B0); PG8_BAR; PG8_SCHED;
            PG8_LDB(B1, 1, 1); PG8_STAGE(PG8_SB(1, 0), b3, voffB);
            PG8_BAR; PG8_WAIT_L(0); PG8_MMA(0, 1, At, B1); PG8_BAR;
            PG8_LDA(At, 1, 1); PG8_STA(PG8_SA(1, 0), a3, 0, ga2, k3);
            PG8_BAR; PG8_WAIT_L(0); PG8_MMA(1, 0, At, B0); PG8_BAR; PG8_SCHED;
            PG8_STAGE(PG8_SB(1, 1), b3 + hstep, voffB);
            PG8_WAIT_V(6); PG8_BAR; PG8_MMA(1, 1, At, B1); PG8_BAR;
            }
        }
        if constexpr (ALIGN_EPI) { if (wr == 0) PG8_BAR; }
        E(acc, cur, wr, wc, fr, fq);
        if (!has_next) break;
#pragma unroll
        for (int a = 0; a < 2; ++a)
#pragma unroll
            for (int b = 0; b < 2; ++b)
#pragma unroll
                for (int m = 0; m < 4; ++m)
#pragma unroll
                    for (int n = 0; n < 2; ++n) acc[a][b][m][n] = (f32x4){0.f, 0.f, 0.f, 0.f};
        cur = nxt; cA = nA; cB = nB; ++ui;
        if constexpr (GATHER) { _Pragma("unroll") for (int _h = 0; _h < 2; ++_h) _Pragma("unroll") for (int _i = 0; _i < 2; ++_i) gaC[_h][_i] = gaN[_h][_i]; }
        if constexpr (ALIGN_EPI) { if (wr == 1) PG8_BAR; }
    }
    PG8_WAIT_V(0);
    if constexpr (!ALIGN_EPI) { if (wr == 0) PG8_BAR; }
    PG8_BAR;
#undef PG8_SA
#undef PG8_SB
#undef PG8_STAGE
#undef PG8_LDA
#undef PG8_LDB
#undef PG8_MMA
#undef PG8_WAIT_V
#undef PG8_WAIT_L
#undef PG8_BAR
#undef PG8_SCHED
#undef PG8_BBASE
#undef PG8_STA
#undef PG8_GA
}
}

#define EPI_ROW(u, ai, m) ((u).pm * 256 + (ai) * 128 + wr * 64 + (m) * 16 + fr)
__device__ __forceinline__ h8 pack8(f32x4 a, f32x4 b) { h8 o; o[0] = (f16)a[0]; o[1] = (f16)a[1]; o[2] = (f16)a[2]; o[3] = (f16)a[3]; o[4] = (f16)b[0]; o[5] = (f16)b[1]; o[6] = (f16)b[2]; o[7] = (f16)b[3]; return o; }
__device__ __forceinline__ void rope4(f32x4& v0, f32x4& v1, const f32x4 cs, const f32x4 sn) {
    const f32x4 a = v0, b = v1;
    v0[0] = a[0] * cs[0] - a[1] * sn[0]; v0[1] = a[1] * cs[0] + a[0] * sn[0];
    v0[2] = a[2] * cs[1] - a[3] * sn[1]; v0[3] = a[3] * cs[1] + a[2] * sn[1];
    v1[0] = b[0] * cs[2] - b[1] * sn[2]; v1[1] = b[1] * cs[2] + b[0] * sn[2];
    v1[2] = b[2] * cs[3] - b[3] * sn[3]; v1[3] = b[3] * cs[3] + b[2] * sn[3];
}
struct EpiLat {
    static constexpr bool PERM = true; f16* cq; f16* ckv; f16* Kp; float* pq; float* pkv; const float* cosm; const float* sinm;
    __device__ __forceinline__ void operator()(const f32x4 (&acc)[2][2][4][2], const pg8::Unit& u, int wr, int wc, int fr, int fq) const {
#pragma unroll
        for (int ai = 0; ai < 2; ++ai)
#pragma unroll
            for (int m = 0; m < 4; ++m) { const int t = EPI_ROW(u, ai, m); float sq = 0.f, sk = 0.f;
#pragma unroll
                for (int bj = 0; bj < 2; ++bj) { const int c8 = u.pn * 256 + bj * 128 + wc * 32 + 8 * fq; const int ht = u.pn * 2 + bj;
                    f32x4 v0 = acc[ai][bj][m][0], v1 = acc[ai][bj][m][1];
                    const float ss = (v0[0] * v0[0] + v0[1] * v0[1]) + (v0[2] * v0[2] + v0[3] * v0[3]) + (v1[0] * v1[0] + v1[1] * v1[1]) + (v1[2] * v1[2] + v1[3] * v1[3]);
                    if (ht < 3) { sq += ss; *(h8*)(cq + (size_t)t * 384 + c8) = pack8(v0, v1); }
                    else if (ht < 5) { sk += ss; *(h8*)(ckv + (size_t)t * 256 + (c8 - 384)) = pack8(v0, v1); }
                    else if (c8 < 704) { const int jj = c8 - 640, i0 = jj >> 1;
                        const f32x4 cs = *(const f32x4*)(cosm + (size_t)t * 32 + i0), sn = *(const f32x4*)(sinm + (size_t)t * 32 + i0); rope4(v0, v1, cs, sn);
                        const h8 o = pack8(v0, v1);
#pragma unroll
                        for (int h = 0; h < 8; ++h) *(h8*)(Kp + (size_t)t * 1536 + h * 192 + 128 + jj) = o; } }
                sq += __shfl_xor(sq, 16); sq += __shfl_xor(sq, 32); sk += __shfl_xor(sk, 16); sk += __shfl_xor(sk, 32);
                if (fq == 0) { if (u.pn < 2) pq[(size_t)t * 8 + u.pn * 4 + wc] = sq; if (u.pn >= 1) pkv[(size_t)t * 8 + (u.pn - 1) * 4 + wc] = sk; }
                asm volatile("" ::: "memory"); }
    }
};
__device__ __forceinline__ float row_rms_scale(const float* part, int t, float inv_n, float eps) {
    const f32x4 a = *(const f32x4*)(part + (size_t)t * 8), b = *(const f32x4*)(part + (size_t)t * 8 + 4);
    const float s = ((a[0] + a[1]) + (a[2] + a[3])) + ((b[0] + b[1]) + (b[2] + b[3]));
    return 1.0f / sqrtf(s * inv_n + eps);
}
constexpr float QLOG2_192 = 0.07216878364870322f * 1.4426950408889634f;
struct EpiQNope {
    static constexpr bool PERM = true; f16* Q; const float* pq;
    __device__ __forceinline__ void operator()(const f32x4 (&acc)[2][2][4][2], const pg8::Unit& u, int wr, int wc, int fr, int fq) const {
#pragma unroll
        for (int ai = 0; ai < 2; ++ai)
#pragma unroll
            for (int m = 0; m < 4; ++m) { const int t = EPI_ROW(u, ai, m); const float rs = row_rms_scale(pq, t, 1.0f / 384.0f, LAT_EPS) * QLOG2_192;
#pragma unroll
                for (int bj = 0; bj < 2; ++bj) { const int c8 = u.pn * 256 + bj * 128 + wc * 32 + 8 * fq;
                    *(h8*)(Q + (size_t)t * 1536 + (c8 >> 7) * 192 + (c8 & 127)) = pack8(acc[ai][bj][m][0] * rs, acc[ai][bj][m][1] * rs); }
                asm volatile("" ::: "memory"); }
    }
};
struct EpiQRope {
    static constexpr bool PERM = true; f16* Q; const float* cosm; const float* sinm; const float* pq;
    __device__ __forceinline__ void operator()(const f32x4 (&acc)[2][2][4][2], const pg8::Unit& u, int wr, int wc, int fr, int fq) const {
#pragma unroll
        for (int ai = 0; ai < 2; ++ai)
#pragma unroll
            for (int m = 0; m < 4; ++m) { const int t = EPI_ROW(u, ai, m); const float rs = row_rms_scale(pq, t, 1.0f / 384.0f, LAT_EPS) * QLOG2_192;
#pragma unroll
                for (int bj = 0; bj < 2; ++bj) { const int cc = u.pn * 256 + bj * 128 + wc * 32 + 8 * fq; const int h = cc >> 6, jj = cc & 63, i0 = jj >> 1;
                    f32x4 v0 = acc[ai][bj][m][0] * rs, v1 = acc[ai][bj][m][1] * rs;
                    const f32x4 cs = *(const f32x4*)(cosm + (size_t)t * 32 + i0), sn = *(const f32x4*)(sinm + (size_t)t * 32 + i0); rope4(v0, v1, cs, sn);
                    *(h8*)(Q + (size_t)t * 1536 + h * 192 + 128 + jj) = pack8(v0, v1); }
                asm volatile("" ::: "memory"); }
    }
};
struct EpiKV {
    static constexpr bool PERM = true; f16* Kp; f16* Vp; const float* pkv;
    __device__ __forceinline__ void operator()(const f32x4 (&acc)[2][2][4][2], const pg8::Unit& u, int wr, int wc, int fr, int fq) const {
#pragma unroll
        for (int ai = 0; ai < 2; ++ai)
#pragma unroll
            for (int m = 0; m < 4; ++m) { const int t = EPI_ROW(u, ai, m); const float rs = row_rms_scale(pkv, t, 1.0f / 256.0f, LAT_EPS);
#pragma unroll
                for (int bj = 0; bj < 2; ++bj) { const int c8 = u.pn * 256 + bj * 128 + wc * 32 + 8 * fq; const int h = c8 >> 8, j = c8 & 255;
                    f16* dst = (j < 128) ? (Kp + (size_t)t * 1536 + h * 192 + j) : (Vp + (size_t)t * 1024 + h * 128 + (j - 128));
                    *(h8*)dst = pack8(acc[ai][bj][m][0] * rs, acc[ai][bj][m][1] * rs); }
                asm volatile("" ::: "memory"); }
    }
};
template <bool XF16> struct EpiPre {
    static constexpr bool PERM = true; const void* xres; const float* gmod; f16* pre;
    __device__ __forceinline__ void operator()(const f32x4 (&acc)[2][2][4][2], const pg8::Unit& u, int wr, int wc, int fr, int fq) const {
        const int b = (u.pm * 256) >> 12;
        f32x4 g0[2], g1[2];
#pragma unroll
        for (int bj = 0; bj < 2; ++bj) { const int c8 = u.pn * 256 + bj * 128 + wc * 32 + 8 * fq; g0[bj] = *(const f32x4*)(gmod + b * 6144 + c8) + 1.0f; g1[bj] = *(const f32x4*)(gmod + b * 6144 + c8 + 4) + 1.0f; }
#pragma unroll
        for (int ai = 0; ai < 2; ++ai)
#pragma unroll
        for (int mh = 0; mh < 2; ++mh) {
            f32x4 x0[2][2], x1[2][2];
#pragma unroll
            for (int mm = 0; mm < 2; ++mm) { const int t = EPI_ROW(u, ai, 2 * mh + mm);
#pragma unroll
                for (int bj = 0; bj < 2; ++bj) { const int c8 = u.pn * 256 + bj * 128 + wc * 32 + 8 * fq;
                    if constexpr (XF16) { const h8 xv = *(const h8*)((const f16*)xres + (size_t)t * 1024 + c8);
                        x0[mm][bj] = (f32x4){(float)xv[0], (float)xv[1], (float)xv[2], (float)xv[3]}; x1[mm][bj] = (f32x4){(float)xv[4], (float)xv[5], (float)xv[6], (float)xv[7]}; }
                    else { x0[mm][bj] = *(const f32x4*)((const float*)xres + (size_t)t * 1024 + c8); x1[mm][bj] = *(const f32x4*)((const float*)xres + (size_t)t * 1024 + c8 + 4); } } }
#pragma unroll
            for (int mm = 0; mm < 2; ++mm) { const int m = 2 * mh + mm; const int t = EPI_ROW(u, ai, m);
#pragma unroll
                for (int bj = 0; bj < 2; ++bj) { const int c8 = u.pn * 256 + bj * 128 + wc * 32 + 8 * fq;
                    *(h8*)(pre + (size_t)t * 1024 + c8) = pack8(x0[mm][bj] * ALPHA + g0[bj] * acc[ai][bj][m][0], x1[mm][bj] * ALPHA + g1[bj] * acc[ai][bj][m][1]); } }
            asm volatile("" ::: "memory"); }
    }
};
struct EpiUp {
    static constexpr bool PERM = true; f16* act;
    __device__ __forceinline__ void operator()(const f32x4 (&acc)[2][2][4][2], const pg8::Unit& u, int wr, int wc, int fr, int fq) const {
#pragma unroll
        for (int ai = 0; ai < 2; ++ai)
#pragma unroll
            for (int m = 0; m < 4; ++m) { const int r = EPI_ROW(u, ai, m);
#pragma unroll
                for (int bj = 0; bj < 2; ++bj) { const int c8 = u.pn * 256 + bj * 128 + wc * 32 + 8 * fq;
                    const f32x4 gq = acc[ai][bj][m][0], uq = acc[ai][bj][m][1]; h4 o;
#pragma unroll
                    for (int i = 0; i < 4; ++i) { const float gg = gq[i]; o[i] = (f16)(gg * __builtin_amdgcn_rcpf(1.0f + __expf(-gg)) * uq[i]); }
                    *(h4*)(act + (size_t)r * 2048 + (c8 >> 1)) = o; } }
    }
};
struct EpiDown {
    static constexpr bool PERM = true; f16* y; const float* gate;
    __device__ __forceinline__ void operator()(const f32x4 (&acc)[2][2][4][2], const pg8::Unit& u, int wr, int wc, int fr, int fq) const {
#pragma unroll
        for (int ai = 0; ai < 2; ++ai)
#pragma unroll
            for (int m = 0; m < 4; ++m) { const int r = EPI_ROW(u, ai, m); const float gt = gate[r];
#pragma unroll
                for (int bj = 0; bj < 2; ++bj) { const int c8 = u.pn * 256 + bj * 128 + wc * 32 + 8 * fq;
                    *(h8*)(y + (size_t)r * 1024 + c8) = pack8(acc[ai][bj][m][0] * gt, acc[ai][bj][m][1] * gt); }
                asm volatile("" ::: "memory"); }
    }
};
constexpr float QLOG2_64 = 0.125f * 1.4426950408889634f;
struct EpiDiffIn {
    static constexpr bool PERM = true; f16* qkv; const float* cosd; const float* sind;
    __device__ __forceinline__ void operator()(const f32x4 (&acc)[2][2][4][2], const pg8::Unit& u, int wr, int wc, int fr, int fq) const {
#pragma unroll
        for (int ai = 0; ai < 2; ++ai)
#pragma unroll
            for (int m = 0; m < 4; ++m) { const int t = EPI_ROW(u, ai, m);
#pragma unroll
                for (int bj = 0; bj < 2; ++bj) { const int c8 = u.pn * 256 + bj * 128 + wc * 32 + 8 * fq;
                    f32x4 v0 = acc[ai][bj][m][0], v1 = acc[ai][bj][m][1];
                    if (c8 < 2048 && (c8 & 63) < 16) { const int i0 = (c8 & 15) >> 1; const f32x4 cs = *(const f32x4*)(cosd + (size_t)t * 8 + i0), sn = *(const f32x4*)(sind + (size_t)t * 8 + i0); rope4(v0, v1, cs, sn); }
                    if (c8 < 1024) { v0 *= QLOG2_64; v1 *= QLOG2_64; }
                    *(h8*)(qkv + (size_t)t * 3072 + c8) = pack8(v0, v1); }
                asm volatile("" ::: "memory"); }
    }
};

namespace att {
constexpr int QBLK = 32, KVBLK = 64, DV = 128;
constexpr float THR = 8.f;
constexpr size_t SHM_V = KVBLK * DV * 2;
#define SBAR() __builtin_amdgcn_sched_barrier(0)
template <class T> __device__ __forceinline__ const T* uniform_ptr(const T* p) { const unsigned long long v = (unsigned long long)p; const unsigned lo = __builtin_amdgcn_readfirstlane((unsigned)v), hi = __builtin_amdgcn_readfirstlane((unsigned)(v >> 32)); return (const T*)(((unsigned long long)hi << 32) | lo); }
__device__ __forceinline__ int crow(int r, int hi) { return (r & 3) + 8 * (r >> 2) + 4 * hi; }
__device__ __forceinline__ unsigned cvtpk(float lo, float hi) { unsigned r; asm volatile("v_cvt_pk_f16_f32 %0, %1, %2" : "=v"(r) : "v"(lo), "v"(hi)); return r; }
template <int DQK> struct Cfg {
    static constexpr int ND0 = DQK / 16, KRB = DQK * 2, NKCH = DQK / 64, KCPR = DQK / 8;
    static constexpr size_t SHM_K = (size_t)KVBLK * KRB;
    static constexpr float SCALE = DQK == 192 ? 0.07216878364870322f : 0.125f;
    static constexpr size_t SHM_TOTAL = 2 * SHM_V + 2 * SHM_K + NWAVES * 64 * 4;
};
template <int DQK> __device__ __forceinline__ void partialSM(f32x16& p0, f32x16& p1, float& m_reg, float& mn, float& alpha) {
    constexpr float SCALE = Cfg<DQK>::SCALE, C = SCALE * 1.4426950408889634f;
    float pmax = p0[0];
#pragma unroll
    for (int r = 1; r < 16; ++r) pmax = fmaxf(pmax, p0[r]);
#pragma unroll
    for (int r = 0; r < 16; ++r) pmax = fmaxf(pmax, p1[r]);
    { auto rr = __builtin_amdgcn_permlane32_swap(__float_as_uint(pmax), __float_as_uint(pmax), false, false);
      pmax = fmaxf(__uint_as_float(rr[0]), __uint_as_float(rr[1])); }
    if (__builtin_expect(__all(pmax - m_reg <= THR / SCALE), 1)) { mn = m_reg; alpha = 1.f; }
    else { mn = fmaxf(m_reg, pmax); alpha = __builtin_amdgcn_exp2f((m_reg - mn) * C); m_reg = mn; }
    const float mnC = -mn * C;
#pragma unroll
    for (int r = 0; r < 16; ++r) p0[r] = fmaf(p0[r], C, mnC);
#pragma unroll
    for (int r = 0; r < 16; ++r) p1[r] = fmaf(p1[r], C, mnC);
#pragma unroll
    for (int r = 0; r < 16; ++r) p0[r] = __builtin_amdgcn_exp2f(p0[r]);
}
__device__ __forceinline__ void finishSM(f32x16& p0, f32x16& p1, float alpha, float& l_reg, h8& pa0, h8& pa1, h8& pa2, h8& pa3) {
#pragma unroll
    for (int r = 0; r < 16; ++r) p1[r] = __builtin_amdgcn_exp2f(p1[r]);
    float ps = 0;
#pragma unroll
    for (int r = 0; r < 16; ++r) ps += p0[r];
#pragma unroll
    for (int r = 0; r < 16; ++r) ps += p1[r];
    { auto rr = __builtin_amdgcn_permlane32_swap(__float_as_uint(ps), __float_as_uint(ps), false, false);
      ps = __uint_as_float(rr[0]) + __uint_as_float(rr[1]); }
    l_reg = l_reg * alpha + ps;
#define PK4(P, BASE, OUT) do { u32x4 w = {cvtpk(P[BASE + 0], P[BASE + 1]), cvtpk(P[BASE + 2], P[BASE + 3]), cvtpk(P[BASE + 4], P[BASE + 5]), cvtpk(P[BASE + 6], P[BASE + 7])}; \
    OUT = *reinterpret_cast<h8*>(&w); } while (0)
    PK4(p0, 0, pa0); PK4(p0, 8, pa1); PK4(p1, 0, pa2); PK4(p1, 8, pa3);
#undef PK4
}
#define KSWZ(row, colB) ((row) * KRB + ((colB) ^ (((row) & 7) << 4)))
template <int DQK> __device__ __forceinline__ void qkt(f32x16& p0, f32x16& p1, const char* Ks, const h8* qr, int r32, int hi) {
    constexpr int KRB = Cfg<DQK>::KRB;
    p0 = f32x16{}; p1 = f32x16{};
#pragma unroll
    for (int d0 = 0; d0 < Cfg<DQK>::ND0; ++d0) { const int cb = (d0 * 16 + hi * 8) * 2;
        const h8 b0 = *reinterpret_cast<const h8*>(Ks + KSWZ(r32, cb));
        const h8 b1 = *reinterpret_cast<const h8*>(Ks + KSWZ(32 + r32, cb));
        p0 = __builtin_amdgcn_mfma_f32_32x32x16_f16(b0, qr[d0], p0, 0, 0, 0);
        p1 = __builtin_amdgcn_mfma_f32_32x32x16_f16(b1, qr[d0], p1, 0, 0, 0); }
}
template <int OFF> __device__ __forceinline__ h8 lds_read128(int addr) { h8 r; asm volatile("ds_read_b128 %0, %1 offset:%2" : "=&v"(r) : "v"(addr), "i"(OFF) : "memory"); return r; }
template <int N> __device__ __forceinline__ void lgkm_wait() { asm volatile("s_waitcnt lgkmcnt(%0)" :: "i"(N) : "memory"); }
template <int DQK, int W, int I> struct QkStep {
    static constexpr int NF = 2 * Cfg<DQK>::ND0, KRB = Cfg<DQK>::KRB;
    static constexpr int koff(int i) { return ((i >> 1) >> 2) * 128 + (i & 1) * 32 * KRB; }
    static __device__ __forceinline__ void issue(h8 (&kf)[W], const int (&ka)[4]) { if constexpr (I < NF) kf[I % W] = lds_read128<koff(I)>(ka[(I >> 1) & 3]); }
    static __device__ __forceinline__ void run(h8 (&kf)[W], f32x16& p0, f32x16& p1, const h8* qr, const int (&ka)[4]) {
        if constexpr (I < NF) {
            constexpr int OUT = (NF - 1 - I) < (W - 1) ? (NF - 1 - I) : (W - 1);
            lgkm_wait<OUT>(); SBAR();
            if constexpr ((I & 1) == 0) p0 = __builtin_amdgcn_mfma_f32_32x32x16_f16(kf[I % W], qr[I >> 1], p0, 0, 0, 0);
            else p1 = __builtin_amdgcn_mfma_f32_32x32x16_f16(kf[I % W], qr[I >> 1], p1, 0, 0, 0);
            SBAR();
            QkStep<DQK, W, I + W>::issue(kf, ka);
            QkStep<DQK, W, I + 1>::run(kf, p0, p1, qr, ka);
        }
    }
    static __device__ __forceinline__ void run_ci(h8 (&kf)[W], f32x16& p0, f32x16& p1, const h8* qr, const int (&ka)[4], const f32x16& ci) {
        if constexpr (I < NF) {
            constexpr int OUT = (NF - 1 - I) < (W - 1) ? (NF - 1 - I) : (W - 1);
            lgkm_wait<OUT>(); SBAR();
            if constexpr (I == 0) p0 = __builtin_amdgcn_mfma_f32_32x32x16_f16(kf[I % W], qr[I >> 1], ci, 0, 0, 0);
            else if constexpr (I == 1) p1 = __builtin_amdgcn_mfma_f32_32x32x16_f16(kf[I % W], qr[I >> 1], ci, 0, 0, 0);
            else if constexpr ((I & 1) == 0) p0 = __builtin_amdgcn_mfma_f32_32x32x16_f16(kf[I % W], qr[I >> 1], p0, 0, 0, 0);
            else p1 = __builtin_amdgcn_mfma_f32_32x32x16_f16(kf[I % W], qr[I >> 1], p1, 0, 0, 0);
            SBAR();
            QkStep<DQK, W, I + W>::issue(kf, ka);
            QkStep<DQK, W, I + 1>::run_ci(kf, p0, p1, qr, ka, ci);
        }
    }
};
template <int DQK, int W, int I> struct QkPrime { static __device__ __forceinline__ void run(h8 (&kf)[W], const int (&ka)[4]) { if constexpr (I < W && I < 2 * Cfg<DQK>::ND0) { QkStep<DQK, W, I>::issue(kf, ka); QkPrime<DQK, W, I + 1>::run(kf, ka); } } };
template <int DQK, int W> __device__ __forceinline__ void qkt_pipe(f32x16& p0, f32x16& p1, int kbase, const h8* qr, int r32, int hi) {
    constexpr int KRB = Cfg<DQK>::KRB;
    int ka[4];
#pragma unroll
    for (int q = 0; q < 4; ++q) ka[q] = kbase + r32 * KRB + ((q * 32 + hi * 16) ^ ((r32 & 7) << 4));
    p0 = f32x16{}; p1 = f32x16{};
    h8 kf[W];
    QkPrime<DQK, W, 0>::run(kf, ka);
    QkStep<DQK, W, 0>::run(kf, p0, p1, qr, ka);
}
template <int DQK, int W> __device__ __forceinline__ void qkt_pipe_ci(f32x16& p0, f32x16& p1, int kbase, const h8* qr, int r32, int hi, const f32x16& ci) {
    constexpr int KRB = Cfg<DQK>::KRB;
    int ka[4];
#pragma unroll
    for (int q = 0; q < 4; ++q) ka[q] = kbase + r32 * KRB + ((q * 32 + hi * 16) ^ ((r32 & 7) << 4));
    h8 kf[W];
    QkPrime<DQK, W, 0>::run(kf, ka);
    QkStep<DQK, W, 0>::run_ci(kf, p0, p1, qr, ka, ci);
}
__device__ __forceinline__ void partialSM_pre(f32x16& p0, f32x16& p1, f32x16& negm, float& alpha, bool first = false) {
    constexpr float THRL = THR * 1.4426950408889634f;
    float pmax = p0[0];
#pragma unroll
    for (int r = 1; r < 16; ++r) pmax = fmaxf(pmax, p0[r]);
#pragma unroll
    for (int r = 0; r < 16; ++r) pmax = fmaxf(pmax, p1[r]);
    { auto rr = __builtin_amdgcn_permlane32_swap(__float_as_uint(pmax), __float_as_uint(pmax), false, false);
      pmax = fmaxf(__uint_as_float(rr[0]), __uint_as_float(rr[1])); }
    if (__builtin_expect(!first && __all(pmax <= THRL), 1)) { alpha = 1.f; }
    else { const float dlt = first ? pmax : fmaxf(pmax, 0.f); alpha = first ? 1.f : __builtin_amdgcn_exp2f(-dlt);
#pragma unroll
        for (int r = 0; r < 16; ++r) { p0[r] -= dlt; p1[r] -= dlt; negm[r] -= dlt; } }
#pragma unroll
    for (int r = 0; r < 16; ++r) p0[r] = __builtin_amdgcn_exp2f(p0[r]);
}
__device__ __forceinline__ int v_st(int k, int c) { const int kk = (k & ~0xC) | ((k & 4) << 1) | ((k & 8) >> 1); return ((kk >> 3) * 4 + (c >> 5)) * 512 + ((kk & 7) * 32 + (c & 31)) * 2; }
__device__ __forceinline__ int v_rd_base(int lane) { return ((lane & 3) << 3) | (((lane >> 2) & 3) << 6) | (((lane >> 4) & 1) << 5) | (((lane >> 5) & 1) << 8); }
constexpr int v_rd_off(int d0, int ks, int half) { return d0 * 512 + ks * 4096 + half * 2048; }
template <int OFF> __device__ __forceinline__ s16x4 tr_read(int vb) {
    s16x4 r; asm volatile("ds_read_b64_tr_b16 %0, %1 offset:%2" : "=&v"(r) : "v"(vb), "i"(OFF) : "memory"); return r;
}
template <int D0> __device__ __forceinline__ void pv_one(f32x16& od, int vb, h8 pa0, h8 pa1, h8 pa2, h8 pa3) {
    const s16x4 l0 = tr_read<v_rd_off(D0, 0, 0)>(vb), h0 = tr_read<v_rd_off(D0, 0, 1)>(vb), l1 = tr_read<v_rd_off(D0, 1, 0)>(vb), h1 = tr_read<v_rd_off(D0, 1, 1)>(vb);
    const s16x4 l2 = tr_read<v_rd_off(D0, 2, 0)>(vb), h2_ = tr_read<v_rd_off(D0, 2, 1)>(vb), l3 = tr_read<v_rd_off(D0, 3, 0)>(vb), h3 = tr_read<v_rd_off(D0, 3, 1)>(vb);
    asm volatile("s_waitcnt lgkmcnt(0)" ::: "memory"); SBAR();
#define PKV(L, H) __builtin_bit_cast(h8, (__attribute__((ext_vector_type(8))) short){L[0], L[1], L[2], L[3], H[0], H[1], H[2], H[3]})
    od = __builtin_amdgcn_mfma_f32_32x32x16_f16(pa0, PKV(l0, h0), od, 0, 0, 0);
    od = __builtin_amdgcn_mfma_f32_32x32x16_f16(pa1, PKV(l1, h1), od, 0, 0, 0);
    od = __builtin_amdgcn_mfma_f32_32x32x16_f16(pa2, PKV(l2, h2_), od, 0, 0, 0);
    od = __builtin_amdgcn_mfma_f32_32x32x16_f16(pa3, PKV(l3, h3), od, 0, 0, 0);
#undef PKV
}
struct VFrag { s16x4 l0, h0, l1, h1, l2, h2, l3, h3; };
template <int D0> __device__ __forceinline__ void v_read8(VFrag& f, int vb) {
    f.l0 = tr_read<v_rd_off(D0, 0, 0)>(vb); f.h0 = tr_read<v_rd_off(D0, 0, 1)>(vb); f.l1 = tr_read<v_rd_off(D0, 1, 0)>(vb); f.h1 = tr_read<v_rd_off(D0, 1, 1)>(vb);
    f.l2 = tr_read<v_rd_off(D0, 2, 0)>(vb); f.h2 = tr_read<v_rd_off(D0, 2, 1)>(vb); f.l3 = tr_read<v_rd_off(D0, 3, 0)>(vb); f.h3 = tr_read<v_rd_off(D0, 3, 1)>(vb);
}
__device__ __forceinline__ void pv_mma4(f32x16& od, const VFrag& f, h8 pa0, h8 pa1, h8 pa2, h8 pa3) {
#define PKV(L, H) __builtin_bit_cast(h8, (__attribute__((ext_vector_type(8))) short){L[0], L[1], L[2], L[3], H[0], H[1], H[2], H[3]})
    od = __builtin_amdgcn_mfma_f32_32x32x16_f16(pa0, PKV(f.l0, f.h0), od, 0, 0, 0);
    od = __builtin_amdgcn_mfma_f32_32x32x16_f16(pa1, PKV(f.l1, f.h1), od, 0, 0, 0);
    od = __builtin_amdgcn_mfma_f32_32x32x16_f16(pa2, PKV(f.l2, f.h2), od, 0, 0, 0);
    od = __builtin_amdgcn_mfma_f32_32x32x16_f16(pa3, PKV(f.l3, f.h3), od, 0, 0, 0);
#undef PKV
}
__device__ __forceinline__ void pv_d0_early(f32x16* o, int vb, VFrag& A, VFrag& B, h8 pa0, h8 pa1, h8 pa2, h8 pa3) {
    asm volatile("s_waitcnt lgkmcnt(8)" ::: "memory"); SBAR(); pv_mma4(o[0], A, pa0, pa1, pa2, pa3); SBAR();
    v_read8<2>(A, vb);
    asm volatile("s_waitcnt lgkmcnt(8)" ::: "memory"); SBAR(); pv_mma4(o[1], B, pa0, pa1, pa2, pa3); SBAR();
    v_read8<3>(B, vb);
    asm volatile("s_waitcnt lgkmcnt(8)" ::: "memory"); SBAR(); pv_mma4(o[2], A, pa0, pa1, pa2, pa3); SBAR();
    asm volatile("s_waitcnt lgkmcnt(0)" ::: "memory"); SBAR(); pv_mma4(o[3], B, pa0, pa1, pa2, pa3);
}
__device__ __forceinline__ void pv_d0(f32x16* o, int vb, h8 pa0, h8 pa1, h8 pa2, h8 pa3) {
    VFrag A, B;
    v_read8<0>(A, vb); v_read8<1>(B, vb);
    asm volatile("s_waitcnt lgkmcnt(8)" ::: "memory"); SBAR(); pv_mma4(o[0], A, pa0, pa1, pa2, pa3); SBAR();
    v_read8<2>(A, vb);
    asm volatile("s_waitcnt lgkmcnt(8)" ::: "memory"); SBAR(); pv_mma4(o[1], B, pa0, pa1, pa2, pa3); SBAR();
    v_read8<3>(B, vb);
    asm volatile("s_waitcnt lgkmcnt(8)" ::: "memory"); SBAR(); pv_mma4(o[2], A, pa0, pa1, pa2, pa3); SBAR();
    asm volatile("s_waitcnt lgkmcnt(0)" ::: "memory"); SBAR(); pv_mma4(o[3], B, pa0, pa1, pa2, pa3);
}
template <int LDO>
__device__ __forceinline__ void attn_epilogue(f32x16 (&o)[4], const float (&rli)[16], f16* Ow, int mode, float lam, const float* subln, int r32, int hi) {
    if (mode == 0) {
#pragma unroll
        for (int r = 0; r < 16; ++r) { const int orow = crow(r, hi);
#pragma unroll
            for (int d0 = 0; d0 < 4; ++d0) Ow[(long)orow * LDO + d0 * 32 + r32] = (f16)(o[d0][r] * rli[r]); }
    } else {
        float sl[4];
#pragma unroll
        for (int d0 = 0; d0 < 4; ++d0) sl[d0] = subln[d0 * 32 + r32] * (1.0f - LAMBDA_INIT);
        f16 t0[4][16];
#pragma unroll
        for (int r = 0; r < 16; ++r) { const int orow = crow(r, hi);
#pragma unroll
            for (int d0 = 0; d0 < 4; ++d0) t0[d0][r] = Ow[(long)orow * LDO + d0 * 32 + r32]; }
        asm volatile("s_waitcnt vmcnt(0)" ::: "memory");
#pragma unroll
        for (int r = 0; r < 16; ++r) { const int orow = crow(r, hi); float ss = 0.f;
#pragma unroll
            for (int d0 = 0; d0 < 4; ++d0) { const float x = (float)t0[d0][r] - lam * (o[d0][r] * rli[r]); o[d0][r] = x; ss += x * x; }
            ss += __shfl_xor(ss, 1); ss += __shfl_xor(ss, 2); ss += __shfl_xor(ss, 4); ss += __shfl_xor(ss, 8); ss += __shfl_xor(ss, 16);
            const float rs = 1.0f / sqrtf(ss * (1.0f / 128.0f) + LN_EPS);
#pragma unroll
            for (int d0 = 0; d0 < 4; ++d0) Ow[(long)orow * LDO + d0 * 32 + r32] = (f16)(o[d0][r] * rs * sl[d0]); }
    }
}
template <int DQK, int LDQ, int LDK, int LDV, int LDO, int SDEPTH>
__device__ __forceinline__ void attn_body(const f16* Qb, const f16* Kh, const f16* Vh, f16* Ob, char* lds, int mode = 0, float lam = 0.f, const float* subln = nullptr) {
    using C = Cfg<DQK>;
    constexpr int KRB = C::KRB, ND0 = C::ND0, NKCH = C::NKCH, KCPR = C::KCPR; constexpr size_t SHM_K = C::SHM_K;
    constexpr int seq = SEQ;
    int tid = threadIdx.x; asm volatile("" : "+v"(tid));
    const int wid = tid >> 6, lane = tid & 63, r32 = lane & 31, hi = lane >> 5;
    char* V_lds = lds; char* K_lds = lds + 2 * SHM_V;
    float* wsl = (float*)(lds + 2 * SHM_V + 2 * SHM_K) + wid * 64; float* li_l = wsl; float* al_l = wsl + 32;
    float m_reg = -1e30f, l_reg = 0; f32x16 o[4] = {}; h8 qr[ND0];
    const f16* Qw = Qb + (long)(wid * QBLK + r32) * LDQ + hi * 8;
#pragma unroll
    for (int d0 = 0; d0 < ND0; ++d0) qr[d0] = *reinterpret_cast<const h8*>(Qw + d0 * 16);
    const int sr = tid >> 4, sc = (tid & 15) * 8, vst0 = v_st(sr, sc), vst1 = v_st(32 + sr, sc);
    int krow[NKCH], kcb[NKCH];
#pragma unroll
    for (int i = 0; i < NKCH; ++i) { const int c = tid + i * 512; krow[i] = c / KCPR; kcb[i] = (c % KCPR) * 16; }
    const int vb0 = (int)(uintptr_t)V_lds + v_rd_base(lane);
    struct { h8 vs0, vs1; h8 ks[NKCH]; } sr_[SDEPTH];
#define SLOAD(i, k0) do { sr_[i].vs0 = *reinterpret_cast<const h8*>(&Vh[(long)((k0) + sr) * LDV + sc]); sr_[i].vs1 = *reinterpret_cast<const h8*>(&Vh[(long)((k0) + 32 + sr) * LDV + sc]); \
    _Pragma("unroll") for (int _c = 0; _c < NKCH; ++_c) sr_[i].ks[_c] = *reinterpret_cast<const h8*>((const char*)Kh + (long)((k0) + krow[_c]) * (LDK * 2) + kcb[_c]); } while (0)
#define SWRITE(b, i) do { *(h8*)(V_lds + (b) * SHM_V + vst0) = sr_[i].vs0; *(h8*)(V_lds + (b) * SHM_V + vst1) = sr_[i].vs1; \
    _Pragma("unroll") for (int _c = 0; _c < NKCH; ++_c) *(h8*)(K_lds + (b) * SHM_K + KSWZ(krow[_c], kcb[_c])) = sr_[i].ks[_c]; } while (0)
#define SWAIT() do { if constexpr (SDEPTH == 2) { if constexpr (NKCH == 3) asm volatile("s_waitcnt vmcnt(5)" ::: "memory"); else asm volatile("s_waitcnt vmcnt(3)" ::: "memory"); } \
    else asm volatile("s_waitcnt vmcnt(0)" ::: "memory"); } while (0)
#define RESC(a) do { if (__any((a) < 1.f)) { if (hi == 0) al_l[r32] = (a); asm volatile("s_waitcnt lgkmcnt(0)" ::: "memory"); \
    _Pragma("unroll") for (int d = 0; d < 4; ++d) _Pragma("unroll") for (int r = 0; r < 16; ++r) o[d][r] *= al_l[crow(r, hi)]; } } while (0)
    f32x16 pA0, pA1, pB0, pB1; float mnA, mnB, alA, alB; h8 pa0, pa1, pa2, pa3; constexpr int NT = seq / KVBLK;
    constexpr int SE = 0, SO = SDEPTH - 1;
    SLOAD(SE, 0); asm volatile("s_waitcnt vmcnt(0)" ::: "memory"); SWRITE(0, SE); __syncthreads();
    qkt<DQK>(pA0, pA1, K_lds, qr, r32, hi); partialSM<DQK>(pA0, pA1, m_reg, mnA, alA);
    SLOAD(SO, KVBLK); if constexpr (SDEPTH == 2) { if (2 < NT) SLOAD(SE, 2 * KVBLK); }
    SWAIT(); SWRITE(1, SO); __syncthreads();
    for (int j = 1; j + 1 < NT; j += 2) {
        SBAR(); qkt<DQK>(pB0, pB1, K_lds + SHM_K, qr, r32, hi);
        finishSM(pA0, pA1, alA, l_reg, pa0, pa1, pa2, pa3); SBAR();
        SLOAD(SO, (j + SDEPTH) * KVBLK); SBAR();
        pv_d0(o, vb0, pa0, pa1, pa2, pa3); partialSM<DQK>(pB0, pB1, m_reg, mnB, alB);
        __syncthreads(); SWAIT(); SWRITE(0, SE);
        RESC(alB); __syncthreads();
        SBAR(); qkt<DQK>(pA0, pA1, K_lds, qr, r32, hi);
        finishSM(pB0, pB1, alB, l_reg, pa0, pa1, pa2, pa3); SBAR();
        if (SDEPTH == 1 || j + 3 < NT) SLOAD(SE, (j + 1 + SDEPTH) * KVBLK); SBAR();
        pv_d0(o, vb0 + (int)SHM_V, pa0, pa1, pa2, pa3); partialSM<DQK>(pA0, pA1, m_reg, mnA, alA);
        __syncthreads(); SWAIT(); SWRITE(1, SO);
        RESC(alA); __syncthreads();
    }
    SBAR(); qkt<DQK>(pB0, pB1, K_lds + SHM_K, qr, r32, hi);
    finishSM(pA0, pA1, alA, l_reg, pa0, pa1, pa2, pa3); SBAR();
    pv_d0(o, vb0, pa0, pa1, pa2, pa3); partialSM<DQK>(pB0, pB1, m_reg, mnB, alB);
    __syncthreads(); RESC(alB);
    finishSM(pB0, pB1, alB, l_reg, pa0, pa1, pa2, pa3); SBAR();
    pv_d0(o, vb0 + (int)SHM_V, pa0, pa1, pa2, pa3);
    if (hi == 0) li_l[r32] = l_reg; asm volatile("s_waitcnt lgkmcnt(0)" ::: "memory");
    float rli[16];
#pragma unroll
    for (int r = 0; r < 16; ++r) rli[r] = __builtin_amdgcn_rcpf(li_l[crow(r, hi)]);
    attn_epilogue<LDO>(o, rli, Ob + (long)(wid * QBLK) * LDO, mode, lam, subln, r32, hi);
    asm volatile("s_waitcnt vmcnt(0) lgkmcnt(0)" ::: "memory");
    __syncthreads();
#undef SLOAD
#undef SWRITE
#undef SWAIT
#undef RESC
}

struct ConvStream {
    const float* win; const float* wout; f16* tin; f16* tout;
    int step, step_end, it, period, pcnt;
    unsigned d[8]; f16* pend;
    char* acc; f16* dst0; int nacc;
};
constexpr int CONV_BULK_LAT = 1024, CONV_BULK_QR = 1024, CONV_BULK_TOPK = 1024;
constexpr int CONV_STEPS_IN = 16 * 64 * 128, CONV_STEPS_OUT = 16 * 16 * 256, CONV_STEPS = CONV_STEPS_IN + CONV_STEPS_OUT;
__device__ __forceinline__ void conv_drain(ConvStream& c, int lane) {
    if (c.nacc > 0) {
        asm volatile("s_waitcnt lgkmcnt(0)" ::: "memory");
        for (int q = 0; q < c.nacc; ++q) { const h8 v = *(const h8*)(c.acc + q * 1024 + lane * 16); *(h8*)(c.dst0 + q * 8) = v; }
        c.nacc = 0; }
}
__device__ __forceinline__ void conv_flush(ConvStream& c, int lane) {
    if (c.pend) { h8 o;
#pragma unroll
        for (int i = 0; i < 8; ++i) o[i] = (f16)__uint_as_float(c.d[i]);
        if (c.nacc == 0) c.dst0 = c.pend;
        *(h8*)(c.acc + c.nacc * 1024 + lane * 16) = o; ++c.nacc; c.pend = nullptr;
        if (c.nacc == 4) conv_drain(c, lane); }
}
__device__ __forceinline__ void conv_tick(ConvStream& c, int lane) {
    c.it += c.pcnt; const bool due = c.it >= c.period; if (due) c.it -= c.period; const bool go = due && (c.step < c.step_end);
    if (go) { const int s = c.step++;
        const float* src; f16* dst; int N;
        if (s < CONV_STEPS_IN) { const int strip = s >> 7, kb = s & 127, e = strip >> 6, n = (strip & 63) * 64 + lane; const int f = n & 2047, dr = (f >> 2) * 8 + (f & 3) + ((n >> 11) << 2);
            src = c.win + ((size_t)e * 1024 + kb * 8) * 4096 + n; dst = c.tin + ((size_t)e * 4096 + dr) * 1024 + kb * 8; N = 4096; }
        else { const int s2 = s - CONV_STEPS_IN; const int strip = s2 >> 8, kb = s2 & 255, e = strip >> 4, n = (strip & 15) * 64 + lane;
            src = c.wout + ((size_t)e * 2048 + kb * 8) * 1024 + n; dst = c.tout + ((size_t)e * 1024 + n) * 2048 + kb * 8; N = 1024; }
        if ((s & 3) == 0) conv_drain(c, lane);
#pragma unroll
        for (int i = 0; i < 8; ++i) c.d[i] = __float_as_uint(src[(size_t)i * N]);
        c.pend = dst; }
}
__device__ __forceinline__ void conv_init(ConvStream& cs, const float* win, const float* wout, f16* tin, f16* tout, int l, int gw, int NGW, int sb, int period, int pcnt, char* acc) {
    cs.acc = acc; cs.nacc = 0; cs.dst0 = nullptr;
    cs.win = win + (size_t)l * NE * 1024 * 4096; cs.wout = wout + (size_t)l * NE * 2048 * 1024; cs.tin = tin + (size_t)l * NE * 4096 * 1024; cs.tout = tout + (size_t)l * NE * 1024 * 2048;
    const int per = ((CONV_STEPS - sb + NGW - 1) / NGW + 3) & ~3;
    cs.step = sb + gw * per < CONV_STEPS ? sb + gw * per : CONV_STEPS; cs.step_end = sb + (gw + 1) * per < CONV_STEPS ? sb + (gw + 1) * per : CONV_STEPS; cs.it = 0; cs.pend = nullptr; cs.period = period; cs.pcnt = pcnt;
}
__device__ __forceinline__ void conv_bulk(const float* win, const float* wout, f16* tin, f16* tout, int l, int g0, int g1, int w, int nw, int lane) {
    win += (size_t)l * NE * 1024 * 4096; wout += (size_t)l * NE * 2048 * 1024; tin += (size_t)l * NE * 4096 * 1024; tout += (size_t)l * NE * 1024 * 2048;
#pragma unroll 1
    for (int g = g0 + w; g < g1; g += nw) { const int s = g * 8;
        const float* src; f16* dst; int N;
        if (s < CONV_STEPS_IN) { const int strip = s >> 7, kb = s & 127, e = strip >> 6, n = (strip & 63) * 64 + lane; const int f = n & 2047, dr = (f >> 2) * 8 + (f & 3) + ((n >> 11) << 2);
            src = win + ((size_t)e * 1024 + kb * 8) * 4096 + n; dst = tin + ((size_t)e * 4096 + dr) * 1024 + kb * 8; N = 4096; }
        else { const int s2 = s - CONV_STEPS_IN; const int strip = s2 >> 8, kb = s2 & 255, e = strip >> 4, n = (strip & 15) * 64 + lane;
            src = wout + ((size_t)e * 2048 + kb * 8) * 1024 + n; dst = tout + ((size_t)e * 1024 + n) * 2048 + kb * 8; N = 1024; }
        unsigned d[8][8];
#pragma unroll
        for (int j = 0; j < 8; ++j)
#pragma unroll
            for (int i = 0; i < 8; ++i) d[j][i] = __float_as_uint(src[(size_t)(j * 8 + i) * N]);
#pragma unroll
        for (int j = 0; j < 8; ++j) { h8 o;
#pragma unroll
            for (int i = 0; i < 8; ++i) o[i] = (f16)__uint_as_float(d[j][i]);
            *(h8*)(dst + j * 8) = o; } }
}
template <int DQK, int LDQ, int LDK, int LDV, int LDO, bool CONV = false, bool GLDS = false, bool VEARLY = false, int KWIN = 6>
__device__ __forceinline__ void attn_body_simple(const f16* Qb, const f16* Kh_, const f16* Vh_, f16* Ob, char* lds, int mode = 0, float lam = 0.f, const float* subln = nullptr, ConvStream* cs = nullptr) {
    using C = Cfg<DQK>; const f16* Kh = uniform_ptr(Kh_); const f16* Vh = uniform_ptr(Vh_);
    constexpr int KRB = C::KRB, ND0 = C::ND0, NKCH = C::NKCH, KCPR = C::KCPR; constexpr size_t SHM_K = C::SHM_K;
    int tid = threadIdx.x; asm volatile("" : "+v"(tid));
    const int wid = tid >> 6, lane = tid & 63, r32 = lane & 31, hi = lane >> 5;
    char* V_lds = lds; char* K_lds = lds + 2 * SHM_V;
    float* wsl = (float*)(lds + 2 * SHM_V + 2 * SHM_K) + wid * 64; float* li_l = wsl; float* al_l = wsl + 32;
    float m_reg = -1e30f, l_reg = 0; f32x16 o[4] = {}; h8 qr[ND0];
    const f16* Qw = Qb + (long)(wid * QBLK + r32) * LDQ + hi * 8;
#pragma unroll
    for (int d0 = 0; d0 < ND0; ++d0) qr[d0] = *reinterpret_cast<const h8*>(Qw + d0 * 16);
    const int sr = tid >> 4, sc = (tid & 15) * 8, vst0 = v_st(sr, sc), vst1 = v_st(32 + sr, sc);
    int krow[NKCH], kcb[NKCH];
#pragma unroll
    for (int i = 0; i < NKCH; ++i) { const int c = tid + i * 512; krow[i] = c / KCPR; kcb[i] = (c % KCPR) * 16; }
    const int vb0 = (int)(uintptr_t)V_lds + v_rd_base(lane);
    h8 vs0, vs1, ks[NKCH];
    unsigned gvoff[2], gkoff[NKCH]; const int wuni = __builtin_amdgcn_readfirstlane(wid);
    if constexpr (GLDS) {
#pragma unroll
        for (int i = 0; i < 2; ++i) { const int p = i * 512 + tid; const int kk = ((p >> 7) & 7) * 8 + ((p >> 2) & 7), c = ((p >> 5) & 3) * 32 + (p & 3) * 8;
            const int k = kk; gvoff[i] = (unsigned)(k * LDV + c) * 2u; }
#pragma unroll
        for (int i = 0; i < NKCH; ++i) { const int p = i * 512 + tid; const int row = p / KCPR, cp = p % KCPR; const int cs_ = (cp & ~7) | ((cp & 7) ^ (row & 7));
            gkoff[i] = (unsigned)(row * LDK + cs_ * 8) * 2u; }
    }
#define GSTAGE(b, k0) do { const char* _vb = (const char*)Vh + (size_t)__builtin_amdgcn_readfirstlane((k0) * (LDV * 2)); const char* _kb = (const char*)Kh + (size_t)__builtin_amdgcn_readfirstlane((k0) * (LDK * 2)); \
    _Pragma("unroll") for (int _i = 0; _i < 2; ++_i) { unsigned _o = gvoff[_i]; asm volatile("" : "+v"(_o)); __builtin_amdgcn_global_load_lds((const unsigned*)(_vb + _o), \
        (LAS unsigned*)(uintptr_t)(unsigned)((int)(uintptr_t)V_lds + (b) * (int)SHM_V + (_i * 512 + wuni * 64) * 16), 16, 0, 0); } \
    _Pragma("unroll") for (int _i = 0; _i < NKCH; ++_i) { unsigned _o = gkoff[_i]; asm volatile("" : "+v"(_o)); __builtin_amdgcn_global_load_lds((const unsigned*)(_kb + _o), \
        (LAS unsigned*)(uintptr_t)(unsigned)((int)(uintptr_t)K_lds + (b) * (int)SHM_K + (_i * 512 + wuni * 64) * 16), 16, 0, 0); } } while (0)
#define SLOAD1(k0) do { vs0 = *reinterpret_cast<const h8*>(&Vh[(long)((k0) + sr) * LDV + sc]); vs1 = *reinterpret_cast<const h8*>(&Vh[(long)((k0) + 32 + sr) * LDV + sc]); \
    _Pragma("unroll") for (int _c = 0; _c < NKCH; ++_c) ks[_c] = *reinterpret_cast<const h8*>((const char*)Kh + (long)((k0) + krow[_c]) * (LDK * 2) + kcb[_c]); } while (0)
#define SWRITE1(b) do { *(h8*)(V_lds + (b) * SHM_V + vst0) = vs0; *(h8*)(V_lds + (b) * SHM_V + vst1) = vs1; \
    _Pragma("unroll") for (int _c = 0; _c < NKCH; ++_c) *(h8*)(K_lds + (b) * SHM_K + KSWZ(krow[_c], kcb[_c])) = ks[_c]; } while (0)
    constexpr int NT = SEQ / KVBLK;
    f32x16 negm = {};
    if constexpr (GLDS) { GSTAGE(0, 0); asm volatile("s_waitcnt vmcnt(0)" ::: "memory"); __syncthreads(); }
    else { SLOAD1(0); asm volatile("s_waitcnt vmcnt(0)" ::: "memory"); SWRITE1(0); __syncthreads(); }
#pragma unroll 1
    for (int j = 0; j < NT; ++j) {
        const int cb = j & 1;
        if constexpr (CONV) conv_tick(*cs, lane);
        if constexpr (GLDS) { if (j + 1 < NT) GSTAGE(cb ^ 1, (j + 1) * KVBLK); } else { if (j + 1 < NT) SLOAD1((j + 1) * KVBLK); }
        SBAR();
        f32x16 p0, p1; float mn, al; h8 pa0, pa1, pa2, pa3;
        qkt_pipe_ci<DQK, KWIN>(p0, p1, (int)(uintptr_t)K_lds + cb * (int)SHM_K, qr, r32, hi, negm);
        VFrag vA, vB;
        if constexpr (VEARLY) { v_read8<0>(vA, vb0 + cb * (int)SHM_V); v_read8<1>(vB, vb0 + cb * (int)SHM_V); SBAR(); }
        partialSM_pre(p0, p1, negm, al, j == 0);
        if (__any(al < 1.f)) { if (hi == 0) al_l[r32] = al; asm volatile("s_waitcnt lgkmcnt(0)" ::: "memory");
#pragma unroll
            for (int d = 0; d < 4; ++d)
#pragma unroll
                for (int r = 0; r < 16; ++r) o[d][r] *= al_l[crow(r, hi)]; }
        finishSM(p0, p1, al, l_reg, pa0, pa1, pa2, pa3); SBAR();
        if constexpr (VEARLY) pv_d0_early(o, vb0 + cb * (int)SHM_V, vA, vB, pa0, pa1, pa2, pa3); else pv_d0(o, vb0 + cb * (int)SHM_V, pa0, pa1, pa2, pa3);
        if constexpr (GLDS) { asm volatile("s_waitcnt vmcnt(0)" ::: "memory"); } else { if (j + 1 < NT) { SWRITE1(cb ^ 1); } }
        if constexpr (CONV) conv_flush(*cs, lane);
        __syncthreads();
    }
    if (hi == 0) li_l[r32] = l_reg; asm volatile("s_waitcnt lgkmcnt(0)" ::: "memory");
    float rli[16];
#pragma unroll
    for (int r = 0; r < 16; ++r) rli[r] = __builtin_amdgcn_rcpf(li_l[crow(r, hi)]);
    attn_epilogue<LDO>(o, rli, Ob + (long)(wid * QBLK) * LDO, mode, lam, subln, r32, hi);
    asm volatile("s_waitcnt vmcnt(0) lgkmcnt(0)" ::: "memory");
    __syncthreads();
#undef SLOAD1
#undef SWRITE1
#undef GSTAGE
}

template <int DQK, int LDQ, int LDK, int LDV, int LDO, bool CONV, int KW>
__device__ __forceinline__ void attn_body_pipe3(const f16* Qb, const f16* Kh_, const f16* Vh_, f16* Ob, char* lds, int mode, float lam, const float* subln, ConvStream* cs) {
    using C = Cfg<DQK>; const f16* Kh = uniform_ptr(Kh_); const f16* Vh = uniform_ptr(Vh_);
    constexpr int KRB = C::KRB, ND0 = C::ND0, NKCH = C::NKCH, KCPR = C::KCPR; constexpr size_t SHM_K = C::SHM_K;
    constexpr int NT = SEQ / KVBLK;
    int tid = threadIdx.x; asm volatile("" : "+v"(tid));
    const int wid = tid >> 6, lane = tid & 63, r32 = lane & 31, hi = lane >> 5;
    char* V_lds = lds; char* K_lds = lds + 3 * SHM_V;
    float* wsl = (float*)(lds + 3 * SHM_V + 3 * SHM_K) + wid * 64; float* li_l = wsl; float* al_l = wsl + 32;
    float m_reg = -1e30f, l_reg = 0; f32x16 o[4] = {}; h8 qr[ND0];
    const f16* Qw = Qb + (long)(wid * QBLK + r32) * LDQ + hi * 8;
#pragma unroll
    for (int d0 = 0; d0 < ND0; ++d0) qr[d0] = *reinterpret_cast<const h8*>(Qw + d0 * 16);
    const int vb0 = (int)(uintptr_t)V_lds + v_rd_base(lane), kb0 = (int)(uintptr_t)K_lds;
    unsigned gvoff[2], gkoff[NKCH]; const int wuni = __builtin_amdgcn_readfirstlane(wid);
#pragma unroll
    for (int i = 0; i < 2; ++i) { const int p = i * 512 + tid; const int kk = ((p >> 7) & 7) * 8 + ((p >> 2) & 7), c = ((p >> 5) & 3) * 32 + (p & 3) * 8;
        const int k = kk; gvoff[i] = (unsigned)(k * LDV + c) * 2u; }
#pragma unroll
    for (int i = 0; i < NKCH; ++i) { const int p = i * 512 + tid; const int row = p / KCPR, cp = p % KCPR; const int cs_ = (cp & ~7) | ((cp & 7) ^ (row & 7)); gkoff[i] = (unsigned)(row * LDK + cs_ * 8) * 2u; }
#define GST3(slot, k0) do { const char* _vb = (const char*)Vh + (size_t)__builtin_amdgcn_readfirstlane((k0) * (LDV * 2)); const char* _kb = (const char*)Kh + (size_t)__builtin_amdgcn_readfirstlane((k0) * (LDK * 2)); \
    _Pragma("unroll") for (int _i = 0; _i < 2; ++_i) { unsigned _o = gvoff[_i]; asm volatile("" : "+v"(_o)); __builtin_amdgcn_global_load_lds((const unsigned*)(_vb + _o), \
        (LAS unsigned*)(uintptr_t)(unsigned)((int)(uintptr_t)V_lds + (slot) * (int)SHM_V + (_i * 512 + wuni * 64) * 16), 16, 0, 0); } \
    _Pragma("unroll") for (int _i = 0; _i < NKCH; ++_i) { unsigned _o = gkoff[_i]; asm volatile("" : "+v"(_o)); __builtin_amdgcn_global_load_lds((const unsigned*)(_kb + _o), \
        (LAS unsigned*)(uintptr_t)(unsigned)((int)(uintptr_t)K_lds + (slot) * (int)SHM_K + (_i * 512 + wuni * 64) * 16), 16, 0, 0); } } while (0)
#define RESC3(a) do { if (__any((a) < 1.f)) { if (hi == 0) al_l[r32] = (a); asm volatile("s_waitcnt lgkmcnt(0)" ::: "memory"); \
    _Pragma("unroll") for (int d = 0; d < 4; ++d) _Pragma("unroll") for (int r = 0; r < 16; ++r) o[d][r] *= al_l[crow(r, hi)]; } } while (0)
    f32x16 pA0, pA1, pB0, pB1; float mnA, mnB, alA, alB; h8 pa0, pa1, pa2, pa3;
    int s_cur = 0, s_nxt = 1, s_nn = 2;
    GST3(0, 0); GST3(1, KVBLK); asm volatile("s_waitcnt vmcnt(0)" ::: "memory"); __syncthreads();
    f32x16 negm = {};
    qkt_pipe<DQK, KW>(pA0, pA1, kb0, qr, r32, hi); partialSM_pre(pA0, pA1, negm, alA, true);
#define STEP3(t, X0, X1, alX, Y0, Y1, mnY, alY) do { \
        if constexpr (CONV) conv_tick(*cs, lane); \
        if ((t) + 2 < NT) GST3(s_nn, ((t) + 2) * KVBLK); \
        SBAR(); qkt_pipe_ci<DQK, KW>(Y0, Y1, kb0 + s_nxt * (int)SHM_K, qr, r32, hi, negm); \
        finishSM(X0, X1, alX, l_reg, pa0, pa1, pa2, pa3); SBAR(); \
        pv_d0(o, vb0 + s_cur * (int)SHM_V, pa0, pa1, pa2, pa3); partialSM_pre(Y0, Y1, negm, alY); \
        RESC3(alY); \
        asm volatile("s_waitcnt vmcnt(0)" ::: "memory"); \
        if constexpr (CONV) conv_flush(*cs, lane); \
        __syncthreads(); \
        { const int _t = s_cur; s_cur = s_nxt; s_nxt = s_nn; s_nn = _t; } } while (0)
#pragma unroll 1
    for (int t = 0; t < NT - 2; t += 2) { STEP3(t, pA0, pA1, alA, pB0, pB1, mnB, alB); STEP3(t + 1, pB0, pB1, alB, pA0, pA1, mnA, alA); }
    STEP3(NT - 2, pA0, pA1, alA, pB0, pB1, mnB, alB);
    finishSM(pB0, pB1, alB, l_reg, pa0, pa1, pa2, pa3); SBAR();
    pv_d0(o, vb0 + s_cur * (int)SHM_V, pa0, pa1, pa2, pa3);
    if (hi == 0) li_l[r32] = l_reg; asm volatile("s_waitcnt lgkmcnt(0)" ::: "memory");
    float rli[16];
#pragma unroll
    for (int r = 0; r < 16; ++r) rli[r] = __builtin_amdgcn_rcpf(li_l[crow(r, hi)]);
    attn_epilogue<LDO>(o, rli, Ob + (long)(wid * QBLK) * LDO, mode, lam, subln, r32, hi);
    asm volatile("s_waitcnt vmcnt(0) lgkmcnt(0)" ::: "memory");
    __syncthreads();
#undef GST3
#undef RESC3
#undef STEP3
}
#undef KSWZ
#undef SBAR
}

struct Args { const void* in[22]; float* out; unsigned char* ws; int ph_lo, ph_hi, li, pad; };
typedef const __attribute__((address_space(4))) Args* KArgs;
__device__ __forceinline__ KArgs kargs() { KArgs p = (KArgs)__builtin_amdgcn_kernarg_segment_ptr(); asm volatile("" : "+s"(p)); return p; }
struct Frame {
    LAS unsigned char* lds; char* ldsg;
    int tid, lane, wave, vcu, G;
    unsigned char* ws;
};
extern __shared__ __attribute__((aligned(16))) unsigned char g_lds[];
__device__ __forceinline__ Frame mkframe(KArgs a) {
    Frame F; int t = threadIdx.x; asm volatile("" : "+v"(t));
    F.lds = (LAS unsigned char*)g_lds; F.ldsg = (char*)g_lds;
    F.tid = t; F.lane = t & 63; F.wave = __builtin_amdgcn_readfirstlane(t >> 6);
    int g = gridDim.x, bx = blockIdx.x; asm volatile("" : "+s"(g), "+s"(bx));
    F.G = g; F.vcu = (g % 8 == 0) ? (bx % 8) * (g / 8) + bx / 8 : bx;
    F.ws = a->ws;
    return F;
}

__device__ __forceinline__ void sincos_d(double a, float& s, float& c) {
    const double k = __builtin_rint(a * 0.63661977236758134308);
    double r = __builtin_fma(-k, 1.57079632679489655800e+00, a); r = __builtin_fma(-k, 6.12323399573676603587e-17, r);
    const double r2 = r * r;
    double sp = -7.6471637318198164759e-13;
    sp = __builtin_fma(sp, r2, 1.6059043836821614599e-10);
    sp = __builtin_fma(sp, r2, -2.5052108385441718775e-08);
    sp = __builtin_fma(sp, r2, 2.7557319223985890653e-06);
    sp = __builtin_fma(sp, r2, -1.9841269841269841270e-04);
    sp = __builtin_fma(sp, r2, 8.3333333333333333333e-03);
    sp = __builtin_fma(sp, r2, -1.6666666666666666667e-01);
    const double sr = __builtin_fma(sp * r2, r, r);
    double cp = 4.7794773323873852974e-14;
    cp = __builtin_fma(cp, r2, -1.1470745597729724714e-11);
    cp = __builtin_fma(cp, r2, 2.0876756987868098979e-09);
    cp = __builtin_fma(cp, r2, -2.7557319223985890653e-07);
    cp = __builtin_fma(cp, r2, 2.4801587301587301587e-05);
    cp = __builtin_fma(cp, r2, -1.3888888888888888889e-03);
    cp = __builtin_fma(cp, r2, 4.1666666666666666667e-02);
    cp = __builtin_fma(cp, r2, -0.5);
    const double cr = __builtin_fma(cp, r2, 1.0);
    const int q = (int)((long long)k & 3);
    const double ss = (q & 1) ? cr : sr, cc = (q & 1) ? sr : cr;
    s = (float)((q & 2) ? -ss : ss); c = (float)(((q + 1) & 2) ? -cc : cc);
}
__device__ const double INV_M[32] = {
    1.0, 0.7498942093324559, 0.5623413251903491, 0.4216965034285822, 0.31622776601683794, 0.23713737056616552, 0.1778279410038923, 0.1333521432163324,
    0.1, 0.07498942093324558, 0.05623413251903491, 0.04216965034285822, 0.03162277660168379, 0.023713737056616554, 0.01778279410038923, 0.01333521432163324,
    0.01, 0.007498942093324559, 0.005623413251903491, 0.004216965034285822, 0.0031622776601683794, 0.0023713737056616554, 0.001778279410038923, 0.001333521432163324,
    0.001, 0.0007498942093324559, 0.0005623413251903491, 0.0004216965034285822, 0.00031622776601683794, 0.00023713737056616554, 0.0001778279410038923, 0.0001333521432163324 };
__device__ const double INV_D[8] = { 1.0, 0.19392274474868576, 0.03760603093086393, 0.007292664737217109, 0.001414213562373095, 0.0002742481756762073, 5.318295896944988e-05, 1.031338537721246e-05 };

template <class FD>
__device__ __forceinline__ void tr_item64(const float* W, int Nsrc, int K, f16* WT, FD dstrow, LAS float* scr, int kb, int cb, int lane, const float* kscale = nullptr) {
    const int k0 = 64 * kb, c0 = 64 * cb, r4 = lane >> 4, cq = (lane & 15) * 4;
    f32x4 v[16];
#pragma unroll
    for (int i = 0; i < 16; ++i) v[i] = *(const f32x4*)(W + (size_t)(k0 + 4 * i + r4) * Nsrc + c0 + cq);
    if (kscale) {
#pragma unroll
        for (int i = 0; i < 16; ++i) v[i] = v[i] * kscale[k0 + 4 * i + r4]; }
#pragma unroll
    for (int i = 0; i < 16; ++i) { const int k = 4 * i + r4, sw = (i >> 1) * 4;
#pragma unroll
        for (int w = 0; w < 4; ++w) scr[k * 64 + ((cq + w) ^ sw)] = v[i][w]; }
    LDS_WAIT(); asm volatile("" ::: "memory");
    const int c = lane & 7;
#pragma unroll
    for (int j = 0; j < 8; ++j) { const int col = (lane >> 3) + 8 * j; const int dr = dstrow(c0 + col); const LAS float* sp = scr + (8 * c) * 64 + (col ^ (c * 4));
        h8 o; o[0] = (f16)sp[0 * 64]; o[1] = (f16)sp[1 * 64]; o[2] = (f16)sp[2 * 64]; o[3] = (f16)sp[3 * 64]; o[4] = (f16)sp[4 * 64]; o[5] = (f16)sp[5 * 64]; o[6] = (f16)sp[6 * 64]; o[7] = (f16)sp[7 * 64];
        *(h8*)(WT + (size_t)dr * K + k0 + 8 * c) = o; }
    LDS_WAIT(); asm volatile("" ::: "memory");
}
struct RowId { __device__ __forceinline__ int operator()(int c) const { return c; } };
struct RowWin0 { __device__ __forceinline__ int operator()(int c) const { if (c < 640) return c; const int jj = c - 640; return 640 + 2 * (jj & 31) + (jj >> 5); } };
struct RowUq { __device__ __forceinline__ int operator()(int c) const { const int h = c / 192, j = c % 192; if (j < 128) return h * 128 + j; const int jj = j - 128; return 1024 + h * 64 + 2 * (jj & 31) + (jj >> 5); } };
struct RowDiff { __device__ __forceinline__ int operator()(int c) const { if (c >= 2048) return c; const int off = c & 63; if (off >= 16) return c; return (c & ~63) + 2 * (off & 7) + (off >> 3); } };
struct RowMoeIn { __device__ __forceinline__ int operator()(int c) const { const int f = c & 2047; return (f >> 2) * 8 + (f & 3) + ((c >> 11) << 2); } };

__device__ __forceinline__ void p0_prologue() {
    const KArgs a = kargs(); const Frame F = mkframe(a);
    const int tid = F.tid, lane = F.lane;
    {
        const float* cin = (const float*)a->in[1]; const float* ada_w = (const float*)a->in[3]; const float* ada_b = (const float*)a->in[4];
        float* mods = (float*)(F.ws + WS_MODS);
        LAS float* sc = (LAS float*)F.lds; LAS float* red = (LAS float*)(F.lds + 16384);
        for (int i = tid; i < 4096; i += NTHREADS) { const float v = cin[i]; sc[i] = v / (1.0f + __expf(-v)); }
        __syncthreads();
        for (int cb = blockIdx.x; cb < 256; cb += F.G) {
            const int f0 = cb * 48, l = f0 / 6144, e0 = f0 % 6144; const int g = tid / 12, cc = tid % 12;
            if (g < 40) { f32x4 a0 = {0.f, 0.f, 0.f, 0.f}, a1 = a0, a2 = a0, a3 = a0; const float* wp = ada_w + (size_t)l * 1024 * 6144 + e0 + 4 * cc;
                f32x4 w[26];
#pragma unroll
                for (int i = 0; i < 26; ++i) { const int d = g + 40 * i; w[i] = (d < 1024) ? *(const f32x4*)(wp + (size_t)d * 6144) : (f32x4){0.f, 0.f, 0.f, 0.f}; }
#pragma unroll
                for (int i = 0; i < 26; ++i) { const int d = (g + 40 * i) & 1023; a0 += w[i] * sc[d]; a1 += w[i] * sc[1024 + d]; a2 += w[i] * sc[2048 + d]; a3 += w[i] * sc[3072 + d]; }
                LAS f32x4* rp = (LAS f32x4*)red + (g * 12 + cc) * 4; rp[0] = a0; rp[1] = a1; rp[2] = a2; rp[3] = a3; }
            __syncthreads();
            if (tid < 192) { const int c2 = tid % 48, b = tid / 48; float s = 0.f;
#pragma unroll 8
                for (int gg = 0; gg < 40; ++gg) s += red[((gg * 12 + (c2 >> 2)) * 4 + b) * 4 + (c2 & 3)];
                mods[(size_t)(l * 4 + b) * 6144 + e0 + c2] = s + ada_b[l * 6144 + e0 + c2]; }
            __syncthreads();
        }
    }
    {
        const int* pos = (const int*)a->in[2];
        float* cosm = (float*)(F.ws + WS_COSM); float* sinm = (float*)(F.ws + WS_SINM); float* cosd = (float*)(F.ws + WS_COSD); float* sind = (float*)(F.ws + WS_SIND);
        for (int i = blockIdx.x * NTHREADS + tid; i < T * 40; i += F.G * NTHREADS) {
            const int t = i / 40, j = i % 40; const double p = (double)pos[t]; float s, c;
            if (j < 32) { sincos_d(p * INV_M[j], s, c); cosm[(size_t)t * 32 + j] = c; sinm[(size_t)t * 32 + j] = s; }
            else { sincos_d(p * INV_D[j - 32], s, c); cosd[(size_t)t * 8 + (j - 32)] = c; sind[(size_t)t * 8 + (j - 32)] = s; }
        }
    }
    {
        LAS float* scr = (LAS float*)(F.lds + F.wave * 16384);
        const int gw = F.vcu * NWAVES + F.wave, NGW = F.G * NWAVES;
        { f16* z = (f16*)(F.ws + WS_WIN0) + (size_t)704 * 1024; for (int i = blockIdx.x * NTHREADS + tid; i < 8192; i += F.G * NTHREADS) *(u32x4*)(z + (size_t)i * 8) = (u32x4){0u, 0u, 0u, 0u}; }
        __syncthreads();
        constexpr int I0 = 16 * 11, I1 = 6 * 24, I2 = 4 * 32, I3 = 16 * 16, I4 = 16 * 48, I5 = 16 * 16;
        constexpr int ISM = I0 + I1 + I2 + I3 + I4 + I5;
        constexpr int IMI = 16 * 64, IMO = 32 * 16;
        constexpr int NITEMS = ISM;
        for (int it = gw; it < NITEMS; it += NGW) {
            int r = it;
            if (r < I0) { tr_item64((const float*)a->in[9], 704, 1024, (f16*)(F.ws + WS_WIN0), RowWin0(), scr, r / 11, r % 11, lane); continue; } r -= I0;
            if (r < I1) { tr_item64((const float*)a->in[12], 1536, 384, (f16*)(F.ws + WS_WUQ), RowUq(), scr, r / 24, r % 24, lane, (const float*)a->in[10]); continue; } r -= I1;
            if (r < I2) { tr_item64((const float*)a->in[13], 2048, 256, (f16*)(F.ws + WS_WUKV), RowId(), scr, r / 32, r % 32, lane, (const float*)a->in[11]); continue; } r -= I2;
            if (r < I3) { tr_item64((const float*)a->in[14], 1024, 1024, (f16*)(F.ws + WS_WO0), RowId(), scr, r / 16, r % 16, lane); continue; } r -= I3;
            if (r < I4) { tr_item64((const float*)a->in[15], 3072, 1024, (f16*)(F.ws + WS_WIN1), RowDiff(), scr, r / 48, r % 48, lane); continue; } r -= I4;
            if (r < I5) { tr_item64((const float*)a->in[18], 1024, 1024, (f16*)(F.ws + WS_WO1), RowId(), scr, r / 16, r % 16, lane); continue; }
        }
    }
}

__device__ __forceinline__ void mod_rows_p1() {
    const KArgs a = kargs(); const Frame F = mkframe(a);
    const float* x = (const float*)a->in[0]; const float* mods_l = (const float*)(F.ws + WS_MODS); f16* out = (f16*)(F.ws + WS_HA);
    const int gw = F.vcu * NWAVES + F.wave, NGW = F.G * NWAVES, lane = F.lane;
    for (int m0 = gw; m0 < T; m0 += 2 * NGW) {
        f32x4 v[2][4], shv[2][4], scv[2][4];
#pragma unroll
        for (int u = 0; u < 2; ++u) { const int m = (m0 + u * NGW < T) ? m0 + u * NGW : m0; const float* mb = mods_l + (m >> 12) * 6144;
#pragma unroll
            for (int j = 0; j < 4; ++j) { const int c = 4 * lane + 256 * j; v[u][j] = *(const f32x4*)(x + (size_t)m * DM + c); shv[u][j] = *(const f32x4*)(mb + c); scv[u][j] = *(const f32x4*)(mb + 1024 + c); } }
#pragma unroll
        for (int u = 0; u < 2; ++u) { const int m = m0 + u * NGW; if (m < T) {
#pragma unroll
            for (int j = 0; j < 4; ++j) { const int c = 4 * lane + 256 * j;
                const f32x4 h = v[u][j] * (scv[u][j] + 1.0f) + shv[u][j]; h4 o; o[0] = (f16)h[0]; o[1] = (f16)h[1]; o[2] = (f16)h[2]; o[3] = (f16)h[3];
                *(h4*)(out + (size_t)m * DM + c) = o; } } }
    }
}

#define RCOL(lane, j) ((((j) >> 1) << 9) + 8 * (lane) + 4 * ((j) & 1))
__device__ __forceinline__ void h8_to_f4(const h8 v, f32x4& a, f32x4& b) { a = (f32x4){(float)v[0], (float)v[1], (float)v[2], (float)v[3]}; b = (f32x4){(float)v[4], (float)v[5], (float)v[6], (float)v[7]}; }
__device__ __forceinline__ int rt_off(int row, int chunk) { return row * 2048 + ((chunk ^ (row & 15)) << 4); }
__device__ __forceinline__ void ln_router(int l) {
    const KArgs a = kargs(); const Frame F = mkframe(a);
    const float* lng = (const float*)a->in[5] + l * DM; const float* lnb = (const float*)a->in[6] + l * DM; const float* router_w = (const float*)a->in[19] + (size_t)l * DM * NE;
    const float* mods_l = (const float*)(F.ws + WS_MODS) + (size_t)l * 4 * 6144;
    const f16* pre = (const f16*)(F.ws + WS_PRE); float* stat = (float*)(F.ws + WS_STAT); f16* hB = (f16*)(F.ws + WS_HB); float* aff = (float*)(F.ws + WS_AFF);
    LAS unsigned char* WHI = F.lds; LAS unsigned char* WLO = F.lds + 32768; LAS unsigned char* HHI = F.lds + 65536; LAS unsigned char* HLO = F.lds + 98304;
    LAS float* PART = (LAS float*)(F.lds + pg8::GATHER_IDX_OFF);
    const int tid = F.tid, lane = F.lane, wave = F.wave;
    for (int d = tid; d < 1024; d += NTHREADS) {
        f32x4 r[4];
#pragma unroll
        for (int q = 0; q < 4; ++q) r[q] = *(const f32x4*)(router_w + (size_t)d * 16 + 4 * q);
#pragma unroll
        for (int e = 0; e < 16; ++e) { const float w = r[e >> 2][e & 3]; const f16 hi = (f16)w; const f16 lo = (f16)(w - (float)hi);
            const int off = rt_off(e, d >> 3) + (d & 7) * 2; *(LAS f16*)(WHI + off) = hi; *(LAS f16*)(WLO + off) = lo; } }
    __syncthreads();
    const int gw = F.vcu * NWAVES + wave, NGW = F.G * NWAVES;
    f32x4 gpar[4], bpar[4];
#pragma unroll
    for (int j = 0; j < 4; ++j) { gpar[j] = *(const f32x4*)(lng + RCOL(lane, j)); bpar[j] = *(const f32x4*)(lnb + RCOL(lane, j)); }
    const int fr = lane & 15, fq = lane >> 4;
#pragma unroll 1
    for (int m0 = gw; m0 < T; m0 += 2 * NGW) {
        h8 pv[2][2]; f32x4 shv[2][4], scv[2][4];
#pragma unroll
        for (int u = 0; u < 2; ++u) { const int m = m0 + u * NGW; pv[u][0] = *(const h8*)(pre + (size_t)m * DM + 8 * lane); pv[u][1] = *(const h8*)(pre + (size_t)m * DM + 512 + 8 * lane);
            const float* mbu = mods_l + (m >> 12) * 6144;
#pragma unroll
            for (int j = 0; j < 4; ++j) { shv[u][j] = *(const f32x4*)(mbu + 3072 + RCOL(lane, j)); scv[u][j] = *(const f32x4*)(mbu + 4096 + RCOL(lane, j)); } }
#pragma unroll
        for (int u = 0; u < 2; ++u) { const int m = m0 + u * NGW; const int tr = 2 * wave + u;
            f32x4 v[4]; h8_to_f4(pv[u][0], v[0], v[1]); h8_to_f4(pv[u][1], v[2], v[3]); float s = 0.f;
#pragma unroll
            for (int j = 0; j < 4; ++j) s += (v[j][0] + v[j][1]) + (v[j][2] + v[j][3]);
            const float mean = wave_sum(s) * (1.f / DM); float s2 = 0.f;
#pragma unroll
            for (int j = 0; j < 4; ++j) { v[j] = v[j] - mean; s2 += (v[j][0] * v[j][0] + v[j][1] * v[j][1]) + (v[j][2] * v[j][2] + v[j][3] * v[j][3]); }
            const float rstd = 1.0f / sqrtf(wave_sum(s2) * (1.f / DM) + LN_EPS);
            if (lane == 0) { f32x2 st = {mean, rstd}; *(f32x2*)(stat + (size_t)m * 2) = st; }
            f32x4 hh[4];
#pragma unroll
            for (int j = 0; j < 4; ++j) { const f32x4 xn = v[j] * rstd * gpar[j] + bpar[j]; hh[j] = xn * (scv[u][j] + 1.0f) + shv[u][j]; }
            const h8 hi0 = pack8(hh[0], hh[1]), hi1 = pack8(hh[2], hh[3]); h8 lo0, lo1;
#pragma unroll
            for (int i = 0; i < 4; ++i) { lo0[i] = (f16)(hh[0][i] - (float)hi0[i]); lo0[4 + i] = (f16)(hh[1][i] - (float)hi0[4 + i]); lo1[i] = (f16)(hh[2][i] - (float)hi1[i]); lo1[4 + i] = (f16)(hh[3][i] - (float)hi1[4 + i]); }
            *(h8*)(hB + (size_t)m * DM + 8 * lane) = hi0; *(h8*)(hB + (size_t)m * DM + 512 + 8 * lane) = hi1;
            *(LAS h8*)(HHI + rt_off(tr, lane)) = hi0; *(LAS h8*)(HHI + rt_off(tr, 64 + lane)) = hi1; *(LAS h8*)(HLO + rt_off(tr, lane)) = lo0; *(LAS h8*)(HLO + rt_off(tr, 64 + lane)) = lo1; }
        __syncthreads();
        f32x4 d = {0.f, 0.f, 0.f, 0.f};
#pragma unroll
        for (int ks = 0; ks < 4; ++ks) { const int ch = (wave * 4 + ks) * 4 + fq;
            const h8 ahi = *(const LAS h8*)(WHI + rt_off(fr, ch)), alo = *(const LAS h8*)(WLO + rt_off(fr, ch)), bhi = *(const LAS h8*)(HHI + rt_off(fr, ch)), blo = *(const LAS h8*)(HLO + rt_off(fr, ch));
            d = __builtin_amdgcn_mfma_f32_16x16x32_f16(ahi, bhi, d, 0, 0, 0); d = __builtin_amdgcn_mfma_f32_16x16x32_f16(ahi, blo, d, 0, 0, 0); d = __builtin_amdgcn_mfma_f32_16x16x32_f16(alo, bhi, d, 0, 0, 0); }
        *(LAS f32x4*)(PART + (wave * 64 + lane) * 4) = d;
        __syncthreads();
        if (wave == 0) {
            f32x4 t = *(const LAS f32x4*)(PART + lane * 4);
#pragma unroll
            for (int w = 1; w < 8; ++w) t += *(const LAS f32x4*)(PART + (w * 64 + lane) * 4);
            float mx = fmaxf(fmaxf(t[0], t[1]), fmaxf(t[2], t[3])); mx = fmaxf(mx, __shfl_xor(mx, 16)); mx = fmaxf(mx, __shfl_xor(mx, 32));
            f32x4 pe; pe[0] = __expf(t[0] - mx); pe[1] = __expf(t[1] - mx); pe[2] = __expf(t[2] - mx); pe[3] = __expf(t[3] - mx);
            float den = (pe[0] + pe[1]) + (pe[2] + pe[3]); den += __shfl_xor(den, 16); den += __shfl_xor(den, 32);
            const float rden = 1.0f / den;
            const int mrow = (F.vcu * NWAVES + (fr >> 1)) + ((m0 - gw) + (fr & 1) * NGW);
            const int bb = mrow >> 12, ss = mrow & 4095;
#pragma unroll
            for (int i = 0; i < 4; ++i) aff[(size_t)(bb * 16 + 4 * fq + i) * SEQ + ss] = pe[i] * rden;
        }
    }
    __syncthreads();
}

__device__ __forceinline__ int block_excl_scan(int v, LAS int* tmp, int tid, int& total) {
    const int lane = tid & 63, wid = tid >> 6; int x = v;
#pragma unroll
    for (int o = 1; o < 64; o <<= 1) { const int y = __shfl_up(x, o); if (lane >= o) x += y; }
    if (lane == 63) tmp[wid] = x;
    __syncthreads();
    int base = 0, tot = 0;
#pragma unroll
    for (int w = 0; w < 8; ++w) { const int t = tmp[w]; if (w < wid) base += t; tot += t; }
    __syncthreads();
    total = tot; return base + x - v;
}
__device__ __forceinline__ void topk_phase(int l) {
    const KArgs a = kargs(); const Frame F = mkframe(a);
    const float* aff = (const float*)(F.ws + WS_AFF); float* gate = (float*)(F.ws + WS_GATE); int* rowtok = (int*)(F.ws + WS_ROWTOK); int* inv = (int*)(F.ws + WS_INV);
    LAS unsigned* hist = (LAS unsigned*)F.lds; LAS unsigned* selw = hist + 256; LAS int* tmp = (LAS int*)(hist + 272);
    const int tid = F.tid;
    for (int p = blockIdx.x; p < NB * NE; p += F.G) { const int b = p >> 4, e = p & 15;
        const float* ap = aff + (size_t)p * SEQ + 8 * tid; unsigned key[8];
        { const f32x4 a0 = *(const f32x4*)ap, a1 = *(const f32x4*)(ap + 4);
          key[0] = __float_as_uint(a0[0]); key[1] = __float_as_uint(a0[1]); key[2] = __float_as_uint(a0[2]); key[3] = __float_as_uint(a0[3]);
          key[4] = __float_as_uint(a1[0]); key[5] = __float_as_uint(a1[1]); key[6] = __float_as_uint(a1[2]); key[7] = __float_as_uint(a1[3]); }
        unsigned prefix = 0u, kk = CAP;
        for (int pass = 0; pass < 4; ++pass) { const int shift = 24 - 8 * pass;
            if (tid < 256) hist[tid] = 0u;
            __syncthreads();
#pragma unroll
            for (int j = 0; j < 8; ++j) { const bool match = (pass == 0) || ((key[j] >> (shift + 8)) == prefix); if (match) atomicAdd((unsigned*)&hist[(key[j] >> shift) & 255u], 1u); }
            __syncthreads();
            { const int hv = (tid < 256) ? (int)hist[255 - tid] : 0; int tot_; const int Sp = block_excl_scan(hv, tmp, tid, tot_);
              if (tid < 256 && (unsigned)Sp < kk && kk <= (unsigned)(Sp + hv)) { selw[0] = 255u - (unsigned)tid; selw[1] = kk - (unsigned)Sp; } }
            __syncthreads();
            prefix = (prefix << 8) | selw[0]; kk = selw[1];
            __syncthreads();
        }
        int ce = 0;
#pragma unroll
        for (int j = 0; j < 8; ++j) ce += (key[j] == prefix) ? 1 : 0;
        int tot; int eqr = block_excl_scan(ce, tmp, tid, tot);
        unsigned selm = 0u; int cs = 0;
#pragma unroll
        for (int j = 0; j < 8; ++j) { bool sel = key[j] > prefix; if (key[j] == prefix) { sel = (unsigned)eqr < kk; ++eqr; } if (sel) { selm |= 1u << j; ++cs; } }
        int slot = block_excl_scan(cs, tmp, tid, tot);
#pragma unroll
        for (int j = 0; j < 8; ++j) { const int s_ = 8 * tid + j; const int tok = b * SEQ + s_; const bool sel = (selm >> j) & 1u;
            if (sel) { const int row = e * EROWS + b * CAP + slot; rowtok[row] = tok; gate[row] = __uint_as_float(key[j]); inv[(size_t)tok * 16 + e] = slot; ++slot; }
            else inv[(size_t)tok * 16 + e] = -1; }
        __syncthreads();
    }
    if (l == 0) { const int first = F.G > NB * NE ? NB * NE : 0; if ((int)blockIdx.x >= first) att::conv_bulk((const float*)a->in[20], (const float*)a->in[21], (f16*)(F.ws + WS_MOEIN), (f16*)(F.ws + WS_MOEOUT), 1, 0, att::CONV_BULK_TOPK, ((int)blockIdx.x - first) * NWAVES + F.wave, (F.G - first) * NWAVES, F.lane); }
}
__device__ __forceinline__ void combine_ln(int l) {
    const KArgs a = kargs(); const Frame F = mkframe(a);
    const float* lng1 = (const float*)a->in[5] + l * DM; const float* lnb1 = (const float*)a->in[6] + l * DM;
    const float* lng = (const float*)a->in[7] + l * DM; const float* lnb = (const float*)a->in[8] + l * DM;
    const float* mods_l = (const float*)(F.ws + WS_MODS) + (size_t)l * 4 * 6144; const float* mods_next = (const float*)(F.ws + WS_MODS) + (size_t)4 * 6144;
    float* xo32 = a->out; f16* x2 = (f16*)(F.ws + WS_X2); f16* hA = (f16*)(F.ws + WS_HA);
    const f16* pre = (const f16*)(F.ws + WS_PRE); const float* stat = (const float*)(F.ws + WS_STAT); const f16* y = (const f16*)(F.ws + WS_Y); const int* inv = (const int*)(F.ws + WS_INV);
    const int gw = F.vcu * NWAVES + F.wave, NGW = F.G * NWAVES, lane = F.lane;
    f32x4 g1p[4], b1p[4], g2p[4], b2p[4];
#pragma unroll
    for (int j = 0; j < 4; ++j) { const int c = RCOL(lane, j); g1p[j] = *(const f32x4*)(lng1 + c); b1p[j] = *(const f32x4*)(lnb1 + c); g2p[j] = *(const f32x4*)(lng + c); b2p[j] = *(const f32x4*)(lnb + c); }
#pragma unroll 1
    for (int m0 = gw; m0 < T; m0 += 2 * NGW) {
        int myinv[2], mr[2]; h8 pv[2][2]; f32x2 st[2]; f32x4 gate[2][4];
#pragma unroll
        for (int u = 0; u < 2; ++u) { const int m = (m0 + u * NGW < T) ? m0 + u * NGW : m0; mr[u] = m; myinv[u] = inv[(size_t)m * 16 + (lane & 15)]; st[u] = *(const f32x2*)(stat + (size_t)m * 2);
            pv[u][0] = *(const h8*)(pre + (size_t)m * DM + 8 * lane); pv[u][1] = *(const h8*)(pre + (size_t)m * DM + 512 + 8 * lane);
            const float* mb = mods_l + (m >> 12) * 6144;
#pragma unroll
            for (int j = 0; j < 4; ++j) gate[u][j] = *(const f32x4*)(mb + 5120 + RCOL(lane, j)); }
        unsigned mask[2]; h8 ya[2][4]; float w1[2];
#pragma unroll
        for (int u = 0; u < 2; ++u) { mask[u] = (unsigned)(__ballot(myinv[u] >= 0) & 0xFFFFull); const int b = mr[u] >> 12;
            unsigned mk = mask[u]; const bool any = mk != 0u; const int e0 = any ? __builtin_ctz(mk) : 0; mk &= mk - 1u; const bool two = mk != 0u; const int e1 = two ? __builtin_ctz(mk) : e0; mk &= mk - 1u; mask[u] = mk;
            const int s0 = any ? __shfl(myinv[u], e0) : 0, s1 = two ? __shfl(myinv[u], e1) : s0;
            const f16* y0 = y + (size_t)(e0 * EROWS + b * CAP + s0) * DM; const f16* y1 = y + (size_t)(e1 * EROWS + b * CAP + s1) * DM;
            ya[u][0] = *(const h8*)(y0 + 8 * lane); ya[u][1] = *(const h8*)(y0 + 512 + 8 * lane); ya[u][2] = *(const h8*)(y1 + 8 * lane); ya[u][3] = *(const h8*)(y1 + 512 + 8 * lane);
            w1[u] = two ? 1.0f : 0.0f; if (!any) { ya[u][0] = h8{}; ya[u][1] = h8{}; } }
#pragma unroll
        for (int u = 0; u < 2; ++u) { const int m = m0 + u * NGW; if (m < T) {
        const int b = m >> 12;
        f32x4 f[4]; { f32x4 t0, t1;
            h8_to_f4(ya[u][0], f[0], f[1]); h8_to_f4(ya[u][1], f[2], f[3]);
            h8_to_f4(ya[u][2], t0, t1); f[0] += t0 * w1[u]; f[1] += t1 * w1[u]; h8_to_f4(ya[u][3], t0, t1); f[2] += t0 * w1[u]; f[3] += t1 * w1[u]; }
        unsigned mk = mask[u];
        while (mk) {
            const int e0 = __builtin_ctz(mk); mk &= mk - 1u; const bool two = mk != 0u; const int e1 = two ? __builtin_ctz(mk) : e0; mk &= mk - 1u;
            const int s0 = __shfl(myinv[u], e0), s1 = __shfl(myinv[u], e1);
            const f16* y0 = y + (size_t)(e0 * EROWS + b * CAP + s0) * DM; const f16* y1 = y + (size_t)(e1 * EROWS + b * CAP + s1) * DM;
            const h8 a00 = *(const h8*)(y0 + 8 * lane), a01 = *(const h8*)(y0 + 512 + 8 * lane), a10 = *(const h8*)(y1 + 8 * lane), a11 = *(const h8*)(y1 + 512 + 8 * lane);
            const float w = two ? 1.0f : 0.0f; f32x4 t0, t1;
            h8_to_f4(a00, t0, t1); f[0] += t0; f[1] += t1; h8_to_f4(a01, t0, t1); f[2] += t0; f[3] += t1;
            h8_to_f4(a10, t0, t1); f[0] += t0 * w; f[1] += t1 * w; h8_to_f4(a11, t0, t1); f[2] += t0 * w; f[3] += t1 * w;
        }
        f32x4 v[4]; h8_to_f4(pv[u][0], v[0], v[1]); h8_to_f4(pv[u][1], v[2], v[3]); float s = 0.f;
#pragma unroll
        for (int j = 0; j < 4; ++j) { const f32x4 x1 = (v[j] - st[u][0]) * st[u][1] * g1p[j] + b1p[j];
            v[j] = x1 * ALPHA + (gate[u][j] + 1.0f) * f[j]; s += (v[j][0] + v[j][1]) + (v[j][2] + v[j][3]); }
        const float mean = wave_sum(s) * (1.f / DM); float s2 = 0.f;
#pragma unroll
        for (int j = 0; j < 4; ++j) { v[j] = v[j] - mean; s2 += (v[j][0] * v[j][0] + v[j][1] * v[j][1]) + (v[j][2] * v[j][2] + v[j][3] * v[j][3]); }
        const float rstd = 1.0f / sqrtf(wave_sum(s2) * (1.f / DM) + LN_EPS);
        f32x4 xn[4];
#pragma unroll
        for (int j = 0; j < 4; ++j) xn[j] = v[j] * rstd * g2p[j] + b2p[j];
        if (l == 0) {
            *(h8*)(x2 + (size_t)m * DM + 8 * lane) = pack8(xn[0], xn[1]); *(h8*)(x2 + (size_t)m * DM + 512 + 8 * lane) = pack8(xn[2], xn[3]);
            const float* mn = mods_next + b * 6144; f32x4 hv[4];
#pragma unroll
            for (int j = 0; j < 4; ++j) { const int c = RCOL(lane, j); const f32x4 sh = *(const f32x4*)(mn + c), sc = *(const f32x4*)(mn + 1024 + c); hv[j] = xn[j] * (sc + 1.0f) + sh; }
            *(h8*)(hA + (size_t)m * DM + 8 * lane) = pack8(hv[0], hv[1]); *(h8*)(hA + (size_t)m * DM + 512 + 8 * lane) = pack8(hv[2], hv[3]);
        } else {
#pragma unroll
            for (int j = 0; j < 4; ++j) *(f32x4*)(xo32 + (size_t)m * DM + RCOL(lane, j)) = xn[j];
        }
        } }
    }
}

__device__ __forceinline__ void attn_mla() {
    const KArgs a = kargs(); const Frame F = mkframe(a);
    const f16* Q = (const f16*)(F.ws + WS_Q); const f16* K = (const f16*)(F.ws + WS_K); const f16* V = (const f16*)(F.ws + WS_V); f16* O = (f16*)(F.ws + WS_O);
    att::ConvStream cs; att::conv_init(cs, (const float*)a->in[20], (const float*)a->in[21], (f16*)(F.ws + WS_MOEIN), (f16*)(F.ws + WS_MOEOUT), 0, F.vcu * NWAVES + F.wave, F.G * NWAVES, (att::CONV_BULK_LAT + att::CONV_BULK_QR) * 8, 128, 88, F.ldsg + 83968 + F.wave * 4096);
    for (int u = F.vcu; u < NB * 8 * 16; u += F.G) { const int qb = u & 15, bh = u >> 4, h = bh & 7, b = bh >> 3;
        att::attn_body_simple<192, 1536, 1536, 1024, 1024, true, true>(Q + (size_t)(b * SEQ + qb * 256) * 1536 + h * 192, K + (size_t)(b * SEQ) * 1536 + h * 192, V + (size_t)(b * SEQ) * 1024 + h * 128,
                                                                 O + (size_t)(b * SEQ + qb * 256) * 1024 + h * 128, F.ldsg, 0, 0.f, nullptr, &cs); }
    while (cs.step < cs.step_end) { cs.it = cs.period; att::conv_tick(cs, F.lane); att::conv_flush(cs, F.lane); }
    att::conv_flush(cs, F.lane); att::conv_drain(cs, F.lane);
}
__device__ __forceinline__ void attn_diff() {
    const KArgs a = kargs(); const Frame F = mkframe(a);
    const f16* QKV = (const f16*)(F.ws + WS_QKV1); f16* O = (f16*)(F.ws + WS_O);
    const float* lamv = (const float*)a->in[16]; const float* subln = (const float*)a->in[17];
    const float l01 = wave_sum(lamv[F.lane] * lamv[64 + F.lane]), l23 = wave_sum(lamv[128 + F.lane] * lamv[192 + F.lane]);
    const float lam = expf(l01) - expf(l23) + LAMBDA_INIT;
    att::ConvStream cs; att::conv_init(cs, (const float*)a->in[20], (const float*)a->in[21], (f16*)(F.ws + WS_MOEIN), (f16*)(F.ws + WS_MOEOUT), 1, F.vcu * NWAVES + F.wave, F.G * NWAVES, att::CONV_BULK_TOPK * 8, 252, 92, F.ldsg + 75776 + F.wave * 4096);
    for (int u = F.vcu; u < NB * 8 * 16; u += F.G) { const int qb = u & 15, bh = u >> 4, h = bh & 7, b = bh >> 3;
        f16* Ob = O + (size_t)(b * SEQ + qb * 256) * 1024 + h * 128; const f16* Vh = QKV + (size_t)(b * SEQ) * 3072 + 2048 + h * 128;
#pragma unroll 1
        for (int c = 0; c < 2; ++c) { const int hh = 2 * h + c;
            att::attn_body_pipe3<64, 3072, 3072, 3072, 1024, true, 8>(QKV + (size_t)(b * SEQ + qb * 256) * 3072 + hh * 64, QKV + (size_t)(b * SEQ) * 3072 + 1024 + hh * 64, Vh, Ob, F.ldsg, c, lam, subln, &cs); } }
    while (cs.step < cs.step_end) { cs.it = cs.period; att::conv_tick(cs, F.lane); att::conv_flush(cs, F.lane); }
    att::conv_flush(cs, F.lane); att::conv_drain(cs, F.lane);
}

__device__ __forceinline__ void ph_gemm_lat() { const KArgs a = kargs(); const Frame F = mkframe(a);
    pg8::Gemm g{(const f16*)(F.ws + WS_HA), (const f16*)(F.ws + WS_WIN0), T, 768, 1024, 1 << 30, 0, nullptr}; pg8::StaticOrder S; S.init(T, 768, F.G, (int)blockIdx.x);
    EpiLat E{(f16*)(F.ws + WS_CQN), (f16*)(F.ws + WS_CKVN), (f16*)(F.ws + WS_K), (float*)(F.ws + WS_PQ), (float*)(F.ws + WS_PKV), (const float*)(F.ws + WS_COSM), (const float*)(F.ws + WS_SINM)}; pg8::gemm_phase<EpiLat>(F.lds, g, S, E);
    { const int first = F.G > S.nwg ? S.nwg : 0; if ((int)blockIdx.x >= first) att::conv_bulk((const float*)a->in[20], (const float*)a->in[21], (f16*)(F.ws + WS_MOEIN), (f16*)(F.ws + WS_MOEOUT), 0, 0, att::CONV_BULK_LAT, ((int)blockIdx.x - first) * NWAVES + F.wave, (F.G - first) * NWAVES, F.lane); } }
__device__ __forceinline__ void ph_gemm_q() { const KArgs a = kargs(); const Frame F = mkframe(a);
    pg8::Gemm g{(const f16*)(F.ws + WS_CQN), (const f16*)(F.ws + WS_WUQ), T, 1024, 384, 1 << 30, 0, nullptr}; pg8::StaticOrder S; S.init(T, 1024, F.G, (int)blockIdx.x);
    EpiQNope E{(f16*)(F.ws + WS_Q), (const float*)(F.ws + WS_PQ)}; pg8::gemm_phase<EpiQNope>(F.lds, g, S, E); }
__device__ __forceinline__ void ph_gemm_qr() { const KArgs a = kargs(); const Frame F = mkframe(a);
    pg8::Gemm g{(const f16*)(F.ws + WS_CQN), (const f16*)(F.ws + WS_WUQ) + (size_t)1024 * 384, T, 512, 384, 1 << 30, 0, nullptr}; pg8::StaticOrder S; S.init(T, 512, F.G, (int)blockIdx.x);
    EpiQRope E{(f16*)(F.ws + WS_Q), (const float*)(F.ws + WS_COSM), (const float*)(F.ws + WS_SINM), (const float*)(F.ws + WS_PQ)}; pg8::gemm_phase<EpiQRope>(F.lds, g, S, E);
    { const int first = F.G > S.nwg ? S.nwg : 0; if ((int)blockIdx.x >= first) att::conv_bulk((const float*)a->in[20], (const float*)a->in[21], (f16*)(F.ws + WS_MOEIN), (f16*)(F.ws + WS_MOEOUT), 0, att::CONV_BULK_LAT, att::CONV_BULK_LAT + att::CONV_BULK_QR, ((int)blockIdx.x - first) * NWAVES + F.wave, (F.G - first) * NWAVES, F.lane); } }
__device__ __forceinline__ void ph_gemm_kv() { const KArgs a = kargs(); const Frame F = mkframe(a);
    pg8::Gemm g{(const f16*)(F.ws + WS_CKVN), (const f16*)(F.ws + WS_WUKV), T, 2048, 256, 1 << 30, 0, nullptr}; pg8::StaticOrder S; S.init(T, 2048, F.G, (int)blockIdx.x);
    EpiKV E{(f16*)(F.ws + WS_K), (f16*)(F.ws + WS_V), (const float*)(F.ws + WS_PKV)}; pg8::gemm_phase<EpiKV>(F.lds, g, S, E); }
__device__ __forceinline__ void ph_gemm_o(int l) { const KArgs a = kargs(); const Frame F = mkframe(a);
    pg8::Gemm g{(const f16*)(F.ws + WS_O), (const f16*)(F.ws + (l == 0 ? WS_WO0 : WS_WO1)), T, 1024, 1024, 1 << 30, 0, nullptr}; pg8::StaticOrder S; S.init(T, 1024, F.G, (int)blockIdx.x);
    const float* gm = (const float*)(F.ws + WS_MODS) + (size_t)l * 4 * 6144 + 2048;
    if (l == 0) { EpiPre<false> E{a->in[0], gm, (f16*)(F.ws + WS_PRE)}; pg8::gemm_phase<EpiPre<false>>(F.lds, g, S, E); }
    else { EpiPre<true> E{(const void*)(F.ws + WS_X2), gm, (f16*)(F.ws + WS_PRE)}; pg8::gemm_phase<EpiPre<true>>(F.lds, g, S, E); } }
__device__ __forceinline__ void ph_gemm_diffin() { const KArgs a = kargs(); const Frame F = mkframe(a);
    pg8::Gemm g{(const f16*)(F.ws + WS_HA), (const f16*)(F.ws + WS_WIN1), T, 3072, 1024, 1 << 30, 0, nullptr}; pg8::StaticOrder S; S.init(T, 3072, F.G, (int)blockIdx.x);
    EpiDiffIn E{(f16*)(F.ws + WS_QKV1), (const float*)(F.ws + WS_COSD), (const float*)(F.ws + WS_SIND)}; pg8::gemm_phase<EpiDiffIn>(F.lds, g, S, E); }
__device__ __forceinline__ void ph_gemm_up(int l) { const KArgs a = kargs(); const Frame F = mkframe(a);
    pg8::Gemm g{(const f16*)(F.ws + WS_HB), (const f16*)(F.ws + WS_MOEIN) + (size_t)l * NE * 4096 * 1024, MROWS, 4096, 1024, EROWS / 256, (size_t)4096 * 1024, (const int*)(F.ws + WS_ROWTOK)}; pg8::StaticOrder S; S.init(MROWS, 4096, F.G, (int)blockIdx.x);
    EpiUp E{(f16*)(F.ws + WS_ACT)}; pg8::gemm_phase<EpiUp, true, true, true>(F.lds, g, S, E); }
__device__ __forceinline__ void ph_gemm_down(int l) { const KArgs a = kargs(); const Frame F = mkframe(a);
    pg8::Gemm g{(const f16*)(F.ws + WS_ACT), (const f16*)(F.ws + WS_MOEOUT) + (size_t)l * NE * 1024 * 2048, MROWS, 1024, 2048, EROWS / 256, (size_t)1024 * 2048, nullptr}; pg8::StaticOrder S; S.init(MROWS, 1024, F.G, (int)blockIdx.x);
    EpiDown E{(f16*)(F.ws + WS_Y), (const float*)(F.ws + WS_GATE)}; pg8::gemm_phase<EpiDown>(F.lds, g, S, E); }

constexpr int NPHASES = 24;
__global__ void __launch_bounds__(NTHREADS, 2) mk_fwd(Args args) {
    LAS unsigned char* ldsp = (LAS unsigned char*)g_lds;
    volatile LAS unsigned* MISC = (volatile LAS unsigned*)(ldsp + MISC_OFF);
    for (int u = threadIdx.x; u < (LDS_BYTES - LDSCTL_OFF) / 4; u += NTHREADS) ((LAS unsigned*)(ldsp + LDSCTL_OFF))[u] = 0u;
    __syncthreads();
    XcdBarrier bar = xcd_barrier_post((unsigned*)(args.ws + WS_CTL) + CW_BAR + args.li * XCD_BAR_WORDS, MISC + 8);
    const int lo = args.ph_lo, hi = args.ph_hi;
#ifndef PH_MASK
#define PH_MASK 0xFFFFFFFFu
#endif
#define IN(k) (((PH_MASK >> (k)) & 1u) && lo <= (k) && (k) < hi)
#define SEAM(k) do { if (lo <= (k) && (k) + 1 < hi) xcd_barrier(bar); } while (0)
#ifndef REP_MASK
#define REP_MASK 0u
#endif
#define RUN(k, call) do { if (IN(k)) { call; if ((REP_MASK >> (k)) & 1u) { __syncthreads(); call; } } } while (0)
    RUN(0, p0_prologue());      SEAM(0);
    RUN(1, mod_rows_p1());      SEAM(1);
    RUN(2, ph_gemm_lat());      SEAM(2);
    RUN(4, ph_gemm_q()); RUN(4, ph_gemm_qr());
    RUN(5, ph_gemm_kv());       SEAM(5);
    RUN(6, attn_mla());         SEAM(6);
#pragma unroll 1
    for (int l = 0; l < 2; ++l) {
        const int pb = (l == 0) ? 7 : 17;
        if (l == 1) {
            RUN(14, ph_gemm_diffin()); SEAM(14);
            RUN(15, attn_diff());      SEAM(15);
        }
        RUN(pb + 0, ph_gemm_o(l));     SEAM(pb + 0);
        RUN(pb + 1, ln_router(l));     SEAM(pb + 1);
        RUN(pb + 2, topk_phase(l));     SEAM(pb + 2);
        RUN(pb + 4, ph_gemm_up(l));    SEAM(pb + 4);
        RUN(pb + 5, ph_gemm_down(l));  SEAM(pb + 5);
        RUN(pb + 6, combine_ln(l));
        if (l == 0) SEAM(pb + 6);
    }
#undef IN
#undef SEAM
}

extern "C" void kernel_launch(void* const* d_in, const int* in_sizes, int n_in, void* d_out, int out_size, void* d_ws, size_t ws_size, hipStream_t stream) {
    static int grid = 0;
    if (grid == 0) {
        if (n_in != 22 || in_sizes[0] != T * DM || out_size != T * DM || ws_size < WS_END) {
            fprintf(stderr, "kernel_launch: shape/workspace mismatch: n_in %d in0 %d out %d ws %zu (need %zu)\n", n_in, n_in > 0 ? in_sizes[0] : -1, out_size, ws_size, (size_t)WS_END); grid = -1; return; }
        int dev = 0, cus = 0, per_cu = 0;
        if (hipGetDevice(&dev) != hipSuccess || hipDeviceGetAttribute(&cus, hipDeviceAttributeMultiprocessorCount, dev) != hipSuccess) { fprintf(stderr, "kernel_launch: device query failed\n"); grid = -1; return; }
        if (hipFuncSetAttribute((const void*)mk_fwd, hipFuncAttributeMaxDynamicSharedMemorySize, LDS_BYTES) != hipSuccess) { fprintf(stderr, "kernel_launch: hipFuncSetAttribute failed\n"); grid = -1; return; }
        if (hipOccupancyMaxActiveBlocksPerMultiprocessor(&per_cu, (const void*)mk_fwd, NTHREADS, LDS_BYTES) != hipSuccess || per_cu < 1)
            fprintf(stderr, "kernel_launch: note: occupancy query reports %d workgroups per CU\n", per_cu);
        (void)hipGetLastError();
        grid = cus;
        if (T % (2 * grid * NWAVES) != 0) { fprintf(stderr, "kernel_launch: %d workgroups do not divide the row phases evenly (need T %% (16 * grid) == 0)\n", grid); grid = -1; return; }
    }
    if (grid < 0) return;
    if (hipMemsetAsync((char*)d_ws + WS_CTL, 0, CTL_ZERO_BYTES, stream) != hipSuccess) { fprintf(stderr, "kernel_launch: memset failed\n"); return; }
    Args a{};
    for (int i = 0; i < 22; ++i) a.in[i] = d_in[i];
    a.out = (float*)d_out; a.ws = (unsigned char*)d_ws;
#if MK_CUTS == 1
    a.ph_lo = 0; a.ph_hi = NPHASES; a.li = 0;
    hipLaunchKernelGGL(mk_fwd, dim3(grid), dim3(NTHREADS), LDS_BYTES, stream, a);
#else
    for (int p = 0; p < NPHASES; ++p) { a.ph_lo = p; a.ph_hi = p + 1; a.li = 0; hipLaunchKernelGGL(mk_fwd, dim3(grid), dim3(NTHREADS), LDS_BYTES, stream, a); }
#endif
    const hipError_t le = hipPeekAtLastError();
    if (le != hipSuccess) fprintf(stderr, "kernel_launch: launch failed: %s\n", hipGetErrorName(le));
}
```
